# Optimizing an MI355X kernel written in HIP

```python
import math
import jax, jax.numpy as jnp
from jax import lax
import numpy as np

D_MODEL = 1024
BATCH = 16
SEQ = 2048
DEPTH = 2

N_HEADS = 16
HEAD_DIM = D_MODEL // N_HEADS
Q_CHUNK = 64
NEG_INF = -1e30
LN_EPS = 1e-5
MOBA_BLOCK = 256
MOBA_TOPK = 3
NSA_KV_HEADS = 4
NSA_GROUP = N_HEADS // NSA_KV_HEADS
CMP_LEN = 32
CMP_STRIDE = 16
CMP_HIDDEN = 256
SLC_BLOCK = 64
SLC_TOPN = 16
SLC_LOCAL = 2
WINDOW = 512
REL_BUCKETS = 32
REL_MAX_DIST = 128
N_EXPERTS = 32
N_GROUPS = 8
EXPERTS_PER_GROUP = N_EXPERTS // N_GROUPS
TOP_K = 2
D_EXPERT = 512
MOE_BLOCK = 128
N_MOBA_LAYERS = (DEPTH + 1) // 2
N_NSA_LAYERS = DEPTH // 2
DEEPNORM_ALPHA = (2 * DEPTH) ** 0.25
DEEPNORM_BETA = (8 * DEPTH) ** -0.25

kernel_name = 'moba_nsa_deepnorm_grouped_moe'


def layer_norm(x, g, b):
    xf = x.astype(jnp.float32)
    mu = jnp.mean(xf, axis=-1, keepdims=True)
    var = jnp.mean(jnp.square(xf - mu), axis=-1, keepdims=True)
    y = (xf - mu) * lax.rsqrt(var + LN_EPS)
    return (y * g.astype(jnp.float32) + b.astype(jnp.float32)).astype(x.dtype)


def t5_bucket(rel):
    n = jnp.maximum(rel, 0)
    max_exact = REL_BUCKETS // 2
    nf = jnp.maximum(n, 1).astype(jnp.float32)
    large = max_exact + (jnp.log(nf / max_exact) / math.log(REL_MAX_DIST / max_exact)
                         * (REL_BUCKETS - max_exact)).astype(jnp.int32)
    large = jnp.minimum(large, REL_BUCKETS - 1)
    return jnp.where(n < max_exact, n, large)


def masked_softmax(s, valid):
    return jax.nn.softmax(jnp.where(valid, s, NEG_INF), axis=-1)


def gather_blocks(blocks, idx):
    return jax.vmap(lambda bl, ix: bl[ix])(blocks, idx)


def moba_attention(x, w_in, w_out, rel_bias):
    B, S, _ = x.shape
    H, d, BLK = N_HEADS, HEAD_DIM, MOBA_BLOCK
    scale = d ** -0.5
    proj = x @ w_in
    q, k, v = jnp.split(proj, 3, axis=-1)
    to_heads = lambda t: t.reshape(B, S, H, d).transpose(0, 2, 1, 3)
    q, k, v = to_heads(q), to_heads(k), to_heads(v)
    S_pad = -(-S // BLK) * BLK
    padw = ((0, 0), (0, 0), (0, S_pad - S), (0, 0))
    q, k, v = jnp.pad(q, padw), jnp.pad(k, padw), jnp.pad(v, padw)
    nb = S_pad // BLK
    topk = min(MOBA_TOPK, nb)
    tbl = rel_bias.T

    def one_seq(args):
        qs, ks, vs = args
        kb = ks.reshape(H, nb, BLK, d)
        vb = vs.reshape(H, nb, BLK, d)
        kmean = jnp.mean(kb.astype(jnp.float32), axis=2).astype(ks.dtype)

        def one_chunk(c):
            start = c * Q_CHUNK
            qc = lax.dynamic_slice_in_dim(qs, start, Q_CHUNK, axis=1)
            qpos = start + jnp.arange(Q_CHUNK)
            qblk = start // BLK
            gate = jnp.einsum('hqd,hnd->hqn', qc, kmean).astype(jnp.float32)
            gate = jnp.where(jnp.arange(nb) < qblk, gate, -jnp.inf)
            _, idx = lax.top_k(gate, topk)
            sel_valid = idx < qblk
            kg = gather_blocks(kb, idx)
            vg = gather_blocks(vb, idx)
            kpos_sel = idx[..., None] * BLK + jnp.arange(BLK)
            s_sel = jnp.einsum('hqd,hqnkd->hqnk', qc, kg).reshape(H, Q_CHUNK, topk * BLK)
            own_start = qblk * BLK
            ko = lax.dynamic_slice_in_dim(ks, own_start, BLK, axis=1)
            vo = lax.dynamic_slice_in_dim(vs, own_start, BLK, axis=1)
            kpos_own = own_start + jnp.arange(BLK)
            s_own = jnp.einsum('hqd,hkd->hqk', qc, ko)
            scores = jnp.concatenate([s_sel, s_own], axis=-1).astype(jnp.float32) * scale
            kpos = jnp.concatenate([kpos_sel.reshape(H, Q_CHUNK, topk * BLK),
                                    jnp.broadcast_to(kpos_own, (H, Q_CHUNK, BLK))], axis=-1)
            valid_sel = jnp.broadcast_to(sel_valid[..., None], (H, Q_CHUNK, topk, BLK)).reshape(H, Q_CHUNK, topk * BLK)
            valid_own = jnp.broadcast_to(kpos_own[None, :] <= qpos[:, None], (H, Q_CHUNK, BLK))
            valid = jnp.concatenate([valid_sel, valid_own], axis=-1)
            rel = qpos[None, :, None] - kpos
            bias = jax.vmap(lambda t, bk: t[bk])(tbl, t5_bucket(rel)).astype(jnp.float32)
            p = masked_softmax(scores + bias, valid).astype(vs.dtype)
            o = (jnp.einsum('hqnk,hqnkd->hqd', p[..., :topk * BLK].reshape(H, Q_CHUNK, topk, BLK), vg)
                 + jnp.einsum('hqk,hkd->hqd', p[..., topk * BLK:], vo))
            return o

        outs = lax.map(one_chunk, jnp.arange(S_pad // Q_CHUNK))
        return outs.transpose(1, 0, 2, 3).reshape(H, S_pad, d)

    o = lax.map(one_seq, (q, k, v))
    o = o[:, :, :S].transpose(0, 2, 1, 3).reshape(B, S, H * d)
    return o @ w_out


def nsa_attention(x, w_in, w_out, pos_k, pos_v, ck_w1, ck_w2, cv_w1, cv_w2, rel_bias):
    B, S, _ = x.shape
    H, Hkv, G, d = N_HEADS, NSA_KV_HEADS, NSA_GROUP, HEAD_DIM
    scale = d ** -0.5
    proj = x @ w_in
    sizes = [H * d] + [Hkv * d] * 6 + [3 * H]
    q, kc, vc, ks, vs, kw, vw, g = jnp.split(proj, np.cumsum(sizes)[:-1].tolist(), axis=-1)
    q = q.reshape(B, S, Hkv, G, d).transpose(0, 2, 3, 1, 4)
    kv_heads = lambda t: t.reshape(B, S, Hkv, d)
    kc, vc, ks, vs, kw, vw = [kv_heads(t) for t in (kc, vc, ks, vs, kw, vw)]
    g = jax.nn.sigmoid(g).reshape(B, S, Hkv, G, 3).transpose(0, 2, 3, 1, 4)

    n_cmp = (S - CMP_LEN) // CMP_STRIDE + 1
    cidx = np.arange(n_cmp)[:, None] * CMP_STRIDE + np.arange(CMP_LEN)[None, :]

    def compress(t, pos, w1, w2):
        blk = t[:, cidx] + pos[None, None, :, None, :]
        blk = blk.transpose(0, 1, 3, 2, 4).reshape(B, n_cmp, Hkv, CMP_LEN * d)
        return (jax.nn.gelu(blk @ w1) @ w2).transpose(0, 2, 1, 3)

    kcmp = compress(kc, pos_k, ck_w1, ck_w2)
    vcmp = compress(vc, pos_v, cv_w1, cv_w2)
    to_hm = lambda t: t.transpose(0, 2, 1, 3)
    ks, vs = to_hm(ks), to_hm(vs)
    padw = ((0, 0), (0, 0), (WINDOW, 0), (0, 0))
    kw_pad, vw_pad = jnp.pad(to_hm(kw), padw), jnp.pad(to_hm(vw), padw)

    n_slc = S // SLC_BLOCK
    topn = min(SLC_TOPN, n_slc)
    ci = np.arange(n_cmp)[:, None] * CMP_STRIDE
    sj = np.arange(n_slc)[None, :] * SLC_BLOCK
    cmp_to_slc = jnp.asarray(((ci < sj + SLC_BLOCK) & (ci + CMP_LEN > sj)).astype(np.float32))
    cmp_end = jnp.arange(n_cmp) * CMP_STRIDE + CMP_LEN - 1
    tbl = rel_bias.T.reshape(Hkv, G, REL_BUCKETS)

    def one_seq(args):
        qs, kcm, vcm, kss, vss, kwp, vwp, gs = args
        ksb = kss.reshape(Hkv, n_slc, SLC_BLOCK, d)
        vsb = vss.reshape(Hkv, n_slc, SLC_BLOCK, d)

        def one_chunk(c):
            start = c * Q_CHUNK
            qc = lax.dynamic_slice_in_dim(qs, start, Q_CHUNK, axis=2)
            qpos = start + jnp.arange(Q_CHUNK)
            s_c = jnp.einsum('hgqd,hnd->hgqn', qc, kcm).astype(jnp.float32) * scale
            v_c = cmp_end[None, :] <= qpos[:, None]
            p_c = masked_softmax(s_c, v_c) * v_c
            o_c = jnp.einsum('hgqn,hnd->hgqd', p_c.astype(vcm.dtype), vcm)
            imp = jnp.einsum('hgqn,nj->hqj', p_c, cmp_to_slc)
            qblk = qpos // SLC_BLOCK
            j = jnp.arange(n_slc)[None, :]
            qb = qblk[:, None]
            forced = (j == 0) | ((j <= qb) & (j > qb - SLC_LOCAL))
            future = j > qb
            imp = jnp.where(forced[None], jnp.inf, jnp.where(future[None], -jnp.inf, imp))
            _, idx = lax.top_k(imp, topn)
            sel_valid = idx <= qblk[None, :, None]
            kg = gather_blocks(ksb, idx)
            vg = gather_blocks(vsb, idx)
            kpos_s = idx[..., None] * SLC_BLOCK + jnp.arange(SLC_BLOCK)
            rel_s = qpos[None, :, None, None] - kpos_s
            valid_s = sel_valid[..., None] & (rel_s >= 0)
            s_s = jnp.einsum('hgqd,hqnkd->hgqnk', qc, kg).astype(jnp.float32) * scale
            bias_s = jax.vmap(lambda t, bk: t[:, bk])(tbl, t5_bucket(rel_s)).astype(jnp.float32)
            s_s = jnp.where(valid_s[:, None], s_s + bias_s, NEG_INF).reshape(Hkv, G, Q_CHUNK, topn * SLC_BLOCK)
            p_s = jax.nn.softmax(s_s, axis=-1).reshape(Hkv, G, Q_CHUNK, topn, SLC_BLOCK)
            o_s = jnp.einsum('hgqnk,hqnkd->hgqd', p_s.astype(vg.dtype), vg)
            kwin = lax.dynamic_slice_in_dim(kwp, start, WINDOW + Q_CHUNK, axis=1)
            vwin = lax.dynamic_slice_in_dim(vwp, start, WINDOW + Q_CHUNK, axis=1)
            kpos_w = start - WINDOW + jnp.arange(WINDOW + Q_CHUNK)
            rel_w = qpos[:, None] - kpos_w[None, :]
            valid_w = (rel_w >= 0) & (rel_w < WINDOW) & (kpos_w[None, :] >= 0)
            s_w = jnp.einsum('hgqd,hkd->hgqk', qc, kwin).astype(jnp.float32) * scale
            bias_w = tbl[:, :, t5_bucket(rel_w)].astype(jnp.float32)
            p_w = masked_softmax(s_w + bias_w, valid_w)
            o_w = jnp.einsum('hgqk,hkd->hgqd', p_w.astype(vwin.dtype), vwin)
            gc = lax.dynamic_slice_in_dim(gs, start, Q_CHUNK, axis=2)
            return gc[..., 0:1] * o_c + gc[..., 1:2] * o_s + gc[..., 2:3] * o_w

        outs = lax.map(one_chunk, jnp.arange(S // Q_CHUNK))
        return outs.transpose(1, 2, 0, 3, 4).reshape(Hkv, G, S, d)

    o = lax.map(one_seq, (q, kcmp, vcmp, ks, vs, kw_pad, vw_pad, g))
    o = o.transpose(0, 3, 1, 2, 4).reshape(B, S, H * d)
    return o @ w_out


def grouped_moe(x, router_w, router_b, w_gate, w_up, w_down):
    B, S, D = x.shape
    N = B * S
    h = x.reshape(N, D)
    probs = jax.nn.softmax((h @ router_w).astype(jnp.float32) + router_b.astype(jnp.float32), axis=-1)
    grp = probs.reshape(N, N_GROUPS, EXPERTS_PER_GROUP)
    grp_score = lax.top_k(grp, TOP_K)[0].sum(-1)
    best = jnp.argmax(grp_score, axis=-1)
    in_grp = jnp.take_along_axis(grp, best[:, None, None], axis=1)[:, 0]
    wts, local = lax.top_k(in_grp, TOP_K)
    wts = wts / jnp.sum(wts, axis=-1, keepdims=True)
    expert = best[:, None] * EXPERTS_PER_GROUP + local
    A = N * TOP_K
    e_flat = expert.reshape(A)
    tok = jnp.repeat(jnp.arange(N), TOP_K)
    w_flat = wts.reshape(A)
    order = jnp.argsort(e_flat)
    e_s, tok_s, w_s = e_flat[order], tok[order], w_flat[order]
    counts = jnp.bincount(e_flat, length=N_EXPERTS)
    starts = jnp.cumsum(counts) - counts
    padded = (counts + MOE_BLOCK - 1) // MOE_BLOCK * MOE_BLOCK
    pends = jnp.cumsum(padded)
    pstarts = pends - padded
    dest = pstarts[e_s] + (jnp.arange(A) - starts[e_s])
    R = A + N_EXPERTS * MOE_BLOCK
    n_blk = R // MOE_BLOCK
    row_tok = jnp.zeros((R,), jnp.int32).at[dest].set(tok_s)
    row_w = jnp.zeros((R,), jnp.float32).at[dest].set(w_s)
    blk_e = jnp.minimum(jnp.searchsorted(pends, jnp.arange(n_blk) * MOE_BLOCK, side='right'), N_EXPERTS - 1)
    xb = h[row_tok].reshape(n_blk, MOE_BLOCK, D)

    def expert_block(args):
        xt, e = args
        hid = jax.nn.silu(xt @ w_gate[e]) * (xt @ w_up[e])
        return hid @ w_down[e]

    yb = lax.map(expert_block, (xb, blk_e)).reshape(R, D)
    out = jnp.zeros((N, D), x.dtype).at[row_tok].add(yb * row_w[:, None].astype(yb.dtype))
    return out.reshape(B, S, D)


def setup_inputs(seed: int = 0) -> dict:
    key = jax.random.key(seed)
    ks = jax.random.split(key, 20)
    nrm = lambda k, shape, s: jax.random.normal(k, shape, jnp.float32) * s
    HD = N_HEADS * HEAD_DIM
    d_in_nsa = HD + 6 * NSA_KV_HEADS * HEAD_DIM + 3 * N_HEADS
    return dict(
        x=nrm(ks[0], (BATCH, SEQ, D_MODEL), 1.0),
        rel_bias=nrm(ks[1], (REL_BUCKETS, N_HEADS), 0.5),
        router_w=nrm(ks[2], (D_MODEL, N_EXPERTS), D_MODEL ** -0.5),
        router_b=nrm(ks[3], (N_EXPERTS,), 0.01),
        ln_g=1.0 + nrm(ks[4], (DEPTH, 2, D_MODEL), 0.05),
        ln_b=nrm(ks[5], (DEPTH, 2, D_MODEL), 0.05),
        moba_w_in=nrm(ks[6], (N_MOBA_LAYERS, D_MODEL, 3 * HD), D_MODEL ** -0.5),
        moba_w_out=nrm(ks[7], (N_MOBA_LAYERS, HD, D_MODEL), DEEPNORM_BETA * HD ** -0.5),
        nsa_w_in=nrm(ks[8], (N_NSA_LAYERS, D_MODEL, d_in_nsa), D_MODEL ** -0.5),
        nsa_w_out=nrm(ks[9], (N_NSA_LAYERS, HD, D_MODEL), DEEPNORM_BETA * HD ** -0.5),
        nsa_pos_k=nrm(ks[10], (N_NSA_LAYERS, CMP_LEN, HEAD_DIM), 0.1),
        nsa_pos_v=nrm(ks[11], (N_NSA_LAYERS, CMP_LEN, HEAD_DIM), 0.1),
        nsa_ck_w1=nrm(ks[12], (N_NSA_LAYERS, CMP_LEN * HEAD_DIM, CMP_HIDDEN), (CMP_LEN * HEAD_DIM) ** -0.5),
        nsa_ck_w2=nrm(ks[13], (N_NSA_LAYERS, CMP_HIDDEN, HEAD_DIM), CMP_HIDDEN ** -0.5),
        nsa_cv_w1=nrm(ks[14], (N_NSA_LAYERS, CMP_LEN * HEAD_DIM, CMP_HIDDEN), (CMP_LEN * HEAD_DIM) ** -0.5),
        nsa_cv_w2=nrm(ks[15], (N_NSA_LAYERS, CMP_HIDDEN, HEAD_DIM), CMP_HIDDEN ** -0.5),
        moe_w_gate=nrm(ks[16], (DEPTH, N_EXPERTS, D_MODEL, D_EXPERT), D_MODEL ** -0.5),
        moe_w_up=nrm(ks[17], (DEPTH, N_EXPERTS, D_MODEL, D_EXPERT), D_MODEL ** -0.5),
        moe_w_down=nrm(ks[18], (DEPTH, N_EXPERTS, D_EXPERT, D_MODEL), DEEPNORM_BETA * D_EXPERT ** -0.5),
    )


def reference(x, rel_bias, router_w, router_b, ln_g, ln_b, moba_w_in, moba_w_out,
              nsa_w_in, nsa_w_out, nsa_pos_k, nsa_pos_v, nsa_ck_w1, nsa_ck_w2,
              nsa_cv_w1, nsa_cv_w2, moe_w_gate, moe_w_up, moe_w_down):
    for i in range(DEPTH):
        j = i // 2
        if i % 2 == 0:
            mix = moba_attention(x, moba_w_in[j], moba_w_out[j], rel_bias)
        else:
            mix = nsa_attention(x, nsa_w_in[j], nsa_w_out[j], nsa_pos_k[j], nsa_pos_v[j],
                                nsa_ck_w1[j], nsa_ck_w2[j], nsa_cv_w1[j], nsa_cv_w2[j], rel_bias)
        x = layer_norm(DEEPNORM_ALPHA * x + mix, ln_g[i, 0], ln_b[i, 0])
        ffn = grouped_moe(x, router_w, router_b, moe_w_gate[i], moe_w_up[i], moe_w_down[i])
        x = layer_norm(DEEPNORM_ALPHA * x + ffn, ln_g[i, 1], ln_b[i, 1])
    return x
```

```cpp
#include <hip/hip_runtime.h>
#include <cstdio>
#include <cstdint>

#ifndef MK_LAUNCHES
#define MK_LAUNCHES 0
#endif

#define LAS __attribute__((address_space(3)))
typedef unsigned short bf16_t;
typedef short bf16x8 __attribute__((ext_vector_type(8)));
typedef short s16x4 __attribute__((ext_vector_type(4)));
typedef short v4i16_t __attribute__((ext_vector_type(4)));
typedef float f32x4 __attribute__((ext_vector_type(4)));
typedef float f32x16 __attribute__((ext_vector_type(16)));
typedef unsigned u32x4 __attribute__((ext_vector_type(4)));
typedef unsigned u32x2 __attribute__((ext_vector_type(2)));
typedef LAS const char* lds_cptr;

constexpr int NTOK = 32768, DM = 1024, SEQ = 2048, NBATCH = 16, NHEAD = 16;
constexpr int QKV_LD = 3072, NSA_LD = 2816;
constexpr int NSA_KC = 1024, NSA_VC = 1280, NSA_KS = 1536, NSA_VS = 1792, NSA_KW = 2048, NSA_VW = 2304, NSA_G = 2560;
constexpr int NEXP = 32, DEXP = 512, MAXPAN = 288, RPAD = MAXPAN * 256;
constexpr int NTHREADS = 512, NWG_EXPECT = 256;
constexpr int LDS_BYTES = 155648;
constexpr float LOG2E = 1.4426950408889634f;
constexpr float C2 = 0.125f * LOG2E;
constexpr float ALPHA = 1.4142135623730951f;
constexpr int BT_N = 288;

constexpr size_t al256(size_t x) { return (x + 255) & ~(size_t)255; }
constexpr size_t WS_CTL = 0;
constexpr size_t WS_TAB = 16384;
constexpr size_t WS_B1 = WS_TAB + al256(16 * BT_N * 4);
constexpr size_t WS_NPAN = WS_B1 + 2048;
constexpr size_t WS_PANEL = WS_NPAN + 256;
constexpr size_t WS_HIST = WS_PANEL + 1280;
constexpr size_t WS_KPART = WS_HIST + 32768;
constexpr size_t WS_RE = WS_KPART + 128 * 2 * 1024 * 4;
constexpr size_t WS_RWT = WS_RE + (size_t)NTOK * 8;
constexpr size_t WS_POS = WS_RWT + (size_t)NTOK * 8;
constexpr size_t WS_ROWTOK = WS_POS + (size_t)NTOK * 8;
constexpr size_t WS_KCMP = WS_ROWTOK + al256((size_t)RPAD * 4);
constexpr size_t WS_VCMP = WS_KCMP + 16 * 4 * 128 * 64 * 2;
constexpr size_t WS_WQKV0 = WS_VCMP + 16 * 4 * 128 * 64 * 2;
constexpr size_t WS_WO0 = WS_WQKV0 + (size_t)3072 * 1024 * 2;
constexpr size_t WS_WIN1 = WS_WO0 + (size_t)1024 * 1024 * 2;
constexpr size_t WS_WO1 = WS_WIN1 + (size_t)2816 * 1024 * 2;
constexpr size_t WS_W1T = WS_WO1 + (size_t)1024 * 1024 * 2;
constexpr size_t WS_GU = WS_W1T + (size_t)2 * 256 * 2048 * 2;
constexpr size_t WS_DN = WS_GU + (size_t)32 * 1024 * 1024 * 2;
constexpr size_t WS_XB = WS_DN + (size_t)32 * 1024 * 512 * 2;
constexpr size_t WS_BIG = WS_XB + (size_t)NTOK * 1024 * 2;
constexpr size_t WS_AOH = WS_BIG + (size_t)NTOK * 3072 * 2;
constexpr size_t WS_X1B = WS_AOH + (size_t)RPAD * 512 * 2;
constexpr size_t WS_END = WS_X1B + (size_t)NTOK * 1024 * 2;

struct Params {
    const float *x, *rel_bias, *router_w, *router_b, *ln_g, *ln_b, *moba_w_in, *moba_w_out, *nsa_w_in, *nsa_w_out, *pos_k, *pos_v,
                *ck_w1, *ck_w2, *cv_w1, *cv_w2, *w_gate, *w_up, *w_down;
    float* out;
    char* ws;
};

__device__ __forceinline__ int otid() { int t = threadIdx.x; asm volatile("" : "+v"(t)); return t; }
__device__ __forceinline__ float bf2f(bf16_t v) { return __uint_as_float(((unsigned)v) << 16); }
__device__ __forceinline__ unsigned cvt_pk_bf16(float lo, float hi) { unsigned r; asm volatile("v_cvt_pk_bf16_f32 %0, %1, %2" : "=v"(r) : "v"(lo), "v"(hi)); return r; }
__device__ __forceinline__ bf16_t f2bf(float f) { return (bf16_t)(cvt_pk_bf16(f, 0.f) & 0xffffu); }
__device__ __forceinline__ float lo_bf(unsigned w) { return __uint_as_float(w << 16); }
__device__ __forceinline__ float hi_bf(unsigned w) { return __uint_as_float(w & 0xffff0000u); }
__device__ __forceinline__ float wave_sum(float v) {
#pragma unroll
    for (int o = 32; o > 0; o >>= 1) v += __shfl_xor(v, o);
    return v; }

#define XB_TMO      128
#define XB_XCNT(j)  (256  + 64 * (j))
#define XB_XSUB(j)  (1280 + 64 * (j))
#define XB_XGEN(j)  (2304 + 64 * (j))
#define XB_TOP      3328
#define XB_TOPGEN   3392
#define XCD_BAR_WORDS 3456
#define XB_SPIN_CAP (1u << 18)
__device__ __forceinline__ unsigned xb_ld(unsigned* p)              { return __hip_atomic_load(p, __ATOMIC_RELAXED, __HIP_MEMORY_SCOPE_AGENT); }
__device__ __forceinline__ unsigned xb_add(unsigned* p, unsigned v) { return __hip_atomic_fetch_add(p, v, __ATOMIC_RELAXED, __HIP_MEMORY_SCOPE_AGENT); }
__device__ __forceinline__ unsigned xb_xcc_id() { return (unsigned)__builtin_amdgcn_s_getreg((3 << 11) | 20) & 0xFu; }
#define XB_SPIN(cond, bar) do { unsigned _sp = 0; while (cond) { __builtin_amdgcn_s_sleep(1); \
    if ((++_sp & 255u) == 0u) { if (xb_ld(&(bar)[XB_TMO])) break; if (_sp > XB_SPIN_CAP) { atomicAdd(&(bar)[XB_TMO], 1u); break; } } } } while (0)
struct XcdBarrier { unsigned* bar; unsigned x; volatile LAS unsigned* st; };
__device__ __forceinline__ XcdBarrier xcd_barrier_post(unsigned* bar, volatile LAS unsigned* st) {
    XcdBarrier b; b.bar = bar; b.x = xb_xcc_id(); b.st = st;
    if (threadIdx.x == 0) (void)xb_add(&bar[XB_XCNT(b.x)], 1u);
    return b;
}
__device__ __forceinline__ void xcd_barrier_complete(unsigned* bar, unsigned x, unsigned& nloc, unsigned& nx) {
    const unsigned G = gridDim.x * gridDim.y * gridDim.z;
    unsigned sum, cnt, mine, sp = 0u;
    for (;;) {
        sum = 0u; cnt = 0u; mine = 0u;
#pragma unroll
        for (unsigned j = 0; j < 16; ++j) { const unsigned c = xb_ld(&bar[XB_XCNT(j)]); sum += c; cnt += (c > 0u) ? 1u : 0u; mine = (j == x) ? c : mine; }
        if (sum == G) break;
        __builtin_amdgcn_s_sleep(1);
        if ((++sp & 255u) == 0u) { if (xb_ld(&bar[XB_TMO])) break; if (sp > XB_SPIN_CAP) { atomicAdd(&bar[XB_TMO], 1u); break; } }
    }
    nloc = mine > 0u ? mine : 1u; nx = cnt > 0u ? cnt : 1u;
}
__device__ __forceinline__ void xcd_barrier(const XcdBarrier& b) {
    asm volatile("s_waitcnt vmcnt(0)" ::: "memory");
    __syncthreads();
    if (threadIdx.x == 0) {
        unsigned* bar = b.bar;
        __builtin_amdgcn_s_waitcnt(0);
        unsigned nloc = b.st[0], nx = b.st[1];
        if (nloc == 0u) { xcd_barrier_complete(bar, b.x, nloc, nx); b.st[0] = nloc; b.st[1] = nx; }
        const unsigned old = xb_add(&bar[XB_XSUB(b.x)], 1u);
        const unsigned gen = old / nloc;
        if (old + 1u == (gen + 1u) * nloc) {
            __builtin_amdgcn_fence(__ATOMIC_RELEASE, "agent");
            asm volatile("s_waitcnt vmcnt(0)" ::: "memory");
            const unsigned og = xb_add(&bar[XB_TOP], 1u);
            const unsigned tg = og / nx;
            if (og + 1u == (tg + 1u) * nx) xb_add(&bar[XB_TOPGEN], 1u);
            else XB_SPIN(xb_ld(&bar[XB_TOPGEN]) == tg, bar);
            __builtin_amdgcn_fence(__ATOMIC_ACQUIRE, "agent");
            xb_add(&bar[XB_XGEN(b.x)], 1u);
            asm volatile("s_waitcnt vmcnt(0)" ::: "memory");
        } else {
            XB_SPIN(xb_ld(&bar[XB_XGEN(b.x)]) == gen, bar);
            __builtin_amdgcn_fence(__ATOMIC_ACQUIRE, "agent");
            asm volatile("s_waitcnt vmcnt(0)" ::: "memory");
        }
    }
    __syncthreads();
}

namespace pg8 {
constexpr int BM = 256, BK = 64, HALF = 128, HTB = HALF * BK * 2, STAGE_BYTES = 8 * HTB, NXCD = 8, WGM = 8;
__device__ __forceinline__ int lds_byte(int r, int c) { const int st = (r >> 4) * 2 + (c >> 5), rr = r & 15, cc = c & 31, ob = rr * 64 + cc * 2; return st * 1024 + (ob ^ (((ob >> 9) & 1) << 5)); }
__device__ __forceinline__ void stage_rc(int b, int& R, int& C) { const int st = b / 1024, sb = b % 1024, swz = sb ^ (((sb >> 9) & 1) << 5); R = (st >> 1) * 16 + swz / 64; C = (st & 1) * 32 + (swz % 64) / 2; }
__device__ __forceinline__ int perm32(int rho) { const int n = rho >> 4, i = rho & 15; return 8 * (i >> 2) + 4 * n + (i & 3); }
struct Unit { int pm, pn, aux; };

__device__ __forceinline__ void static_unit(int L, int nM, int nN, Unit& u) {
    const int nwg = nM * nN;
    int wgid = L; { const int q = nwg / NXCD, r = nwg % NXCD, xcd = wgid % NXCD, off = wgid / NXCD; wgid = (xcd < r ? xcd * (q + 1) : r * (q + 1) + (xcd - r) * q) + off; }
    const int nig = WGM * nN, gid = wgid / nig, fm = gid * WGM, gsz = (nM - fm) < WGM ? (nM - fm) : WGM;
    u.pm = fm + ((wgid % nig) % gsz); u.pn = (wgid % nig) / gsz; u.aux = 0;
}

template <class Epi, class Sched>
__device__ __forceinline__ void gemm_phase(LAS unsigned char* lds, const Sched& S, const Epi& E) {
    const int tid = otid(), wid = __builtin_amdgcn_readfirstlane(tid >> 6), lane = tid & 63, wr = wid >> 2, wc = wid & 3, fr = lane & 15, fq = lane >> 4;
    const int nt = S.nt;
    int sR[2], sC[2];
    unsigned vB[2][2];
#pragma unroll
    for (int i = 0; i < 2; ++i) { stage_rc(tid * 16 + i * 8192, sR[i], sC[i]); const int Rb = Epi::PERM ? ((sR[i] & ~31) + perm32(sR[i] & 31)) : sR[i];
#pragma unroll
        for (int h = 0; h < 2; ++h) vB[h][i] = (unsigned)(h * HALF + Rb) * S.ldb + (unsigned)sC[i] * 2u; }
    const size_t kstepA = S.kstepA, kstepB = S.kstepB;
    const unsigned ldsw = (unsigned)wid * 1024u;
    const int aoff = lds_byte(wr * 64 + fr, fq * 8), boff = lds_byte(wc * 32 + fr, fq * 8);
#define PG8_SA(b, h) (((b) * 2 + (h)) * HTB)
#define PG8_SB(b, h) ((4 + (b) * 2 + (h)) * HTB)
#define PG8_STAGE(bufoff, gbase, v0, v1) do { \
        __builtin_amdgcn_global_load_lds((const unsigned*)((const char*)(gbase) + (v0)), (LAS unsigned*)(lds + (bufoff) + ldsw), 16, 0, 0); \
        __builtin_amdgcn_global_load_lds((const unsigned*)((const char*)(gbase) + (v1)), (LAS unsigned*)(lds + (bufoff) + ldsw + 8192), 16, 0, 0); } while (0)
#define PG8_LDA(dst, b, h) do { _Pragma("unroll") for (int m = 0; m < 4; ++m) _Pragma("unroll") for (int k = 0; k < 2; ++k) dst[m][k] = *(const LAS bf16x8*)(lds + PG8_SA(b, h) + aoff + m * 2048 + k * 1024); } while (0)
#define PG8_LDB(dst, b, h) do { _Pragma("unroll") for (int n = 0; n < 2; ++n) _Pragma("unroll") for (int k = 0; k < 2; ++k) dst[n][k] = *(const LAS bf16x8*)(lds + PG8_SB(b, h) + boff + n * 2048 + k * 1024); } while (0)
#define PG8_MMA(ai, bj, At, Bt) do { __builtin_amdgcn_s_setprio(1); _Pragma("unroll") for (int m = 0; m < 4; ++m) _Pragma("unroll") for (int n = 0; n < 2; ++n) _Pragma("unroll") for (int k = 0; k < 2; ++k) \
        acc[ai][bj][m][n] = __builtin_amdgcn_mfma_f32_16x16x32_bf16(Bt[n][k], At[m][k], acc[ai][bj][m][n], 0, 0, 0); __builtin_amdgcn_s_setprio(0); } while (0)
#define PG8_WAIT_V(n) asm volatile("s_waitcnt vmcnt(" #n ")" ::: "memory")
#define PG8_WAIT_L(n) asm volatile("s_waitcnt lgkmcnt(" #n ")" ::: "memory")
#define PG8_BAR __builtin_amdgcn_s_barrier()
#define PG8_SCHED __builtin_amdgcn_sched_barrier(0)
    Unit cur, nxt; int ui = 0;
    if (!S.next(0, cur)) return;
    f32x4 acc[2][2][4][2];
#pragma unroll
    for (int a = 0; a < 2; ++a)
#pragma unroll
        for (int b = 0; b < 2; ++b)
#pragma unroll
            for (int m = 0; m < 4; ++m)
#pragma unroll
                for (int n = 0; n < 2; ++n) acc[a][b][m][n] = (f32x4){0.f, 0.f, 0.f, 0.f};
    bf16x8 At[4][2], B0[2][2], B1[2][2];
    unsigned vA[2][2], vN[2][2];
#pragma unroll
    for (int h = 0; h < 2; ++h)
#pragma unroll
        for (int i = 0; i < 2; ++i) { vA[h][i] = S.aoff(cur, h * HALF + sR[i], sC[i]); vN[h][i] = vA[h][i]; }
    const char* cA = S.abase(cur); const char* cB = S.bbase(cur);
    PG8_STAGE(PG8_SB(0, 0), cB, vB[0][0], vB[0][1]); PG8_STAGE(PG8_SA(0, 0), cA, vA[0][0], vA[0][1]); PG8_STAGE(PG8_SB(0, 1), cB, vB[1][0], vB[1][1]); PG8_STAGE(PG8_SA(0, 1), cA, vA[1][0], vA[1][1]);
    if (wr == 1) PG8_BAR;
    PG8_WAIT_V(4); PG8_BAR;
    PG8_STAGE(PG8_SB(1, 0), cB + kstepB, vB[0][0], vB[0][1]); PG8_STAGE(PG8_SA(1, 0), cA + kstepA, vA[0][0], vA[0][1]); PG8_STAGE(PG8_SB(1, 1), cB + kstepB, vB[1][0], vB[1][1]);
    PG8_WAIT_V(6); PG8_BAR;
    for (;;) {
        const bool has_next = S.next(ui + 1, nxt);
        const char* nA = has_next ? S.abase(nxt) : cA; const char* nB = has_next ? S.bbase(nxt) : cB;
        if (Sched::DYN_A && has_next) {
#pragma unroll
            for (int h = 0; h < 2; ++h)
#pragma unroll
                for (int i = 0; i < 2; ++i) vN[h][i] = S.aoff(nxt, h * HALF + sR[i], sC[i]);
        }
        for (int t = 0; t < nt; t += 2) {
            const bool last = (t == nt - 2);
            const char* a1 = cA + (size_t)(t + 1) * kstepA;
            const char* a2 = last ? nA : cA + (size_t)(t + 2) * kstepA; const char* b2 = last ? nB : cB + (size_t)(t + 2) * kstepB;
            const char* a3 = a2 + kstepA; const char* b3 = b2 + kstepB;
            PG8_LDB(B0, 0, 0); PG8_SCHED; PG8_LDA(At, 0, 0); PG8_STAGE(PG8_SA(1, 1), a1, vA[1][0], vA[1][1]);
            if (Sched::DYN_A && last) {
#pragma unroll
                for (int h = 0; h < 2; ++h)
#pragma unroll
                    for (int i = 0; i < 2; ++i) vA[h][i] = vN[h][i]; }
            PG8_WAIT_L(8); PG8_BAR; PG8_WAIT_L(0); PG8_MMA(0, 0, At, B0); PG8_BAR; PG8_SCHED;
            PG8_LDB(B1, 0, 1); PG8_STAGE(PG8_SB(0, 0), b2, vB[0][0], vB[0][1]);
            PG8_BAR; PG8_WAIT_L(0); PG8_MMA(0, 1, At, B1); PG8_BAR;
            PG8_LDA(At, 0, 1); PG8_STAGE(PG8_SA(0, 0), a2, vA[0][0], vA[0][1]);
            PG8_BAR; PG8_WAIT_L(0); PG8_MMA(1, 0, At, B0); PG8_BAR; PG8_SCHED;
            PG8_STAGE(PG8_SB(0, 1), b2, vB[1][0], vB[1][1]);
            PG8_WAIT_V(6); PG8_BAR; PG8_MMA(1, 1, At, B1); PG8_BAR;
            PG8_LDB(B0, 1, 0); PG8_SCHED; PG8_LDA(At, 1, 0); PG8_STAGE(PG8_SA(0, 1), a2, vA[1][0], vA[1][1]);
            PG8_WAIT_L(8); PG8_BAR; PG8_WAIT_L(0); PG8_MMA(0, 0, At, B0); PG8_BAR; PG8_SCHED;
            PG8_LDB(B1, 1, 1); PG8_STAGE(PG8_SB(1, 0), b3, vB[0][0], vB[0][1]);
            PG8_BAR; PG8_WAIT_L(0); PG8_MMA(0, 1, At, B1); PG8_BAR;
            PG8_LDA(At, 1, 1); PG8_STAGE(PG8_SA(1, 0), a3, vA[0][0], vA[0][1]);
            PG8_BAR; PG8_WAIT_L(0); PG8_MMA(1, 0, At, B0); PG8_BAR; PG8_SCHED;
            PG8_STAGE(PG8_SB(1, 1), b3, vB[1][0], vB[1][1]);
            PG8_WAIT_V(6); PG8_BAR; PG8_MMA(1, 1, At, B1); PG8_BAR;
        }
        E(acc, cur, wr, wc, fr, fq);
        if (!has_next) break;
#pragma unroll
        for (int a = 0; a < 2; ++a)
#pragma unroll
            for (int b = 0; b < 2; ++b)
#pragma unroll
                for (int m = 0; m < 4; ++m)
#pragma unroll
                    for (int n = 0; n < 2; ++n) acc[a][b][m][n] = (f32x4){0.f, 0.f, 0.f, 0.f};
        cur = nxt; cA = nA; cB = nB; ++ui;
    }
    PG8_WAIT_V(0);
    if (wr == 0) PG8_BAR;
    PG8_BAR;
#undef PG8_SA
#undef PG8_SB
#undef PG8_STAGE
#undef PG8_LDA
#undef PG8_LDB
#undef PG8_MMA
#undef PG8_WAIT_V
#undef PG8_WAIT_L
#undef PG8_BAR
#undef PG8_SCHED
}
}
using pg8::Unit;

struct SchedPlain {
    static constexpr bool DYN_A = false;
    const char* A; const char* Bt; int K, nM, nN, G, c; int nt; unsigned kstepA, kstepB, ldb;
    __device__ __forceinline__ void init(const void* A_, const void* Bt_, int M, int N, int K_) { A = (const char*)A_; Bt = (const char*)Bt_; K = K_; nM = M / 256; nN = N / 256; G = gridDim.x; c = blockIdx.x; nt = K / 64; kstepA = 128; kstepB = 128; ldb = (unsigned)K * 2u; }
    __device__ __forceinline__ bool next(int i, Unit& u) const { const int L = i * G + c; if (L >= nM * nN) return false; pg8::static_unit(L, nM, nN, u); return true; }
    __device__ __forceinline__ const char* abase(const Unit& u) const { return A + (size_t)u.pm * 256 * K * 2; }
    __device__ __forceinline__ const char* bbase(const Unit& u) const { return Bt + (size_t)u.pn * 256 * K * 2; }
    __device__ __forceinline__ unsigned aoff(const Unit&, int row, int col) const { return (unsigned)(row * K + col) * 2u; }
};
struct SchedMoeGU {
    static constexpr bool DYN_A = true;
    const char* X; const char* W; const int* rowtok; const int* panel; int nM, G, c; int nt; unsigned kstepA, kstepB, ldb;
    __device__ __forceinline__ void init(const char* ws) { X = ws + WS_X1B; W = ws + WS_GU; rowtok = (const int*)(ws + WS_ROWTOK); panel = (const int*)(ws + WS_PANEL); nM = *(const int*)(ws + WS_NPAN); G = gridDim.x; c = blockIdx.x; nt = 16; kstepA = 128; kstepB = 128; ldb = 2048; }
    __device__ __forceinline__ bool next(int i, Unit& u) const { const int L = i * G + c; if (L >= nM * 4) return false; pg8::static_unit(L, nM, 4, u); u.aux = panel[u.pm]; return true; }
    __device__ __forceinline__ const char* abase(const Unit&) const { return X; }
    __device__ __forceinline__ const char* bbase(const Unit& u) const { return W + ((size_t)u.aux * 1024 + (size_t)u.pn * 256) * 2048; }
    __device__ __forceinline__ unsigned aoff(const Unit& u, int row, int col) const { return (unsigned)rowtok[u.pm * 256 + row] * 2048u + (unsigned)col * 2u; }
};
struct SchedMoeDN {
    static constexpr bool DYN_A = false;
    const char* H; const char* W; const int* panel; int nM, G, c; int nt; unsigned kstepA, kstepB, ldb;
    __device__ __forceinline__ void init(const char* ws) { H = ws + WS_AOH; W = ws + WS_DN; panel = (const int*)(ws + WS_PANEL); nM = *(const int*)(ws + WS_NPAN); G = gridDim.x; c = blockIdx.x; nt = 8; kstepA = 128; kstepB = 128; ldb = 1024; }
    __device__ __forceinline__ bool next(int i, Unit& u) const { const int L = i * G + c; if (L >= nM * 4) return false; pg8::static_unit(L, nM, 4, u); u.aux = panel[u.pm]; return true; }
    __device__ __forceinline__ const char* abase(const Unit& u) const { return H + (size_t)u.pm * 256 * 1024; }
    __device__ __forceinline__ const char* bbase(const Unit& u) const { return W + ((size_t)u.aux * 1024 + (size_t)u.pn * 256) * 1024; }
    __device__ __forceinline__ unsigned aoff(const Unit&, int row, int col) const { return (unsigned)(row * 512 + col) * 2u; }
};
struct SchedCmp {
    static constexpr bool DYN_A = false  ;
    const char* Q; const char* W; int G, c; int nt; unsigned kstepA, kstepB, ldb;
    __device__ __forceinline__ void init(const char* ws) { Q = ws + WS_BIG; W = ws + WS_W1T; G = gridDim.x; c = blockIdx.x; nt = 8; kstepA = NSA_LD * 2; kstepB = 128; ldb = 4096; }
    __device__ __forceinline__ bool next(int i, Unit& u) const { const int L = i * G + c; if (L >= 256) return false; u.aux = L >> 7; u.pm = (L >> 2) & 31; u.pn = L & 3; return true; }
    __device__ __forceinline__ const char* abase(const Unit& u) const { return Q + (size_t)(u.aux ? NSA_VC : NSA_KC) * 2 + (size_t)u.pn * 8 * (NSA_LD * 2); }
    __device__ __forceinline__ const char* bbase(const Unit& u) const { return W + (size_t)u.aux * 256 * 4096 + (size_t)u.pn * 8 * 128; }
    __device__ __forceinline__ unsigned aoff(const Unit& u, int row, int col) const {
        const int m = u.pm * 256 + row, bh = m >> 7, n = m & 127, nn = n > 126 ? 126 : n, b = bh >> 2, hkv = bh & 3;
        return (unsigned)(((b * SEQ + 16 * nn) * NSA_LD) + hkv * 64 + col) * 2u; }
};

struct EpiQKV0 {
    static constexpr bool PERM = true;
    bf16_t* O; float* kpart;
    __device__ __forceinline__ void operator()(const f32x4 (&acc)[2][2][4][2], const Unit& u, int wr, int wc, int fr, int fq) const {
        const int row0 = u.pm * 256 + wr * 64 + fr, col0 = u.pn * 256 + wc * 32 + 8 * fq;
        const float sc = (u.pn < 4) ? C2 : 1.0f;
#pragma unroll
        for (int ai = 0; ai < 2; ++ai)
#pragma unroll
            for (int m = 0; m < 4; ++m) { bf16_t* rowp = O + (size_t)(row0 + ai * 128 + m * 16) * QKV_LD + col0;
#pragma unroll
                for (int bj = 0; bj < 2; ++bj) { const f32x4 v0 = acc[ai][bj][m][0] * sc, v1 = acc[ai][bj][m][1] * sc;
                    u32x4 w; w.x = cvt_pk_bf16(v0[0], v0[1]); w.y = cvt_pk_bf16(v0[2], v0[3]); w.z = cvt_pk_bf16(v1[0], v1[1]); w.w = cvt_pk_bf16(v1[2], v1[3]);
                    *(u32x4*)(rowp + bj * 128) = w; } }
        if (u.pn >= 4 && u.pn < 8) {
#pragma unroll
            for (int bj = 0; bj < 2; ++bj)
#pragma unroll
                for (int n = 0; n < 2; ++n) { f32x4 s = (f32x4){0.f, 0.f, 0.f, 0.f};
#pragma unroll
                    for (int ai = 0; ai < 2; ++ai)
#pragma unroll
                        for (int m = 0; m < 4; ++m) s += acc[ai][bj][m][n];
#pragma unroll
                    for (int j = 0; j < 4; ++j) { float v = s[j]; v += __shfl_xor(v, 1); v += __shfl_xor(v, 2); v += __shfl_xor(v, 4); v += __shfl_xor(v, 8); s[j] = v; }
                    if (fr == 0) *(f32x4*)(kpart + ((size_t)u.pm * 2 + wr) * 1024 + (u.pn - 4) * 256 + bj * 128 + wc * 32 + 8 * fq + 4 * n) = s; }
        }
    }
};
struct EpiNSA {
    static constexpr bool PERM = true;
    bf16_t* O;
    __device__ __forceinline__ void operator()(const f32x4 (&acc)[2][2][4][2], const Unit& u, int wr, int wc, int fr, int fq) const {
        const int row0 = u.pm * 256 + wr * 64 + fr, col0 = u.pn * 256 + wc * 32 + 8 * fq;
        const float sc = (u.pn < 4) ? C2 : 1.0f; const bool sg = (u.pn == 10);
#pragma unroll
        for (int ai = 0; ai < 2; ++ai)
#pragma unroll
            for (int m = 0; m < 4; ++m) { bf16_t* rowp = O + (size_t)(row0 + ai * 128 + m * 16) * NSA_LD + col0;
#pragma unroll
                for (int bj = 0; bj < 2; ++bj) { f32x4 v0 = acc[ai][bj][m][0] * sc, v1 = acc[ai][bj][m][1] * sc;
                    if (sg) {
#pragma unroll
                        for (int j = 0; j < 4; ++j) { v0[j] = 1.0f / (1.0f + __expf(-v0[j])); v1[j] = 1.0f / (1.0f + __expf(-v1[j])); } }
                    u32x4 w; w.x = cvt_pk_bf16(v0[0], v0[1]); w.y = cvt_pk_bf16(v0[2], v0[3]); w.z = cvt_pk_bf16(v1[0], v1[1]); w.w = cvt_pk_bf16(v1[2], v1[3]);
                    *(u32x4*)(rowp + bj * 128) = w; } }
    }
};
template <bool RES_F32> struct EpiRes {
    static constexpr bool PERM = true;
    bf16_t* O; const float* rf; const bf16_t* rb;
    __device__ __forceinline__ void operator()(const f32x4 (&acc)[2][2][4][2], const Unit& u, int wr, int wc, int fr, int fq) const {
        const int row0 = u.pm * 256 + wr * 64 + fr, col0 = u.pn * 256 + wc * 32 + 8 * fq;
#pragma unroll
        for (int ai = 0; ai < 2; ++ai)
#pragma unroll
            for (int m = 0; m < 4; ++m) { const size_t ro = (size_t)(row0 + ai * 128 + m * 16) * 1024 + col0;
#pragma unroll
                for (int bj = 0; bj < 2; ++bj) { f32x4 r0, r1;
                    if (RES_F32) { r0 = *(const f32x4*)(rf + ro + bj * 128); r1 = *(const f32x4*)(rf + ro + bj * 128 + 4); }
                    else { const u32x4 rw = *(const u32x4*)(rb + ro + bj * 128); r0 = (f32x4){lo_bf(rw.x), hi_bf(rw.x), lo_bf(rw.y), hi_bf(rw.y)}; r1 = (f32x4){lo_bf(rw.z), hi_bf(rw.z), lo_bf(rw.w), hi_bf(rw.w)}; }
                    const f32x4 v0 = acc[ai][bj][m][0] + r0 * ALPHA, v1 = acc[ai][bj][m][1] + r1 * ALPHA;
                    u32x4 w; w.x = cvt_pk_bf16(v0[0], v0[1]); w.y = cvt_pk_bf16(v0[2], v0[3]); w.z = cvt_pk_bf16(v1[0], v1[1]); w.w = cvt_pk_bf16(v1[2], v1[3]);
                    *(u32x4*)(O + ro + bj * 128) = w; } }
    }
};
struct EpiGU {
    static constexpr bool PERM = true;
    bf16_t* O;
    __device__ __forceinline__ void operator()(const f32x4 (&acc)[2][2][4][2], const Unit& u, int wr, int wc, int fr, int fq) const {
        const int row0 = u.pm * 256 + wr * 64 + fr, col0 = u.pn * 128 + wc * 32 + 8 * fq;
#pragma unroll
        for (int ai = 0; ai < 2; ++ai)
#pragma unroll
            for (int m = 0; m < 4; ++m) { float h[8];
#pragma unroll
                for (int n = 0; n < 2; ++n)
#pragma unroll
                    for (int j = 0; j < 4; ++j) { const float g = acc[ai][0][m][n][j], up = acc[ai][1][m][n][j]; h[n * 4 + j] = g * up / (1.0f + __expf(-g)); }
                u32x4 w; w.x = cvt_pk_bf16(h[0], h[1]); w.y = cvt_pk_bf16(h[2], h[3]); w.z = cvt_pk_bf16(h[4], h[5]); w.w = cvt_pk_bf16(h[6], h[7]);
                *(u32x4*)(O + (size_t)(row0 + ai * 128 + m * 16) * 512 + col0) = w; }
    }
};
struct EpiDN {
    static constexpr bool PERM = true;
    bf16_t* O;
    __device__ __forceinline__ void operator()(const f32x4 (&acc)[2][2][4][2], const Unit& u, int wr, int wc, int fr, int fq) const {
        const int row0 = u.pm * 256 + wr * 64 + fr, col0 = u.pn * 256 + wc * 32 + 8 * fq;
#pragma unroll
        for (int ai = 0; ai < 2; ++ai)
#pragma unroll
            for (int m = 0; m < 4; ++m) { bf16_t* rowp = O + (size_t)(row0 + ai * 128 + m * 16) * 1024 + col0;
#pragma unroll
                for (int bj = 0; bj < 2; ++bj) { const f32x4 v0 = acc[ai][bj][m][0], v1 = acc[ai][bj][m][1];
                    u32x4 w; w.x = cvt_pk_bf16(v0[0], v0[1]); w.y = cvt_pk_bf16(v0[2], v0[3]); w.z = cvt_pk_bf16(v1[0], v1[1]); w.w = cvt_pk_bf16(v1[2], v1[3]);
                    *(u32x4*)(rowp + bj * 128) = w; } }
    }
};
struct EpiCmp {
    static constexpr bool PERM = false;
    float* CP;
    __device__ __forceinline__ void operator()(const f32x4 (&acc)[2][2][4][2], const Unit& u, int wr, int wc, int fr, int fq) const {
        float* base = CP + ((size_t)(u.aux * 4 + u.pn) * 8192 + (size_t)u.pm * 256) * 256;
        const int row0 = wr * 64 + fr, col0 = wc * 32 + 4 * fq;
#pragma unroll
        for (int ai = 0; ai < 2; ++ai)
#pragma unroll
            for (int m = 0; m < 4; ++m) { float* rowp = base + (size_t)(row0 + ai * 128 + m * 16) * 256 + col0;
#pragma unroll
                for (int bj = 0; bj < 2; ++bj)
#pragma unroll
                    for (int n = 0; n < 2; ++n) *(f32x4*)(rowp + bj * 128 + n * 16) = acc[ai][bj][m][n]; }
    }
};

constexpr int AL_K = 0, AL_V = 16384, AL_BIAS = 32768, AL_KM = AL_BIAS + 16 * BT_N * 4  , AL_IMP = AL_KM + 2048  , AL_SEL = AL_IMP + 4 * 64 * 33 * 4  , AL_END = AL_SEL + 512;
#define MFMA32(a, b, c) __builtin_amdgcn_mfma_f32_32x32x16_bf16(a, b, c, 0, 0, 0)
__device__ __forceinline__ s16x4 vtr(lds_cptr p) { return __builtin_bit_cast(s16x4, __builtin_amdgcn_ds_read_tr16_b64_v4i16((LAS v4i16_t*)p)); }
__device__ __forceinline__ float xhalf_max(float m) { auto rr = __builtin_amdgcn_permlane32_swap(__float_as_uint(m), __float_as_uint(m), false, false); return __builtin_fmaxf(__uint_as_float(rr[0]), __uint_as_float(rr[1])); }
__device__ __forceinline__ float xhalf_sum(float m) { auto rr = __builtin_amdgcn_permlane32_swap(__float_as_uint(m), __float_as_uint(m), false, false); return __uint_as_float(rr[0]) + __uint_as_float(rr[1]); }
__device__ __forceinline__ float max16(const f32x16& p) { float a = __builtin_fmaxf(p[0], p[1]), b = __builtin_fmaxf(p[2], p[3]);
#pragma unroll
    for (int r = 4; r < 16; r += 4) { a = __builtin_fmaxf(a, __builtin_fmaxf(p[r], p[r + 1])); b = __builtin_fmaxf(b, __builtin_fmaxf(p[r + 2], p[r + 3])); }
    return __builtin_fmaxf(a, b); }

__device__ __forceinline__ void dma_k(const bf16_t* src, int ld, LAS unsigned char* lds, int slot, int wid, int lane) {
    __builtin_amdgcn_global_load_lds((const unsigned*)(src + (size_t)lane * ld + wid * 8), (LAS unsigned*)(lds + AL_K + slot * 8192 + wid * 1024), 16, 0, 0); }
__device__ __forceinline__ void dma_v(const bf16_t* src, int ld, LAS unsigned char* lds, int slot, int wid, int lane) {
    __builtin_amdgcn_global_load_lds((const unsigned*)(src + (size_t)(16 * (wid & 3) + (lane >> 2)) * ld + (wid >> 2) * 32 + (lane & 3) * 8), (LAS unsigned*)(lds + AL_V + slot * 8192 + wid * 1024), 16, 0, 0); }

struct FState { float m, l; f32x16 o0, o1; };
__device__ __forceinline__ void fstate_reset(FState& s) { s.m = -1e30f; s.l = 0.f;
#pragma unroll
    for (int r = 0; r < 16; ++r) { s.o0[r] = 0.f; s.o1[r] = 0.f; } }

__device__ __forceinline__ void qk_tile(f32x16& c0, f32x16& c1, const bf16x8 (&qr)[4], lds_cptr kp) {
#pragma unroll
    for (int d0 = 0; d0 < 4; ++d0) { const bf16x8 k0 = *(const LAS bf16x8*)(kp + d0 * 2048), k1 = *(const LAS bf16x8*)(kp + d0 * 2048 + 512);
        c0 = MFMA32(k0, qr[d0], c0); c1 = MFMA32(k1, qr[d0], c1); }
}
__device__ __forceinline__ void pv_tile(f32x16& o0, f32x16& o1, const f32x16& p0, const f32x16& p1, lds_cptr vp) {
    u32x4 pw[4];
#pragma unroll
    for (int k = 0; k < 2; ++k) { pw[k] = (u32x4){cvt_pk_bf16(p0[8 * k], p0[8 * k + 1]), cvt_pk_bf16(p0[8 * k + 2], p0[8 * k + 3]), cvt_pk_bf16(p0[8 * k + 4], p0[8 * k + 5]), cvt_pk_bf16(p0[8 * k + 6], p0[8 * k + 7])};
        pw[2 + k] = (u32x4){cvt_pk_bf16(p1[8 * k], p1[8 * k + 1]), cvt_pk_bf16(p1[8 * k + 2], p1[8 * k + 3]), cvt_pk_bf16(p1[8 * k + 4], p1[8 * k + 5]), cvt_pk_bf16(p1[8 * k + 6], p1[8 * k + 7])}; }
#pragma unroll
    for (int i = 0; i < 8; ++i) { const s16x4 lo = vtr(vp + ((i >> 2) * 4096 + (i & 3) * 1024)), hi = vtr(vp + ((i >> 2) * 4096 + (i & 3) * 1024 + 512));
        const bf16x8 vf = (bf16x8){lo[0], lo[1], lo[2], lo[3], hi[0], hi[1], hi[2], hi[3]};
        const bf16x8 pf = __builtin_bit_cast(bf16x8, pw[i & 3]);
        if (i < 4) o0 = MFMA32(vf, pf, o0); else o1 = MFMA32(vf, pf, o1); }
}
template <bool WIN>
__device__ __forceinline__ void flash_tile(FState& st, const bf16x8 (&qr)[4], lds_cptr kp, lds_cptr vp, const LAS float* btab, float cfar, int Dmin, int r32, int hi, bool rowok) {
    const int Dl = Dmin + r32 - 4 * hi;
    f32x16 c0, c1;
    if (Dmin - 63 < 127) {
        const LAS float* bp = btab + Dl;
#pragma unroll
        for (int r = 0; r < 16; ++r) { const int ko = (r & 3) + 8 * (r >> 2); c0[r] = bp[63 - ko]; c1[r] = bp[31 - ko]; }
    } else {
#pragma unroll
        for (int r = 0; r < 16; ++r) { c0[r] = cfar; c1[r] = cfar; }
    }
    const float pen = rowok ? 0.f : -INFINITY;
#pragma unroll
    for (int r = 0; r < 16; ++r) { c0[r] += pen; c1[r] += pen; }
    qk_tile(c0, c1, qr, kp);
    if (Dmin < 63) {
#pragma unroll
        for (int r = 0; r < 16; ++r) { const int ko = (r & 3) + 8 * (r >> 2); if (Dl - ko < 0) c0[r] = -INFINITY; if (Dl - 32 - ko < 0) c1[r] = -INFINITY; }
    }
    if (WIN && (Dmin + 31 >= 512)) {
#pragma unroll
        for (int r = 0; r < 16; ++r) { const int ko = (r & 3) + 8 * (r >> 2); if (Dl - ko >= 512) c0[r] = -INFINITY; if (Dl - 32 - ko >= 512) c1[r] = -INFINITY; }
    }
    const float mx = xhalf_max(__builtin_fmaxf(max16(c0), max16(c1)));
    const float mn = __builtin_fmaxf(st.m, mx);
    const float alpha = __builtin_amdgcn_exp2f(st.m - mn);
    st.m = mn;
    float rs = 0.f;
#pragma unroll
    for (int r = 0; r < 16; ++r) { c0[r] = __builtin_amdgcn_exp2f(c0[r] - mn); c1[r] = __builtin_amdgcn_exp2f(c1[r] - mn); rs += c0[r] + c1[r]; }
    st.l = st.l * alpha + rs;
#pragma unroll
    for (int r = 0; r < 16; ++r) { st.o0[r] *= alpha; st.o1[r] *= alpha; }
    pv_tile(st.o0, st.o1, c0, c1, vp);
}

__device__ __forceinline__ void conv_tile(const float* src, int N, bf16_t* dst, int ldd, int k0, int n0, int rowadd, int mode, LAS float* t, int lane) {
    float4 v[16];
#pragma unroll
    for (int i = 0; i < 16; ++i) { const int r = i * 4 + (lane >> 4), cc = n0 + (lane & 15) * 4;
        v[i] = (cc < N) ? *(const float4*)(src + (size_t)(k0 + r) * N + cc) : make_float4(0.f, 0.f, 0.f, 0.f); }
#pragma unroll
    for (int i = 0; i < 16; ++i) { const int r = i * 4 + (lane >> 4), cc = (lane & 15) * 4; LAS float* q = t + r * 65 + cc; q[0] = v[i].x; q[1] = v[i].y; q[2] = v[i].z; q[3] = v[i].w; }
    asm volatile("s_waitcnt lgkmcnt(0)" ::: "memory");
#pragma unroll
    for (int i = 0; i < 8; ++i) { const int nr = i * 8 + (lane >> 3), kc = (lane & 7) * 8; float f[8];
#pragma unroll
        for (int j = 0; j < 8; ++j) f[j] = t[(kc + j) * 65 + nr];
        const int n = n0 + nr; const int drow = (mode == 0) ? n : (256 * (n >> 7) + (n & 127) + rowadd);
        u32x4 w; w.x = cvt_pk_bf16(f[0], f[1]); w.y = cvt_pk_bf16(f[2], f[3]); w.z = cvt_pk_bf16(f[4], f[5]); w.w = cvt_pk_bf16(f[6], f[7]);
        *(u32x4*)(dst + (size_t)drow * ldd + k0 + kc) = w; }
    asm volatile("s_waitcnt lgkmcnt(0)" ::: "memory");
}
__device__ __forceinline__ int conv_job(const float* src, int K, int N, int Npad, bf16_t* dst, int ldd, int rowadd, int mode, int tile0, LAS float* t, int gw, int ngw, int lane) {
    const int nkt = K / 64, nnt = Npad / 64, ntile = nkt * nnt;
    int first = (gw - tile0 % ngw + ngw) % ngw;
    for (int i = first; i < ntile; i += ngw) conv_tile(src, N, dst, ldd, (i / nnt) * 64, (i % nnt) * 64, rowadd, mode, t, lane);
    return tile0 + ntile;
}
__device__ __forceinline__ void conv_moe_layer(const Params& p, int layer, LAS unsigned char* lds) {
    const int tid = otid(), lane = tid & 63, wid = tid >> 6, gw = blockIdx.x * 8 + wid, ngw = gridDim.x * 8;
    LAS float* t = (LAS float*)(lds + wid * (64 * 65 * 4));
    bf16_t* GU = (bf16_t*)(p.ws + WS_GU); bf16_t* DN = (bf16_t*)(p.ws + WS_DN);
    int tile0 = 0;
    for (int e = 0; e < NEXP; ++e) {
        const size_t wo = ((size_t)layer * NEXP + e) * 1024 * 512;
        tile0 = conv_job(p.w_gate + wo, 1024, 512, 512, GU + (size_t)e * 1024 * 1024, 1024, 0, 1, tile0, t, gw, ngw, lane);
        tile0 = conv_job(p.w_up + wo, 1024, 512, 512, GU + (size_t)e * 1024 * 1024, 1024, 128, 1, tile0, t, gw, ngw, lane);
        tile0 = conv_job(p.w_down + wo, 512, 1024, 1024, DN + (size_t)e * 1024 * 512, 512, 0, 0, tile0, t, gw, ngw, lane);
    }
}
__device__ __forceinline__ void phase_prologue(const Params& p, LAS unsigned char* lds) {
    const int tid = otid(), lane = tid & 63, wid = tid >> 6, gw = blockIdx.x * 8 + wid, ngw = gridDim.x * 8;
    LAS float* t = (LAS float*)(lds + wid * (64 * 65 * 4));
    char* ws = p.ws;
    { const size_t n8 = (size_t)NTOK * 1024 / 8; bf16_t* xb = (bf16_t*)(ws + WS_XB);
      for (size_t i = (size_t)blockIdx.x * NTHREADS + tid; i < n8; i += (size_t)gridDim.x * NTHREADS) {
          const float4 a = *(const float4*)(p.x + i * 8), b = *(const float4*)(p.x + i * 8 + 4);
          u32x4 w; w.x = cvt_pk_bf16(a.x, a.y); w.y = cvt_pk_bf16(a.z, a.w); w.z = cvt_pk_bf16(b.x, b.y); w.w = cvt_pk_bf16(b.z, b.w);
          *(u32x4*)(xb + i * 8) = w; } }
    int tile0 = 0;
    tile0 = conv_job(p.moba_w_in, 1024, 3072, 3072, (bf16_t*)(ws + WS_WQKV0), 1024, 0, 0, tile0, t, gw, ngw, lane);
    tile0 = conv_job(p.moba_w_out, 1024, 1024, 1024, (bf16_t*)(ws + WS_WO0), 1024, 0, 0, tile0, t, gw, ngw, lane);
    tile0 = conv_job(p.nsa_w_in, 1024, 2608, 2816, (bf16_t*)(ws + WS_WIN1), 1024, 0, 0, tile0, t, gw, ngw, lane);
    tile0 = conv_job(p.nsa_w_out, 1024, 1024, 1024, (bf16_t*)(ws + WS_WO1), 1024, 0, 0, tile0, t, gw, ngw, lane);
    tile0 = conv_job(p.ck_w1, 2048, 256, 256, (bf16_t*)(ws + WS_W1T), 2048, 0, 0, tile0, t, gw, ngw, lane);
    tile0 = conv_job(p.cv_w1, 2048, 256, 256, (bf16_t*)(ws + WS_W1T) + 256 * 2048, 2048, 0, 0, tile0, t, gw, ngw, lane);
    conv_moe_layer(p, 0, lds);
    for (int i = blockIdx.x * NTHREADS + tid; i < 16 * BT_N; i += gridDim.x * NTHREADS) {
        const int h = i / BT_N, e = i % BT_N; int n = e - 63; n = n < 0 ? 0 : (n > 127 ? 127 : n);
        int bk = n;
        if (n >= 16) { bk = 16 + (int)(logf((float)n / 16.0f) / logf(8.0f) * 16.0f); bk = bk > 31 ? 31 : bk; }
        ((float*)(ws + WS_TAB))[i] = p.rel_bias[bk * 16 + h] * LOG2E; }
    if (blockIdx.x < 2 && tid < 256) { const float* pos = blockIdx.x ? p.pos_v : p.pos_k; const float* w1 = blockIdx.x ? p.cv_w1 : p.ck_w1; float s = 0.f;
        for (int k = 0; k < 2048; ++k) s += pos[k] * w1[(size_t)k * 256 + tid];
        ((float*)(ws + WS_B1))[blockIdx.x * 256 + tid] = s; }
}

__device__ __forceinline__ void moba_unit(const Params& p, LAS unsigned char* lds, int b, int h, int qb) {
    const int tid = otid(), lane = tid & 63, r32 = lane & 31, hi = lane >> 5; const int wid = __builtin_amdgcn_readfirstlane(tid >> 6);
    const bf16_t* QKV = (const bf16_t*)(p.ws + WS_BIG);
    const size_t rowbase = (size_t)b * SEQ; const int q0 = qb * 256, qw = q0 + wid * 32;
    const bf16_t* Kb = QKV + rowbase * QKV_LD + 1024 + h * 64; const bf16_t* Vb = QKV + rowbase * QKV_LD + 2048 + h * 64;
    bf16x8 qr[4];
    { const bf16_t* qp = QKV + (rowbase + qw + r32) * QKV_LD + h * 64 + hi * 8;
#pragma unroll
      for (int d0 = 0; d0 < 4; ++d0) qr[d0] = *(const bf16x8*)(qp + d0 * 16); }
    __syncthreads();
    { const float* kp = (const float*)(p.ws + WS_KPART); const int j = tid >> 6, d = tid & 63;
      const float* s = kp + ((size_t)(b * 8 + j) * 2) * 1024 + h * 64 + d;
      ((LAS float*)(lds + AL_KM))[tid] = s[0] + s[1024];
      if (tid < BT_N) ((LAS float*)(lds + AL_BIAS))[tid] = ((const float*)(p.ws + WS_TAB))[h * BT_N + tid]; }
    const int NT = 4 + 4 * qb;
    dma_k(Kb + (size_t)(q0) * QKV_LD, QKV_LD, lds, 0, wid, lane); dma_v(Vb + (size_t)(q0) * QKV_LD, QKV_LD, lds, 0, wid, lane);
    __syncthreads();
    unsigned sel = 0;
    { float g[8];
#pragma unroll
      for (int j = 0; j < 8; ++j) { float s = 0.f; const LAS float* km = (const LAS float*)(lds + AL_KM) + j * 64 + hi * 8;
#pragma unroll
          for (int d0 = 0; d0 < 4; ++d0)
#pragma unroll
              for (int i = 0; i < 8; ++i) s += bf2f((bf16_t)qr[d0][i]) * km[d0 * 16 + i];
          g[j] = xhalf_sum(s); }
#pragma unroll
      for (int round = 0; round < 3; ++round) { int best = -1; float bv = 0.f;
#pragma unroll
          for (int j = 0; j < 8; ++j) { const bool ok = (j < qb) && !((sel >> j) & 1u) && (best < 0 || g[j] > bv); if (ok) { best = j; bv = g[j]; } }
          if (best >= 0) sel |= 1u << best; } }
    const LAS float* btab = (const LAS float*)(lds + AL_BIAS); const float cfar = btab[BT_N - 1];
    FState st; fstate_reset(st);
    const lds_cptr kp0 = (lds_cptr)lds + AL_K + hi * 1024 + r32 * 16;
    const lds_cptr vp0 = (lds_cptr)lds + AL_V + ((lane >> 4) & 1) * 32 + (lane & 3) * 8 + (4 * hi + ((lane & 15) >> 2)) * 64;
    for (int t = 0; t < NT; ++t) {
        asm volatile("s_waitcnt vmcnt(0)" ::: "memory");
        __syncthreads();
        if (t + 1 < NT) { const int t1 = t + 1; const int blk = t1 < 4 ? qb : qb - 1 - ((t1 - 4) >> 2), kt = t1 < 4 ? t1 : ((t1 - 4) & 3); const size_t key0 = (size_t)blk * 256 + kt * 64;
            dma_k(Kb + key0 * QKV_LD, QKV_LD, lds, t1 & 1, wid, lane); dma_v(Vb + key0 * QKV_LD, QKV_LD, lds, t1 & 1, wid, lane); }
        const int blk = t < 4 ? qb : qb - 1 - ((t - 4) >> 2), kt = t < 4 ? t : ((t - 4) & 3); const int key0 = blk * 256 + kt * 64;
        bool rowok = true, run = true;
        if (blk == qb) run = (64 * kt <= wid * 32 + 31);
        else { rowok = (sel >> blk) & 1u; run = __any(rowok); }
        if (run) flash_tile<false>(st, qr, kp0 + (t & 1) * 8192, vp0 + (t & 1) * 8192, btab, cfar, qw - key0, r32, hi, rowok);
    }
    const float inv = 1.0f / xhalf_sum(st.l);
    bf16_t* op = (bf16_t*)(p.ws + WS_AOH) + (rowbase + qw + r32) * 1024 + h * 64 + 4 * hi;
#pragma unroll
    for (int g4 = 0; g4 < 4; ++g4) {
        u32x2 w0, w1; w0.x = cvt_pk_bf16(st.o0[4 * g4] * inv, st.o0[4 * g4 + 1] * inv); w0.y = cvt_pk_bf16(st.o0[4 * g4 + 2] * inv, st.o0[4 * g4 + 3] * inv);
        w1.x = cvt_pk_bf16(st.o1[4 * g4] * inv, st.o1[4 * g4 + 1] * inv); w1.y = cvt_pk_bf16(st.o1[4 * g4 + 2] * inv, st.o1[4 * g4 + 3] * inv);
        *(u32x2*)(op + 8 * g4) = w0; *(u32x2*)(op + 32 + 8 * g4) = w1; }
}
__device__ __forceinline__ void phase_moba(const Params& p, LAS unsigned char* lds) {
    for (int pr = blockIdx.x; pr < 1024; pr += gridDim.x) { const int bh = pr >> 2, j = pr & 3;
        moba_unit(p, lds, bh >> 4, bh & 15, 7 - j);
        moba_unit(p, lds, bh >> 4, bh & 15, j); }
    __syncthreads();
}

__device__ __forceinline__ void nsa_unit(const Params& p, LAS unsigned char* lds, int b, int hkv, int c) {
    const int tid = otid(), lane = tid & 63, r32 = lane & 31, hi = lane >> 5; const int wid = __builtin_amdgcn_readfirstlane(tid >> 6);
    const bf16_t* P = (const bf16_t*)(p.ws + WS_BIG);
    const size_t rowbase = (size_t)b * SEQ; const int g = wid >> 1, qq0 = (wid & 1) * 32, h = hkv * 4 + g, qw = c * 64 + qq0, qpos = qw + r32;
    bf16x8 qr[4];
    const bf16_t* rowp = P + (rowbase + qpos) * NSA_LD;
#pragma unroll
    for (int d0 = 0; d0 < 4; ++d0) qr[d0] = *(const bf16x8*)(rowp + h * 64 + hi * 8 + d0 * 16);
    const float g0 = bf2f(rowp[NSA_G + h * 3]), g1 = bf2f(rowp[NSA_G + h * 3 + 1]), g2 = bf2f(rowp[NSA_G + h * 3 + 2]);
    __syncthreads();
    for (int i = tid; i < 4 * BT_N; i += NTHREADS) ((LAS float*)(lds + AL_BIAS))[i] = ((const float*)(p.ws + WS_TAB))[hkv * 4 * BT_N + i];
    if (tid < 64) ((LAS unsigned*)(lds + AL_SEL))[tid] = 0u;
    { const bf16_t* kc = (const bf16_t*)(p.ws + WS_KCMP) + (size_t)(b * 4 + hkv) * 128 * 64; const bf16_t* vc = (const bf16_t*)(p.ws + WS_VCMP) + (size_t)(b * 4 + hkv) * 128 * 64;
      dma_k(kc, 64, lds, 0, wid, lane); dma_k(kc + 64 * 64, 64, lds, 1, wid, lane); dma_v(vc, 64, lds, 0, wid, lane); dma_v(vc + 64 * 64, 64, lds, 1, wid, lane); }
    asm volatile("s_waitcnt vmcnt(0)" ::: "memory");
    __syncthreads();
    const lds_cptr kp0 = (lds_cptr)lds + AL_K + hi * 1024 + r32 * 16;
    const lds_cptr vp0 = (lds_cptr)lds + AL_V + ((lane >> 4) & 1) * 32 + (lane & 3) * 8 + (4 * hi + ((lane & 15) >> 2)) * 64;
    f32x16 cb0, cb1;
    {
        f32x16 s[2][2];
        const int nlim = (qpos >= 31 ? ((qpos - 31) >> 4) + 1 : 0) - 4 * hi;
#pragma unroll
        for (int t = 0; t < 2; ++t) {
#pragma unroll
            for (int r = 0; r < 16; ++r) { s[t][0][r] = 0.f; s[t][1][r] = 0.f; }
            qk_tile(s[t][0], s[t][1], qr, kp0 + t * 8192);
#pragma unroll
            for (int n2 = 0; n2 < 2; ++n2)
#pragma unroll
                for (int r = 0; r < 16; ++r) { const int nk = 64 * t + 32 * n2 + (r & 3) + 8 * (r >> 2); if (nk >= nlim) s[t][n2][r] = -INFINITY; }
        }
        const float mx = xhalf_max(__builtin_fmaxf(__builtin_fmaxf(max16(s[0][0]), max16(s[0][1])), __builtin_fmaxf(max16(s[1][0]), max16(s[1][1]))));
        const float mref = (mx == -INFINITY) ? 0.f : mx;
        float rs = 0.f;
#pragma unroll
        for (int t = 0; t < 2; ++t)
#pragma unroll
            for (int n2 = 0; n2 < 2; ++n2)
#pragma unroll
                for (int r = 0; r < 16; ++r) { const float e = __builtin_amdgcn_exp2f(s[t][n2][r] - mref); s[t][n2][r] = e; rs += e; }
        const float lt = xhalf_sum(rs); const float inv = lt > 0.f ? 1.0f / lt : 0.f;
#pragma unroll
        for (int t = 0; t < 2; ++t)
#pragma unroll
            for (int n2 = 0; n2 < 2; ++n2)
#pragma unroll
                for (int r = 0; r < 16; ++r) s[t][n2][r] *= inv;
        float Q[16], T[16];
#pragma unroll
        for (int t = 0; t < 2; ++t)
#pragma unroll
            for (int n2 = 0; n2 < 2; ++n2)
#pragma unroll
                for (int r4 = 0; r4 < 4; ++r4) { const int u = 8 * t + 4 * n2 + r4; Q[u] = (s[t][n2][4 * r4] + s[t][n2][4 * r4 + 1]) + (s[t][n2][4 * r4 + 2] + s[t][n2][4 * r4 + 3]); T[u] = s[t][n2][4 * r4 + 3]; }
        LAS float* imp = (LAS float*)(lds + AL_IMP) + (g * 64 + qq0 + r32) * 33;
        float prev = 0.f;
#pragma unroll
        for (int u = 0; u < 16; ++u) { const float rcv = __shfl_xor(T[u], 32); const float add = hi ? rcv : prev; prev = rcv; imp[2 * u + hi] = Q[u] + add; }
        f32x16 o0, o1;
#pragma unroll
        for (int r = 0; r < 16; ++r) { o0[r] = 0.f; o1[r] = 0.f; }
        pv_tile(o0, o1, s[0][0], s[0][1], vp0); pv_tile(o0, o1, s[1][0], s[1][1], vp0 + 8192);
#pragma unroll
        for (int r = 0; r < 16; ++r) { cb0[r] = g0 * o0[r]; cb1[r] = g0 * o1[r]; }
    }
    __syncthreads();
    {
        const int q = tid >> 3, jg = tid & 7; const LAS float* ib = (const LAS float*)(lds + AL_IMP) + q * 33;
        float val[32];
#pragma unroll
        for (int j = 0; j < 32; ++j) { float v = (ib[j] + ib[64 * 33 + j]) + (ib[2 * 64 * 33 + j] + ib[3 * 64 * 33 + j]);
            const bool forced = (j == 0) || (j == c) || (j == c - 1); v = forced ? INFINITY : v; val[j] = (j > c) ? -INFINITY : v; }
        unsigned bits = 0;
#pragma unroll
        for (int i = 0; i < 4; ++i) { const int j = jg * 4 + i; float vj = 0.f;
#pragma unroll
            for (int jj = 0; jj < 32; ++jj) vj = (jj == j) ? val[jj] : vj;
            int rank = 0;
#pragma unroll
            for (int jj = 0; jj < 32; ++jj) rank += (val[jj] > vj || (val[jj] == vj && jj < j)) ? 1 : 0;
            if (j <= c && rank < 16) bits |= 1u << j; }
        if (bits) atomicOr((unsigned*)(lds + AL_SEL) + q, bits);
    }
    __syncthreads();
    unsigned uni = ((const LAS unsigned*)(lds + AL_SEL))[lane];
#pragma unroll
    for (int o = 32; o > 0; o >>= 1) uni |= (unsigned)__shfl_xor((int)uni, o);
    uni = (unsigned)__builtin_amdgcn_readfirstlane((int)uni);
    const unsigned rowmask = ((const LAS unsigned*)(lds + AL_SEL))[qq0 + r32];
    const LAS float* btab = (const LAS float*)(lds + AL_BIAS) + g * BT_N; const float cfar = btab[BT_N - 1];
    const int nslc = __builtin_popcount(uni); const int wlo = c >= 8 ? 0 : 8 - c; const int NT = nslc + (9 - wlo);
    const bf16_t* KS = P + rowbase * NSA_LD + NSA_KS + hkv * 64; const bf16_t* VS = P + rowbase * NSA_LD + NSA_VS + hkv * 64;
    const bf16_t* KW = P + rowbase * NSA_LD + NSA_KW + hkv * 64; const bf16_t* VW = P + rowbase * NSA_LD + NSA_VW + hkv * 64;
    unsigned remd = uni;
    { const int j = __builtin_ctz(remd); remd &= remd - 1; dma_k(KS + (size_t)j * 64 * NSA_LD, NSA_LD, lds, 0, wid, lane); dma_v(VS + (size_t)j * 64 * NSA_LD, NSA_LD, lds, 0, wid, lane); }
    unsigned remc = uni;
    FState st; fstate_reset(st);
    for (int t = 0; t < NT; ++t) {
        asm volatile("s_waitcnt vmcnt(0)" ::: "memory");
        __syncthreads();
        if (t + 1 < NT) { const int t1 = t + 1;
            if (t1 < nslc) { const int j = __builtin_ctz(remd); remd &= remd - 1; dma_k(KS + (size_t)j * 64 * NSA_LD, NSA_LD, lds, t1 & 1, wid, lane); dma_v(VS + (size_t)j * 64 * NSA_LD, NSA_LD, lds, t1 & 1, wid, lane); }
            else { const int kb = c - 8 + wlo + (t1 - nslc); dma_k(KW + (size_t)kb * 64 * NSA_LD, NSA_LD, lds, t1 & 1, wid, lane); dma_v(VW + (size_t)kb * 64 * NSA_LD, NSA_LD, lds, t1 & 1, wid, lane); } }
        if (t < nslc) {
            const int j = __builtin_ctz(remc); remc &= remc - 1;
            const bool rowok = (rowmask >> j) & 1u;
            if (__any(rowok)) flash_tile<false>(st, qr, kp0 + (t & 1) * 8192, vp0 + (t & 1) * 8192, btab, cfar, qw - 64 * j, r32, hi, rowok);
            if (t == nslc - 1) { const float f = g1 / xhalf_sum(st.l);
#pragma unroll
                for (int r = 0; r < 16; ++r) { cb0[r] += f * st.o0[r]; cb1[r] += f * st.o1[r]; }
                fstate_reset(st); }
        } else {
            const int kb = c - 8 + wlo + (t - nslc);
            flash_tile<true>(st, qr, kp0 + (t & 1) * 8192, vp0 + (t & 1) * 8192, btab, cfar, qw - 64 * kb, r32, hi, true);
        }
    }
    { const float f = g2 / xhalf_sum(st.l);
#pragma unroll
      for (int r = 0; r < 16; ++r) { cb0[r] += f * st.o0[r]; cb1[r] += f * st.o1[r]; } }
    bf16_t* op = (bf16_t*)(p.ws + WS_AOH) + (rowbase + qpos) * 1024 + h * 64 + 4 * hi;
#pragma unroll
    for (int g4 = 0; g4 < 4; ++g4) {
        u32x2 w0, w1; w0.x = cvt_pk_bf16(cb0[4 * g4], cb0[4 * g4 + 1]); w0.y = cvt_pk_bf16(cb0[4 * g4 + 2], cb0[4 * g4 + 3]);
        w1.x = cvt_pk_bf16(cb1[4 * g4], cb1[4 * g4 + 1]); w1.y = cvt_pk_bf16(cb1[4 * g4 + 2], cb1[4 * g4 + 3]);
        *(u32x2*)(op + 8 * g4) = w0; *(u32x2*)(op + 32 + 8 * g4) = w1; }
}
__device__ __forceinline__ void phase_nsa(const Params& p, LAS unsigned char* lds) {
    for (int pr = blockIdx.x; pr < 1024; pr += gridDim.x) { const int bh = pr >> 4, j = pr & 15;
        nsa_unit(p, lds, bh >> 2, bh & 3, 31 - j);
        nsa_unit(p, lds, bh >> 2, bh & 3, j); }
    __syncthreads();
}

template <int L> __device__ __forceinline__ void phase_ln1(const Params& p, LAS unsigned char* lds) {
    const int tid = otid(), lane = tid & 63, wid = tid >> 6, r = lane & 15, q = lane >> 4;
    const float* lg = p.ln_g + (L * 2 + 0) * 1024; const float* lb = p.ln_b + (L * 2 + 0) * 1024;
    const bf16_t* Y = (const bf16_t*)(p.ws + WS_BIG); bf16_t* X1 = (bf16_t*)(p.ws + WS_X1B);
    for (int i = tid; i < 32 * 2 * 64; i += NTHREADS) { const int l2 = i & 63, nb = (i >> 6) & 1, s = i >> 7; const int e = 16 * nb + (l2 & 15), k0 = 32 * s + 8 * (l2 >> 4);
        float w[8]; unsigned hw[4], lw[4];
#pragma unroll
        for (int j = 0; j < 8; ++j) w[j] = p.router_w[(size_t)(k0 + j) * 32 + e];
#pragma unroll
        for (int j = 0; j < 4; ++j) { hw[j] = cvt_pk_bf16(w[2 * j], w[2 * j + 1]); lw[j] = cvt_pk_bf16(w[2 * j] - lo_bf(hw[j]), w[2 * j + 1] - hi_bf(hw[j])); }
        *(LAS u32x4*)(lds + ((size_t)((s * 2 + nb) * 2 + 0) * 64 + l2) * 16) = (u32x4){hw[0], hw[1], hw[2], hw[3]};
        *(LAS u32x4*)(lds + ((size_t)((s * 2 + nb) * 2 + 1) * 64 + l2) * 16) = (u32x4){lw[0], lw[1], lw[2], lw[3]}; }
    LAS int* hist = (LAS int*)(lds + 131072 + 8 * 2048);
    if (tid < 32) hist[tid] = 0;
    __syncthreads();
    for (int tb = blockIdx.x; tb < NTOK / 128; tb += gridDim.x) {
        const int tok = tb * 128 + wid * 16 + r;
        const bf16_t* yp = Y + (size_t)tok * 1024 + 8 * q;
        float sum = 0.f, sq = 0.f;
#pragma unroll 8
        for (int s = 0; s < 32; ++s) { const u32x4 y = *(const u32x4*)(yp + 32 * s); const unsigned yw[4] = {y.x, y.y, y.z, y.w};
#pragma unroll
            for (int j = 0; j < 4; ++j) { const float a = lo_bf(yw[j]), b2 = hi_bf(yw[j]); sum += a + b2; sq += a * a + b2 * b2; } }
        sum += __shfl_xor(sum, 16); sum += __shfl_xor(sum, 32); sq += __shfl_xor(sq, 16); sq += __shfl_xor(sq, 32);
        const float mu = sum * (1.0f / 1024.0f);
        const float rstd = rsqrtf(fmaxf(sq * (1.0f / 1024.0f) - mu * mu, 0.f) + 1e-5f);
        f32x4 acc0 = (f32x4){0.f, 0.f, 0.f, 0.f}, acc1 = acc0;
        bf16_t* xp = X1 + (size_t)tok * 1024 + 8 * q;
#pragma unroll 2
        for (int s = 0; s < 32; ++s) {
            const u32x4 y = *(const u32x4*)(yp + 32 * s);
            const f32x4 ga = *(const f32x4*)(lg + 32 * s + 8 * q), gb = *(const f32x4*)(lg + 32 * s + 8 * q + 4), ba = *(const f32x4*)(lb + 32 * s + 8 * q), bb = *(const f32x4*)(lb + 32 * s + 8 * q + 4);
            u32x4 w;
            w.x = cvt_pk_bf16((lo_bf(y.x) - mu) * rstd * ga[0] + ba[0], (hi_bf(y.x) - mu) * rstd * ga[1] + ba[1]);
            w.y = cvt_pk_bf16((lo_bf(y.y) - mu) * rstd * ga[2] + ba[2], (hi_bf(y.y) - mu) * rstd * ga[3] + ba[3]);
            w.z = cvt_pk_bf16((lo_bf(y.z) - mu) * rstd * gb[0] + bb[0], (hi_bf(y.z) - mu) * rstd * gb[1] + bb[1]);
            w.w = cvt_pk_bf16((lo_bf(y.w) - mu) * rstd * gb[2] + bb[2], (hi_bf(y.w) - mu) * rstd * gb[3] + bb[3]);
            *(u32x4*)(xp + 32 * s) = w;
            const bf16x8 af = __builtin_bit_cast(bf16x8, w);
            const LAS unsigned char* bq = lds + (size_t)s * 4096 + lane * 16;
            const bf16x8 b0h = *(const LAS bf16x8*)(bq), b0l = *(const LAS bf16x8*)(bq + 1024), b1h = *(const LAS bf16x8*)(bq + 2048), b1l = *(const LAS bf16x8*)(bq + 3072);
            acc0 = __builtin_amdgcn_mfma_f32_16x16x32_bf16(af, b0h, acc0, 0, 0, 0); acc0 = __builtin_amdgcn_mfma_f32_16x16x32_bf16(af, b0l, acc0, 0, 0, 0);
            acc1 = __builtin_amdgcn_mfma_f32_16x16x32_bf16(af, b1h, acc1, 0, 0, 0); acc1 = __builtin_amdgcn_mfma_f32_16x16x32_bf16(af, b1l, acc1, 0, 0, 0);
        }
        LAS float* lg2 = (LAS float*)(lds + 131072 + wid * 2048);
#pragma unroll
        for (int i = 0; i < 4; ++i) { lg2[(4 * q + i) * 32 + r] = acc0[i] + p.router_b[r]; lg2[(4 * q + i) * 32 + 16 + r] = acc1[i] + p.router_b[16 + r]; }
        asm volatile("s_waitcnt lgkmcnt(0)" ::: "memory");
        if (lane < 16) {
            float pr[32]; float mx = -INFINITY;
#pragma unroll
            for (int e = 0; e < 32; ++e) { pr[e] = lg2[lane * 32 + e]; mx = fmaxf(mx, pr[e]); }
#pragma unroll
            for (int e = 0; e < 32; ++e) pr[e] = __expf(pr[e] - mx);
            int best = 0; float bs = -1.f;
#pragma unroll
            for (int gi = 0; gi < 8; ++gi) { const float a = pr[4 * gi], b2 = pr[4 * gi + 1], c2 = pr[4 * gi + 2], d2 = pr[4 * gi + 3];
                const float h1 = fmaxf(a, b2), l1 = fminf(a, b2), h2 = fmaxf(c2, d2), l2 = fminf(c2, d2);
                const float m1 = fmaxf(h1, h2), m2 = fmaxf(fminf(h1, h2), fmaxf(l1, l2));
                const float sc = m1 + m2; if (sc > bs) { bs = sc; best = gi; } }
            float v[4];
#pragma unroll
            for (int gi = 0; gi < 8; ++gi) if (gi == best) { v[0] = pr[4 * gi]; v[1] = pr[4 * gi + 1]; v[2] = pr[4 * gi + 2]; v[3] = pr[4 * gi + 3]; }
            int i0 = 0; float v0 = v[0];
#pragma unroll
            for (int i = 1; i < 4; ++i) if (v[i] > v0) { v0 = v[i]; i0 = i; }
            int i1 = -1; float v1 = -1.f;
#pragma unroll
            for (int i = 0; i < 4; ++i) if (i != i0 && v[i] > v1) { v1 = v[i]; i1 = i; }
            const int t2 = tb * 128 + wid * 16 + lane; const int e0 = best * 4 + i0, e1 = best * 4 + i1; const float ws = 1.0f / (v0 + v1);
            ((int*)(p.ws + WS_RE))[t2 * 2] = e0; ((int*)(p.ws + WS_RE))[t2 * 2 + 1] = e1;
            ((float*)(p.ws + WS_RWT))[t2 * 2] = v0 * ws; ((float*)(p.ws + WS_RWT))[t2 * 2 + 1] = v1 * ws;
            atomicAdd((int*)hist + e0, 1); atomicAdd((int*)hist + e1, 1);
        }
        __syncthreads();
        if (tid < 32) { ((int*)(p.ws + WS_HIST))[tb * 32 + tid] = hist[tid]; hist[tid] = 0; }
        __syncthreads();
    }
}

__device__ __forceinline__ void phase_scatter(const Params& p, LAS unsigned char* lds) {
    const int tid = otid();
    LAS int* cnt = (LAS int*)lds; LAS int* pre = cnt + 32; LAS int* pst = cnt + 64; LAS int* earr = cnt + 128;
    const int* HIST = (const int*)(p.ws + WS_HIST); const int* RE = (const int*)(p.ws + WS_RE);
    int* ROWTOK = (int*)(p.ws + WS_ROWTOK); int* POS = (int*)(p.ws + WS_POS);
    for (int tb = blockIdx.x; tb < NTOK / 128; tb += gridDim.x) {
        __syncthreads();
        if (tid < 32) { int c = 0, pr = 0; for (int g = 0; g < NTOK / 128; ++g) { const int hv = HIST[g * 32 + tid]; c += hv; pr += (g < tb) ? hv : 0; } cnt[tid] = c; pre[tid] = pr; }
        if (tid < 256) earr[tid] = RE[tb * 256 + tid];
        __syncthreads();
        if (tid == 0) { int s = 0; for (int e = 0; e < 32; ++e) { pst[e] = s; s += (cnt[e] + 255) & ~255; } pst[32] = s; }
        __syncthreads();
        if (tid < 256) { const int e = earr[tid]; int rank = 0; for (int a = 0; a < tid; ++a) rank += (earr[a] == e) ? 1 : 0;
            const int slot = pst[e] + pre[e] + rank; ROWTOK[slot] = tb * 128 + (tid >> 1); POS[tb * 256 + tid] = slot; }
        if (tb < 32) { const int e = tb; const int c = cnt[e], pc = (c + 255) & ~255; for (int i = c + tid; i < pc; i += NTHREADS) ROWTOK[pst[e] + i] = 0; }
        if (tb == 0) { for (int e = 0; e < 32; ++e) { const int np = ((cnt[e] + 255) >> 8), p0 = pst[e] >> 8; for (int i = tid; i < np; i += NTHREADS) ((int*)(p.ws + WS_PANEL))[p0 + i] = e; }
            if (tid == 0) *(int*)(p.ws + WS_NPAN) = pst[32] >> 8; }
    }
}

template <int L> __device__ __forceinline__ void phase_ln2(const Params& p) {
    const int tid = otid(), lane = tid & 63, wid = tid >> 6;
    const float* lg = p.ln_g + (L * 2 + 1) * 1024; const float* lb = p.ln_b + (L * 2 + 1) * 1024;
    const bf16_t* X1 = (const bf16_t*)(p.ws + WS_X1B); const bf16_t* YB = (const bf16_t*)(p.ws + WS_BIG);
    const int* POS = (const int*)(p.ws + WS_POS); const float* RW = (const float*)(p.ws + WS_RWT);
    for (int tok = blockIdx.x * 8 + wid; tok < NTOK; tok += gridDim.x * 8) {
        const int s0 = POS[tok * 2], s1 = POS[tok * 2 + 1]; const float w0 = RW[tok * 2], w1 = RW[tok * 2 + 1];
        float v[16];
#pragma unroll
        for (int hf = 0; hf < 2; ++hf) { const int c0 = hf * 512 + lane * 8;
            const u32x4 a = *(const u32x4*)(X1 + (size_t)tok * 1024 + c0), b = *(const u32x4*)(YB + (size_t)s0 * 1024 + c0), c = *(const u32x4*)(YB + (size_t)s1 * 1024 + c0);
            const unsigned aw[4] = {a.x, a.y, a.z, a.w}, bw[4] = {b.x, b.y, b.z, b.w}, cw[4] = {c.x, c.y, c.z, c.w};
#pragma unroll
            for (int j = 0; j < 4; ++j) { v[hf * 8 + 2 * j] = ALPHA * lo_bf(aw[j]) + w0 * lo_bf(bw[j]) + w1 * lo_bf(cw[j]); v[hf * 8 + 2 * j + 1] = ALPHA * hi_bf(aw[j]) + w0 * hi_bf(bw[j]) + w1 * hi_bf(cw[j]); } }
        float s = 0.f;
#pragma unroll
        for (int i = 0; i < 16; ++i) s += v[i];
        const float mu = wave_sum(s) * (1.0f / 1024.0f);
        float qv = 0.f;
#pragma unroll
        for (int i = 0; i < 16; ++i) { const float d = v[i] - mu; qv += d * d; }
        const float rstd = rsqrtf(wave_sum(qv) * (1.0f / 1024.0f) + 1e-5f);
#pragma unroll
        for (int hf = 0; hf < 2; ++hf) { const int c0 = hf * 512 + lane * 8; float o[8];
            const f32x4 ga = *(const f32x4*)(lg + c0), gb = *(const f32x4*)(lg + c0 + 4), ba = *(const f32x4*)(lb + c0), bb = *(const f32x4*)(lb + c0 + 4);
#pragma unroll
            for (int j = 0; j < 4; ++j) { o[j] = (v[hf * 8 + j] - mu) * rstd * ga[j] + ba[j]; o[4 + j] = (v[hf * 8 + 4 + j] - mu) * rstd * gb[j] + bb[j]; }
            if (L == 1) { *(f32x4*)(p.out + (size_t)tok * 1024 + c0) = (f32x4){o[0], o[1], o[2], o[3]}; *(f32x4*)(p.out + (size_t)tok * 1024 + c0 + 4) = (f32x4){o[4], o[5], o[6], o[7]}; }
            else { u32x4 w; w.x = cvt_pk_bf16(o[0], o[1]); w.y = cvt_pk_bf16(o[2], o[3]); w.z = cvt_pk_bf16(o[4], o[5]); w.w = cvt_pk_bf16(o[6], o[7]); *(u32x4*)((bf16_t*)(p.ws + WS_XB) + (size_t)tok * 1024 + c0) = w; } }
    }
}

__device__ __forceinline__ void phase_cmpfin(const Params& p, LAS unsigned char* lds) {
    const int tid = otid(), lane = tid & 63, wid = tid >> 6;
    LAS float* w2s = (LAS float*)lds;
    LAS float* hs = (LAS float*)(lds + 131072) + wid * 256;
    for (int i = tid; i < 2 * 256 * 64; i += NTHREADS) w2s[i] = (i < 256 * 64) ? p.ck_w2[i] : p.cv_w2[i - 256 * 64];
    __syncthreads();
    const float* CP = (const float*)(p.ws + WS_X1B); const float* B1 = (const float*)(p.ws + WS_B1);
    for (int row = blockIdx.x * 8 + wid; row < 2 * 8192; row += gridDim.x * 8) {
        const int kv = row >> 13, m = row & 8191;
#pragma unroll
        for (int i = 0; i < 4; ++i) { const int j = lane + 64 * i; float a = B1[kv * 256 + j];
#pragma unroll
            for (int ks = 0; ks < 4; ++ks) a += CP[((size_t)(kv * 4 + ks) * 8192 + m) * 256 + j];
            const float u = 0.7978845608028654f * (a + 0.044715f * a * a * a); const float th = 1.0f - 2.0f / (1.0f + __expf(2.0f * u));
            hs[j] = 0.5f * a * (1.0f + th); }
        asm volatile("s_waitcnt lgkmcnt(0)" ::: "memory");
        float o = 0.f; const LAS float* w2 = w2s + kv * 256 * 64 + lane;
#pragma unroll 8
        for (int j = 0; j < 256; ++j) o += hs[j] * w2[j * 64];
        if ((m & 127) == 127) o = 0.f;
        ((bf16_t*)(p.ws + (kv ? WS_VCMP : WS_KCMP)))[(size_t)m * 64 + lane] = f2bf(o);
        asm volatile("s_waitcnt lgkmcnt(0)" ::: "memory");
    }
}

constexpr int NPHASE = 19;
template <int PH> __device__ __forceinline__ void run_phase(const Params& p, LAS unsigned char* lds) {
    char* ws = p.ws;
    if constexpr (PH == 0) phase_prologue(p, lds);
    else if constexpr (PH == 1) { SchedPlain S; S.init(ws + WS_XB, ws + WS_WQKV0, NTOK, 3072, 1024); EpiQKV0 E{(bf16_t*)(ws + WS_BIG), (float*)(ws + WS_KPART)}; pg8::gemm_phase(lds, S, E); }
    else if constexpr (PH == 2) phase_moba(p, lds);
    else if constexpr (PH == 3) { SchedPlain S; S.init(ws + WS_AOH, ws + WS_WO0, NTOK, 1024, 1024); EpiRes<true> E{(bf16_t*)(ws + WS_BIG), p.x, nullptr}; pg8::gemm_phase(lds, S, E); }
    else if constexpr (PH == 4) phase_ln1<0>(p, lds);
    else if constexpr (PH == 5 || PH == 15) phase_scatter(p, lds);
    else if constexpr (PH == 6 || PH == 16) { SchedMoeGU S; S.init(ws); EpiGU E{(bf16_t*)(ws + WS_AOH)}; pg8::gemm_phase(lds, S, E); }
    else if constexpr (PH == 7 || PH == 17) { SchedMoeDN S; S.init(ws); EpiDN E{(bf16_t*)(ws + WS_BIG)}; pg8::gemm_phase(lds, S, E); }
    else if constexpr (PH == 8) { phase_ln2<0>(p); conv_moe_layer(p, 1, lds); }
    else if constexpr (PH == 9) { SchedPlain S; S.init(ws + WS_XB, ws + WS_WIN1, NTOK, 2816, 1024); EpiNSA E{(bf16_t*)(ws + WS_BIG)}; pg8::gemm_phase(lds, S, E); }
    else if constexpr (PH == 10) { SchedCmp S; S.init(ws); EpiCmp E{(float*)(ws + WS_X1B)}; pg8::gemm_phase(lds, S, E); }
    else if constexpr (PH == 11) phase_cmpfin(p, lds);
    else if constexpr (PH == 12) phase_nsa(p, lds);
    else if constexpr (PH == 13) { SchedPlain S; S.init(ws + WS_AOH, ws + WS_WO1, NTOK, 1024, 1024); EpiRes<false> E{(bf16_t*)(ws + WS_BIG), nullptr, (const bf16_t*)(ws + WS_XB)}; pg8::gemm_phase(lds, S, E); }
    else if constexpr (PH == 14) phase_ln1<1>(p, lds);
    else if constexpr (PH == 18) phase_ln2<1>(p);
}

extern __shared__ __attribute__((aligned(16))) unsigned char g_smem[];

template <int PH> __global__ void __launch_bounds__(NTHREADS, 2) k_phase(Params p) {
    run_phase<PH>(p, (LAS unsigned char*)g_smem);
}

#if !MK_LAUNCHES
template <int PH> __device__ __forceinline__ void mega_seq(const Params& p, LAS unsigned char* lds, const XcdBarrier& bar) {
    run_phase<PH>(p, lds);
    if constexpr (PH + 1 < NPHASE) { xcd_barrier(bar); mega_seq<PH + 1>(p, lds, bar); }
}
__global__ void __launch_bounds__(NTHREADS, 2) k_mega(Params p) {
    LAS unsigned char* lds = (LAS unsigned char*)g_smem;
    LAS unsigned* stw = (LAS unsigned*)(lds + LDS_BYTES - 16);
    if (threadIdx.x == 0) { stw[0] = 0u; stw[1] = 0u; stw[2] = 0u; stw[3] = 0u; }
    __syncthreads();
    XcdBarrier bar = xcd_barrier_post((unsigned*)(p.ws + WS_CTL), (volatile LAS unsigned*)stw);
    mega_seq<0>(p, lds, bar);
}

#endif
template <int PH> static void launch_phases(const Params& p, int grid, hipStream_t stream) {
    hipFuncSetAttribute((const void*)k_phase<PH>, hipFuncAttributeMaxDynamicSharedMemorySize, LDS_BYTES);
    hipLaunchKernelGGL(k_phase<PH>, dim3(grid), dim3(NTHREADS), LDS_BYTES, stream, p);
    if constexpr (PH + 1 < NPHASE) launch_phases<PH + 1>(p, grid, stream);
}

extern "C" void kernel_launch(void* const* d_in, const int* in_sizes, int n_in, void* d_out, int out_size, void* d_ws, size_t ws_size, hipStream_t stream) {
    if (n_in != 19 || ws_size < WS_END) { fprintf(stderr, "kernel_launch: need 19 inputs and %zu bytes of workspace (got %d, %zu)\n", (size_t)WS_END, n_in, ws_size); return; }
    Params p{};
    p.x = (const float*)d_in[0]; p.rel_bias = (const float*)d_in[1]; p.router_w = (const float*)d_in[2]; p.router_b = (const float*)d_in[3];
    p.ln_g = (const float*)d_in[4]; p.ln_b = (const float*)d_in[5]; p.moba_w_in = (const float*)d_in[6]; p.moba_w_out = (const float*)d_in[7];
    p.nsa_w_in = (const float*)d_in[8]; p.nsa_w_out = (const float*)d_in[9]; p.pos_k = (const float*)d_in[10]; p.pos_v = (const float*)d_in[11];
    p.ck_w1 = (const float*)d_in[12]; p.ck_w2 = (const float*)d_in[13]; p.cv_w1 = (const float*)d_in[14]; p.cv_w2 = (const float*)d_in[15];
    p.w_gate = (const float*)d_in[16]; p.w_up = (const float*)d_in[17]; p.w_down = (const float*)d_in[18];
    p.out = (float*)d_out; p.ws = (char*)d_ws;
    const int grid = NWG_EXPECT;
#if MK_LAUNCHES
    launch_phases<0>(p, grid, stream);
#else
    hipFuncSetAttribute((const void*)k_mega, hipFuncAttributeMaxDynamicSharedMemorySize, LDS_BYTES);
    hipMemsetAsync((char*)d_ws + WS_CTL, 0, 16384, stream);
    hipLaunchKernelGGL(k_mega, dim3(grid), dim3(NTHREADS), LDS_BYTES, stream, p);
#endif
}
```

```cpp
#include <hip/hip_runtime.h>
#include <cstdio>
#include <cstdint>

#ifndef MK_LAUNCHES
#define MK_LAUNCHES 0
#endif

#define LAS __attribute__((address_space(3)))
typedef unsigned short bf16_t;
typedef short bf16x8 __attribute__((ext_vector_type(8)));
typedef short s16x4 __attribute__((ext_vector_type(4)));
typedef short v4i16_t __attribute__((ext_vector_type(4)));
typedef float f32x4 __attribute__((ext_vector_type(4)));
typedef float f32x16 __attribute__((ext_vector_type(16)));
typedef unsigned u32x4 __attribute__((ext_vector_type(4)));
typedef unsigned u32x2 __attribute__((ext_vector_type(2)));
typedef LAS const char* lds_cptr;

constexpr int NTOK = 32768, DM = 1024, SEQ = 2048, NBATCH = 16, NHEAD = 16;
constexpr int QKV_LD = 3072, NSA_LD = 2816;
constexpr int NSA_KC = 1024, NSA_VC = 1280, NSA_KS = 1536, NSA_VS = 1792, NSA_KW = 2048, NSA_VW = 2304, NSA_G = 2560;
constexpr int NEXP = 32, DEXP = 512, MAXPAN = 288, RPAD = MAXPAN * 256;
constexpr int NTHREADS = 512, NWG_EXPECT = 256;
constexpr int LDS_BYTES = 155648;
constexpr float LOG2E = 1.4426950408889634f;
constexpr float C2 = 0.125f * LOG2E;
constexpr float ALPHA = 1.4142135623730951f;
constexpr int BT_N = 288;

constexpr size_t al256(size_t x) { return (x + 255) & ~(size_t)255; }
constexpr size_t WS_CTL = 0;
constexpr size_t WS_TAB = 16384;
constexpr size_t WS_B1 = WS_TAB + al256(16 * BT_N * 4);
constexpr size_t WS_NPAN = WS_B1 + 65536;
constexpr size_t WS_PANEL = WS_NPAN + 256;
constexpr size_t WS_HIST = WS_PANEL + 1280;
constexpr size_t WS_KPART = WS_HIST + 32768;
constexpr size_t WS_RE = WS_KPART + 128 * 2 * 1024 * 4;
constexpr size_t WS_RWT = WS_RE + (size_t)NTOK * 8;
constexpr size_t WS_POS = WS_RWT + (size_t)NTOK * 8;
constexpr size_t WS_ROWTOK = WS_POS + (size_t)NTOK * 8;
constexpr size_t WS_KCMP = WS_ROWTOK + al256((size_t)RPAD * 4);
constexpr size_t WS_VCMP = WS_KCMP + 16 * 4 * 128 * 64 * 2;
constexpr size_t WS_WQKV0 = WS_VCMP + 16 * 4 * 128 * 64 * 2;
constexpr size_t WS_WO0 = WS_WQKV0 + (size_t)3072 * 1024 * 2;
constexpr size_t WS_WIN1 = WS_WO0 + (size_t)1024 * 1024 * 2;
constexpr size_t WS_WO1 = WS_WIN1 + (size_t)2816 * 1024 * 2;
constexpr size_t WS_W1T = WS_WO1 + (size_t)1024 * 1024 * 2;
constexpr size_t WS_GU = WS_W1T + (size_t)2 * 256 * 2048 * 2;
constexpr size_t WS_DN = WS_GU + (size_t)32 * 1024 * 1024 * 2;
constexpr size_t WS_XB = WS_DN + (size_t)32 * 1024 * 512 * 2;
constexpr size_t WS_BIG = WS_XB + (size_t)NTOK * 1024 * 2;
constexpr size_t WS_AOH = WS_BIG + (size_t)NTOK * 3072 * 2;
constexpr size_t WS_X1B = WS_AOH + (size_t)RPAD * 512 * 2;
constexpr size_t WS_END = WS_X1B + (size_t)NTOK * 1024 * 2;

struct Params {
    const float *x, *rel_bias, *router_w, *router_b, *ln_g, *ln_b, *moba_w_in, *moba_w_out, *nsa_w_in, *nsa_w_out, *pos_k, *pos_v,
                *ck_w1, *ck_w2, *cv_w1, *cv_w2, *w_gate, *w_up, *w_down;
    float* out;
    char* ws;
};

__device__ __forceinline__ int otid() { int t = threadIdx.x; asm volatile("" : "+v"(t)); return t; }
__device__ __forceinline__ float bf2f(bf16_t v) { return __uint_as_float(((unsigned)v) << 16); }
__device__ __forceinline__ unsigned cvt_pk_bf16(float lo, float hi) { unsigned r; asm volatile("v_cvt_pk_bf16_f32 %0, %1, %2" : "=v"(r) : "v"(lo), "v"(hi)); return r; }
__device__ __forceinline__ bf16_t f2bf(float f) { return (bf16_t)(cvt_pk_bf16(f, 0.f) & 0xffffu); }
__device__ __forceinline__ float lo_bf(unsigned w) { return __uint_as_float(w << 16); }
__device__ __forceinline__ float hi_bf(unsigned w) { return __uint_as_float(w & 0xffff0000u); }
__device__ __forceinline__ float wave_sum(float v) {
#pragma unroll
    for (int o = 32; o > 0; o >>= 1) v += __shfl_xor(v, o);
    return v; }

#define XB_TMO      128
#define XB_XCNT(j)  (256  + 64 * (j))
#define XB_XSUB(j)  (1280 + 64 * (j))
#define XB_XGEN(j)  (2304 + 64 * (j))
#define XB_TOP      3328
#define XB_TOPGEN   3392
#define XCD_BAR_WORDS 3456
#define XB_SPIN_CAP (1u << 18)
__device__ __forceinline__ unsigned xb_ld(unsigned* p)              { return __hip_atomic_load(p, __ATOMIC_RELAXED, __HIP_MEMORY_SCOPE_AGENT); }
__device__ __forceinline__ unsigned xb_add(unsigned* p, unsigned v) { return __hip_atomic_fetch_add(p, v, __ATOMIC_RELAXED, __HIP_MEMORY_SCOPE_AGENT); }
__device__ __forceinline__ unsigned xb_xcc_id() { return (unsigned)__builtin_amdgcn_s_getreg((3 << 11) | 20) & 0xFu; }
#define XB_SPIN(cond, bar) do { unsigned _sp = 0; while (cond) { __builtin_amdgcn_s_sleep(1); \
    if ((++_sp & 255u) == 0u) { if (xb_ld(&(bar)[XB_TMO])) break; if (_sp > XB_SPIN_CAP) { atomicAdd(&(bar)[XB_TMO], 1u); break; } } } } while (0)
struct XcdBarrier { unsigned* bar; unsigned x; volatile LAS unsigned* st; };
__device__ __forceinline__ XcdBarrier xcd_barrier_post(unsigned* bar, volatile LAS unsigned* st) {
    XcdBarrier b; b.bar = bar; b.x = xb_xcc_id(); b.st = st;
    if (threadIdx.x == 0) (void)xb_add(&bar[XB_XCNT(b.x)], 1u);
    return b;
}
__device__ __forceinline__ void xcd_barrier_complete(unsigned* bar, unsigned x, unsigned& nloc, unsigned& nx) {
    const unsigned G = gridDim.x * gridDim.y * gridDim.z;
    unsigned sum, cnt, mine, sp = 0u;
    for (;;) {
        sum = 0u; cnt = 0u; mine = 0u;
#pragma unroll
        for (unsigned j = 0; j < 16; ++j) { const unsigned c = xb_ld(&bar[XB_XCNT(j)]); sum += c; cnt += (c > 0u) ? 1u : 0u; mine = (j == x) ? c : mine; }
        if (sum == G) break;
        __builtin_amdgcn_s_sleep(1);
        if ((++sp & 255u) == 0u) { if (xb_ld(&bar[XB_TMO])) break; if (sp > XB_SPIN_CAP) { atomicAdd(&bar[XB_TMO], 1u); break; } }
    }
    nloc = mine > 0u ? mine : 1u; nx = cnt > 0u ? cnt : 1u;
}
__device__ __forceinline__ void xcd_barrier(const XcdBarrier& b) {
    asm volatile("s_waitcnt vmcnt(0)" ::: "memory");
    __syncthreads();
    if (threadIdx.x == 0) {
        unsigned* bar = b.bar;
        __builtin_amdgcn_s_waitcnt(0);
        unsigned nloc = b.st[0], nx = b.st[1];
        if (nloc == 0u) { xcd_barrier_complete(bar, b.x, nloc, nx); b.st[0] = nloc; b.st[1] = nx; }
        const unsigned old = xb_add(&bar[XB_XSUB(b.x)], 1u);
        const unsigned gen = old / nloc;
        if (old + 1u == (gen + 1u) * nloc) {
            __builtin_amdgcn_fence(__ATOMIC_RELEASE, "agent");
            asm volatile("s_waitcnt vmcnt(0)" ::: "memory");
            const unsigned og = xb_add(&bar[XB_TOP], 1u);
            const unsigned tg = og / nx;
            if (og + 1u == (tg + 1u) * nx) xb_add(&bar[XB_TOPGEN], 1u);
            else XB_SPIN(xb_ld(&bar[XB_TOPGEN]) == tg, bar);
            __builtin_amdgcn_fence(__ATOMIC_ACQUIRE, "agent");
            xb_add(&bar[XB_XGEN(b.x)], 1u);
            asm volatile("s_waitcnt vmcnt(0)" ::: "memory");
        } else {
            XB_SPIN(xb_ld(&bar[XB_XGEN(b.x)]) == gen, bar);
            __builtin_amdgcn_fence(__ATOMIC_ACQUIRE, "agent");
            asm volatile("s_waitcnt vmcnt(0)" ::: "memory");
        }
    }
    __syncthreads();
}

namespace pg8 {
constexpr int BM = 256, BK = 64, HALF = 128, HTB = HALF * BK * 2, STAGE_BYTES = 8 * HTB, NXCD = 8, WGM = 8;
__device__ __forceinline__ int lds_byte(int r, int c) { const int st = (r >> 4) * 2 + (c >> 5), rr = r & 15, cc = c & 31, ob = rr * 64 + cc * 2; return st * 1024 + (ob ^ (((ob >> 9) & 1) << 5)); }
__device__ __forceinline__ void stage_rc(int b, int& R, int& C) { const int st = b / 1024, sb = b % 1024, swz = sb ^ (((sb >> 9) & 1) << 5); R = (st >> 1) * 16 + swz / 64; C = (st & 1) * 32 + (swz % 64) / 2; }
__device__ __forceinline__ int perm32(int rho) { const int n = rho >> 4, i = rho & 15; return 8 * (i >> 2) + 4 * n + (i & 3); }
struct Unit { int pm, pn, aux; };

__device__ __forceinline__ void static_unit(int L, int nM, int nN, Unit& u) {
    const int nwg = nM * nN;
    int wgid = L; { const int q = nwg / NXCD, r = nwg % NXCD, xcd = wgid % NXCD, off = wgid / NXCD; wgid = (xcd < r ? xcd * (q + 1) : r * (q + 1) + (xcd - r) * q) + off; }
    const int nig = WGM * nN, gid = wgid / nig, fm = gid * WGM, gsz = (nM - fm) < WGM ? (nM - fm) : WGM;
    u.pm = fm + ((wgid % nig) % gsz); u.pn = (wgid % nig) / gsz; u.aux = 0;
}

template <class Epi, class Sched>
__device__ __forceinline__ void gemm_phase(LAS unsigned char* lds, const Sched& S, const Epi& E) {
    const int tid = otid(), wid = __builtin_amdgcn_readfirstlane(tid >> 6), lane = tid & 63, wr = wid >> 2, wc = wid & 3, fr = lane & 15, fq = lane >> 4;
    const int nt = S.nt;
    int sR[2], sC[2];
    unsigned vB[2][2];
#pragma unroll
    for (int i = 0; i < 2; ++i) { stage_rc(tid * 16 + i * 8192, sR[i], sC[i]); const int Rb = Epi::PERM ? ((sR[i] & ~31) + perm32(sR[i] & 31)) : sR[i];
#pragma unroll
        for (int h = 0; h < 2; ++h) vB[h][i] = (unsigned)(h * HALF + Rb) * S.ldb + (unsigned)sC[i] * 2u; }
    const size_t kstepA = S.kstepA, kstepB = S.kstepB;
    const unsigned ldsw = (unsigned)wid * 1024u;
    const int aoff = lds_byte(wr * 64 + fr, fq * 8), boff = lds_byte(wc * 32 + fr, fq * 8);
#define PG8_SA(b, h) (((b) * 2 + (h)) * HTB)
#define PG8_SB(b, h) ((4 + (b) * 2 + (h)) * HTB)
#define PG8_STAGE(bufoff, gbase, v0, v1) do { \
        __builtin_amdgcn_global_load_lds((const unsigned*)((const char*)(gbase) + (v0)), (LAS unsigned*)(lds + (bufoff) + ldsw), 16, 0, 0); \
        __builtin_amdgcn_global_load_lds((const unsigned*)((const char*)(gbase) + (v1)), (LAS unsigned*)(lds + (bufoff) + ldsw + 8192), 16, 0, 0); } while (0)
#define PG8_LDA(dst, b, h) do { _Pragma("unroll") for (int m = 0; m < 4; ++m) _Pragma("unroll") for (int k = 0; k < 2; ++k) dst[m][k] = *(const LAS bf16x8*)(lds + PG8_SA(b, h) + aoff + m * 2048 + k * 1024); } while (0)
#define PG8_LDB(dst, b, h) do { _Pragma("unroll") for (int n = 0; n < 2; ++n) _Pragma("unroll") for (int k = 0; k < 2; ++k) dst[n][k] = *(const LAS bf16x8*)(lds + PG8_SB(b, h) + boff + n * 2048 + k * 1024); } while (0)
#define PG8_MMA(ai, bj, At, Bt) do { __builtin_amdgcn_s_setprio(1); _Pragma("unroll") for (int m = 0; m < 4; ++m) _Pragma("unroll") for (int n = 0; n < 2; ++n) _Pragma("unroll") for (int k = 0; k < 2; ++k) \
        acc[ai][bj][m][n] = __builtin_amdgcn_mfma_f32_16x16x32_bf16(Bt[n][k], At[m][k], acc[ai][bj][m][n], 0, 0, 0); __builtin_amdgcn_s_setprio(0); } while (0)
#define PG8_WAIT_V(n) asm volatile("s_waitcnt vmcnt(" #n ")" ::: "memory")
#define PG8_WAIT_L(n) asm volatile("s_waitcnt lgkmcnt(" #n ")" ::: "memory")
#define PG8_BAR __builtin_amdgcn_s_barrier()
#define PG8_SCHED __builtin_amdgcn_sched_barrier(0)
    Unit cur, nxt; int ui = 0;
    if (!S.next(0, cur)) return;
    f32x4 acc[2][2][4][2];
#pragma unroll
    for (int a = 0; a < 2; ++a)
#pragma unroll
        for (int b = 0; b < 2; ++b)
#pragma unroll
            for (int m = 0; m < 4; ++m)
#pragma unroll
                for (int n = 0; n < 2; ++n) acc[a][b][m][n] = (f32x4){0.f, 0.f, 0.f, 0.f};
    bf16x8 At[4][2], B0[2][2], B1[2][2];
    unsigned vA[2][2], vN[2][2];
#pragma unroll
    for (int h = 0; h < 2; ++h)
#pragma unroll
        for (int i = 0; i < 2; ++i) { vA[h][i] = S.aoff(cur, h * HALF + sR[i], sC[i]); vN[h][i] = vA[h][i]; }
    const char* cA = S.abase(cur); const char* cB = S.bbase(cur);
    PG8_STAGE(PG8_SB(0, 0), cB, vB[0][0], vB[0][1]); PG8_STAGE(PG8_SA(0, 0), cA, vA[0][0], vA[0][1]); PG8_STAGE(PG8_SB(0, 1), cB, vB[1][0], vB[1][1]); PG8_STAGE(PG8_SA(0, 1), cA, vA[1][0], vA[1][1]);
    if (wr == 1) PG8_BAR;
    PG8_WAIT_V(4); PG8_BAR;
    PG8_STAGE(PG8_SB(1, 0), cB + kstepB, vB[0][0], vB[0][1]); PG8_STAGE(PG8_SA(1, 0), cA + kstepA, vA[0][0], vA[0][1]); PG8_STAGE(PG8_SB(1, 1), cB + kstepB, vB[1][0], vB[1][1]);
    PG8_WAIT_V(6); PG8_BAR;
    for (;;) {
        const bool has_next = S.next(ui + 1, nxt);
        const char* nA = has_next ? S.abase(nxt) : cA; const char* nB = has_next ? S.bbase(nxt) : cB;
        if (Sched::DYN_A && has_next) {
#pragma unroll
            for (int h = 0; h < 2; ++h)
#pragma unroll
                for (int i = 0; i < 2; ++i) vN[h][i] = S.aoff(nxt, h * HALF + sR[i], sC[i]);
        }
        for (int t = 0; t < nt; t += 2) {
            const bool last = (t == nt - 2);
            const char* a1 = cA + (size_t)(t + 1) * kstepA;
            const char* a2 = last ? nA : cA + (size_t)(t + 2) * kstepA; const char* b2 = last ? nB : cB + (size_t)(t + 2) * kstepB;
            const char* a3 = a2 + kstepA; const char* b3 = b2 + kstepB;
            PG8_LDB(B0, 0, 0); PG8_SCHED; PG8_LDA(At, 0, 0); PG8_STAGE(PG8_SA(1, 1), a1, vA[1][0], vA[1][1]);
            if (Sched::DYN_A && last) {
#pragma unroll
                for (int h = 0; h < 2; ++h)
#pragma unroll
                    for (int i = 0; i < 2; ++i) vA[h][i] = vN[h][i]; }
            PG8_WAIT_L(8); PG8_BAR; PG8_WAIT_L(0); PG8_MMA(0, 0, At, B0); PG8_BAR; PG8_SCHED;
            PG8_LDB(B1, 0, 1); PG8_STAGE(PG8_SB(0, 0), b2, vB[0][0], vB[0][1]);
            PG8_BAR; PG8_WAIT_L(0); PG8_MMA(0, 1, At, B1); PG8_BAR;
            PG8_LDA(At, 0, 1); PG8_STAGE(PG8_SA(0, 0), a2, vA[0][0], vA[0][1]);
            PG8_BAR; PG8_WAIT_L(0); PG8_MMA(1, 0, At, B0); PG8_BAR; PG8_SCHED;
            PG8_STAGE(PG8_SB(0, 1), b2, vB[1][0], vB[1][1]);
            PG8_WAIT_V(6); PG8_BAR; PG8_MMA(1, 1, At, B1); PG8_BAR;
            PG8_LDB(B0, 1, 0); PG8_SCHED; PG8_LDA(At, 1, 0); PG8_STAGE(PG8_SA(0, 1), a2, vA[1][0], vA[1][1]);
            PG8_WAIT_L(8); PG8_BAR; PG8_WAIT_L(0); PG8_MMA(0, 0, At, B0); PG8_BAR; PG8_SCHED;
            PG8_LDB(B1, 1, 1); PG8_STAGE(PG8_SB(1, 0), b3, vB[0][0], vB[0][1]);
            PG8_BAR; PG8_WAIT_L(0); PG8_MMA(0, 1, At, B1); PG8_BAR;
            PG8_LDA(At, 1, 1); PG8_STAGE(PG8_SA(1, 0), a3, vA[0][0], vA[0][1]);
            PG8_BAR; PG8_WAIT_L(0); PG8_MMA(1, 0, At, B0); PG8_BAR; PG8_SCHED;
            PG8_STAGE(PG8_SB(1, 1), b3, vB[1][0], vB[1][1]);
            PG8_WAIT_V(6); PG8_BAR; PG8_MMA(1, 1, At, B1); PG8_BAR;
        }
        E(acc, cur, wr, wc, fr, fq);
        if (!has_next) break;
#pragma unroll
        for (int a = 0; a < 2; ++a)
#pragma unroll
            for (int b = 0; b < 2; ++b)
#pragma unroll
                for (int m = 0; m < 4; ++m)
#pragma unroll
                    for (int n = 0; n < 2; ++n) acc[a][b][m][n] = (f32x4){0.f, 0.f, 0.f, 0.f};
        cur = nxt; cA = nA; cB = nB; ++ui;
    }
    PG8_WAIT_V(0);
    if (wr == 0) PG8_BAR;
    PG8_BAR;
#undef PG8_SA
#undef PG8_SB
#undef PG8_STAGE
#undef PG8_LDA
#undef PG8_LDB
#undef PG8_MMA
#undef PG8_WAIT_V
#undef PG8_WAIT_L
#undef PG8_BAR
#undef PG8_SCHED
}
}
using pg8::Unit;

struct SchedPlain {
    static constexpr bool DYN_A = false;
    const char* A; const char* Bt; int K, nM, nN, G, c; int nt; unsigned kstepA, kstepB, ldb;
    __device__ __forceinline__ void init(const void* A_, const void* Bt_, int M, int N, int K_) { A = (const char*)A_; Bt = (const char*)Bt_; K = K_; nM = M / 256; nN = N / 256; G = gridDim.x; c = blockIdx.x; nt = K / 64; kstepA = 128; kstepB = 128; ldb = (unsigned)K * 2u; }
    __device__ __forceinline__ bool next(int i, Unit& u) const { const int L = i * G + c; if (L >= nM * nN) return false; pg8::static_unit(L, nM, nN, u); return true; }
    __device__ __forceinline__ const char* abase(const Unit& u) const { return A + (size_t)u.pm * 256 * K * 2; }
    __device__ __forceinline__ const char* bbase(const Unit& u) const { return Bt + (size_t)u.pn * 256 * K * 2; }
    __device__ __forceinline__ unsigned aoff(const Unit&, int row, int col) const { return (unsigned)(row * K + col) * 2u; }
};
struct SchedMoeGU {
    static constexpr bool DYN_A = true;
    const char* X; const char* W; const int* rowtok; const int* panel; int nM, G, c; int nt; unsigned kstepA, kstepB, ldb;
    __device__ __forceinline__ void init(const char* ws) { X = ws + WS_X1B; W = ws + WS_GU; rowtok = (const int*)(ws + WS_ROWTOK); panel = (const int*)(ws + WS_PANEL); nM = *(const int*)(ws + WS_NPAN); G = gridDim.x; c = blockIdx.x; nt = 16; kstepA = 128; kstepB = 128; ldb = 2048; }
    __device__ __forceinline__ bool next(int i, Unit& u) const { const int L = i * G + c; if (L >= nM * 4) return false; pg8::static_unit(L, nM, 4, u); u.aux = panel[u.pm]; return true; }
    __device__ __forceinline__ const char* abase(const Unit&) const { return X; }
    __device__ __forceinline__ const char* bbase(const Unit& u) const { return W + ((size_t)u.aux * 1024 + (size_t)u.pn * 256) * 2048; }
    __device__ __forceinline__ unsigned aoff(const Unit& u, int row, int col) const { return (unsigned)rowtok[u.pm * 256 + row] * 2048u + (unsigned)col * 2u; }
};
struct SchedMoeDN {
    static constexpr bool DYN_A = false;
    const char* H; const char* W; const int* panel; int nM, G, c; int nt; unsigned kstepA, kstepB, ldb;
    __device__ __forceinline__ void init(const char* ws) { H = ws + WS_AOH; W = ws + WS_DN; panel = (const int*)(ws + WS_PANEL); nM = *(const int*)(ws + WS_NPAN); G = gridDim.x; c = blockIdx.x; nt = 8; kstepA = 128; kstepB = 128; ldb = 1024; }
    __device__ __forceinline__ bool next(int i, Unit& u) const { const int L = i * G + c; if (L >= nM * 4) return false; pg8::static_unit(L, nM, 4, u); u.aux = panel[u.pm]; return true; }
    __device__ __forceinline__ const char* abase(const Unit& u) const { return H + (size_t)u.pm * 256 * 1024; }
    __device__ __forceinline__ const char* bbase(const Unit& u) const { return W + ((size_t)u.aux * 1024 + (size_t)u.pn * 256) * 1024; }
    __device__ __forceinline__ unsigned aoff(const Unit&, int row, int col) const { return (unsigned)(row * 512 + col) * 2u; }
};
struct SchedCmp {
    static constexpr bool DYN_A = false  ;
    const char* Q; const char* W; int G, c; int nt; unsigned kstepA, kstepB, ldb;
    __device__ __forceinline__ void init(const char* ws) { Q = ws + WS_BIG; W = ws + WS_W1T; G = gridDim.x; c = blockIdx.x; nt = 8; kstepA = NSA_LD * 2; kstepB = 128; ldb = 4096; }
    __device__ __forceinline__ bool next(int i, Unit& u) const { const int L = i * G + c; if (L >= 256) return false; u.aux = L >> 7; u.pm = (L >> 2) & 31; u.pn = L & 3; return true; }
    __device__ __forceinline__ const char* abase(const Unit& u) const { return Q + (size_t)(u.aux ? NSA_VC : NSA_KC) * 2 + (size_t)u.pn * 8 * (NSA_LD * 2); }
    __device__ __forceinline__ const char* bbase(const Unit& u) const { return W + (size_t)u.aux * 256 * 4096 + (size_t)u.pn * 8 * 128; }
    __device__ __forceinline__ unsigned aoff(const Unit& u, int row, int col) const {
        const int m = u.pm * 256 + row, bh = m >> 7, n = m & 127, nn = n > 126 ? 126 : n, b = bh >> 2, hkv = bh & 3;
        return (unsigned)(((b * SEQ + 16 * nn) * NSA_LD) + hkv * 64 + col) * 2u; }
};

struct EpiQKV0 {
    static constexpr bool PERM = true;
    bf16_t* O; float* kpart;
    __device__ __forceinline__ void operator()(const f32x4 (&acc)[2][2][4][2], const Unit& u, int wr, int wc, int fr, int fq) const {
        const int row0 = u.pm * 256 + wr * 64 + fr, col0 = u.pn * 256 + wc * 32 + 8 * fq;
        const float sc = (u.pn < 4) ? C2 : 1.0f;
#pragma unroll
        for (int ai = 0; ai < 2; ++ai)
#pragma unroll
            for (int m = 0; m < 4; ++m) { bf16_t* rowp = O + (size_t)(row0 + ai * 128 + m * 16) * QKV_LD + col0;
#pragma unroll
                for (int bj = 0; bj < 2; ++bj) { const f32x4 v0 = acc[ai][bj][m][0] * sc, v1 = acc[ai][bj][m][1] * sc;
                    u32x4 w; w.x = cvt_pk_bf16(v0[0], v0[1]); w.y = cvt_pk_bf16(v0[2], v0[3]); w.z = cvt_pk_bf16(v1[0], v1[1]); w.w = cvt_pk_bf16(v1[2], v1[3]);
                    *(u32x4*)(rowp + bj * 128) = w; } }
        if (u.pn >= 4 && u.pn < 8) {
#pragma unroll
            for (int bj = 0; bj < 2; ++bj)
#pragma unroll
                for (int n = 0; n < 2; ++n) { f32x4 s = (f32x4){0.f, 0.f, 0.f, 0.f};
#pragma unroll
                    for (int ai = 0; ai < 2; ++ai)
#pragma unroll
                        for (int m = 0; m < 4; ++m) s += acc[ai][bj][m][n];
#pragma unroll
                    for (int j = 0; j < 4; ++j) { float v = s[j]; v += __shfl_xor(v, 1); v += __shfl_xor(v, 2); v += __shfl_xor(v, 4); v += __shfl_xor(v, 8); s[j] = v; }
                    if (fr == 0) *(f32x4*)(kpart + ((size_t)u.pm * 2 + wr) * 1024 + (u.pn - 4) * 256 + bj * 128 + wc * 32 + 8 * fq + 4 * n) = s; }
        }
    }
};
struct EpiNSA {
    static constexpr bool PERM = true;
    bf16_t* O;
    __device__ __forceinline__ void operator()(const f32x4 (&acc)[2][2][4][2], const Unit& u, int wr, int wc, int fr, int fq) const {
        const int row0 = u.pm * 256 + wr * 64 + fr, col0 = u.pn * 256 + wc * 32 + 8 * fq;
        const float sc = (u.pn < 4) ? C2 : 1.0f; const bool sg = (u.pn == 10);
#pragma unroll
        for (int ai = 0; ai < 2; ++ai)
#pragma unroll
            for (int m = 0; m < 4; ++m) { bf16_t* rowp = O + (size_t)(row0 + ai * 128 + m * 16) * NSA_LD + col0;
#pragma unroll
                for (int bj = 0; bj < 2; ++bj) { f32x4 v0 = acc[ai][bj][m][0] * sc, v1 = acc[ai][bj][m][1] * sc;
                    if (sg) {
#pragma unroll
                        for (int j = 0; j < 4; ++j) { v0[j] = 1.0f / (1.0f + __expf(-v0[j])); v1[j] = 1.0f / (1.0f + __expf(-v1[j])); } }
                    u32x4 w; w.x = cvt_pk_bf16(v0[0], v0[1]); w.y = cvt_pk_bf16(v0[2], v0[3]); w.z = cvt_pk_bf16(v1[0], v1[1]); w.w = cvt_pk_bf16(v1[2], v1[3]);
                    *(u32x4*)(rowp + bj * 128) = w; } }
    }
};
template <bool RES_F32> struct EpiRes {
    static constexpr bool PERM = true;
    bf16_t* O; const float* rf; const bf16_t* rb;
    __device__ __forceinline__ void operator()(const f32x4 (&acc)[2][2][4][2], const Unit& u, int wr, int wc, int fr, int fq) const {
        const int row0 = u.pm * 256 + wr * 64 + fr, col0 = u.pn * 256 + wc * 32 + 8 * fq;
#pragma unroll
        for (int ai = 0; ai < 2; ++ai)
#pragma unroll
            for (int m = 0; m < 4; ++m) { const size_t ro = (size_t)(row0 + ai * 128 + m * 16) * 1024 + col0;
#pragma unroll
                for (int bj = 0; bj < 2; ++bj) { f32x4 r0, r1;
                    if (RES_F32) { r0 = *(const f32x4*)(rf + ro + bj * 128); r1 = *(const f32x4*)(rf + ro + bj * 128 + 4); }
                    else { const u32x4 rw = *(const u32x4*)(rb + ro + bj * 128); r0 = (f32x4){lo_bf(rw.x), hi_bf(rw.x), lo_bf(rw.y), hi_bf(rw.y)}; r1 = (f32x4){lo_bf(rw.z), hi_bf(rw.z), lo_bf(rw.w), hi_bf(rw.w)}; }
                    const f32x4 v0 = acc[ai][bj][m][0] + r0 * ALPHA, v1 = acc[ai][bj][m][1] + r1 * ALPHA;
                    u32x4 w; w.x = cvt_pk_bf16(v0[0], v0[1]); w.y = cvt_pk_bf16(v0[2], v0[3]); w.z = cvt_pk_bf16(v1[0], v1[1]); w.w = cvt_pk_bf16(v1[2], v1[3]);
                    *(u32x4*)(O + ro + bj * 128) = w; } }
    }
};
struct EpiGU {
    static constexpr bool PERM = true;
    bf16_t* O;
    __device__ __forceinline__ void operator()(const f32x4 (&acc)[2][2][4][2], const Unit& u, int wr, int wc, int fr, int fq) const {
        const int row0 = u.pm * 256 + wr * 64 + fr, col0 = u.pn * 128 + wc * 32 + 8 * fq;
#pragma unroll
        for (int ai = 0; ai < 2; ++ai)
#pragma unroll
            for (int m = 0; m < 4; ++m) { float h[8];
#pragma unroll
                for (int n = 0; n < 2; ++n)
#pragma unroll
                    for (int j = 0; j < 4; ++j) { const float g = acc[ai][0][m][n][j], up = acc[ai][1][m][n][j]; h[n * 4 + j] = g * up / (1.0f + __expf(-g)); }
                u32x4 w; w.x = cvt_pk_bf16(h[0], h[1]); w.y = cvt_pk_bf16(h[2], h[3]); w.z = cvt_pk_bf16(h[4], h[5]); w.w = cvt_pk_bf16(h[6], h[7]);
                *(u32x4*)(O + (size_t)(row0 + ai * 128 + m * 16) * 512 + col0) = w; }
    }
};
struct EpiDN {
    static constexpr bool PERM = true;
    bf16_t* O;
    __device__ __forceinline__ void operator()(const f32x4 (&acc)[2][2][4][2], const Unit& u, int wr, int wc, int fr, int fq) const {
        const int row0 = u.pm * 256 + wr * 64 + fr, col0 = u.pn * 256 + wc * 32 + 8 * fq;
#pragma unroll
        for (int ai = 0; ai < 2; ++ai)
#pragma unroll
            for (int m = 0; m < 4; ++m) { bf16_t* rowp = O + (size_t)(row0 + ai * 128 + m * 16) * 1024 + col0;
#pragma unroll
                for (int bj = 0; bj < 2; ++bj) { const f32x4 v0 = acc[ai][bj][m][0], v1 = acc[ai][bj][m][1];
                    u32x4 w; w.x = cvt_pk_bf16(v0[0], v0[1]); w.y = cvt_pk_bf16(v0[2], v0[3]); w.z = cvt_pk_bf16(v1[0], v1[1]); w.w = cvt_pk_bf16(v1[2], v1[3]);
                    *(u32x4*)(rowp + bj * 128) = w; } }
    }
};
struct EpiCmp {
    static constexpr bool PERM = false;
    float* CP;
    __device__ __forceinline__ void operator()(const f32x4 (&acc)[2][2][4][2], const Unit& u, int wr, int wc, int fr, int fq) const {
        float* base = CP + ((size_t)(u.aux * 4 + u.pn) * 8192 + (size_t)u.pm * 256) * 256;
        const int row0 = wr * 64 + fr, col0 = wc * 32 + 4 * fq;
#pragma unroll
        for (int ai = 0; ai < 2; ++ai)
#pragma unroll
            for (int m = 0; m < 4; ++m) { float* rowp = base + (size_t)(row0 + ai * 128 + m * 16) * 256 + col0;
#pragma unroll
                for (int bj = 0; bj < 2; ++bj)
#pragma unroll
                    for (int n = 0; n < 2; ++n) *(f32x4*)(rowp + bj * 128 + n * 16) = acc[ai][bj][m][n]; }
    }
};

constexpr int AL_K = 0  , AL_V = 24576  , AL_BIAS = 57344  , AL_KM = AL_BIAS + 4 * BT_N * 4, AL_IMP = AL_KM + 2048  , AL_SEL = AL_IMP + 65536, AL_LIST = AL_SEL + 512, AL_END = AL_LIST + 256;
static_assert(AL_END <= LDS_BYTES - 16 && 4 * 64 * 33 * 4 <= 65536, "attention LDS map");
#define MFMA32(a, b, c) __builtin_amdgcn_mfma_f32_32x32x16_bf16(a, b, c, 0, 0, 0)
__device__ __forceinline__ s16x4 vtr(lds_cptr p) { return __builtin_bit_cast(s16x4, __builtin_amdgcn_ds_read_tr16_b64_v4i16((LAS v4i16_t*)p)); }
__device__ __forceinline__ float xhalf_max(float m) { auto rr = __builtin_amdgcn_permlane32_swap(__float_as_uint(m), __float_as_uint(m), false, false); return __builtin_fmaxf(__uint_as_float(rr[0]), __uint_as_float(rr[1])); }
__device__ __forceinline__ float xhalf_sum(float m) { auto rr = __builtin_amdgcn_permlane32_swap(__float_as_uint(m), __float_as_uint(m), false, false); return __uint_as_float(rr[0]) + __uint_as_float(rr[1]); }
__device__ __forceinline__ float max16(const f32x16& p) { float a = __builtin_fmaxf(p[0], p[1]), b = __builtin_fmaxf(p[2], p[3]);
#pragma unroll
    for (int r = 4; r < 16; r += 4) { a = __builtin_fmaxf(a, __builtin_fmaxf(p[r], p[r + 1])); b = __builtin_fmaxf(b, __builtin_fmaxf(p[r + 2], p[r + 3])); }
    return __builtin_fmaxf(a, b); }

#define MX3(a, b, c) __builtin_fmaxf(__builtin_fmaxf((a), (b)), (c))
__device__ __forceinline__ float max32(const f32x16& p0, const f32x16& p1) {
    float a = MX3(p0[0], p0[1], p1[0]), b = MX3(p0[2], p0[3], p1[1]); a = MX3(a, p1[2], p1[3]);
#pragma unroll
    for (int r = 4; r < 16; r += 4) { a = MX3(a, p0[r], p0[r + 1]); b = MX3(b, p0[r + 2], p0[r + 3]); a = MX3(a, p1[r], p1[r + 1]); b = MX3(b, p1[r + 2], p1[r + 3]); }
    return __builtin_fmaxf(a, b); }
constexpr float FLASH_THR = 8.0f;
__device__ __forceinline__ void glds16(const void* g, unsigned lds_addr) {
    unsigned sv; asm volatile("s_mov_b32 %0, m0\n\ts_mov_b32 m0, %2\n\ts_nop 0\n\tglobal_load_lds_dwordx4 %1, off\n\ts_mov_b32 m0, %0" : "=&s"(sv) : "v"(g), "s"(lds_addr) : "memory"); }
__device__ __forceinline__ void dma_k(const bf16_t* src, int ld, LAS unsigned char* lds, int slot, int wid, int lane) {
    const int rl = lane >> 3, ch = lane & 7;
    glds16(src + (size_t)(wid * 8 + rl) * ld + ((ch ^ rl) * 8), (unsigned)__builtin_amdgcn_readfirstlane((int)((unsigned)(unsigned long)lds + AL_K + slot * 8192 + wid * 1024))); }
__device__ __forceinline__ void dma_v(const bf16_t* src, int ld, LAS unsigned char* lds, int slot, int wid, int lane) {
    glds16(src + (size_t)(16 * (wid & 3) + (lane >> 2)) * ld + (wid >> 2) * 32 + (lane & 3) * 8, (unsigned)__builtin_amdgcn_readfirstlane((int)((unsigned)(unsigned long)lds + AL_V + slot * 8192 + wid * 1024))); }

struct FState { float m, l; f32x16 o0, o1; };
__device__ __forceinline__ void fstate_reset(FState& s) { s.m = -1e30f; s.l = 0.f;
#pragma unroll
    for (int r = 0; r < 16; ++r) { s.o0[r] = 0.f; s.o1[r] = 0.f; } }

__device__ __forceinline__ int kchunk_off(int d0, int kx) { return (((2 * d0 + (kx >> 3)) ^ (kx & 7)) * 16); }
__device__ __forceinline__ void qk_tile(f32x16& c0, f32x16& c1, const bf16x8 (&qr)[4], lds_cptr kp, int kx) {
#pragma unroll
    for (int d0 = 0; d0 < 4; ++d0) { const bf16x8 k0 = *(const LAS bf16x8*)(kp + kchunk_off(d0, kx)), k1 = *(const LAS bf16x8*)(kp + kchunk_off(d0, kx) + 4096);
        c0 = MFMA32(k0, qr[d0], c0); c1 = MFMA32(k1, qr[d0], c1); }
}
__device__ __forceinline__ void pv_tile(f32x16& o0, f32x16& o1, const f32x16& p0, const f32x16& p1, lds_cptr vp) {
#pragma unroll
    for (int k = 0; k < 4; ++k) {
        const f32x16& ps = (k < 2) ? p0 : p1; const int b = 8 * (k & 1);
        const u32x4 pw = (u32x4){cvt_pk_bf16(ps[b], ps[b + 1]), cvt_pk_bf16(ps[b + 2], ps[b + 3]), cvt_pk_bf16(ps[b + 4], ps[b + 5]), cvt_pk_bf16(ps[b + 6], ps[b + 7])};
        const bf16x8 pf = __builtin_bit_cast(bf16x8, pw);
        { const s16x4 lo = vtr(vp + k * 1024), hi = vtr(vp + k * 1024 + 512);
          const bf16x8 vf = (bf16x8){lo[0], lo[1], lo[2], lo[3], hi[0], hi[1], hi[2], hi[3]}; o0 = MFMA32(vf, pf, o0); }
        { const s16x4 lo = vtr(vp + 4096 + k * 1024), hi = vtr(vp + 4096 + k * 1024 + 512);
          const bf16x8 vf = (bf16x8){lo[0], lo[1], lo[2], lo[3], hi[0], hi[1], hi[2], hi[3]}; o1 = MFMA32(vf, pf, o1); }
    }
}
struct TileP { int Dmin; bool rowok, run, win; };
__device__ __forceinline__ void load_kf(bf16x8 (&kf)[8], lds_cptr kp, int kx) {
#pragma unroll
    for (int d0 = 0; d0 < 4; ++d0) { kf[2 * d0] = *(const LAS bf16x8*)(kp + kchunk_off(d0, kx)); kf[2 * d0 + 1] = *(const LAS bf16x8*)(kp + kchunk_off(d0, kx) + 4096); } }
__device__ __forceinline__ void flash_qk(f32x16& c0, f32x16& c1, float& cf, const bf16x8 (&qr)[4], lds_cptr kp, int kx, const LAS float* btab, float cfar, int Dmin, int r32, int hi) {
    bf16x8 kf[8]; load_kf(kf, kp, kx);
    if (Dmin - 63 < 127) {
        const LAS float* bp = btab + (Dmin + r32 - 4 * hi); cf = 0.f;
#pragma unroll
        for (int r = 0; r < 16; ++r) { const int ko = (r & 3) + 8 * (r >> 2); c0[r] = bp[63 - ko]; c1[r] = bp[31 - ko]; }
#pragma unroll
        for (int d0 = 0; d0 < 4; ++d0) { c0 = MFMA32(kf[2 * d0], qr[d0], c0); c1 = MFMA32(kf[2 * d0 + 1], qr[d0], c1); }
    } else {
        cf = cfar;
        const f32x16 z = {0.f, 0.f, 0.f, 0.f, 0.f, 0.f, 0.f, 0.f, 0.f, 0.f, 0.f, 0.f, 0.f, 0.f, 0.f, 0.f};
        c0 = MFMA32(kf[0], qr[0], z); c1 = MFMA32(kf[1], qr[0], z);
#pragma unroll
        for (int d0 = 1; d0 < 4; ++d0) { c0 = MFMA32(kf[2 * d0], qr[d0], c0); c1 = MFMA32(kf[2 * d0 + 1], qr[d0], c1); }
    }
}
__device__ __forceinline__ void flash_sm(FState& st, f32x16& c0, f32x16& c1, float cf, const TileP& tp, int r32, int hi) {
    const int Dmin = tp.Dmin, Dl = Dmin + r32 - 4 * hi;
    if (Dmin < 63) {
#pragma unroll
        for (int r = 0; r < 16; ++r) { const int ko = (r & 3) + 8 * (r >> 2); if (Dl < ko) c0[r] = -INFINITY; if (Dl < 32 + ko) c1[r] = -INFINITY; }
    }
    if (tp.win && (Dmin + 31 >= 512)) {
#pragma unroll
        for (int r = 0; r < 16; ++r) { const int ko = (r & 3) + 8 * (r >> 2); if (Dl >= 512 + ko) c0[r] = -INFINITY; if (Dl >= 544 + ko) c1[r] = -INFINITY; }
    }
    float mx = xhalf_max(max32(c0, c1)) + cf;
    mx = tp.rowok ? mx : -INFINITY;
    if (__any(mx > st.m + FLASH_THR)) {
        const float mn = __builtin_fmaxf(st.m, mx); const float alpha = __builtin_amdgcn_exp2f(st.m - mn);
        st.m = mn; st.l *= alpha;
#pragma unroll
        for (int r = 0; r < 16; ++r) { st.o0[r] *= alpha; st.o1[r] *= alpha; }
    }
    const float msub = tp.rowok ? (st.m - cf) : INFINITY;
    float rs0 = 0.f, rs1 = 0.f;
#pragma unroll
    for (int r = 0; r < 16; ++r) { c0[r] = __builtin_amdgcn_exp2f(c0[r] - msub); c1[r] = __builtin_amdgcn_exp2f(c1[r] - msub); rs0 += c0[r]; rs1 += c1[r]; }
    st.l += rs0 + rs1;
}
template <int VAR, class Src>
__device__ __forceinline__ void attn_stream(Src& S, int NT, FState& st, const bf16x8 (&qr)[4], LAS unsigned char* lds, const LAS float* btab, float cfar, int wid, int lane, int r32, int hi) {
    const lds_cptr kp0 = (lds_cptr)lds + AL_K + r32 * 128; const int kx = (r32 & 7) | (hi << 3);
    const lds_cptr vp0 = (lds_cptr)lds + AL_V + ((lane >> 4) & 1) * 32 + (lane & 3) * 8 + (4 * hi + ((lane & 15) >> 2)) * 64;
    S.dma(0, 0, 0); if (NT > 1 && VAR != 5 && VAR != 6) S.dma(1, 1, 1);
    if (VAR == 5) { asm volatile("s_waitcnt vmcnt(0)" ::: "memory"); __syncthreads(); }
    int sc = 0, sn = 2;
    for (int t = 0; t < NT; ++t) {
        if (VAR != 5) { if (t + 1 < NT) asm volatile("s_waitcnt vmcnt(2)" ::: "memory"); else asm volatile("s_waitcnt vmcnt(0)" ::: "memory");
        __syncthreads(); }
        if (VAR != 5 && VAR != 6) { if (t + 2 < NT) S.dma(t + 2, sn, sn); }
        const TileP tp = S.params(t);
        if (tp.run) { f32x16 c0, c1; float cf;
            flash_qk(c0, c1, cf, qr, kp0 + sc * 8192, kx, btab, cfar, tp.Dmin, r32, hi);
            flash_sm(st, c0, c1, cf, tp, r32, hi);
            pv_tile(st.o0, st.o1, c0, c1, vp0 + sc * 8192); }
        S.after(t, st);
        sc = (sc == 2) ? 0 : sc + 1; sn = (sn == 2) ? 0 : sn + 1;
    }
}

__device__ __forceinline__ void conv_tile(const float* src, int N, bf16_t* dst, int ldd, int k0, int n0, int rowadd, int mode, LAS float* t, int lane) {
    float4 v[16];
#pragma unroll
    for (int i = 0; i < 16; ++i) { const int r = i * 4 + (lane >> 4), cc = n0 + (lane & 15) * 4;
        v[i] = (cc < N) ? *(const float4*)(src + (size_t)(k0 + r) * N + cc) : make_float4(0.f, 0.f, 0.f, 0.f); }
#pragma unroll
    for (int i = 0; i < 16; ++i) { const int r = i * 4 + (lane >> 4), cc = (lane & 15) * 4; LAS float* q = t + r * 65 + cc; q[0] = v[i].x; q[1] = v[i].y; q[2] = v[i].z; q[3] = v[i].w; }
    asm volatile("s_waitcnt lgkmcnt(0)" ::: "memory");
#pragma unroll
    for (int i = 0; i < 8; ++i) { const int nr = i * 8 + (lane >> 3), kc = (lane & 7) * 8; float f[8];
#pragma unroll
        for (int j = 0; j < 8; ++j) f[j] = t[(kc + j) * 65 + nr];
        const int n = n0 + nr; const int drow = (mode == 0) ? n : (256 * (n >> 7) + (n & 127) + rowadd);
        u32x4 w; w.x = cvt_pk_bf16(f[0], f[1]); w.y = cvt_pk_bf16(f[2], f[3]); w.z = cvt_pk_bf16(f[4], f[5]); w.w = cvt_pk_bf16(f[6], f[7]);
        *(u32x4*)(dst + (size_t)drow * ldd + k0 + kc) = w; }
    asm volatile("s_waitcnt lgkmcnt(0)" ::: "memory");
}
__device__ __forceinline__ int conv_job(const float* src, int K, int N, int Npad, bf16_t* dst, int ldd, int rowadd, int mode, int tile0, LAS float* t, int gw, int ngw, int lane) {
    const int nkt = K / 64, nnt = Npad / 64, ntile = nkt * nnt;
    int first = (gw - tile0 % ngw + ngw) % ngw;
    for (int i = first; i < ntile; i += ngw) conv_tile(src, N, dst, ldd, (i / nnt) * 64, (i % nnt) * 64, rowadd, mode, t, lane);
    return tile0 + ntile;
}
__device__ __forceinline__ void conv_moe_layer(const Params& p, int layer, LAS unsigned char* lds) {
    const int tid = otid(), lane = tid & 63, wid = tid >> 6, gw = blockIdx.x * 8 + wid, ngw = gridDim.x * 8;
    LAS float* t = (LAS float*)(lds + wid * (64 * 65 * 4));
    bf16_t* GU = (bf16_t*)(p.ws + WS_GU); bf16_t* DN = (bf16_t*)(p.ws + WS_DN);
    int tile0 = 0;
    for (int e = 0; e < NEXP; ++e) {
        const size_t wo = ((size_t)layer * NEXP + e) * 1024 * 512;
        tile0 = conv_job(p.w_gate + wo, 1024, 512, 512, GU + (size_t)e * 1024 * 1024, 1024, 0, 1, tile0, t, gw, ngw, lane);
        tile0 = conv_job(p.w_up + wo, 1024, 512, 512, GU + (size_t)e * 1024 * 1024, 1024, 128, 1, tile0, t, gw, ngw, lane);
        tile0 = conv_job(p.w_down + wo, 512, 1024, 1024, DN + (size_t)e * 1024 * 512, 512, 0, 0, tile0, t, gw, ngw, lane);
    }
}
__device__ __forceinline__ void phase_prologue(const Params& p, LAS unsigned char* lds) {
    const int tid = otid(), lane = tid & 63, wid = tid >> 6, gw = blockIdx.x * 8 + wid, ngw = gridDim.x * 8;
    LAS float* t = (LAS float*)(lds + wid * (64 * 65 * 4));
    char* ws = p.ws;
    { const size_t n8 = (size_t)NTOK * 1024 / 8; bf16_t* xb = (bf16_t*)(ws + WS_XB);
      for (size_t i = (size_t)blockIdx.x * NTHREADS + tid; i < n8; i += (size_t)gridDim.x * NTHREADS) {
          const float4 a = *(const float4*)(p.x + i * 8), b = *(const float4*)(p.x + i * 8 + 4);
          u32x4 w; w.x = cvt_pk_bf16(a.x, a.y); w.y = cvt_pk_bf16(a.z, a.w); w.z = cvt_pk_bf16(b.x, b.y); w.w = cvt_pk_bf16(b.z, b.w);
          *(u32x4*)(xb + i * 8) = w; } }
    int tile0 = 0;
    tile0 = conv_job(p.moba_w_in, 1024, 3072, 3072, (bf16_t*)(ws + WS_WQKV0), 1024, 0, 0, tile0, t, gw, ngw, lane);
    tile0 = conv_job(p.moba_w_out, 1024, 1024, 1024, (bf16_t*)(ws + WS_WO0), 1024, 0, 0, tile0, t, gw, ngw, lane);
    tile0 = conv_job(p.nsa_w_in, 1024, 2608, 2816, (bf16_t*)(ws + WS_WIN1), 1024, 0, 0, tile0, t, gw, ngw, lane);
    tile0 = conv_job(p.nsa_w_out, 1024, 1024, 1024, (bf16_t*)(ws + WS_WO1), 1024, 0, 0, tile0, t, gw, ngw, lane);
    tile0 = conv_job(p.ck_w1, 2048, 256, 256, (bf16_t*)(ws + WS_W1T), 2048, 0, 0, tile0, t, gw, ngw, lane);
    tile0 = conv_job(p.cv_w1, 2048, 256, 256, (bf16_t*)(ws + WS_W1T) + 256 * 2048, 2048, 0, 0, tile0, t, gw, ngw, lane);
    conv_moe_layer(p, 0, lds);
    for (int i = blockIdx.x * NTHREADS + tid; i < 16 * BT_N; i += gridDim.x * NTHREADS) {
        const int h = i / BT_N, e = i % BT_N; int n = e - 63; n = n < 0 ? 0 : (n > 127 ? 127 : n);
        int bk = n;
        if (n >= 16) { bk = 16 + (int)(logf((float)n / 16.0f) / logf(8.0f) * 16.0f); bk = bk > 31 ? 31 : bk; }
        ((float*)(ws + WS_TAB))[i] = p.rel_bias[bk * 16 + h] * LOG2E; }
    if (blockIdx.x < 32) { const int kv = blockIdx.x >> 4, part = (blockIdx.x & 15) * 2 + (tid >> 8), j = tid & 255;
        const float* pos = kv ? p.pos_v : p.pos_k; const float* w1 = kv ? p.cv_w1 : p.ck_w1; float s = 0.f;
#pragma unroll 16
        for (int k = part * 64; k < part * 64 + 64; ++k) s += pos[k] * w1[(size_t)k * 256 + j];
        ((float*)(ws + WS_B1))[(kv * 32 + part) * 256 + j] = s; }
}

template <int VAR> __device__ __forceinline__ void moba_unit(const Params& p, LAS unsigned char* lds, int b, int h, int qb) {
    const int tid = otid(), lane = tid & 63, r32 = lane & 31, hi = lane >> 5; const int wid = __builtin_amdgcn_readfirstlane(tid >> 6);
    const bf16_t* QKV = (const bf16_t*)(p.ws + WS_BIG);
    const size_t rowbase = (size_t)b * SEQ; const int q0 = qb * 256, qw = q0 + wid * 32;
    const bf16_t* Kb = QKV + rowbase * QKV_LD + 1024 + h * 64; const bf16_t* Vb = QKV + rowbase * QKV_LD + 2048 + h * 64;
    bf16x8 qr[4];
    { const bf16_t* qp = QKV + (rowbase + qw + r32) * QKV_LD + h * 64 + hi * 8;
#pragma unroll
      for (int d0 = 0; d0 < 4; ++d0) qr[d0] = *(const bf16x8*)(qp + d0 * 16); }
    __syncthreads();
    { const float* kp = (const float*)(p.ws + WS_KPART); const int j = tid >> 6, d = tid & 63;
      const float* s = kp + ((size_t)(b * 8 + j) * 2) * 1024 + h * 64 + d;
      ((LAS float*)(lds + AL_KM))[tid] = s[0] + s[1024];
      if (tid < BT_N) ((LAS float*)(lds + AL_BIAS))[tid] = ((const float*)(p.ws + WS_TAB))[h * BT_N + tid]; }
    const int NT = 4 + 4 * qb;
    __syncthreads();
    unsigned sel = 0;
    { float g[8];
#pragma unroll
      for (int j = 0; j < 8; ++j) { float s = 0.f; const LAS float* km = (const LAS float*)(lds + AL_KM) + j * 64 + hi * 8;
#pragma unroll
          for (int d0 = 0; d0 < 4; ++d0)
#pragma unroll
              for (int i = 0; i < 8; ++i) s += bf2f((bf16_t)qr[d0][i]) * km[d0 * 16 + i];
          g[j] = xhalf_sum(s); }
#pragma unroll
      for (int round = 0; round < 3; ++round) { int best = -1; float bv = 0.f;
#pragma unroll
          for (int j = 0; j < 8; ++j) { const bool ok = (j < qb) && !((sel >> j) & 1u) && (best < 0 || g[j] > bv); if (ok) { best = j; bv = g[j]; } }
          if (best >= 0) sel |= 1u << best; } }
    const LAS float* btab = (const LAS float*)(lds + AL_BIAS); const float cfar = btab[BT_N - 1];
    FState st; fstate_reset(st);
    struct MobaSrc {
        const bf16_t *Kb, *Vb; LAS unsigned char* lds; int qb, qw, wid, lane; unsigned sel;
        __device__ __forceinline__ void tile(int t, int& blk, int& kt) const { blk = t < 4 ? qb : qb - 1 - ((t - 4) >> 2); kt = t < 4 ? t : ((t - 4) & 3); }
        __device__ __forceinline__ void dma(int t, int ks, int vs) const { int blk, kt; tile(t, blk, kt); const size_t key0 = (size_t)blk * 256 + kt * 64;
            dma_k(Kb + key0 * QKV_LD, QKV_LD, lds, ks, wid, lane); dma_v(Vb + key0 * QKV_LD, QKV_LD, lds, vs, wid, lane); }
        __device__ __forceinline__ TileP params(int t) const { int blk, kt; tile(t, blk, kt); TileP tp; tp.Dmin = qw - (blk * 256 + kt * 64); tp.win = false;
            if (blk == qb) { tp.rowok = true; tp.run = (64 * kt <= wid * 32 + 31); } else { tp.rowok = (sel >> blk) & 1u; tp.run = __any(tp.rowok); }
            return tp; }
        __device__ __forceinline__ void after(int, FState&) const {}
    } S{Kb, Vb, lds, qb, qw, wid, lane, sel};
    attn_stream<VAR>(S, NT, st, qr, lds, btab, cfar, wid, lane, r32, hi);
    const float inv = 1.0f / xhalf_sum(st.l);
    bf16_t* op = (bf16_t*)(p.ws + (VAR ? WS_X1B : WS_AOH)) + (rowbase + qw + r32) * 1024 + h * 64 + 4 * hi;
#pragma unroll
    for (int g4 = 0; g4 < 4; ++g4) {
        u32x2 w0, w1; w0.x = cvt_pk_bf16(st.o0[4 * g4] * inv, st.o0[4 * g4 + 1] * inv); w0.y = cvt_pk_bf16(st.o0[4 * g4 + 2] * inv, st.o0[4 * g4 + 3] * inv);
        w1.x = cvt_pk_bf16(st.o1[4 * g4] * inv, st.o1[4 * g4 + 1] * inv); w1.y = cvt_pk_bf16(st.o1[4 * g4 + 2] * inv, st.o1[4 * g4 + 3] * inv);
        *(u32x2*)(op + 8 * g4) = w0; *(u32x2*)(op + 32 + 8 * g4) = w1; }
}
template <int VAR> __device__ __forceinline__ void phase_moba(const Params& p, LAS unsigned char* lds) {
    for (int pr = blockIdx.x, rnd = 0; pr < 1024; pr += gridDim.x, ++rnd) { const int x = blockIdx.x & 7, s = blockIdx.x >> 3; const int bh = (gridDim.x == 256) ? (x + 8 * (rnd * 8 + (s >> 2))) : (pr >> 2), j = (gridDim.x == 256) ? (s & 3) : (pr & 3);
        moba_unit<VAR>(p, lds, bh >> 4, bh & 15, 7 - j);
        moba_unit<VAR>(p, lds, bh >> 4, bh & 15, j); }
    __syncthreads();
}

__device__ __forceinline__ void nsa_unit(const Params& p, LAS unsigned char* lds, int b, int hkv, int c) {
    const int tid = otid(), lane = tid & 63, r32 = lane & 31, hi = lane >> 5; const int wid = __builtin_amdgcn_readfirstlane(tid >> 6);
    const bf16_t* P = (const bf16_t*)(p.ws + WS_BIG);
    const size_t rowbase = (size_t)b * SEQ; const int g = wid >> 1, qq0 = (wid & 1) * 32, h = hkv * 4 + g, qw = c * 64 + qq0, qpos = qw + r32;
    bf16x8 qr[4];
    const bf16_t* rowp = P + (rowbase + qpos) * NSA_LD;
#pragma unroll
    for (int d0 = 0; d0 < 4; ++d0) qr[d0] = *(const bf16x8*)(rowp + h * 64 + hi * 8 + d0 * 16);
    const float g0 = bf2f(rowp[NSA_G + h * 3]), g1 = bf2f(rowp[NSA_G + h * 3 + 1]), g2 = bf2f(rowp[NSA_G + h * 3 + 2]);
    __syncthreads();
    for (int i = tid; i < 4 * BT_N; i += NTHREADS) ((LAS float*)(lds + AL_BIAS))[i] = ((const float*)(p.ws + WS_TAB))[hkv * 4 * BT_N + i];
    if (tid < 64) ((LAS unsigned*)(lds + AL_SEL))[tid] = 0u;
    { const bf16_t* kc = (const bf16_t*)(p.ws + WS_KCMP) + (size_t)(b * 4 + hkv) * 128 * 64; const bf16_t* vc = (const bf16_t*)(p.ws + WS_VCMP) + (size_t)(b * 4 + hkv) * 128 * 64;
      dma_k(kc, 64, lds, 0, wid, lane); dma_k(kc + 64 * 64, 64, lds, 1, wid, lane); dma_v(vc, 64, lds, 0, wid, lane); dma_v(vc + 64 * 64, 64, lds, 1, wid, lane); }
    asm volatile("s_waitcnt vmcnt(0)" ::: "memory");
    __syncthreads();
    const lds_cptr kp0 = (lds_cptr)lds + AL_K + r32 * 128; const int kx = (r32 & 7) | (hi << 3);
    const lds_cptr vp0 = (lds_cptr)lds + AL_V + ((lane >> 4) & 1) * 32 + (lane & 3) * 8 + (4 * hi + ((lane & 15) >> 2)) * 64;
    f32x16 cb0, cb1;
    {
        f32x16 s[2][2];
        const int nlim = (qpos >= 31 ? ((qpos - 31) >> 4) + 1 : 0) - 4 * hi;
#pragma unroll
        for (int t = 0; t < 2; ++t) {
#pragma unroll
            for (int r = 0; r < 16; ++r) { s[t][0][r] = 0.f; s[t][1][r] = 0.f; }
            qk_tile(s[t][0], s[t][1], qr, kp0 + t * 8192, kx);
#pragma unroll
            for (int n2 = 0; n2 < 2; ++n2)
#pragma unroll
                for (int r = 0; r < 16; ++r) { const int nk = 64 * t + 32 * n2 + (r & 3) + 8 * (r >> 2); if (nk >= nlim) s[t][n2][r] = -INFINITY; }
        }
        const float mx = xhalf_max(__builtin_fmaxf(__builtin_fmaxf(max16(s[0][0]), max16(s[0][1])), __builtin_fmaxf(max16(s[1][0]), max16(s[1][1]))));
        const float mref = (mx == -INFINITY) ? 0.f : mx;
        float rs = 0.f;
#pragma unroll
        for (int t = 0; t < 2; ++t)
#pragma unroll
            for (int n2 = 0; n2 < 2; ++n2)
#pragma unroll
                for (int r = 0; r < 16; ++r) { const float e = __builtin_amdgcn_exp2f(s[t][n2][r] - mref); s[t][n2][r] = e; rs += e; }
        const float lt = xhalf_sum(rs); const float inv = lt > 0.f ? 1.0f / lt : 0.f;
#pragma unroll
        for (int t = 0; t < 2; ++t)
#pragma unroll
            for (int n2 = 0; n2 < 2; ++n2)
#pragma unroll
                for (int r = 0; r < 16; ++r) s[t][n2][r] *= inv;
        float Q[16], T[16];
#pragma unroll
        for (int t = 0; t < 2; ++t)
#pragma unroll
            for (int n2 = 0; n2 < 2; ++n2)
#pragma unroll
                for (int r4 = 0; r4 < 4; ++r4) { const int u = 8 * t + 4 * n2 + r4; Q[u] = (s[t][n2][4 * r4] + s[t][n2][4 * r4 + 1]) + (s[t][n2][4 * r4 + 2] + s[t][n2][4 * r4 + 3]); T[u] = s[t][n2][4 * r4 + 3]; }
        LAS float* imp = (LAS float*)(lds + AL_IMP) + (g * 64 + qq0 + r32) * 33;
        float prev = 0.f;
#pragma unroll
        for (int u = 0; u < 16; ++u) { const float rcv = __shfl_xor(T[u], 32); const float add = hi ? rcv : prev; prev = rcv; imp[2 * u + hi] = Q[u] + add; }
        f32x16 o0, o1;
#pragma unroll
        for (int r = 0; r < 16; ++r) { o0[r] = 0.f; o1[r] = 0.f; }
        pv_tile(o0, o1, s[0][0], s[0][1], vp0); pv_tile(o0, o1, s[1][0], s[1][1], vp0 + 8192);
#pragma unroll
        for (int r = 0; r < 16; ++r) { cb0[r] = g0 * o0[r]; cb1[r] = g0 * o1[r]; }
    }
    __syncthreads();
    {
        const int q = tid >> 3, jg = tid & 7; const LAS float* ib = (const LAS float*)(lds + AL_IMP) + q * 33;
        float val[32];
#pragma unroll
        for (int j = 0; j < 32; ++j) { float v = (ib[j] + ib[64 * 33 + j]) + (ib[2 * 64 * 33 + j] + ib[3 * 64 * 33 + j]);
            const bool forced = (j == 0) || (j == c) || (j == c - 1); v = forced ? INFINITY : v; val[j] = (j > c) ? -INFINITY : v; }
        unsigned bits = 0;
#pragma unroll
        for (int i = 0; i < 4; ++i) { const int j = jg * 4 + i; float vj = 0.f;
#pragma unroll
            for (int jj = 0; jj < 32; ++jj) vj = (jj == j) ? val[jj] : vj;
            int rank = 0;
#pragma unroll
            for (int jj = 0; jj < 32; ++jj) rank += (val[jj] > vj || (val[jj] == vj && jj < j)) ? 1 : 0;
            if (j <= c && rank < 16) bits |= 1u << j; }
        if (bits) atomicOr((unsigned*)(lds + AL_SEL) + q, bits);
    }
    __syncthreads();
    LAS float* stash = (LAS float*)(lds + AL_IMP) + wid * 2048 + lane;
#pragma unroll
    for (int r = 0; r < 16; ++r) { stash[r * 64] = cb0[r]; stash[(16 + r) * 64] = cb1[r]; }
    unsigned uni = ((const LAS unsigned*)(lds + AL_SEL))[lane];
#pragma unroll
    for (int o = 32; o > 0; o >>= 1) uni |= (unsigned)__shfl_xor((int)uni, o);
    uni = (unsigned)__builtin_amdgcn_readfirstlane((int)uni);
    const unsigned rowmask = ((const LAS unsigned*)(lds + AL_SEL))[qq0 + r32];
    const LAS float* btab = (const LAS float*)(lds + AL_BIAS) + g * BT_N; const float cfar = btab[BT_N - 1];
    const bf16_t* KS = P + rowbase * NSA_LD + NSA_KS + hkv * 64; const bf16_t* VS = P + rowbase * NSA_LD + NSA_VS + hkv * 64;
    const bf16_t* KW = P + rowbase * NSA_LD + NSA_KW + hkv * 64; const bf16_t* VW = P + rowbase * NSA_LD + NSA_VW + hkv * 64;
    const int nslc = __builtin_popcount(uni); const int wlo = c >= 8 ? 0 : 8 - c; const int NT = nslc + (9 - wlo);
    LAS int* list = (LAS int*)(lds + AL_LIST);
    if (tid < 32) { if ((uni >> tid) & 1u) list[__builtin_popcount(uni & ((1u << tid) - 1u))] = tid; }
    else if (tid < 32 + 9 - wlo) list[nslc + (tid - 32)] = 64 + (c - 8 + wlo + (tid - 32));
    __syncthreads();
    FState st; fstate_reset(st);
    struct NsaSrc {
        const bf16_t *KS, *VS, *KW, *VW; LAS unsigned char* lds; const LAS int* list; int nslc, qw, wid, lane; unsigned rowmask; float g1; LAS float* stash;
        __device__ __forceinline__ void dma(int t, int ks, int vs) const { const int e = __builtin_amdgcn_readfirstlane(list[t]);
            if (e < 64) { dma_k(KS + (size_t)e * 64 * NSA_LD, NSA_LD, lds, ks, wid, lane); dma_v(VS + (size_t)e * 64 * NSA_LD, NSA_LD, lds, vs, wid, lane); }
            else { dma_k(KW + (size_t)(e - 64) * 64 * NSA_LD, NSA_LD, lds, ks, wid, lane); dma_v(VW + (size_t)(e - 64) * 64 * NSA_LD, NSA_LD, lds, vs, wid, lane); } }
        __device__ __forceinline__ TileP params(int t) const { const int e = __builtin_amdgcn_readfirstlane(list[t]); TileP tp;
            if (e < 64) { tp.Dmin = qw - 64 * e; tp.rowok = (rowmask >> e) & 1u; tp.run = __any(tp.rowok); tp.win = false; }
            else { tp.Dmin = qw - 64 * (e - 64); tp.rowok = true; tp.run = true; tp.win = true; }
            return tp; }
        __device__ __forceinline__ void after(int t, FState& st) const {
            if (t == nslc - 1) { const float f = g1 / xhalf_sum(st.l);
#pragma unroll
                for (int r = 0; r < 16; ++r) { stash[r * 64] += f * st.o0[r]; stash[(16 + r) * 64] += f * st.o1[r]; }
                fstate_reset(st); } }
    } S{KS, VS, KW, VW, lds, list, nslc, qw, wid, lane, rowmask, g1, stash};
    attn_stream<0>(S, NT, st, qr, lds, btab, cfar, wid, lane, r32, hi);
    { const float f = g2 / xhalf_sum(st.l);
#pragma unroll
      for (int r = 0; r < 16; ++r) { cb0[r] = stash[r * 64] + f * st.o0[r]; cb1[r] = stash[(16 + r) * 64] + f * st.o1[r]; } }
    bf16_t* op = (bf16_t*)(p.ws + WS_AOH) + (rowbase + qpos) * 1024 + h * 64 + 4 * hi;
#pragma unroll
    for (int g4 = 0; g4 < 4; ++g4) {
        u32x2 w0, w1; w0.x = cvt_pk_bf16(cb0[4 * g4], cb0[4 * g4 + 1]); w0.y = cvt_pk_bf16(cb0[4 * g4 + 2], cb0[4 * g4 + 3]);
        w1.x = cvt_pk_bf16(cb1[4 * g4], cb1[4 * g4 + 1]); w1.y = cvt_pk_bf16(cb1[4 * g4 + 2], cb1[4 * g4 + 3]);
        *(u32x2*)(op + 8 * g4) = w0; *(u32x2*)(op + 32 + 8 * g4) = w1; }
}
__device__ __forceinline__ void phase_nsa(const Params& p, LAS unsigned char* lds) {
    for (int pr = blockIdx.x, rnd = 0; pr < 1024; pr += gridDim.x, ++rnd) { const int x = blockIdx.x & 7, s = blockIdx.x >> 3; const int bh = (gridDim.x == 256) ? (x + 8 * (rnd * 2 + (s >> 4))) : (pr >> 4), j = (gridDim.x == 256) ? (s & 15) : (pr & 15);
        nsa_unit(p, lds, bh >> 2, bh & 3, 31 - j);
        nsa_unit(p, lds, bh >> 2, bh & 3, j); }
    __syncthreads();
}

template <int L> __device__ __forceinline__ void phase_ln1(const Params& p, LAS unsigned char* lds) {
    const int tid = otid(), lane = tid & 63, wid = tid >> 6, r = lane & 15, q = lane >> 4;
    const float* lg = p.ln_g + (L * 2 + 0) * 1024; const float* lb = p.ln_b + (L * 2 + 0) * 1024;
    const bf16_t* Y = (const bf16_t*)(p.ws + WS_BIG); bf16_t* X1 = (bf16_t*)(p.ws + WS_X1B);
    for (int i = tid; i < 32 * 2 * 64; i += NTHREADS) { const int l2 = i & 63, nb = (i >> 6) & 1, s = i >> 7; const int e = 16 * nb + (l2 & 15), k0 = 32 * s + 8 * (l2 >> 4);
        float w[8]; unsigned hw[4], lw[4];
#pragma unroll
        for (int j = 0; j < 8; ++j) w[j] = p.router_w[(size_t)(k0 + j) * 32 + e];
#pragma unroll
        for (int j = 0; j < 4; ++j) { hw[j] = cvt_pk_bf16(w[2 * j], w[2 * j + 1]); lw[j] = cvt_pk_bf16(w[2 * j] - lo_bf(hw[j]), w[2 * j + 1] - hi_bf(hw[j])); }
        *(LAS u32x4*)(lds + ((size_t)((s * 2 + nb) * 2 + 0) * 64 + l2) * 16) = (u32x4){hw[0], hw[1], hw[2], hw[3]};
        *(LAS u32x4*)(lds + ((size_t)((s * 2 + nb) * 2 + 1) * 64 + l2) * 16) = (u32x4){lw[0], lw[1], lw[2], lw[3]}; }
    LAS int* hist = (LAS int*)(lds + 131072 + 8 * 2048);
    if (tid < 32) hist[tid] = 0;
    __syncthreads();
    for (int tb = blockIdx.x; tb < NTOK / 128; tb += gridDim.x) {
        const int tok = tb * 128 + wid * 16 + r;
        const bf16_t* yp = Y + (size_t)tok * 1024 + 8 * q;
        float sum = 0.f, sq = 0.f;
#pragma unroll 8
        for (int s = 0; s < 32; ++s) { const u32x4 y = *(const u32x4*)(yp + 32 * s); const unsigned yw[4] = {y.x, y.y, y.z, y.w};
#pragma unroll
            for (int j = 0; j < 4; ++j) { const float a = lo_bf(yw[j]), b2 = hi_bf(yw[j]); sum += a + b2; sq += a * a + b2 * b2; } }
        sum += __shfl_xor(sum, 16); sum += __shfl_xor(sum, 32); sq += __shfl_xor(sq, 16); sq += __shfl_xor(sq, 32);
        const float mu = sum * (1.0f / 1024.0f);
        const float rstd = rsqrtf(fmaxf(sq * (1.0f / 1024.0f) - mu * mu, 0.f) + 1e-5f);
        f32x4 acc0 = (f32x4){0.f, 0.f, 0.f, 0.f}, acc1 = acc0;
        bf16_t* xp = X1 + (size_t)tok * 1024 + 8 * q;
#pragma unroll 2
        for (int s = 0; s < 32; ++s) {
            const u32x4 y = *(const u32x4*)(yp + 32 * s);
            const f32x4 ga = *(const f32x4*)(lg + 32 * s + 8 * q), gb = *(const f32x4*)(lg + 32 * s + 8 * q + 4), ba = *(const f32x4*)(lb + 32 * s + 8 * q), bb = *(const f32x4*)(lb + 32 * s + 8 * q + 4);
            u32x4 w;
            w.x = cvt_pk_bf16((lo_bf(y.x) - mu) * rstd * ga[0] + ba[0], (hi_bf(y.x) - mu) * rstd * ga[1] + ba[1]);
            w.y = cvt_pk_bf16((lo_bf(y.y) - mu) * rstd * ga[2] + ba[2], (hi_bf(y.y) - mu) * rstd * ga[3] + ba[3]);
            w.z = cvt_pk_bf16((lo_bf(y.z) - mu) * rstd * gb[0] + bb[0], (hi_bf(y.z) - mu) * rstd * gb[1] + bb[1]);
            w.w = cvt_pk_bf16((lo_bf(y.w) - mu) * rstd * gb[2] + bb[2], (hi_bf(y.w) - mu) * rstd * gb[3] + bb[3]);
            *(u32x4*)(xp + 32 * s) = w;
            const bf16x8 af = __builtin_bit_cast(bf16x8, w);
            const LAS unsigned char* bq = lds + (size_t)s * 4096 + lane * 16;
            const bf16x8 b0h = *(const LAS bf16x8*)(bq), b0l = *(const LAS bf16x8*)(bq + 1024), b1h = *(const LAS bf16x8*)(bq + 2048), b1l = *(const LAS bf16x8*)(bq + 3072);
            acc0 = __builtin_amdgcn_mfma_f32_16x16x32_bf16(af, b0h, acc0, 0, 0, 0); acc0 = __builtin_amdgcn_mfma_f32_16x16x32_bf16(af, b0l, acc0, 0, 0, 0);
            acc1 = __builtin_amdgcn_mfma_f32_16x16x32_bf16(af, b1h, acc1, 0, 0, 0); acc1 = __builtin_amdgcn_mfma_f32_16x16x32_bf16(af, b1l, acc1, 0, 0, 0);
        }
        LAS float* lg2 = (LAS float*)(lds + 131072 + wid * 2048);
#pragma unroll
        for (int i = 0; i < 4; ++i) { lg2[(4 * q + i) * 32 + r] = acc0[i] + p.router_b[r]; lg2[(4 * q + i) * 32 + 16 + r] = acc1[i] + p.router_b[16 + r]; }
        asm volatile("s_waitcnt lgkmcnt(0)" ::: "memory");
        if (lane < 16) {
            float pr[32]; float mx = -INFINITY;
#pragma unroll
            for (int e = 0; e < 32; ++e) { pr[e] = lg2[lane * 32 + e]; mx = fmaxf(mx, pr[e]); }
#pragma unroll
            for (int e = 0; e < 32; ++e) pr[e] = __expf(pr[e] - mx);
            int best = 0; float bs = -1.f;
#pragma unroll
            for (int gi = 0; gi < 8; ++gi) { const float a = pr[4 * gi], b2 = pr[4 * gi + 1], c2 = pr[4 * gi + 2], d2 = pr[4 * gi + 3];
                const float h1 = fmaxf(a, b2), l1 = fminf(a, b2), h2 = fmaxf(c2, d2), l2 = fminf(c2, d2);
                const float m1 = fmaxf(h1, h2), m2 = fmaxf(fminf(h1, h2), fmaxf(l1, l2));
                const float sc = m1 + m2; if (sc > bs) { bs = sc; best = gi; } }
            float v[4];
#pragma unroll
            for (int gi = 0; gi < 8; ++gi) if (gi == best) { v[0] = pr[4 * gi]; v[1] = pr[4 * gi + 1]; v[2] = pr[4 * gi + 2]; v[3] = pr[4 * gi + 3]; }
            int i0 = 0; float v0 = v[0];
#pragma unroll
            for (int i = 1; i < 4; ++i) if (v[i] > v0) { v0 = v[i]; i0 = i; }
            int i1 = -1; float v1 = -1.f;
#pragma unroll
            for (int i = 0; i < 4; ++i) if (i != i0 && v[i] > v1) { v1 = v[i]; i1 = i; }
            const int t2 = tb * 128 + wid * 16 + lane; const int e0 = best * 4 + i0, e1 = best * 4 + i1; const float ws = 1.0f / (v0 + v1);
            ((int*)(p.ws + WS_RE))[t2 * 2] = e0; ((int*)(p.ws + WS_RE))[t2 * 2 + 1] = e1;
            ((float*)(p.ws + WS_RWT))[t2 * 2] = v0 * ws; ((float*)(p.ws + WS_RWT))[t2 * 2 + 1] = v1 * ws;
            atomicAdd((int*)hist + e0, 1); atomicAdd((int*)hist + e1, 1);
        }
        __syncthreads();
        if (tid < 32) { ((int*)(p.ws + WS_HIST))[tb * 32 + tid] = hist[tid]; hist[tid] = 0; }
        __syncthreads();
    }
}

__device__ __forceinline__ void phase_scatter(const Params& p, LAS unsigned char* lds) {
    const int tid = otid();
    LAS int* cnt = (LAS int*)lds; LAS int* pre = cnt + 32; LAS int* pst = cnt + 64; LAS int* earr = cnt + 128;
    const int* HIST = (const int*)(p.ws + WS_HIST); const int* RE = (const int*)(p.ws + WS_RE);
    int* ROWTOK = (int*)(p.ws + WS_ROWTOK); int* POS = (int*)(p.ws + WS_POS);
    for (int tb = blockIdx.x; tb < NTOK / 128; tb += gridDim.x) {
        __syncthreads();
        if (tid < 32) { int c = 0, pr = 0; for (int g = 0; g < NTOK / 128; ++g) { const int hv = HIST[g * 32 + tid]; c += hv; pr += (g < tb) ? hv : 0; } cnt[tid] = c; pre[tid] = pr; }
        if (tid < 256) earr[tid] = RE[tb * 256 + tid];
        __syncthreads();
        if (tid == 0) { int s = 0; for (int e = 0; e < 32; ++e) { pst[e] = s; s += (cnt[e] + 255) & ~255; } pst[32] = s; }
        __syncthreads();
        if (tid < 256) { const int e = earr[tid]; int rank = 0; for (int a = 0; a < tid; ++a) rank += (earr[a] == e) ? 1 : 0;
            const int slot = pst[e] + pre[e] + rank; ROWTOK[slot] = tb * 128 + (tid >> 1); POS[tb * 256 + tid] = slot; }
        if (tb < 32) { const int e = tb; const int c = cnt[e], pc = (c + 255) & ~255; for (int i = c + tid; i < pc; i += NTHREADS) ROWTOK[pst[e] + i] = 0; }
        if (tb == 0) { for (int e = 0; e < 32; ++e) { const int np = ((cnt[e] + 255) >> 8), p0 = pst[e] >> 8; for (int i = tid; i < np; i += NTHREADS) ((int*)(p.ws + WS_PANEL))[p0 + i] = e; }
            if (tid == 0) *(int*)(p.ws + WS_NPAN) = pst[32] >> 8; }
    }
}

template <int L> __device__ __forceinline__ void phase_ln2(const Params& p) {
    const int tid = otid(), lane = tid & 63, wid = tid >> 6;
    const float* lg = p.ln_g + (L * 2 + 1) * 1024; const float* lb = p.ln_b + (L * 2 + 1) * 1024;
    const bf16_t* X1 = (const bf16_t*)(p.ws + WS_X1B); const bf16_t* YB = (const bf16_t*)(p.ws + WS_BIG);
    const int* POS = (const int*)(p.ws + WS_POS); const float* RW = (const float*)(p.ws + WS_RWT);
    for (int tok = blockIdx.x * 8 + wid; tok < NTOK; tok += gridDim.x * 8) {
        const int s0 = POS[tok * 2], s1 = POS[tok * 2 + 1]; const float w0 = RW[tok * 2], w1 = RW[tok * 2 + 1];
        float v[16];
#pragma unroll
        for (int hf = 0; hf < 2; ++hf) { const int c0 = hf * 512 + lane * 8;
            const u32x4 a = *(const u32x4*)(X1 + (size_t)tok * 1024 + c0), b = *(const u32x4*)(YB + (size_t)s0 * 1024 + c0), c = *(const u32x4*)(YB + (size_t)s1 * 1024 + c0);
            const unsigned aw[4] = {a.x, a.y, a.z, a.w}, bw[4] = {b.x, b.y, b.z, b.w}, cw[4] = {c.x, c.y, c.z, c.w};
#pragma unroll
            for (int j = 0; j < 4; ++j) { v[hf * 8 + 2 * j] = ALPHA * lo_bf(aw[j]) + w0 * lo_bf(bw[j]) + w1 * lo_bf(cw[j]); v[hf * 8 + 2 * j + 1] = ALPHA * hi_bf(aw[j]) + w0 * hi_bf(bw[j]) + w1 * hi_bf(cw[j]); } }
        float s = 0.f;
#pragma unroll
        for (int i = 0; i < 16; ++i) s += v[i];
        const float mu = wave_sum(s) * (1.0f / 1024.0f);
        float qv = 0.f;
#pragma unroll
        for (int i = 0; i < 16; ++i) { const float d = v[i] - mu; qv += d * d; }
        const float rstd = rsqrtf(wave_sum(qv) * (1.0f / 1024.0f) + 1e-5f);
#pragma unroll
        for (int hf = 0; hf < 2; ++hf) { const int c0 = hf * 512 + lane * 8; float o[8];
            const f32x4 ga = *(const f32x4*)(lg + c0), gb = *(const f32x4*)(lg + c0 + 4), ba = *(const f32x4*)(lb + c0), bb = *(const f32x4*)(lb + c0 + 4);
#pragma unroll
            for (int j = 0; j < 4; ++j) { o[j] = (v[hf * 8 + j] - mu) * rstd * ga[j] + ba[j]; o[4 + j] = (v[hf * 8 + 4 + j] - mu) * rstd * gb[j] + bb[j]; }
            if (L == 1) { *(f32x4*)(p.out + (size_t)tok * 1024 + c0) = (f32x4){o[0], o[1], o[2], o[3]}; *(f32x4*)(p.out + (size_t)tok * 1024 + c0 + 4) = (f32x4){o[4], o[5], o[6], o[7]}; }
            else { u32x4 w; w.x = cvt_pk_bf16(o[0], o[1]); w.y = cvt_pk_bf16(o[2], o[3]); w.z = cvt_pk_bf16(o[4], o[5]); w.w = cvt_pk_bf16(o[6], o[7]); *(u32x4*)((bf16_t*)(p.ws + WS_XB) + (size_t)tok * 1024 + c0) = w; } }
    }
}

__device__ __forceinline__ void phase_cmpfin(const Params& p, LAS unsigned char* lds) {
    const int tid = otid(), lane = tid & 63, wid = tid >> 6;
    LAS float* w2s = (LAS float*)lds;
    LAS float* hs = (LAS float*)(lds + 65536) + wid * 1024;
    LAS float* b1s = (LAS float*)(lds + 65536 + 32768);
    const float* CP = (const float*)(p.ws + WS_X1B); const float* B1 = (const float*)(p.ws + WS_B1);
    for (int kv = 0; kv < 2; ++kv) {
        __syncthreads();
        { const float* w2g = kv ? p.cv_w2 : p.ck_w2; for (int i = tid; i < 256 * 64; i += NTHREADS) w2s[i] = w2g[i]; }
        if (tid < 256) { float b1 = 0.f;
#pragma unroll 8
            for (int pt = 0; pt < 32; ++pt) b1 += B1[(kv * 32 + pt) * 256 + tid];
            b1s[tid] = b1; }
        __syncthreads();
        bf16_t* dst = (bf16_t*)(p.ws + (kv ? WS_VCMP : WS_KCMP));
        for (int rg = blockIdx.x * 8 + wid; rg < 8192 / 4; rg += gridDim.x * 8) {
            const int m0 = rg * 4;
#pragma unroll
            for (int i = 0; i < 4; ++i) { const int j = lane + 64 * i; const float b1 = b1s[j];
                f32x4 hv;
#pragma unroll
                for (int rr = 0; rr < 4; ++rr) { float a = b1;
#pragma unroll
                    for (int ks = 0; ks < 4; ++ks) a += CP[((size_t)(kv * 4 + ks) * 8192 + m0 + rr) * 256 + j];
                    const float u = 0.7978845608028654f * (a + 0.044715f * a * a * a); const float th = 1.0f - 2.0f / (1.0f + __expf(2.0f * u));
                    hv[rr] = 0.5f * a * (1.0f + th); }
                *(LAS f32x4*)(hs + j * 4) = hv; }
            asm volatile("s_waitcnt lgkmcnt(0)" ::: "memory");
            f32x4 o = (f32x4){0.f, 0.f, 0.f, 0.f}; const LAS float* w2 = w2s + lane;
#pragma unroll 8
            for (int j = 0; j < 256; ++j) o += *(const LAS f32x4*)(hs + j * 4) * w2[j * 64];
#pragma unroll
            for (int rr = 0; rr < 4; ++rr) dst[(size_t)(m0 + rr) * 64 + lane] = f2bf((((m0 + rr) & 127) == 127) ? 0.f : o[rr]);
            asm volatile("s_waitcnt lgkmcnt(0)" ::: "memory");
        }
    }
}

constexpr int NPHASE = 19;
template <int PH> __device__ __forceinline__ void run_phase(const Params& p, LAS unsigned char* lds) {
    char* ws = p.ws;
    if constexpr (PH == 0) phase_prologue(p, lds);
    else if constexpr (PH == 1) { SchedPlain S; S.init(ws + WS_XB, ws + WS_WQKV0, NTOK, 3072, 1024); EpiQKV0 E{(bf16_t*)(ws + WS_BIG), (float*)(ws + WS_KPART)}; pg8::gemm_phase(lds, S, E); }
    else if constexpr (PH == 2) phase_moba<0>(p, lds);
    else if constexpr (PH == 3) { SchedPlain S; S.init(ws + WS_AOH, ws + WS_WO0, NTOK, 1024, 1024); EpiRes<true> E{(bf16_t*)(ws + WS_BIG), p.x, nullptr}; pg8::gemm_phase(lds, S, E); }
    else if constexpr (PH == 4) phase_ln1<0>(p, lds);
    else if constexpr (PH == 5 || PH == 15) phase_scatter(p, lds);
    else if constexpr (PH == 6 || PH == 16) { SchedMoeGU S; S.init(ws); EpiGU E{(bf16_t*)(ws + WS_AOH)}; pg8::gemm_phase(lds, S, E); }
    else if constexpr (PH == 7 || PH == 17) { SchedMoeDN S; S.init(ws); EpiDN E{(bf16_t*)(ws + WS_BIG)}; pg8::gemm_phase(lds, S, E); }
    else if constexpr (PH == 8) { phase_ln2<0>(p); conv_moe_layer(p, 1, lds); }
    else if constexpr (PH == 9) { SchedPlain S; S.init(ws + WS_XB, ws + WS_WIN1, NTOK, 2816, 1024); EpiNSA E{(bf16_t*)(ws + WS_BIG)}; pg8::gemm_phase(lds, S, E); }
    else if constexpr (PH == 10) { SchedCmp S; S.init(ws); EpiCmp E{(float*)(ws + WS_X1B)}; pg8::gemm_phase(lds, S, E); }
    else if constexpr (PH == 11) phase_cmpfin(p, lds);
    else if constexpr (PH == 12) phase_nsa(p, lds);
    else if constexpr (PH == 13) { SchedPlain S; S.init(ws + WS_AOH, ws + WS_WO1, NTOK, 1024, 1024); EpiRes<false> E{(bf16_t*)(ws + WS_BIG), nullptr, (const bf16_t*)(ws + WS_XB)}; pg8::gemm_phase(lds, S, E); }
    else if constexpr (PH == 14) phase_ln1<1>(p, lds);
    else if constexpr (PH == 18) phase_ln2<1>(p);
}

extern __shared__ __attribute__((aligned(16))) unsigned char g_smem[];

template <int PH> __global__ void __launch_bounds__(NTHREADS, 2) k_phase(Params p) {
    run_phase<PH>(p, (LAS unsigned char*)g_smem);
}

#if !MK_LAUNCHES
template <int PH> __device__ __forceinline__ void mega_seq(const Params& p, LAS unsigned char* lds, const XcdBarrier& bar) {
    run_phase<PH>(p, lds);
#ifdef PROBE_VAR
    if constexpr (PH == 2) { xcd_barrier(bar); phase_moba<PROBE_VAR>(p, lds); }
#endif
#ifdef PROBE_MASK
    if constexpr ((PROBE_MASK >> PH) & 1) { xcd_barrier(bar); run_phase<PH>(p, lds); }
#endif
    if constexpr (PH + 1 < NPHASE) { xcd_barrier(bar); mega_seq<PH + 1>(p, lds, bar); }
}
__global__ void __launch_bounds__(NTHREADS, 2) k_mega(Params p) {
    LAS unsigned char* lds = (LAS unsigned char*)g_smem;
    LAS unsigned* stw = (LAS unsigned*)(lds + LDS_BYTES - 16);
    if (threadIdx.x == 0) { stw[0] = 0u; stw[1] = 0u; stw[2] = 0u; stw[3] = 0u; }
    __syncthreads();
    XcdBarrier bar = xcd_barrier_post((unsigned*)(p.ws + WS_CTL), (volatile LAS unsigned*)stw);
    mega_seq<0>(p, lds, bar);
}

#endif
template <int PH> static void launch_phases(const Params& p, int grid, hipStream_t stream) {
    hipFuncSetAttribute((const void*)k_phase<PH>, hipFuncAttributeMaxDynamicSharedMemorySize, LDS_BYTES);
    hipLaunchKernelGGL(k_phase<PH>, dim3(grid), dim3(NTHREADS), LDS_BYTES, stream, p);
    if constexpr (PH + 1 < NPHASE) launch_phases<PH + 1>(p, grid, stream);
}

extern "C" void kernel_launch(void* const* d_in, const int* in_sizes, int n_in, void* d_out, int out_size, void* d_ws, size_t ws_size, hipStream_t stream) {
    if (n_in != 19 || ws_size < WS_END) { fprintf(stderr, "kernel_launch: need 19 inputs and %zu bytes of workspace (got %d, %zu)\n", (size_t)WS_END, n_in, ws_size); return; }
    Params p{};
    p.x = (const float*)d_in[0]; p.rel_bias = (const float*)d_in[1]; p.router_w = (const float*)d_in[2]; p.router_b = (const float*)d_in[3];
    p.ln_g = (const float*)d_in[4]; p.ln_b = (const float*)d_in[5]; p.moba_w_in = (const float*)d_in[6]; p.moba_w_out = (const float*)d_in[7];
    p.nsa_w_in = (const float*)d_in[8]; p.nsa_w_out = (const float*)d_in[9]; p.pos_k = (const float*)d_in[10]; p.pos_v = (const float*)d_in[11];
    p.ck_w1 = (const float*)d_in[12]; p.ck_w2 = (const float*)d_in[13]; p.cv_w1 = (const float*)d_in[14]; p.cv_w2 = (const float*)d_in[15];
    p.w_gate = (const float*)d_in[16]; p.w_up = (const float*)d_in[17]; p.w_down = (const float*)d_in[18];
    p.out = (float*)d_out; p.ws = (char*)d_ws;
    const int grid = NWG_EXPECT;
#if MK_LAUNCHES
    launch_phases<0>(p, grid, stream);
#else
    hipFuncSetAttribute((const void*)k_mega, hipFuncAttributeMaxDynamicSharedMemorySize, LDS_BYTES);
    hipMemsetAsync((char*)d_ws + WS_CTL, 0, 16384, stream);
    hipLaunchKernelGGL(k_mega, dim3(grid), dim3(NTHREADS), LDS_BYTES, stream, p);
#endif
}
```

```cpp
#include <hip/hip_runtime.h>
#include <cstdio>
#include <cstdint>

#ifndef MK_LAUNCHES
#define MK_LAUNCHES 0
#endif

#define LAS __attribute__((address_space(3)))
typedef unsigned short bf16_t;
typedef short bf16x8 __attribute__((ext_vector_type(8)));
typedef short s16x4 __attribute__((ext_vector_type(4)));
typedef short v4i16_t __attribute__((ext_vector_type(4)));
typedef float f32x4 __attribute__((ext_vector_type(4)));
typedef float f32x16 __attribute__((ext_vector_type(16)));
typedef unsigned u32x4 __attribute__((ext_vector_type(4)));
typedef unsigned u32x2 __attribute__((ext_vector_type(2)));
typedef LAS const char* lds_cptr;

constexpr int NTOK = 32768, DM = 1024, SEQ = 2048, NBATCH = 16, NHEAD = 16;
constexpr int QKV_LD = 3072, NSA_LD = 2816;
constexpr int NSA_KC = 1024, NSA_VC = 1280, NSA_KS = 1536, NSA_VS = 1792, NSA_KW = 2048, NSA_VW = 2304, NSA_G = 2560;
constexpr int NEXP = 32, DEXP = 512, MAXPAN = 288, RPAD = MAXPAN * 256;
constexpr int NTHREADS = 512, NWG_EXPECT = 256;
constexpr int LDS_BYTES = 155648;
constexpr float LOG2E = 1.4426950408889634f;
constexpr float C2 = 0.125f * LOG2E;
constexpr float ALPHA = 1.4142135623730951f;
constexpr int BT_N = 288;
constexpr int BT_S = 292, BT_H = 4 * BT_S;

constexpr size_t al256(size_t x) { return (x + 255) & ~(size_t)255; }
constexpr size_t WS_CTL = 0;
constexpr size_t WS_GCNT = 14336;
constexpr size_t WS_TAB = 16384;
constexpr size_t WS_B1 = WS_TAB + al256(16 * BT_H * 4);
constexpr size_t WS_NPAN = WS_B1 + 65536;
constexpr size_t WS_PANEL = WS_NPAN + 256;
constexpr size_t WS_HIST = WS_PANEL + 1280;
constexpr size_t WS_KPART = WS_HIST + 32768;
constexpr size_t WS_RE = WS_KPART + 128 * 2 * 1024 * 4;
constexpr size_t WS_RWT = WS_RE + (size_t)NTOK * 8;
constexpr size_t WS_POS = WS_RWT + (size_t)NTOK * 8;
constexpr size_t WS_ROWTOK = WS_POS + (size_t)NTOK * 8;
constexpr size_t WS_KCMP = WS_ROWTOK + (size_t)32 * 65536 * 4;
constexpr size_t WS_VCMP = WS_KCMP + 16 * 4 * 128 * 64 * 2;
constexpr size_t WS_WQKV0 = WS_VCMP + 16 * 4 * 128 * 64 * 2;
constexpr size_t WS_WO0 = WS_WQKV0 + (size_t)3072 * 1024 * 2;
constexpr size_t WS_WIN1 = WS_WO0 + (size_t)1024 * 1024 * 2;
constexpr size_t WS_WO1 = WS_WIN1 + (size_t)2816 * 1024 * 2;
constexpr size_t WS_W1T = WS_WO1 + (size_t)1024 * 1024 * 2;
constexpr size_t WS_GU = WS_W1T + (size_t)2 * 256 * 2048 * 2;
constexpr size_t WS_DN = WS_GU + (size_t)32 * 1024 * 1024 * 2;
constexpr size_t WS_XB = WS_DN + (size_t)32 * 1024 * 512 * 2;
constexpr size_t WS_BIG = WS_XB + (size_t)NTOK * 1024 * 2;
constexpr size_t WS_AOH = WS_BIG + (size_t)NTOK * 3072 * 2;
constexpr size_t WS_X1B = WS_AOH + (size_t)RPAD * 512 * 2;
constexpr size_t WS_END = WS_X1B + (size_t)NTOK * 1024 * 2;

struct Params {
    const float *x, *rel_bias, *router_w, *router_b, *ln_g, *ln_b, *moba_w_in, *moba_w_out, *nsa_w_in, *nsa_w_out, *pos_k, *pos_v,
                *ck_w1, *ck_w2, *cv_w1, *cv_w2, *w_gate, *w_up, *w_down;
    float* out;
    char* ws;
};

__device__ __forceinline__ int otid() { int t = threadIdx.x; asm volatile("" : "+v"(t)); return t; }
__device__ __forceinline__ float bf2f(bf16_t v) { return __uint_as_float(((unsigned)v) << 16); }
__device__ __forceinline__ unsigned cvt_pk_bf16(float lo, float hi) { unsigned r; asm volatile("v_cvt_pk_bf16_f32 %0, %1, %2" : "=v"(r) : "v"(lo), "v"(hi)); return r; }
__device__ __forceinline__ bf16_t f2bf(float f) { return (bf16_t)(cvt_pk_bf16(f, 0.f) & 0xffffu); }
__device__ __forceinline__ float lo_bf(unsigned w) { return __uint_as_float(w << 16); }
__device__ __forceinline__ float hi_bf(unsigned w) { return __uint_as_float(w & 0xffff0000u); }
__device__ __forceinline__ float wave_sum(float v) {
#pragma unroll
    for (int o = 32; o > 0; o >>= 1) v += __shfl_xor(v, o);
    return v; }

#define XB_TMO      128
#define XB_XCNT(j)  (256  + 64 * (j))
#define XB_XSUB(j)  (1280 + 64 * (j))
#define XB_XGEN(j)  (2304 + 64 * (j))
#define XB_TOP      3328
#define XB_TOPGEN   3392
#define XCD_BAR_WORDS 3456
#define XB_SPIN_CAP (1u << 18)
__device__ __forceinline__ unsigned xb_ld(unsigned* p)              { return __hip_atomic_load(p, __ATOMIC_RELAXED, __HIP_MEMORY_SCOPE_AGENT); }
__device__ __forceinline__ unsigned xb_add(unsigned* p, unsigned v) { return __hip_atomic_fetch_add(p, v, __ATOMIC_RELAXED, __HIP_MEMORY_SCOPE_AGENT); }
__device__ __forceinline__ unsigned xb_xcc_id() { return (unsigned)__builtin_amdgcn_s_getreg((3 << 11) | 20) & 0xFu; }
#define XB_SPIN(cond, bar) do { unsigned _sp = 0; while (cond) { __builtin_amdgcn_s_sleep(1); \
    if ((++_sp & 255u) == 0u) { if (xb_ld(&(bar)[XB_TMO])) break; if (_sp > XB_SPIN_CAP) { atomicAdd(&(bar)[XB_TMO], 1u); break; } } } } while (0)
struct XcdBarrier { unsigned* bar; unsigned x; volatile LAS unsigned* st; };
__device__ __forceinline__ XcdBarrier xcd_barrier_post(unsigned* bar, volatile LAS unsigned* st) {
    XcdBarrier b; b.bar = bar; b.x = xb_xcc_id(); b.st = st;
    if (threadIdx.x == 0) (void)xb_add(&bar[XB_XCNT(b.x)], 1u);
    return b;
}
__device__ __forceinline__ void xcd_barrier_complete(unsigned* bar, unsigned x, unsigned& nloc, unsigned& nx) {
    const unsigned G = gridDim.x * gridDim.y * gridDim.z;
    unsigned sum, cnt, mine, sp = 0u;
    for (;;) {
        sum = 0u; cnt = 0u; mine = 0u;
#pragma unroll
        for (unsigned j = 0; j < 16; ++j) { const unsigned c = xb_ld(&bar[XB_XCNT(j)]); sum += c; cnt += (c > 0u) ? 1u : 0u; mine = (j == x) ? c : mine; }
        if (sum == G) break;
        __builtin_amdgcn_s_sleep(1);
        if ((++sp & 255u) == 0u) { if (xb_ld(&bar[XB_TMO])) break; if (sp > XB_SPIN_CAP) { atomicAdd(&bar[XB_TMO], 1u); break; } }
    }
    nloc = mine > 0u ? mine : 1u; nx = cnt > 0u ? cnt : 1u;
}
__device__ __forceinline__ void xcd_barrier(const XcdBarrier& b) {
    asm volatile("s_waitcnt vmcnt(0)" ::: "memory");
    __syncthreads();
    if (threadIdx.x == 0) {
        unsigned* bar = b.bar;
        __builtin_amdgcn_s_waitcnt(0);
        unsigned nloc = b.st[0], nx = b.st[1];
        if (nloc == 0u) { xcd_barrier_complete(bar, b.x, nloc, nx); b.st[0] = nloc; b.st[1] = nx; }
        const unsigned old = xb_add(&bar[XB_XSUB(b.x)], 1u);
        const unsigned gen = old / nloc;
        if (old + 1u == (gen + 1u) * nloc) {
            __builtin_amdgcn_fence(__ATOMIC_RELEASE, "agent");
            asm volatile("s_waitcnt vmcnt(0)" ::: "memory");
            const unsigned og = xb_add(&bar[XB_TOP], 1u);
            const unsigned tg = og / nx;
            if (og + 1u == (tg + 1u) * nx) xb_add(&bar[XB_TOPGEN], 1u);
            else XB_SPIN(xb_ld(&bar[XB_TOPGEN]) == tg, bar);
            __builtin_amdgcn_fence(__ATOMIC_ACQUIRE, "agent");
            xb_add(&bar[XB_XGEN(b.x)], 1u);
            asm volatile("s_waitcnt vmcnt(0)" ::: "memory");
        } else {
            XB_SPIN(xb_ld(&bar[XB_XGEN(b.x)]) == gen, bar);
            __builtin_amdgcn_fence(__ATOMIC_ACQUIRE, "agent");
            asm volatile("s_waitcnt vmcnt(0)" ::: "memory");
        }
    }
    __syncthreads();
}

namespace pg8 {
constexpr int BM = 256, BK = 64, HALF = 128, HTB = HALF * BK * 2, STAGE_BYTES = 8 * HTB, NXCD = 8, WGM = 8;
__device__ __forceinline__ int lds_byte(int r, int c) { const int st = (r >> 4) * 2 + (c >> 5), rr = r & 15, cc = c & 31, ob = rr * 64 + cc * 2; return st * 1024 + (ob ^ (((ob >> 9) & 1) << 5)); }
__device__ __forceinline__ void stage_rc(int b, int& R, int& C) { const int st = b / 1024, sb = b % 1024, swz = sb ^ (((sb >> 9) & 1) << 5); R = (st >> 1) * 16 + swz / 64; C = (st & 1) * 32 + (swz % 64) / 2; }
__device__ __forceinline__ int perm32(int rho) { const int n = rho >> 4, i = rho & 15; return 8 * (i >> 2) + 4 * n + (i & 3); }
struct Unit { int pm, pn, aux, aux2; };

__device__ __forceinline__ void static_unit(int L, int nM, int nN, Unit& u) {
    const int nwg = nM * nN;
    int wgid = L; { const int q = nwg / NXCD, r = nwg % NXCD, xcd = wgid % NXCD, off = wgid / NXCD; wgid = (xcd < r ? xcd * (q + 1) : r * (q + 1) + (xcd - r) * q) + off; }
    const int nig = WGM * nN, gid = wgid / nig, fm = gid * WGM, gsz = (nM - fm) < WGM ? (nM - fm) : WGM;
    u.pm = fm + ((wgid % nig) % gsz); u.pn = (wgid % nig) / gsz; u.aux = 0; u.aux2 = 0;
}

template <class Epi, class Sched>
__device__ __forceinline__ void gemm_phase(LAS unsigned char* lds, const Sched& S, const Epi& E) {
    const int tid = otid(), wid = __builtin_amdgcn_readfirstlane(tid >> 6), lane = tid & 63, wr = wid >> 2, wc = wid & 3, fr = lane & 15, fq = lane >> 4;
    const int nt = S.nt;
    int sR[2], sC[2];
    unsigned vB[2][2];
#pragma unroll
    for (int i = 0; i < 2; ++i) { stage_rc(tid * 16 + i * 8192, sR[i], sC[i]); const int Rb = Epi::PERM ? ((sR[i] & ~31) + perm32(sR[i] & 31)) : sR[i];
#pragma unroll
        for (int h = 0; h < 2; ++h) vB[h][i] = (unsigned)(h * HALF + Rb) * S.ldb + (unsigned)sC[i] * 2u; }
    const size_t kstepA = S.kstepA, kstepB = S.kstepB;
    const unsigned ldsw = (unsigned)wid * 1024u;
    const int aoff = lds_byte(wr * 64 + fr, fq * 8), boff = lds_byte(wc * 32 + fr, fq * 8);
#define PG8_SA(b, h) (((b) * 2 + (h)) * HTB)
#define PG8_SB(b, h) ((4 + (b) * 2 + (h)) * HTB)
#define PG8_STAGE(bufoff, gbase, v0, v1) do { \
        __builtin_amdgcn_global_load_lds((const unsigned*)((const char*)(gbase) + (v0)), (LAS unsigned*)(lds + (bufoff) + ldsw), 16, 0, 0); \
        __builtin_amdgcn_global_load_lds((const unsigned*)((const char*)(gbase) + (v1)), (LAS unsigned*)(lds + (bufoff) + ldsw + 8192), 16, 0, 0); } while (0)
#define PG8_LDA(dst, b, h) do { _Pragma("unroll") for (int m = 0; m < 4; ++m) _Pragma("unroll") for (int k = 0; k < 2; ++k) dst[m][k] = *(const LAS bf16x8*)(lds + PG8_SA(b, h) + aoff + m * 2048 + k * 1024); } while (0)
#define PG8_LDB(dst, b, h) do { _Pragma("unroll") for (int n = 0; n < 2; ++n) _Pragma("unroll") for (int k = 0; k < 2; ++k) dst[n][k] = *(const LAS bf16x8*)(lds + PG8_SB(b, h) + boff + n * 2048 + k * 1024); } while (0)
#define PG8_MMA(ai, bj, At, Bt) do { __builtin_amdgcn_s_setprio(1); _Pragma("unroll") for (int m = 0; m < 4; ++m) _Pragma("unroll") for (int n = 0; n < 2; ++n) _Pragma("unroll") for (int k = 0; k < 2; ++k) \
        acc[ai][bj][m][n] = __builtin_amdgcn_mfma_f32_16x16x32_bf16(Bt[n][k], At[m][k], acc[ai][bj][m][n], 0, 0, 0); __builtin_amdgcn_s_setprio(0); } while (0)
#define PG8_WAIT_V(n) asm volatile("s_waitcnt vmcnt(" #n ")" ::: "memory")
#define PG8_WAIT_L(n) asm volatile("s_waitcnt lgkmcnt(" #n ")" ::: "memory")
#define PG8_BAR __builtin_amdgcn_s_barrier()
#define PG8_SCHED __builtin_amdgcn_sched_barrier(0)
    Unit cur, nxt; int ui = 0;
    if (!S.next(0, cur)) return;
    f32x4 acc[2][2][4][2];
#pragma unroll
    for (int a = 0; a < 2; ++a)
#pragma unroll
        for (int b = 0; b < 2; ++b)
#pragma unroll
            for (int m = 0; m < 4; ++m)
#pragma unroll
                for (int n = 0; n < 2; ++n) acc[a][b][m][n] = (f32x4){0.f, 0.f, 0.f, 0.f};
    bf16x8 At[4][2], B0[2][2], B1[2][2];
    unsigned vA[2][2], vN[2][2];
#pragma unroll
    for (int h = 0; h < 2; ++h)
#pragma unroll
        for (int i = 0; i < 2; ++i) { vA[h][i] = S.aoff(cur, h * HALF + sR[i], sC[i]); vN[h][i] = vA[h][i]; }
    const char* cA = S.abase(cur); const char* cB = S.bbase(cur);
    PG8_STAGE(PG8_SB(0, 0), cB, vB[0][0], vB[0][1]); PG8_STAGE(PG8_SA(0, 0), cA, vA[0][0], vA[0][1]); PG8_STAGE(PG8_SB(0, 1), cB, vB[1][0], vB[1][1]); PG8_STAGE(PG8_SA(0, 1), cA, vA[1][0], vA[1][1]);
    if (wr == 1) PG8_BAR;
    PG8_WAIT_V(4); PG8_BAR;
    PG8_STAGE(PG8_SB(1, 0), cB + kstepB, vB[0][0], vB[0][1]); PG8_STAGE(PG8_SA(1, 0), cA + kstepA, vA[0][0], vA[0][1]); PG8_STAGE(PG8_SB(1, 1), cB + kstepB, vB[1][0], vB[1][1]);
    PG8_WAIT_V(6); PG8_BAR;
    for (;;) {
        const bool has_next = S.next(ui + 1, nxt);
        const char* nA = has_next ? S.abase(nxt) : cA; const char* nB = has_next ? S.bbase(nxt) : cB;
        if (Sched::DYN_A && has_next) {
#pragma unroll
            for (int h = 0; h < 2; ++h)
#pragma unroll
                for (int i = 0; i < 2; ++i) vN[h][i] = S.aoff(nxt, h * HALF + sR[i], sC[i]);
        }
        for (int t = 0; t < nt; t += 2) {
            const bool last = (t == nt - 2);
            const char* a1 = cA + (size_t)(t + 1) * kstepA;
            const char* a2 = last ? nA : cA + (size_t)(t + 2) * kstepA; const char* b2 = last ? nB : cB + (size_t)(t + 2) * kstepB;
            const char* a3 = a2 + kstepA; const char* b3 = b2 + kstepB;
            PG8_LDB(B0, 0, 0); PG8_SCHED; PG8_LDA(At, 0, 0); PG8_STAGE(PG8_SA(1, 1), a1, vA[1][0], vA[1][1]);
            if (Sched::DYN_A && last) {
#pragma unroll
                for (int h = 0; h < 2; ++h)
#pragma unroll
                    for (int i = 0; i < 2; ++i) vA[h][i] = vN[h][i]; }
            PG8_WAIT_L(8); PG8_BAR; PG8_WAIT_L(0); PG8_MMA(0, 0, At, B0); PG8_BAR; PG8_SCHED;
            PG8_LDB(B1, 0, 1); PG8_STAGE(PG8_SB(0, 0), b2, vB[0][0], vB[0][1]);
            PG8_BAR; PG8_WAIT_L(0); PG8_MMA(0, 1, At, B1); PG8_BAR;
            PG8_LDA(At, 0, 1); PG8_STAGE(PG8_SA(0, 0), a2, vA[0][0], vA[0][1]);
            PG8_BAR; PG8_WAIT_L(0); PG8_MMA(1, 0, At, B0); PG8_BAR; PG8_SCHED;
            PG8_STAGE(PG8_SB(0, 1), b2, vB[1][0], vB[1][1]);
            PG8_WAIT_V(6); PG8_BAR; PG8_MMA(1, 1, At, B1); PG8_BAR;
            PG8_LDB(B0, 1, 0); PG8_SCHED; PG8_LDA(At, 1, 0); PG8_STAGE(PG8_SA(0, 1), a2, vA[1][0], vA[1][1]);
            PG8_WAIT_L(8); PG8_BAR; PG8_WAIT_L(0); PG8_MMA(0, 0, At, B0); PG8_BAR; PG8_SCHED;
            PG8_LDB(B1, 1, 1); PG8_STAGE(PG8_SB(1, 0), b3, vB[0][0], vB[0][1]);
            PG8_BAR; PG8_WAIT_L(0); PG8_MMA(0, 1, At, B1); PG8_BAR;
            PG8_LDA(At, 1, 1); PG8_STAGE(PG8_SA(1, 0), a3, vA[0][0], vA[0][1]);
            PG8_BAR; PG8_WAIT_L(0); PG8_MMA(1, 0, At, B0); PG8_BAR; PG8_SCHED;
            PG8_STAGE(PG8_SB(1, 1), b3, vB[1][0], vB[1][1]);
            PG8_WAIT_V(6); PG8_BAR; PG8_MMA(1, 1, At, B1); PG8_BAR;
        }
        E(acc, cur, wr, wc, fr, fq);
        if (!has_next) break;
#pragma unroll
        for (int a = 0; a < 2; ++a)
#pragma unroll
            for (int b = 0; b < 2; ++b)
#pragma unroll
                for (int m = 0; m < 4; ++m)
#pragma unroll
                    for (int n = 0; n < 2; ++n) acc[a][b][m][n] = (f32x4){0.f, 0.f, 0.f, 0.f};
        cur = nxt; cA = nA; cB = nB; ++ui;
    }
    PG8_WAIT_V(0);
    if (wr == 0) PG8_BAR;
    PG8_BAR;
#undef PG8_SA
#undef PG8_SB
#undef PG8_STAGE
#undef PG8_LDA
#undef PG8_LDB
#undef PG8_MMA
#undef PG8_WAIT_V
#undef PG8_WAIT_L
#undef PG8_BAR
#undef PG8_SCHED
}
}
using pg8::Unit;

struct SchedPlain {
    static constexpr bool DYN_A = false;
    const char* A; const char* Bt; int K, nM, nN, G, c; int nt; unsigned kstepA, kstepB, ldb;
    __device__ __forceinline__ void init(const void* A_, const void* Bt_, int M, int N, int K_) { A = (const char*)A_; Bt = (const char*)Bt_; K = K_; nM = M / 256; nN = N / 256; G = gridDim.x; c = blockIdx.x; nt = K / 64; kstepA = 128; kstepB = 128; ldb = (unsigned)K * 2u; }
    __device__ __forceinline__ bool next(int i, Unit& u) const { const int L = i * G + c; if (L >= nM * nN) return false; pg8::static_unit(L, nM, nN, u); return true; }
    __device__ __forceinline__ const char* abase(const Unit& u) const { return A + (size_t)u.pm * 256 * K * 2; }
    __device__ __forceinline__ const char* bbase(const Unit& u) const { return Bt + (size_t)u.pn * 256 * K * 2; }
    __device__ __forceinline__ unsigned aoff(const Unit&, int row, int col) const { return (unsigned)(row * K + col) * 2u; }
};
constexpr int ML_CNT = 131072, ML_PPRE = ML_CNT + 128, ML_PE = ML_PPRE + 256;
__device__ __forceinline__ int moe_tables(const char* ws, int layer, LAS unsigned char* lds) {
    const int tid = otid(); LAS int* cnt = (LAS int*)(lds + ML_CNT); LAS int* ppre = (LAS int*)(lds + ML_PPRE); LAS int* pe = (LAS int*)(lds + ML_PE);
    __syncthreads();
    if (tid < 32) cnt[tid] = ((const int*)(ws + WS_GCNT))[layer * 32 + tid];
    __syncthreads();
    if (tid == 0) { int s = 0; for (int e = 0; e < NEXP; ++e) { ppre[e] = s; s += (cnt[e] + 255) >> 8; } ppre[NEXP] = s; }
    __syncthreads();
    const int nM = ppre[NEXP];
    if (tid < nM) { int e = 0; for (int k = 1; k < NEXP; ++k) e += (ppre[k] <= tid) ? 1 : 0; pe[tid] = e; }
    __syncthreads();
    return nM;
}
struct SchedMoeGU {
    static constexpr bool DYN_A = true;
    const char* X; const char* W; const int* tokof; LAS unsigned char* lds; int nM, G, c; int nt; unsigned kstepA, kstepB, ldb;
    __device__ __forceinline__ void init(const char* ws, int layer, LAS unsigned char* lds_) { lds = lds_; nM = moe_tables(ws, layer, lds_); X = ws + WS_X1B; W = ws + WS_GU; tokof = (const int*)(ws + WS_ROWTOK); G = gridDim.x; c = blockIdx.x; nt = 16; kstepA = 128; kstepB = 128; ldb = 2048; }
    __device__ __forceinline__ bool next(int i, Unit& u) const { const int L = i * G + c; if (L >= nM * 4) return false; pg8::static_unit(L, nM, 4, u);
        const int e = ((const LAS int*)(lds + ML_PE))[u.pm]; u.aux = e | ((u.pm - ((const LAS int*)(lds + ML_PPRE))[e]) << 16); u.aux2 = ((const LAS int*)(lds + ML_CNT))[e]; return true; }
    __device__ __forceinline__ const char* abase(const Unit&) const { return X; }
    __device__ __forceinline__ const char* bbase(const Unit& u) const { return W + ((size_t)(u.aux & 255) * 1024 + (size_t)u.pn * 256) * 2048; }
    __device__ __forceinline__ unsigned aoff(const Unit& u, int row, int col) const { const int slot = (u.aux >> 16) * 256 + row; const int sl = slot < u.aux2 ? slot : 0;
        return (unsigned)tokof[(u.aux & 255) * 65536 + sl] * 2048u + (unsigned)col * 2u; }
};
struct SchedMoeDN {
    static constexpr bool DYN_A = false;
    const char* H; const char* W; LAS unsigned char* lds; int nM, G, c; int nt; unsigned kstepA, kstepB, ldb;
    __device__ __forceinline__ void init(const char* ws, int layer, LAS unsigned char* lds_) { lds = lds_; nM = moe_tables(ws, layer, lds_); H = ws + WS_AOH; W = ws + WS_DN; G = gridDim.x; c = blockIdx.x; nt = 8; kstepA = 128; kstepB = 128; ldb = 1024; }
    __device__ __forceinline__ bool next(int i, Unit& u) const { const int L = i * G + c; if (L >= nM * 4) return false; pg8::static_unit(L, nM, 4, u); u.aux = ((const LAS int*)(lds + ML_PE))[u.pm]; u.aux2 = 0; return true; }
    __device__ __forceinline__ const char* abase(const Unit& u) const { return H + (size_t)u.pm * 256 * 1024; }
    __device__ __forceinline__ const char* bbase(const Unit& u) const { return W + ((size_t)u.aux * 1024 + (size_t)u.pn * 256) * 1024; }
    __device__ __forceinline__ unsigned aoff(const Unit&, int row, int col) const { return (unsigned)(row * 512 + col) * 2u; }
};
struct SchedCmp {
    static constexpr bool DYN_A = false  ;
    const char* Q; const char* W; int G, c; int nt; unsigned kstepA, kstepB, ldb;
    __device__ __forceinline__ void init(const char* ws) { Q = ws + WS_BIG; W = ws + WS_W1T; G = gridDim.x; c = blockIdx.x; nt = 8; kstepA = NSA_LD * 2; kstepB = 128; ldb = 4096; }
    __device__ __forceinline__ bool next(int i, Unit& u) const { const int L = i * G + c; if (L >= 256) return false; u.aux = L >> 7; u.aux2 = 0; u.pm = (L >> 2) & 31; u.pn = L & 3; return true; }
    __device__ __forceinline__ const char* abase(const Unit& u) const { return Q + (size_t)(u.aux ? NSA_VC : NSA_KC) * 2 + (size_t)u.pn * 8 * (NSA_LD * 2); }
    __device__ __forceinline__ const char* bbase(const Unit& u) const { return W + (size_t)u.aux * 256 * 4096 + (size_t)u.pn * 8 * 128; }
    __device__ __forceinline__ unsigned aoff(const Unit& u, int row, int col) const {
        const int m = u.pm * 256 + row, bh = m >> 7, n = m & 127, nn = n > 126 ? 126 : n, b = bh >> 2, hkv = bh & 3;
        return (unsigned)(((b * SEQ + 16 * nn) * NSA_LD) + hkv * 64 + col) * 2u; }
};

struct EpiQKV0 {
    static constexpr bool PERM = true;
    bf16_t* O; float* kpart;
    __device__ __forceinline__ void operator()(const f32x4 (&acc)[2][2][4][2], const Unit& u, int wr, int wc, int fr, int fq) const {
        const int row0 = u.pm * 256 + wr * 64 + fr, col0 = u.pn * 256 + wc * 32 + 8 * fq;
        const float sc = (u.pn < 4) ? C2 : 1.0f;
#pragma unroll
        for (int ai = 0; ai < 2; ++ai)
#pragma unroll
            for (int m = 0; m < 4; ++m) { bf16_t* rowp = O + (size_t)(row0 + ai * 128 + m * 16) * QKV_LD + col0;
#pragma unroll
                for (int bj = 0; bj < 2; ++bj) { const f32x4 v0 = acc[ai][bj][m][0] * sc, v1 = acc[ai][bj][m][1] * sc;
                    u32x4 w; w.x = cvt_pk_bf16(v0[0], v0[1]); w.y = cvt_pk_bf16(v0[2], v0[3]); w.z = cvt_pk_bf16(v1[0], v1[1]); w.w = cvt_pk_bf16(v1[2], v1[3]);
                    *(u32x4*)(rowp + bj * 128) = w; } }
        if (u.pn >= 4 && u.pn < 8) {
#pragma unroll
            for (int bj = 0; bj < 2; ++bj)
#pragma unroll
                for (int n = 0; n < 2; ++n) { f32x4 s = (f32x4){0.f, 0.f, 0.f, 0.f};
#pragma unroll
                    for (int ai = 0; ai < 2; ++ai)
#pragma unroll
                        for (int m = 0; m < 4; ++m) s += acc[ai][bj][m][n];
#pragma unroll
                    for (int j = 0; j < 4; ++j) { float v = s[j]; v += __shfl_xor(v, 1); v += __shfl_xor(v, 2); v += __shfl_xor(v, 4); v += __shfl_xor(v, 8); s[j] = v; }
                    if (fr == 0) *(f32x4*)(kpart + ((size_t)u.pm * 2 + wr) * 1024 + (u.pn - 4) * 256 + bj * 128 + wc * 32 + 8 * fq + 4 * n) = s; }
        }
    }
};
struct EpiNSA {
    static constexpr bool PERM = true;
    bf16_t* O;
    __device__ __forceinline__ void operator()(const f32x4 (&acc)[2][2][4][2], const Unit& u, int wr, int wc, int fr, int fq) const {
        const int row0 = u.pm * 256 + wr * 64 + fr, col0 = u.pn * 256 + wc * 32 + 8 * fq;
        const float sc = (u.pn < 4) ? C2 : 1.0f; const bool sg = (u.pn == 10);
#pragma unroll
        for (int ai = 0; ai < 2; ++ai)
#pragma unroll
            for (int m = 0; m < 4; ++m) { bf16_t* rowp = O + (size_t)(row0 + ai * 128 + m * 16) * NSA_LD + col0;
#pragma unroll
                for (int bj = 0; bj < 2; ++bj) { f32x4 v0 = acc[ai][bj][m][0] * sc, v1 = acc[ai][bj][m][1] * sc;
                    if (sg) {
#pragma unroll
                        for (int j = 0; j < 4; ++j) { v0[j] = 1.0f / (1.0f + __expf(-v0[j])); v1[j] = 1.0f / (1.0f + __expf(-v1[j])); } }
                    u32x4 w; w.x = cvt_pk_bf16(v0[0], v0[1]); w.y = cvt_pk_bf16(v0[2], v0[3]); w.z = cvt_pk_bf16(v1[0], v1[1]); w.w = cvt_pk_bf16(v1[2], v1[3]);
                    *(u32x4*)(rowp + bj * 128) = w; } }
    }
};
template <bool RES_F32> struct EpiRes {
    static constexpr bool PERM = true;
    bf16_t* O; const float* rf; const bf16_t* rb;
    __device__ __forceinline__ void operator()(const f32x4 (&acc)[2][2][4][2], const Unit& u, int wr, int wc, int fr, int fq) const {
        const int row0 = u.pm * 256 + wr * 64 + fr, col0 = u.pn * 256 + wc * 32 + 8 * fq;
#pragma unroll
        for (int ai = 0; ai < 2; ++ai)
#pragma unroll
            for (int m = 0; m < 4; ++m) { const size_t ro = (size_t)(row0 + ai * 128 + m * 16) * 1024 + col0;
#pragma unroll
                for (int bj = 0; bj < 2; ++bj) { f32x4 r0, r1;
                    if (RES_F32) { r0 = *(const f32x4*)(rf + ro + bj * 128); r1 = *(const f32x4*)(rf + ro + bj * 128 + 4); }
                    else { const u32x4 rw = *(const u32x4*)(rb + ro + bj * 128); r0 = (f32x4){lo_bf(rw.x), hi_bf(rw.x), lo_bf(rw.y), hi_bf(rw.y)}; r1 = (f32x4){lo_bf(rw.z), hi_bf(rw.z), lo_bf(rw.w), hi_bf(rw.w)}; }
                    const f32x4 v0 = acc[ai][bj][m][0] + r0 * ALPHA, v1 = acc[ai][bj][m][1] + r1 * ALPHA;
                    u32x4 w; w.x = cvt_pk_bf16(v0[0], v0[1]); w.y = cvt_pk_bf16(v0[2], v0[3]); w.z = cvt_pk_bf16(v1[0], v1[1]); w.w = cvt_pk_bf16(v1[2], v1[3]);
                    *(u32x4*)(O + ro + bj * 128) = w; } }
    }
};
struct EpiGU {
    static constexpr bool PERM = true;
    bf16_t* O;
    __device__ __forceinline__ void operator()(const f32x4 (&acc)[2][2][4][2], const Unit& u, int wr, int wc, int fr, int fq) const {
        const int row0 = u.pm * 256 + wr * 64 + fr, col0 = u.pn * 128 + wc * 32 + 8 * fq;
#pragma unroll
        for (int ai = 0; ai < 2; ++ai)
#pragma unroll
            for (int m = 0; m < 4; ++m) { float h[8];
#pragma unroll
                for (int n = 0; n < 2; ++n)
#pragma unroll
                    for (int j = 0; j < 4; ++j) { const float g = acc[ai][0][m][n][j], up = acc[ai][1][m][n][j]; h[n * 4 + j] = g * up / (1.0f + __expf(-g)); }
                u32x4 w; w.x = cvt_pk_bf16(h[0], h[1]); w.y = cvt_pk_bf16(h[2], h[3]); w.z = cvt_pk_bf16(h[4], h[5]); w.w = cvt_pk_bf16(h[6], h[7]);
                *(u32x4*)(O + (size_t)(row0 + ai * 128 + m * 16) * 512 + col0) = w; }
    }
};
struct EpiDN {
    static constexpr bool PERM = true;
    bf16_t* O;
    __device__ __forceinline__ void operator()(const f32x4 (&acc)[2][2][4][2], const Unit& u, int wr, int wc, int fr, int fq) const {
        const int row0 = u.pm * 256 + wr * 64 + fr, col0 = u.pn * 256 + wc * 32 + 8 * fq;
#pragma unroll
        for (int ai = 0; ai < 2; ++ai)
#pragma unroll
            for (int m = 0; m < 4; ++m) { bf16_t* rowp = O + (size_t)(row0 + ai * 128 + m * 16) * 1024 + col0;
#pragma unroll
                for (int bj = 0; bj < 2; ++bj) { const f32x4 v0 = acc[ai][bj][m][0], v1 = acc[ai][bj][m][1];
                    u32x4 w; w.x = cvt_pk_bf16(v0[0], v0[1]); w.y = cvt_pk_bf16(v0[2], v0[3]); w.z = cvt_pk_bf16(v1[0], v1[1]); w.w = cvt_pk_bf16(v1[2], v1[3]);
                    *(u32x4*)(rowp + bj * 128) = w; } }
    }
};
struct EpiCmp {
    static constexpr bool PERM = false;
    float* CP;
    __device__ __forceinline__ void operator()(const f32x4 (&acc)[2][2][4][2], const Unit& u, int wr, int wc, int fr, int fq) const {
        float* base = CP + ((size_t)(u.aux * 4 + u.pn) * 8192 + (size_t)u.pm * 256) * 256;
        const int row0 = wr * 64 + fr, col0 = wc * 32 + 4 * fq;
#pragma unroll
        for (int ai = 0; ai < 2; ++ai)
#pragma unroll
            for (int m = 0; m < 4; ++m) { float* rowp = base + (size_t)(row0 + ai * 128 + m * 16) * 256 + col0;
#pragma unroll
                for (int bj = 0; bj < 2; ++bj)
#pragma unroll
                    for (int n = 0; n < 2; ++n) *(f32x4*)(rowp + bj * 128 + n * 16) = acc[ai][bj][m][n]; }
    }
};

constexpr int AL_K = 0  , AL_V = 24576  , AL_BIAS = 57344  , AL_KM = AL_BIAS + 4 * BT_H * 4, AL_IMP = AL_KM + 2048  , AL_SEL = AL_IMP + 65536, AL_LIST = AL_SEL + 512, AL_END = AL_LIST + 256;
static_assert(AL_END <= LDS_BYTES - 16 && 4 * 64 * 33 * 4 <= 65536, "attention LDS map");
#define MFMA32(a, b, c) __builtin_amdgcn_mfma_f32_32x32x16_bf16(a, b, c, 0, 0, 0)
__device__ __forceinline__ s16x4 vtr(lds_cptr p) { return __builtin_bit_cast(s16x4, __builtin_amdgcn_ds_read_tr16_b64_v4i16((LAS v4i16_t*)p)); }
__device__ __forceinline__ float xhalf_max(float m) { auto rr = __builtin_amdgcn_permlane32_swap(__float_as_uint(m), __float_as_uint(m), false, false); return __builtin_fmaxf(__uint_as_float(rr[0]), __uint_as_float(rr[1])); }
__device__ __forceinline__ float xhalf_sum(float m) { auto rr = __builtin_amdgcn_permlane32_swap(__float_as_uint(m), __float_as_uint(m), false, false); return __uint_as_float(rr[0]) + __uint_as_float(rr[1]); }
__device__ __forceinline__ float max16(const f32x16& p) { float a = __builtin_fmaxf(p[0], p[1]), b = __builtin_fmaxf(p[2], p[3]);
#pragma unroll
    for (int r = 4; r < 16; r += 4) { a = __builtin_fmaxf(a, __builtin_fmaxf(p[r], p[r + 1])); b = __builtin_fmaxf(b, __builtin_fmaxf(p[r + 2], p[r + 3])); }
    return __builtin_fmaxf(a, b); }

#define MX3(a, b, c) __builtin_fmaxf(__builtin_fmaxf((a), (b)), (c))
__device__ __forceinline__ float max32(const f32x16& p0, const f32x16& p1) {
    float a = MX3(p0[0], p0[1], p1[0]), b = MX3(p0[2], p0[3], p1[1]); a = MX3(a, p1[2], p1[3]);
#pragma unroll
    for (int r = 4; r < 16; r += 4) { a = MX3(a, p0[r], p0[r + 1]); b = MX3(b, p0[r + 2], p0[r + 3]); a = MX3(a, p1[r], p1[r + 1]); b = MX3(b, p1[r + 2], p1[r + 3]); }
    return __builtin_fmaxf(a, b); }
constexpr float FLASH_THR = 8.0f;
__device__ __forceinline__ void glds16(const void* g, unsigned lds_addr) {
    unsigned sv; asm volatile("s_mov_b32 %0, m0\n\ts_mov_b32 m0, %2\n\ts_nop 0\n\tglobal_load_lds_dwordx4 %1, off\n\ts_mov_b32 m0, %0" : "=&s"(sv) : "v"(g), "s"(lds_addr) : "memory"); }
__device__ __forceinline__ void dma_k(const bf16_t* src, int ld, LAS unsigned char* lds, int slot, int wid, int lane) {
    const int rl = lane >> 3, ch = lane & 7;
    glds16(src + (size_t)(wid * 8 + rl) * ld + ((ch ^ rl) * 8), (unsigned)__builtin_amdgcn_readfirstlane((int)((unsigned)(unsigned long)lds + AL_K + slot * 8192 + wid * 1024))); }
__device__ __forceinline__ void dma_v(const bf16_t* src, int ld, LAS unsigned char* lds, int slot, int wid, int lane) {
    glds16(src + (size_t)(16 * (wid & 3) + (lane >> 2)) * ld + (wid >> 2) * 32 + (lane & 3) * 8, (unsigned)__builtin_amdgcn_readfirstlane((int)((unsigned)(unsigned long)lds + AL_V + slot * 8192 + wid * 1024))); }

struct FState { float m, l; f32x16 o0, o1; };
__device__ __forceinline__ void fstate_reset(FState& s) { s.m = -1e30f; s.l = 0.f;
#pragma unroll
    for (int r = 0; r < 16; ++r) { s.o0[r] = 0.f; s.o1[r] = 0.f; } }

__device__ __forceinline__ int kchunk_off(int d0, int kx) { return (((2 * d0 + (kx >> 3)) ^ (kx & 7)) * 16); }
__device__ __forceinline__ void qk_tile(f32x16& c0, f32x16& c1, const bf16x8 (&qr)[4], lds_cptr kp, int kx) {
#pragma unroll
    for (int d0 = 0; d0 < 4; ++d0) { const bf16x8 k0 = *(const LAS bf16x8*)(kp + kchunk_off(d0, kx)), k1 = *(const LAS bf16x8*)(kp + kchunk_off(d0, kx) + 4096);
        c0 = MFMA32(k0, qr[d0], c0); c1 = MFMA32(k1, qr[d0], c1); }
}
__device__ __forceinline__ void pv_tile(f32x16& o0, f32x16& o1, const f32x16& p0, const f32x16& p1, lds_cptr vp) {
#pragma unroll
    for (int k = 0; k < 4; ++k) {
        const f32x16& ps = (k < 2) ? p0 : p1; const int b = 8 * (k & 1);
        const u32x4 pw = (u32x4){cvt_pk_bf16(ps[b], ps[b + 1]), cvt_pk_bf16(ps[b + 2], ps[b + 3]), cvt_pk_bf16(ps[b + 4], ps[b + 5]), cvt_pk_bf16(ps[b + 6], ps[b + 7])};
        const bf16x8 pf = __builtin_bit_cast(bf16x8, pw);
        { const s16x4 lo = vtr(vp + k * 1024), hi = vtr(vp + k * 1024 + 512);
          const bf16x8 vf = (bf16x8){lo[0], lo[1], lo[2], lo[3], hi[0], hi[1], hi[2], hi[3]}; o0 = MFMA32(vf, pf, o0); }
        { const s16x4 lo = vtr(vp + 4096 + k * 1024), hi = vtr(vp + 4096 + k * 1024 + 512);
          const bf16x8 vf = (bf16x8){lo[0], lo[1], lo[2], lo[3], hi[0], hi[1], hi[2], hi[3]}; o1 = MFMA32(vf, pf, o1); }
    }
}
struct TileP { int Dmin; bool rowok, run, win; };
__device__ __forceinline__ void load_kf(bf16x8 (&kf)[8], lds_cptr kp, int kx) {
#pragma unroll
    for (int d0 = 0; d0 < 4; ++d0) { kf[2 * d0] = *(const LAS bf16x8*)(kp + kchunk_off(d0, kx)); kf[2 * d0 + 1] = *(const LAS bf16x8*)(kp + kchunk_off(d0, kx) + 4096); } }
__device__ __forceinline__ void flash_qk(f32x16& c0, f32x16& c1, float& cf, const bf16x8 (&qr)[4], lds_cptr kp, int kx, const LAS float* btab, float cfar, int Dmin, int r32, int hi) {
    bf16x8 kf[8]; load_kf(kf, kp, kx);
    if (Dmin - 63 < 127) {
        const int s0 = (BT_N - 1 - 63) - (Dmin + r32 - 4 * hi), ksh = s0 & 3; cf = 0.f;
        const LAS f32x4* bp = (const LAS f32x4*)(btab + ksh * BT_S + (s0 - ksh));
#pragma unroll
        for (int g = 0; g < 4; ++g) { const f32x4 a = bp[2 * g], b = bp[8 + 2 * g];
#pragma unroll
            for (int i = 0; i < 4; ++i) { c0[4 * g + i] = a[i]; c1[4 * g + i] = b[i]; } }
#pragma unroll
        for (int d0 = 0; d0 < 4; ++d0) { c0 = MFMA32(kf[2 * d0], qr[d0], c0); c1 = MFMA32(kf[2 * d0 + 1], qr[d0], c1); }
    } else {
        cf = cfar;
        const f32x16 z = {0.f, 0.f, 0.f, 0.f, 0.f, 0.f, 0.f, 0.f, 0.f, 0.f, 0.f, 0.f, 0.f, 0.f, 0.f, 0.f};
        c0 = MFMA32(kf[0], qr[0], z); c1 = MFMA32(kf[1], qr[0], z);
#pragma unroll
        for (int d0 = 1; d0 < 4; ++d0) { c0 = MFMA32(kf[2 * d0], qr[d0], c0); c1 = MFMA32(kf[2 * d0 + 1], qr[d0], c1); }
    }
}
__device__ __forceinline__ void flash_sm(FState& st, f32x16& c0, f32x16& c1, float cf, const TileP& tp, int r32, int hi) {
    const int Dmin = tp.Dmin, Dl = Dmin + r32 - 4 * hi;
    if (tp.win && (Dmin + 31 >= 512)) {
#pragma unroll
        for (int r = 0; r < 16; ++r) { const int ko = (r & 3) + 8 * (r >> 2); if (Dl >= 512 + ko) c0[r] = -INFINITY; if (Dl >= 544 + ko) c1[r] = -INFINITY; }
    }
    float mx = xhalf_max(max32(c0, c1)) + cf;
    mx = tp.rowok ? mx : -INFINITY;
    if (__any(mx > st.m + FLASH_THR)) {
        const float mn = __builtin_fmaxf(st.m, mx); const float alpha = __builtin_amdgcn_exp2f(st.m - mn);
        st.m = mn; st.l *= alpha;
#pragma unroll
        for (int r = 0; r < 16; ++r) { st.o0[r] *= alpha; st.o1[r] *= alpha; }
    }
    const float msub = tp.rowok ? (st.m - cf) : INFINITY;
    float rs0 = 0.f, rs1 = 0.f;
#pragma unroll
    for (int r = 0; r < 16; ++r) { c0[r] = __builtin_amdgcn_exp2f(c0[r] - msub); c1[r] = __builtin_amdgcn_exp2f(c1[r] - msub); rs0 += c0[r]; rs1 += c1[r]; }
    st.l += rs0 + rs1;
}
template <int VAR, class Src>
__device__ __forceinline__ void attn_stream(Src& S, int NT, FState& st, const bf16x8 (&qr)[4], LAS unsigned char* lds, const LAS float* btab, float cfar, int wid, int lane, int r32, int hi) {
    const lds_cptr kp0 = (lds_cptr)lds + AL_K + r32 * 128; const int kx = (r32 & 7) | (hi << 3);
    const lds_cptr vp0 = (lds_cptr)lds + AL_V + ((lane >> 4) & 1) * 32 + (lane & 3) * 8 + (4 * hi + ((lane & 15) >> 2)) * 64;
    S.dma(0, 0, 0); if (NT > 1 && VAR != 5 && VAR != 6) S.dma(1, 1, 1);
    if (VAR == 5) { asm volatile("s_waitcnt vmcnt(0)" ::: "memory"); __syncthreads(); }
    int sc = 0, sn = 2;
    for (int t = 0; t < NT; ++t) {
        if (VAR != 5) { if (t + 1 < NT) asm volatile("s_waitcnt vmcnt(2)" ::: "memory"); else asm volatile("s_waitcnt vmcnt(0)" ::: "memory");
        __syncthreads(); }
        if (VAR != 5 && VAR != 6) { if (t + 2 < NT) S.dma(t + 2, sn, sn); }
        const TileP tp = S.params(t);
        if (tp.run) { f32x16 c0, c1; float cf;
            flash_qk(c0, c1, cf, qr, kp0 + sc * 8192, kx, btab, cfar, tp.Dmin, r32, hi);
            flash_sm(st, c0, c1, cf, tp, r32, hi);
            pv_tile(st.o0, st.o1, c0, c1, vp0 + sc * 8192); }
        S.after(t, st);
        sc = (sc == 2) ? 0 : sc + 1; sn = (sn == 2) ? 0 : sn + 1;
    }
}

__device__ __forceinline__ void conv_tile(const float* src, int N, bf16_t* dst, int ldd, int k0, int n0, int rowadd, int mode, LAS float* t, int lane) {
    float4 v[16];
#pragma unroll
    for (int i = 0; i < 16; ++i) { const int r = i * 4 + (lane >> 4), cc = n0 + (lane & 15) * 4;
        v[i] = (cc < N) ? *(const float4*)(src + (size_t)(k0 + r) * N + cc) : make_float4(0.f, 0.f, 0.f, 0.f); }
#pragma unroll
    for (int i = 0; i < 16; ++i) { const int r = i * 4 + (lane >> 4), cc = (lane & 15) * 4; LAS float* q = t + r * 65 + cc; q[0] = v[i].x; q[1] = v[i].y; q[2] = v[i].z; q[3] = v[i].w; }
    asm volatile("s_waitcnt lgkmcnt(0)" ::: "memory");
#pragma unroll
    for (int i = 0; i < 8; ++i) { const int nr = i * 8 + (lane >> 3), kc = (lane & 7) * 8; float f[8];
#pragma unroll
        for (int j = 0; j < 8; ++j) f[j] = t[(kc + j) * 65 + nr];
        const int n = n0 + nr; const int drow = (mode == 0) ? n : (256 * (n >> 7) + (n & 127) + rowadd);
        u32x4 w; w.x = cvt_pk_bf16(f[0], f[1]); w.y = cvt_pk_bf16(f[2], f[3]); w.z = cvt_pk_bf16(f[4], f[5]); w.w = cvt_pk_bf16(f[6], f[7]);
        *(u32x4*)(dst + (size_t)drow * ldd + k0 + kc) = w; }
    asm volatile("s_waitcnt lgkmcnt(0)" ::: "memory");
}
__device__ __forceinline__ int conv_job(const float* src, int K, int N, int Npad, bf16_t* dst, int ldd, int rowadd, int mode, int tile0, LAS float* t, int gw, int ngw, int lane) {
    const int nkt = K / 64, nnt = Npad / 64, ntile = nkt * nnt;
    int first = (gw - tile0 % ngw + ngw) % ngw;
    for (int i = first; i < ntile; i += ngw) conv_tile(src, N, dst, ldd, (i / nnt) * 64, (i % nnt) * 64, rowadd, mode, t, lane);
    return tile0 + ntile;
}
__device__ __forceinline__ void conv_moe_layer(const Params& p, int layer, LAS unsigned char* lds) {
    const int tid = otid(), lane = tid & 63, wid = tid >> 6, gw = blockIdx.x * 8 + wid, ngw = gridDim.x * 8;
    LAS float* t = (LAS float*)(lds + wid * (64 * 65 * 4));
    bf16_t* GU = (bf16_t*)(p.ws + WS_GU); bf16_t* DN = (bf16_t*)(p.ws + WS_DN);
    int tile0 = 0;
    for (int e = 0; e < NEXP; ++e) {
        const size_t wo = ((size_t)layer * NEXP + e) * 1024 * 512;
        tile0 = conv_job(p.w_gate + wo, 1024, 512, 512, GU + (size_t)e * 1024 * 1024, 1024, 0, 1, tile0, t, gw, ngw, lane);
        tile0 = conv_job(p.w_up + wo, 1024, 512, 512, GU + (size_t)e * 1024 * 1024, 1024, 128, 1, tile0, t, gw, ngw, lane);
        tile0 = conv_job(p.w_down + wo, 512, 1024, 1024, DN + (size_t)e * 1024 * 512, 512, 0, 0, tile0, t, gw, ngw, lane);
    }
}
__device__ __forceinline__ void phase_prologue(const Params& p, LAS unsigned char* lds) {
    const int tid = otid(), lane = tid & 63, wid = tid >> 6, gw = blockIdx.x * 8 + wid, ngw = gridDim.x * 8;
    LAS float* t = (LAS float*)(lds + wid * (64 * 65 * 4));
    char* ws = p.ws;
    { const size_t n8 = (size_t)NTOK * 1024 / 8; bf16_t* xb = (bf16_t*)(ws + WS_XB);
      for (size_t i = (size_t)blockIdx.x * NTHREADS + tid; i < n8; i += (size_t)gridDim.x * NTHREADS) {
          const float4 a = *(const float4*)(p.x + i * 8), b = *(const float4*)(p.x + i * 8 + 4);
          u32x4 w; w.x = cvt_pk_bf16(a.x, a.y); w.y = cvt_pk_bf16(a.z, a.w); w.z = cvt_pk_bf16(b.x, b.y); w.w = cvt_pk_bf16(b.z, b.w);
          *(u32x4*)(xb + i * 8) = w; } }
    int tile0 = 0;
    tile0 = conv_job(p.moba_w_in, 1024, 3072, 3072, (bf16_t*)(ws + WS_WQKV0), 1024, 0, 0, tile0, t, gw, ngw, lane);
    tile0 = conv_job(p.moba_w_out, 1024, 1024, 1024, (bf16_t*)(ws + WS_WO0), 1024, 0, 0, tile0, t, gw, ngw, lane);
    tile0 = conv_job(p.nsa_w_in, 1024, 2608, 2816, (bf16_t*)(ws + WS_WIN1), 1024, 0, 0, tile0, t, gw, ngw, lane);
    tile0 = conv_job(p.nsa_w_out, 1024, 1024, 1024, (bf16_t*)(ws + WS_WO1), 1024, 0, 0, tile0, t, gw, ngw, lane);
    tile0 = conv_job(p.ck_w1, 2048, 256, 256, (bf16_t*)(ws + WS_W1T), 2048, 0, 0, tile0, t, gw, ngw, lane);
    tile0 = conv_job(p.cv_w1, 2048, 256, 256, (bf16_t*)(ws + WS_W1T) + 256 * 2048, 2048, 0, 0, tile0, t, gw, ngw, lane);
    conv_moe_layer(p, 0, lds);
    for (int i = blockIdx.x * NTHREADS + tid; i < 16 * BT_H; i += gridDim.x * NTHREADS) {
        const int h = i / BT_H, k = (i % BT_H) / BT_S, j = i % BT_S; int e = (BT_N - 1) - (j + k); e = e < 0 ? 0 : e;
        int n = e - 63; const bool future = n < 0; n = n < 0 ? 0 : (n > 127 ? 127 : n);
        int bk = n;
        if (n >= 16) { bk = 16 + (int)(logf((float)n / 16.0f) / logf(8.0f) * 16.0f); bk = bk > 31 ? 31 : bk; }
        ((float*)(ws + WS_TAB))[i] = future ? -INFINITY : p.rel_bias[bk * 16 + h] * LOG2E; }
    if (blockIdx.x < 32) { const int kv = blockIdx.x >> 4, part = (blockIdx.x & 15) * 2 + (tid >> 8), j = tid & 255;
        const float* pos = kv ? p.pos_v : p.pos_k; const float* w1 = kv ? p.cv_w1 : p.ck_w1; float s = 0.f;
#pragma unroll 16
        for (int k = part * 64; k < part * 64 + 64; ++k) s += pos[k] * w1[(size_t)k * 256 + j];
        ((float*)(ws + WS_B1))[(kv * 32 + part) * 256 + j] = s; }
}

template <int VAR> __device__ __forceinline__ void moba_unit(const Params& p, LAS unsigned char* lds, int b, int h, int qb) {
    const int tid = otid(), lane = tid & 63, r32 = lane & 31, hi = lane >> 5; const int wid = __builtin_amdgcn_readfirstlane(tid >> 6);
    const bf16_t* QKV = (const bf16_t*)(p.ws + WS_BIG);
    const size_t rowbase = (size_t)b * SEQ; const int q0 = qb * 256, qw = q0 + wid * 32;
    const bf16_t* Kb = QKV + rowbase * QKV_LD + 1024 + h * 64; const bf16_t* Vb = QKV + rowbase * QKV_LD + 2048 + h * 64;
    bf16x8 qr[4];
    { const bf16_t* qp = QKV + (rowbase + qw + r32) * QKV_LD + h * 64 + hi * 8;
#pragma unroll
      for (int d0 = 0; d0 < 4; ++d0) qr[d0] = *(const bf16x8*)(qp + d0 * 16); }
    __syncthreads();
    { const float* kp = (const float*)(p.ws + WS_KPART); const int j = tid >> 6, d = tid & 63;
      const float* s = kp + ((size_t)(b * 8 + j) * 2) * 1024 + h * 64 + d;
      ((LAS float*)(lds + AL_KM))[tid] = s[0] + s[1024];
      for (int i = tid; i < BT_H; i += NTHREADS) ((LAS float*)(lds + AL_BIAS))[i] = ((const float*)(p.ws + WS_TAB))[h * BT_H + i]; }
    const int NT = 4 + 4 * qb;
    __syncthreads();
    unsigned sel = 0;
    { float g[8];
#pragma unroll
      for (int j = 0; j < 8; ++j) { float s = 0.f; const LAS float* km = (const LAS float*)(lds + AL_KM) + j * 64 + hi * 8;
#pragma unroll
          for (int d0 = 0; d0 < 4; ++d0)
#pragma unroll
              for (int i = 0; i < 8; ++i) s += bf2f((bf16_t)qr[d0][i]) * km[d0 * 16 + i];
          g[j] = xhalf_sum(s); }
#pragma unroll
      for (int round = 0; round < 3; ++round) { int best = -1; float bv = 0.f;
#pragma unroll
          for (int j = 0; j < 8; ++j) { const bool ok = (j < qb) && !((sel >> j) & 1u) && (best < 0 || g[j] > bv); if (ok) { best = j; bv = g[j]; } }
          if (best >= 0) sel |= 1u << best; } }
    const LAS float* btab = (const LAS float*)(lds + AL_BIAS); const float cfar = btab[0];
    FState st; fstate_reset(st);
    struct MobaSrc {
        const bf16_t *Kb, *Vb; LAS unsigned char* lds; int qb, qw, wid, lane; unsigned sel;
        __device__ __forceinline__ void tile(int t, int& blk, int& kt) const { blk = t < 4 ? qb : qb - 1 - ((t - 4) >> 2); kt = t < 4 ? t : ((t - 4) & 3); }
        __device__ __forceinline__ void dma(int t, int ks, int vs) const { int blk, kt; tile(t, blk, kt); const size_t key0 = (size_t)blk * 256 + kt * 64;
            dma_k(Kb + key0 * QKV_LD, QKV_LD, lds, ks, wid, lane); dma_v(Vb + key0 * QKV_LD, QKV_LD, lds, vs, wid, lane); }
        __device__ __forceinline__ TileP params(int t) const { int blk, kt; tile(t, blk, kt); TileP tp; tp.Dmin = qw - (blk * 256 + kt * 64); tp.win = false;
            if (blk == qb) { tp.rowok = true; tp.run = (64 * kt <= wid * 32 + 31); } else { tp.rowok = (sel >> blk) & 1u; tp.run = __any(tp.rowok); }
            return tp; }
        __device__ __forceinline__ void after(int, FState&) const {}
    } S{Kb, Vb, lds, qb, qw, wid, lane, sel};
    attn_stream<VAR>(S, NT, st, qr, lds, btab, cfar, wid, lane, r32, hi);
    const float inv = 1.0f / xhalf_sum(st.l);
    bf16_t* op = (bf16_t*)(p.ws + (VAR ? WS_X1B : WS_AOH)) + (rowbase + qw + r32) * 1024 + h * 64 + 4 * hi;
#pragma unroll
    for (int g4 = 0; g4 < 4; ++g4) {
        u32x2 w0, w1; w0.x = cvt_pk_bf16(st.o0[4 * g4] * inv, st.o0[4 * g4 + 1] * inv); w0.y = cvt_pk_bf16(st.o0[4 * g4 + 2] * inv, st.o0[4 * g4 + 3] * inv);
        w1.x = cvt_pk_bf16(st.o1[4 * g4] * inv, st.o1[4 * g4 + 1] * inv); w1.y = cvt_pk_bf16(st.o1[4 * g4 + 2] * inv, st.o1[4 * g4 + 3] * inv);
        *(u32x2*)(op + 8 * g4) = w0; *(u32x2*)(op + 32 + 8 * g4) = w1; }
}
template <int VAR> __device__ __forceinline__ void phase_moba(const Params& p, LAS unsigned char* lds) {
    for (int pr = blockIdx.x, rnd = 0; pr < 1024; pr += gridDim.x, ++rnd) { const int x = blockIdx.x & 7, s = blockIdx.x >> 3; const int bh = (gridDim.x == 256) ? (x + 8 * (rnd * 8 + (s >> 2))) : (pr >> 2), j = (gridDim.x == 256) ? (s & 3) : (pr & 3);
        moba_unit<VAR>(p, lds, bh >> 4, bh & 15, 7 - j);
        moba_unit<VAR>(p, lds, bh >> 4, bh & 15, j); }
    __syncthreads();
}

__device__ __forceinline__ void nsa_unit(const Params& p, LAS unsigned char* lds, int b, int hkv, int c) {
    const int tid = otid(), lane = tid & 63, r32 = lane & 31, hi = lane >> 5; const int wid = __builtin_amdgcn_readfirstlane(tid >> 6);
    const bf16_t* P = (const bf16_t*)(p.ws + WS_BIG);
    const size_t rowbase = (size_t)b * SEQ; const int g = wid >> 1, qq0 = (wid & 1) * 32, h = hkv * 4 + g, qw = c * 64 + qq0, qpos = qw + r32;
    bf16x8 qr[4];
    const bf16_t* rowp = P + (rowbase + qpos) * NSA_LD;
#pragma unroll
    for (int d0 = 0; d0 < 4; ++d0) qr[d0] = *(const bf16x8*)(rowp + h * 64 + hi * 8 + d0 * 16);
    const float g0 = bf2f(rowp[NSA_G + h * 3]), g1 = bf2f(rowp[NSA_G + h * 3 + 1]), g2 = bf2f(rowp[NSA_G + h * 3 + 2]);
    __syncthreads();
    for (int i = tid; i < 4 * BT_H; i += NTHREADS) ((LAS float*)(lds + AL_BIAS))[i] = ((const float*)(p.ws + WS_TAB))[hkv * 4 * BT_H + i];
    if (tid < 64) ((LAS unsigned*)(lds + AL_SEL))[tid] = 0u;
    { const bf16_t* kc = (const bf16_t*)(p.ws + WS_KCMP) + (size_t)(b * 4 + hkv) * 128 * 64; const bf16_t* vc = (const bf16_t*)(p.ws + WS_VCMP) + (size_t)(b * 4 + hkv) * 128 * 64;
      dma_k(kc, 64, lds, 0, wid, lane); dma_k(kc + 64 * 64, 64, lds, 1, wid, lane); dma_v(vc, 64, lds, 0, wid, lane); dma_v(vc + 64 * 64, 64, lds, 1, wid, lane); }
    asm volatile("s_waitcnt vmcnt(0)" ::: "memory");
    __syncthreads();
    const lds_cptr kp0 = (lds_cptr)lds + AL_K + r32 * 128; const int kx = (r32 & 7) | (hi << 3);
    const lds_cptr vp0 = (lds_cptr)lds + AL_V + ((lane >> 4) & 1) * 32 + (lane & 3) * 8 + (4 * hi + ((lane & 15) >> 2)) * 64;
    f32x16 cb0, cb1;
    {
        f32x16 s[2][2];
        const int nlim = (qpos >= 31 ? ((qpos - 31) >> 4) + 1 : 0) - 4 * hi;
#pragma unroll
        for (int t = 0; t < 2; ++t) {
#pragma unroll
            for (int r = 0; r < 16; ++r) { s[t][0][r] = 0.f; s[t][1][r] = 0.f; }
            qk_tile(s[t][0], s[t][1], qr, kp0 + t * 8192, kx);
#pragma unroll
            for (int n2 = 0; n2 < 2; ++n2)
#pragma unroll
                for (int r = 0; r < 16; ++r) { const int nk = 64 * t + 32 * n2 + (r & 3) + 8 * (r >> 2); if (nk >= nlim) s[t][n2][r] = -INFINITY; }
        }
        const float mx = xhalf_max(__builtin_fmaxf(__builtin_fmaxf(max16(s[0][0]), max16(s[0][1])), __builtin_fmaxf(max16(s[1][0]), max16(s[1][1]))));
        const float mref = (mx == -INFINITY) ? 0.f : mx;
        float rs = 0.f;
#pragma unroll
        for (int t = 0; t < 2; ++t)
#pragma unroll
            for (int n2 = 0; n2 < 2; ++n2)
#pragma unroll
                for (int r = 0; r < 16; ++r) { const float e = __builtin_amdgcn_exp2f(s[t][n2][r] - mref); s[t][n2][r] = e; rs += e; }
        const float lt = xhalf_sum(rs); const float inv = lt > 0.f ? 1.0f / lt : 0.f;
#pragma unroll
        for (int t = 0; t < 2; ++t)
#pragma unroll
            for (int n2 = 0; n2 < 2; ++n2)
#pragma unroll
                for (int r = 0; r < 16; ++r) s[t][n2][r] *= inv;
        float Q[16], T[16];
#pragma unroll
        for (int t = 0; t < 2; ++t)
#pragma unroll
            for (int n2 = 0; n2 < 2; ++n2)
#pragma unroll
                for (int r4 = 0; r4 < 4; ++r4) { const int u = 8 * t + 4 * n2 + r4; Q[u] = (s[t][n2][4 * r4] + s[t][n2][4 * r4 + 1]) + (s[t][n2][4 * r4 + 2] + s[t][n2][4 * r4 + 3]); T[u] = s[t][n2][4 * r4 + 3]; }
        LAS float* imp = (LAS float*)(lds + AL_IMP) + (g * 64 + qq0 + r32) * 33;
        float prev = 0.f;
#pragma unroll
        for (int u = 0; u < 16; ++u) { const float rcv = __shfl_xor(T[u], 32); const float add = hi ? rcv : prev; prev = rcv; imp[2 * u + hi] = Q[u] + add; }
        f32x16 o0, o1;
#pragma unroll
        for (int r = 0; r < 16; ++r) { o0[r] = 0.f; o1[r] = 0.f; }
        pv_tile(o0, o1, s[0][0], s[0][1], vp0); pv_tile(o0, o1, s[1][0], s[1][1], vp0 + 8192);
#pragma unroll
        for (int r = 0; r < 16; ++r) { cb0[r] = g0 * o0[r]; cb1[r] = g0 * o1[r]; }
    }
    __syncthreads();
    {
        const int q = tid >> 3, jg = tid & 7; const LAS float* ib = (const LAS float*)(lds + AL_IMP) + q * 33;
        float val[32];
#pragma unroll
        for (int j = 0; j < 32; ++j) { float v = (ib[j] + ib[64 * 33 + j]) + (ib[2 * 64 * 33 + j] + ib[3 * 64 * 33 + j]);
            const bool forced = (j == 0) || (j == c) || (j == c - 1); v = forced ? INFINITY : v; val[j] = (j > c) ? -INFINITY : v; }
        unsigned bits = 0;
#pragma unroll
        for (int i = 0; i < 4; ++i) { const int j = jg * 4 + i; float vj = 0.f;
#pragma unroll
            for (int jj = 0; jj < 32; ++jj) vj = (jj == j) ? val[jj] : vj;
            int rank = 0;
#pragma unroll
            for (int jj = 0; jj < 32; ++jj) rank += (val[jj] > vj || (val[jj] == vj && jj < j)) ? 1 : 0;
            if (j <= c && rank < 16) bits |= 1u << j; }
        if (bits) atomicOr((unsigned*)(lds + AL_SEL) + q, bits);
    }
    __syncthreads();
    LAS float* stash = (LAS float*)(lds + AL_IMP) + wid * 2048 + lane;
#pragma unroll
    for (int r = 0; r < 16; ++r) { stash[r * 64] = cb0[r]; stash[(16 + r) * 64] = cb1[r]; }
    unsigned uni = ((const LAS unsigned*)(lds + AL_SEL))[lane];
#pragma unroll
    for (int o = 32; o > 0; o >>= 1) uni |= (unsigned)__shfl_xor((int)uni, o);
    uni = (unsigned)__builtin_amdgcn_readfirstlane((int)uni);
    const unsigned rowmask = ((const LAS unsigned*)(lds + AL_SEL))[qq0 + r32];
    const LAS float* btab = (const LAS float*)(lds + AL_BIAS) + g * BT_H; const float cfar = btab[0];
    const bf16_t* KS = P + rowbase * NSA_LD + NSA_KS + hkv * 64; const bf16_t* VS = P + rowbase * NSA_LD + NSA_VS + hkv * 64;
    const bf16_t* KW = P + rowbase * NSA_LD + NSA_KW + hkv * 64; const bf16_t* VW = P + rowbase * NSA_LD + NSA_VW + hkv * 64;
    const int nslc = __builtin_popcount(uni); const int wlo = c >= 8 ? 0 : 8 - c; const int NT = nslc + (9 - wlo);
    LAS int* list = (LAS int*)(lds + AL_LIST);
    if (tid < 32) { if ((uni >> tid) & 1u) list[__builtin_popcount(uni & ((1u << tid) - 1u))] = tid; }
    else if (tid < 32 + 9 - wlo) list[nslc + (tid - 32)] = 64 + (c - 8 + wlo + (tid - 32));
    __syncthreads();
    FState st; fstate_reset(st);
    struct NsaSrc {
        const bf16_t *KS, *VS, *KW, *VW; LAS unsigned char* lds; const LAS int* list; int nslc, qw, wid, lane; unsigned rowmask; float g1; LAS float* stash;
        __device__ __forceinline__ void dma(int t, int ks, int vs) const { const int e = __builtin_amdgcn_readfirstlane(list[t]);
            if (e < 64) { dma_k(KS + (size_t)e * 64 * NSA_LD, NSA_LD, lds, ks, wid, lane); dma_v(VS + (size_t)e * 64 * NSA_LD, NSA_LD, lds, vs, wid, lane); }
            else { dma_k(KW + (size_t)(e - 64) * 64 * NSA_LD, NSA_LD, lds, ks, wid, lane); dma_v(VW + (size_t)(e - 64) * 64 * NSA_LD, NSA_LD, lds, vs, wid, lane); } }
        __device__ __forceinline__ TileP params(int t) const { const int e = __builtin_amdgcn_readfirstlane(list[t]); TileP tp;
            if (e < 64) { tp.Dmin = qw - 64 * e; tp.rowok = (rowmask >> e) & 1u; tp.run = __any(tp.rowok); tp.win = false; }
            else { tp.Dmin = qw - 64 * (e - 64); tp.rowok = true; tp.run = true; tp.win = true; }
            return tp; }
        __device__ __forceinline__ void after(int t, FState& st) const {
            if (t == nslc - 1) { const float f = g1 / xhalf_sum(st.l);
#pragma unroll
                for (int r = 0; r < 16; ++r) { stash[r * 64] += f * st.o0[r]; stash[(16 + r) * 64] += f * st.o1[r]; }
                fstate_reset(st); } }
    } S{KS, VS, KW, VW, lds, list, nslc, qw, wid, lane, rowmask, g1, stash};
    attn_stream<0>(S, NT, st, qr, lds, btab, cfar, wid, lane, r32, hi);
    { const float f = g2 / xhalf_sum(st.l);
#pragma unroll
      for (int r = 0; r < 16; ++r) { cb0[r] = stash[r * 64] + f * st.o0[r]; cb1[r] = stash[(16 + r) * 64] + f * st.o1[r]; } }
    bf16_t* op = (bf16_t*)(p.ws + WS_AOH) + (rowbase + qpos) * 1024 + h * 64 + 4 * hi;
#pragma unroll
    for (int g4 = 0; g4 < 4; ++g4) {
        u32x2 w0, w1; w0.x = cvt_pk_bf16(cb0[4 * g4], cb0[4 * g4 + 1]); w0.y = cvt_pk_bf16(cb0[4 * g4 + 2], cb0[4 * g4 + 3]);
        w1.x = cvt_pk_bf16(cb1[4 * g4], cb1[4 * g4 + 1]); w1.y = cvt_pk_bf16(cb1[4 * g4 + 2], cb1[4 * g4 + 3]);
        *(u32x2*)(op + 8 * g4) = w0; *(u32x2*)(op + 32 + 8 * g4) = w1; }
}
__device__ __forceinline__ void phase_nsa(const Params& p, LAS unsigned char* lds) {
    for (int pr = blockIdx.x, rnd = 0; pr < 1024; pr += gridDim.x, ++rnd) { const int x = blockIdx.x & 7, s = blockIdx.x >> 3; const int bh = (gridDim.x == 256) ? (x + 8 * (rnd * 2 + (s >> 4))) : (pr >> 4), j = (gridDim.x == 256) ? (s & 15) : (pr & 15);
        nsa_unit(p, lds, bh >> 2, bh & 3, 31 - j);
        nsa_unit(p, lds, bh >> 2, bh & 3, j); }
    __syncthreads();
}

template <int L> __device__ __forceinline__ void phase_ln1(const Params& p, LAS unsigned char* lds) {
    const int tid = otid(), lane = tid & 63, wid = tid >> 6, r = lane & 15, q = lane >> 4;
    const float* lg = p.ln_g + (L * 2 + 0) * 1024; const float* lb = p.ln_b + (L * 2 + 0) * 1024;
    const bf16_t* Y = (const bf16_t*)(p.ws + WS_BIG); bf16_t* X1 = (bf16_t*)(p.ws + WS_X1B);
    for (int i = tid; i < 32 * 2 * 64; i += NTHREADS) { const int l2 = i & 63, nb = (i >> 6) & 1, s = i >> 7; const int e = 16 * nb + (l2 & 15), k0 = 32 * s + 8 * (l2 >> 4);
        float w[8]; unsigned hw[4], lw[4];
#pragma unroll
        for (int j = 0; j < 8; ++j) w[j] = p.router_w[(size_t)(k0 + j) * 32 + e];
#pragma unroll
        for (int j = 0; j < 4; ++j) { hw[j] = cvt_pk_bf16(w[2 * j], w[2 * j + 1]); lw[j] = cvt_pk_bf16(w[2 * j] - lo_bf(hw[j]), w[2 * j + 1] - hi_bf(hw[j])); }
        *(LAS u32x4*)(lds + ((size_t)((s * 2 + nb) * 2 + 0) * 64 + l2) * 16) = (u32x4){hw[0], hw[1], hw[2], hw[3]};
        *(LAS u32x4*)(lds + ((size_t)((s * 2 + nb) * 2 + 1) * 64 + l2) * 16) = (u32x4){lw[0], lw[1], lw[2], lw[3]}; }
    LAS int* hist = (LAS int*)(lds + 131072 + 8 * 2048);
    if (tid < 32) hist[tid] = 0;
    __syncthreads();
    for (int tb = blockIdx.x; tb < NTOK / 128; tb += gridDim.x) {
        const int tok = tb * 128 + wid * 16 + r;
        const bf16_t* yp = Y + (size_t)tok * 1024 + 8 * q;
        float sum = 0.f, sq = 0.f;
#pragma unroll 8
        for (int s = 0; s < 32; ++s) { const u32x4 y = *(const u32x4*)(yp + 32 * s); const unsigned yw[4] = {y.x, y.y, y.z, y.w};
#pragma unroll
            for (int j = 0; j < 4; ++j) { const float a = lo_bf(yw[j]), b2 = hi_bf(yw[j]); sum += a + b2; sq += a * a + b2 * b2; } }
        sum += __shfl_xor(sum, 16); sum += __shfl_xor(sum, 32); sq += __shfl_xor(sq, 16); sq += __shfl_xor(sq, 32);
        const float mu = sum * (1.0f / 1024.0f);
        const float rstd = rsqrtf(fmaxf(sq * (1.0f / 1024.0f) - mu * mu, 0.f) + 1e-5f);
        f32x4 acc0 = (f32x4){0.f, 0.f, 0.f, 0.f}, acc1 = acc0;
        bf16_t* xp = X1 + (size_t)tok * 1024 + 8 * q;
#pragma unroll 2
        for (int s = 0; s < 32; ++s) {
            const u32x4 y = *(const u32x4*)(yp + 32 * s);
            const f32x4 ga = *(const f32x4*)(lg + 32 * s + 8 * q), gb = *(const f32x4*)(lg + 32 * s + 8 * q + 4), ba = *(const f32x4*)(lb + 32 * s + 8 * q), bb = *(const f32x4*)(lb + 32 * s + 8 * q + 4);
            u32x4 w;
            w.x = cvt_pk_bf16((lo_bf(y.x) - mu) * rstd * ga[0] + ba[0], (hi_bf(y.x) - mu) * rstd * ga[1] + ba[1]);
            w.y = cvt_pk_bf16((lo_bf(y.y) - mu) * rstd * ga[2] + ba[2], (hi_bf(y.y) - mu) * rstd * ga[3] + ba[3]);
            w.z = cvt_pk_bf16((lo_bf(y.z) - mu) * rstd * gb[0] + bb[0], (hi_bf(y.z) - mu) * rstd * gb[1] + bb[1]);
            w.w = cvt_pk_bf16((lo_bf(y.w) - mu) * rstd * gb[2] + bb[2], (hi_bf(y.w) - mu) * rstd * gb[3] + bb[3]);
            *(u32x4*)(xp + 32 * s) = w;
            const bf16x8 af = __builtin_bit_cast(bf16x8, w);
            const LAS unsigned char* bq = lds + (size_t)s * 4096 + lane * 16;
            const bf16x8 b0h = *(const LAS bf16x8*)(bq), b0l = *(const LAS bf16x8*)(bq + 1024), b1h = *(const LAS bf16x8*)(bq + 2048), b1l = *(const LAS bf16x8*)(bq + 3072);
            acc0 = __builtin_amdgcn_mfma_f32_16x16x32_bf16(af, b0h, acc0, 0, 0, 0); acc0 = __builtin_amdgcn_mfma_f32_16x16x32_bf16(af, b0l, acc0, 0, 0, 0);
            acc1 = __builtin_amdgcn_mfma_f32_16x16x32_bf16(af, b1h, acc1, 0, 0, 0); acc1 = __builtin_amdgcn_mfma_f32_16x16x32_bf16(af, b1l, acc1, 0, 0, 0);
        }
        LAS float* lg2 = (LAS float*)(lds + 131072 + wid * 2048);
#pragma unroll
        for (int i = 0; i < 4; ++i) { lg2[(4 * q + i) * 32 + r] = acc0[i] + p.router_b[r]; lg2[(4 * q + i) * 32 + 16 + r] = acc1[i] + p.router_b[16 + r]; }
        asm volatile("s_waitcnt lgkmcnt(0)" ::: "memory");
        int e0 = 0, e1 = 0, r0 = 0, r1 = 0; float w0 = 0.f, w1 = 0.f;
        if (lane < 16) {
            float pr[32]; float mx = -INFINITY;
#pragma unroll
            for (int e = 0; e < 32; ++e) { pr[e] = lg2[lane * 32 + e]; mx = fmaxf(mx, pr[e]); }
#pragma unroll
            for (int e = 0; e < 32; ++e) pr[e] = __expf(pr[e] - mx);
            int best = 0; float bs = -1.f;
#pragma unroll
            for (int gi = 0; gi < 8; ++gi) { const float a = pr[4 * gi], b2 = pr[4 * gi + 1], c2 = pr[4 * gi + 2], d2 = pr[4 * gi + 3];
                const float h1 = fmaxf(a, b2), l1 = fminf(a, b2), h2 = fmaxf(c2, d2), l2 = fminf(c2, d2);
                const float m1 = fmaxf(h1, h2), m2 = fmaxf(fminf(h1, h2), fmaxf(l1, l2));
                const float sc = m1 + m2; if (sc > bs) { bs = sc; best = gi; } }
            float v[4];
#pragma unroll
            for (int gi = 0; gi < 8; ++gi) if (gi == best) { v[0] = pr[4 * gi]; v[1] = pr[4 * gi + 1]; v[2] = pr[4 * gi + 2]; v[3] = pr[4 * gi + 3]; }
            int i0 = 0; float v0 = v[0];
#pragma unroll
            for (int i = 1; i < 4; ++i) if (v[i] > v0) { v0 = v[i]; i0 = i; }
            int i1 = -1; float v1 = -1.f;
#pragma unroll
            for (int i = 0; i < 4; ++i) if (i != i0 && v[i] > v1) { v1 = v[i]; i1 = i; }
            e0 = best * 4 + i0; e1 = best * 4 + i1; const float ws = 1.0f / (v0 + v1); w0 = v0 * ws; w1 = v1 * ws;
            r0 = atomicAdd((int*)hist + e0, 1); r1 = atomicAdd((int*)hist + e1, 1);
        }
        __syncthreads();
        if (tid < 32) { const int hv = hist[tid]; hist[32 + tid] = hv ? atomicAdd((int*)(p.ws + WS_GCNT) + L * 32 + tid, hv) : 0; }
        __syncthreads();
        if (lane < 16) { const int t2 = tb * 128 + wid * 16 + lane; const int s0 = hist[32 + e0] + r0, s1 = hist[32 + e1] + r1;
            ((int*)(p.ws + WS_RE))[t2 * 2] = e0; ((int*)(p.ws + WS_RE))[t2 * 2 + 1] = e1;
            ((float*)(p.ws + WS_RWT))[t2 * 2] = w0; ((float*)(p.ws + WS_RWT))[t2 * 2 + 1] = w1;
            ((int*)(p.ws + WS_POS))[t2 * 2] = s0; ((int*)(p.ws + WS_POS))[t2 * 2 + 1] = s1;
            ((int*)(p.ws + WS_ROWTOK))[e0 * 65536 + s0] = t2; ((int*)(p.ws + WS_ROWTOK))[e1 * 65536 + s1] = t2; }
        __syncthreads();
        if (tid < 32) hist[tid] = 0;
        __syncthreads();
    }
}

template <int L> __device__ __forceinline__ void phase_ln2(const Params& p, LAS unsigned char* lds) {
    const int tid = otid(), lane = tid & 63, wid = tid >> 6;
    LAS int* pst = (LAS int*)lds;
    __syncthreads();
    if (tid == 0) { const int* cnt = (const int*)(p.ws + WS_GCNT) + L * 32; int s = 0; for (int e = 0; e < NEXP; ++e) { pst[e] = s; s += (cnt[e] + 255) & ~255; } }
    __syncthreads();
    const int* RE = (const int*)(p.ws + WS_RE);
    const float* lg = p.ln_g + (L * 2 + 1) * 1024; const float* lb = p.ln_b + (L * 2 + 1) * 1024;
    const bf16_t* X1 = (const bf16_t*)(p.ws + WS_X1B); const bf16_t* YB = (const bf16_t*)(p.ws + WS_BIG);
    const int* POS = (const int*)(p.ws + WS_POS); const float* RW = (const float*)(p.ws + WS_RWT);
    for (int tok = blockIdx.x * 8 + wid; tok < NTOK; tok += gridDim.x * 8) {
        const int s0 = pst[RE[tok * 2]] + POS[tok * 2], s1 = pst[RE[tok * 2 + 1]] + POS[tok * 2 + 1]; const float w0 = RW[tok * 2], w1 = RW[tok * 2 + 1];
        float v[16];
#pragma unroll
        for (int hf = 0; hf < 2; ++hf) { const int c0 = hf * 512 + lane * 8;
            const u32x4 a = *(const u32x4*)(X1 + (size_t)tok * 1024 + c0), b = *(const u32x4*)(YB + (size_t)s0 * 1024 + c0), c = *(const u32x4*)(YB + (size_t)s1 * 1024 + c0);
            const unsigned aw[4] = {a.x, a.y, a.z, a.w}, bw[4] = {b.x, b.y, b.z, b.w}, cw[4] = {c.x, c.y, c.z, c.w};
#pragma unroll
            for (int j = 0; j < 4; ++j) { v[hf * 8 + 2 * j] = ALPHA * lo_bf(aw[j]) + w0 * lo_bf(bw[j]) + w1 * lo_bf(cw[j]); v[hf * 8 + 2 * j + 1] = ALPHA * hi_bf(aw[j]) + w0 * hi_bf(bw[j]) + w1 * hi_bf(cw[j]); } }
        float s = 0.f;
#pragma unroll
        for (int i = 0; i < 16; ++i) s += v[i];
        const float mu = wave_sum(s) * (1.0f / 1024.0f);
        float qv = 0.f;
#pragma unroll
        for (int i = 0; i < 16; ++i) { const float d = v[i] - mu; qv += d * d; }
        const float rstd = rsqrtf(wave_sum(qv) * (1.0f / 1024.0f) + 1e-5f);
#pragma unroll
        for (int hf = 0; hf < 2; ++hf) { const int c0 = hf * 512 + lane * 8; float o[8];
            const f32x4 ga = *(const f32x4*)(lg + c0), gb = *(const f32x4*)(lg + c0 + 4), ba = *(const f32x4*)(lb + c0), bb = *(const f32x4*)(lb + c0 + 4);
#pragma unroll
            for (int j = 0; j < 4; ++j) { o[j] = (v[hf * 8 + j] - mu) * rstd * ga[j] + ba[j]; o[4 + j] = (v[hf * 8 + 4 + j] - mu) * rstd * gb[j] + bb[j]; }
            if (L == 1) { *(f32x4*)(p.out + (size_t)tok * 1024 + c0) = (f32x4){o[0], o[1], o[2], o[3]}; *(f32x4*)(p.out + (size_t)tok * 1024 + c0 + 4) = (f32x4){o[4], o[5], o[6], o[7]}; }
            else { u32x4 w; w.x = cvt_pk_bf16(o[0], o[1]); w.y = cvt_pk_bf16(o[2], o[3]); w.z = cvt_pk_bf16(o[4], o[5]); w.w = cvt_pk_bf16(o[6], o[7]); *(u32x4*)((bf16_t*)(p.ws + WS_XB) + (size_t)tok * 1024 + c0) = w; } }
    }
}

__device__ __forceinline__ void phase_cmpfin(const Params& p, LAS unsigned char* lds) {
    const int tid = otid(), lane = tid & 63, wid = tid >> 6;
    LAS float* w2s = (LAS float*)lds;
    LAS float* hs = (LAS float*)(lds + 65536) + wid * 1024;
    LAS float* b1s = (LAS float*)(lds + 65536 + 32768);
    const float* CP = (const float*)(p.ws + WS_X1B); const float* B1 = (const float*)(p.ws + WS_B1);
    for (int kv = 0; kv < 2; ++kv) {
        __syncthreads();
        { const float* w2g = kv ? p.cv_w2 : p.ck_w2; for (int i = tid; i < 256 * 64; i += NTHREADS) w2s[i] = w2g[i]; }
        if (tid < 256) { float b1 = 0.f;
#pragma unroll 8
            for (int pt = 0; pt < 32; ++pt) b1 += B1[(kv * 32 + pt) * 256 + tid];
            b1s[tid] = b1; }
        __syncthreads();
        bf16_t* dst = (bf16_t*)(p.ws + (kv ? WS_VCMP : WS_KCMP));
        for (int rg = blockIdx.x * 8 + wid; rg < 8192 / 4; rg += gridDim.x * 8) {
            const int m0 = rg * 4;
#pragma unroll
            for (int i = 0; i < 4; ++i) { const int j = lane + 64 * i; const float b1 = b1s[j];
                f32x4 hv;
#pragma unroll
                for (int rr = 0; rr < 4; ++rr) { float a = b1;
#pragma unroll
                    for (int ks = 0; ks < 4; ++ks) a += CP[((size_t)(kv * 4 + ks) * 8192 + m0 + rr) * 256 + j];
                    const float u = 0.7978845608028654f * (a + 0.044715f * a * a * a); const float th = 1.0f - 2.0f / (1.0f + __expf(2.0f * u));
                    hv[rr] = 0.5f * a * (1.0f + th); }
                *(LAS f32x4*)(hs + j * 4) = hv; }
            asm volatile("s_waitcnt lgkmcnt(0)" ::: "memory");
            f32x4 o = (f32x4){0.f, 0.f, 0.f, 0.f}; const LAS float* w2 = w2s + lane;
#pragma unroll 8
            for (int j = 0; j < 256; ++j) o += *(const LAS f32x4*)(hs + j * 4) * w2[j * 64];
#pragma unroll
            for (int rr = 0; rr < 4; ++rr) dst[(size_t)(m0 + rr) * 64 + lane] = f2bf((((m0 + rr) & 127) == 127) ? 0.f : o[rr]);
            asm volatile("s_waitcnt lgkmcnt(0)" ::: "memory");
        }
    }
}

constexpr int NPHASE = 19;
template <int PH> __device__ __forceinline__ void run_phase(const Params& p, LAS unsigned char* lds) {
    char* ws = p.ws;
    if constexpr (PH == 0) phase_prologue(p, lds);
    else if constexpr (PH == 1) { SchedPlain S; S.init(ws + WS_XB, ws + WS_WQKV0, NTOK, 3072, 1024); EpiQKV0 E{(bf16_t*)(ws + WS_BIG), (float*)(ws + WS_KPART)}; pg8::gemm_phase(lds, S, E); }
    else if constexpr (PH == 2) phase_moba<0>(p, lds);
    else if constexpr (PH == 3) { SchedPlain S; S.init(ws + WS_AOH, ws + WS_WO0, NTOK, 1024, 1024); EpiRes<true> E{(bf16_t*)(ws + WS_BIG), p.x, nullptr}; pg8::gemm_phase(lds, S, E); }
    else if constexpr (PH == 4) phase_ln1<0>(p, lds);
    else if constexpr (PH == 6 || PH == 16) { SchedMoeGU S; S.init(ws, PH == 16, lds); EpiGU E{(bf16_t*)(ws + WS_AOH)}; pg8::gemm_phase(lds, S, E); }
    else if constexpr (PH == 7 || PH == 17) { SchedMoeDN S; S.init(ws, PH == 17, lds); EpiDN E{(bf16_t*)(ws + WS_BIG)}; pg8::gemm_phase(lds, S, E); }
    else if constexpr (PH == 8) { phase_ln2<0>(p, lds); __syncthreads(); conv_moe_layer(p, 1, lds); }
    else if constexpr (PH == 9) { SchedPlain S; S.init(ws + WS_XB, ws + WS_WIN1, NTOK, 2816, 1024); EpiNSA E{(bf16_t*)(ws + WS_BIG)}; pg8::gemm_phase(lds, S, E); }
    else if constexpr (PH == 10) { SchedCmp S; S.init(ws); EpiCmp E{(float*)(ws + WS_X1B)}; pg8::gemm_phase(lds, S, E); }
    else if constexpr (PH == 11) phase_cmpfin(p, lds);
    else if constexpr (PH == 12) phase_nsa(p, lds);
    else if constexpr (PH == 13) { SchedPlain S; S.init(ws + WS_AOH, ws + WS_WO1, NTOK, 1024, 1024); EpiRes<false> E{(bf16_t*)(ws + WS_BIG), nullptr, (const bf16_t*)(ws + WS_XB)}; pg8::gemm_phase(lds, S, E); }
    else if constexpr (PH == 14) phase_ln1<1>(p, lds);
    else if constexpr (PH == 18) phase_ln2<1>(p, lds);
}

extern __shared__ __attribute__((aligned(16))) unsigned char g_smem[];

template <int PH> __global__ void __launch_bounds__(NTHREADS, 2) k_phase(Params p) {
    run_phase<PH>(p, (LAS unsigned char*)g_smem);
}

#if !MK_LAUNCHES
template <int PH> __device__ __forceinline__ void mega_seq(const Params& p, LAS unsigned char* lds, const XcdBarrier& bar) {
    if constexpr (PH == 5 || PH == 15) { mega_seq<PH + 1>(p, lds, bar); return; }
    run_phase<PH>(p, lds);
#ifdef PROBE_VAR
    if constexpr (PH == 2) { xcd_barrier(bar); phase_moba<PROBE_VAR>(p, lds); }
#endif
#ifdef PROBE_MASK
    if constexpr ((PROBE_MASK >> PH) & 1) { xcd_barrier(bar); run_phase<PH>(p, lds); }
#endif
    if constexpr (PH + 1 < NPHASE) { xcd_barrier(bar); mega_seq<PH + 1>(p, lds, bar); }
}
__global__ void __launch_bounds__(NTHREADS, 2) k_mega(Params p) {
    LAS unsigned char* lds = (LAS unsigned char*)g_smem;
    LAS unsigned* stw = (LAS unsigned*)(lds + LDS_BYTES - 16);
    if (threadIdx.x == 0) { stw[0] = 0u; stw[1] = 0u; stw[2] = 0u; stw[3] = 0u; }
    __syncthreads();
    XcdBarrier bar = xcd_barrier_post((unsigned*)(p.ws + WS_CTL), (volatile LAS unsigned*)stw);
    mega_seq<0>(p, lds, bar);
}

#endif
template <int PH> static void launch_phases(const Params& p, int grid, hipStream_t stream) {
    hipFuncSetAttribute((const void*)k_phase<PH>, hipFuncAttributeMaxDynamicSharedMemorySize, LDS_BYTES);
    hipLaunchKernelGGL(k_phase<PH>, dim3(grid), dim3(NTHREADS), LDS_BYTES, stream, p);
    if constexpr (PH + 1 < NPHASE) launch_phases<PH + 1>(p, grid, stream);
}

extern "C" void kernel_launch(void* const* d_in, const int* in_sizes, int n_in, void* d_out, int out_size, void* d_ws, size_t ws_size, hipStream_t stream) {
    if (n_in != 19 || ws_size < WS_END) { fprintf(stderr, "kernel_launch: need 19 inputs and %zu bytes of workspace (got %d, %zu)\n", (size_t)WS_END, n_in, ws_size); return; }
    Params p{};
    p.x = (const float*)d_in[0]; p.rel_bias = (const float*)d_in[1]; p.router_w = (const float*)d_in[2]; p.router_b = (const float*)d_in[3];
    p.ln_g = (const float*)d_in[4]; p.ln_b = (const float*)d_in[5]; p.moba_w_in = (const float*)d_in[6]; p.moba_w_out = (const float*)d_in[7];
    p.nsa_w_in = (const float*)d_in[8]; p.nsa_w_out = (const float*)d_in[9]; p.pos_k = (const float*)d_in[10]; p.pos_v = (const float*)d_in[11];
    p.ck_w1 = (const float*)d_in[12]; p.ck_w2 = (const float*)d_in[13]; p.cv_w1 = (const float*)d_in[14]; p.cv_w2 = (const float*)d_in[15];
    p.w_gate = (const float*)d_in[16]; p.w_up = (const float*)d_in[17]; p.w_down = (const float*)d_in[18];
    p.out = (float*)d_out; p.ws = (char*)d_ws;
    const int grid = NWG_EXPECT;
#if MK_LAUNCHES
    launch_phases<0>(p, grid, stream);
#else
    hipFuncSetAttribute((const void*)k_mega, hipFuncAttributeMaxDynamicSharedMemorySize, LDS_BYTES);
    hipMemsetAsync((char*)d_ws + WS_CTL, 0, 16384, stream);
    hipLaunchKernelGGL(k_mega, dim3(grid), dim3(NTHREADS), LDS_BYTES, stream, p);
#endif
}
```

```cpp
#include <hip/hip_runtime.h>
#include <cstdio>
#include <cstdint>

#ifndef MK_LAUNCHES
#define MK_LAUNCHES 0
#endif

#define LAS __attribute__((address_space(3)))
typedef unsigned short bf16_t;
typedef short bf16x8 __attribute__((ext_vector_type(8)));
typedef short s16x4 __attribute__((ext_vector_type(4)));
typedef short v4i16_t __attribute__((ext_vector_type(4)));
typedef float f32x4 __attribute__((ext_vector_type(4)));
typedef float f32x16 __attribute__((ext_vector_type(16)));
typedef unsigned u32x4 __attribute__((ext_vector_type(4)));
typedef unsigned u32x2 __attribute__((ext_vector_type(2)));
typedef LAS const char* lds_cptr;

constexpr int NTOK = 32768, DM = 1024, SEQ = 2048, NBATCH = 16, NHEAD = 16;
constexpr int QKV_LD = 3072, NSA_LD = 2816;
constexpr int NSA_KC = 1024, NSA_VC = 1280, NSA_KS = 1536, NSA_VS = 1792, NSA_KW = 2048, NSA_VW = 2304, NSA_G = 2560;
constexpr int NEXP = 32, DEXP = 512, MAXPAN = 288, RPAD = MAXPAN * 256;
constexpr int NTHREADS = 512, NWG_EXPECT = 256;
constexpr int LDS_BYTES = 155648;
constexpr float LOG2E = 1.4426950408889634f;
constexpr float C2 = 0.125f * LOG2E;
constexpr float ALPHA = 1.4142135623730951f;
constexpr int BT_N = 288;
constexpr int BT_S = 292, BT_H = 4 * BT_S;

constexpr size_t al256(size_t x) { return (x + 255) & ~(size_t)255; }
constexpr size_t WS_CTL = 0;
constexpr size_t WS_GCNT = 14336;
constexpr size_t WS_TAB = 16384;
constexpr size_t WS_B1 = WS_TAB + al256(16 * BT_H * 4);
constexpr size_t WS_NPAN = WS_B1 + 65536;
constexpr size_t WS_PANEL = WS_NPAN + 256;
constexpr size_t WS_HIST = WS_PANEL + 1280;
constexpr size_t WS_KPART = WS_HIST + 32768;
constexpr size_t WS_RE = WS_KPART + 128 * 2 * 1024 * 4;
constexpr size_t WS_RWT = WS_RE + (size_t)NTOK * 8;
constexpr size_t WS_POS = WS_RWT + (size_t)NTOK * 8;
constexpr size_t WS_ROWTOK = WS_POS + (size_t)NTOK * 8;
constexpr size_t WS_KCMP = WS_ROWTOK + (size_t)32 * 65536 * 4;
constexpr size_t WS_VCMP = WS_KCMP + 16 * 4 * 128 * 64 * 2;
constexpr size_t WS_WQKV0 = WS_VCMP + 16 * 4 * 128 * 64 * 2;
constexpr size_t WS_WO0 = WS_WQKV0 + (size_t)3072 * 1024 * 2;
constexpr size_t WS_WIN1 = WS_WO0 + (size_t)1024 * 1024 * 2;
constexpr size_t WS_WO1 = WS_WIN1 + (size_t)2816 * 1024 * 2;
constexpr size_t WS_W1T = WS_WO1 + (size_t)1024 * 1024 * 2;
constexpr size_t WS_GU = WS_W1T + (size_t)2 * 256 * 2048 * 2;
constexpr size_t WS_DN = WS_GU + (size_t)32 * 1024 * 1024 * 2;
constexpr size_t WS_XB = WS_DN + (size_t)32 * 1024 * 512 * 2;
constexpr size_t WS_BIG = WS_XB + (size_t)NTOK * 1024 * 2;
constexpr size_t WS_AOH = WS_BIG + (size_t)NTOK * 3072 * 2;
constexpr size_t WS_X1B = WS_AOH + (size_t)RPAD * 512 * 2;
constexpr size_t WS_END = WS_X1B + (size_t)NTOK * 1024 * 2;

struct Params {
    const float *x, *rel_bias, *router_w, *router_b, *ln_g, *ln_b, *moba_w_in, *moba_w_out, *nsa_w_in, *nsa_w_out, *pos_k, *pos_v,
                *ck_w1, *ck_w2, *cv_w1, *cv_w2, *w_gate, *w_up, *w_down;
    float* out;
    char* ws;
};

__device__ __forceinline__ int otid() { int t = threadIdx.x; asm volatile("" : "+v"(t)); return t; }
__device__ __forceinline__ float bf2f(bf16_t v) { return __uint_as_float(((unsigned)v) << 16); }
__device__ __forceinline__ unsigned cvt_pk_bf16(float lo, float hi) { unsigned r; asm volatile("v_cvt_pk_bf16_f32 %0, %1, %2" : "=v"(r) : "v"(lo), "v"(hi)); return r; }
__device__ __forceinline__ bf16_t f2bf(float f) { return (bf16_t)(cvt_pk_bf16(f, 0.f) & 0xffffu); }
__device__ __forceinline__ float lo_bf(unsigned w) { return __uint_as_float(w << 16); }
__device__ __forceinline__ float hi_bf(unsigned w) { return __uint_as_float(w & 0xffff0000u); }
__device__ __forceinline__ float wave_sum(float v) {
#pragma unroll
    for (int o = 32; o > 0; o >>= 1) v += __shfl_xor(v, o);
    return v; }

#define XB_TMO      128
#define XB_XCNT(j)  (256  + 64 * (j))
#define XB_XSUB(j)  (1280 + 64 * (j))
#define XB_XGEN(j)  (2304 + 64 * (j))
#define XB_TOP      3328
#define XB_TOPGEN   3392
#define XCD_BAR_WORDS 3456
#define XB_SPIN_CAP (1u << 18)
__device__ __forceinline__ unsigned xb_ld(unsigned* p)              { return __hip_atomic_load(p, __ATOMIC_RELAXED, __HIP_MEMORY_SCOPE_AGENT); }
__device__ __forceinline__ unsigned xb_add(unsigned* p, unsigned v) { return __hip_atomic_fetch_add(p, v, __ATOMIC_RELAXED, __HIP_MEMORY_SCOPE_AGENT); }
__device__ __forceinline__ unsigned xb_xcc_id() { return (unsigned)__builtin_amdgcn_s_getreg((3 << 11) | 20) & 0xFu; }
#define XB_SPIN(cond, bar) do { unsigned _sp = 0; while (cond) { __builtin_amdgcn_s_sleep(1); \
    if ((++_sp & 255u) == 0u) { if (xb_ld(&(bar)[XB_TMO])) break; if (_sp > XB_SPIN_CAP) { atomicAdd(&(bar)[XB_TMO], 1u); break; } } } } while (0)
struct XcdBarrier { unsigned* bar; unsigned x; volatile LAS unsigned* st; };
__device__ __forceinline__ XcdBarrier xcd_barrier_post(unsigned* bar, volatile LAS unsigned* st) {
    XcdBarrier b; b.bar = bar; b.x = xb_xcc_id(); b.st = st;
    if (threadIdx.x == 0) (void)xb_add(&bar[XB_XCNT(b.x)], 1u);
    return b;
}
__device__ __forceinline__ void xcd_barrier_complete(unsigned* bar, unsigned x, unsigned& nloc, unsigned& nx) {
    const unsigned G = gridDim.x * gridDim.y * gridDim.z;
    unsigned sum, cnt, mine, sp = 0u;
    for (;;) {
        sum = 0u; cnt = 0u; mine = 0u;
#pragma unroll
        for (unsigned j = 0; j < 16; ++j) { const unsigned c = xb_ld(&bar[XB_XCNT(j)]); sum += c; cnt += (c > 0u) ? 1u : 0u; mine = (j == x) ? c : mine; }
        if (sum == G) break;
        __builtin_amdgcn_s_sleep(1);
        if ((++sp & 255u) == 0u) { if (xb_ld(&bar[XB_TMO])) break; if (sp > XB_SPIN_CAP) { atomicAdd(&bar[XB_TMO], 1u); break; } }
    }
    nloc = mine > 0u ? mine : 1u; nx = cnt > 0u ? cnt : 1u;
}
__device__ __forceinline__ void xcd_barrier(const XcdBarrier& b) {
    asm volatile("s_waitcnt vmcnt(0)" ::: "memory");
    __syncthreads();
    if (threadIdx.x == 0) {
        unsigned* bar = b.bar;
        __builtin_amdgcn_s_waitcnt(0);
        unsigned nloc = b.st[0], nx = b.st[1];
        if (nloc == 0u) { xcd_barrier_complete(bar, b.x, nloc, nx); b.st[0] = nloc; b.st[1] = nx; }
        const unsigned old = xb_add(&bar[XB_XSUB(b.x)], 1u);
        const unsigned gen = old / nloc;
        if (old + 1u == (gen + 1u) * nloc) {
            __builtin_amdgcn_fence(__ATOMIC_RELEASE, "agent");
            asm volatile("s_waitcnt vmcnt(0)" ::: "memory");
            const unsigned og = xb_add(&bar[XB_TOP], 1u);
            const unsigned tg = og / nx;
            if (og + 1u == (tg + 1u) * nx) xb_add(&bar[XB_TOPGEN], 1u);
            else XB_SPIN(xb_ld(&bar[XB_TOPGEN]) == tg, bar);
            __builtin_amdgcn_fence(__ATOMIC_ACQUIRE, "agent");
            xb_add(&bar[XB_XGEN(b.x)], 1u);
            asm volatile("s_waitcnt vmcnt(0)" ::: "memory");
        } else {
            XB_SPIN(xb_ld(&bar[XB_XGEN(b.x)]) == gen, bar);
            __builtin_amdgcn_fence(__ATOMIC_ACQUIRE, "agent");
            asm volatile("s_waitcnt vmcnt(0)" ::: "memory");
        }
    }
    __syncthreads();
}

namespace pg8 {
constexpr int BM = 256, BK = 64, HALF = 128, HTB = HALF * BK * 2, STAGE_BYTES = 8 * HTB, NXCD = 8, WGM = 8;
__device__ __forceinline__ int lds_byte(int r, int c) { const int st = (r >> 4) * 2 + (c >> 5), rr = r & 15, cc = c & 31, ob = rr * 64 + cc * 2; return st * 1024 + (ob ^ (((ob >> 9) & 1) << 5)); }
__device__ __forceinline__ void stage_rc(int b, int& R, int& C) { const int st = b / 1024, sb = b % 1024, swz = sb ^ (((sb >> 9) & 1) << 5); R = (st >> 1) * 16 + swz / 64; C = (st & 1) * 32 + (swz % 64) / 2; }
__device__ __forceinline__ int perm32(int rho) { const int n = rho >> 4, i = rho & 15; return 8 * (i >> 2) + 4 * n + (i & 3); }
struct Unit { int pm, pn, aux, aux2; };

__device__ __forceinline__ void static_unit(int L, int nM, int nN, Unit& u) {
    const int nwg = nM * nN;
    int wgid = L; { const int q = nwg / NXCD, r = nwg % NXCD, xcd = wgid % NXCD, off = wgid / NXCD; wgid = (xcd < r ? xcd * (q + 1) : r * (q + 1) + (xcd - r) * q) + off; }
    const int nig = WGM * nN, gid = wgid / nig, fm = gid * WGM, gsz = (nM - fm) < WGM ? (nM - fm) : WGM;
    u.pm = fm + ((wgid % nig) % gsz); u.pn = (wgid % nig) / gsz; u.aux = 0; u.aux2 = 0;
}

template <class Epi, class Sched>
__device__ __forceinline__ void gemm_phase(LAS unsigned char* lds, const Sched& S, const Epi& E) {
    const int tid = otid(), wid = __builtin_amdgcn_readfirstlane(tid >> 6), lane = tid & 63, wr = wid >> 2, wc = wid & 3, fr = lane & 15, fq = lane >> 4;
    const int nt = S.nt;
    int sR[2], sC[2];
    unsigned vB[2][2];
#pragma unroll
    for (int i = 0; i < 2; ++i) { stage_rc(tid * 16 + i * 8192, sR[i], sC[i]); const int Rb = Epi::PERM ? ((sR[i] & ~31) + perm32(sR[i] & 31)) : sR[i];
#pragma unroll
        for (int h = 0; h < 2; ++h) vB[h][i] = (unsigned)(h * HALF + Rb) * S.ldb + (unsigned)sC[i] * 2u; }
    const size_t kstepA = S.kstepA, kstepB = S.kstepB;
    const unsigned ldsw = (unsigned)wid * 1024u;
    const int aoff = lds_byte(wr * 64 + fr, fq * 8), boff = lds_byte(wc * 32 + fr, fq * 8);
#define PG8_SA(b, h) (((b) * 2 + (h)) * HTB)
#define PG8_SB(b, h) ((4 + (b) * 2 + (h)) * HTB)
#define PG8_STAGE(bufoff, gbase, v0, v1) do { \
        __builtin_amdgcn_global_load_lds((const unsigned*)((const char*)(gbase) + (v0)), (LAS unsigned*)(lds + (bufoff) + ldsw), 16, 0, 0); \
        __builtin_amdgcn_global_load_lds((const unsigned*)((const char*)(gbase) + (v1)), (LAS unsigned*)(lds + (bufoff) + ldsw + 8192), 16, 0, 0); } while (0)
#define PG8_LDA(dst, b, h) do { _Pragma("unroll") for (int m = 0; m < 4; ++m) _Pragma("unroll") for (int k = 0; k < 2; ++k) dst[m][k] = *(const LAS bf16x8*)(lds + PG8_SA(b, h) + aoff + m * 2048 + k * 1024); } while (0)
#define PG8_LDB(dst, b, h) do { _Pragma("unroll") for (int n = 0; n < 2; ++n) _Pragma("unroll") for (int k = 0; k < 2; ++k) dst[n][k] = *(const LAS bf16x8*)(lds + PG8_SB(b, h) + boff + n * 2048 + k * 1024); } while (0)
#define PG8_MMA(ai, bj, At, Bt) do { __builtin_amdgcn_s_setprio(1); _Pragma("unroll") for (int m = 0; m < 4; ++m) _Pragma("unroll") for (int n = 0; n < 2; ++n) _Pragma("unroll") for (int k = 0; k < 2; ++k) \
        acc[ai][bj][m][n] = __builtin_amdgcn_mfma_f32_16x16x32_bf16(Bt[n][k], At[m][k], acc[ai][bj][m][n], 0, 0, 0); __builtin_amdgcn_s_setprio(0); } while (0)
#define PG8_WAIT_V(n) asm volatile("s_waitcnt vmcnt(" #n ")" ::: "memory")
#define PG8_WAIT_L(n) asm volatile("s_waitcnt lgkmcnt(" #n ")" ::: "memory")
#define PG8_BAR __builtin_amdgcn_s_barrier()
#define PG8_SCHED __builtin_amdgcn_sched_barrier(0)
    Unit cur, nxt; int ui = 0;
    if (!S.next(0, cur)) return;
    f32x4 acc[2][2][4][2];
#pragma unroll
    for (int a = 0; a < 2; ++a)
#pragma unroll
        for (int b = 0; b < 2; ++b)
#pragma unroll
            for (int m = 0; m < 4; ++m)
#pragma unroll
                for (int n = 0; n < 2; ++n) acc[a][b][m][n] = (f32x4){0.f, 0.f, 0.f, 0.f};
    bf16x8 At[4][2], B0[2][2], B1[2][2];
    unsigned vA[2][2], vN[2][2];
#pragma unroll
    for (int h = 0; h < 2; ++h)
#pragma unroll
        for (int i = 0; i < 2; ++i) { vA[h][i] = S.aoff(cur, h * HALF + sR[i], sC[i]); vN[h][i] = vA[h][i]; }
    const char* cA = S.abase(cur); const char* cB = S.bbase(cur);
    PG8_STAGE(PG8_SB(0, 0), cB, vB[0][0], vB[0][1]); PG8_STAGE(PG8_SA(0, 0), cA, vA[0][0], vA[0][1]); PG8_STAGE(PG8_SB(0, 1), cB, vB[1][0], vB[1][1]); PG8_STAGE(PG8_SA(0, 1), cA, vA[1][0], vA[1][1]);
    if (wr == 1) PG8_BAR;
    PG8_WAIT_V(4); PG8_BAR;
    PG8_STAGE(PG8_SB(1, 0), cB + kstepB, vB[0][0], vB[0][1]); PG8_STAGE(PG8_SA(1, 0), cA + kstepA, vA[0][0], vA[0][1]); PG8_STAGE(PG8_SB(1, 1), cB + kstepB, vB[1][0], vB[1][1]);
    PG8_WAIT_V(6); PG8_BAR;
    for (;;) {
        const bool has_next = S.next(ui + 1, nxt);
        const char* nA = has_next ? S.abase(nxt) : cA; const char* nB = has_next ? S.bbase(nxt) : cB;
        if (Sched::DYN_A && has_next) {
#pragma unroll
            for (int h = 0; h < 2; ++h)
#pragma unroll
                for (int i = 0; i < 2; ++i) vN[h][i] = S.aoff(nxt, h * HALF + sR[i], sC[i]);
        }
        for (int t = 0; t < nt; t += 2) {
            const bool last = (t == nt - 2);
            const char* a1 = cA + (size_t)(t + 1) * kstepA;
            const char* a2 = last ? nA : cA + (size_t)(t + 2) * kstepA; const char* b2 = last ? nB : cB + (size_t)(t + 2) * kstepB;
            const char* a3 = a2 + kstepA; const char* b3 = b2 + kstepB;
            PG8_LDB(B0, 0, 0); PG8_SCHED; PG8_LDA(At, 0, 0); PG8_STAGE(PG8_SA(1, 1), a1, vA[1][0], vA[1][1]);
            if (Sched::DYN_A && last) {
#pragma unroll
                for (int h = 0; h < 2; ++h)
#pragma unroll
                    for (int i = 0; i < 2; ++i) vA[h][i] = vN[h][i]; }
            PG8_WAIT_L(8); PG8_BAR; PG8_WAIT_L(0); PG8_MMA(0, 0, At, B0); PG8_BAR; PG8_SCHED;
            PG8_LDB(B1, 0, 1); PG8_STAGE(PG8_SB(0, 0), b2, vB[0][0], vB[0][1]);
            PG8_BAR; PG8_WAIT_L(0); PG8_MMA(0, 1, At, B1); PG8_BAR;
            PG8_LDA(At, 0, 1); PG8_STAGE(PG8_SA(0, 0), a2, vA[0][0], vA[0][1]);
            PG8_BAR; PG8_WAIT_L(0); PG8_MMA(1, 0, At, B0); PG8_BAR; PG8_SCHED;
            PG8_STAGE(PG8_SB(0, 1), b2, vB[1][0], vB[1][1]);
            PG8_WAIT_V(6); PG8_BAR; PG8_MMA(1, 1, At, B1); PG8_BAR;
            PG8_LDB(B0, 1, 0); PG8_SCHED; PG8_LDA(At, 1, 0); PG8_STAGE(PG8_SA(0, 1), a2, vA[1][0], vA[1][1]);
            PG8_WAIT_L(8); PG8_BAR; PG8_WAIT_L(0); PG8_MMA(0, 0, At, B0); PG8_BAR; PG8_SCHED;
            PG8_LDB(B1, 1, 1); PG8_STAGE(PG8_SB(1, 0), b3, vB[0][0], vB[0][1]);
            PG8_BAR; PG8_WAIT_L(0); PG8_MMA(0, 1, At, B1); PG8_BAR;
            PG8_LDA(At, 1, 1); PG8_STAGE(PG8_SA(1, 0), a3, vA[0][0], vA[0][1]);
            PG8_BAR; PG8_WAIT_L(0); PG8_MMA(1, 0, At, B0); PG8_BAR; PG8_SCHED;
            PG8_STAGE(PG8_SB(1, 1), b3, vB[1][0], vB[1][1]);
            PG8_WAIT_V(6); PG8_BAR; PG8_MMA(1, 1, At, B1); PG8_BAR;
        }
        E(acc, cur, wr, wc, fr, fq);
        if (!has_next) break;
#pragma unroll
        for (int a = 0; a < 2; ++a)
#pragma unroll
            for (int b = 0; b < 2; ++b)
#pragma unroll
                for (int m = 0; m < 4; ++m)
#pragma unroll
                    for (int n = 0; n < 2; ++n) acc[a][b][m][n] = (f32x4){0.f, 0.f, 0.f, 0.f};
        cur = nxt; cA = nA; cB = nB; ++ui;
    }
    PG8_WAIT_V(0);
    if (wr == 0) PG8_BAR;
    PG8_BAR;
#undef PG8_SA
#undef PG8_SB
#undef PG8_STAGE
#undef PG8_LDA
#undef PG8_LDB
#undef PG8_MMA
#undef PG8_WAIT_V
#undef PG8_WAIT_L
#undef PG8_BAR
#undef PG8_SCHED
}
}
using pg8::Unit;

struct SchedPlain {
    static constexpr bool DYN_A = false;
    const char* A; const char* Bt; int K, nM, nN, G, c; int nt; unsigned kstepA, kstepB, ldb;
    __device__ __forceinline__ void init(const void* A_, const void* Bt_, int M, int N, int K_) { A = (const char*)A_; Bt = (const char*)Bt_; K = K_; nM = M / 256; nN = N / 256; G = gridDim.x; c = blockIdx.x; nt = K / 64; kstepA = 128; kstepB = 128; ldb = (unsigned)K * 2u; }
    __device__ __forceinline__ bool next(int i, Unit& u) const { const int L = i * G + c; if (L >= nM * nN) return false; pg8::static_unit(L, nM, nN, u); return true; }
    __device__ __forceinline__ const char* abase(const Unit& u) const { return A + (size_t)u.pm * 256 * K * 2; }
    __device__ __forceinline__ const char* bbase(const Unit& u) const { return Bt + (size_t)u.pn * 256 * K * 2; }
    __device__ __forceinline__ unsigned aoff(const Unit&, int row, int col) const { return (unsigned)(row * K + col) * 2u; }
};
constexpr int ML_CNT = 131072, ML_PPRE = ML_CNT + 128, ML_PE = ML_PPRE + 256;
__device__ __forceinline__ int moe_tables(const char* ws, int layer, LAS unsigned char* lds) {
    const int tid = otid(); LAS int* cnt = (LAS int*)(lds + ML_CNT); LAS int* ppre = (LAS int*)(lds + ML_PPRE); LAS int* pe = (LAS int*)(lds + ML_PE);
    __syncthreads();
    if (tid < 32) cnt[tid] = ((const int*)(ws + WS_GCNT))[layer * 32 + tid];
    __syncthreads();
    if (tid == 0) { int s = 0; for (int e = 0; e < NEXP; ++e) { ppre[e] = s; s += (cnt[e] + 255) >> 8; } ppre[NEXP] = s; }
    __syncthreads();
    const int nM = ppre[NEXP];
    if (tid < nM) { int e = 0; for (int k = 1; k < NEXP; ++k) e += (ppre[k] <= tid) ? 1 : 0; pe[tid] = e; }
    __syncthreads();
    return nM;
}
struct SchedMoeGU {
    static constexpr bool DYN_A = true;
    const char* X; const char* W; const int* tokof; LAS unsigned char* lds; int nM, G, c; int nt; unsigned kstepA, kstepB, ldb;
    __device__ __forceinline__ void init(const char* ws, int layer, LAS unsigned char* lds_) { lds = lds_; nM = moe_tables(ws, layer, lds_); X = ws + WS_X1B; W = ws + WS_GU; tokof = (const int*)(ws + WS_ROWTOK); G = gridDim.x; c = blockIdx.x; nt = 16; kstepA = 128; kstepB = 128; ldb = 2048; }
    __device__ __forceinline__ bool next(int i, Unit& u) const { const int L = i * G + c; if (L >= nM * 4) return false; pg8::static_unit(L, nM, 4, u);
        const int e = ((const LAS int*)(lds + ML_PE))[u.pm]; u.aux = e | ((u.pm - ((const LAS int*)(lds + ML_PPRE))[e]) << 16); u.aux2 = ((const LAS int*)(lds + ML_CNT))[e]; return true; }
    __device__ __forceinline__ const char* abase(const Unit&) const { return X; }
    __device__ __forceinline__ const char* bbase(const Unit& u) const { return W + ((size_t)(u.aux & 255) * 1024 + (size_t)u.pn * 256) * 2048; }
    __device__ __forceinline__ unsigned aoff(const Unit& u, int row, int col) const { const int slot = (u.aux >> 16) * 256 + row; const int sl = slot < u.aux2 ? slot : 0;
        return (unsigned)tokof[(u.aux & 255) * 65536 + sl] * 2048u + (unsigned)col * 2u; }
};
struct SchedMoeDN {
    static constexpr bool DYN_A = false;
    const char* H; const char* W; LAS unsigned char* lds; int nM, G, c; int nt; unsigned kstepA, kstepB, ldb;
    __device__ __forceinline__ void init(const char* ws, int layer, LAS unsigned char* lds_) { lds = lds_; nM = moe_tables(ws, layer, lds_); H = ws + WS_AOH; W = ws + WS_DN; G = gridDim.x; c = blockIdx.x; nt = 8; kstepA = 128; kstepB = 128; ldb = 1024; }
    __device__ __forceinline__ bool next(int i, Unit& u) const { const int L = i * G + c; if (L >= nM * 4) return false; pg8::static_unit(L, nM, 4, u); u.aux = ((const LAS int*)(lds + ML_PE))[u.pm]; u.aux2 = 0; return true; }
    __device__ __forceinline__ const char* abase(const Unit& u) const { return H + (size_t)u.pm * 256 * 1024; }
    __device__ __forceinline__ const char* bbase(const Unit& u) const { return W + ((size_t)u.aux * 1024 + (size_t)u.pn * 256) * 1024; }
    __device__ __forceinline__ unsigned aoff(const Unit&, int row, int col) const { return (unsigned)(row * 512 + col) * 2u; }
};
struct SchedCmp {
    static constexpr bool DYN_A = false  ;
    const char* Q; const char* W; int G, c; int nt; unsigned kstepA, kstepB, ldb;
    __device__ __forceinline__ void init(const char* ws) { Q = ws + WS_BIG; W = ws + WS_W1T; G = gridDim.x; c = blockIdx.x; nt = 8; kstepA = NSA_LD * 2; kstepB = 128; ldb = 4096; }
    __device__ __forceinline__ bool next(int i, Unit& u) const { const int L = i * G + c; if (L >= 256) return false; u.aux = L >> 7; u.aux2 = 0; u.pm = (L >> 2) & 31; u.pn = L & 3; return true; }
    __device__ __forceinline__ const char* abase(const Unit& u) const { return Q + (size_t)(u.aux ? NSA_VC : NSA_KC) * 2 + (size_t)u.pn * 8 * (NSA_LD * 2); }
    __device__ __forceinline__ const char* bbase(const Unit& u) const { return W + (size_t)u.aux * 256 * 4096 + (size_t)u.pn * 8 * 128; }
    __device__ __forceinline__ unsigned aoff(const Unit& u, int row, int col) const {
        const int m = u.pm * 256 + row, bh = m >> 7, n = m & 127, nn = n > 126 ? 126 : n, b = bh >> 2, hkv = bh & 3;
        return (unsigned)(((b * SEQ + 16 * nn) * NSA_LD) + hkv * 64 + col) * 2u; }
};

struct EpiQKV0 {
    static constexpr bool PERM = true;
    bf16_t* O; float* kpart;
    __device__ __forceinline__ void operator()(const f32x4 (&acc)[2][2][4][2], const Unit& u, int wr, int wc, int fr, int fq) const {
        const int row0 = u.pm * 256 + wr * 64 + fr, col0 = u.pn * 256 + wc * 32 + 8 * fq;
        const float sc = (u.pn < 4) ? C2 : 1.0f;
#pragma unroll
        for (int ai = 0; ai < 2; ++ai)
#pragma unroll
            for (int m = 0; m < 4; ++m) { bf16_t* rowp = O + (size_t)(row0 + ai * 128 + m * 16) * QKV_LD + col0;
#pragma unroll
                for (int bj = 0; bj < 2; ++bj) { const f32x4 v0 = acc[ai][bj][m][0] * sc, v1 = acc[ai][bj][m][1] * sc;
                    u32x4 w; w.x = cvt_pk_bf16(v0[0], v0[1]); w.y = cvt_pk_bf16(v0[2], v0[3]); w.z = cvt_pk_bf16(v1[0], v1[1]); w.w = cvt_pk_bf16(v1[2], v1[3]);
                    *(u32x4*)(rowp + bj * 128) = w; } }
        if (u.pn >= 4 && u.pn < 8) {
#pragma unroll
            for (int bj = 0; bj < 2; ++bj)
#pragma unroll
                for (int n = 0; n < 2; ++n) { f32x4 s = (f32x4){0.f, 0.f, 0.f, 0.f};
#pragma unroll
                    for (int ai = 0; ai < 2; ++ai)
#pragma unroll
                        for (int m = 0; m < 4; ++m) s += acc[ai][bj][m][n];
#pragma unroll
                    for (int j = 0; j < 4; ++j) { float v = s[j]; v += __shfl_xor(v, 1); v += __shfl_xor(v, 2); v += __shfl_xor(v, 4); v += __shfl_xor(v, 8); s[j] = v; }
                    if (fr == 0) *(f32x4*)(kpart + ((size_t)u.pm * 2 + wr) * 1024 + (u.pn - 4) * 256 + bj * 128 + wc * 32 + 8 * fq + 4 * n) = s; }
        }
    }
};
struct EpiNull {
    static constexpr bool PERM = true;
    float* sink;
    __device__ __forceinline__ void operator()(const f32x4 (&acc)[2][2][4][2], const Unit& u, int wr, int wc, int fr, int fq) const {
        float s = 0.f;
#pragma unroll
        for (int ai = 0; ai < 2; ++ai)
#pragma unroll
            for (int bj = 0; bj < 2; ++bj)
#pragma unroll
                for (int m = 0; m < 4; ++m)
#pragma unroll
                    for (int n = 0; n < 2; ++n) s += acc[ai][bj][m][n][0] + acc[ai][bj][m][n][3];
        if (s == 12345.678f) sink[u.pm + wr + wc + fr + fq] = s;
    }
};
struct EpiNSA {
    static constexpr bool PERM = true;
    bf16_t* O;
    __device__ __forceinline__ void operator()(const f32x4 (&acc)[2][2][4][2], const Unit& u, int wr, int wc, int fr, int fq) const {
        const int row0 = u.pm * 256 + wr * 64 + fr, col0 = u.pn * 256 + wc * 32 + 8 * fq;
        const float sc = (u.pn < 4) ? C2 : 1.0f; const bool sg = (u.pn == 10);
#pragma unroll
        for (int ai = 0; ai < 2; ++ai)
#pragma unroll
            for (int m = 0; m < 4; ++m) { bf16_t* rowp = O + (size_t)(row0 + ai * 128 + m * 16) * NSA_LD + col0;
#pragma unroll
                for (int bj = 0; bj < 2; ++bj) { f32x4 v0 = acc[ai][bj][m][0] * sc, v1 = acc[ai][bj][m][1] * sc;
                    if (sg) {
#pragma unroll
                        for (int j = 0; j < 4; ++j) { v0[j] = 1.0f / (1.0f + __expf(-v0[j])); v1[j] = 1.0f / (1.0f + __expf(-v1[j])); } }
                    u32x4 w; w.x = cvt_pk_bf16(v0[0], v0[1]); w.y = cvt_pk_bf16(v0[2], v0[3]); w.z = cvt_pk_bf16(v1[0], v1[1]); w.w = cvt_pk_bf16(v1[2], v1[3]);
                    *(u32x4*)(rowp + bj * 128) = w; } }
    }
};
template <bool RES_F32> struct EpiRes {
    static constexpr bool PERM = true;
    bf16_t* O; const float* rf; const bf16_t* rb;
    __device__ __forceinline__ void operator()(const f32x4 (&acc)[2][2][4][2], const Unit& u, int wr, int wc, int fr, int fq) const {
        const int row0 = u.pm * 256 + wr * 64 + fr, col0 = u.pn * 256 + wc * 32 + 8 * fq;
#pragma unroll
        for (int ai = 0; ai < 2; ++ai) {
            if (RES_F32) {
#pragma unroll
                for (int mh = 0; mh < 2; ++mh) { f32x4 r[2][2][2];
#pragma unroll
                    for (int m2 = 0; m2 < 2; ++m2)
#pragma unroll
                        for (int bj = 0; bj < 2; ++bj) { const size_t ro = (size_t)(row0 + ai * 128 + (mh * 2 + m2) * 16) * 1024 + col0 + bj * 128; r[m2][bj][0] = *(const f32x4*)(rf + ro); r[m2][bj][1] = *(const f32x4*)(rf + ro + 4); }
#pragma unroll
                    for (int m2 = 0; m2 < 2; ++m2)
#pragma unroll
                        for (int bj = 0; bj < 2; ++bj) { const int m = mh * 2 + m2; const size_t ro = (size_t)(row0 + ai * 128 + m * 16) * 1024 + col0 + bj * 128;
                            const f32x4 v0 = acc[ai][bj][m][0] + r[m2][bj][0] * ALPHA, v1 = acc[ai][bj][m][1] + r[m2][bj][1] * ALPHA;
                            u32x4 w; w.x = cvt_pk_bf16(v0[0], v0[1]); w.y = cvt_pk_bf16(v0[2], v0[3]); w.z = cvt_pk_bf16(v1[0], v1[1]); w.w = cvt_pk_bf16(v1[2], v1[3]);
                            *(u32x4*)(O + ro) = w; } }
            } else {
                u32x4 r[4][2];
#pragma unroll
                for (int m = 0; m < 4; ++m)
#pragma unroll
                    for (int bj = 0; bj < 2; ++bj) r[m][bj] = *(const u32x4*)(rb + (size_t)(row0 + ai * 128 + m * 16) * 1024 + col0 + bj * 128);
#pragma unroll
                for (int m = 0; m < 4; ++m)
#pragma unroll
                    for (int bj = 0; bj < 2; ++bj) { const size_t ro = (size_t)(row0 + ai * 128 + m * 16) * 1024 + col0 + bj * 128; const u32x4 rw = r[m][bj];
                        const f32x4 r0 = (f32x4){lo_bf(rw.x), hi_bf(rw.x), lo_bf(rw.y), hi_bf(rw.y)}, r1 = (f32x4){lo_bf(rw.z), hi_bf(rw.z), lo_bf(rw.w), hi_bf(rw.w)};
                        const f32x4 v0 = acc[ai][bj][m][0] + r0 * ALPHA, v1 = acc[ai][bj][m][1] + r1 * ALPHA;
                        u32x4 w; w.x = cvt_pk_bf16(v0[0], v0[1]); w.y = cvt_pk_bf16(v0[2], v0[3]); w.z = cvt_pk_bf16(v1[0], v1[1]); w.w = cvt_pk_bf16(v1[2], v1[3]);
                        *(u32x4*)(O + ro) = w; }
            }
        }
    }
};
struct EpiGU {
    static constexpr bool PERM = true;
    bf16_t* O;
    __device__ __forceinline__ void operator()(const f32x4 (&acc)[2][2][4][2], const Unit& u, int wr, int wc, int fr, int fq) const {
        const int row0 = u.pm * 256 + wr * 64 + fr, col0 = u.pn * 128 + wc * 32 + 8 * fq;
#pragma unroll
        for (int ai = 0; ai < 2; ++ai)
#pragma unroll
            for (int m = 0; m < 4; ++m) { float h[8];
#pragma unroll
                for (int n = 0; n < 2; ++n)
#pragma unroll
                    for (int j = 0; j < 4; ++j) { const float g = acc[ai][0][m][n][j], up = acc[ai][1][m][n][j]; h[n * 4 + j] = g * up / (1.0f + __expf(-g)); }
                u32x4 w; w.x = cvt_pk_bf16(h[0], h[1]); w.y = cvt_pk_bf16(h[2], h[3]); w.z = cvt_pk_bf16(h[4], h[5]); w.w = cvt_pk_bf16(h[6], h[7]);
                *(u32x4*)(O + (size_t)(row0 + ai * 128 + m * 16) * 512 + col0) = w; }
    }
};
struct EpiDN {
    static constexpr bool PERM = true;
    bf16_t* O;
    __device__ __forceinline__ void operator()(const f32x4 (&acc)[2][2][4][2], const Unit& u, int wr, int wc, int fr, int fq) const {
        const int row0 = u.pm * 256 + wr * 64 + fr, col0 = u.pn * 256 + wc * 32 + 8 * fq;
#pragma unroll
        for (int ai = 0; ai < 2; ++ai)
#pragma unroll
            for (int m = 0; m < 4; ++m) { bf16_t* rowp = O + (size_t)(row0 + ai * 128 + m * 16) * 1024 + col0;
#pragma unroll
                for (int bj = 0; bj < 2; ++bj) { const f32x4 v0 = acc[ai][bj][m][0], v1 = acc[ai][bj][m][1];
                    u32x4 w; w.x = cvt_pk_bf16(v0[0], v0[1]); w.y = cvt_pk_bf16(v0[2], v0[3]); w.z = cvt_pk_bf16(v1[0], v1[1]); w.w = cvt_pk_bf16(v1[2], v1[3]);
                    *(u32x4*)(rowp + bj * 128) = w; } }
    }
};
struct EpiCmp {
    static constexpr bool PERM = false;
    float* CP;
    __device__ __forceinline__ void operator()(const f32x4 (&acc)[2][2][4][2], const Unit& u, int wr, int wc, int fr, int fq) const {
        float* base = CP + ((size_t)(u.aux * 4 + u.pn) * 8192 + (size_t)u.pm * 256) * 256;
        const int row0 = wr * 64 + fr, col0 = wc * 32 + 4 * fq;
#pragma unroll
        for (int ai = 0; ai < 2; ++ai)
#pragma unroll
            for (int m = 0; m < 4; ++m) { float* rowp = base + (size_t)(row0 + ai * 128 + m * 16) * 256 + col0;
#pragma unroll
                for (int bj = 0; bj < 2; ++bj)
#pragma unroll
                    for (int n = 0; n < 2; ++n) *(f32x4*)(rowp + bj * 128 + n * 16) = acc[ai][bj][m][n]; }
    }
};

constexpr int AL_K = 0  , AL_V = 24576  , AL_BIAS = 57344  , AL_KM = AL_BIAS + 4 * BT_H * 4, AL_IMP = AL_KM + 2048  , AL_SEL = AL_IMP + 65536, AL_LIST = AL_SEL + 512, AL_END = AL_LIST + 256;
static_assert(AL_END <= LDS_BYTES - 16 && 4 * 64 * 33 * 4 <= 65536, "attention LDS map");
#define MFMA32(a, b, c) __builtin_amdgcn_mfma_f32_32x32x16_bf16(a, b, c, 0, 0, 0)
__device__ __forceinline__ s16x4 vtr(lds_cptr p) { return __builtin_bit_cast(s16x4, __builtin_amdgcn_ds_read_tr16_b64_v4i16((LAS v4i16_t*)p)); }
__device__ __forceinline__ float xhalf_max(float m) { auto rr = __builtin_amdgcn_permlane32_swap(__float_as_uint(m), __float_as_uint(m), false, false); return __builtin_fmaxf(__uint_as_float(rr[0]), __uint_as_float(rr[1])); }
__device__ __forceinline__ float xhalf_sum(float m) { auto rr = __builtin_amdgcn_permlane32_swap(__float_as_uint(m), __float_as_uint(m), false, false); return __uint_as_float(rr[0]) + __uint_as_float(rr[1]); }
__device__ __forceinline__ float max16(const f32x16& p) { float a = __builtin_fmaxf(p[0], p[1]), b = __builtin_fmaxf(p[2], p[3]);
#pragma unroll
    for (int r = 4; r < 16; r += 4) { a = __builtin_fmaxf(a, __builtin_fmaxf(p[r], p[r + 1])); b = __builtin_fmaxf(b, __builtin_fmaxf(p[r + 2], p[r + 3])); }
    return __builtin_fmaxf(a, b); }

#define MX3(a, b, c) __builtin_fmaxf(__builtin_fmaxf((a), (b)), (c))
__device__ __forceinline__ float max32(const f32x16& p0, const f32x16& p1) {
    float a = MX3(p0[0], p0[1], p1[0]), b = MX3(p0[2], p0[3], p1[1]); a = MX3(a, p1[2], p1[3]);
#pragma unroll
    for (int r = 4; r < 16; r += 4) { a = MX3(a, p0[r], p0[r + 1]); b = MX3(b, p0[r + 2], p0[r + 3]); a = MX3(a, p1[r], p1[r + 1]); b = MX3(b, p1[r + 2], p1[r + 3]); }
    return __builtin_fmaxf(a, b); }
constexpr float FLASH_THR = 8.0f;
__device__ __forceinline__ void glds16(const void* g, unsigned lds_addr) {
    unsigned sv; asm volatile("s_mov_b32 %0, m0\n\ts_mov_b32 m0, %2\n\ts_nop 0\n\tglobal_load_lds_dwordx4 %1, off\n\ts_mov_b32 m0, %0" : "=&s"(sv) : "v"(g), "s"(lds_addr) : "memory"); }
__device__ __forceinline__ void dma_k(const bf16_t* src, int ld, LAS unsigned char* lds, int slot, int wid, int lane) {
    const int rl = lane >> 3, ch = lane & 7;
    glds16(src + (size_t)(wid * 8 + rl) * ld + ((ch ^ rl) * 8), (unsigned)__builtin_amdgcn_readfirstlane((int)((unsigned)(unsigned long)lds + AL_K + slot * 8192 + wid * 1024))); }
__device__ __forceinline__ void dma_v(const bf16_t* src, int ld, LAS unsigned char* lds, int slot, int wid, int lane) {
    glds16(src + (size_t)(16 * (wid & 3) + (lane >> 2)) * ld + (wid >> 2) * 32 + (lane & 3) * 8, (unsigned)__builtin_amdgcn_readfirstlane((int)((unsigned)(unsigned long)lds + AL_V + slot * 8192 + wid * 1024))); }

struct FState { float m, l; f32x16 o0, o1; };
__device__ __forceinline__ void fstate_reset(FState& s) { s.m = -1e30f; s.l = 0.f;
#pragma unroll
    for (int r = 0; r < 16; ++r) { s.o0[r] = 0.f; s.o1[r] = 0.f; } }

__device__ __forceinline__ int kchunk_off(int d0, int kx) { return (((2 * d0 + (kx >> 3)) ^ (kx & 7)) * 16); }
__device__ __forceinline__ void qk_tile(f32x16& c0, f32x16& c1, const bf16x8 (&qr)[4], lds_cptr kp, int kx) {
#pragma unroll
    for (int d0 = 0; d0 < 4; ++d0) { const bf16x8 k0 = *(const LAS bf16x8*)(kp + kchunk_off(d0, kx)), k1 = *(const LAS bf16x8*)(kp + kchunk_off(d0, kx) + 4096);
        c0 = MFMA32(k0, qr[d0], c0); c1 = MFMA32(k1, qr[d0], c1); }
}
__device__ __forceinline__ void pv_tile(f32x16& o0, f32x16& o1, const f32x16& p0, const f32x16& p1, lds_cptr vp) {
#pragma unroll
    for (int k = 0; k < 4; ++k) {
        const f32x16& ps = (k < 2) ? p0 : p1; const int b = 8 * (k & 1);
        const u32x4 pw = (u32x4){cvt_pk_bf16(ps[b], ps[b + 1]), cvt_pk_bf16(ps[b + 2], ps[b + 3]), cvt_pk_bf16(ps[b + 4], ps[b + 5]), cvt_pk_bf16(ps[b + 6], ps[b + 7])};
        const bf16x8 pf = __builtin_bit_cast(bf16x8, pw);
        { const s16x4 lo = vtr(vp + k * 1024), hi = vtr(vp + k * 1024 + 512);
          const bf16x8 vf = (bf16x8){lo[0], lo[1], lo[2], lo[3], hi[0], hi[1], hi[2], hi[3]}; o0 = MFMA32(vf, pf, o0); }
        { const s16x4 lo = vtr(vp + 4096 + k * 1024), hi = vtr(vp + 4096 + k * 1024 + 512);
          const bf16x8 vf = (bf16x8){lo[0], lo[1], lo[2], lo[3], hi[0], hi[1], hi[2], hi[3]}; o1 = MFMA32(vf, pf, o1); }
    }
}
struct TileP { int Dmin; bool rowok, run, win; };
__device__ __forceinline__ void load_kf(bf16x8 (&kf)[8], lds_cptr kp, int kx) {
#pragma unroll
    for (int d0 = 0; d0 < 4; ++d0) { kf[2 * d0] = *(const LAS bf16x8*)(kp + kchunk_off(d0, kx)); kf[2 * d0 + 1] = *(const LAS bf16x8*)(kp + kchunk_off(d0, kx) + 4096); } }
__device__ __forceinline__ void flash_qk(f32x16& c0, f32x16& c1, float& cf, const bf16x8 (&qr)[4], lds_cptr kp, int kx, const LAS float* btab, float cfar, int Dmin, int r32, int hi) {
    bf16x8 kf[8]; load_kf(kf, kp, kx);
    if (Dmin - 63 < 127) {
        const int s0 = (BT_N - 1 - 63) - (Dmin + r32 - 4 * hi), ksh = s0 & 3; cf = 0.f;
        const LAS f32x4* bp = (const LAS f32x4*)(btab + ksh * BT_S + (s0 - ksh));
#pragma unroll
        for (int g = 0; g < 4; ++g) { const f32x4 a = bp[2 * g], b = bp[8 + 2 * g];
#pragma unroll
            for (int i = 0; i < 4; ++i) { c0[4 * g + i] = a[i]; c1[4 * g + i] = b[i]; } }
#pragma unroll
        for (int d0 = 0; d0 < 4; ++d0) { c0 = MFMA32(kf[2 * d0], qr[d0], c0); c1 = MFMA32(kf[2 * d0 + 1], qr[d0], c1); }
    } else {
        cf = cfar;
        const f32x16 z = {0.f, 0.f, 0.f, 0.f, 0.f, 0.f, 0.f, 0.f, 0.f, 0.f, 0.f, 0.f, 0.f, 0.f, 0.f, 0.f};
        c0 = MFMA32(kf[0], qr[0], z); c1 = MFMA32(kf[1], qr[0], z);
#pragma unroll
        for (int d0 = 1; d0 < 4; ++d0) { c0 = MFMA32(kf[2 * d0], qr[d0], c0); c1 = MFMA32(kf[2 * d0 + 1], qr[d0], c1); }
    }
}
__device__ __forceinline__ void flash_sm(FState& st, f32x16& c0, f32x16& c1, float cf, const TileP& tp, int r32, int hi) {
    const int Dmin = tp.Dmin, Dl = Dmin + r32 - 4 * hi;
    if (tp.win && (Dmin + 31 >= 512)) {
#pragma unroll
        for (int r = 0; r < 16; ++r) { const int ko = (r & 3) + 8 * (r >> 2); if (Dl >= 512 + ko) c0[r] = -INFINITY; if (Dl >= 544 + ko) c1[r] = -INFINITY; }
    }
    float mx = xhalf_max(max32(c0, c1)) + cf;
    mx = tp.rowok ? mx : -INFINITY;
    if (__any(mx > st.m + FLASH_THR)) {
        const float mn = __builtin_fmaxf(st.m, mx); const float alpha = __builtin_amdgcn_exp2f(st.m - mn);
        st.m = mn; st.l *= alpha;
#pragma unroll
        for (int r = 0; r < 16; ++r) { st.o0[r] *= alpha; st.o1[r] *= alpha; }
    }
    const float msub = tp.rowok ? (st.m - cf) : INFINITY;
    float rs0 = 0.f, rs1 = 0.f;
#pragma unroll
    for (int r = 0; r < 16; ++r) { c0[r] = __builtin_amdgcn_exp2f(c0[r] - msub); c1[r] = __builtin_amdgcn_exp2f(c1[r] - msub); rs0 += c0[r]; rs1 += c1[r]; }
    st.l += rs0 + rs1;
}
template <int VAR, class Src>
__device__ __forceinline__ void attn_stream(Src& S, int NT, FState& st, const bf16x8 (&qr)[4], LAS unsigned char* lds, const LAS float* btab, float cfar, int wid, int lane, int r32, int hi) {
    const lds_cptr kp0 = (lds_cptr)lds + AL_K + r32 * 128; const int kx = (r32 & 7) | (hi << 3);
    const lds_cptr vp0 = (lds_cptr)lds + AL_V + ((lane >> 4) & 1) * 32 + (lane & 3) * 8 + (4 * hi + ((lane & 15) >> 2)) * 64;
    S.dma(0, 0, 0); if (NT > 1 && VAR != 5 && VAR != 6) S.dma(1, 1, 1);
    if (VAR == 5) { asm volatile("s_waitcnt vmcnt(0)" ::: "memory"); __syncthreads(); }
    int sc = 0, sn = 2;
    for (int t = 0; t < NT; ++t) {
        if (VAR != 5) { if (t + 1 < NT) asm volatile("s_waitcnt vmcnt(2)" ::: "memory"); else asm volatile("s_waitcnt vmcnt(0)" ::: "memory");
        __syncthreads(); }
        if (VAR != 5 && VAR != 6) { if (t + 2 < NT) S.dma(t + 2, sn, sn); }
        const TileP tp = S.params(t);
        if (tp.run) { f32x16 c0, c1; float cf;
            flash_qk(c0, c1, cf, qr, kp0 + sc * 8192, kx, btab, cfar, tp.Dmin, r32, hi);
            flash_sm(st, c0, c1, cf, tp, r32, hi);
            pv_tile(st.o0, st.o1, c0, c1, vp0 + sc * 8192); }
        S.after(t, st);
        sc = (sc == 2) ? 0 : sc + 1; sn = (sn == 2) ? 0 : sn + 1;
    }
}

__device__ __forceinline__ void conv_tile(const float* src, int N, bf16_t* dst, int ldd, int k0, int n0, int rowadd, int mode, LAS float* t, int lane) {
    float4 v[16];
#pragma unroll
    for (int i = 0; i < 16; ++i) { const int r = i * 4 + (lane >> 4), cc = n0 + (lane & 15) * 4;
        v[i] = (cc < N) ? *(const float4*)(src + (size_t)(k0 + r) * N + cc) : make_float4(0.f, 0.f, 0.f, 0.f); }
#pragma unroll
    for (int i = 0; i < 16; ++i) { const int r = i * 4 + (lane >> 4), cc = (lane & 15) * 4; LAS float* q = t + r * 65 + cc; q[0] = v[i].x; q[1] = v[i].y; q[2] = v[i].z; q[3] = v[i].w; }
    asm volatile("s_waitcnt lgkmcnt(0)" ::: "memory");
#pragma unroll
    for (int i = 0; i < 8; ++i) { const int nr = i * 8 + (lane >> 3), kc = (lane & 7) * 8; float f[8];
#pragma unroll
        for (int j = 0; j < 8; ++j) f[j] = t[(kc + j) * 65 + nr];
        const int n = n0 + nr; const int drow = (mode == 0) ? n : (256 * (n >> 7) + (n & 127) + rowadd);
        u32x4 w; w.x = cvt_pk_bf16(f[0], f[1]); w.y = cvt_pk_bf16(f[2], f[3]); w.z = cvt_pk_bf16(f[4], f[5]); w.w = cvt_pk_bf16(f[6], f[7]);
        *(u32x4*)(dst + (size_t)drow * ldd + k0 + kc) = w; }
    asm volatile("s_waitcnt lgkmcnt(0)" ::: "memory");
}
__device__ __forceinline__ int conv_job(const float* src, int K, int N, int Npad, bf16_t* dst, int ldd, int rowadd, int mode, int tile0, LAS float* t, int gw, int ngw, int lane) {
    const int nkt = K / 64, nnt = Npad / 64, ntile = nkt * nnt;
    int first = (gw - tile0 % ngw + ngw) % ngw;
    for (int i = first; i < ntile; i += ngw) conv_tile(src, N, dst, ldd, (i / nnt) * 64, (i % nnt) * 64, rowadd, mode, t, lane);
    return tile0 + ntile;
}
__device__ __forceinline__ void conv_moe_layer(const Params& p, int layer, LAS unsigned char* lds) {
    const int tid = otid(), lane = tid & 63, wid = tid >> 6, gw = blockIdx.x * 8 + wid, ngw = gridDim.x * 8;
    LAS float* t = (LAS float*)(lds + wid * (64 * 65 * 4));
    bf16_t* GU = (bf16_t*)(p.ws + WS_GU); bf16_t* DN = (bf16_t*)(p.ws + WS_DN);
    int tile0 = 0;
    for (int e = 0; e < NEXP; ++e) {
        const size_t wo = ((size_t)layer * NEXP + e) * 1024 * 512;
        tile0 = conv_job(p.w_gate + wo, 1024, 512, 512, GU + (size_t)e * 1024 * 1024, 1024, 0, 1, tile0, t, gw, ngw, lane);
        tile0 = conv_job(p.w_up + wo, 1024, 512, 512, GU + (size_t)e * 1024 * 1024, 1024, 128, 1, tile0, t, gw, ngw, lane);
        tile0 = conv_job(p.w_down + wo, 512, 1024, 1024, DN + (size_t)e * 1024 * 512, 512, 0, 0, tile0, t, gw, ngw, lane);
    }
}
__device__ __forceinline__ void phase_prologue(const Params& p, LAS unsigned char* lds) {
    const int tid = otid(), lane = tid & 63, wid = tid >> 6, gw = blockIdx.x * 8 + wid, ngw = gridDim.x * 8;
    LAS float* t = (LAS float*)(lds + wid * (64 * 65 * 4));
    char* ws = p.ws;
    { const size_t n8 = (size_t)NTOK * 1024 / 8; bf16_t* xb = (bf16_t*)(ws + WS_XB);
      for (size_t i = (size_t)blockIdx.x * NTHREADS + tid; i < n8; i += (size_t)gridDim.x * NTHREADS) {
          const float4 a = *(const float4*)(p.x + i * 8), b = *(const float4*)(p.x + i * 8 + 4);
          u32x4 w; w.x = cvt_pk_bf16(a.x, a.y); w.y = cvt_pk_bf16(a.z, a.w); w.z = cvt_pk_bf16(b.x, b.y); w.w = cvt_pk_bf16(b.z, b.w);
          *(u32x4*)(xb + i * 8) = w; } }
    int tile0 = 0;
    tile0 = conv_job(p.moba_w_in, 1024, 3072, 3072, (bf16_t*)(ws + WS_WQKV0), 1024, 0, 0, tile0, t, gw, ngw, lane);
    tile0 = conv_job(p.moba_w_out, 1024, 1024, 1024, (bf16_t*)(ws + WS_WO0), 1024, 0, 0, tile0, t, gw, ngw, lane);
    tile0 = conv_job(p.nsa_w_in, 1024, 2608, 2816, (bf16_t*)(ws + WS_WIN1), 1024, 0, 0, tile0, t, gw, ngw, lane);
    tile0 = conv_job(p.nsa_w_out, 1024, 1024, 1024, (bf16_t*)(ws + WS_WO1), 1024, 0, 0, tile0, t, gw, ngw, lane);
    tile0 = conv_job(p.ck_w1, 2048, 256, 256, (bf16_t*)(ws + WS_W1T), 2048, 0, 0, tile0, t, gw, ngw, lane);
    tile0 = conv_job(p.cv_w1, 2048, 256, 256, (bf16_t*)(ws + WS_W1T) + 256 * 2048, 2048, 0, 0, tile0, t, gw, ngw, lane);
    conv_moe_layer(p, 0, lds);
    for (int i = blockIdx.x * NTHREADS + tid; i < 16 * BT_H; i += gridDim.x * NTHREADS) {
        const int h = i / BT_H, k = (i % BT_H) / BT_S, j = i % BT_S; int e = (BT_N - 1) - (j + k); e = e < 0 ? 0 : e;
        int n = e - 63; const bool future = n < 0; n = n < 0 ? 0 : (n > 127 ? 127 : n);
        int bk = n;
        if (n >= 16) { bk = 16 + (int)(logf((float)n / 16.0f) / logf(8.0f) * 16.0f); bk = bk > 31 ? 31 : bk; }
        ((float*)(ws + WS_TAB))[i] = future ? -INFINITY : p.rel_bias[bk * 16 + h] * LOG2E; }
    if (blockIdx.x < 32) { const int kv = blockIdx.x >> 4, part = (blockIdx.x & 15) * 2 + (tid >> 8), j = tid & 255;
        const float* pos = kv ? p.pos_v : p.pos_k; const float* w1 = kv ? p.cv_w1 : p.ck_w1; float s = 0.f;
#pragma unroll 16
        for (int k = part * 64; k < part * 64 + 64; ++k) s += pos[k] * w1[(size_t)k * 256 + j];
        ((float*)(ws + WS_B1))[(kv * 32 + part) * 256 + j] = s; }
}

template <int VAR> __device__ __forceinline__ void moba_unit(const Params& p, LAS unsigned char* lds, int b, int h, int qb) {
    const int tid = otid(), lane = tid & 63, r32 = lane & 31, hi = lane >> 5; const int wid = __builtin_amdgcn_readfirstlane(tid >> 6);
    const bf16_t* QKV = (const bf16_t*)(p.ws + WS_BIG);
    const size_t rowbase = (size_t)b * SEQ; const int q0 = qb * 256, qw = q0 + wid * 32;
    const bf16_t* Kb = QKV + rowbase * QKV_LD + 1024 + h * 64; const bf16_t* Vb = QKV + rowbase * QKV_LD + 2048 + h * 64;
    bf16x8 qr[4];
    { const bf16_t* qp = QKV + (rowbase + qw + r32) * QKV_LD + h * 64 + hi * 8;
#pragma unroll
      for (int d0 = 0; d0 < 4; ++d0) qr[d0] = *(const bf16x8*)(qp + d0 * 16); }
    __syncthreads();
    { const float* kp = (const float*)(p.ws + WS_KPART); const int j = tid >> 6, d = tid & 63;
      const float* s = kp + ((size_t)(b * 8 + j) * 2) * 1024 + h * 64 + d;
      ((LAS float*)(lds + AL_KM))[tid] = s[0] + s[1024];
      for (int i = tid; i < BT_H; i += NTHREADS) ((LAS float*)(lds + AL_BIAS))[i] = ((const float*)(p.ws + WS_TAB))[h * BT_H + i]; }
    const int NT = 4 + 4 * qb;
    __syncthreads();
    unsigned sel = 0;
    { float g[8];
#pragma unroll
      for (int j = 0; j < 8; ++j) { float s = 0.f; const LAS float* km = (const LAS float*)(lds + AL_KM) + j * 64 + hi * 8;
#pragma unroll
          for (int d0 = 0; d0 < 4; ++d0)
#pragma unroll
              for (int i = 0; i < 8; ++i) s += bf2f((bf16_t)qr[d0][i]) * km[d0 * 16 + i];
          g[j] = xhalf_sum(s); }
#pragma unroll
      for (int round = 0; round < 3; ++round) { int best = -1; float bv = 0.f;
#pragma unroll
          for (int j = 0; j < 8; ++j) { const bool ok = (j < qb) && !((sel >> j) & 1u) && (best < 0 || g[j] > bv); if (ok) { best = j; bv = g[j]; } }
          if (best >= 0) sel |= 1u << best; } }
    const LAS float* btab = (const LAS float*)(lds + AL_BIAS); const float cfar = btab[0];
    FState st; fstate_reset(st);
    struct MobaSrc {
        const bf16_t *Kb, *Vb; LAS unsigned char* lds; int qb, qw, wid, lane; unsigned sel;
        __device__ __forceinline__ void tile(int t, int& blk, int& kt) const { blk = t < 4 ? qb : qb - 1 - ((t - 4) >> 2); kt = t < 4 ? t : ((t - 4) & 3); }
        __device__ __forceinline__ void dma(int t, int ks, int vs) const { int blk, kt; tile(t, blk, kt); const size_t key0 = (size_t)blk * 256 + kt * 64;
            dma_k(Kb + key0 * QKV_LD, QKV_LD, lds, ks, wid, lane); dma_v(Vb + key0 * QKV_LD, QKV_LD, lds, vs, wid, lane); }
        __device__ __forceinline__ TileP params(int t) const { int blk, kt; tile(t, blk, kt); TileP tp; tp.Dmin = qw - (blk * 256 + kt * 64); tp.win = false;
            if (blk == qb) { tp.rowok = true; tp.run = (64 * kt <= wid * 32 + 31); } else { tp.rowok = (sel >> blk) & 1u; tp.run = __any(tp.rowok); }
            return tp; }
        __device__ __forceinline__ void after(int, FState&) const {}
    } S{Kb, Vb, lds, qb, qw, wid, lane, sel};
    attn_stream<VAR>(S, NT, st, qr, lds, btab, cfar, wid, lane, r32, hi);
    const float inv = 1.0f / xhalf_sum(st.l);
    bf16_t* op = (bf16_t*)(p.ws + (VAR ? WS_X1B : WS_AOH)) + (rowbase + qw + r32) * 1024 + h * 64 + 4 * hi;
#pragma unroll
    for (int g4 = 0; g4 < 4; ++g4) {
        u32x2 w0, w1; w0.x = cvt_pk_bf16(st.o0[4 * g4] * inv, st.o0[4 * g4 + 1] * inv); w0.y = cvt_pk_bf16(st.o0[4 * g4 + 2] * inv, st.o0[4 * g4 + 3] * inv);
        w1.x = cvt_pk_bf16(st.o1[4 * g4] * inv, st.o1[4 * g4 + 1] * inv); w1.y = cvt_pk_bf16(st.o1[4 * g4 + 2] * inv, st.o1[4 * g4 + 3] * inv);
        *(u32x2*)(op + 8 * g4) = w0; *(u32x2*)(op + 32 + 8 * g4) = w1; }
}
template <int VAR> __device__ __forceinline__ void phase_moba(const Params& p, LAS unsigned char* lds) {
    for (int pr = blockIdx.x, rnd = 0; pr < 1024; pr += gridDim.x, ++rnd) { const int x = blockIdx.x & 7, s = blockIdx.x >> 3; const int bh = (gridDim.x == 256) ? (x + 8 * (rnd * 8 + (s >> 2))) : (pr >> 2), j = (gridDim.x == 256) ? (s & 3) : (pr & 3);
        moba_unit<VAR>(p, lds, bh >> 4, bh & 15, 7 - j);
        moba_unit<VAR>(p, lds, bh >> 4, bh & 15, j); }
    __syncthreads();
}

__device__ __forceinline__ void nsa_unit(const Params& p, LAS unsigned char* lds, int b, int hkv, int c, bool load_tab) {
    const int tid = otid(), lane = tid & 63, r32 = lane & 31, hi = lane >> 5; const int wid = __builtin_amdgcn_readfirstlane(tid >> 6);
    const bf16_t* P = (const bf16_t*)(p.ws + WS_BIG);
    const size_t rowbase = (size_t)b * SEQ; const int g = wid >> 1, qq0 = (wid & 1) * 32, h = hkv * 4 + g, qw = c * 64 + qq0, qpos = qw + r32;
    bf16x8 qr[4];
    const bf16_t* rowp = P + (rowbase + qpos) * NSA_LD;
#pragma unroll
    for (int d0 = 0; d0 < 4; ++d0) qr[d0] = *(const bf16x8*)(rowp + h * 64 + hi * 8 + d0 * 16);
    const float g0 = bf2f(rowp[NSA_G + h * 3]), g1 = bf2f(rowp[NSA_G + h * 3 + 1]), g2 = bf2f(rowp[NSA_G + h * 3 + 2]);
    __syncthreads();
    if (load_tab) { for (int i = tid; i < 4 * BT_H; i += NTHREADS) ((LAS float*)(lds + AL_BIAS))[i] = ((const float*)(p.ws + WS_TAB))[hkv * 4 * BT_H + i]; }
    if (tid < 64) ((LAS unsigned*)(lds + AL_SEL))[tid] = 0u;
    { const bf16_t* kc = (const bf16_t*)(p.ws + WS_KCMP) + (size_t)(b * 4 + hkv) * 128 * 64; const bf16_t* vc = (const bf16_t*)(p.ws + WS_VCMP) + (size_t)(b * 4 + hkv) * 128 * 64;
      dma_k(kc, 64, lds, 0, wid, lane); dma_k(kc + 64 * 64, 64, lds, 1, wid, lane); dma_v(vc, 64, lds, 0, wid, lane); dma_v(vc + 64 * 64, 64, lds, 1, wid, lane); }
    asm volatile("s_waitcnt vmcnt(0)" ::: "memory");
    __syncthreads();
    const lds_cptr kp0 = (lds_cptr)lds + AL_K + r32 * 128; const int kx = (r32 & 7) | (hi << 3);
    const lds_cptr vp0 = (lds_cptr)lds + AL_V + ((lane >> 4) & 1) * 32 + (lane & 3) * 8 + (4 * hi + ((lane & 15) >> 2)) * 64;
    f32x16 cb0, cb1;
    {
        f32x16 s[2][2];
        const int nlim = (qpos >= 31 ? ((qpos - 31) >> 4) + 1 : 0) - 4 * hi;
#pragma unroll
        for (int t = 0; t < 2; ++t) {
#pragma unroll
            for (int r = 0; r < 16; ++r) { s[t][0][r] = 0.f; s[t][1][r] = 0.f; }
            qk_tile(s[t][0], s[t][1], qr, kp0 + t * 8192, kx);
#pragma unroll
            for (int n2 = 0; n2 < 2; ++n2)
#pragma unroll
                for (int r = 0; r < 16; ++r) { const int nk = 64 * t + 32 * n2 + (r & 3) + 8 * (r >> 2); if (nk >= nlim) s[t][n2][r] = -INFINITY; }
        }
        const float mx = xhalf_max(__builtin_fmaxf(__builtin_fmaxf(max16(s[0][0]), max16(s[0][1])), __builtin_fmaxf(max16(s[1][0]), max16(s[1][1]))));
        const float mref = (mx == -INFINITY) ? 0.f : mx;
        float rs = 0.f;
#pragma unroll
        for (int t = 0; t < 2; ++t)
#pragma unroll
            for (int n2 = 0; n2 < 2; ++n2)
#pragma unroll
                for (int r = 0; r < 16; ++r) { const float e = __builtin_amdgcn_exp2f(s[t][n2][r] - mref); s[t][n2][r] = e; rs += e; }
        const float lt = xhalf_sum(rs); const float inv = lt > 0.f ? 1.0f / lt : 0.f;
#pragma unroll
        for (int t = 0; t < 2; ++t)
#pragma unroll
            for (int n2 = 0; n2 < 2; ++n2)
#pragma unroll
                for (int r = 0; r < 16; ++r) s[t][n2][r] *= inv;
        float Q[16], T[16];
#pragma unroll
        for (int t = 0; t < 2; ++t)
#pragma unroll
            for (int n2 = 0; n2 < 2; ++n2)
#pragma unroll
                for (int r4 = 0; r4 < 4; ++r4) { const int u = 8 * t + 4 * n2 + r4; Q[u] = (s[t][n2][4 * r4] + s[t][n2][4 * r4 + 1]) + (s[t][n2][4 * r4 + 2] + s[t][n2][4 * r4 + 3]); T[u] = s[t][n2][4 * r4 + 3]; }
        LAS float* imp = (LAS float*)(lds + AL_IMP) + (g * 64 + qq0 + r32) * 33;
        float prev = 0.f;
#pragma unroll
        for (int u = 0; u < 16; ++u) { const float rcv = __shfl_xor(T[u], 32); const float add = hi ? rcv : prev; prev = rcv; imp[2 * u + hi] = Q[u] + add; }
        f32x16 o0, o1;
#pragma unroll
        for (int r = 0; r < 16; ++r) { o0[r] = 0.f; o1[r] = 0.f; }
        pv_tile(o0, o1, s[0][0], s[0][1], vp0); pv_tile(o0, o1, s[1][0], s[1][1], vp0 + 8192);
#pragma unroll
        for (int r = 0; r < 16; ++r) { cb0[r] = g0 * o0[r]; cb1[r] = g0 * o1[r]; }
    }
    __syncthreads();
    {
        const int q = tid >> 3, jg = tid & 7; const LAS float* ib = (const LAS float*)(lds + AL_IMP) + q * 33;
        float val[32];
#pragma unroll
        for (int j = 0; j < 32; ++j) { float v = (ib[j] + ib[64 * 33 + j]) + (ib[2 * 64 * 33 + j] + ib[3 * 64 * 33 + j]);
            const bool forced = (j == 0) || (j == c) || (j == c - 1); v = forced ? INFINITY : v; val[j] = (j > c) ? -INFINITY : v; }
        unsigned bits = 0;
#pragma unroll
        for (int i = 0; i < 4; ++i) { const int j = jg * 4 + i; float vj = 0.f;
#pragma unroll
            for (int jj = 0; jj < 32; ++jj) vj = (jj == j) ? val[jj] : vj;
            int rank = 0;
#pragma unroll
            for (int jj = 0; jj < 32; ++jj) rank += (val[jj] > vj || (val[jj] == vj && jj < j)) ? 1 : 0;
            if (j <= c && rank < 16) bits |= 1u << j; }
        if (bits) atomicOr((unsigned*)(lds + AL_SEL) + q, bits);
    }
    __syncthreads();
    LAS float* stash = (LAS float*)(lds + AL_IMP) + wid * 2048 + lane;
#pragma unroll
    for (int r = 0; r < 16; ++r) { stash[r * 64] = cb0[r]; stash[(16 + r) * 64] = cb1[r]; }
    unsigned uni = ((const LAS unsigned*)(lds + AL_SEL))[lane];
#pragma unroll
    for (int o = 32; o > 0; o >>= 1) uni |= (unsigned)__shfl_xor((int)uni, o);
    uni = (unsigned)__builtin_amdgcn_readfirstlane((int)uni);
    const unsigned rowmask = ((const LAS unsigned*)(lds + AL_SEL))[qq0 + r32];
    const LAS float* btab = (const LAS float*)(lds + AL_BIAS) + g * BT_H; const float cfar = btab[0];
    const bf16_t* KS = P + rowbase * NSA_LD + NSA_KS + hkv * 64; const bf16_t* VS = P + rowbase * NSA_LD + NSA_VS + hkv * 64;
    const bf16_t* KW = P + rowbase * NSA_LD + NSA_KW + hkv * 64; const bf16_t* VW = P + rowbase * NSA_LD + NSA_VW + hkv * 64;
    const int nslc = __builtin_popcount(uni); const int wlo = c >= 8 ? 0 : 8 - c; const int NT = nslc + (9 - wlo);
    LAS int* list = (LAS int*)(lds + AL_LIST);
    if (tid < 32) { if ((uni >> tid) & 1u) list[__builtin_popcount(uni & ((1u << tid) - 1u))] = tid; }
    else if (tid < 32 + 9 - wlo) list[nslc + (tid - 32)] = 64 + (c - 8 + wlo + (tid - 32));
    __syncthreads();
    FState st; fstate_reset(st);
    struct NsaSrc {
        const bf16_t *KS, *VS, *KW, *VW; LAS unsigned char* lds; const LAS int* list; int nslc, qw, wid, lane; unsigned rowmask; float g1; LAS float* stash;
        __device__ __forceinline__ void dma(int t, int ks, int vs) const { const int e = __builtin_amdgcn_readfirstlane(list[t]);
            if (e < 64) { dma_k(KS + (size_t)e * 64 * NSA_LD, NSA_LD, lds, ks, wid, lane); dma_v(VS + (size_t)e * 64 * NSA_LD, NSA_LD, lds, vs, wid, lane); }
            else { dma_k(KW + (size_t)(e - 64) * 64 * NSA_LD, NSA_LD, lds, ks, wid, lane); dma_v(VW + (size_t)(e - 64) * 64 * NSA_LD, NSA_LD, lds, vs, wid, lane); } }
        __device__ __forceinline__ TileP params(int t) const { const int e = __builtin_amdgcn_readfirstlane(list[t]); TileP tp;
            if (e < 64) { tp.Dmin = qw - 64 * e; tp.rowok = (rowmask >> e) & 1u; tp.run = __any(tp.rowok); tp.win = false; }
            else { tp.Dmin = qw - 64 * (e - 64); tp.rowok = true; tp.run = true; tp.win = true; }
            return tp; }
        __device__ __forceinline__ void after(int t, FState& st) const {
            if (t == nslc - 1) { const float f = g1 / xhalf_sum(st.l);
#pragma unroll
                for (int r = 0; r < 16; ++r) { stash[r * 64] += f * st.o0[r]; stash[(16 + r) * 64] += f * st.o1[r]; }
                fstate_reset(st); } }
    } S{KS, VS, KW, VW, lds, list, nslc, qw, wid, lane, rowmask, g1, stash};
    attn_stream<0>(S, NT, st, qr, lds, btab, cfar, wid, lane, r32, hi);
    { const float f = g2 / xhalf_sum(st.l);
#pragma unroll
      for (int r = 0; r < 16; ++r) { cb0[r] = stash[r * 64] + f * st.o0[r]; cb1[r] = stash[(16 + r) * 64] + f * st.o1[r]; } }
    bf16_t* op = (bf16_t*)(p.ws + WS_AOH) + (rowbase + qpos) * 1024 + h * 64 + 4 * hi;
#pragma unroll
    for (int g4 = 0; g4 < 4; ++g4) {
        u32x2 w0, w1; w0.x = cvt_pk_bf16(cb0[4 * g4], cb0[4 * g4 + 1]); w0.y = cvt_pk_bf16(cb0[4 * g4 + 2], cb0[4 * g4 + 3]);
        w1.x = cvt_pk_bf16(cb1[4 * g4], cb1[4 * g4 + 1]); w1.y = cvt_pk_bf16(cb1[4 * g4 + 2], cb1[4 * g4 + 3]);
        *(u32x2*)(op + 8 * g4) = w0; *(u32x2*)(op + 32 + 8 * g4) = w1; }
}
__device__ __forceinline__ void phase_nsa(const Params& p, LAS unsigned char* lds) {
    int last_hkv = -1;
    for (int pr = blockIdx.x, rnd = 0; pr < 1024; pr += gridDim.x, ++rnd) { const int x = blockIdx.x & 7, s = blockIdx.x >> 3; const int bh = (gridDim.x == 256) ? (x + 8 * (rnd * 2 + (s >> 4))) : (pr >> 4), j = (gridDim.x == 256) ? (s & 15) : (pr & 15);
        nsa_unit(p, lds, bh >> 2, bh & 3, 31 - j, (bh & 3) != last_hkv);
        nsa_unit(p, lds, bh >> 2, bh & 3, j, false); last_hkv = bh & 3; }
    __syncthreads();
}

template <int L> __device__ __forceinline__ void phase_ln1(const Params& p, LAS unsigned char* lds) {
    const int tid = otid(), lane = tid & 63, wid = tid >> 6, r = lane & 15, q = lane >> 4;
    const float* lg = p.ln_g + (L * 2 + 0) * 1024; const float* lb = p.ln_b + (L * 2 + 0) * 1024;
    const bf16_t* Y = (const bf16_t*)(p.ws + WS_BIG); bf16_t* X1 = (bf16_t*)(p.ws + WS_X1B);
    for (int i = tid; i < 32 * 2 * 64; i += NTHREADS) { const int l2 = i & 63, nb = (i >> 6) & 1, s = i >> 7; const int e = 16 * nb + (l2 & 15), k0 = 32 * s + 8 * (l2 >> 4);
        float w[8]; unsigned hw[4], lw[4];
#pragma unroll
        for (int j = 0; j < 8; ++j) w[j] = p.router_w[(size_t)(k0 + j) * 32 + e];
#pragma unroll
        for (int j = 0; j < 4; ++j) { hw[j] = cvt_pk_bf16(w[2 * j], w[2 * j + 1]); lw[j] = cvt_pk_bf16(w[2 * j] - lo_bf(hw[j]), w[2 * j + 1] - hi_bf(hw[j])); }
        *(LAS u32x4*)(lds + ((size_t)((s * 2 + nb) * 2 + 0) * 64 + l2) * 16) = (u32x4){hw[0], hw[1], hw[2], hw[3]};
        *(LAS u32x4*)(lds + ((size_t)((s * 2 + nb) * 2 + 1) * 64 + l2) * 16) = (u32x4){lw[0], lw[1], lw[2], lw[3]}; }
    LAS int* hist = (LAS int*)(lds + 131072 + 8 * 2048);
    if (tid < 32) hist[tid] = 0;
    __syncthreads();
    for (int tb = blockIdx.x; tb < NTOK / 128; tb += gridDim.x) {
        const int tok = tb * 128 + wid * 16 + r;
        const bf16_t* yp = Y + (size_t)tok * 1024 + 8 * q;
        float sum = 0.f, sq = 0.f;
#pragma unroll 16
        for (int s = 0; s < 32; ++s) { const u32x4 y = *(const u32x4*)(yp + 32 * s); const unsigned yw[4] = {y.x, y.y, y.z, y.w};
#pragma unroll
            for (int j = 0; j < 4; ++j) { const float a = lo_bf(yw[j]), b2 = hi_bf(yw[j]); sum += a + b2; sq += a * a + b2 * b2; } }
        sum += __shfl_xor(sum, 16); sum += __shfl_xor(sum, 32); sq += __shfl_xor(sq, 16); sq += __shfl_xor(sq, 32);
        const float mu = sum * (1.0f / 1024.0f);
        const float rstd = rsqrtf(fmaxf(sq * (1.0f / 1024.0f) - mu * mu, 0.f) + 1e-5f);
        f32x4 acc0 = (f32x4){0.f, 0.f, 0.f, 0.f}, acc1 = acc0;
        bf16_t* xp = X1 + (size_t)tok * 1024 + 8 * q;
#pragma unroll 4
        for (int s = 0; s < 32; ++s) {
            const u32x4 y = *(const u32x4*)(yp + 32 * s);
            const f32x4 ga = *(const f32x4*)(lg + 32 * s + 8 * q), gb = *(const f32x4*)(lg + 32 * s + 8 * q + 4), ba = *(const f32x4*)(lb + 32 * s + 8 * q), bb = *(const f32x4*)(lb + 32 * s + 8 * q + 4);
            u32x4 w;
            w.x = cvt_pk_bf16((lo_bf(y.x) - mu) * rstd * ga[0] + ba[0], (hi_bf(y.x) - mu) * rstd * ga[1] + ba[1]);
            w.y = cvt_pk_bf16((lo_bf(y.y) - mu) * rstd * ga[2] + ba[2], (hi_bf(y.y) - mu) * rstd * ga[3] + ba[3]);
            w.z = cvt_pk_bf16((lo_bf(y.z) - mu) * rstd * gb[0] + bb[0], (hi_bf(y.z) - mu) * rstd * gb[1] + bb[1]);
            w.w = cvt_pk_bf16((lo_bf(y.w) - mu) * rstd * gb[2] + bb[2], (hi_bf(y.w) - mu) * rstd * gb[3] + bb[3]);
            *(u32x4*)(xp + 32 * s) = w;
            const bf16x8 af = __builtin_bit_cast(bf16x8, w);
            const LAS unsigned char* bq = lds + (size_t)s * 4096 + lane * 16;
            const bf16x8 b0h = *(const LAS bf16x8*)(bq), b0l = *(const LAS bf16x8*)(bq + 1024), b1h = *(const LAS bf16x8*)(bq + 2048), b1l = *(const LAS bf16x8*)(bq + 3072);
            acc0 = __builtin_amdgcn_mfma_f32_16x16x32_bf16(af, b0h, acc0, 0, 0, 0); acc0 = __builtin_amdgcn_mfma_f32_16x16x32_bf16(af, b0l, acc0, 0, 0, 0);
            acc1 = __builtin_amdgcn_mfma_f32_16x16x32_bf16(af, b1h, acc1, 0, 0, 0); acc1 = __builtin_amdgcn_mfma_f32_16x16x32_bf16(af, b1l, acc1, 0, 0, 0);
        }
        LAS float* lg2 = (LAS float*)(lds + 131072 + wid * 2048);
#pragma unroll
        for (int i = 0; i < 4; ++i) { lg2[(4 * q + i) * 32 + r] = acc0[i] + p.router_b[r]; lg2[(4 * q + i) * 32 + 16 + r] = acc1[i] + p.router_b[16 + r]; }
        asm volatile("s_waitcnt lgkmcnt(0)" ::: "memory");
        int e0 = 0, e1 = 0, r0 = 0, r1 = 0; float w0 = 0.f, w1 = 0.f;
        if (lane < 16) {
            float pr[32]; float mx = -INFINITY;
#pragma unroll
            for (int e = 0; e < 32; ++e) { pr[e] = lg2[lane * 32 + e]; mx = fmaxf(mx, pr[e]); }
#pragma unroll
            for (int e = 0; e < 32; ++e) pr[e] = __expf(pr[e] - mx);
            int best = 0; float bs = -1.f;
#pragma unroll
            for (int gi = 0; gi < 8; ++gi) { const float a = pr[4 * gi], b2 = pr[4 * gi + 1], c2 = pr[4 * gi + 2], d2 = pr[4 * gi + 3];
                const float h1 = fmaxf(a, b2), l1 = fminf(a, b2), h2 = fmaxf(c2, d2), l2 = fminf(c2, d2);
                const float m1 = fmaxf(h1, h2), m2 = fmaxf(fminf(h1, h2), fmaxf(l1, l2));
                const float sc = m1 + m2; if (sc > bs) { bs = sc; best = gi; } }
            float v[4];
#pragma unroll
            for (int gi = 0; gi < 8; ++gi) if (gi == best) { v[0] = pr[4 * gi]; v[1] = pr[4 * gi + 1]; v[2] = pr[4 * gi + 2]; v[3] = pr[4 * gi + 3]; }
            int i0 = 0; float v0 = v[0];
#pragma unroll
            for (int i = 1; i < 4; ++i) if (v[i] > v0) { v0 = v[i]; i0 = i; }
            int i1 = -1; float v1 = -1.f;
#pragma unroll
            for (int i = 0; i < 4; ++i) if (i != i0 && v[i] > v1) { v1 = v[i]; i1 = i; }
            e0 = best * 4 + i0; e1 = best * 4 + i1; const float ws = 1.0f / (v0 + v1); w0 = v0 * ws; w1 = v1 * ws;
            r0 = atomicAdd((int*)hist + e0, 1); r1 = atomicAdd((int*)hist + e1, 1);
        }
        __syncthreads();
        if (tid < 32) { const int hv = hist[tid]; hist[32 + tid] = hv ? atomicAdd((int*)(p.ws + WS_GCNT) + L * 32 + tid, hv) : 0; }
        __syncthreads();
        if (lane < 16) { const int t2 = tb * 128 + wid * 16 + lane; const int s0 = hist[32 + e0] + r0, s1 = hist[32 + e1] + r1;
            ((int*)(p.ws + WS_RE))[t2 * 2] = e0; ((int*)(p.ws + WS_RE))[t2 * 2 + 1] = e1;
            ((float*)(p.ws + WS_RWT))[t2 * 2] = w0; ((float*)(p.ws + WS_RWT))[t2 * 2 + 1] = w1;
            ((int*)(p.ws + WS_POS))[t2 * 2] = s0; ((int*)(p.ws + WS_POS))[t2 * 2 + 1] = s1;
            ((int*)(p.ws + WS_ROWTOK))[e0 * 65536 + s0] = t2; ((int*)(p.ws + WS_ROWTOK))[e1 * 65536 + s1] = t2; }
        __syncthreads();
        if (tid < 32) hist[tid] = 0;
        __syncthreads();
    }
}

template <int L> __device__ __forceinline__ void phase_ln2(const Params& p, LAS unsigned char* lds) {
    const int tid = otid(), lane = tid & 63, wid = tid >> 6;
    LAS int* pst = (LAS int*)lds;
    __syncthreads();
    if (tid == 0) { const int* cnt = (const int*)(p.ws + WS_GCNT) + L * 32; int s = 0; for (int e = 0; e < NEXP; ++e) { pst[e] = s; s += (cnt[e] + 255) & ~255; } }
    __syncthreads();
    const int* RE = (const int*)(p.ws + WS_RE);
    const float* lg = p.ln_g + (L * 2 + 1) * 1024; const float* lb = p.ln_b + (L * 2 + 1) * 1024;
    const bf16_t* X1 = (const bf16_t*)(p.ws + WS_X1B); const bf16_t* YB = (const bf16_t*)(p.ws + WS_BIG);
    const int* POS = (const int*)(p.ws + WS_POS); const float* RW = (const float*)(p.ws + WS_RWT);
    const int tok0 = blockIdx.x * 8 + wid, tstride = gridDim.x * 8, nk = (NTOK - tok0 + tstride - 1) / tstride;
    int rs0 = 0, rs1 = 0; float rw0 = 0.f, rw1 = 0.f;
    if (lane < nk && lane < 16) { const int t = tok0 + lane * tstride; rs0 = pst[RE[t * 2]] + POS[t * 2]; rs1 = pst[RE[t * 2 + 1]] + POS[t * 2 + 1]; rw0 = RW[t * 2]; rw1 = RW[t * 2 + 1]; }
    u32x4 ra[2][2], rb[2][2], rc[2][2];
#define LN2_LOAD(k, buf) do { const int t_ = tok0 + (k) * tstride; const int s0_ = __shfl(rs0, (k)), s1_ = __shfl(rs1, (k)); _Pragma("unroll") for (int hf = 0; hf < 2; ++hf) { const int c0 = hf * 512 + lane * 8; \
        ra[buf][hf] = *(const u32x4*)(X1 + (size_t)t_ * 1024 + c0); rb[buf][hf] = *(const u32x4*)(YB + (size_t)s0_ * 1024 + c0); rc[buf][hf] = *(const u32x4*)(YB + (size_t)s1_ * 1024 + c0); } } while (0)
    if (nk > 0) LN2_LOAD(0, 0);
#pragma unroll
    for (int k = 0; k < 16; ++k) {
        if (k < nk) {
            const int tok = tok0 + k * tstride; const float w0 = __shfl(rw0, k), w1 = __shfl(rw1, k);
            if (k + 1 < nk) LN2_LOAD(k + 1, (k + 1) & 1);
            float v[16];
#pragma unroll
            for (int hf = 0; hf < 2; ++hf) { const u32x4 a = ra[k & 1][hf], b = rb[k & 1][hf], c = rc[k & 1][hf];
                const unsigned aw[4] = {a.x, a.y, a.z, a.w}, bw[4] = {b.x, b.y, b.z, b.w}, cw[4] = {c.x, c.y, c.z, c.w};
#pragma unroll
                for (int j = 0; j < 4; ++j) { v[hf * 8 + 2 * j] = ALPHA * lo_bf(aw[j]) + w0 * lo_bf(bw[j]) + w1 * lo_bf(cw[j]); v[hf * 8 + 2 * j + 1] = ALPHA * hi_bf(aw[j]) + w0 * hi_bf(bw[j]) + w1 * hi_bf(cw[j]); } }
            float s = 0.f;
#pragma unroll
            for (int i = 0; i < 16; ++i) s += v[i];
            const float mu = wave_sum(s) * (1.0f / 1024.0f);
            float qv = 0.f;
#pragma unroll
            for (int i = 0; i < 16; ++i) { const float d = v[i] - mu; qv += d * d; }
            const float rstd = rsqrtf(wave_sum(qv) * (1.0f / 1024.0f) + 1e-5f);
#pragma unroll
            for (int hf = 0; hf < 2; ++hf) { const int c0 = hf * 512 + lane * 8; float o[8];
                const f32x4 ga = *(const f32x4*)(lg + c0), gb = *(const f32x4*)(lg + c0 + 4), ba = *(const f32x4*)(lb + c0), bb = *(const f32x4*)(lb + c0 + 4);
#pragma unroll
                for (int j = 0; j < 4; ++j) { o[j] = (v[hf * 8 + j] - mu) * rstd * ga[j] + ba[j]; o[4 + j] = (v[hf * 8 + 4 + j] - mu) * rstd * gb[j] + bb[j]; }
                if (L == 1) { *(f32x4*)(p.out + (size_t)tok * 1024 + c0) = (f32x4){o[0], o[1], o[2], o[3]}; *(f32x4*)(p.out + (size_t)tok * 1024 + c0 + 4) = (f32x4){o[4], o[5], o[6], o[7]}; }
                else { u32x4 w; w.x = cvt_pk_bf16(o[0], o[1]); w.y = cvt_pk_bf16(o[2], o[3]); w.z = cvt_pk_bf16(o[4], o[5]); w.w = cvt_pk_bf16(o[6], o[7]); *(u32x4*)((bf16_t*)(p.ws + WS_XB) + (size_t)tok * 1024 + c0) = w; } }
        }
    }
#undef LN2_LOAD
}

__device__ __forceinline__ void phase_cmpfin(const Params& p, LAS unsigned char* lds) {
    const int tid = otid(), lane = tid & 63, wid = tid >> 6;
    LAS float* w2s = (LAS float*)lds;
    LAS float* hs = (LAS float*)(lds + 65536) + wid * 1024;
    LAS float* b1s = (LAS float*)(lds + 65536 + 32768);
    const float* CP = (const float*)(p.ws + WS_X1B); const float* B1 = (const float*)(p.ws + WS_B1);
    for (int kv = 0; kv < 2; ++kv) {
        __syncthreads();
        { const float* w2g = kv ? p.cv_w2 : p.ck_w2; for (int i = tid; i < 256 * 64; i += NTHREADS) w2s[i] = w2g[i]; }
        if (tid < 256) { float b1 = 0.f;
#pragma unroll 8
            for (int pt = 0; pt < 32; ++pt) b1 += B1[(kv * 32 + pt) * 256 + tid];
            b1s[tid] = b1; }
        __syncthreads();
        bf16_t* dst = (bf16_t*)(p.ws + (kv ? WS_VCMP : WS_KCMP));
        for (int rg = blockIdx.x * 8 + wid; rg < 8192 / 4; rg += gridDim.x * 8) {
            const int m0 = rg * 4;
#pragma unroll
            for (int i = 0; i < 4; ++i) { const int j = lane + 64 * i; const float b1 = b1s[j];
                f32x4 hv;
#pragma unroll
                for (int rr = 0; rr < 4; ++rr) { float a = b1;
#pragma unroll
                    for (int ks = 0; ks < 4; ++ks) a += CP[((size_t)(kv * 4 + ks) * 8192 + m0 + rr) * 256 + j];
                    const float u = 0.7978845608028654f * (a + 0.044715f * a * a * a); const float th = 1.0f - 2.0f / (1.0f + __expf(2.0f * u));
                    hv[rr] = 0.5f * a * (1.0f + th); }
                *(LAS f32x4*)(hs + j * 4) = hv; }
            asm volatile("s_waitcnt lgkmcnt(0)" ::: "memory");
            f32x4 o = (f32x4){0.f, 0.f, 0.f, 0.f}; const LAS float* w2 = w2s + lane;
#pragma unroll 8
            for (int j = 0; j < 256; ++j) o += *(const LAS f32x4*)(hs + j * 4) * w2[j * 64];
#pragma unroll
            for (int rr = 0; rr < 4; ++rr) dst[(size_t)(m0 + rr) * 64 + lane] = f2bf((((m0 + rr) & 127) == 127) ? 0.f : o[rr]);
            asm volatile("s_waitcnt lgkmcnt(0)" ::: "memory");
        }
    }
}

constexpr int NPHASE = 19;
template <int PH> __device__ __forceinline__ void run_phase(const Params& p, LAS unsigned char* lds) {
    char* ws = p.ws;
    if constexpr (PH == 0) phase_prologue(p, lds);
    else if constexpr (PH == 1) { SchedPlain S; S.init(ws + WS_XB, ws + WS_WQKV0, NTOK, 3072, 1024); EpiQKV0 E{(bf16_t*)(ws + WS_BIG), (float*)(ws + WS_KPART)}; pg8::gemm_phase(lds, S, E); }
    else if constexpr (PH == 2) phase_moba<0>(p, lds);
    else if constexpr (PH == 3) { SchedPlain S; S.init(ws + WS_AOH, ws + WS_WO0, NTOK, 1024, 1024); EpiRes<true> E{(bf16_t*)(ws + WS_BIG), p.x, nullptr}; pg8::gemm_phase(lds, S, E); }
    else if constexpr (PH == 4) phase_ln1<0>(p, lds);
    else if constexpr (PH == 6 || PH == 16) { SchedMoeGU S; S.init(ws, PH == 16, lds); EpiGU E{(bf16_t*)(ws + WS_AOH)}; pg8::gemm_phase(lds, S, E); }
    else if constexpr (PH == 7 || PH == 17) { SchedMoeDN S; S.init(ws, PH == 17, lds); EpiDN E{(bf16_t*)(ws + WS_BIG)}; pg8::gemm_phase(lds, S, E); }
    else if constexpr (PH == 8) { phase_ln2<0>(p, lds); __syncthreads(); conv_moe_layer(p, 1, lds); }
    else if constexpr (PH == 9) { SchedPlain S; S.init(ws + WS_XB, ws + WS_WIN1, NTOK, 2816, 1024); EpiNSA E{(bf16_t*)(ws + WS_BIG)}; pg8::gemm_phase(lds, S, E); }
    else if constexpr (PH == 10) { SchedCmp S; S.init(ws); EpiCmp E{(float*)(ws + WS_X1B)}; pg8::gemm_phase(lds, S, E); }
    else if constexpr (PH == 11) phase_cmpfin(p, lds);
    else if constexpr (PH == 12) phase_nsa(p, lds);
    else if constexpr (PH == 13) { SchedPlain S; S.init(ws + WS_AOH, ws + WS_WO1, NTOK, 1024, 1024); EpiRes<false> E{(bf16_t*)(ws + WS_BIG), nullptr, (const bf16_t*)(ws + WS_XB)}; pg8::gemm_phase(lds, S, E); }
    else if constexpr (PH == 14) phase_ln1<1>(p, lds);
    else if constexpr (PH == 18) phase_ln2<1>(p, lds);
}

extern __shared__ __attribute__((aligned(16))) unsigned char g_smem[];

template <int PH> __global__ void __launch_bounds__(NTHREADS, 2) k_phase(Params p) {
    run_phase<PH>(p, (LAS unsigned char*)g_smem);
}

#if !MK_LAUNCHES
template <int PH> __device__ __forceinline__ void mega_seq(const Params& p, LAS unsigned char* lds, const XcdBarrier& bar) {
    if constexpr (PH == 5 || PH == 15) { mega_seq<PH + 1>(p, lds, bar); return; }
    run_phase<PH>(p, lds);
#ifdef PROBE_VAR
    if constexpr (PH == 2) { xcd_barrier(bar); phase_moba<PROBE_VAR>(p, lds); }
#endif
#ifdef PROBE_BAR
    if constexpr (PH == 3) { for (int i = 0; i < 16; ++i) xcd_barrier(bar); }
#endif
#ifdef PROBE_GEMM_NULL
    if constexpr (PH == 1) { xcd_barrier(bar); SchedPlain S; S.init(p.ws + WS_XB, p.ws + WS_WQKV0, NTOK, 3072, 1024); EpiNull E{(float*)(p.ws + WS_X1B)}; pg8::gemm_phase(lds, S, E); }
#endif
#ifdef PROBE_MASK
    if constexpr ((PROBE_MASK >> PH) & 1) { xcd_barrier(bar); run_phase<PH>(p, lds); }
#endif
    if constexpr (PH + 1 < NPHASE) { xcd_barrier(bar); mega_seq<PH + 1>(p, lds, bar); }
}
__global__ void __launch_bounds__(NTHREADS, 2) k_mega(Params p) {
    LAS unsigned char* lds = (LAS unsigned char*)g_smem;
    LAS unsigned* stw = (LAS unsigned*)(lds + LDS_BYTES - 16);
    if (threadIdx.x == 0) { stw[0] = 0u; stw[1] = 0u; stw[2] = 0u; stw[3] = 0u; }
    __syncthreads();
    XcdBarrier bar = xcd_barrier_post((unsigned*)(p.ws + WS_CTL), (volatile LAS unsigned*)stw);
    mega_seq<0>(p, lds, bar);
}

#endif
template <int PH> static void launch_phases(const Params& p, int grid, hipStream_t stream) {
    hipFuncSetAttribute((const void*)k_phase<PH>, hipFuncAttributeMaxDynamicSharedMemorySize, LDS_BYTES);
    hipLaunchKernelGGL(k_phase<PH>, dim3(grid), dim3(NTHREADS), LDS_BYTES, stream, p);
    if constexpr (PH + 1 < NPHASE) launch_phases<PH + 1>(p, grid, stream);
}

extern "C" void kernel_launch(void* const* d_in, const int* in_sizes, int n_in, void* d_out, int out_size, void* d_ws, size_t ws_size, hipStream_t stream) {
    if (n_in != 19 || ws_size < WS_END) { fprintf(stderr, "kernel_launch: need 19 inputs and %zu bytes of workspace (got %d, %zu)\n", (size_t)WS_END, n_in, ws_size); return; }
    Params p{};
    p.x = (const float*)d_in[0]; p.rel_bias = (const float*)d_in[1]; p.router_w = (const float*)d_in[2]; p.router_b = (const float*)d_in[3];
    p.ln_g = (const float*)d_in[4]; p.ln_b = (const float*)d_in[5]; p.moba_w_in = (const float*)d_in[6]; p.moba_w_out = (const float*)d_in[7];
    p.nsa_w_in = (const float*)d_in[8]; p.nsa_w_out = (const float*)d_in[9]; p.pos_k = (const float*)d_in[10]; p.pos_v = (const float*)d_in[11];
    p.ck_w1 = (const float*)d_in[12]; p.ck_w2 = (const float*)d_in[13]; p.cv_w1 = (const float*)d_in[14]; p.cv_w2 = (const float*)d_in[15];
    p.w_gate = (const float*)d_in[16]; p.w_up = (const float*)d_in[17]; p.w_down = (const float*)d_in[18];
    p.out = (float*)d_out; p.ws = (char*)d_ws;
    const int grid = NWG_EXPECT;
#if MK_LAUNCHES
    launch_phases<0>(p, grid, stream);
#else
    hipFuncSetAttribute((const void*)k_mega, hipFuncAttributeMaxDynamicSharedMemorySize, LDS_BYTES);
    hipMemsetAsync((char*)d_ws + WS_CTL, 0, 16384, stream);
    hipLaunchKernelGGL(k_mega, dim3(grid), dim3(NTHREADS), LDS_BYTES, stream, p);
#endif
}
```

```cpp
#include <hip/hip_runtime.h>
#include <cstdio>
#include <cstdint>

#ifndef MK_LAUNCHES
#define MK_LAUNCHES 0
#endif

#define LAS __attribute__((address_space(3)))
typedef unsigned short bf16_t;
typedef short bf16x8 __attribute__((ext_vector_type(8)));
typedef short s16x4 __attribute__((ext_vector_type(4)));
typedef short v4i16_t __attribute__((ext_vector_type(4)));
typedef float f32x4 __attribute__((ext_vector_type(4)));
typedef float f32x16 __attribute__((ext_vector_type(16)));
typedef unsigned u32x4 __attribute__((ext_vector_type(4)));
typedef unsigned u32x2 __attribute__((ext_vector_type(2)));
typedef LAS const char* lds_cptr;

constexpr int NTOK = 32768, DM = 1024, SEQ = 2048, NBATCH = 16, NHEAD = 16;
constexpr int QKV_LD = 3072, NSA_LD = 2816;
constexpr int NSA_KC = 1024, NSA_VC = 1280, NSA_KS = 1536, NSA_VS = 1792, NSA_KW = 2048, NSA_VW = 2304, NSA_G = 2560;
constexpr int NEXP = 32, DEXP = 512, MAXPAN = 288, RPAD = MAXPAN * 256;
constexpr int NTHREADS = 512, NWG_EXPECT = 256;
constexpr int LDS_BYTES = 155648;
constexpr float LOG2E = 1.4426950408889634f;
constexpr float C2 = 0.125f * LOG2E;
constexpr float ALPHA = 1.4142135623730951f;
constexpr int BT_N = 288;
constexpr int BT_S = 292, BT_H = 4 * BT_S;

constexpr size_t al256(size_t x) { return (x + 255) & ~(size_t)255; }
constexpr size_t WS_CTL = 0;
constexpr size_t WS_GCNT = 14336;
constexpr size_t WS_TAB = 16384;
constexpr size_t WS_B1 = WS_TAB + al256(16 * BT_H * 4);
constexpr size_t WS_NPAN = WS_B1 + 65536;
constexpr size_t WS_PANEL = WS_NPAN + 256;
constexpr size_t WS_HIST = WS_PANEL + 1280;
constexpr size_t WS_KPART = WS_HIST + 32768;
constexpr size_t WS_RE = WS_KPART + 128 * 2 * 1024 * 4;
constexpr size_t WS_RWT = WS_RE + (size_t)NTOK * 8;
constexpr size_t WS_POS = WS_RWT + (size_t)NTOK * 8;
constexpr size_t WS_ROWTOK = WS_POS + (size_t)NTOK * 8;
constexpr size_t WS_KCMP = WS_ROWTOK + (size_t)32 * 65536 * 4;
constexpr size_t WS_VCMP = WS_KCMP + 16 * 4 * 128 * 64 * 2;
constexpr size_t WS_WQKV0 = WS_VCMP + 16 * 4 * 128 * 64 * 2;
constexpr size_t WS_WO0 = WS_WQKV0 + (size_t)3072 * 1024 * 2;
constexpr size_t WS_WIN1 = WS_WO0 + (size_t)1024 * 1024 * 2;
constexpr size_t WS_WO1 = WS_WIN1 + (size_t)2816 * 1024 * 2;
constexpr size_t WS_W1T = WS_WO1 + (size_t)1024 * 1024 * 2;
constexpr size_t WS_GU = WS_W1T + (size_t)2 * 256 * 2048 * 2;
constexpr size_t WS_DN = WS_GU + (size_t)32 * 1024 * 1024 * 2;
constexpr size_t WS_XB = WS_DN + (size_t)32 * 1024 * 512 * 2;
constexpr size_t WS_BIG = WS_XB + (size_t)NTOK * 1024 * 2;
constexpr size_t WS_AOH = WS_BIG + (size_t)NTOK * 3072 * 2;
constexpr size_t WS_X1B = WS_AOH + (size_t)RPAD * 512 * 2;
constexpr size_t WS_END = WS_X1B + (size_t)NTOK * 1024 * 2;

struct Params {
    const float *x, *rel_bias, *router_w, *router_b, *ln_g, *ln_b, *moba_w_in, *moba_w_out, *nsa_w_in, *nsa_w_out, *pos_k, *pos_v,
                *ck_w1, *ck_w2, *cv_w1, *cv_w2, *w_gate, *w_up, *w_down;
    float* out;
    char* ws;
};

__device__ __forceinline__ int otid() { int t = threadIdx.x; asm volatile("" : "+v"(t)); return t; }
__device__ __forceinline__ float bf2f(bf16_t v) { return __uint_as_float(((unsigned)v) << 16); }
__device__ __forceinline__ unsigned cvt_pk_bf16(float lo, float hi) { unsigned r; asm volatile("v_cvt_pk_bf16_f32 %0, %1, %2" : "=v"(r) : "v"(lo), "v"(hi)); return r; }
__device__ __forceinline__ bf16_t f2bf(float f) { return (bf16_t)(cvt_pk_bf16(f, 0.f) & 0xffffu); }
__device__ __forceinline__ float lo_bf(unsigned w) { return __uint_as_float(w << 16); }
__device__ __forceinline__ float hi_bf(unsigned w) { return __uint_as_float(w & 0xffff0000u); }
__device__ __forceinline__ float wave_sum(float v) {
#pragma unroll
    for (int o = 32; o > 0; o >>= 1) v += __shfl_xor(v, o);
    return v; }

#define XB_TMO      128
#define XB_XCNT(j)  (256  + 64 * (j))
#define XB_XSUB(j)  (1280 + 64 * (j))
#define XB_XGEN(j)  (2304 + 64 * (j))
#define XB_TOP      3328
#define XB_TOPGEN   3392
#define XCD_BAR_WORDS 3456
#define XB_SPIN_CAP (1u << 18)
__device__ __forceinline__ unsigned xb_ld(unsigned* p)              { return __hip_atomic_load(p, __ATOMIC_RELAXED, __HIP_MEMORY_SCOPE_AGENT); }
__device__ __forceinline__ unsigned xb_add(unsigned* p, unsigned v) { return __hip_atomic_fetch_add(p, v, __ATOMIC_RELAXED, __HIP_MEMORY_SCOPE_AGENT); }
__device__ __forceinline__ unsigned xb_xcc_id() { return (unsigned)__builtin_amdgcn_s_getreg((3 << 11) | 20) & 0xFu; }
#define XB_SPIN(cond, bar) do { unsigned _sp = 0; while (cond) { __builtin_amdgcn_s_sleep(1); \
    if ((++_sp & 255u) == 0u) { if (xb_ld(&(bar)[XB_TMO])) break; if (_sp > XB_SPIN_CAP) { atomicAdd(&(bar)[XB_TMO], 1u); break; } } } } while (0)
struct XcdBarrier { unsigned* bar; unsigned x; volatile LAS unsigned* st; };
__device__ __forceinline__ XcdBarrier xcd_barrier_post(unsigned* bar, volatile LAS unsigned* st) {
    XcdBarrier b; b.bar = bar; b.x = xb_xcc_id(); b.st = st;
    if (threadIdx.x == 0) (void)xb_add(&bar[XB_XCNT(b.x)], 1u);
    return b;
}
__device__ __forceinline__ void xcd_barrier_complete(unsigned* bar, unsigned x, unsigned& nloc, unsigned& nx) {
    const unsigned G = gridDim.x * gridDim.y * gridDim.z;
    unsigned sum, cnt, mine, sp = 0u;
    for (;;) {
        sum = 0u; cnt = 0u; mine = 0u;
#pragma unroll
        for (unsigned j = 0; j < 16; ++j) { const unsigned c = xb_ld(&bar[XB_XCNT(j)]); sum += c; cnt += (c > 0u) ? 1u : 0u; mine = (j == x) ? c : mine; }
        if (sum == G) break;
        __builtin_amdgcn_s_sleep(1);
        if ((++sp & 255u) == 0u) { if (xb_ld(&bar[XB_TMO])) break; if (sp > XB_SPIN_CAP) { atomicAdd(&bar[XB_TMO], 1u); break; } }
    }
    nloc = mine > 0u ? mine : 1u; nx = cnt > 0u ? cnt : 1u;
}
__device__ __forceinline__ void xcd_barrier(const XcdBarrier& b) {
    asm volatile("s_waitcnt vmcnt(0)" ::: "memory");
    __syncthreads();
    if (threadIdx.x == 0) {
        unsigned* bar = b.bar;
        __builtin_amdgcn_s_waitcnt(0);
        unsigned nloc = b.st[0], nx = b.st[1];
        if (nloc == 0u) { xcd_barrier_complete(bar, b.x, nloc, nx); b.st[0] = nloc; b.st[1] = nx; }
        const unsigned old = xb_add(&bar[XB_XSUB(b.x)], 1u);
        const unsigned gen = old / nloc;
        if (old + 1u == (gen + 1u) * nloc) {
            __builtin_amdgcn_fence(__ATOMIC_RELEASE, "agent");
            asm volatile("s_waitcnt vmcnt(0)" ::: "memory");
            const unsigned og = xb_add(&bar[XB_TOP], 1u);
            const unsigned tg = og / nx;
            if (og + 1u == (tg + 1u) * nx) xb_add(&bar[XB_TOPGEN], 1u);
            else XB_SPIN(xb_ld(&bar[XB_TOPGEN]) == tg, bar);
            __builtin_amdgcn_fence(__ATOMIC_ACQUIRE, "agent");
            xb_add(&bar[XB_XGEN(b.x)], 1u);
            asm volatile("s_waitcnt vmcnt(0)" ::: "memory");
        } else {
            XB_SPIN(xb_ld(&bar[XB_XGEN(b.x)]) == gen, bar);
            __builtin_amdgcn_fence(__ATOMIC_ACQUIRE, "agent");
            asm volatile("s_waitcnt vmcnt(0)" ::: "memory");
        }
    }
    __syncthreads();
}

namespace pg8 {
constexpr int BM = 256, BK = 64, HALF = 128, HTB = HALF * BK * 2, STAGE_BYTES = 8 * HTB, NXCD = 8, WGM = 8;
__device__ __forceinline__ int lds_byte(int r, int c) { const int st = (r >> 4) * 2 + (c >> 5), rr = r & 15, cc = c & 31, ob = rr * 64 + cc * 2; return st * 1024 + (ob ^ (((ob >> 9) & 1) << 5)); }
__device__ __forceinline__ void stage_rc(int b, int& R, int& C) { const int st = b / 1024, sb = b % 1024, swz = sb ^ (((sb >> 9) & 1) << 5); R = (st >> 1) * 16 + swz / 64; C = (st & 1) * 32 + (swz % 64) / 2; }
__device__ __forceinline__ int perm32(int rho) { const int n = rho >> 4, i = rho & 15; return 8 * (i >> 2) + 4 * n + (i & 3); }
struct Unit { int pm, pn, aux, aux2; };

__device__ __forceinline__ void static_unit(int L, int nM, int nN, Unit& u) {
    const int nwg = nM * nN;
    int wgid = L; { const int q = nwg / NXCD, r = nwg % NXCD, xcd = wgid % NXCD, off = wgid / NXCD; wgid = (xcd < r ? xcd * (q + 1) : r * (q + 1) + (xcd - r) * q) + off; }
    const int nig = WGM * nN, gid = wgid / nig, fm = gid * WGM, gsz = (nM - fm) < WGM ? (nM - fm) : WGM;
    u.pm = fm + ((wgid % nig) % gsz); u.pn = (wgid % nig) / gsz; u.aux = 0; u.aux2 = 0;
}

template <class Epi, class Sched>
__device__ __forceinline__ void gemm_phase(LAS unsigned char* lds, const Sched& S, const Epi& E) {
    const int tid = otid(), wid = __builtin_amdgcn_readfirstlane(tid >> 6), lane = tid & 63, wr = wid >> 2, wc = wid & 3, fr = lane & 15, fq = lane >> 4;
    const int nt = S.nt;
    int sR[2], sC[2];
    unsigned vB[2][2];
#pragma unroll
    for (int i = 0; i < 2; ++i) { stage_rc(tid * 16 + i * 8192, sR[i], sC[i]); const int Rb = Epi::PERM ? ((sR[i] & ~31) + perm32(sR[i] & 31)) : sR[i];
#pragma unroll
        for (int h = 0; h < 2; ++h) vB[h][i] = (unsigned)(h * HALF + Rb) * S.ldb + (unsigned)sC[i] * 2u; }
    const size_t kstepA = S.kstepA, kstepB = S.kstepB;
    const unsigned ldsw = (unsigned)wid * 1024u;
    const int aoff = lds_byte(wr * 64 + fr, fq * 8), boff = lds_byte(wc * 32 + fr, fq * 8);
#define PG8_SA(b, h) (((b) * 2 + (h)) * HTB)
#define PG8_SB(b, h) ((4 + (b) * 2 + (h)) * HTB)
#define PG8_STAGE(bufoff, gbase, v0, v1) do { \
        __builtin_amdgcn_global_load_lds((const unsigned*)((const char*)(gbase) + (v0)), (LAS unsigned*)(lds + (bufoff) + ldsw), 16, 0, 0); \
        __builtin_amdgcn_global_load_lds((const unsigned*)((const char*)(gbase) + (v1)), (LAS unsigned*)(lds + (bufoff) + ldsw + 8192), 16, 0, 0); } while (0)
#define PG8_LDA(dst, b, h) do { _Pragma("unroll") for (int m = 0; m < 4; ++m) _Pragma("unroll") for (int k = 0; k < 2; ++k) dst[m][k] = *(const LAS bf16x8*)(lds + PG8_SA(b, h) + aoff + m * 2048 + k * 1024); } while (0)
#define PG8_LDB(dst, b, h) do { _Pragma("unroll") for (int n = 0; n < 2; ++n) _Pragma("unroll") for (int k = 0; k < 2; ++k) dst[n][k] = *(const LAS bf16x8*)(lds + PG8_SB(b, h) + boff + n * 2048 + k * 1024); } while (0)
#define PG8_MMA(ai, bj, At, Bt) do { __builtin_amdgcn_s_setprio(1); _Pragma("unroll") for (int m = 0; m < 4; ++m) _Pragma("unroll") for (int n = 0; n < 2; ++n) _Pragma("unroll") for (int k = 0; k < 2; ++k) \
        acc[ai][bj][m][n] = __builtin_amdgcn_mfma_f32_16x16x32_bf16(Bt[n][k], At[m][k], acc[ai][bj][m][n], 0, 0, 0); __builtin_amdgcn_s_setprio(0); } while (0)
#define PG8_WAIT_V(n) asm volatile("s_waitcnt vmcnt(" #n ")" ::: "memory")
#define PG8_WAIT_L(n) asm volatile("s_waitcnt lgkmcnt(" #n ")" ::: "memory")
#define PG8_BAR __builtin_amdgcn_s_barrier()
#define PG8_SCHED __builtin_amdgcn_sched_barrier(0)
    Unit cur, nxt; int ui = 0;
    if (!S.next(0, cur)) return;
    f32x4 acc[2][2][4][2];
#pragma unroll
    for (int a = 0; a < 2; ++a)
#pragma unroll
        for (int b = 0; b < 2; ++b)
#pragma unroll
            for (int m = 0; m < 4; ++m)
#pragma unroll
                for (int n = 0; n < 2; ++n) acc[a][b][m][n] = (f32x4){0.f, 0.f, 0.f, 0.f};
    bf16x8 At[4][2], B0[2][2], B1[2][2];
    unsigned vA[2][2], vN[2][2];
#pragma unroll
    for (int h = 0; h < 2; ++h)
#pragma unroll
        for (int i = 0; i < 2; ++i) { vA[h][i] = S.aoff(cur, h * HALF + sR[i], sC[i]); vN[h][i] = vA[h][i]; }
    const char* cA = S.abase(cur); const char* cB = S.bbase(cur);
    PG8_STAGE(PG8_SB(0, 0), cB, vB[0][0], vB[0][1]); PG8_STAGE(PG8_SA(0, 0), cA, vA[0][0], vA[0][1]); PG8_STAGE(PG8_SB(0, 1), cB, vB[1][0], vB[1][1]); PG8_STAGE(PG8_SA(0, 1), cA, vA[1][0], vA[1][1]);
    if (wr == 1) PG8_BAR;
    PG8_WAIT_V(4); PG8_BAR;
    PG8_STAGE(PG8_SB(1, 0), cB + kstepB, vB[0][0], vB[0][1]); PG8_STAGE(PG8_SA(1, 0), cA + kstepA, vA[0][0], vA[0][1]); PG8_STAGE(PG8_SB(1, 1), cB + kstepB, vB[1][0], vB[1][1]);
    PG8_WAIT_V(6); PG8_BAR;
    for (;;) {
        const bool has_next = S.next(ui + 1, nxt);
        const char* nA = has_next ? S.abase(nxt) : cA; const char* nB = has_next ? S.bbase(nxt) : cB;
        if (Sched::DYN_A && has_next) {
#pragma unroll
            for (int h = 0; h < 2; ++h)
#pragma unroll
                for (int i = 0; i < 2; ++i) vN[h][i] = S.aoff(nxt, h * HALF + sR[i], sC[i]);
        }
        for (int t = 0; t < nt; t += 2) {
            const bool last = (t == nt - 2);
            const char* a1 = cA + (size_t)(t + 1) * kstepA;
            const char* a2 = last ? nA : cA + (size_t)(t + 2) * kstepA; const char* b2 = last ? nB : cB + (size_t)(t + 2) * kstepB;
            const char* a3 = a2 + kstepA; const char* b3 = b2 + kstepB;
            PG8_LDB(B0, 0, 0); PG8_SCHED; PG8_LDA(At, 0, 0); PG8_STAGE(PG8_SA(1, 1), a1, vA[1][0], vA[1][1]);
            if (Sched::DYN_A && last) {
#pragma unroll
                for (int h = 0; h < 2; ++h)
#pragma unroll
                    for (int i = 0; i < 2; ++i) vA[h][i] = vN[h][i]; }
            PG8_WAIT_L(8); PG8_BAR; PG8_WAIT_L(0); PG8_MMA(0, 0, At, B0); PG8_BAR; PG8_SCHED;
            PG8_LDB(B1, 0, 1); PG8_STAGE(PG8_SB(0, 0), b2, vB[0][0], vB[0][1]);
            PG8_BAR; PG8_WAIT_L(0); PG8_MMA(0, 1, At, B1); PG8_BAR;
            PG8_LDA(At, 0, 1); PG8_STAGE(PG8_SA(0, 0), a2, vA[0][0], vA[0][1]);
            PG8_BAR; PG8_WAIT_L(0); PG8_MMA(1, 0, At, B0); PG8_BAR; PG8_SCHED;
            PG8_STAGE(PG8_SB(0, 1), b2, vB[1][0], vB[1][1]);
            PG8_WAIT_V(6); PG8_BAR; PG8_MMA(1, 1, At, B1); PG8_BAR;
            PG8_LDB(B0, 1, 0); PG8_SCHED; PG8_LDA(At, 1, 0); PG8_STAGE(PG8_SA(0, 1), a2, vA[1][0], vA[1][1]);
            PG8_WAIT_L(8); PG8_BAR; PG8_WAIT_L(0); PG8_MMA(0, 0, At, B0); PG8_BAR; PG8_SCHED;
            PG8_LDB(B1, 1, 1); PG8_STAGE(PG8_SB(1, 0), b3, vB[0][0], vB[0][1]);
            PG8_BAR; PG8_WAIT_L(0); PG8_MMA(0, 1, At, B1); PG8_BAR;
            PG8_LDA(At, 1, 1); PG8_STAGE(PG8_SA(1, 0), a3, vA[0][0], vA[0][1]);
            PG8_BAR; PG8_WAIT_L(0); PG8_MMA(1, 0, At, B0); PG8_BAR; PG8_SCHED;
            PG8_STAGE(PG8_SB(1, 1), b3, vB[1][0], vB[1][1]);
            PG8_WAIT_V(6); PG8_BAR; PG8_MMA(1, 1, At, B1); PG8_BAR;
        }
        E(acc, cur, wr, wc, fr, fq);
        if (!has_next) break;
#pragma unroll
        for (int a = 0; a < 2; ++a)
#pragma unroll
            for (int b = 0; b < 2; ++b)
#pragma unroll
                for (int m = 0; m < 4; ++m)
#pragma unroll
                    for (int n = 0; n < 2; ++n) acc[a][b][m][n] = (f32x4){0.f, 0.f, 0.f, 0.f};
        cur = nxt; cA = nA; cB = nB; ++ui;
    }
    PG8_WAIT_V(0);
    if (wr == 0) PG8_BAR;
    PG8_BAR;
#undef PG8_SA
#undef PG8_SB
#undef PG8_STAGE
#undef PG8_LDA
#undef PG8_LDB
#undef PG8_MMA
#undef PG8_WAIT_V
#undef PG8_WAIT_L
#undef PG8_BAR
#undef PG8_SCHED
}
}
using pg8::Unit;

struct SchedPlain {
    static constexpr bool DYN_A = false;
    const char* A; const char* Bt; int K, nM, nN, G, c; int nt; unsigned kstepA, kstepB, ldb;
    __device__ __forceinline__ void init(const void* A_, const void* Bt_, int M, int N, int K_) { A = (const char*)A_; Bt = (const char*)Bt_; K = K_; nM = M / 256; nN = N / 256; G = gridDim.x; c = blockIdx.x; nt = K / 64; kstepA = 128; kstepB = 128; ldb = (unsigned)K * 2u; }
    __device__ __forceinline__ bool next(int i, Unit& u) const { const int L = i * G + c; if (L >= nM * nN) return false; pg8::static_unit(L, nM, nN, u); return true; }
    __device__ __forceinline__ const char* abase(const Unit& u) const { return A + (size_t)u.pm * 256 * K * 2; }
    __device__ __forceinline__ const char* bbase(const Unit& u) const { return Bt + (size_t)u.pn * 256 * K * 2; }
    __device__ __forceinline__ unsigned aoff(const Unit&, int row, int col) const { return (unsigned)(row * K + col) * 2u; }
};
constexpr int ML_CNT = 131072, ML_PPRE = ML_CNT + 128, ML_PE = ML_PPRE + 256;
__device__ __forceinline__ int moe_tables(const char* ws, int layer, LAS unsigned char* lds) {
    const int tid = otid(); LAS int* cnt = (LAS int*)(lds + ML_CNT); LAS int* ppre = (LAS int*)(lds + ML_PPRE); LAS int* pe = (LAS int*)(lds + ML_PE);
    __syncthreads();
    if (tid < 32) cnt[tid] = ((const int*)(ws + WS_GCNT))[layer * 32 + tid];
    __syncthreads();
    if (tid == 0) { int s = 0; for (int e = 0; e < NEXP; ++e) { ppre[e] = s; s += (cnt[e] + 255) >> 8; } ppre[NEXP] = s; }
    __syncthreads();
    const int nM = ppre[NEXP];
    if (tid < nM) { int e = 0; for (int k = 1; k < NEXP; ++k) e += (ppre[k] <= tid) ? 1 : 0; pe[tid] = e; }
    __syncthreads();
    return nM;
}
struct SchedMoeGU {
    static constexpr bool DYN_A = true;
    const char* X; const char* W; const int* tokof; LAS unsigned char* lds; int nM, G, c; int nt; unsigned kstepA, kstepB, ldb;
    __device__ __forceinline__ void init(const char* ws, int layer, LAS unsigned char* lds_) { lds = lds_; nM = moe_tables(ws, layer, lds_); X = ws + WS_X1B; W = ws + WS_GU; tokof = (const int*)(ws + WS_ROWTOK); G = gridDim.x; c = blockIdx.x; nt = 16; kstepA = 128; kstepB = 128; ldb = 2048; }
    __device__ __forceinline__ bool next(int i, Unit& u) const { const int L = i * G + c; if (L >= nM * 4) return false; pg8::static_unit(L, nM, 4, u);
        const int e = ((const LAS int*)(lds + ML_PE))[u.pm]; u.aux = e | ((u.pm - ((const LAS int*)(lds + ML_PPRE))[e]) << 16); u.aux2 = ((const LAS int*)(lds + ML_CNT))[e]; return true; }
    __device__ __forceinline__ const char* abase(const Unit&) const { return X; }
    __device__ __forceinline__ const char* bbase(const Unit& u) const { return W + ((size_t)(u.aux & 255) * 1024 + (size_t)u.pn * 256) * 2048; }
    __device__ __forceinline__ unsigned aoff(const Unit& u, int row, int col) const { const int slot = (u.aux >> 16) * 256 + row; const int sl = slot < u.aux2 ? slot : 0;
        return (unsigned)tokof[(u.aux & 255) * 65536 + sl] * 2048u + (unsigned)col * 2u; }
};
struct SchedMoeDN {
    static constexpr bool DYN_A = false;
    const char* H; const char* W; LAS unsigned char* lds; int nM, G, c; int nt; unsigned kstepA, kstepB, ldb;
    __device__ __forceinline__ void init(const char* ws, int layer, LAS unsigned char* lds_) { lds = lds_; nM = moe_tables(ws, layer, lds_); H = ws + WS_AOH; W = ws + WS_DN; G = gridDim.x; c = blockIdx.x; nt = 8; kstepA = 128; kstepB = 128; ldb = 1024; }
    __device__ __forceinline__ bool next(int i, Unit& u) const { const int L = i * G + c; if (L >= nM * 4) return false; pg8::static_unit(L, nM, 4, u); u.aux = ((const LAS int*)(lds + ML_PE))[u.pm]; u.aux2 = 0; return true; }
    __device__ __forceinline__ const char* abase(const Unit& u) const { return H + (size_t)u.pm * 256 * 1024; }
    __device__ __forceinline__ const char* bbase(const Unit& u) const { return W + ((size_t)u.aux * 1024 + (size_t)u.pn * 256) * 1024; }
    __device__ __forceinline__ unsigned aoff(const Unit&, int row, int col) const { return (unsigned)(row * 512 + col) * 2u; }
};
struct SchedCmp {
    static constexpr bool DYN_A = false  ;
    const char* Q; const char* W; int G, c; int nt; unsigned kstepA, kstepB, ldb;
    __device__ __forceinline__ void init(const char* ws) { Q = ws + WS_BIG; W = ws + WS_W1T; G = gridDim.x; c = blockIdx.x; nt = 8; kstepA = NSA_LD * 2; kstepB = 128; ldb = 4096; }
    __device__ __forceinline__ bool next(int i, Unit& u) const { const int L = i * G + c; if (L >= 256) return false; u.aux = L >> 7; u.aux2 = 0; u.pm = (L >> 2) & 31; u.pn = L & 3; return true; }
    __device__ __forceinline__ const char* abase(const Unit& u) const { return Q + (size_t)(u.aux ? NSA_VC : NSA_KC) * 2 + (size_t)u.pn * 8 * (NSA_LD * 2); }
    __device__ __forceinline__ const char* bbase(const Unit& u) const { return W + (size_t)u.aux * 256 * 4096 + (size_t)u.pn * 8 * 128; }
    __device__ __forceinline__ unsigned aoff(const Unit& u, int row, int col) const {
        const int m = u.pm * 256 + row, bh = m >> 7, n = m & 127, nn = n > 126 ? 126 : n, b = bh >> 2, hkv = bh & 3;
        return (unsigned)(((b * SEQ + 16 * nn) * NSA_LD) + hkv * 64 + col) * 2u; }
};

struct EpiQKV0 {
    static constexpr bool PERM = true;
    bf16_t* O; float* kpart;
    __device__ __forceinline__ void operator()(const f32x4 (&acc)[2][2][4][2], const Unit& u, int wr, int wc, int fr, int fq) const {
        const int row0 = u.pm * 256 + wr * 64 + fr, col0 = u.pn * 256 + wc * 32 + 8 * fq;
        const float sc = (u.pn < 4) ? C2 : 1.0f;
#pragma unroll
        for (int ai = 0; ai < 2; ++ai)
#pragma unroll
            for (int m = 0; m < 4; ++m) { bf16_t* rowp = O + (size_t)(row0 + ai * 128 + m * 16) * QKV_LD + col0;
#pragma unroll
                for (int bj = 0; bj < 2; ++bj) { const f32x4 v0 = acc[ai][bj][m][0] * sc, v1 = acc[ai][bj][m][1] * sc;
                    u32x4 w; w.x = cvt_pk_bf16(v0[0], v0[1]); w.y = cvt_pk_bf16(v0[2], v0[3]); w.z = cvt_pk_bf16(v1[0], v1[1]); w.w = cvt_pk_bf16(v1[2], v1[3]);
                    *(u32x4*)(rowp + bj * 128) = w; } }
        if (u.pn >= 4 && u.pn < 8) {
#pragma unroll
            for (int bj = 0; bj < 2; ++bj)
#pragma unroll
                for (int n = 0; n < 2; ++n) { f32x4 s = (f32x4){0.f, 0.f, 0.f, 0.f};
#pragma unroll
                    for (int ai = 0; ai < 2; ++ai)
#pragma unroll
                        for (int m = 0; m < 4; ++m) s += acc[ai][bj][m][n];
#pragma unroll
                    for (int j = 0; j < 4; ++j) { float v = s[j]; v += __shfl_xor(v, 1); v += __shfl_xor(v, 2); v += __shfl_xor(v, 4); v += __shfl_xor(v, 8); s[j] = v; }
                    if (fr == 0) *(f32x4*)(kpart + ((size_t)u.pm * 2 + wr) * 1024 + (u.pn - 4) * 256 + bj * 128 + wc * 32 + 8 * fq + 4 * n) = s; }
        }
    }
};
struct EpiNull {
    static constexpr bool PERM = true;
    float* sink;
    __device__ __forceinline__ void operator()(const f32x4 (&acc)[2][2][4][2], const Unit& u, int wr, int wc, int fr, int fq) const {
        float s = 0.f;
#pragma unroll
        for (int ai = 0; ai < 2; ++ai)
#pragma unroll
            for (int bj = 0; bj < 2; ++bj)
#pragma unroll
                for (int m = 0; m < 4; ++m)
#pragma unroll
                    for (int n = 0; n < 2; ++n) s += acc[ai][bj][m][n][0] + acc[ai][bj][m][n][3];
        if (s == 12345.678f) sink[u.pm + wr + wc + fr + fq] = s;
    }
};
struct EpiNSA {
    static constexpr bool PERM = true;
    bf16_t* O;
    __device__ __forceinline__ void operator()(const f32x4 (&acc)[2][2][4][2], const Unit& u, int wr, int wc, int fr, int fq) const {
        const int row0 = u.pm * 256 + wr * 64 + fr, col0 = u.pn * 256 + wc * 32 + 8 * fq;
        const float sc = (u.pn < 4) ? C2 : 1.0f; const bool sg = (u.pn == 10);
#pragma unroll
        for (int ai = 0; ai < 2; ++ai)
#pragma unroll
            for (int m = 0; m < 4; ++m) { bf16_t* rowp = O + (size_t)(row0 + ai * 128 + m * 16) * NSA_LD + col0;
#pragma unroll
                for (int bj = 0; bj < 2; ++bj) { f32x4 v0 = acc[ai][bj][m][0] * sc, v1 = acc[ai][bj][m][1] * sc;
                    if (sg) {
#pragma unroll
                        for (int j = 0; j < 4; ++j) { v0[j] = __builtin_amdgcn_rcpf(1.0f + __builtin_amdgcn_exp2f(-LOG2E * v0[j])); v1[j] = __builtin_amdgcn_rcpf(1.0f + __builtin_amdgcn_exp2f(-LOG2E * v1[j])); } }
                    u32x4 w; w.x = cvt_pk_bf16(v0[0], v0[1]); w.y = cvt_pk_bf16(v0[2], v0[3]); w.z = cvt_pk_bf16(v1[0], v1[1]); w.w = cvt_pk_bf16(v1[2], v1[3]);
                    *(u32x4*)(rowp + bj * 128) = w; } }
    }
};
template <bool RES_F32> struct EpiRes {
    static constexpr bool PERM = true;
    bf16_t* O; const float* rf; const bf16_t* rb;
    __device__ __forceinline__ void operator()(const f32x4 (&acc)[2][2][4][2], const Unit& u, int wr, int wc, int fr, int fq) const {
        const int row0 = u.pm * 256 + wr * 64 + fr, col0 = u.pn * 256 + wc * 32 + 8 * fq;
#pragma unroll
        for (int ai = 0; ai < 2; ++ai) {
            if (RES_F32) {
#pragma unroll
                for (int mh = 0; mh < 2; ++mh) { f32x4 r[2][2][2];
#pragma unroll
                    for (int m2 = 0; m2 < 2; ++m2)
#pragma unroll
                        for (int bj = 0; bj < 2; ++bj) { const size_t ro = (size_t)(row0 + ai * 128 + (mh * 2 + m2) * 16) * 1024 + col0 + bj * 128; r[m2][bj][0] = *(const f32x4*)(rf + ro); r[m2][bj][1] = *(const f32x4*)(rf + ro + 4); }
#pragma unroll
                    for (int m2 = 0; m2 < 2; ++m2)
#pragma unroll
                        for (int bj = 0; bj < 2; ++bj) { const int m = mh * 2 + m2; const size_t ro = (size_t)(row0 + ai * 128 + m * 16) * 1024 + col0 + bj * 128;
                            const f32x4 v0 = acc[ai][bj][m][0] + r[m2][bj][0] * ALPHA, v1 = acc[ai][bj][m][1] + r[m2][bj][1] * ALPHA;
                            u32x4 w; w.x = cvt_pk_bf16(v0[0], v0[1]); w.y = cvt_pk_bf16(v0[2], v0[3]); w.z = cvt_pk_bf16(v1[0], v1[1]); w.w = cvt_pk_bf16(v1[2], v1[3]);
                            *(u32x4*)(O + ro) = w; } }
            } else {
                u32x4 r[4][2];
#pragma unroll
                for (int m = 0; m < 4; ++m)
#pragma unroll
                    for (int bj = 0; bj < 2; ++bj) r[m][bj] = *(const u32x4*)(rb + (size_t)(row0 + ai * 128 + m * 16) * 1024 + col0 + bj * 128);
#pragma unroll
                for (int m = 0; m < 4; ++m)
#pragma unroll
                    for (int bj = 0; bj < 2; ++bj) { const size_t ro = (size_t)(row0 + ai * 128 + m * 16) * 1024 + col0 + bj * 128; const u32x4 rw = r[m][bj];
                        const f32x4 r0 = (f32x4){lo_bf(rw.x), hi_bf(rw.x), lo_bf(rw.y), hi_bf(rw.y)}, r1 = (f32x4){lo_bf(rw.z), hi_bf(rw.z), lo_bf(rw.w), hi_bf(rw.w)};
                        const f32x4 v0 = acc[ai][bj][m][0] + r0 * ALPHA, v1 = acc[ai][bj][m][1] + r1 * ALPHA;
                        u32x4 w; w.x = cvt_pk_bf16(v0[0], v0[1]); w.y = cvt_pk_bf16(v0[2], v0[3]); w.z = cvt_pk_bf16(v1[0], v1[1]); w.w = cvt_pk_bf16(v1[2], v1[3]);
                        *(u32x4*)(O + ro) = w; }
            }
        }
    }
};
struct EpiGU {
    static constexpr bool PERM = true;
    bf16_t* O;
    __device__ __forceinline__ void operator()(const f32x4 (&acc)[2][2][4][2], const Unit& u, int wr, int wc, int fr, int fq) const {
        const int row0 = u.pm * 256 + wr * 64 + fr, col0 = u.pn * 128 + wc * 32 + 8 * fq;
#pragma unroll
        for (int ai = 0; ai < 2; ++ai)
#pragma unroll
            for (int m = 0; m < 4; ++m) { float h[8];
#pragma unroll
                for (int n = 0; n < 2; ++n)
#pragma unroll
                    for (int j = 0; j < 4; ++j) { const float g = acc[ai][0][m][n][j], up = acc[ai][1][m][n][j]; h[n * 4 + j] = g * up * __builtin_amdgcn_rcpf(1.0f + __builtin_amdgcn_exp2f(-LOG2E * g)); }
                u32x4 w; w.x = cvt_pk_bf16(h[0], h[1]); w.y = cvt_pk_bf16(h[2], h[3]); w.z = cvt_pk_bf16(h[4], h[5]); w.w = cvt_pk_bf16(h[6], h[7]);
                *(u32x4*)(O + (size_t)(row0 + ai * 128 + m * 16) * 512 + col0) = w; }
    }
};
struct EpiDN {
    static constexpr bool PERM = true;
    bf16_t* O;
    __device__ __forceinline__ void operator()(const f32x4 (&acc)[2][2][4][2], const Unit& u, int wr, int wc, int fr, int fq) const {
        const int row0 = u.pm * 256 + wr * 64 + fr, col0 = u.pn * 256 + wc * 32 + 8 * fq;
#pragma unroll
        for (int ai = 0; ai < 2; ++ai)
#pragma unroll
            for (int m = 0; m < 4; ++m) { bf16_t* rowp = O + (size_t)(row0 + ai * 128 + m * 16) * 1024 + col0;
#pragma unroll
                for (int bj = 0; bj < 2; ++bj) { const f32x4 v0 = acc[ai][bj][m][0], v1 = acc[ai][bj][m][1];
                    u32x4 w; w.x = cvt_pk_bf16(v0[0], v0[1]); w.y = cvt_pk_bf16(v0[2], v0[3]); w.z = cvt_pk_bf16(v1[0], v1[1]); w.w = cvt_pk_bf16(v1[2], v1[3]);
                    *(u32x4*)(rowp + bj * 128) = w; } }
    }
};
struct EpiCmp {
    static constexpr bool PERM = false;
    float* CP;
    __device__ __forceinline__ void operator()(const f32x4 (&acc)[2][2][4][2], const Unit& u, int wr, int wc, int fr, int fq) const {
        float* base = CP + ((size_t)(u.aux * 4 + u.pn) * 8192 + (size_t)u.pm * 256) * 256;
        const int row0 = wr * 64 + fr, col0 = wc * 32 + 4 * fq;
#pragma unroll
        for (int ai = 0; ai < 2; ++ai)
#pragma unroll
            for (int m = 0; m < 4; ++m) { float* rowp = base + (size_t)(row0 + ai * 128 + m * 16) * 256 + col0;
#pragma unroll
                for (int bj = 0; bj < 2; ++bj)
#pragma unroll
                    for (int n = 0; n < 2; ++n) *(f32x4*)(rowp + bj * 128 + n * 16) = acc[ai][bj][m][n]; }
    }
};

constexpr int AL_K = 0  , AL_V = 24576  , AL_BIAS = 57344  , AL_KM = AL_BIAS + 4 * BT_H * 4, AL_IMP = AL_KM + 2048  , AL_SEL = AL_IMP + 65536, AL_LIST = AL_SEL + 512, AL_END = AL_LIST + 256;
static_assert(AL_END <= LDS_BYTES - 16 && 4 * 64 * 33 * 4 <= 65536, "attention LDS map");
#define MFMA32(a, b, c) __builtin_amdgcn_mfma_f32_32x32x16_bf16(a, b, c, 0, 0, 0)
__device__ __forceinline__ s16x4 vtr(lds_cptr p) { return __builtin_bit_cast(s16x4, __builtin_amdgcn_ds_read_tr16_b64_v4i16((LAS v4i16_t*)p)); }
__device__ __forceinline__ float xhalf_max(float m) { auto rr = __builtin_amdgcn_permlane32_swap(__float_as_uint(m), __float_as_uint(m), false, false); return __builtin_fmaxf(__uint_as_float(rr[0]), __uint_as_float(rr[1])); }
__device__ __forceinline__ float xhalf_sum(float m) { auto rr = __builtin_amdgcn_permlane32_swap(__float_as_uint(m), __float_as_uint(m), false, false); return __uint_as_float(rr[0]) + __uint_as_float(rr[1]); }
__device__ __forceinline__ float max16(const f32x16& p) { float a = __builtin_fmaxf(p[0], p[1]), b = __builtin_fmaxf(p[2], p[3]);
#pragma unroll
    for (int r = 4; r < 16; r += 4) { a = __builtin_fmaxf(a, __builtin_fmaxf(p[r], p[r + 1])); b = __builtin_fmaxf(b, __builtin_fmaxf(p[r + 2], p[r + 3])); }
    return __builtin_fmaxf(a, b); }

#define MX3(a, b, c) __builtin_fmaxf(__builtin_fmaxf((a), (b)), (c))
__device__ __forceinline__ float max32(const f32x16& p0, const f32x16& p1) {
    float a = MX3(p0[0], p0[1], p1[0]), b = MX3(p0[2], p0[3], p1[1]); a = MX3(a, p1[2], p1[3]);
#pragma unroll
    for (int r = 4; r < 16; r += 4) { a = MX3(a, p0[r], p0[r + 1]); b = MX3(b, p0[r + 2], p0[r + 3]); a = MX3(a, p1[r], p1[r + 1]); b = MX3(b, p1[r + 2], p1[r + 3]); }
    return __builtin_fmaxf(a, b); }
constexpr float FLASH_THR = 8.0f;
__device__ __forceinline__ void glds16(const void* g, unsigned lds_addr) {
    unsigned sv; asm volatile("s_mov_b32 %0, m0\n\ts_mov_b32 m0, %2\n\ts_nop 0\n\tglobal_load_lds_dwordx4 %1, off\n\ts_mov_b32 m0, %0" : "=&s"(sv) : "v"(g), "s"(lds_addr) : "memory"); }
__device__ __forceinline__ void dma_k(const bf16_t* src, int ld, LAS unsigned char* lds, int slot, int wid, int lane) {
    const int rl = lane >> 3, ch = lane & 7;
    glds16(src + (size_t)(wid * 8 + rl) * ld + ((ch ^ rl) * 8), (unsigned)__builtin_amdgcn_readfirstlane((int)((unsigned)(unsigned long)lds + AL_K + slot * 8192 + wid * 1024))); }
__device__ __forceinline__ void dma_v(const bf16_t* src, int ld, LAS unsigned char* lds, int slot, int wid, int lane) {
    glds16(src + (size_t)(16 * (wid & 3) + (lane >> 2)) * ld + (wid >> 2) * 32 + (lane & 3) * 8, (unsigned)__builtin_amdgcn_readfirstlane((int)((unsigned)(unsigned long)lds + AL_V + slot * 8192 + wid * 1024))); }

struct FState { float m, l; f32x16 o0, o1; };
__device__ __forceinline__ void fstate_reset(FState& s) { s.m = -1e30f; s.l = 0.f;
#pragma unroll
    for (int r = 0; r < 16; ++r) { s.o0[r] = 0.f; s.o1[r] = 0.f; } }

__device__ __forceinline__ int kchunk_off(int d0, int kx) { return (((2 * d0 + (kx >> 3)) ^ (kx & 7)) * 16); }
__device__ __forceinline__ void qk_tile(f32x16& c0, f32x16& c1, const bf16x8 (&qr)[4], lds_cptr kp, int kx) {
#pragma unroll
    for (int d0 = 0; d0 < 4; ++d0) { const bf16x8 k0 = *(const LAS bf16x8*)(kp + kchunk_off(d0, kx)), k1 = *(const LAS bf16x8*)(kp + kchunk_off(d0, kx) + 4096);
        c0 = MFMA32(k0, qr[d0], c0); c1 = MFMA32(k1, qr[d0], c1); }
}
__device__ __forceinline__ void pv_tile(f32x16& o0, f32x16& o1, const f32x16& p0, const f32x16& p1, lds_cptr vp) {
#pragma unroll
    for (int k = 0; k < 4; ++k) {
        const f32x16& ps = (k < 2) ? p0 : p1; const int b = 8 * (k & 1);
        const u32x4 pw = (u32x4){cvt_pk_bf16(ps[b], ps[b + 1]), cvt_pk_bf16(ps[b + 2], ps[b + 3]), cvt_pk_bf16(ps[b + 4], ps[b + 5]), cvt_pk_bf16(ps[b + 6], ps[b + 7])};
        const bf16x8 pf = __builtin_bit_cast(bf16x8, pw);
        { const s16x4 lo = vtr(vp + k * 1024), hi = vtr(vp + k * 1024 + 512);
          const bf16x8 vf = (bf16x8){lo[0], lo[1], lo[2], lo[3], hi[0], hi[1], hi[2], hi[3]}; o0 = MFMA32(vf, pf, o0); }
        { const s16x4 lo = vtr(vp + 4096 + k * 1024), hi = vtr(vp + 4096 + k * 1024 + 512);
          const bf16x8 vf = (bf16x8){lo[0], lo[1], lo[2], lo[3], hi[0], hi[1], hi[2], hi[3]}; o1 = MFMA32(vf, pf, o1); }
    }
}
struct TileP { int Dmin; bool rowok, run, win; };
__device__ __forceinline__ void load_kf(bf16x8 (&kf)[8], lds_cptr kp, int kx) {
#pragma unroll
    for (int d0 = 0; d0 < 4; ++d0) { kf[2 * d0] = *(const LAS bf16x8*)(kp + kchunk_off(d0, kx)); kf[2 * d0 + 1] = *(const LAS bf16x8*)(kp + kchunk_off(d0, kx) + 4096); } }
__device__ __forceinline__ void flash_qk(f32x16& c0, f32x16& c1, float& cf, const bf16x8 (&qr)[4], lds_cptr kp, int kx, const LAS float* btab, float cfar, int Dmin, int r32, int hi) {
    bf16x8 kf[8]; load_kf(kf, kp, kx);
    if (Dmin - 63 < 127) {
        const int s0 = (BT_N - 1 - 63) - (Dmin + r32 - 4 * hi), ksh = s0 & 3; cf = 0.f;
        const LAS f32x4* bp = (const LAS f32x4*)(btab + ksh * BT_S + (s0 - ksh));
#pragma unroll
        for (int g = 0; g < 4; ++g) { const f32x4 a = bp[2 * g], b = bp[8 + 2 * g];
#pragma unroll
            for (int i = 0; i < 4; ++i) { c0[4 * g + i] = a[i]; c1[4 * g + i] = b[i]; } }
#pragma unroll
        for (int d0 = 0; d0 < 4; ++d0) { c0 = MFMA32(kf[2 * d0], qr[d0], c0); c1 = MFMA32(kf[2 * d0 + 1], qr[d0], c1); }
    } else {
        cf = cfar;
        const f32x16 z = {0.f, 0.f, 0.f, 0.f, 0.f, 0.f, 0.f, 0.f, 0.f, 0.f, 0.f, 0.f, 0.f, 0.f, 0.f, 0.f};
        c0 = MFMA32(kf[0], qr[0], z); c1 = MFMA32(kf[1], qr[0], z);
#pragma unroll
        for (int d0 = 1; d0 < 4; ++d0) { c0 = MFMA32(kf[2 * d0], qr[d0], c0); c1 = MFMA32(kf[2 * d0 + 1], qr[d0], c1); }
    }
}
__device__ __forceinline__ void flash_sm(FState& st, f32x16& c0, f32x16& c1, float cf, const TileP& tp, int r32, int hi) {
    const int Dmin = tp.Dmin, Dl = Dmin + r32 - 4 * hi;
    if (tp.win && (Dmin + 31 >= 512)) {
#pragma unroll
        for (int r = 0; r < 16; ++r) { const int ko = (r & 3) + 8 * (r >> 2); if (Dl >= 512 + ko) c0[r] = -INFINITY; if (Dl >= 544 + ko) c1[r] = -INFINITY; }
    }
    float mx = xhalf_max(max32(c0, c1)) + cf;
    mx = tp.rowok ? mx : -INFINITY;
    if (__any(mx > st.m + FLASH_THR)) {
        const float mn = __builtin_fmaxf(st.m, mx); const float alpha = __builtin_amdgcn_exp2f(st.m - mn);
        st.m = mn; st.l *= alpha;
#pragma unroll
        for (int r = 0; r < 16; ++r) { st.o0[r] *= alpha; st.o1[r] *= alpha; }
    }
    const float msub = tp.rowok ? (st.m - cf) : INFINITY;
    float rs0 = 0.f, rs1 = 0.f;
#pragma unroll
    for (int r = 0; r < 16; ++r) { c0[r] = __builtin_amdgcn_exp2f(c0[r] - msub); c1[r] = __builtin_amdgcn_exp2f(c1[r] - msub); rs0 += c0[r]; rs1 += c1[r]; }
    st.l += rs0 + rs1;
}
template <int VAR, class Src>
__device__ __forceinline__ void attn_stream(Src& S, int NT, FState& st, const bf16x8 (&qr)[4], LAS unsigned char* lds, const LAS float* btab, float cfar, int wid, int lane, int r32, int hi) {
    const lds_cptr kp0 = (lds_cptr)lds + AL_K + r32 * 128; const int kx = (r32 & 7) | (hi << 3);
    const lds_cptr vp0 = (lds_cptr)lds + AL_V + ((lane >> 4) & 1) * 32 + (lane & 3) * 8 + (4 * hi + ((lane & 15) >> 2)) * 64;
    S.dma(0, 0, 0); if (NT > 1 && VAR != 5 && VAR != 6) S.dma(1, 1, 1);
    if (VAR == 5) { asm volatile("s_waitcnt vmcnt(0)" ::: "memory"); __syncthreads(); }
    int sc = 0, sn = 2;
    for (int t = 0; t < NT; ++t) {
        if (VAR != 5) { if (t + 1 < NT) asm volatile("s_waitcnt vmcnt(2)" ::: "memory"); else asm volatile("s_waitcnt vmcnt(0)" ::: "memory");
        __syncthreads(); }
        if (VAR != 5 && VAR != 6) { if (t + 2 < NT) S.dma(t + 2, sn, sn); }
        const TileP tp = S.params(t);
        if (tp.run) { f32x16 c0, c1; float cf;
            flash_qk(c0, c1, cf, qr, kp0 + sc * 8192, kx, btab, cfar, tp.Dmin, r32, hi);
            flash_sm(st, c0, c1, cf, tp, r32, hi);
            pv_tile(st.o0, st.o1, c0, c1, vp0 + sc * 8192); }
        S.after(t, st);
        sc = (sc == 2) ? 0 : sc + 1; sn = (sn == 2) ? 0 : sn + 1;
    }
}

__device__ __forceinline__ void conv_tile(const float* src, int N, bf16_t* dst, int ldd, int k0, int n0, int rowadd, int mode, LAS float* t, int lane) {
    float4 v[16];
#pragma unroll
    for (int i = 0; i < 16; ++i) { const int r = i * 4 + (lane >> 4), cc = n0 + (lane & 15) * 4;
        v[i] = (cc < N) ? *(const float4*)(src + (size_t)(k0 + r) * N + cc) : make_float4(0.f, 0.f, 0.f, 0.f); }
#pragma unroll
    for (int i = 0; i < 16; ++i) { const int r = i * 4 + (lane >> 4), cc = (lane & 15) * 4; LAS float* q = t + r * 65 + cc; q[0] = v[i].x; q[1] = v[i].y; q[2] = v[i].z; q[3] = v[i].w; }
    asm volatile("s_waitcnt lgkmcnt(0)" ::: "memory");
#pragma unroll
    for (int i = 0; i < 8; ++i) { const int nr = i * 8 + (lane >> 3), kc = (lane & 7) * 8; float f[8];
#pragma unroll
        for (int j = 0; j < 8; ++j) f[j] = t[(kc + j) * 65 + nr];
        const int n = n0 + nr; const int drow = (mode == 0) ? n : (256 * (n >> 7) + (n & 127) + rowadd);
        u32x4 w; w.x = cvt_pk_bf16(f[0], f[1]); w.y = cvt_pk_bf16(f[2], f[3]); w.z = cvt_pk_bf16(f[4], f[5]); w.w = cvt_pk_bf16(f[6], f[7]);
        *(u32x4*)(dst + (size_t)drow * ldd + k0 + kc) = w; }
    asm volatile("s_waitcnt lgkmcnt(0)" ::: "memory");
}
__device__ __forceinline__ int conv_job(const float* src, int K, int N, int Npad, bf16_t* dst, int ldd, int rowadd, int mode, int tile0, LAS float* t, int gw, int ngw, int lane) {
    const int nkt = K / 64, nnt = Npad / 64, ntile = nkt * nnt;
    int first = (gw - tile0 % ngw + ngw) % ngw;
    for (int i = first; i < ntile; i += ngw) conv_tile(src, N, dst, ldd, (i / nnt) * 64, (i % nnt) * 64, rowadd, mode, t, lane);
    return tile0 + ntile;
}
__device__ __forceinline__ void conv_moe_layer(const Params& p, int layer, LAS unsigned char* lds) {
    const int tid = otid(), lane = tid & 63, wid = tid >> 6, gw = blockIdx.x * 8 + wid, ngw = gridDim.x * 8;
    LAS float* t = (LAS float*)(lds + wid * (64 * 65 * 4));
    bf16_t* GU = (bf16_t*)(p.ws + WS_GU); bf16_t* DN = (bf16_t*)(p.ws + WS_DN);
    int tile0 = 0;
    for (int e = 0; e < NEXP; ++e) {
        const size_t wo = ((size_t)layer * NEXP + e) * 1024 * 512;
        tile0 = conv_job(p.w_gate + wo, 1024, 512, 512, GU + (size_t)e * 1024 * 1024, 1024, 0, 1, tile0, t, gw, ngw, lane);
        tile0 = conv_job(p.w_up + wo, 1024, 512, 512, GU + (size_t)e * 1024 * 1024, 1024, 128, 1, tile0, t, gw, ngw, lane);
        tile0 = conv_job(p.w_down + wo, 512, 1024, 1024, DN + (size_t)e * 1024 * 512, 512, 0, 0, tile0, t, gw, ngw, lane);
    }
}
__device__ __forceinline__ void phase_prologue(const Params& p, LAS unsigned char* lds) {
    const int tid = otid(), lane = tid & 63, wid = tid >> 6, gw = blockIdx.x * 8 + wid, ngw = gridDim.x * 8;
    LAS float* t = (LAS float*)(lds + wid * (64 * 65 * 4));
    char* ws = p.ws;
    { const size_t n8 = (size_t)NTOK * 1024 / 8; bf16_t* xb = (bf16_t*)(ws + WS_XB);
      for (size_t i = (size_t)blockIdx.x * NTHREADS + tid; i < n8; i += (size_t)gridDim.x * NTHREADS) {
          const float4 a = *(const float4*)(p.x + i * 8), b = *(const float4*)(p.x + i * 8 + 4);
          u32x4 w; w.x = cvt_pk_bf16(a.x, a.y); w.y = cvt_pk_bf16(a.z, a.w); w.z = cvt_pk_bf16(b.x, b.y); w.w = cvt_pk_bf16(b.z, b.w);
          *(u32x4*)(xb + i * 8) = w; } }
    int tile0 = 0;
    tile0 = conv_job(p.moba_w_in, 1024, 3072, 3072, (bf16_t*)(ws + WS_WQKV0), 1024, 0, 0, tile0, t, gw, ngw, lane);
    tile0 = conv_job(p.moba_w_out, 1024, 1024, 1024, (bf16_t*)(ws + WS_WO0), 1024, 0, 0, tile0, t, gw, ngw, lane);
    tile0 = conv_job(p.nsa_w_in, 1024, 2608, 2816, (bf16_t*)(ws + WS_WIN1), 1024, 0, 0, tile0, t, gw, ngw, lane);
    tile0 = conv_job(p.nsa_w_out, 1024, 1024, 1024, (bf16_t*)(ws + WS_WO1), 1024, 0, 0, tile0, t, gw, ngw, lane);
    tile0 = conv_job(p.ck_w1, 2048, 256, 256, (bf16_t*)(ws + WS_W1T), 2048, 0, 0, tile0, t, gw, ngw, lane);
    tile0 = conv_job(p.cv_w1, 2048, 256, 256, (bf16_t*)(ws + WS_W1T) + 256 * 2048, 2048, 0, 0, tile0, t, gw, ngw, lane);
    conv_moe_layer(p, 0, lds);
    for (int i = blockIdx.x * NTHREADS + tid; i < 16 * BT_H; i += gridDim.x * NTHREADS) {
        const int h = i / BT_H, k = (i % BT_H) / BT_S, j = i % BT_S; int e = (BT_N - 1) - (j + k); e = e < 0 ? 0 : e;
        int n = e - 63; const bool future = n < 0; n = n < 0 ? 0 : (n > 127 ? 127 : n);
        int bk = n;
        if (n >= 16) { bk = 16 + (int)(logf((float)n / 16.0f) / logf(8.0f) * 16.0f); bk = bk > 31 ? 31 : bk; }
        ((float*)(ws + WS_TAB))[i] = future ? -INFINITY : p.rel_bias[bk * 16 + h] * LOG2E; }
    if (blockIdx.x < 32) { const int kv = blockIdx.x >> 4, part = (blockIdx.x & 15) * 2 + (tid >> 8), j = tid & 255;
        const float* pos = kv ? p.pos_v : p.pos_k; const float* w1 = kv ? p.cv_w1 : p.ck_w1; float s = 0.f;
#pragma unroll 16
        for (int k = part * 64; k < part * 64 + 64; ++k) s += pos[k] * w1[(size_t)k * 256 + j];
        ((float*)(ws + WS_B1))[(kv * 32 + part) * 256 + j] = s; }
}

template <int VAR> __device__ __forceinline__ void moba_unit(const Params& p, LAS unsigned char* lds, int b, int h, int qb) {
    const int tid = otid(), lane = tid & 63, r32 = lane & 31, hi = lane >> 5; const int wid = __builtin_amdgcn_readfirstlane(tid >> 6);
    const bf16_t* QKV = (const bf16_t*)(p.ws + WS_BIG);
    const size_t rowbase = (size_t)b * SEQ; const int q0 = qb * 256, qw = q0 + wid * 32;
    const bf16_t* Kb = QKV + rowbase * QKV_LD + 1024 + h * 64; const bf16_t* Vb = QKV + rowbase * QKV_LD + 2048 + h * 64;
    bf16x8 qr[4];
    { const bf16_t* qp = QKV + (rowbase + qw + r32) * QKV_LD + h * 64 + hi * 8;
#pragma unroll
      for (int d0 = 0; d0 < 4; ++d0) qr[d0] = *(const bf16x8*)(qp + d0 * 16); }
    __syncthreads();
    { const float* kp = (const float*)(p.ws + WS_KPART); const int j = tid >> 6, d = tid & 63;
      const float* s = kp + ((size_t)(b * 8 + j) * 2) * 1024 + h * 64 + d;
      ((LAS float*)(lds + AL_KM))[tid] = s[0] + s[1024];
      for (int i = tid; i < BT_H; i += NTHREADS) ((LAS float*)(lds + AL_BIAS))[i] = ((const float*)(p.ws + WS_TAB))[h * BT_H + i]; }
    const int NT = 4 + 4 * qb;
    __syncthreads();
    unsigned sel = 0;
    { float g[8];
#pragma unroll
      for (int j = 0; j < 8; ++j) { float s = 0.f; const LAS float* km = (const LAS float*)(lds + AL_KM) + j * 64 + hi * 8;
#pragma unroll
          for (int d0 = 0; d0 < 4; ++d0)
#pragma unroll
              for (int i = 0; i < 8; ++i) s += bf2f((bf16_t)qr[d0][i]) * km[d0 * 16 + i];
          g[j] = xhalf_sum(s); }
#pragma unroll
      for (int round = 0; round < 3; ++round) { int best = -1; float bv = 0.f;
#pragma unroll
          for (int j = 0; j < 8; ++j) { const bool ok = (j < qb) && !((sel >> j) & 1u) && (best < 0 || g[j] > bv); if (ok) { best = j; bv = g[j]; } }
          if (best >= 0) sel |= 1u << best; } }
    const LAS float* btab = (const LAS float*)(lds + AL_BIAS); const float cfar = btab[0];
    FState st; fstate_reset(st);
    struct MobaSrc {
        const bf16_t *Kb, *Vb; LAS unsigned char* lds; int qb, qw, wid, lane; unsigned sel;
        __device__ __forceinline__ void tile(int t, int& blk, int& kt) const { blk = t < 4 ? qb : qb - 1 - ((t - 4) >> 2); kt = t < 4 ? t : ((t - 4) & 3); }
        __device__ __forceinline__ void dma(int t, int ks, int vs) const { int blk, kt; tile(t, blk, kt); const size_t key0 = (size_t)blk * 256 + kt * 64;
            dma_k(Kb + key0 * QKV_LD, QKV_LD, lds, ks, wid, lane); dma_v(Vb + key0 * QKV_LD, QKV_LD, lds, vs, wid, lane); }
        __device__ __forceinline__ TileP params(int t) const { int blk, kt; tile(t, blk, kt); TileP tp; tp.Dmin = qw - (blk * 256 + kt * 64); tp.win = false;
            if (blk == qb) { tp.rowok = true; tp.run = (64 * kt <= wid * 32 + 31); } else { tp.rowok = (sel >> blk) & 1u; tp.run = __any(tp.rowok); }
            return tp; }
        __device__ __forceinline__ void after(int, FState&) const {}
    } S{Kb, Vb, lds, qb, qw, wid, lane, sel};
    attn_stream<VAR>(S, NT, st, qr, lds, btab, cfar, wid, lane, r32, hi);
    const float inv = 1.0f / xhalf_sum(st.l);
    bf16_t* op = (bf16_t*)(p.ws + (VAR ? WS_X1B : WS_AOH)) + (rowbase + qw + r32) * 1024 + h * 64 + 4 * hi;
#pragma unroll
    for (int g4 = 0; g4 < 4; ++g4) {
        u32x2 w0, w1; w0.x = cvt_pk_bf16(st.o0[4 * g4] * inv, st.o0[4 * g4 + 1] * inv); w0.y = cvt_pk_bf16(st.o0[4 * g4 + 2] * inv, st.o0[4 * g4 + 3] * inv);
        w1.x = cvt_pk_bf16(st.o1[4 * g4] * inv, st.o1[4 * g4 + 1] * inv); w1.y = cvt_pk_bf16(st.o1[4 * g4 + 2] * inv, st.o1[4 * g4 + 3] * inv);
        *(u32x2*)(op + 8 * g4) = w0; *(u32x2*)(op + 32 + 8 * g4) = w1; }
}
template <int VAR> __device__ __forceinline__ void phase_moba(const Params& p, LAS unsigned char* lds) {
    for (int pr = blockIdx.x, rnd = 0; pr < 1024; pr += gridDim.x, ++rnd) { const int x = blockIdx.x & 7, s = blockIdx.x >> 3; const int bh = (gridDim.x == 256) ? (x + 8 * (rnd * 8 + (s >> 2))) : (pr >> 2), j = (gridDim.x == 256) ? (s & 3) : (pr & 3);
        moba_unit<VAR>(p, lds, bh >> 4, bh & 15, 7 - j);
        moba_unit<VAR>(p, lds, bh >> 4, bh & 15, j); }
    __syncthreads();
}

__device__ __forceinline__ void nsa_unit(const Params& p, LAS unsigned char* lds, int b, int hkv, int c, bool load_tab) {
    const int tid = otid(), lane = tid & 63, r32 = lane & 31, hi = lane >> 5; const int wid = __builtin_amdgcn_readfirstlane(tid >> 6);
    const bf16_t* P = (const bf16_t*)(p.ws + WS_BIG);
    const size_t rowbase = (size_t)b * SEQ; const int g = wid >> 1, qq0 = (wid & 1) * 32, h = hkv * 4 + g, qw = c * 64 + qq0, qpos = qw + r32;
    bf16x8 qr[4];
    const bf16_t* rowp = P + (rowbase + qpos) * NSA_LD;
#pragma unroll
    for (int d0 = 0; d0 < 4; ++d0) qr[d0] = *(const bf16x8*)(rowp + h * 64 + hi * 8 + d0 * 16);
    const float g0 = bf2f(rowp[NSA_G + h * 3]), g1 = bf2f(rowp[NSA_G + h * 3 + 1]), g2 = bf2f(rowp[NSA_G + h * 3 + 2]);
    __syncthreads();
    if (load_tab) { for (int i = tid; i < 4 * BT_H; i += NTHREADS) ((LAS float*)(lds + AL_BIAS))[i] = ((const float*)(p.ws + WS_TAB))[hkv * 4 * BT_H + i]; }
    if (tid < 64) ((LAS unsigned*)(lds + AL_SEL))[tid] = 0u;
    { const bf16_t* kc = (const bf16_t*)(p.ws + WS_KCMP) + (size_t)(b * 4 + hkv) * 128 * 64; const bf16_t* vc = (const bf16_t*)(p.ws + WS_VCMP) + (size_t)(b * 4 + hkv) * 128 * 64;
      dma_k(kc, 64, lds, 0, wid, lane); dma_k(kc + 64 * 64, 64, lds, 1, wid, lane); dma_v(vc, 64, lds, 0, wid, lane); dma_v(vc + 64 * 64, 64, lds, 1, wid, lane); }
    asm volatile("s_waitcnt vmcnt(0)" ::: "memory");
    __syncthreads();
    const lds_cptr kp0 = (lds_cptr)lds + AL_K + r32 * 128; const int kx = (r32 & 7) | (hi << 3);
    const lds_cptr vp0 = (lds_cptr)lds + AL_V + ((lane >> 4) & 1) * 32 + (lane & 3) * 8 + (4 * hi + ((lane & 15) >> 2)) * 64;
    f32x16 cb0, cb1;
    {
        f32x16 s[2][2];
        const int nlim = (qpos >= 31 ? ((qpos - 31) >> 4) + 1 : 0) - 4 * hi;
#pragma unroll
        for (int t = 0; t < 2; ++t) {
#pragma unroll
            for (int r = 0; r < 16; ++r) { s[t][0][r] = 0.f; s[t][1][r] = 0.f; }
            qk_tile(s[t][0], s[t][1], qr, kp0 + t * 8192, kx);
#pragma unroll
            for (int n2 = 0; n2 < 2; ++n2)
#pragma unroll
                for (int r = 0; r < 16; ++r) { const int nk = 64 * t + 32 * n2 + (r & 3) + 8 * (r >> 2); if (nk >= nlim) s[t][n2][r] = -INFINITY; }
        }
        const float mx = xhalf_max(__builtin_fmaxf(__builtin_fmaxf(max16(s[0][0]), max16(s[0][1])), __builtin_fmaxf(max16(s[1][0]), max16(s[1][1]))));
        const float mref = (mx == -INFINITY) ? 0.f : mx;
        float rs = 0.f;
#pragma unroll
        for (int t = 0; t < 2; ++t)
#pragma unroll
            for (int n2 = 0; n2 < 2; ++n2)
#pragma unroll
                for (int r = 0; r < 16; ++r) { const float e = __builtin_amdgcn_exp2f(s[t][n2][r] - mref); s[t][n2][r] = e; rs += e; }
        const float lt = xhalf_sum(rs); const float inv = lt > 0.f ? 1.0f / lt : 0.f;
#pragma unroll
        for (int t = 0; t < 2; ++t)
#pragma unroll
            for (int n2 = 0; n2 < 2; ++n2)
#pragma unroll
                for (int r = 0; r < 16; ++r) s[t][n2][r] *= inv;
        float Q[16], T[16];
#pragma unroll
        for (int t = 0; t < 2; ++t)
#pragma unroll
            for (int n2 = 0; n2 < 2; ++n2)
#pragma unroll
                for (int r4 = 0; r4 < 4; ++r4) { const int u = 8 * t + 4 * n2 + r4; Q[u] = (s[t][n2][4 * r4] + s[t][n2][4 * r4 + 1]) + (s[t][n2][4 * r4 + 2] + s[t][n2][4 * r4 + 3]); T[u] = s[t][n2][4 * r4 + 3]; }
        LAS float* imp = (LAS float*)(lds + AL_IMP) + (g * 64 + qq0 + r32) * 33;
        float prev = 0.f;
#pragma unroll
        for (int u = 0; u < 16; ++u) { const float rcv = __shfl_xor(T[u], 32); const float add = hi ? rcv : prev; prev = rcv; imp[2 * u + hi] = Q[u] + add; }
        f32x16 o0, o1;
#pragma unroll
        for (int r = 0; r < 16; ++r) { o0[r] = 0.f; o1[r] = 0.f; }
        pv_tile(o0, o1, s[0][0], s[0][1], vp0); pv_tile(o0, o1, s[1][0], s[1][1], vp0 + 8192);
#pragma unroll
        for (int r = 0; r < 16; ++r) { cb0[r] = g0 * o0[r]; cb1[r] = g0 * o1[r]; }
    }
    __syncthreads();
    {
        const int q = tid >> 3, jg = tid & 7; const LAS float* ib = (const LAS float*)(lds + AL_IMP) + q * 33;
        float val[32];
#pragma unroll
        for (int j = 0; j < 32; ++j) { float v = (ib[j] + ib[64 * 33 + j]) + (ib[2 * 64 * 33 + j] + ib[3 * 64 * 33 + j]);
            const bool forced = (j == 0) || (j == c) || (j == c - 1); v = forced ? INFINITY : v; val[j] = (j > c) ? -INFINITY : v; }
        unsigned bits = 0;
#pragma unroll
        for (int i = 0; i < 4; ++i) { const int j = jg * 4 + i; float vj = 0.f;
#pragma unroll
            for (int jj = 0; jj < 32; ++jj) vj = (jj == j) ? val[jj] : vj;
            int rank = 0;
#pragma unroll
            for (int jj = 0; jj < 32; ++jj) rank += (val[jj] > vj || (val[jj] == vj && jj < j)) ? 1 : 0;
            if (j <= c && rank < 16) bits |= 1u << j; }
        if (bits) atomicOr((unsigned*)(lds + AL_SEL) + q, bits);
    }
    __syncthreads();
    LAS float* stash = (LAS float*)(lds + AL_IMP) + wid * 2048 + lane;
#pragma unroll
    for (int r = 0; r < 16; ++r) { stash[r * 64] = cb0[r]; stash[(16 + r) * 64] = cb1[r]; }
    unsigned uni = ((const LAS unsigned*)(lds + AL_SEL))[lane];
#pragma unroll
    for (int o = 32; o > 0; o >>= 1) uni |= (unsigned)__shfl_xor((int)uni, o);
    uni = (unsigned)__builtin_amdgcn_readfirstlane((int)uni);
    const unsigned rowmask = ((const LAS unsigned*)(lds + AL_SEL))[qq0 + r32];
    const LAS float* btab = (const LAS float*)(lds + AL_BIAS) + g * BT_H; const float cfar = btab[0];
    const bf16_t* KS = P + rowbase * NSA_LD + NSA_KS + hkv * 64; const bf16_t* VS = P + rowbase * NSA_LD + NSA_VS + hkv * 64;
    const bf16_t* KW = P + rowbase * NSA_LD + NSA_KW + hkv * 64; const bf16_t* VW = P + rowbase * NSA_LD + NSA_VW + hkv * 64;
    const int nslc = __builtin_popcount(uni); const int wlo = c >= 8 ? 0 : 8 - c; const int NT = nslc + (9 - wlo);
    LAS int* list = (LAS int*)(lds + AL_LIST);
    if (tid < 32) { if ((uni >> tid) & 1u) list[__builtin_popcount(uni & ((1u << tid) - 1u))] = tid; }
    else if (tid < 32 + 9 - wlo) list[nslc + (tid - 32)] = 64 + (c - 8 + wlo + (tid - 32));
    __syncthreads();
    FState st; fstate_reset(st);
    struct NsaSrc {
        const bf16_t *KS, *VS, *KW, *VW; LAS unsigned char* lds; const LAS int* list; int nslc, qw, wid, lane; unsigned rowmask; float g1; LAS float* stash;
        __device__ __forceinline__ void dma(int t, int ks, int vs) const { const int e = __builtin_amdgcn_readfirstlane(list[t]);
            if (e < 64) { dma_k(KS + (size_t)e * 64 * NSA_LD, NSA_LD, lds, ks, wid, lane); dma_v(VS + (size_t)e * 64 * NSA_LD, NSA_LD, lds, vs, wid, lane); }
            else { dma_k(KW + (size_t)(e - 64) * 64 * NSA_LD, NSA_LD, lds, ks, wid, lane); dma_v(VW + (size_t)(e - 64) * 64 * NSA_LD, NSA_LD, lds, vs, wid, lane); } }
        __device__ __forceinline__ TileP params(int t) const { const int e = __builtin_amdgcn_readfirstlane(list[t]); TileP tp;
            if (e < 64) { tp.Dmin = qw - 64 * e; tp.rowok = (rowmask >> e) & 1u; tp.run = __any(tp.rowok); tp.win = false; }
            else { tp.Dmin = qw - 64 * (e - 64); tp.rowok = true; tp.run = true; tp.win = true; }
            return tp; }
        __device__ __forceinline__ void after(int t, FState& st) const {
            if (t == nslc - 1) { const float f = g1 / xhalf_sum(st.l);
#pragma unroll
                for (int r = 0; r < 16; ++r) { stash[r * 64] += f * st.o0[r]; stash[(16 + r) * 64] += f * st.o1[r]; }
                fstate_reset(st); } }
    } S{KS, VS, KW, VW, lds, list, nslc, qw, wid, lane, rowmask, g1, stash};
    attn_stream<0>(S, NT, st, qr, lds, btab, cfar, wid, lane, r32, hi);
    { const float f = g2 / xhalf_sum(st.l);
#pragma unroll
      for (int r = 0; r < 16; ++r) { cb0[r] = stash[r * 64] + f * st.o0[r]; cb1[r] = stash[(16 + r) * 64] + f * st.o1[r]; } }
    bf16_t* op = (bf16_t*)(p.ws + WS_AOH) + (rowbase + qpos) * 1024 + h * 64 + 4 * hi;
#pragma unroll
    for (int g4 = 0; g4 < 4; ++g4) {
        u32x2 w0, w1; w0.x = cvt_pk_bf16(cb0[4 * g4], cb0[4 * g4 + 1]); w0.y = cvt_pk_bf16(cb0[4 * g4 + 2], cb0[4 * g4 + 3]);
        w1.x = cvt_pk_bf16(cb1[4 * g4], cb1[4 * g4 + 1]); w1.y = cvt_pk_bf16(cb1[4 * g4 + 2], cb1[4 * g4 + 3]);
        *(u32x2*)(op + 8 * g4) = w0; *(u32x2*)(op + 32 + 8 * g4) = w1; }
}
__device__ __forceinline__ void phase_nsa(const Params& p, LAS unsigned char* lds) {
    int last_hkv = -1;
    for (int pr = blockIdx.x, rnd = 0; pr < 1024; pr += gridDim.x, ++rnd) { const int x = blockIdx.x & 7, s = blockIdx.x >> 3; const int bh = (gridDim.x == 256) ? (x + 8 * (rnd * 2 + (s >> 4))) : (pr >> 4), j = (gridDim.x == 256) ? (s & 15) : (pr & 15);
        nsa_unit(p, lds, bh >> 2, bh & 3, 31 - j, (bh & 3) != last_hkv);
        nsa_unit(p, lds, bh >> 2, bh & 3, j, false); last_hkv = bh & 3; }
    __syncthreads();
}

template <int L> __device__ __forceinline__ void phase_ln1(const Params& p, LAS unsigned char* lds) {
    const int tid = otid(), lane = tid & 63, wid = tid >> 6, r = lane & 15, q = lane >> 4;
    const float* lg = p.ln_g + (L * 2 + 0) * 1024; const float* lb = p.ln_b + (L * 2 + 0) * 1024;
    const bf16_t* Y = (const bf16_t*)(p.ws + WS_BIG); bf16_t* X1 = (bf16_t*)(p.ws + WS_X1B);
    for (int i = tid; i < 32 * 2 * 64; i += NTHREADS) { const int l2 = i & 63, nb = (i >> 6) & 1, s = i >> 7; const int e = 16 * nb + (l2 & 15), k0 = 32 * s + 8 * (l2 >> 4);
        float w[8]; unsigned hw[4], lw[4];
#pragma unroll
        for (int j = 0; j < 8; ++j) w[j] = p.router_w[(size_t)(k0 + j) * 32 + e];
#pragma unroll
        for (int j = 0; j < 4; ++j) { hw[j] = cvt_pk_bf16(w[2 * j], w[2 * j + 1]); lw[j] = cvt_pk_bf16(w[2 * j] - lo_bf(hw[j]), w[2 * j + 1] - hi_bf(hw[j])); }
        *(LAS u32x4*)(lds + ((size_t)((s * 2 + nb) * 2 + 0) * 64 + l2) * 16) = (u32x4){hw[0], hw[1], hw[2], hw[3]};
        *(LAS u32x4*)(lds + ((size_t)((s * 2 + nb) * 2 + 1) * 64 + l2) * 16) = (u32x4){lw[0], lw[1], lw[2], lw[3]}; }
    LAS int* hist = (LAS int*)(lds + 131072 + 8 * 2048);
    if (tid < 32) hist[tid] = 0;
    __syncthreads();
    for (int tb = blockIdx.x; tb < NTOK / 128; tb += gridDim.x) {
        const int tok = tb * 128 + wid * 16 + r;
        const bf16_t* yp = Y + (size_t)tok * 1024 + 8 * q;
        float sum = 0.f, sq = 0.f;
#pragma unroll 16
        for (int s = 0; s < 32; ++s) { const u32x4 y = *(const u32x4*)(yp + 32 * s); const unsigned yw[4] = {y.x, y.y, y.z, y.w};
#pragma unroll
            for (int j = 0; j < 4; ++j) { const float a = lo_bf(yw[j]), b2 = hi_bf(yw[j]); sum += a + b2; sq += a * a + b2 * b2; } }
        sum += __shfl_xor(sum, 16); sum += __shfl_xor(sum, 32); sq += __shfl_xor(sq, 16); sq += __shfl_xor(sq, 32);
        const float mu = sum * (1.0f / 1024.0f);
        const float rstd = rsqrtf(fmaxf(sq * (1.0f / 1024.0f) - mu * mu, 0.f) + 1e-5f);
        f32x4 acc0 = (f32x4){0.f, 0.f, 0.f, 0.f}, acc1 = acc0;
        bf16_t* xp = X1 + (size_t)tok * 1024 + 8 * q;
#pragma unroll 4
        for (int s = 0; s < 32; ++s) {
            const u32x4 y = *(const u32x4*)(yp + 32 * s);
            const f32x4 ga = *(const f32x4*)(lg + 32 * s + 8 * q), gb = *(const f32x4*)(lg + 32 * s + 8 * q + 4), ba = *(const f32x4*)(lb + 32 * s + 8 * q), bb = *(const f32x4*)(lb + 32 * s + 8 * q + 4);
            u32x4 w;
            w.x = cvt_pk_bf16((lo_bf(y.x) - mu) * rstd * ga[0] + ba[0], (hi_bf(y.x) - mu) * rstd * ga[1] + ba[1]);
            w.y = cvt_pk_bf16((lo_bf(y.y) - mu) * rstd * ga[2] + ba[2], (hi_bf(y.y) - mu) * rstd * ga[3] + ba[3]);
            w.z = cvt_pk_bf16((lo_bf(y.z) - mu) * rstd * gb[0] + bb[0], (hi_bf(y.z) - mu) * rstd * gb[1] + bb[1]);
            w.w = cvt_pk_bf16((lo_bf(y.w) - mu) * rstd * gb[2] + bb[2], (hi_bf(y.w) - mu) * rstd * gb[3] + bb[3]);
            *(u32x4*)(xp + 32 * s) = w;
            const bf16x8 af = __builtin_bit_cast(bf16x8, w);
            const LAS unsigned char* bq = lds + (size_t)s * 4096 + lane * 16;
            const bf16x8 b0h = *(const LAS bf16x8*)(bq), b0l = *(const LAS bf16x8*)(bq + 1024), b1h = *(const LAS bf16x8*)(bq + 2048), b1l = *(const LAS bf16x8*)(bq + 3072);
            acc0 = __builtin_amdgcn_mfma_f32_16x16x32_bf16(af, b0h, acc0, 0, 0, 0); acc0 = __builtin_amdgcn_mfma_f32_16x16x32_bf16(af, b0l, acc0, 0, 0, 0);
            acc1 = __builtin_amdgcn_mfma_f32_16x16x32_bf16(af, b1h, acc1, 0, 0, 0); acc1 = __builtin_amdgcn_mfma_f32_16x16x32_bf16(af, b1l, acc1, 0, 0, 0);
        }
        LAS float* lg2 = (LAS float*)(lds + 131072 + wid * 2048);
#pragma unroll
        for (int i = 0; i < 4; ++i) { lg2[(4 * q + i) * 32 + r] = acc0[i] + p.router_b[r]; lg2[(4 * q + i) * 32 + 16 + r] = acc1[i] + p.router_b[16 + r]; }
        asm volatile("s_waitcnt lgkmcnt(0)" ::: "memory");
        int e0 = 0, e1 = 0, r0 = 0, r1 = 0; float w0 = 0.f, w1 = 0.f;
        if (lane < 16) {
            float pr[32]; float mx = -INFINITY;
#pragma unroll
            for (int e = 0; e < 32; ++e) { pr[e] = lg2[lane * 32 + e]; mx = fmaxf(mx, pr[e]); }
#pragma unroll
            for (int e = 0; e < 32; ++e) pr[e] = __expf(pr[e] - mx);
            int best = 0; float bs = -1.f;
#pragma unroll
            for (int gi = 0; gi < 8; ++gi) { const float a = pr[4 * gi], b2 = pr[4 * gi + 1], c2 = pr[4 * gi + 2], d2 = pr[4 * gi + 3];
                const float h1 = fmaxf(a, b2), l1 = fminf(a, b2), h2 = fmaxf(c2, d2), l2 = fminf(c2, d2);
                const float m1 = fmaxf(h1, h2), m2 = fmaxf(fminf(h1, h2), fmaxf(l1, l2));
                const float sc = m1 + m2; if (sc > bs) { bs = sc; best = gi; } }
            float v[4];
#pragma unroll
            for (int gi = 0; gi < 8; ++gi) if (gi == best) { v[0] = pr[4 * gi]; v[1] = pr[4 * gi + 1]; v[2] = pr[4 * gi + 2]; v[3] = pr[4 * gi + 3]; }
            int i0 = 0; float v0 = v[0];
#pragma unroll
            for (int i = 1; i < 4; ++i) if (v[i] > v0) { v0 = v[i]; i0 = i; }
            int i1 = -1; float v1 = -1.f;
#pragma unroll
            for (int i = 0; i < 4; ++i) if (i != i0 && v[i] > v1) { v1 = v[i]; i1 = i; }
            e0 = best * 4 + i0; e1 = best * 4 + i1; const float ws = 1.0f / (v0 + v1); w0 = v0 * ws; w1 = v1 * ws;
            r0 = atomicAdd((int*)hist + e0, 1); r1 = atomicAdd((int*)hist + e1, 1);
        }
        __syncthreads();
        if (tid < 32) { const int hv = hist[tid]; hist[32 + tid] = hv ? atomicAdd((int*)(p.ws + WS_GCNT) + L * 32 + tid, hv) : 0; }
        __syncthreads();
        if (lane < 16) { const int t2 = tb * 128 + wid * 16 + lane; const int s0 = hist[32 + e0] + r0, s1 = hist[32 + e1] + r1;
            ((int*)(p.ws + WS_RE))[t2 * 2] = e0; ((int*)(p.ws + WS_RE))[t2 * 2 + 1] = e1;
            ((float*)(p.ws + WS_RWT))[t2 * 2] = w0; ((float*)(p.ws + WS_RWT))[t2 * 2 + 1] = w1;
            ((int*)(p.ws + WS_POS))[t2 * 2] = s0; ((int*)(p.ws + WS_POS))[t2 * 2 + 1] = s1;
            ((int*)(p.ws + WS_ROWTOK))[e0 * 65536 + s0] = t2; ((int*)(p.ws + WS_ROWTOK))[e1 * 65536 + s1] = t2; }
        __syncthreads();
        if (tid < 32) hist[tid] = 0;
        __syncthreads();
    }
}

template <int L> __device__ __forceinline__ void phase_ln2(const Params& p, LAS unsigned char* lds) {
    const int tid = otid(), lane = tid & 63, wid = tid >> 6;
    LAS int* pst = (LAS int*)lds;
    __syncthreads();
    if (tid == 0) { const int* cnt = (const int*)(p.ws + WS_GCNT) + L * 32; int s = 0; for (int e = 0; e < NEXP; ++e) { pst[e] = s; s += (cnt[e] + 255) & ~255; } }
    __syncthreads();
    const int* RE = (const int*)(p.ws + WS_RE);
    const float* lg = p.ln_g + (L * 2 + 1) * 1024; const float* lb = p.ln_b + (L * 2 + 1) * 1024;
    const bf16_t* X1 = (const bf16_t*)(p.ws + WS_X1B); const bf16_t* YB = (const bf16_t*)(p.ws + WS_BIG);
    const int* POS = (const int*)(p.ws + WS_POS); const float* RW = (const float*)(p.ws + WS_RWT);
    const int tok0 = blockIdx.x * 8 + wid, tstride = gridDim.x * 8, nk = (NTOK - tok0 + tstride - 1) / tstride;
    int rs0 = 0, rs1 = 0; float rw0 = 0.f, rw1 = 0.f;
    if (lane < nk && lane < 16) { const int t = tok0 + lane * tstride; rs0 = pst[RE[t * 2]] + POS[t * 2]; rs1 = pst[RE[t * 2 + 1]] + POS[t * 2 + 1]; rw0 = RW[t * 2]; rw1 = RW[t * 2 + 1]; }
    u32x4 ra[2][2], rb[2][2], rc[2][2];
#define LN2_LOAD(k, buf) do { const int t_ = tok0 + (k) * tstride; const int s0_ = __shfl(rs0, (k)), s1_ = __shfl(rs1, (k)); _Pragma("unroll") for (int hf = 0; hf < 2; ++hf) { const int c0 = hf * 512 + lane * 8; \
        ra[buf][hf] = *(const u32x4*)(X1 + (size_t)t_ * 1024 + c0); rb[buf][hf] = *(const u32x4*)(YB + (size_t)s0_ * 1024 + c0); rc[buf][hf] = *(const u32x4*)(YB + (size_t)s1_ * 1024 + c0); } } while (0)
    if (nk > 0) LN2_LOAD(0, 0);
#pragma unroll
    for (int k = 0; k < 16; ++k) {
        if (k < nk) {
            const int tok = tok0 + k * tstride; const float w0 = __shfl(rw0, k), w1 = __shfl(rw1, k);
            if (k + 1 < nk) LN2_LOAD(k + 1, (k + 1) & 1);
            float v[16];
#pragma unroll
            for (int hf = 0; hf < 2; ++hf) { const u32x4 a = ra[k & 1][hf], b = rb[k & 1][hf], c = rc[k & 1][hf];
                const unsigned aw[4] = {a.x, a.y, a.z, a.w}, bw[4] = {b.x, b.y, b.z, b.w}, cw[4] = {c.x, c.y, c.z, c.w};
#pragma unroll
                for (int j = 0; j < 4; ++j) { v[hf * 8 + 2 * j] = ALPHA * lo_bf(aw[j]) + w0 * lo_bf(bw[j]) + w1 * lo_bf(cw[j]); v[hf * 8 + 2 * j + 1] = ALPHA * hi_bf(aw[j]) + w0 * hi_bf(bw[j]) + w1 * hi_bf(cw[j]); } }
            float s = 0.f;
#pragma unroll
            for (int i = 0; i < 16; ++i) s += v[i];
            const float mu = wave_sum(s) * (1.0f / 1024.0f);
            float qv = 0.f;
#pragma unroll
            for (int i = 0; i < 16; ++i) { const float d = v[i] - mu; qv += d * d; }
            const float rstd = rsqrtf(wave_sum(qv) * (1.0f / 1024.0f) + 1e-5f);
#pragma unroll
            for (int hf = 0; hf < 2; ++hf) { const int c0 = hf * 512 + lane * 8; float o[8];
                const f32x4 ga = *(const f32x4*)(lg + c0), gb = *(const f32x4*)(lg + c0 + 4), ba = *(const f32x4*)(lb + c0), bb = *(const f32x4*)(lb + c0 + 4);
#pragma unroll
                for (int j = 0; j < 4; ++j) { o[j] = (v[hf * 8 + j] - mu) * rstd * ga[j] + ba[j]; o[4 + j] = (v[hf * 8 + 4 + j] - mu) * rstd * gb[j] + bb[j]; }
                if (L == 1) { *(f32x4*)(p.out + (size_t)tok * 1024 + c0) = (f32x4){o[0], o[1], o[2], o[3]}; *(f32x4*)(p.out + (size_t)tok * 1024 + c0 + 4) = (f32x4){o[4], o[5], o[6], o[7]}; }
                else { u32x4 w; w.x = cvt_pk_bf16(o[0], o[1]); w.y = cvt_pk_bf16(o[2], o[3]); w.z = cvt_pk_bf16(o[4], o[5]); w.w = cvt_pk_bf16(o[6], o[7]); *(u32x4*)((bf16_t*)(p.ws + WS_XB) + (size_t)tok * 1024 + c0) = w; } }
        }
    }
#undef LN2_LOAD
}

__device__ __forceinline__ void phase_cmpfin(const Params& p, LAS unsigned char* lds) {
    const int tid = otid(), lane = tid & 63, wid = tid >> 6;
    LAS float* w2s = (LAS float*)lds;
    LAS float* hs = (LAS float*)(lds + 65536) + wid * 1024;
    LAS float* b1s = (LAS float*)(lds + 65536 + 32768);
    const float* CP = (const float*)(p.ws + WS_X1B); const float* B1 = (const float*)(p.ws + WS_B1);
    for (int kv = 0; kv < 2; ++kv) {
        __syncthreads();
        { const float* w2g = kv ? p.cv_w2 : p.ck_w2; for (int i = tid; i < 256 * 64; i += NTHREADS) w2s[i] = w2g[i]; }
        if (tid < 256) { float b1 = 0.f;
#pragma unroll 8
            for (int pt = 0; pt < 32; ++pt) b1 += B1[(kv * 32 + pt) * 256 + tid];
            b1s[tid] = b1; }
        __syncthreads();
        bf16_t* dst = (bf16_t*)(p.ws + (kv ? WS_VCMP : WS_KCMP));
        for (int rg = blockIdx.x * 8 + wid; rg < 8192 / 4; rg += gridDim.x * 8) {
            const int m0 = rg * 4;
#pragma unroll
            for (int i = 0; i < 4; ++i) { const int j = lane + 64 * i; const float b1 = b1s[j];
                f32x4 hv;
#pragma unroll
                for (int rr = 0; rr < 4; ++rr) { float a = b1;
#pragma unroll
                    for (int ks = 0; ks < 4; ++ks) a += CP[((size_t)(kv * 4 + ks) * 8192 + m0 + rr) * 256 + j];
                    const float u = 0.7978845608028654f * (a + 0.044715f * a * a * a); const float th = 1.0f - 2.0f / (1.0f + __expf(2.0f * u));
                    hv[rr] = 0.5f * a * (1.0f + th); }
                *(LAS f32x4*)(hs + j * 4) = hv; }
            asm volatile("s_waitcnt lgkmcnt(0)" ::: "memory");
            f32x4 o = (f32x4){0.f, 0.f, 0.f, 0.f}; const LAS float* w2 = w2s + lane;
#pragma unroll 8
            for (int j = 0; j < 256; ++j) o += *(const LAS f32x4*)(hs + j * 4) * w2[j * 64];
#pragma unroll
            for (int rr = 0; rr < 4; ++rr) dst[(size_t)(m0 + rr) * 64 + lane] = f2bf((((m0 + rr) & 127) == 127) ? 0.f : o[rr]);
            asm volatile("s_waitcnt lgkmcnt(0)" ::: "memory");
        }
    }
}

constexpr int NPHASE = 19;
template <int PH> __device__ __forceinline__ void run_phase(const Params& p, LAS unsigned char* lds) {
    char* ws = p.ws;
    if constexpr (PH == 0) phase_prologue(p, lds);
    else if constexpr (PH == 1) { SchedPlain S; S.init(ws + WS_XB, ws + WS_WQKV0, NTOK, 3072, 1024); EpiQKV0 E{(bf16_t*)(ws + WS_BIG), (float*)(ws + WS_KPART)}; pg8::gemm_phase(lds, S, E); }
    else if constexpr (PH == 2) phase_moba<0>(p, lds);
    else if constexpr (PH == 3) { SchedPlain S; S.init(ws + WS_AOH, ws + WS_WO0, NTOK, 1024, 1024); EpiRes<true> E{(bf16_t*)(ws + WS_BIG), p.x, nullptr}; pg8::gemm_phase(lds, S, E); }
    else if constexpr (PH == 4) phase_ln1<0>(p, lds);
    else if constexpr (PH == 6 || PH == 16) { SchedMoeGU S; S.init(ws, PH == 16, lds); EpiGU E{(bf16_t*)(ws + WS_AOH)}; pg8::gemm_phase(lds, S, E); }
    else if constexpr (PH == 7 || PH == 17) { SchedMoeDN S; S.init(ws, PH == 17, lds); EpiDN E{(bf16_t*)(ws + WS_BIG)}; pg8::gemm_phase(lds, S, E); }
    else if constexpr (PH == 8) { phase_ln2<0>(p, lds); __syncthreads(); conv_moe_layer(p, 1, lds); }
    else if constexpr (PH == 9) { SchedPlain S; S.init(ws + WS_XB, ws + WS_WIN1, NTOK, 2816, 1024); EpiNSA E{(bf16_t*)(ws + WS_BIG)}; pg8::gemm_phase(lds, S, E); }
    else if constexpr (PH == 10) { SchedCmp S; S.init(ws); EpiCmp E{(float*)(ws + WS_X1B)}; pg8::gemm_phase(lds, S, E); }
    else if constexpr (PH == 11) phase_cmpfin(p, lds);
    else if constexpr (PH == 12) phase_nsa(p, lds);
    else if constexpr (PH == 13) { SchedPlain S; S.init(ws + WS_AOH, ws + WS_WO1, NTOK, 1024, 1024); EpiRes<false> E{(bf16_t*)(ws + WS_BIG), nullptr, (const bf16_t*)(ws + WS_XB)}; pg8::gemm_phase(lds, S, E); }
    else if constexpr (PH == 14) phase_ln1<1>(p, lds);
    else if constexpr (PH == 18) phase_ln2<1>(p, lds);
}

extern __shared__ __attribute__((aligned(16))) unsigned char g_smem[];

template <int PH> __global__ void __launch_bounds__(NTHREADS, 2) k_phase(Params p) {
    run_phase<PH>(p, (LAS unsigned char*)g_smem);
}

#if !MK_LAUNCHES
template <int PH> __device__ __forceinline__ void mega_seq(const Params& p, LAS unsigned char* lds, const XcdBarrier& bar) {
    if constexpr (PH == 5 || PH == 15) { mega_seq<PH + 1>(p, lds, bar); return; }
    run_phase<PH>(p, lds);
#ifdef PROBE_VAR
    if constexpr (PH == 2) { xcd_barrier(bar); phase_moba<PROBE_VAR>(p, lds); }
#endif
#ifdef PROBE_BAR
    if constexpr (PH == 3) { for (int i = 0; i < 16; ++i) xcd_barrier(bar); }
#endif
#ifdef PROBE_GEMM_NULL
    if constexpr (PH == 1) { xcd_barrier(bar); SchedPlain S; S.init(p.ws + WS_XB, p.ws + WS_WQKV0, NTOK, 3072, 1024); EpiNull E{(float*)(p.ws + WS_X1B)}; pg8::gemm_phase(lds, S, E); }
#endif
#ifdef PROBE_MASK
    if constexpr ((PROBE_MASK >> PH) & 1) { xcd_barrier(bar); run_phase<PH>(p, lds); }
#endif
    if constexpr (PH + 1 < NPHASE) { xcd_barrier(bar); mega_seq<PH + 1>(p, lds, bar); }
}
__global__ void __launch_bounds__(NTHREADS, 2) k_mega(Params p) {
    LAS unsigned char* lds = (LAS unsigned char*)g_smem;
    LAS unsigned* stw = (LAS unsigned*)(lds + LDS_BYTES - 16);
    if (threadIdx.x == 0) { stw[0] = 0u; stw[1] = 0u; stw[2] = 0u; stw[3] = 0u; }
    __syncthreads();
    XcdBarrier bar = xcd_barrier_post((unsigned*)(p.ws + WS_CTL), (volatile LAS unsigned*)stw);
    mega_seq<0>(p, lds, bar);
}

#endif
template <int PH> static void launch_phases(const Params& p, int grid, hipStream_t stream) {
    hipFuncSetAttribute((const void*)k_phase<PH>, hipFuncAttributeMaxDynamicSharedMemorySize, LDS_BYTES);
    hipLaunchKernelGGL(k_phase<PH>, dim3(grid), dim3(NTHREADS), LDS_BYTES, stream, p);
    if constexpr (PH + 1 < NPHASE) launch_phases<PH + 1>(p, grid, stream);
}

extern "C" void kernel_launch(void* const* d_in, const int* in_sizes, int n_in, void* d_out, int out_size, void* d_ws, size_t ws_size, hipStream_t stream) {
    if (n_in != 19 || ws_size < WS_END) { fprintf(stderr, "kernel_launch: need 19 inputs and %zu bytes of workspace (got %d, %zu)\n", (size_t)WS_END, n_in, ws_size); return; }
    Params p{};
    p.x = (const float*)d_in[0]; p.rel_bias = (const float*)d_in[1]; p.router_w = (const float*)d_in[2]; p.router_b = (const float*)d_in[3];
    p.ln_g = (const float*)d_in[4]; p.ln_b = (const float*)d_in[5]; p.moba_w_in = (const float*)d_in[6]; p.moba_w_out = (const float*)d_in[7];
    p.nsa_w_in = (const float*)d_in[8]; p.nsa_w_out = (const float*)d_in[9]; p.pos_k = (const float*)d_in[10]; p.pos_v = (const float*)d_in[11];
    p.ck_w1 = (const float*)d_in[12]; p.ck_w2 = (const float*)d_in[13]; p.cv_w1 = (const float*)d_in[14]; p.cv_w2 = (const float*)d_in[15];
    p.w_gate = (const float*)d_in[16]; p.w_up = (const float*)d_in[17]; p.w_down = (const float*)d_in[18];
    p.out = (float*)d_out; p.ws = (char*)d_ws;
    const int grid = NWG_EXPECT;
#if MK_LAUNCHES
    launch_phases<0>(p, grid, stream);
#else
    hipFuncSetAttribute((const void*)k_mega, hipFuncAttributeMaxDynamicSharedMemorySize, LDS_BYTES);
    hipMemsetAsync((char*)d_ws + WS_CTL, 0, 16384, stream);
    hipLaunchKernelGGL(k_mega, dim3(grid), dim3(NTHREADS), LDS_BYTES, stream, p);
#endif
}
```

```cpp
#include <hip/hip_runtime.h>
#include <cstdio>
#include <cstdint>

#ifndef MK_LAUNCHES
#define MK_LAUNCHES 0
#endif

#define LAS __attribute__((address_space(3)))
typedef unsigned short bf16_t;
typedef short bf16x8 __attribute__((ext_vector_type(8)));
typedef short s16x4 __attribute__((ext_vector_type(4)));
typedef short v4i16_t __attribute__((ext_vector_type(4)));
typedef float f32x4 __attribute__((ext_vector_type(4)));
typedef float f32x16 __attribute__((ext_vector_type(16)));
typedef unsigned u32x4 __attribute__((ext_vector_type(4)));
typedef unsigned u32x2 __attribute__((ext_vector_type(2)));
typedef float f32x2 __attribute__((ext_vector_type(2)));
typedef int i32x4 __attribute__((ext_vector_type(4)));
typedef int i32x8 __attribute__((ext_vector_type(8)));
typedef LAS const char* lds_cptr;

constexpr int NTOK = 32768, DM = 1024, SEQ = 2048, NBATCH = 16, NHEAD = 16;
constexpr int QKV_LD = 3072, NSA_LD = 2816;
constexpr int NSA_KC = 1024, NSA_VC = 1280, NSA_KS = 1536, NSA_VS = 1792, NSA_KW = 2048, NSA_VW = 2304, NSA_G = 2560;
constexpr int NEXP = 32, DEXP = 512, MAXPAN = 288, RPAD = MAXPAN * 256;
constexpr int NTHREADS = 512, NWG_EXPECT = 256;
constexpr int LDS_BYTES = 155648;
constexpr float LOG2E = 1.4426950408889634f;
constexpr float C2 = 0.125f * LOG2E;
constexpr float ALPHA = 1.4142135623730951f;
constexpr int BT_N = 288;
constexpr int BT_S = 292, BT_H = 4 * BT_S;

constexpr size_t al256(size_t x) { return (x + 255) & ~(size_t)255; }
constexpr size_t WS_CTL = 0;
constexpr size_t WS_BCNT = 14592;
constexpr size_t WS_GCNT = 14336;
constexpr size_t WS_TAB = 16384;
constexpr size_t WS_B1 = WS_TAB + al256(16 * BT_H * 4);
constexpr size_t WS_NPAN = WS_B1 + 65536;
constexpr size_t WS_PANEL = WS_NPAN + 256;
constexpr size_t WS_HIST = WS_PANEL + 1280;
constexpr size_t WS_KPART = WS_HIST + 32768;
constexpr size_t WS_RE = WS_KPART + 128 * 2 * 1024 * 4;
constexpr size_t WS_RWT = WS_RE + (size_t)NTOK * 8;
constexpr size_t WS_POS = WS_RWT + (size_t)NTOK * 8;
constexpr size_t WS_ROWTOK = WS_POS + (size_t)NTOK * 8;
constexpr size_t WS_KCMP = WS_ROWTOK + (size_t)32 * 65536 * 4;
constexpr size_t WS_VCMP = WS_KCMP + 16 * 4 * 128 * 64 * 2;
constexpr size_t WS_WQKV0 = WS_VCMP + 16 * 4 * 128 * 64 * 2;
constexpr size_t WS_WO0 = WS_WQKV0 + (size_t)3072 * 1024 * 2;
constexpr size_t WS_WIN1 = WS_WO0 + (size_t)1024 * 1024 * 2;
constexpr size_t WS_WO1 = WS_WIN1 + (size_t)2816 * 1024 * 2;
constexpr size_t WS_W1T = WS_WO1 + (size_t)1024 * 1024 * 2;
constexpr size_t WS_GU = WS_W1T + (size_t)2 * 256 * 2048 * 2;
constexpr size_t WS_X1Q = WS_GU + (size_t)32 * 1024 * 1024;
constexpr size_t WS_DN = WS_GU + (size_t)32 * 1024 * 1024 * 2;
constexpr int GU1_EARLY = 1536;
constexpr size_t DN1_OFF = (size_t)16 * 1024 * 1024;
constexpr size_t WS_XB = WS_DN + (size_t)32 * 1024 * 512 * 2;
constexpr size_t WS_BIG = WS_XB + (size_t)NTOK * 1024 * 2;
constexpr size_t WS_AOH = WS_BIG + (size_t)NTOK * 3072 * 2;
constexpr size_t WS_X1B = WS_AOH + (size_t)RPAD * 512 * 2;
constexpr size_t WS_END = WS_X1B + (size_t)NTOK * 1024 * 2;

struct Params {
    const float *x, *rel_bias, *router_w, *router_b, *ln_g, *ln_b, *moba_w_in, *moba_w_out, *nsa_w_in, *nsa_w_out, *pos_k, *pos_v,
                *ck_w1, *ck_w2, *cv_w1, *cv_w2, *w_gate, *w_up, *w_down;
    float* out;
    char* ws;
};

__device__ __forceinline__ int otid() { int t = threadIdx.x; asm volatile("" : "+v"(t)); return t; }
__device__ __forceinline__ float bf2f(bf16_t v) { return __uint_as_float(((unsigned)v) << 16); }
__device__ __forceinline__ unsigned cvt_pk_bf16(float lo, float hi) { unsigned r; asm volatile("v_cvt_pk_bf16_f32 %0, %1, %2" : "=v"(r) : "v"(lo), "v"(hi)); return r; }
constexpr float F8_SW = 256.0f, F8_SX = 8.0f, F8_INV = 1.0f / (F8_SW * F8_SX);
constexpr float I8_SX = 127.0f / 6.0f, I8_SW = 127.0f / 0.18f, I8_INV = 1.0f / (I8_SX * I8_SW);
__device__ __forceinline__ unsigned cvt4_i8(float a, float b, float c, float d) {
    a = __builtin_amdgcn_fmed3f(a, -127.f, 127.f) + 12582912.0f; b = __builtin_amdgcn_fmed3f(b, -127.f, 127.f) + 12582912.0f; c = __builtin_amdgcn_fmed3f(c, -127.f, 127.f) + 12582912.0f; d = __builtin_amdgcn_fmed3f(d, -127.f, 127.f) + 12582912.0f;
    return (__float_as_uint(a) & 0xffu) | ((__float_as_uint(b) & 0xffu) << 8) | ((__float_as_uint(c) & 0xffu) << 16) | (__float_as_uint(d) << 24); }
constexpr float I8_SKC = 127.0f / 6.0f, I8_SW1 = 127.0f / 0.13f, I8_INVC = 1.0f / (I8_SKC * I8_SW1);
constexpr float F8_SY = 32.0f;
constexpr float F8_SO = 16.0f, F8_INVO = 1.0f / (F8_SW * F8_SO);
__device__ __forceinline__ unsigned cvt4_fp8(float a, float b, float c, float d) {
    a = __builtin_amdgcn_fmed3f(a, -448.f, 448.f); b = __builtin_amdgcn_fmed3f(b, -448.f, 448.f); c = __builtin_amdgcn_fmed3f(c, -448.f, 448.f); d = __builtin_amdgcn_fmed3f(d, -448.f, 448.f);
    int w = 0; w = __builtin_amdgcn_cvt_pk_fp8_f32(a, b, w, false); w = __builtin_amdgcn_cvt_pk_fp8_f32(c, d, w, true); return (unsigned)w; }
__device__ __forceinline__ bf16_t f2bf(float f) { return (bf16_t)(cvt_pk_bf16(f, 0.f) & 0xffffu); }
__device__ __forceinline__ float lo_bf(unsigned w) { return __uint_as_float(w << 16); }
__device__ __forceinline__ float hi_bf(unsigned w) { return __uint_as_float(w & 0xffff0000u); }
__device__ __forceinline__ float wave_sum(float v) {
#pragma unroll
    for (int o = 32; o > 0; o >>= 1) v += __shfl_xor(v, o);
    return v; }

#define XB_TMO      128
#define XB_XCNT(j)  (256  + 64 * (j))
#define XB_XSUB(j)  (1280 + 64 * (j))
#define XB_XGEN(j)  (2304 + 64 * (j))
#define XB_TOP      3328
#define XB_TOPGEN   3392
#define XCD_BAR_WORDS 3456
#define XB_SPIN_CAP (1u << 18)
__device__ __forceinline__ unsigned xb_ld(unsigned* p)              { return __hip_atomic_load(p, __ATOMIC_RELAXED, __HIP_MEMORY_SCOPE_AGENT); }
__device__ __forceinline__ unsigned xb_add(unsigned* p, unsigned v) { return __hip_atomic_fetch_add(p, v, __ATOMIC_RELAXED, __HIP_MEMORY_SCOPE_AGENT); }
__device__ __forceinline__ unsigned xb_xcc_id() { return (unsigned)__builtin_amdgcn_s_getreg((3 << 11) | 20) & 0xFu; }
#define XB_SPIN(cond, bar) do { unsigned _sp = 0; while (cond) { __builtin_amdgcn_s_sleep(1); \
    if ((++_sp & 255u) == 0u) { if (xb_ld(&(bar)[XB_TMO])) break; if (_sp > XB_SPIN_CAP) { atomicAdd(&(bar)[XB_TMO], 1u); break; } } } } while (0)
struct XcdBarrier { unsigned* bar; unsigned x; volatile LAS unsigned* st; };
__device__ __forceinline__ XcdBarrier xcd_barrier_post(unsigned* bar, volatile LAS unsigned* st) {
    XcdBarrier b; b.bar = bar; b.x = xb_xcc_id(); b.st = st;
    if (threadIdx.x == 0) (void)xb_add(&bar[XB_XCNT(b.x)], 1u);
    return b;
}
__device__ __forceinline__ void xcd_barrier_complete(unsigned* bar, unsigned x, unsigned& nloc, unsigned& nx) {
    const unsigned G = gridDim.x * gridDim.y * gridDim.z;
    unsigned sum, cnt, mine, sp = 0u;
    for (;;) {
        sum = 0u; cnt = 0u; mine = 0u;
#pragma unroll
        for (unsigned j = 0; j < 16; ++j) { const unsigned c = xb_ld(&bar[XB_XCNT(j)]); sum += c; cnt += (c > 0u) ? 1u : 0u; mine = (j == x) ? c : mine; }
        if (sum == G) break;
        __builtin_amdgcn_s_sleep(1);
        if ((++sp & 255u) == 0u) { if (xb_ld(&bar[XB_TMO])) break; if (sp > XB_SPIN_CAP) { atomicAdd(&bar[XB_TMO], 1u); break; } }
    }
    nloc = mine > 0u ? mine : 1u; nx = cnt > 0u ? cnt : 1u;
}
__device__ __forceinline__ void xcd_barrier(const XcdBarrier& b) {
    asm volatile("s_waitcnt vmcnt(0)" ::: "memory");
    __syncthreads();
    if (threadIdx.x == 0) {
        unsigned* bar = b.bar;
        __builtin_amdgcn_s_waitcnt(0);
        unsigned nloc = b.st[0], nx = b.st[1];
        if (nloc == 0u) { xcd_barrier_complete(bar, b.x, nloc, nx); b.st[0] = nloc; b.st[1] = nx; }
        const unsigned old = xb_add(&bar[XB_XSUB(b.x)], 1u);
        const unsigned gen = old / nloc;
        bool released = false;
        if (old + 1u == (gen + 1u) * nloc) {
            __builtin_amdgcn_fence(__ATOMIC_RELEASE, "agent");
            asm volatile("s_waitcnt vmcnt(0)" ::: "memory");
            const unsigned og = xb_add(&bar[XB_TOP], 1u);
            const unsigned tg = og / nx;
            if (og + 1u == (tg + 1u) * nx) {
#pragma unroll
                for (unsigned j = 0; j < 16; ++j) xb_add(&bar[XB_XGEN(j)], 1u);
                released = true;
            }
        }
        __builtin_amdgcn_fence(__ATOMIC_ACQUIRE, "agent");
        if (!released) XB_SPIN(xb_ld(&bar[XB_XGEN(b.x)]) == gen, bar);
        asm volatile("s_waitcnt vmcnt(0)" ::: "memory");
    }
    __syncthreads();
}

namespace pg8 {
constexpr int BM = 256, BK = 64, HALF = 128, HTB = HALF * BK * 2, STAGE_BYTES = 8 * HTB, NXCD = 8, WGM = 8;
__device__ __forceinline__ int lds_byte(int r, int c) { const int st = (r >> 4) * 2 + (c >> 5), rr = r & 15, cc = c & 31, ob = rr * 64 + cc * 2; return st * 1024 + (ob ^ (((ob >> 9) & 1) << 5)); }
__device__ __forceinline__ void stage_rc(int b, int& R, int& C) { const int st = b / 1024, sb = b % 1024, swz = sb ^ (((sb >> 9) & 1) << 5); R = (st >> 1) * 16 + swz / 64; C = (st & 1) * 32 + (swz % 64) / 2; }
__device__ __forceinline__ int perm32(int rho) { const int n = rho >> 4, i = rho & 15; return 8 * (i >> 2) + 4 * n + (i & 3); }
struct Unit { int pm, pn, aux, aux2; };
__device__ __forceinline__ i32x8 cat8(bf16x8 a, bf16x8 b) { const i32x4 x = __builtin_bit_cast(i32x4, a), y = __builtin_bit_cast(i32x4, b); return __builtin_shufflevector(x, y, 0, 1, 2, 3, 4, 5, 6, 7); }

__device__ __forceinline__ void static_unit(int L, int nM, int nN, Unit& u) {
    const int nwg = nM * nN;
    int wgid = L; { const int q = nwg / NXCD, r = nwg % NXCD, xcd = wgid % NXCD, off = wgid / NXCD; wgid = (xcd < r ? xcd * (q + 1) : r * (q + 1) + (xcd - r) * q) + off; }
    const int nig = WGM * nN, gid = wgid / nig, fm = gid * WGM, gsz = (nM - fm) < WGM ? (nM - fm) : WGM;
    u.pm = fm + ((wgid % nig) % gsz); u.pn = (wgid % nig) / gsz; u.aux = 0; u.aux2 = 0;
}

__device__ __forceinline__ void stage2(const char* sbase, unsigned v0, unsigned v1, unsigned lds0) {
    unsigned sv;
    asm volatile("s_mov_b32 %0, m0\n\ts_mov_b32 m0, %4\n\ts_nop 0\n\tglobal_load_lds_dwordx4 %1, %3\n\ts_mov_b32 m0, %5\n\ts_nop 0\n\tglobal_load_lds_dwordx4 %2, %3\n\ts_mov_b32 m0, %0"
                 : "=&s"(sv) : "v"(v0), "v"(v1), "s"(sbase), "s"(lds0), "s"(lds0 + 8192u) : "memory");
}
template <class Epi, class Sched>
__device__ __forceinline__ void gemm_phase(LAS unsigned char* lds, const Sched& S, const Epi& E) {
    const int tid = otid(), wid = __builtin_amdgcn_readfirstlane(tid >> 6), lane = tid & 63, wr = wid >> 2, wc = wid & 3, fr = lane & 15, fq = lane >> 4;
    int nt_ = S.nt; asm volatile("" : "+s"(nt_));
    const int nt = nt_;
    int sR[2], sC[2];
    unsigned vB[2][2];
#pragma unroll
    for (int i = 0; i < 2; ++i) { stage_rc(tid * 16 + i * 8192, sR[i], sC[i]); const int Rb = Epi::PERM ? ((sR[i] & ~31) + perm32(sR[i] & 31)) : sR[i];
#pragma unroll
        for (int h = 0; h < 2; ++h) vB[h][i] = (unsigned)(h * HALF + Rb) * S.ldb + (unsigned)sC[i] * 2u; }
    const size_t kstepA = S.kstepA, kstepB = S.kstepB;
    const unsigned ldsb = (unsigned)__builtin_amdgcn_readfirstlane((int)((unsigned)(unsigned long)lds + (unsigned)wid * 1024u));
    const int aoff = lds_byte(wr * 64 + fr, fq * 8), boff = lds_byte(wc * 32 + fr, fq * 8);
#define PG8_SA(b, h) (((b) * 2 + (h)) * HTB)
#define PG8_SB(b, h) ((4 + (b) * 2 + (h)) * HTB)
#define PG8_STAGE(bufoff, gbase, v0, v1) stage2((const char*)(gbase), (v0), (v1), ldsb + (unsigned)(bufoff))
#define PG8_LDA(dst, b, h) do { if constexpr (Sched::F8) { _Pragma("unroll") for (int m = 0; m < 4; ++m) { dst##8[m].lo = *(const LAS i32x4*)(lds + PG8_SA(b, h) + aoff + m * 2048); dst##8[m].hi = *(const LAS i32x4*)(lds + PG8_SA(b, h) + aoff + m * 2048 + 1024); } } \
        else { _Pragma("unroll") for (int m = 0; m < 4; ++m) _Pragma("unroll") for (int k = 0; k < 2; ++k) dst[m][k] = *(const LAS bf16x8*)(lds + PG8_SA(b, h) + aoff + m * 2048 + k * 1024); } } while (0)
#define PG8_LDB(dst, b, h) do { if constexpr (Sched::F8) { _Pragma("unroll") for (int n = 0; n < 2; ++n) { dst##8[n].lo = *(const LAS i32x4*)(lds + PG8_SB(b, h) + boff + n * 2048); dst##8[n].hi = *(const LAS i32x4*)(lds + PG8_SB(b, h) + boff + n * 2048 + 1024); } } \
        else { _Pragma("unroll") for (int n = 0; n < 2; ++n) _Pragma("unroll") for (int k = 0; k < 2; ++k) dst[n][k] = *(const LAS bf16x8*)(lds + PG8_SB(b, h) + boff + n * 2048 + k * 1024); } } while (0)
#define PG8_MMA(ai, bj, At, Bt) do { __builtin_amdgcn_s_setprio(1); \
        if constexpr (Sched::F8) { _Pragma("unroll") for (int m = 0; m < 4; ++m) _Pragma("unroll") for (int n = 0; n < 2; ++n) \
            acc[ai][bj][m][n] = __builtin_amdgcn_mfma_scale_f32_16x16x128_f8f6f4(Bt##8[n], At##8[m], acc[ai][bj][m][n], 0, 0, 0, 0, 0, 0); } \
        else if constexpr (Sched::I8) { _Pragma("unroll") for (int m = 0; m < 4; ++m) _Pragma("unroll") for (int n = 0; n < 2; ++n) _Pragma("unroll") for (int k = 0; k < 2; ++k) \
            acc[ai][bj][m][n] = __builtin_bit_cast(f32x4, __builtin_amdgcn_mfma_i32_16x16x64_i8(__builtin_bit_cast(i32x4, Bt[n][k]), __builtin_bit_cast(i32x4, At[m][k]), __builtin_bit_cast(i32x4, acc[ai][bj][m][n]), 0, 0, 0)); } \
        else { _Pragma("unroll") for (int m = 0; m < 4; ++m) _Pragma("unroll") for (int n = 0; n < 2; ++n) _Pragma("unroll") for (int k = 0; k < 2; ++k) \
            acc[ai][bj][m][n] = __builtin_amdgcn_mfma_f32_16x16x32_bf16(Bt[n][k], At[m][k], acc[ai][bj][m][n], 0, 0, 0); } \
        __builtin_amdgcn_s_setprio(0); } while (0)
#define PG8_WAIT_V(n) asm volatile("s_waitcnt vmcnt(" #n ")" ::: "memory")
#define PG8_WAIT_L(n) asm volatile("s_waitcnt lgkmcnt(" #n ")" ::: "memory")
#define PG8_BAR __builtin_amdgcn_s_barrier()
#define PG8_SCHED __builtin_amdgcn_sched_barrier(0)
    Unit cur, nxt; int ui = 0; int prev_code = -1;
    if (!S.next(0, cur)) return;
    f32x4 acc[2][2][4][2];
#pragma unroll
    for (int a = 0; a < 2; ++a)
#pragma unroll
        for (int b = 0; b < 2; ++b)
#pragma unroll
            for (int m = 0; m < 4; ++m)
#pragma unroll
                for (int n = 0; n < 2; ++n) acc[a][b][m][n] = (f32x4){0.f, 0.f, 0.f, 0.f};
    bf16x8 At[4][2], B0[2][2], B1[2][2]; i32x8 At8[4], B08[2], B18[2];
    unsigned vA[2][2], vN[2][2];
#pragma unroll
    for (int h = 0; h < 2; ++h)
#pragma unroll
        for (int i = 0; i < 2; ++i) { vA[h][i] = S.aoff(cur, h * HALF + sR[i], sC[i]); vN[h][i] = vA[h][i]; }
    const char* cA = S.abase(cur); const char* cB = S.bbase(cur);
    S.a_ready(cur);
    PG8_STAGE(PG8_SB(0, 0), cB, vB[0][0], vB[0][1]); PG8_STAGE(PG8_SA(0, 0), cA, vA[0][0], vA[0][1]); PG8_STAGE(PG8_SB(0, 1), cB, vB[1][0], vB[1][1]); PG8_STAGE(PG8_SA(0, 1), cA, vA[1][0], vA[1][1]);
    if (wr == 1) PG8_BAR;
    PG8_WAIT_V(4); PG8_BAR;
    PG8_STAGE(PG8_SB(1, 0), cB + kstepB, vB[0][0], vB[0][1]); PG8_STAGE(PG8_SA(1, 0), cA + kstepA, vA[0][0], vA[0][1]); PG8_STAGE(PG8_SB(1, 1), cB + kstepB, vB[1][0], vB[1][1]);
    PG8_WAIT_V(6); PG8_BAR;
    for (;;) {
        const bool has_next = S.next(ui + 1, nxt);
        const char* nA = has_next ? S.abase(nxt) : cA; const char* nB = has_next ? S.bbase(nxt) : cB;
        if (Sched::DYN_A && has_next) {
#pragma unroll
            for (int h = 0; h < 2; ++h)
#pragma unroll
                for (int i = 0; i < 2; ++i) vN[h][i] = S.aoff(nxt, h * HALF + sR[i], sC[i]);
        }
        asm volatile(".p2align 8" ::: );
#pragma unroll 1
        for (int t = 0; t < nt; t += 2) {
            const bool last = (t == nt - 2);
            const char* a1 = cA + (size_t)(t + 1) * kstepA;
            const char* a2 = last ? nA : cA + (size_t)(t + 2) * kstepA; const char* b2 = last ? nB : cB + (size_t)(t + 2) * kstepB;
            const char* a3 = a2 + kstepA; const char* b3 = b2 + kstepB;
            if (last && has_next) S.a_ready(nxt);
            PG8_LDB(B0, 0, 0); PG8_SCHED; PG8_LDA(At, 0, 0); PG8_STAGE(PG8_SA(1, 1), a1, vA[1][0], vA[1][1]);
            if (Sched::DYN_A && last) {
#pragma unroll
                for (int h = 0; h < 2; ++h)
#pragma unroll
                    for (int i = 0; i < 2; ++i) vA[h][i] = vN[h][i]; }
            PG8_WAIT_L(8); PG8_BAR; PG8_WAIT_L(0); PG8_MMA(0, 0, At, B0); PG8_BAR; PG8_SCHED;
            PG8_LDB(B1, 0, 1); PG8_STAGE(PG8_SB(0, 0), b2, vB[0][0], vB[0][1]);
            PG8_BAR; PG8_WAIT_L(0); PG8_MMA(0, 1, At, B1); PG8_BAR;
            PG8_LDA(At, 0, 1); PG8_STAGE(PG8_SA(0, 0), a2, vA[0][0], vA[0][1]);
            PG8_BAR; PG8_WAIT_L(0); PG8_MMA(1, 0, At, B0); PG8_BAR; PG8_SCHED;
            PG8_STAGE(PG8_SB(0, 1), b2, vB[1][0], vB[1][1]);
            PG8_WAIT_V(6); PG8_BAR; PG8_MMA(1, 1, At, B1); PG8_BAR;
            PG8_LDB(B0, 1, 0); PG8_SCHED; PG8_LDA(At, 1, 0); PG8_STAGE(PG8_SA(0, 1), a2, vA[1][0], vA[1][1]);
            PG8_WAIT_L(8); PG8_BAR; PG8_WAIT_L(0); PG8_MMA(0, 0, At, B0); PG8_BAR; PG8_SCHED;
            PG8_LDB(B1, 1, 1); PG8_STAGE(PG8_SB(1, 0), b3, vB[0][0], vB[0][1]);
            PG8_BAR; PG8_WAIT_L(0); PG8_MMA(0, 1, At, B1); PG8_BAR;
            PG8_LDA(At, 1, 1); PG8_STAGE(PG8_SA(1, 0), a3, vA[0][0], vA[0][1]);
            PG8_BAR; PG8_WAIT_L(0); PG8_MMA(1, 0, At, B0); PG8_BAR; PG8_SCHED;
            PG8_STAGE(PG8_SB(1, 1), b3, vB[1][0], vB[1][1]);
            PG8_WAIT_V(6); PG8_BAR; PG8_MMA(1, 1, At, B1); PG8_BAR;
            if (Sched::PUBLISH && prev_code >= 0) { S.done(prev_code); prev_code = -1; }
        }
        if constexpr (Sched::I8) {
#pragma unroll
            for (int a = 0; a < 2; ++a)
#pragma unroll
                for (int b = 0; b < 2; ++b)
#pragma unroll
                    for (int m = 0; m < 4; ++m)
#pragma unroll
                        for (int n = 0; n < 2; ++n) { const i32x4 iv = __builtin_bit_cast(i32x4, acc[a][b][m][n]); acc[a][b][m][n] = (f32x4){(float)iv[0], (float)iv[1], (float)iv[2], (float)iv[3]} * Sched::ISCALE; } }
        E(acc, cur, wr, wc, fr, fq); prev_code = Sched::PUBLISH ? (cur.pm | (cur.pn << 16)) : -1;
        if (!has_next) break;
#pragma unroll
        for (int a = 0; a < 2; ++a)
#pragma unroll
            for (int b = 0; b < 2; ++b)
#pragma unroll
                for (int m = 0; m < 4; ++m)
#pragma unroll
                    for (int n = 0; n < 2; ++n) acc[a][b][m][n] = (f32x4){0.f, 0.f, 0.f, 0.f};
        cur = nxt; cA = nA; cB = nB; ++ui;
    }
    PG8_WAIT_V(0);
    if (Sched::PUBLISH && prev_code >= 0) S.done(prev_code);
    if (wr == 0) PG8_BAR;
    PG8_BAR;
#undef PG8_SA
#undef PG8_SB
#undef PG8_STAGE
#undef PG8_LDA
#undef PG8_LDB
#undef PG8_MMA
#undef PG8_WAIT_V
#undef PG8_WAIT_L
#undef PG8_BAR
#undef PG8_SCHED
}
}
using pg8::Unit;

struct SchedPlain {
    static constexpr bool DYN_A = false;
    static constexpr bool F8 = false;
    static constexpr bool I8 = false;
    static constexpr float ISCALE = 1.0f;
    const char* A; const char* Bt; int K, nM, nN, G, c; int nt; unsigned kstepA, kstepB, ldb;
    __device__ __forceinline__ void init(const void* A_, const void* Bt_, int M, int N, int K_) { A = (const char*)A_; Bt = (const char*)Bt_; K = K_; nM = M / 256; nN = N / 256; G = gridDim.x; c = blockIdx.x; nt = K / 64; kstepA = 128; kstepB = 128; ldb = (unsigned)K * 2u; }
    __device__ __forceinline__ bool next(int i, Unit& u) const { const int L = i * G + c; if (L >= nM * nN) return false; pg8::static_unit(L, nM, nN, u); return true; }
    __device__ __forceinline__ const char* abase(const Unit& u) const { return A + (size_t)u.pm * 256 * K * 2; }
    __device__ __forceinline__ const char* bbase(const Unit& u) const { return Bt + (size_t)u.pn * 256 * K * 2; }
    __device__ __forceinline__ unsigned aoff(const Unit&, int row, int col) const { return (unsigned)(row * K + col) * 2u; }
    static constexpr bool PUBLISH = false;
    __device__ __forceinline__ void a_ready(const Unit&) const {}
    __device__ __forceinline__ void done(int) const {}
};
constexpr int ML_CNT = 131072, ML_PPRE = ML_CNT + 128, ML_PE = ML_PPRE + 256;
__device__ __forceinline__ int moe_tables(const char* ws, int layer, LAS unsigned char* lds) {
    const int tid = otid(); LAS int* cnt = (LAS int*)(lds + ML_CNT); LAS int* ppre = (LAS int*)(lds + ML_PPRE); LAS int* pe = (LAS int*)(lds + ML_PE);
    __syncthreads();
    if (tid < 32) cnt[tid] = ((const int*)(ws + WS_GCNT))[layer * 32 + tid];
    __syncthreads();
    if (tid == 0) { int s = 0; for (int e = 0; e < NEXP; ++e) { ppre[e] = s; s += (cnt[e] + 255) >> 8; } ppre[NEXP] = s; }
    __syncthreads();
    const int nM = ppre[NEXP];
    if (tid < nM) { int e = 0; for (int k = 1; k < NEXP; ++k) e += (ppre[k] <= tid) ? 1 : 0; pe[tid] = e; }
    __syncthreads();
    return nM;
}
struct SchedPlainF8 : SchedPlain {
    static constexpr bool F8 = true;
    static constexpr bool I8 = false;
    static constexpr float ISCALE = 1.0f;
    static constexpr bool DYN_A = true;
    __device__ __forceinline__ const char* abase(const Unit&) const { return A; }
    __device__ __forceinline__ unsigned aoff(const Unit& u, int row, int col) const { return (unsigned)((u.pm * 256 + row) * K + col) * 2u; }
};
struct SchedNsaProj : SchedPlain {
    static constexpr bool PUBLISH = true;
    unsigned* bcnt;
    __device__ __forceinline__ void done(int code) const { const int pm = code & 0xffff, pn = code >> 16;
        if ((pn == 4 || pn == 5) && (threadIdx.x & 63) == 0) __hip_atomic_fetch_add(bcnt + (pm >> 3) * 16, 1u, __ATOMIC_RELAXED, __HIP_MEMORY_SCOPE_AGENT); }
};
struct SchedPlainI8 : SchedPlain { static constexpr bool I8 = true; static constexpr float ISCALE = I8_INV; };
struct SchedNsaProjI8 : SchedNsaProj { static constexpr bool I8 = true; static constexpr float ISCALE = I8_INV; };
struct SchedMoeGU {
    static constexpr bool DYN_A = true;
    static constexpr bool F8 = true;
    static constexpr bool I8 = false;
    static constexpr float ISCALE = 1.0f;
    const char* X; const char* W; const int* tokof; LAS unsigned char* lds; int nM, G, c; int nt; unsigned kstepA, kstepB, ldb;
    __device__ __forceinline__ void init(const char* ws, int layer, LAS unsigned char* lds_) { lds = lds_; nM = moe_tables(ws, layer, lds_); X = ws + WS_X1Q; W = ws + WS_GU; tokof = (const int*)(ws + WS_ROWTOK); G = gridDim.x; c = blockIdx.x; nt = 8; kstepA = 128; kstepB = 128; ldb = 1024; }
    __device__ __forceinline__ bool next(int i, Unit& u) const { const int L = i * G + c; if (L >= nM * 4) return false; pg8::static_unit(L, nM, 4, u);
        const int e = ((const LAS int*)(lds + ML_PE))[u.pm]; u.aux = e | ((u.pm - ((const LAS int*)(lds + ML_PPRE))[e]) << 16); u.aux2 = ((const LAS int*)(lds + ML_CNT))[e]; return true; }
    __device__ __forceinline__ const char* abase(const Unit&) const { return X; }
    __device__ __forceinline__ const char* bbase(const Unit& u) const { return W + ((size_t)(u.aux & 255) * 1024 + (size_t)u.pn * 256) * 1024; }
    __device__ __forceinline__ unsigned aoff(const Unit& u, int row, int col) const { const int slot = (u.aux >> 16) * 256 + row; const int sl = slot < u.aux2 ? slot : 0;
        return (unsigned)tokof[(u.aux & 255) * 65536 + sl] * 1024u + (unsigned)col * 2u; }
    static constexpr bool PUBLISH = false;
    __device__ __forceinline__ void a_ready(const Unit&) const {}
    __device__ __forceinline__ void done(int) const {}
};
struct SchedMoeDN {
    static constexpr bool DYN_A = true;
    static constexpr bool F8 = true;
    static constexpr bool I8 = false;
    static constexpr float ISCALE = 1.0f;
    const char* H; const char* W; LAS unsigned char* lds; int nM, G, c; int nt; unsigned kstepA, kstepB, ldb;
    __device__ __forceinline__ void init(const char* ws, int layer, LAS unsigned char* lds_) { lds = lds_; nM = moe_tables(ws, layer, lds_); H = ws + WS_AOH; W = ws + WS_DN + (layer ? DN1_OFF : 0); G = gridDim.x; c = blockIdx.x; nt = 4; kstepA = 128; kstepB = 128; ldb = 512; }
    __device__ __forceinline__ bool next(int i, Unit& u) const { const int L = i * G + c; if (L >= nM * 4) return false; pg8::static_unit(L, nM, 4, u); u.aux = ((const LAS int*)(lds + ML_PE))[u.pm]; u.aux2 = 0; return true; }
    __device__ __forceinline__ const char* abase(const Unit&) const { return H; }
    __device__ __forceinline__ const char* bbase(const Unit& u) const { return W + ((size_t)u.aux * 1024 + (size_t)u.pn * 256) * 512; }
    __device__ __forceinline__ unsigned aoff(const Unit& u, int row, int col) const { return (unsigned)((u.pm * 256 + row) * 512 + col * 2); }
    static constexpr bool PUBLISH = false;
    __device__ __forceinline__ void a_ready(const Unit&) const {}
    __device__ __forceinline__ void done(int) const {}
};
struct SchedCmp {
    static constexpr bool DYN_A = false;
    static constexpr bool F8 = false;
    static constexpr bool I8 = true;
    static constexpr float ISCALE = I8_INVC;
    static constexpr bool PUBLISH = false;
    const char* Q; const char* W; unsigned* bcnt; unsigned* tmo; int c; int nt; unsigned kstepA, kstepB, ldb;
    __device__ __forceinline__ void init(const char* ws) { Q = ws + WS_BIG; W = ws + WS_W1T; bcnt = (unsigned*)(ws + WS_BCNT); tmo = (unsigned*)(ws + WS_CTL) + XB_TMO; c = (int)blockIdx.x - 128; nt = 8; kstepA = 2 * NSA_LD * 2; kstepB = 128; ldb = 2048; }
    __device__ __forceinline__ bool next(int i, Unit& u) const { if (c < 0 || i >= 1 || gridDim.x != 256) return false; const int L = c; u.aux = L >> 6; u.aux2 = 0; u.pm = (L >> 1) & 31; u.pn = L & 1; return true; }
    __device__ __forceinline__ const char* abase(const Unit& u) const { return Q + (size_t)(u.aux ? 5 : 4) * 512 + (size_t)u.pn * 16 * (NSA_LD * 2); }
    __device__ __forceinline__ const char* bbase(const Unit& u) const { return W + (size_t)u.aux * 256 * 2048 + (size_t)u.pn * 1024; }
    __device__ __forceinline__ unsigned aoff(const Unit& u, int row, int col) const {
        const int m = u.pm * 256 + row, bh = m >> 7, n = m & 127, nn = n > 126 ? 126 : n, b = bh >> 2, hkv = bh & 3;
        return (unsigned)(b * SEQ + 16 * nn + (col >> 5)) * (unsigned)(NSA_LD * 2) + (unsigned)(hkv * 64 + (col & 31) * 2); }
    __device__ __forceinline__ void a_ready(const Unit& u) const {
        if (threadIdx.x < 64) { unsigned polls = 0; unsigned* w = bcnt + (u.pm >> 1) * 16;
            while ((unsigned)__builtin_amdgcn_readfirstlane((int)__hip_atomic_load(w, __ATOMIC_RELAXED, __HIP_MEMORY_SCOPE_AGENT)) < 128u) {
                __builtin_amdgcn_s_sleep(2);
                if ((++polls & 255u) == 0u) { if (__builtin_amdgcn_readfirstlane((int)__hip_atomic_load(tmo, __ATOMIC_RELAXED, __HIP_MEMORY_SCOPE_AGENT)) != 0) break;
                    if (polls > (1u << 18)) { if (threadIdx.x == 0) __hip_atomic_fetch_add(tmo, 1u, __ATOMIC_RELAXED, __HIP_MEMORY_SCOPE_AGENT); break; } } }
            __builtin_amdgcn_fence(__ATOMIC_ACQUIRE, "agent");
            asm volatile("s_waitcnt vmcnt(0)" ::: "memory"); }
        asm volatile("" ::: "memory"); __builtin_amdgcn_s_barrier(); asm volatile("" ::: "memory");
    }
    __device__ __forceinline__ void done(int) const {}
};

struct EpiQKV0 {
    static constexpr bool PERM = true;
    bf16_t* O; float* kpart;
    __device__ __forceinline__ void operator()(const f32x4 (&acc)[2][2][4][2], const Unit& u, int wr, int wc, int fr, int fq) const {
        const int row0 = u.pm * 256 + wr * 64 + fr, col0 = u.pn * 256 + wc * 32 + 8 * fq;
        const float sc = (u.pn < 4) ? C2 : 1.0f;
#pragma unroll
        for (int ai = 0; ai < 2; ++ai)
#pragma unroll
            for (int m = 0; m < 4; ++m) { bf16_t* rowp = O + (size_t)(row0 + ai * 128 + m * 16) * QKV_LD + col0;
#pragma unroll
                for (int bj = 0; bj < 2; ++bj) { const f32x4 v0 = acc[ai][bj][m][0] * sc, v1 = acc[ai][bj][m][1] * sc;
                    u32x4 w; w.x = cvt_pk_bf16(v0[0], v0[1]); w.y = cvt_pk_bf16(v0[2], v0[3]); w.z = cvt_pk_bf16(v1[0], v1[1]); w.w = cvt_pk_bf16(v1[2], v1[3]);
                    *(u32x4*)(rowp + bj * 128) = w; } }
        if (u.pn >= 4 && u.pn < 8) {
#pragma unroll
            for (int bj = 0; bj < 2; ++bj)
#pragma unroll
                for (int n = 0; n < 2; ++n) { f32x4 s = (f32x4){0.f, 0.f, 0.f, 0.f};
#pragma unroll
                    for (int ai = 0; ai < 2; ++ai)
#pragma unroll
                        for (int m = 0; m < 4; ++m) s += acc[ai][bj][m][n];
#pragma unroll
                    for (int j = 0; j < 4; ++j) { float v = s[j]; v += __shfl_xor(v, 1); v += __shfl_xor(v, 2); v += __shfl_xor(v, 4); v += __shfl_xor(v, 8); s[j] = v; }
                    if (fr == 0) *(f32x4*)(kpart + ((size_t)u.pm * 2 + wr) * 1024 + (u.pn - 4) * 256 + bj * 128 + wc * 32 + 8 * fq + 4 * n) = s; }
        }
    }
};
struct EpiNull {
    static constexpr bool PERM = true;
    float* sink;
    __device__ __forceinline__ void operator()(const f32x4 (&acc)[2][2][4][2], const Unit& u, int wr, int wc, int fr, int fq) const {
        float s = 0.f;
#pragma unroll
        for (int ai = 0; ai < 2; ++ai)
#pragma unroll
            for (int bj = 0; bj < 2; ++bj)
#pragma unroll
                for (int m = 0; m < 4; ++m)
#pragma unroll
                    for (int n = 0; n < 2; ++n) s += acc[ai][bj][m][n][0] + acc[ai][bj][m][n][3];
        if (s == 12345.678f) sink[u.pm + wr + wc + fr + fq] = s;
    }
};
struct EpiNSA {
    static constexpr bool PERM = true;
    bf16_t* O;
    __device__ __forceinline__ void operator()(const f32x4 (&acc)[2][2][4][2], const Unit& u, int wr, int wc, int fr, int fq) const {
        const int row0 = u.pm * 256 + wr * 64 + fr, col0 = u.pn * 256 + wc * 32 + 8 * fq;
        const float sc = (u.pn < 4) ? C2 : 1.0f; const bool sg = (u.pn == 10), wt = (u.pn == 4 || u.pn == 5);
        const auto rsrc = __builtin_amdgcn_make_buffer_rsrc((void*)O, 0, (int)((size_t)NTOK * NSA_LD * 2), 0x00020000);
#pragma unroll
        for (int ai = 0; ai < 2; ++ai)
#pragma unroll
            for (int m = 0; m < 4; ++m) { bf16_t* rowp = O + (size_t)(row0 + ai * 128 + m * 16) * NSA_LD + col0;
#pragma unroll
                for (int bj = 0; bj < 2; ++bj) { f32x4 v0 = acc[ai][bj][m][0] * sc, v1 = acc[ai][bj][m][1] * sc;
                    if (sg) {
#pragma unroll
                        for (int j = 0; j < 4; ++j) { v0[j] = __builtin_amdgcn_rcpf(1.0f + __builtin_amdgcn_exp2f(-LOG2E * v0[j])); v1[j] = __builtin_amdgcn_rcpf(1.0f + __builtin_amdgcn_exp2f(-LOG2E * v1[j])); } }
                    u32x4 w; w.x = cvt_pk_bf16(v0[0], v0[1]); w.y = cvt_pk_bf16(v0[2], v0[3]); w.z = cvt_pk_bf16(v1[0], v1[1]); w.w = cvt_pk_bf16(v1[2], v1[3]);
                    if (wt) { u32x2 w8; w8.x = cvt4_i8(v0[0] * I8_SKC, v0[1] * I8_SKC, v0[2] * I8_SKC, v0[3] * I8_SKC); w8.y = cvt4_i8(v1[0] * I8_SKC, v1[1] * I8_SKC, v1[2] * I8_SKC, v1[3] * I8_SKC);
                        __builtin_amdgcn_raw_buffer_store_b64(w8, rsrc, (int)((unsigned)(row0 + ai * 128 + m * 16) * (unsigned)(NSA_LD * 2) + (unsigned)(u.pn * 512 + wc * 32 + 8 * fq + bj * 128)), 0, 16); }
                    else *(u32x4*)(rowp + bj * 128) = w; } }
    }
};
template <bool RES_F32, bool F8O = false> struct EpiRes {
    static constexpr bool PERM = true;
    bf16_t* O; const float* rf; const bf16_t* rb;
    __device__ __forceinline__ void operator()(const f32x4 (&acc)[2][2][4][2], const Unit& u, int wr, int wc, int fr, int fq) const {
        const int row0 = u.pm * 256 + wr * 64 + fr, col0 = u.pn * 256 + wc * 32 + 8 * fq;
#pragma unroll
        for (int ai = 0; ai < 2; ++ai) {
            if (RES_F32) {
#pragma unroll
                for (int mh = 0; mh < 2; ++mh) { f32x4 r[2][2][2];
#pragma unroll
                    for (int m2 = 0; m2 < 2; ++m2)
#pragma unroll
                        for (int bj = 0; bj < 2; ++bj) { const size_t ro = (size_t)(row0 + ai * 128 + (mh * 2 + m2) * 16) * 1024 + col0 + bj * 128; r[m2][bj][0] = *(const f32x4*)(rf + ro); r[m2][bj][1] = *(const f32x4*)(rf + ro + 4); }
#pragma unroll
                    for (int m2 = 0; m2 < 2; ++m2)
#pragma unroll
                        for (int bj = 0; bj < 2; ++bj) { const int m = mh * 2 + m2; const size_t ro = (size_t)(row0 + ai * 128 + m * 16) * 1024 + col0 + bj * 128;
                            const f32x4 v0 = acc[ai][bj][m][0] + r[m2][bj][0] * ALPHA, v1 = acc[ai][bj][m][1] + r[m2][bj][1] * ALPHA;
                            u32x4 w; w.x = cvt_pk_bf16(v0[0], v0[1]); w.y = cvt_pk_bf16(v0[2], v0[3]); w.z = cvt_pk_bf16(v1[0], v1[1]); w.w = cvt_pk_bf16(v1[2], v1[3]);
                            *(u32x4*)(O + ro) = w; } }
            } else {
                u32x4 r[4][2];
#pragma unroll
                for (int m = 0; m < 4; ++m)
#pragma unroll
                    for (int bj = 0; bj < 2; ++bj) r[m][bj] = *(const u32x4*)(rb + (size_t)(row0 + ai * 128 + m * 16) * 1024 + col0 + bj * 128);
#pragma unroll
                for (int m = 0; m < 4; ++m)
#pragma unroll
                    for (int bj = 0; bj < 2; ++bj) { const size_t ro = (size_t)(row0 + ai * 128 + m * 16) * 1024 + col0 + bj * 128; const u32x4 rw = r[m][bj];
                        const f32x4 r0 = (f32x4){lo_bf(rw.x), hi_bf(rw.x), lo_bf(rw.y), hi_bf(rw.y)}, r1 = (f32x4){lo_bf(rw.z), hi_bf(rw.z), lo_bf(rw.w), hi_bf(rw.w)};
                        const f32x4 v0 = (F8O ? acc[ai][bj][m][0] * F8_INVO : acc[ai][bj][m][0]) + r0 * ALPHA, v1 = (F8O ? acc[ai][bj][m][1] * F8_INVO : acc[ai][bj][m][1]) + r1 * ALPHA;
                        u32x4 w; w.x = cvt_pk_bf16(v0[0], v0[1]); w.y = cvt_pk_bf16(v0[2], v0[3]); w.z = cvt_pk_bf16(v1[0], v1[1]); w.w = cvt_pk_bf16(v1[2], v1[3]);
                        *(u32x4*)(O + ro) = w; }
            }
        }
    }
};
struct EpiGU {
    static constexpr bool PERM = true;
    unsigned char* O;
    __device__ __forceinline__ void operator()(const f32x4 (&acc)[2][2][4][2], const Unit& u, int wr, int wc, int fr, int fq) const {
        const int row0 = u.pm * 256 + wr * 64 + fr, col0 = u.pn * 128 + wc * 32 + 8 * fq;
#pragma unroll
        for (int ai = 0; ai < 2; ++ai)
#pragma unroll
            for (int m = 0; m < 4; ++m) { float h[8];
#pragma unroll
                for (int n = 0; n < 2; ++n)
#pragma unroll
                    for (int j = 0; j < 4; ++j) { const float g = acc[ai][0][m][n][j] * F8_INV, up = acc[ai][1][m][n][j] * (F8_INV * F8_SX); h[n * 4 + j] = g * up * __builtin_amdgcn_rcpf(1.0f + __builtin_amdgcn_exp2f(-LOG2E * g)); }
                u32x2 w; w.x = cvt4_fp8(h[0], h[1], h[2], h[3]); w.y = cvt4_fp8(h[4], h[5], h[6], h[7]);
                *(u32x2*)(O + (size_t)(row0 + ai * 128 + m * 16) * 512 + col0) = w; }
    }
};
struct EpiDN {
    static constexpr bool PERM = true;
    unsigned char* O;
    __device__ __forceinline__ void operator()(const f32x4 (&acc)[2][2][4][2], const Unit& u, int wr, int wc, int fr, int fq) const {
        const int row0 = u.pm * 256 + wr * 64 + fr, col0 = u.pn * 256 + wc * 32 + 8 * fq; constexpr float s = F8_INV * F8_SY;
#pragma unroll
        for (int ai = 0; ai < 2; ++ai)
#pragma unroll
            for (int m = 0; m < 4; ++m) { unsigned char* rowp = O + (size_t)(row0 + ai * 128 + m * 16) * 1024 + col0;
#pragma unroll
                for (int bj = 0; bj < 2; ++bj) { const f32x4 v0 = acc[ai][bj][m][0] * s, v1 = acc[ai][bj][m][1] * s;
                    u32x2 w; w.x = cvt4_fp8(v0[0], v0[1], v0[2], v0[3]); w.y = cvt4_fp8(v1[0], v1[1], v1[2], v1[3]);
                    *(u32x2*)(rowp + bj * 128) = w; } }
    }
};
struct EpiCmp {
    static constexpr bool PERM = false;
    float* CP;
    __device__ __forceinline__ void operator()(const f32x4 (&acc)[2][2][4][2], const Unit& u, int wr, int wc, int fr, int fq) const {
        float* base = CP + ((size_t)(u.aux * 2 + u.pn) * 8192 + (size_t)u.pm * 256) * 256;
        const int row0 = wr * 64 + fr, col0 = wc * 32 + 4 * fq;
#pragma unroll
        for (int ai = 0; ai < 2; ++ai)
#pragma unroll
            for (int m = 0; m < 4; ++m) { float* rowp = base + (size_t)(row0 + ai * 128 + m * 16) * 256 + col0;
#pragma unroll
                for (int bj = 0; bj < 2; ++bj)
#pragma unroll
                    for (int n = 0; n < 2; ++n) *(f32x4*)(rowp + bj * 128 + n * 16) = acc[ai][bj][m][n]; }
    }
};

constexpr int AL_K = 0  , AL_V = 24576  , AL_BIAS = 57344  , AL_KM = AL_BIAS + 4 * BT_H * 4, AL_IMP = AL_KM + 2048  , AL_CMP = AL_IMP + 33792  , AL_SEL = AL_CMP + 32768, AL_LIST = AL_SEL + 512, AL_END = AL_LIST + 256;
static_assert(AL_END <= LDS_BYTES, "attention LDS map");
static_assert(AL_END <= LDS_BYTES - 16 && 4 * 64 * 33 * 4 <= 65536, "attention LDS map");
#define MFMA32(a, b, c) __builtin_amdgcn_mfma_f32_32x32x16_bf16(a, b, c, 0, 0, 0)
__device__ __forceinline__ s16x4 vtr(lds_cptr p) { return __builtin_bit_cast(s16x4, __builtin_amdgcn_ds_read_tr16_b64_v4i16((LAS v4i16_t*)p)); }
__device__ __forceinline__ float xhalf_max(float m) { auto rr = __builtin_amdgcn_permlane32_swap(__float_as_uint(m), __float_as_uint(m), false, false); return __builtin_fmaxf(__uint_as_float(rr[0]), __uint_as_float(rr[1])); }
__device__ __forceinline__ float xhalf_sum(float m) { auto rr = __builtin_amdgcn_permlane32_swap(__float_as_uint(m), __float_as_uint(m), false, false); return __uint_as_float(rr[0]) + __uint_as_float(rr[1]); }
__device__ __forceinline__ float max16(const f32x16& p) { float a = __builtin_fmaxf(p[0], p[1]), b = __builtin_fmaxf(p[2], p[3]);
#pragma unroll
    for (int r = 4; r < 16; r += 4) { a = __builtin_fmaxf(a, __builtin_fmaxf(p[r], p[r + 1])); b = __builtin_fmaxf(b, __builtin_fmaxf(p[r + 2], p[r + 3])); }
    return __builtin_fmaxf(a, b); }

#define MX3(a, b, c) __builtin_fmaxf(__builtin_fmaxf((a), (b)), (c))
__device__ __forceinline__ float max32(const f32x16& p0, const f32x16& p1) {
    float a = MX3(p0[0], p0[1], p1[0]), b = MX3(p0[2], p0[3], p1[1]); a = MX3(a, p1[2], p1[3]);
#pragma unroll
    for (int r = 4; r < 16; r += 4) { a = MX3(a, p0[r], p0[r + 1]); b = MX3(b, p0[r + 2], p0[r + 3]); a = MX3(a, p1[r], p1[r + 1]); b = MX3(b, p1[r + 2], p1[r + 3]); }
    return __builtin_fmaxf(a, b); }
constexpr float FLASH_THR = 8.0f;
__device__ __forceinline__ void glds16(const void* g, unsigned lds_addr) {
    unsigned sv; asm volatile("s_mov_b32 %0, m0\n\ts_mov_b32 m0, %2\n\ts_nop 0\n\tglobal_load_lds_dwordx4 %1, off\n\ts_mov_b32 m0, %0" : "=&s"(sv) : "v"(g), "s"(lds_addr) : "memory"); }
__device__ __forceinline__ void dma_k(const bf16_t* src, int ld, LAS unsigned char* lds, int slot, int wid, int lane, int base = AL_K) {
    const int rl = lane >> 3, ch = lane & 7;
    glds16(src + (size_t)(wid * 8 + rl) * ld + ((ch ^ rl) * 8), (unsigned)__builtin_amdgcn_readfirstlane((int)((unsigned)(unsigned long)lds + base + slot * 8192 + wid * 1024))); }
__device__ __forceinline__ void dma_v(const bf16_t* src, int ld, LAS unsigned char* lds, int slot, int wid, int lane, int base = AL_V) {
    glds16(src + (size_t)(16 * (wid & 3) + (lane >> 2)) * ld + (wid >> 2) * 32 + (lane & 3) * 8, (unsigned)__builtin_amdgcn_readfirstlane((int)((unsigned)(unsigned long)lds + base + slot * 8192 + wid * 1024))); }

struct FState { float m, l; f32x16 o0, o1; };
__device__ __forceinline__ void fstate_reset(FState& s) { s.m = -1e30f; s.l = 0.f;
#pragma unroll
    for (int r = 0; r < 16; ++r) { s.o0[r] = 0.f; s.o1[r] = 0.f; } }

__device__ __forceinline__ int kchunk_off(int d0, int kx) { return (((2 * d0 + (kx >> 3)) ^ (kx & 7)) * 16); }
__device__ __forceinline__ void qk_tile(f32x16& c0, f32x16& c1, const bf16x8 (&qr)[4], lds_cptr kp, int kx) {
#pragma unroll
    for (int d0 = 0; d0 < 4; ++d0) { const bf16x8 k0 = *(const LAS bf16x8*)(kp + kchunk_off(d0, kx)), k1 = *(const LAS bf16x8*)(kp + kchunk_off(d0, kx) + 4096);
        c0 = MFMA32(k0, qr[d0], c0); c1 = MFMA32(k1, qr[d0], c1); }
}
__device__ __forceinline__ void pv_tile(f32x16& o0, f32x16& o1, const f32x16& p0, const f32x16& p1, lds_cptr vp) {
#pragma unroll
    for (int k = 0; k < 4; ++k) {
        const f32x16& ps = (k < 2) ? p0 : p1; const int b = 8 * (k & 1);
        const u32x4 pw = (u32x4){cvt_pk_bf16(ps[b], ps[b + 1]), cvt_pk_bf16(ps[b + 2], ps[b + 3]), cvt_pk_bf16(ps[b + 4], ps[b + 5]), cvt_pk_bf16(ps[b + 6], ps[b + 7])};
        const bf16x8 pf = __builtin_bit_cast(bf16x8, pw);
        { const s16x4 lo = vtr(vp + k * 1024), hi = vtr(vp + k * 1024 + 512);
          const bf16x8 vf = (bf16x8){lo[0], lo[1], lo[2], lo[3], hi[0], hi[1], hi[2], hi[3]}; o0 = MFMA32(vf, pf, o0); }
        { const s16x4 lo = vtr(vp + 4096 + k * 1024), hi = vtr(vp + 4096 + k * 1024 + 512);
          const bf16x8 vf = (bf16x8){lo[0], lo[1], lo[2], lo[3], hi[0], hi[1], hi[2], hi[3]}; o1 = MFMA32(vf, pf, o1); }
    }
}
struct TileP { int Dmin; bool rowok, run, win; };
__device__ __forceinline__ void load_kf(bf16x8 (&kf)[8], lds_cptr kp, int kx) {
#pragma unroll
    for (int d0 = 0; d0 < 4; ++d0) { kf[2 * d0] = *(const LAS bf16x8*)(kp + kchunk_off(d0, kx)); kf[2 * d0 + 1] = *(const LAS bf16x8*)(kp + kchunk_off(d0, kx) + 4096); } }
__device__ __forceinline__ void flash_qk(f32x16& c0, f32x16& c1, float& cf, const bf16x8 (&qr)[4], lds_cptr kp, int kx, const LAS float* btab, float cfar, int Dmin, int r32, int hi) {
    bf16x8 kf[8]; load_kf(kf, kp, kx);
    if (Dmin - 63 < 127) {
        const int s0 = (BT_N - 1 - 63) - (Dmin + r32 - 4 * hi), ksh = s0 & 3; cf = 0.f;
        const LAS f32x4* bp = (const LAS f32x4*)(btab + ksh * BT_S + (s0 - ksh));
#pragma unroll
        for (int g = 0; g < 4; ++g) { const f32x4 a = bp[2 * g], b = bp[8 + 2 * g];
#pragma unroll
            for (int i = 0; i < 4; ++i) { c0[4 * g + i] = a[i]; c1[4 * g + i] = b[i]; } }
#pragma unroll
        for (int d0 = 0; d0 < 4; ++d0) { c0 = MFMA32(kf[2 * d0], qr[d0], c0); c1 = MFMA32(kf[2 * d0 + 1], qr[d0], c1); }
    } else {
        cf = cfar;
        const f32x16 z = {0.f, 0.f, 0.f, 0.f, 0.f, 0.f, 0.f, 0.f, 0.f, 0.f, 0.f, 0.f, 0.f, 0.f, 0.f, 0.f};
        c0 = MFMA32(kf[0], qr[0], z); c1 = MFMA32(kf[1], qr[0], z);
#pragma unroll
        for (int d0 = 1; d0 < 4; ++d0) { c0 = MFMA32(kf[2 * d0], qr[d0], c0); c1 = MFMA32(kf[2 * d0 + 1], qr[d0], c1); }
    }
}
__device__ __forceinline__ void flash_sm(FState& st, f32x16& c0, f32x16& c1, float cf, const TileP& tp, int r32, int hi) {
    const int Dmin = tp.Dmin, Dl = Dmin + r32 - 4 * hi;
    if (tp.win && (Dmin + 31 >= 512)) {
#pragma unroll
        for (int r = 0; r < 16; ++r) { const int ko = (r & 3) + 8 * (r >> 2); if (Dl >= 512 + ko) c0[r] = -INFINITY; if (Dl >= 544 + ko) c1[r] = -INFINITY; }
    }
    float mx = xhalf_max(max32(c0, c1)) + cf;
    mx = tp.rowok ? mx : -INFINITY;
    if (__any(mx > st.m + FLASH_THR)) {
        const float mn = __builtin_fmaxf(st.m, mx); const float alpha = __builtin_amdgcn_exp2f(st.m - mn);
        st.m = mn; st.l *= alpha;
#pragma unroll
        for (int r = 0; r < 16; ++r) { st.o0[r] *= alpha; st.o1[r] *= alpha; }
    }
    const float msub = tp.rowok ? (st.m - cf) : INFINITY;
    float rs0 = 0.f, rs1 = 0.f;
#pragma unroll
    for (int r = 0; r < 16; ++r) { c0[r] = __builtin_amdgcn_exp2f(c0[r] - msub); c1[r] = __builtin_amdgcn_exp2f(c1[r] - msub); rs0 += c0[r]; rs1 += c1[r]; }
    st.l += rs0 + rs1;
}
template <int VAR, class Src, bool PRE = false>
__device__ __forceinline__ void attn_stream(Src& S, int NT, FState& st, const bf16x8 (&qr)[4], LAS unsigned char* lds, const LAS float* btab, float cfar, int wid, int lane, int r32, int hi) {
    const lds_cptr kp0 = (lds_cptr)lds + AL_K + r32 * 128; const int kx = (r32 & 7) | (hi << 3);
    const lds_cptr vp0 = (lds_cptr)lds + AL_V + ((lane >> 4) & 1) * 32 + (lane & 3) * 8 + (4 * hi + ((lane & 15) >> 2)) * 64;
    if (!PRE) { S.dma(0, 0, 0); if (NT > 1 && VAR != 5 && VAR != 6) S.dma(1, 1, 1); }
    if (VAR == 5) { asm volatile("s_waitcnt vmcnt(0)" ::: "memory"); __syncthreads(); }
    int sc = 0, sn = 2;
    S.prefetch(-1);
#pragma nounroll
    for (int t = 0; t < NT; ++t) {
        if (VAR != 5) { if (t + 1 < NT) asm volatile("s_waitcnt vmcnt(2)" ::: "memory"); else asm volatile("s_waitcnt vmcnt(0)" ::: "memory");
        __syncthreads(); }
        if (VAR != 5 && VAR != 6) { if (t + 2 < NT) S.dma_pre(t + 2, sn, sn); }
        const TileP tp = S.params(t);
        S.prefetch(t);
        if (tp.run) { f32x16 c0, c1; float cf;
            flash_qk(c0, c1, cf, qr, kp0 + sc * 8192, kx, btab, cfar, tp.Dmin, r32, hi);
            flash_sm(st, c0, c1, cf, tp, r32, hi);
            pv_tile(st.o0, st.o1, c0, c1, vp0 + sc * 8192); }
        S.after(t, st);
        sc = (sc == 2) ? 0 : sc + 1; sn = (sn == 2) ? 0 : sn + 1;
    }
}

__device__ __forceinline__ void conv_tile(const float* src, int N, bf16_t* dst, int ldd, int k0, int n0, int rowadd, int mode, LAS float* t, int lane) {
    f32x4 v[16];
#pragma unroll
    for (int i = 0; i < 16; ++i) { const int r = i * 4 + (lane >> 4), cc = n0 + (lane & 15) * 4;
        v[i] = (cc < N) ? __builtin_nontemporal_load((const f32x4*)(src + (size_t)(k0 + r) * N + cc)) : (f32x4){0.f, 0.f, 0.f, 0.f}; }
#pragma unroll
    for (int i = 0; i < 16; ++i) { const int r = i * 4 + (lane >> 4), cc = (lane & 15) * 4; LAS float* q = t + r * 65 + cc; q[0] = v[i][0]; q[1] = v[i][1]; q[2] = v[i][2]; q[3] = v[i][3]; }
    asm volatile("s_waitcnt lgkmcnt(0)" ::: "memory");
#pragma unroll
    for (int i = 0; i < 8; ++i) { const int nr = i * 8 + (lane >> 3), kc = (lane & 7) * 8; float f[8];
#pragma unroll
        for (int j = 0; j < 8; ++j) f[j] = t[(kc + j) * 65 + nr];
        const int n = n0 + nr; const int drow = ((mode & 1) == 0) ? n : (256 * (n >> 7) + (n & 127) + rowadd);
        if (mode & 2) { u32x2 w8;
            if (mode & 4) { const float sw = (mode & 8) ? I8_SW1 : I8_SW; w8.x = cvt4_i8(f[0] * sw, f[1] * sw, f[2] * sw, f[3] * sw); w8.y = cvt4_i8(f[4] * sw, f[5] * sw, f[6] * sw, f[7] * sw); }
            else { w8.x = cvt4_fp8(f[0] * F8_SW, f[1] * F8_SW, f[2] * F8_SW, f[3] * F8_SW); w8.y = cvt4_fp8(f[4] * F8_SW, f[5] * F8_SW, f[6] * F8_SW, f[7] * F8_SW); }
            *(u32x2*)((unsigned char*)dst + (size_t)drow * ldd + k0 + kc) = w8; }
        else { u32x4 w; w.x = cvt_pk_bf16(f[0], f[1]); w.y = cvt_pk_bf16(f[2], f[3]); w.z = cvt_pk_bf16(f[4], f[5]); w.w = cvt_pk_bf16(f[6], f[7]);
            *(u32x4*)(dst + (size_t)drow * ldd + k0 + kc) = w; } }
    asm volatile("s_waitcnt lgkmcnt(0)" ::: "memory");
}
__device__ __forceinline__ int conv_job(const float* src, int K, int N, int Npad, bf16_t* dst, int ldd, int rowadd, int mode, int tile0, LAS float* t, int gw, int ngw, int lane) {
    const int nkt = K / 64, nnt = Npad / 64, ntile = nkt * nnt;
    int first = (gw - tile0 % ngw + ngw) % ngw;
    for (int i = first; i < ntile; i += ngw) conv_tile(src, N, dst, ldd, (i / nnt) * 64, (i % nnt) * 64, rowadd, mode, t, lane);
    return tile0 + ntile;
}
struct MoeTile { const float* src; unsigned char* dst; int N, ldd, k0, n0, rowadd, gated; };
__device__ __forceinline__ MoeTile moe_tile(const Params& p, int layer, int g, int which, size_t dn_off) {
    const int e = which ? (g >> 7) : (g >> 8), job = which ? 2 : ((g >> 7) & 1), tl = g & 127; const size_t wo = ((size_t)layer * NEXP + e) * 1024 * 512; MoeTile m;
    if (job < 2) { m.src = (job ? p.w_up : p.w_gate) + wo; m.N = 512; m.dst = (unsigned char*)(p.ws + WS_GU) + (size_t)e * 1024 * 1024; m.ldd = 1024; m.k0 = (tl >> 3) * 64; m.n0 = (tl & 7) * 64; m.rowadd = job * 128; m.gated = 1; }
    else { m.src = p.w_down + wo; m.N = 1024; m.dst = (unsigned char*)(p.ws + WS_DN) + dn_off + (size_t)e * 1024 * 512; m.ldd = 512; m.k0 = (tl >> 4) * 64; m.n0 = (tl & 15) * 64; m.rowadd = 0; m.gated = 0; }
    return m;
}
__device__ __forceinline__ void moe_tile_load(f32x4 (&v)[16], const MoeTile& m, int lane) {
#pragma unroll
    for (int i = 0; i < 16; ++i) { const int r = i * 4 + (lane >> 4), cc = m.n0 + (lane & 15) * 4; v[i] = __builtin_nontemporal_load((const f32x4*)(m.src + (size_t)(m.k0 + r) * m.N + cc)); }
}
__device__ __forceinline__ void moe_tile_finish(const f32x4 (&v)[16], const MoeTile& m, LAS float* t, int lane) {
#pragma unroll
    for (int i = 0; i < 16; ++i) { const int r = i * 4 + (lane >> 4), cc = (lane & 15) * 4; LAS float* q = t + r * 65 + cc; q[0] = v[i][0]; q[1] = v[i][1]; q[2] = v[i][2]; q[3] = v[i][3]; }
    asm volatile("s_waitcnt lgkmcnt(0)" ::: "memory");
#pragma unroll
    for (int i = 0; i < 8; ++i) { const int nr = i * 8 + (lane >> 3), kc = (lane & 7) * 8; float f[8];
#pragma unroll
        for (int j = 0; j < 8; ++j) f[j] = t[(kc + j) * 65 + nr];
        const int n = m.n0 + nr; const int drow = m.gated ? (256 * (n >> 7) + (n & 127) + m.rowadd) : n;
        u32x2 w8; w8.x = cvt4_fp8(f[0] * F8_SW, f[1] * F8_SW, f[2] * F8_SW, f[3] * F8_SW); w8.y = cvt4_fp8(f[4] * F8_SW, f[5] * F8_SW, f[6] * F8_SW, f[7] * F8_SW);
        *(u32x2*)(m.dst + (size_t)drow * m.ldd + m.k0 + kc) = w8; }
    asm volatile("s_waitcnt lgkmcnt(0)" ::: "memory");
}
__device__ __forceinline__ void conv_moe_stream(const Params& p, int layer, int which, size_t dn_off, LAS unsigned char* lds, int gw, int ngw, int gbeg = 0, int gend = -1) {
    const int tid = otid(), lane = tid & 63, wid = tid >> 6;
    LAS float* t = (LAS float*)(lds + wid * (64 * 65 * 4));
    const int NTILE = gend >= 0 ? gend : (which ? NEXP * 128 : NEXP * 256);
    f32x4 va[16], vb[16];
    int g = gbeg + gw;
    if (g < NTILE) { const MoeTile m = moe_tile(p, layer, g, which, dn_off); moe_tile_load(va, m, lane); }
    while (g < NTILE) {
        { const int gn = g + ngw; if (gn < NTILE) { const MoeTile mn = moe_tile(p, layer, gn, which, dn_off); moe_tile_load(vb, mn, lane); }
          const MoeTile m = moe_tile(p, layer, g, which, dn_off); moe_tile_finish(va, m, t, lane); g = gn; }
        if (g >= NTILE) break;
        { const int gn = g + ngw; if (gn < NTILE) { const MoeTile mn = moe_tile(p, layer, gn, which, dn_off); moe_tile_load(va, mn, lane); }
          const MoeTile m = moe_tile(p, layer, g, which, dn_off); moe_tile_finish(vb, m, t, lane); g = gn; }
    }
}
__device__ __forceinline__ void phase_prologue(const Params& p, LAS unsigned char* lds) {
    const int tid = otid(), lane = tid & 63, wid = tid >> 6, gw = blockIdx.x * 8 + wid, ngw = gridDim.x * 8;
    LAS float* t = (LAS float*)(lds + wid * (64 * 65 * 4));
    char* ws = p.ws;
    { const size_t n8 = (size_t)NTOK * 1024 / 8; bf16_t* xb = (bf16_t*)(ws + WS_XB);
      for (size_t i = (size_t)blockIdx.x * NTHREADS + tid; i < n8; i += (size_t)gridDim.x * NTHREADS) {
          const f32x4 a = __builtin_nontemporal_load((const f32x4*)(p.x + i * 8)), b = __builtin_nontemporal_load((const f32x4*)(p.x + i * 8 + 4));
          u32x4 w; w.x = cvt_pk_bf16(a[0], a[1]); w.y = cvt_pk_bf16(a[2], a[3]); w.z = cvt_pk_bf16(b[0], b[1]); w.w = cvt_pk_bf16(b[2], b[3]);
          *(u32x4*)(xb + i * 8) = w;
          u32x2 w8; w8.x = cvt4_i8(a[0] * I8_SX, a[1] * I8_SX, a[2] * I8_SX, a[3] * I8_SX); w8.y = cvt4_i8(b[0] * I8_SX, b[1] * I8_SX, b[2] * I8_SX, b[3] * I8_SX);
          *(u32x2*)((unsigned char*)(ws + WS_X1Q) + i * 8) = w8; } }
    int tile0 = 0;
    tile0 = conv_job(p.moba_w_in, 1024, 3072, 3072, (bf16_t*)(ws + WS_WQKV0), 1024, 0, 6, tile0, t, gw, ngw, lane);
    tile0 = conv_job(p.moba_w_out, 1024, 1024, 1024, (bf16_t*)(ws + WS_WO0), 1024, 0, 2, tile0, t, gw, ngw, lane);
    tile0 = conv_job(p.nsa_w_in, 1024, 2608, 2816, (bf16_t*)(ws + WS_WIN1), 1024, 0, 6, tile0, t, gw, ngw, lane);
    tile0 = conv_job(p.nsa_w_out, 1024, 1024, 1024, (bf16_t*)(ws + WS_WO1), 1024, 0, 2, tile0, t, gw, ngw, lane);
    tile0 = conv_job(p.ck_w1, 2048, 256, 256, (bf16_t*)(ws + WS_W1T), 2048, 0, 14, tile0, t, gw, ngw, lane);
    tile0 = conv_job(p.cv_w1, 2048, 256, 256, (bf16_t*)(ws + WS_W1T + (size_t)256 * 2048), 2048, 0, 14, tile0, t, gw, ngw, lane);
    conv_moe_stream(p, 0, 0, 0, lds, gw, ngw); conv_moe_stream(p, 0, 1, 0, lds, gw, ngw);
    for (int i = blockIdx.x * NTHREADS + tid; i < 16 * BT_H; i += gridDim.x * NTHREADS) {
        const int h = i / BT_H, k = (i % BT_H) / BT_S, j = i % BT_S; int e = (BT_N - 1) - (j + k); e = e < 0 ? 0 : e;
        int n = e - 63; const bool future = n < 0; n = n < 0 ? 0 : (n > 127 ? 127 : n);
        int bk = n;
        if (n >= 16) { bk = 16 + (int)(logf((float)n / 16.0f) / logf(8.0f) * 16.0f); bk = bk > 31 ? 31 : bk; }
        ((float*)(ws + WS_TAB))[i] = future ? -INFINITY : p.rel_bias[bk * 16 + h] * LOG2E; }
    if (blockIdx.x < 32) { const int kv = blockIdx.x >> 4, part = (blockIdx.x & 15) * 2 + (tid >> 8), j = tid & 255;
        const float* pos = kv ? p.pos_v : p.pos_k; const float* w1 = kv ? p.cv_w1 : p.ck_w1; float s = 0.f;
#pragma unroll 16
        for (int k = part * 64; k < part * 64 + 64; ++k) s += pos[k] * w1[(size_t)k * 256 + j];
        ((float*)(ws + WS_B1))[(kv * 32 + part) * 256 + j] = s; }
}

__device__ __forceinline__ void store_o_rows(LAS unsigned char* stg, unsigned char* grow0, const f32x16& a0, const f32x16& a1, float scale, int lane, int r32, int hi) {
    LAS unsigned char* sp = stg + r32 * 80 + hi * 4; const float s16 = scale * F8_SO;
#pragma unroll
    for (int g4 = 0; g4 < 4; ++g4) {
        *(LAS unsigned*)(sp + g4 * 8) = cvt4_fp8(a0[4 * g4] * s16, a0[4 * g4 + 1] * s16, a0[4 * g4 + 2] * s16, a0[4 * g4 + 3] * s16);
        *(LAS unsigned*)(sp + 32 + g4 * 8) = cvt4_fp8(a1[4 * g4] * s16, a1[4 * g4 + 1] * s16, a1[4 * g4 + 2] * s16, a1[4 * g4 + 3] * s16); }
    asm volatile("s_waitcnt lgkmcnt(0)" ::: "memory");
#pragma unroll
    for (int it = 0; it < 2; ++it) { const int row = it * 16 + (lane >> 2), ch = lane & 3;
        const u32x4 v = *(const LAS u32x4*)(stg + row * 80 + ch * 16);
        *(u32x4*)(grow0 + (size_t)row * 1024 + ch * 16) = v; }
    asm volatile("s_waitcnt lgkmcnt(0)" ::: "memory");
}
template <int VAR> __device__ __forceinline__ void moba_unit(const Params& p, LAS unsigned char* lds, int b, int h, int qb) {
    const int tid = otid(), lane = tid & 63, r32 = lane & 31, hi = lane >> 5; const int wid = __builtin_amdgcn_readfirstlane(tid >> 6);
    const bf16_t* QKV = (const bf16_t*)(p.ws + WS_BIG);
    const size_t rowbase = (size_t)b * SEQ; const int q0 = qb * 256, qw = q0 + wid * 32;
    const bf16_t* Kb = QKV + rowbase * QKV_LD + 1024 + h * 64; const bf16_t* Vb = QKV + rowbase * QKV_LD + 2048 + h * 64;
    bf16x8 qr[4];
    { const bf16_t* qp = QKV + (rowbase + qw + r32) * QKV_LD + h * 64 + hi * 8;
#pragma unroll
      for (int d0 = 0; d0 < 4; ++d0) qr[d0] = *(const bf16x8*)(qp + d0 * 16); }
    float kmv, btv[3];
    { const float* kp = (const float*)(p.ws + WS_KPART); const int j = tid >> 6, d = tid & 63;
      const float* s = kp + ((size_t)(b * 8 + j) * 2) * 1024 + h * 64 + d; kmv = s[0] + s[1024];
#pragma unroll
      for (int i = 0; i < 3; ++i) { const int ix = tid + i * NTHREADS; btv[i] = ((const float*)(p.ws + WS_TAB))[h * BT_H + (ix < BT_H ? ix : 0)]; } }
    __syncthreads();
    dma_k(Kb + (size_t)q0 * QKV_LD, QKV_LD, lds, 0, wid, lane); dma_v(Vb + (size_t)q0 * QKV_LD, QKV_LD, lds, 0, wid, lane);
    dma_k(Kb + (size_t)(q0 + 64) * QKV_LD, QKV_LD, lds, 1, wid, lane); dma_v(Vb + (size_t)(q0 + 64) * QKV_LD, QKV_LD, lds, 1, wid, lane);
    ((LAS float*)(lds + AL_KM))[tid] = kmv;
#pragma unroll
    for (int i = 0; i < 3; ++i) { const int ix = tid + i * NTHREADS; if (ix < BT_H) ((LAS float*)(lds + AL_BIAS))[ix] = btv[i]; }
    const int NT = 4 + 4 * qb;
    __syncthreads();
    unsigned sel = 0;
    { float g[8];
#pragma unroll
      for (int j = 0; j < 8; ++j) { float s = 0.f; const LAS float* km = (const LAS float*)(lds + AL_KM) + j * 64 + hi * 8;
#pragma unroll
          for (int d0 = 0; d0 < 4; ++d0)
#pragma unroll
              for (int i = 0; i < 8; ++i) s += bf2f((bf16_t)qr[d0][i]) * km[d0 * 16 + i];
          g[j] = xhalf_sum(s); }
#pragma unroll
      for (int round = 0; round < 3; ++round) { int best = -1; float bv = 0.f;
#pragma unroll
          for (int j = 0; j < 8; ++j) { const bool ok = (j < qb) && !((sel >> j) & 1u) && (best < 0 || g[j] > bv); if (ok) { best = j; bv = g[j]; } }
          if (best >= 0) sel |= 1u << best; } }
    const LAS float* btab = (const LAS float*)(lds + AL_BIAS); const float cfar = btab[0];
    FState st; fstate_reset(st);
    struct MobaSrc {
        const bf16_t *Kb, *Vb; LAS unsigned char* lds; int qb, qw, wid, lane; unsigned sel;
        __device__ __forceinline__ void tile(int t, int& blk, int& kt) const { blk = t < 4 ? qb : qb - 1 - ((t - 4) >> 2); kt = t < 4 ? t : ((t - 4) & 3); }
        __device__ __forceinline__ void dma(int t, int ks, int vs) const { int blk, kt; tile(t, blk, kt); const size_t key0 = (size_t)blk * 256 + kt * 64;
            dma_k(Kb + key0 * QKV_LD, QKV_LD, lds, ks, wid, lane); dma_v(Vb + key0 * QKV_LD, QKV_LD, lds, vs, wid, lane); }
        __device__ __forceinline__ TileP params(int t) const { int blk, kt; tile(t, blk, kt); TileP tp; tp.Dmin = qw - (blk * 256 + kt * 64); tp.win = false;
            if (blk == qb) { tp.rowok = true; tp.run = (64 * kt <= wid * 32 + 31); } else { tp.rowok = (sel >> blk) & 1u; tp.run = __any(tp.rowok); }
            return tp; }
        __device__ __forceinline__ void dma_pre(int t, int ks, int vs) const { dma(t, ks, vs); }
        __device__ __forceinline__ void prefetch(int) const {}
        __device__ __forceinline__ void after(int, FState&) const {}
    } S{Kb, Vb, lds, qb, qw, wid, lane, sel};
    attn_stream<VAR, MobaSrc, true>(S, NT, st, qr, lds, btab, cfar, wid, lane, r32, hi);
    const float inv = 1.0f / xhalf_sum(st.l);
    store_o_rows(lds + AL_IMP + wid * 8192, (unsigned char*)(p.ws + (VAR ? WS_X1B : WS_AOH)) + (size_t)(rowbase + qw) * 1024 + h * 64, st.o0, st.o1, inv, lane, r32, hi);
}
template <int VAR> __device__ __forceinline__ void phase_moba(const Params& p, LAS unsigned char* lds) {
    for (int pr = blockIdx.x, rnd = 0; pr < 1024; pr += gridDim.x, ++rnd) { const int x = blockIdx.x & 7, s = blockIdx.x >> 3; const int bh = (gridDim.x == 256) ? (x + 8 * (rnd * 8 + (s >> 2))) : (pr >> 2), j = (gridDim.x == 256) ? (s & 3) : (pr & 3);
        moba_unit<VAR>(p, lds, bh >> 4, bh & 15, 7 - j);
        moba_unit<VAR>(p, lds, bh >> 4, bh & 15, j); }
    __syncthreads();
}

__device__ __forceinline__ void nsa_unit(const Params& p, LAS unsigned char* lds, int b, int hkv, int c, bool load_tab, bool load_cmp) {
    const int tid = otid(), lane = tid & 63, r32 = lane & 31, hi = lane >> 5; const int wid = __builtin_amdgcn_readfirstlane(tid >> 6);
    const bf16_t* P = (const bf16_t*)(p.ws + WS_BIG);
    const size_t rowbase = (size_t)b * SEQ; const int g = wid >> 1, qq0 = (wid & 1) * 32, h = hkv * 4 + g, qw = c * 64 + qq0, qpos = qw + r32;
    bf16x8 qr[4];
    const bf16_t* rowp = P + (rowbase + qpos) * NSA_LD;
#pragma unroll
    for (int d0 = 0; d0 < 4; ++d0) qr[d0] = *(const bf16x8*)(rowp + h * 64 + hi * 8 + d0 * 16);
    const float g0 = bf2f(rowp[NSA_G + h * 3]), g1 = bf2f(rowp[NSA_G + h * 3 + 1]), g2 = bf2f(rowp[NSA_G + h * 3 + 2]);
    __syncthreads();
    if (load_tab) { for (int i = tid; i < 4 * BT_H; i += NTHREADS) ((LAS float*)(lds + AL_BIAS))[i] = ((const float*)(p.ws + WS_TAB))[hkv * 4 * BT_H + i]; }
    if (tid < 64) ((LAS unsigned*)(lds + AL_SEL))[tid] = 0u;
    const bf16_t* KS = P + rowbase * NSA_LD + NSA_KS + hkv * 64; const bf16_t* VS = P + rowbase * NSA_LD + NSA_VS + hkv * 64;
    if (load_cmp) { const bf16_t* kc = (const bf16_t*)(p.ws + WS_KCMP) + (size_t)(b * 4 + hkv) * 128 * 64; const bf16_t* vc = (const bf16_t*)(p.ws + WS_VCMP) + (size_t)(b * 4 + hkv) * 128 * 64;
      dma_k(kc, 64, lds, 0, wid, lane, AL_CMP); dma_k(kc + 64 * 64, 64, lds, 1, wid, lane, AL_CMP); dma_v(vc, 64, lds, 2, wid, lane, AL_CMP); dma_v(vc + 64 * 64, 64, lds, 3, wid, lane, AL_CMP); }
    dma_k(KS, NSA_LD, lds, 0, wid, lane); dma_v(VS, NSA_LD, lds, 0, wid, lane);
    asm volatile("s_waitcnt vmcnt(2)" ::: "memory");
    __syncthreads();
    const lds_cptr kp0 = (lds_cptr)lds + AL_CMP + r32 * 128; const int kx = (r32 & 7) | (hi << 3);
    const lds_cptr vp0 = (lds_cptr)lds + AL_CMP + 16384 + ((lane >> 4) & 1) * 32 + (lane & 3) * 8 + (4 * hi + ((lane & 15) >> 2)) * 64;
    f32x16 cb0, cb1;
    {
        f32x16 s[2][2];
        const int nlim = (qpos >= 31 ? ((qpos - 31) >> 4) + 1 : 0) - 4 * hi;
#pragma unroll
        for (int t = 0; t < 2; ++t) {
#pragma unroll
            for (int r = 0; r < 16; ++r) { s[t][0][r] = 0.f; s[t][1][r] = 0.f; }
            qk_tile(s[t][0], s[t][1], qr, kp0 + t * 8192, kx);
#pragma unroll
            for (int n2 = 0; n2 < 2; ++n2)
#pragma unroll
                for (int r = 0; r < 16; ++r) { const int nk = 64 * t + 32 * n2 + (r & 3) + 8 * (r >> 2); if (nk >= nlim) s[t][n2][r] = -INFINITY; }
        }
        const float mx = xhalf_max(__builtin_fmaxf(__builtin_fmaxf(max16(s[0][0]), max16(s[0][1])), __builtin_fmaxf(max16(s[1][0]), max16(s[1][1]))));
        const float mref = (mx == -INFINITY) ? 0.f : mx;
        float rs = 0.f;
#pragma unroll
        for (int t = 0; t < 2; ++t)
#pragma unroll
            for (int n2 = 0; n2 < 2; ++n2)
#pragma unroll
                for (int r = 0; r < 16; ++r) { const float e = __builtin_amdgcn_exp2f(s[t][n2][r] - mref); s[t][n2][r] = e; rs += e; }
        const float lt = xhalf_sum(rs); const float inv = lt > 0.f ? 1.0f / lt : 0.f;
#pragma unroll
        for (int t = 0; t < 2; ++t)
#pragma unroll
            for (int n2 = 0; n2 < 2; ++n2)
#pragma unroll
                for (int r = 0; r < 16; ++r) s[t][n2][r] *= inv;
        float Q[16], T[16];
#pragma unroll
        for (int t = 0; t < 2; ++t)
#pragma unroll
            for (int n2 = 0; n2 < 2; ++n2)
#pragma unroll
                for (int r4 = 0; r4 < 4; ++r4) { const int u = 8 * t + 4 * n2 + r4; Q[u] = (s[t][n2][4 * r4] + s[t][n2][4 * r4 + 1]) + (s[t][n2][4 * r4 + 2] + s[t][n2][4 * r4 + 3]); T[u] = s[t][n2][4 * r4 + 3]; }
        LAS float* imp = (LAS float*)(lds + AL_IMP) + (g * 64 + qq0 + r32) * 33;
        float prev = 0.f;
#pragma unroll
        for (int u = 0; u < 16; ++u) { const float rcv = __shfl_xor(T[u], 32); const float add = hi ? rcv : prev; prev = rcv; imp[2 * u + hi] = Q[u] + add; }
        f32x16 o0, o1;
#pragma unroll
        for (int r = 0; r < 16; ++r) { o0[r] = 0.f; o1[r] = 0.f; }
        pv_tile(o0, o1, s[0][0], s[0][1], vp0); pv_tile(o0, o1, s[1][0], s[1][1], vp0 + 8192);
#pragma unroll
        for (int r = 0; r < 16; ++r) { cb0[r] = g0 * o0[r]; cb1[r] = g0 * o1[r]; }
    }
    __syncthreads();
    {
        const int q = tid >> 3, jg = tid & 7; const LAS float* ib = (const LAS float*)(lds + AL_IMP) + q * 33;
        float val[32];
#pragma unroll
        for (int j = 0; j < 32; ++j) { float v = (ib[j] + ib[64 * 33 + j]) + (ib[2 * 64 * 33 + j] + ib[3 * 64 * 33 + j]);
            const bool forced = (j == 0) || (j == c) || (j == c - 1); v = forced ? INFINITY : v; val[j] = (j > c) ? -INFINITY : v; }
        unsigned bits = 0;
#pragma unroll
        for (int i = 0; i < 4; ++i) { const int j = jg * 4 + i; float vj = 0.f;
#pragma unroll
            for (int jj = 0; jj < 32; ++jj) vj = (jj == j) ? val[jj] : vj;
            int rank = 0;
#pragma unroll
            for (int jj = 0; jj < 32; ++jj) rank += (val[jj] > vj || (val[jj] == vj && jj < j)) ? 1 : 0;
            if (j <= c && rank < 16) bits |= 1u << j; }
        if (bits) atomicOr((unsigned*)(lds + AL_SEL) + q, bits);
    }
    __syncthreads();
    unsigned uni = ((const LAS unsigned*)(lds + AL_SEL))[lane];
#pragma unroll
    for (int o = 32; o > 0; o >>= 1) uni |= (unsigned)__shfl_xor((int)uni, o);
    uni = (unsigned)__builtin_amdgcn_readfirstlane((int)uni);
    const unsigned rowmask = ((const LAS unsigned*)(lds + AL_SEL))[qq0 + r32];
    const LAS float* btab = (const LAS float*)(lds + AL_BIAS) + g * BT_H; const float cfar = btab[0];
    const bf16_t* KW = P + rowbase * NSA_LD + NSA_KW + hkv * 64; const bf16_t* VW = P + rowbase * NSA_LD + NSA_VW + hkv * 64;
    const int nslc = __builtin_popcount(uni); const int wlo = c >= 8 ? 0 : 8 - c; const int NT = nslc + (9 - wlo);
    LAS int* list = (LAS int*)(lds + AL_LIST);
    if (tid < 32) { if ((uni >> tid) & 1u) list[__builtin_popcount(uni & ((1u << tid) - 1u))] = tid; }
    else if (tid < 32 + 9 - wlo) list[nslc + (tid - 32)] = 64 + (c - 8 + wlo + (tid - 32));
    __syncthreads();
    FState st; fstate_reset(st);
    struct NsaSrc {
        const bf16_t *KS, *VS, *KW, *VW; LAS unsigned char* lds; const LAS int* list; int nslc, qw, wid, lane; unsigned rowmask; float g1; f32x16* cb0; f32x16* cb1; int pre_d, pre_p;
        __device__ __forceinline__ void prefetch(int t) { pre_d = list[t + 3]; pre_p = list[t + 1]; }
        __device__ __forceinline__ void dma_pre(int, int ks, int vs) const { const int e = __builtin_amdgcn_readfirstlane(pre_d);
            if (e < 64) { dma_k(KS + (size_t)e * 64 * NSA_LD, NSA_LD, lds, ks, wid, lane); dma_v(VS + (size_t)e * 64 * NSA_LD, NSA_LD, lds, vs, wid, lane); }
            else { dma_k(KW + (size_t)(e - 64) * 64 * NSA_LD, NSA_LD, lds, ks, wid, lane); dma_v(VW + (size_t)(e - 64) * 64 * NSA_LD, NSA_LD, lds, vs, wid, lane); } }
        __device__ __forceinline__ void dma(int t, int ks, int vs) const { const int e = __builtin_amdgcn_readfirstlane(list[t]);
            if (e < 64) { dma_k(KS + (size_t)e * 64 * NSA_LD, NSA_LD, lds, ks, wid, lane); dma_v(VS + (size_t)e * 64 * NSA_LD, NSA_LD, lds, vs, wid, lane); }
            else { dma_k(KW + (size_t)(e - 64) * 64 * NSA_LD, NSA_LD, lds, ks, wid, lane); dma_v(VW + (size_t)(e - 64) * 64 * NSA_LD, NSA_LD, lds, vs, wid, lane); } }
        __device__ __forceinline__ TileP params(int) const { const int e = __builtin_amdgcn_readfirstlane(pre_p); TileP tp;
            if (e < 64) { tp.Dmin = qw - 64 * e; tp.rowok = (rowmask >> e) & 1u; tp.run = __any(tp.rowok); tp.win = false; }
            else { tp.Dmin = qw - 64 * (e - 64); tp.rowok = true; tp.run = true; tp.win = true; }
            return tp; }
        __device__ __forceinline__ void after(int t, FState& st) const {
            if (t == nslc - 1) { const float f = g1 / xhalf_sum(st.l);
#pragma unroll
                for (int r = 0; r < 16; ++r) { (*cb0)[r] += f * st.o0[r]; (*cb1)[r] += f * st.o1[r]; }
                fstate_reset(st); } }
    } S{KS, VS, KW, VW, lds, list, nslc, qw, wid, lane, rowmask, g1, &cb0, &cb1, 0, 0};
    S.dma(1, 1, 1);
    attn_stream<0, NsaSrc, true>(S, NT, st, qr, lds, btab, cfar, wid, lane, r32, hi);
    { const float f = g2 / xhalf_sum(st.l);
#pragma unroll
      for (int r = 0; r < 16; ++r) { cb0[r] += f * st.o0[r]; cb1[r] += f * st.o1[r]; } }
    store_o_rows(lds + AL_IMP + wid * 4096, (unsigned char*)(p.ws + WS_AOH) + (size_t)(rowbase + qw) * 1024 + h * 64, cb0, cb1, 1.0f, lane, r32, hi);
}
__device__ __forceinline__ void phase_nsa(const Params& p, LAS unsigned char* lds) {
    int last_hkv = -1;
    for (int pr = blockIdx.x, rnd = 0; pr < 1024; pr += gridDim.x, ++rnd) { const int x = blockIdx.x & 7, s = blockIdx.x >> 3; const int bh = (gridDim.x == 256) ? (x + 8 * (rnd * 2 + (s >> 4))) : (pr >> 4), j = (gridDim.x == 256) ? ((s + 4 * rnd) & 15) : (pr & 15);
        nsa_unit(p, lds, bh >> 2, bh & 3, 31 - j, (bh & 3) != last_hkv, true);
        nsa_unit(p, lds, bh >> 2, bh & 3, j, false, false); last_hkv = bh & 3; }
    __syncthreads();
}

template <int L> __device__ __forceinline__ void phase_ln1(const Params& p, LAS unsigned char* lds) {
    const int tid = otid(), lane = tid & 63, wid = tid >> 6, r = lane & 15, q = lane >> 4;
    const float* lg = p.ln_g + (L * 2 + 0) * 1024; const float* lb = p.ln_b + (L * 2 + 0) * 1024;
    const bf16_t* Y = (const bf16_t*)(p.ws + WS_BIG); bf16_t* X1 = (bf16_t*)(p.ws + WS_X1B);
    for (int i = tid; i < 32 * 2 * 64; i += NTHREADS) { const int l2 = i & 63, nb = (i >> 6) & 1, s = i >> 7; const int e = 16 * nb + (l2 & 15), k0 = 32 * s + 8 * (l2 >> 4);
        float w[8]; unsigned hw[4], lw[4];
#pragma unroll
        for (int j = 0; j < 8; ++j) w[j] = p.router_w[(size_t)(k0 + j) * 32 + e];
#pragma unroll
        for (int j = 0; j < 4; ++j) { hw[j] = cvt_pk_bf16(w[2 * j], w[2 * j + 1]); lw[j] = cvt_pk_bf16(w[2 * j] - lo_bf(hw[j]), w[2 * j + 1] - hi_bf(hw[j])); }
        *(LAS u32x4*)(lds + ((size_t)((s * 2 + nb) * 2 + 0) * 64 + l2) * 16) = (u32x4){hw[0], hw[1], hw[2], hw[3]};
        *(LAS u32x4*)(lds + ((size_t)((s * 2 + nb) * 2 + 1) * 64 + l2) * 16) = (u32x4){lw[0], lw[1], lw[2], lw[3]}; }
    LAS int* hist = (LAS int*)(lds + 131072 + 8 * 2048);
    if (tid < 32) hist[tid] = 0;
    __syncthreads();
    for (int tb = blockIdx.x; tb < NTOK / 128; tb += gridDim.x) {
        const int tok = tb * 128 + wid * 16 + r;
        const bf16_t* yp = Y + (size_t)tok * 1024 + 8 * q;
        float sum = 0.f, sq = 0.f;
#pragma unroll 16
        for (int s = 0; s < 32; ++s) { const u32x4 y = *(const u32x4*)(yp + 32 * s); const unsigned yw[4] = {y.x, y.y, y.z, y.w};
#pragma unroll
            for (int j = 0; j < 4; ++j) { const float a = lo_bf(yw[j]), b2 = hi_bf(yw[j]); sum += a + b2; sq += a * a + b2 * b2; } }
        sum += __shfl_xor(sum, 16); sum += __shfl_xor(sum, 32); sq += __shfl_xor(sq, 16); sq += __shfl_xor(sq, 32);
        const float mu = sum * (1.0f / 1024.0f);
        const float rstd = rsqrtf(fmaxf(sq * (1.0f / 1024.0f) - mu * mu, 0.f) + 1e-5f);
        f32x4 acc0 = (f32x4){0.f, 0.f, 0.f, 0.f}, acc1 = acc0;
        bf16_t* xp = X1 + (size_t)tok * 1024 + 8 * q; unsigned char* xq = (unsigned char*)(p.ws + WS_X1Q) + (size_t)tok * 1024 + 8 * q;
#pragma unroll 4
        for (int s = 0; s < 32; ++s) {
            const u32x4 y = *(const u32x4*)(yp + 32 * s);
            const f32x4 ga = *(const f32x4*)(lg + 32 * s + 8 * q), gb = *(const f32x4*)(lg + 32 * s + 8 * q + 4), ba = *(const f32x4*)(lb + 32 * s + 8 * q), bb = *(const f32x4*)(lb + 32 * s + 8 * q + 4);
            u32x4 w;
            const float x0 = (lo_bf(y.x) - mu) * rstd * ga[0] + ba[0], x1 = (hi_bf(y.x) - mu) * rstd * ga[1] + ba[1], x2 = (lo_bf(y.y) - mu) * rstd * ga[2] + ba[2], x3 = (hi_bf(y.y) - mu) * rstd * ga[3] + ba[3];
            const float x4 = (lo_bf(y.z) - mu) * rstd * gb[0] + bb[0], x5 = (hi_bf(y.z) - mu) * rstd * gb[1] + bb[1], x6 = (lo_bf(y.w) - mu) * rstd * gb[2] + bb[2], x7 = (hi_bf(y.w) - mu) * rstd * gb[3] + bb[3];
            w.x = cvt_pk_bf16(x0, x1); w.y = cvt_pk_bf16(x2, x3); w.z = cvt_pk_bf16(x4, x5); w.w = cvt_pk_bf16(x6, x7);
            *(u32x4*)(xp + 32 * s) = w;
            { u32x2 w8; w8.x = cvt4_fp8(x0 * F8_SX, x1 * F8_SX, x2 * F8_SX, x3 * F8_SX); w8.y = cvt4_fp8(x4 * F8_SX, x5 * F8_SX, x6 * F8_SX, x7 * F8_SX); *(u32x2*)(xq + 32 * s) = w8; }
            const bf16x8 af = __builtin_bit_cast(bf16x8, w);
            const LAS unsigned char* bq = lds + (size_t)s * 4096 + lane * 16;
            const bf16x8 b0h = *(const LAS bf16x8*)(bq), b0l = *(const LAS bf16x8*)(bq + 1024), b1h = *(const LAS bf16x8*)(bq + 2048), b1l = *(const LAS bf16x8*)(bq + 3072);
            acc0 = __builtin_amdgcn_mfma_f32_16x16x32_bf16(af, b0h, acc0, 0, 0, 0); acc0 = __builtin_amdgcn_mfma_f32_16x16x32_bf16(af, b0l, acc0, 0, 0, 0);
            acc1 = __builtin_amdgcn_mfma_f32_16x16x32_bf16(af, b1h, acc1, 0, 0, 0); acc1 = __builtin_amdgcn_mfma_f32_16x16x32_bf16(af, b1l, acc1, 0, 0, 0);
        }
        LAS float* lg2 = (LAS float*)(lds + 131072 + wid * 2048);
#pragma unroll
        for (int i = 0; i < 4; ++i) { lg2[(4 * q + i) * 32 + r] = acc0[i] + p.router_b[r]; lg2[(4 * q + i) * 32 + 16 + r] = acc1[i] + p.router_b[16 + r]; }
        asm volatile("s_waitcnt lgkmcnt(0)" ::: "memory");
        int e0 = 0, e1 = 0, r0 = 0, r1 = 0; float w0 = 0.f, w1 = 0.f;
        if (lane < 16) {
            float pr[32]; float mx = -INFINITY;
#pragma unroll
            for (int e = 0; e < 32; ++e) { pr[e] = lg2[lane * 32 + e]; mx = fmaxf(mx, pr[e]); }
#pragma unroll
            for (int e = 0; e < 32; ++e) pr[e] = __expf(pr[e] - mx);
            int best = 0; float bs = -1.f;
#pragma unroll
            for (int gi = 0; gi < 8; ++gi) { const float a = pr[4 * gi], b2 = pr[4 * gi + 1], c2 = pr[4 * gi + 2], d2 = pr[4 * gi + 3];
                const float h1 = fmaxf(a, b2), l1 = fminf(a, b2), h2 = fmaxf(c2, d2), l2 = fminf(c2, d2);
                const float m1 = fmaxf(h1, h2), m2 = fmaxf(fminf(h1, h2), fmaxf(l1, l2));
                const float sc = m1 + m2; if (sc > bs) { bs = sc; best = gi; } }
            float v[4];
#pragma unroll
            for (int gi = 0; gi < 8; ++gi) if (gi == best) { v[0] = pr[4 * gi]; v[1] = pr[4 * gi + 1]; v[2] = pr[4 * gi + 2]; v[3] = pr[4 * gi + 3]; }
            int i0 = 0; float v0 = v[0];
#pragma unroll
            for (int i = 1; i < 4; ++i) if (v[i] > v0) { v0 = v[i]; i0 = i; }
            int i1 = -1; float v1 = -1.f;
#pragma unroll
            for (int i = 0; i < 4; ++i) if (i != i0 && v[i] > v1) { v1 = v[i]; i1 = i; }
            e0 = best * 4 + i0; e1 = best * 4 + i1; const float ws = 1.0f / (v0 + v1); w0 = v0 * ws; w1 = v1 * ws;
            r0 = atomicAdd((int*)hist + e0, 1); r1 = atomicAdd((int*)hist + e1, 1);
        }
        __syncthreads();
        if (tid < 32) { const int hv = hist[tid]; hist[32 + tid] = hv ? atomicAdd((int*)(p.ws + WS_GCNT) + L * 32 + tid, hv) : 0; }
        __syncthreads();
        if (lane < 16) { const int t2 = tb * 128 + wid * 16 + lane; const int s0 = hist[32 + e0] + r0, s1 = hist[32 + e1] + r1;
            ((int*)(p.ws + WS_RE))[t2 * 2] = e0; ((int*)(p.ws + WS_RE))[t2 * 2 + 1] = e1;
            ((float*)(p.ws + WS_RWT))[t2 * 2] = w0 * (1.0f / F8_SY); ((float*)(p.ws + WS_RWT))[t2 * 2 + 1] = w1 * (1.0f / F8_SY);
            ((int*)(p.ws + WS_POS))[t2 * 2] = s0; ((int*)(p.ws + WS_POS))[t2 * 2 + 1] = s1;
            ((int*)(p.ws + WS_ROWTOK))[e0 * 65536 + s0] = t2; ((int*)(p.ws + WS_ROWTOK))[e1 * 65536 + s1] = t2; }
        __syncthreads();
        if (tid < 32) hist[tid] = 0;
        __syncthreads();
    }
}

template <int L> __device__ __forceinline__ void phase_ln2(const Params& p, LAS unsigned char* lds) {
    const int tid = otid(), lane = tid & 63, wid = tid >> 6;
    LAS int* pst = (LAS int*)lds;
    __syncthreads();
    if (tid == 0) { const int* cnt = (const int*)(p.ws + WS_GCNT) + L * 32; int s = 0; for (int e = 0; e < NEXP; ++e) { pst[e] = s; s += (cnt[e] + 255) & ~255; } }
    __syncthreads();
    const int* RE = (const int*)(p.ws + WS_RE);
    const float* lg = p.ln_g + (L * 2 + 1) * 1024; const float* lb = p.ln_b + (L * 2 + 1) * 1024;
    const bf16_t* X1 = (const bf16_t*)(p.ws + WS_X1B); const unsigned char* YB = (const unsigned char*)(p.ws + WS_BIG);
    const int* POS = (const int*)(p.ws + WS_POS); const float* RW = (const float*)(p.ws + WS_RWT);
    const int tok0 = blockIdx.x * 8 + wid, tstride = gridDim.x * 8, nk = (NTOK - tok0 + tstride - 1) / tstride;
    int rs0 = 0, rs1 = 0; float rw0 = 0.f, rw1 = 0.f;
    if (lane < nk && lane < 16) { const int t = tok0 + lane * tstride; rs0 = pst[RE[t * 2]] + POS[t * 2]; rs1 = pst[RE[t * 2 + 1]] + POS[t * 2 + 1]; rw0 = RW[t * 2]; rw1 = RW[t * 2 + 1]; }
    u32x4 ra[2][2]; u32x2 rb[2][2], rc[2][2];
#define LN2_LOAD(k, buf) do { const int t_ = tok0 + (k) * tstride; const int s0_ = __shfl(rs0, (k)), s1_ = __shfl(rs1, (k)); _Pragma("unroll") for (int hf = 0; hf < 2; ++hf) { const int c0 = hf * 512 + lane * 8; \
        ra[buf][hf] = __builtin_nontemporal_load((const u32x4*)(X1 + (size_t)t_ * 1024 + c0)); rb[buf][hf] = __builtin_nontemporal_load((const u32x2*)(YB + (size_t)s0_ * 1024 + c0)); rc[buf][hf] = __builtin_nontemporal_load((const u32x2*)(YB + (size_t)s1_ * 1024 + c0)); } } while (0)
    if (nk > 0) LN2_LOAD(0, 0);
#pragma unroll
    for (int k = 0; k < 16; ++k) {
        if (k < nk) {
            const int tok = tok0 + k * tstride; const float w0 = __shfl(rw0, k), w1 = __shfl(rw1, k);
            if (k + 1 < nk) LN2_LOAD(k + 1, (k + 1) & 1);
            float v[16];
#pragma unroll
            for (int hf = 0; hf < 2; ++hf) { const u32x4 a = ra[k & 1][hf]; const u32x2 b = rb[k & 1][hf], c = rc[k & 1][hf];
                const unsigned aw[4] = {a.x, a.y, a.z, a.w}, bw[2] = {b.x, b.y}, cw[2] = {c.x, c.y};
#pragma unroll
                for (int j = 0; j < 4; ++j) { const f32x2 yb = (j & 1) ? __builtin_amdgcn_cvt_pk_f32_fp8((int)bw[j >> 1], true) : __builtin_amdgcn_cvt_pk_f32_fp8((int)bw[j >> 1], false);
                    const f32x2 yc = (j & 1) ? __builtin_amdgcn_cvt_pk_f32_fp8((int)cw[j >> 1], true) : __builtin_amdgcn_cvt_pk_f32_fp8((int)cw[j >> 1], false);
                    v[hf * 8 + 2 * j] = ALPHA * lo_bf(aw[j]) + w0 * yb[0] + w1 * yc[0]; v[hf * 8 + 2 * j + 1] = ALPHA * hi_bf(aw[j]) + w0 * yb[1] + w1 * yc[1]; } }
            float s = 0.f;
#pragma unroll
            for (int i = 0; i < 16; ++i) s += v[i];
            const float mu = wave_sum(s) * (1.0f / 1024.0f);
            float qv = 0.f;
#pragma unroll
            for (int i = 0; i < 16; ++i) { const float d = v[i] - mu; qv += d * d; }
            const float rstd = rsqrtf(wave_sum(qv) * (1.0f / 1024.0f) + 1e-5f);
#pragma unroll
            for (int hf = 0; hf < 2; ++hf) { const int c0 = hf * 512 + lane * 8; float o[8];
                const f32x4 ga = *(const f32x4*)(lg + c0), gb = *(const f32x4*)(lg + c0 + 4), ba = *(const f32x4*)(lb + c0), bb = *(const f32x4*)(lb + c0 + 4);
#pragma unroll
                for (int j = 0; j < 4; ++j) { o[j] = (v[hf * 8 + j] - mu) * rstd * ga[j] + ba[j]; o[4 + j] = (v[hf * 8 + 4 + j] - mu) * rstd * gb[j] + bb[j]; }
                if (L == 1) { __builtin_nontemporal_store((f32x4){o[0], o[1], o[2], o[3]}, (f32x4*)(p.out + (size_t)tok * 1024 + c0)); __builtin_nontemporal_store((f32x4){o[4], o[5], o[6], o[7]}, (f32x4*)(p.out + (size_t)tok * 1024 + c0 + 4)); }
                else { u32x4 w; w.x = cvt_pk_bf16(o[0], o[1]); w.y = cvt_pk_bf16(o[2], o[3]); w.z = cvt_pk_bf16(o[4], o[5]); w.w = cvt_pk_bf16(o[6], o[7]); *(u32x4*)((bf16_t*)(p.ws + WS_XB) + (size_t)tok * 1024 + c0) = w;
                    u32x2 w8; w8.x = cvt4_i8(o[0] * I8_SX, o[1] * I8_SX, o[2] * I8_SX, o[3] * I8_SX); w8.y = cvt4_i8(o[4] * I8_SX, o[5] * I8_SX, o[6] * I8_SX, o[7] * I8_SX);
                    *(u32x2*)((unsigned char*)(p.ws + WS_X1Q) + (size_t)tok * 1024 + c0) = w8; } }
        }
    }
#undef LN2_LOAD
}

__device__ __forceinline__ void phase_cmpfin(const Params& p, LAS unsigned char* lds) {
    const int tid = otid(), lane = tid & 63, wid = tid >> 6;
    LAS float* w2s = (LAS float*)lds;
    LAS float* hs = (LAS float*)(lds + 65536) + wid * 1024;
    LAS float* b1s = (LAS float*)(lds + 65536 + 32768);
    const float* CP = (const float*)(p.ws + WS_X1B); const float* B1 = (const float*)(p.ws + WS_B1);
    for (int kv = 0; kv < 2; ++kv) {
        __syncthreads();
        { const float* w2g = kv ? p.cv_w2 : p.ck_w2; for (int i = tid; i < 256 * 64; i += NTHREADS) w2s[i] = w2g[i]; }
        if (tid < 256) { float b1 = 0.f;
#pragma unroll 8
            for (int pt = 0; pt < 32; ++pt) b1 += B1[(kv * 32 + pt) * 256 + tid];
            b1s[tid] = b1; }
        __syncthreads();
        bf16_t* dst = (bf16_t*)(p.ws + (kv ? WS_VCMP : WS_KCMP));
        for (int rg = blockIdx.x * 8 + wid; rg < 8192 / 4; rg += gridDim.x * 8) {
            const int m0 = rg * 4;
#pragma unroll
            for (int i = 0; i < 4; ++i) { const int j = lane + 64 * i; const float b1 = b1s[j];
                f32x4 hv;
#pragma unroll
                for (int rr = 0; rr < 4; ++rr) { float a = b1;
#pragma unroll
                    for (int ks = 0; ks < 2; ++ks) a += __builtin_nontemporal_load(CP + ((size_t)(kv * 2 + ks) * 8192 + m0 + rr) * 256 + j);
                    const float u = 0.7978845608028654f * (a + 0.044715f * a * a * a); const float th = 1.0f - 2.0f / (1.0f + __expf(2.0f * u));
                    hv[rr] = 0.5f * a * (1.0f + th); }
                *(LAS f32x4*)(hs + j * 4) = hv; }
            asm volatile("s_waitcnt lgkmcnt(0)" ::: "memory");
            f32x4 o = (f32x4){0.f, 0.f, 0.f, 0.f}; const LAS float* w2 = w2s + lane;
#pragma unroll 8
            for (int j = 0; j < 256; ++j) o += *(const LAS f32x4*)(hs + j * 4) * w2[j * 64];
#pragma unroll
            for (int rr = 0; rr < 4; ++rr) dst[(size_t)(m0 + rr) * 64 + lane] = f2bf((((m0 + rr) & 127) == 127) ? 0.f : o[rr]);
            asm volatile("s_waitcnt lgkmcnt(0)" ::: "memory");
        }
    }
}

constexpr int NPHASE = 19;
template <int PH> __device__ __forceinline__ void run_phase(const Params& p, LAS unsigned char* lds) {
    char* ws = p.ws;
    if constexpr (PH == 0) phase_prologue(p, lds);
    else if constexpr (PH == 1) { SchedPlainI8 S; S.init(ws + WS_X1Q, ws + WS_WQKV0, NTOK, 3072, 512); EpiQKV0 E{(bf16_t*)(ws + WS_BIG), (float*)(ws + WS_KPART)}; pg8::gemm_phase(lds, S, E); }
    else if constexpr (PH == 2) phase_moba<0>(p, lds);
    else if constexpr (PH == 3) { SchedPlainF8 S; S.init(ws + WS_AOH, ws + WS_WO0, NTOK, 1024, 512); EpiRes<false, true> E{(bf16_t*)(ws + WS_BIG), nullptr, (const bf16_t*)(ws + WS_XB)}; pg8::gemm_phase(lds, S, E); }
    else if constexpr (PH == 4) phase_ln1<0>(p, lds);
    else if constexpr (PH == 6 || PH == 16) { SchedMoeGU S; S.init(ws, PH == 16, lds); EpiGU E{(unsigned char*)(ws + WS_AOH)}; pg8::gemm_phase(lds, S, E);
        if constexpr (PH == 6) {
            const int rem = (S.nM * 4) % (int)gridDim.x, nidle = (int)gridDim.x - rem; const bool useidle = (rem > 0 && nidle * 2 >= (int)gridDim.x);
            __syncthreads();
            if (!useidle) conv_moe_stream(p, 1, 1, DN1_OFF, lds, (int)blockIdx.x * 8 + (otid() >> 6), (int)gridDim.x * 8);
            else if ((int)blockIdx.x >= rem) conv_moe_stream(p, 1, 1, DN1_OFF, lds, ((int)blockIdx.x - rem) * 8 + (otid() >> 6), nidle * 8); } }
    else if constexpr (PH == 7 || PH == 17) { SchedMoeDN S; S.init(ws, PH == 17, lds); EpiDN E{(unsigned char*)(ws + WS_BIG)}; pg8::gemm_phase(lds, S, E);
        if constexpr (PH == 7) {
            const int rem = (S.nM * 4) % (int)gridDim.x, nidle = (int)gridDim.x - rem; const bool useidle = (rem > 0 && nidle * 2 >= (int)gridDim.x);
            __syncthreads();
            if (!useidle) conv_moe_stream(p, 1, 0, 0, lds, (int)blockIdx.x * 8 + (otid() >> 6), (int)gridDim.x * 8, 0, GU1_EARLY);
            else if ((int)blockIdx.x >= rem) conv_moe_stream(p, 1, 0, 0, lds, ((int)blockIdx.x - rem) * 8 + (otid() >> 6), nidle * 8, 0, GU1_EARLY); } }
    else if constexpr (PH == 8) { phase_ln2<0>(p, lds); __syncthreads(); conv_moe_stream(p, 1, 0, 0, lds, (int)blockIdx.x * 8 + (otid() >> 6), (int)gridDim.x * 8, GU1_EARLY); }
    else if constexpr (PH == 9) {
        { SchedNsaProjI8 S; S.init(ws + WS_X1Q, ws + WS_WIN1, NTOK, 2816, 512); S.bcnt = (unsigned*)(ws + WS_BCNT); EpiNSA E{(bf16_t*)(ws + WS_BIG)}; pg8::gemm_phase(lds, S, E); }
        { SchedCmp S; S.init(ws); EpiCmp E{(float*)(ws + WS_X1B)}; pg8::gemm_phase(lds, S, E); } }
    else if constexpr (PH == 11) phase_cmpfin(p, lds);
    else if constexpr (PH == 12) phase_nsa(p, lds);
    else if constexpr (PH == 13) { SchedPlainF8 S; S.init(ws + WS_AOH, ws + WS_WO1, NTOK, 1024, 512); EpiRes<false, true> E{(bf16_t*)(ws + WS_BIG), nullptr, (const bf16_t*)(ws + WS_XB)}; pg8::gemm_phase(lds, S, E); }
    else if constexpr (PH == 14) phase_ln1<1>(p, lds);
    else if constexpr (PH == 18) phase_ln2<1>(p, lds);
}

extern __shared__ __attribute__((aligned(16))) unsigned char g_smem[];

template <int PH> __global__ void __launch_bounds__(NTHREADS, 2) k_phase(Params p) {
    run_phase<PH>(p, (LAS unsigned char*)g_smem);
}

#if !MK_LAUNCHES
template <int PH> __device__ __forceinline__ void mega_seq(const Params& p, LAS unsigned char* lds, const XcdBarrier& bar) {
    if constexpr (PH == 5 || PH == 15 || PH == 10) { mega_seq<PH + 1>(p, lds, bar); return; }
    run_phase<PH>(p, lds);
#ifdef PROBE_VAR
    if constexpr (PH == 2) { xcd_barrier(bar); phase_moba<PROBE_VAR>(p, lds); }
#endif
#ifdef PROBE_BAR
    if constexpr (PH == 3) { for (int i = 0; i < 16; ++i) xcd_barrier(bar); }
#endif
#ifdef PROBE_GEMM_NULL
    if constexpr (PH == 1) { xcd_barrier(bar); SchedPlain S; S.init(p.ws + WS_XB, p.ws + WS_WQKV0, NTOK, 3072, 1024); EpiNull E{(float*)(p.ws + WS_X1B)}; pg8::gemm_phase(lds, S, E); }
#endif
#ifdef PROBE_MASK
    if constexpr ((PROBE_MASK >> PH) & 1) { xcd_barrier(bar); run_phase<PH>(p, lds); }
#endif
    if constexpr (PH + 1 < NPHASE) { xcd_barrier(bar); mega_seq<PH + 1>(p, lds, bar); }
}
__global__ void __launch_bounds__(NTHREADS, 2) k_mega(Params p) {
    LAS unsigned char* lds = (LAS unsigned char*)g_smem;
    LAS unsigned* stw = (LAS unsigned*)(lds + LDS_BYTES - 16);
    if (threadIdx.x == 0) { stw[0] = 0u; stw[1] = 0u; stw[2] = 0u; stw[3] = 0u; }
    __syncthreads();
    XcdBarrier bar = xcd_barrier_post((unsigned*)(p.ws + WS_CTL), (volatile LAS unsigned*)stw);
    mega_seq<0>(p, lds, bar);
}

#endif
template <int PH> static void launch_phases(const Params& p, int grid, hipStream_t stream) {
    hipFuncSetAttribute((const void*)k_phase<PH>, hipFuncAttributeMaxDynamicSharedMemorySize, LDS_BYTES);
    hipLaunchKernelGGL(k_phase<PH>, dim3(grid), dim3(NTHREADS), LDS_BYTES, stream, p);
    if constexpr (PH + 1 < NPHASE) launch_phases<PH + 1>(p, grid, stream);
}

extern "C" void kernel_launch(void* const* d_in, const int* in_sizes, int n_in, void* d_out, int out_size, void* d_ws, size_t ws_size, hipStream_t stream) {
    if (n_in != 19 || ws_size < WS_END) { fprintf(stderr, "kernel_launch: need 19 inputs and %zu bytes of workspace (got %d, %zu)\n", (size_t)WS_END, n_in, ws_size); return; }
    Params p{};
    p.x = (const float*)d_in[0]; p.rel_bias = (const float*)d_in[1]; p.router_w = (const float*)d_in[2]; p.router_b = (const float*)d_in[3];
    p.ln_g = (const float*)d_in[4]; p.ln_b = (const float*)d_in[5]; p.moba_w_in = (const float*)d_in[6]; p.moba_w_out = (const float*)d_in[7];
    p.nsa_w_in = (const float*)d_in[8]; p.nsa_w_out = (const float*)d_in[9]; p.pos_k = (const float*)d_in[10]; p.pos_v = (const float*)d_in[11];
    p.ck_w1 = (const float*)d_in[12]; p.ck_w2 = (const float*)d_in[13]; p.cv_w1 = (const float*)d_in[14]; p.cv_w2 = (const float*)d_in[15];
    p.w_gate = (const float*)d_in[16]; p.w_up = (const float*)d_in[17]; p.w_down = (const float*)d_in[18];
    p.out = (float*)d_out; p.ws = (char*)d_ws;
    const int grid = NWG_EXPECT;
#if MK_LAUNCHES
    launch_phases<0>(p, grid, stream);
#else
    hipFuncSetAttribute((const void*)k_mega, hipFuncAttributeMaxDynamicSharedMemorySize, LDS_BYTES);
    hipMemsetAsync((char*)d_ws + WS_CTL, 0, 16384, stream);
    hipLaunchKernelGGL(k_mega, dim3(grid), dim3(NTHREADS), LDS_BYTES, stream, p);
#endif
}
```

```cpp
#include <hip/hip_runtime.h>
#include <cstdio>
#include <cstdint>

#ifndef MK_LAUNCHES
#define MK_LAUNCHES 0
#endif

#define LAS __attribute__((address_space(3)))
typedef unsigned short bf16_t;
typedef short bf16x8 __attribute__((ext_vector_type(8)));
typedef short s16x4 __attribute__((ext_vector_type(4)));
typedef short v4i16_t __attribute__((ext_vector_type(4)));
typedef float f32x4 __attribute__((ext_vector_type(4)));
typedef float f32x16 __attribute__((ext_vector_type(16)));
typedef unsigned u32x4 __attribute__((ext_vector_type(4)));
typedef unsigned u32x2 __attribute__((ext_vector_type(2)));
typedef float f32x2 __attribute__((ext_vector_type(2)));
typedef int i32x4 __attribute__((ext_vector_type(4)));
typedef int i32x8 __attribute__((ext_vector_type(8)));
typedef LAS const char* lds_cptr;

constexpr int NTOK = 32768, DM = 1024, SEQ = 2048, NBATCH = 16, NHEAD = 16;
constexpr int QKV_LD = 3072, NSA_LD = 2816;
constexpr int NSA_KC = 1024, NSA_VC = 1280, NSA_KS = 1536, NSA_VS = 1792, NSA_KW = 2048, NSA_VW = 2304, NSA_G = 2560;
constexpr int NEXP = 32, DEXP = 512, MAXPAN = 288, RPAD = MAXPAN * 256;
constexpr int NTHREADS = 512, NWG_EXPECT = 256;
constexpr int LDS_BYTES = 155648;
constexpr float LOG2E = 1.4426950408889634f;
constexpr float C2 = 0.125f * LOG2E;
constexpr float ALPHA = 1.4142135623730951f;
constexpr int BT_N = 288;
constexpr int BT_S = 292, BT_H = 4 * BT_S;

constexpr size_t al256(size_t x) { return (x + 255) & ~(size_t)255; }
constexpr size_t WS_CTL = 0;
constexpr size_t WS_BCNT = 14592;
constexpr size_t WS_GCNT = 14336;
constexpr size_t WS_TAB = 16384;
constexpr size_t WS_B1 = WS_TAB + al256(16 * BT_H * 4);
constexpr size_t WS_NPAN = WS_B1 + 65536;
constexpr size_t WS_PANEL = WS_NPAN + 256;
constexpr size_t WS_HIST = WS_PANEL + 1280;
constexpr size_t WS_KPART = WS_HIST + 32768;
constexpr size_t WS_RE = WS_KPART + 128 * 2 * 1024 * 4;
constexpr size_t WS_RWT = WS_RE + (size_t)NTOK * 8;
constexpr size_t WS_POS = WS_RWT + (size_t)NTOK * 8;
constexpr size_t WS_ROWTOK = WS_POS + (size_t)NTOK * 8;
constexpr size_t WS_KCMP = WS_ROWTOK + (size_t)32 * 65536 * 4;
constexpr size_t WS_VCMP = WS_KCMP + 16 * 4 * 128 * 64 * 2;
constexpr size_t WS_WQKV0 = WS_VCMP + 16 * 4 * 128 * 64 * 2;
constexpr size_t WS_WO0 = WS_WQKV0 + (size_t)3072 * 1024 * 2;
constexpr size_t WS_WIN1 = WS_WO0 + (size_t)1024 * 1024 * 2;
constexpr size_t WS_WO1 = WS_WIN1 + (size_t)2816 * 1024 * 2;
constexpr size_t WS_W1T = WS_WO1 + (size_t)1024 * 1024 * 2;
constexpr size_t WS_GU = WS_W1T + (size_t)2 * 256 * 2048 * 2;
constexpr size_t WS_X1Q = WS_GU + (size_t)32 * 1024 * 1024;
constexpr size_t WS_DN = WS_GU + (size_t)32 * 1024 * 1024 * 2;
constexpr int GU1_EARLY = 1536;
constexpr size_t DN1_OFF = (size_t)16 * 1024 * 1024;
constexpr size_t WS_XB = WS_DN + (size_t)32 * 1024 * 512 * 2;
constexpr size_t WS_BIG = WS_XB + (size_t)NTOK * 1024 * 2;
constexpr size_t WS_AOH = WS_BIG + (size_t)NTOK * 3072 * 2;
constexpr size_t WS_X1B = WS_AOH + (size_t)RPAD * 512 * 2;
constexpr size_t WS_END = WS_X1B + (size_t)NTOK * 1024 * 2;

struct Params {
    const float *x, *rel_bias, *router_w, *router_b, *ln_g, *ln_b, *moba_w_in, *moba_w_out, *nsa_w_in, *nsa_w_out, *pos_k, *pos_v,
                *ck_w1, *ck_w2, *cv_w1, *cv_w2, *w_gate, *w_up, *w_down;
    float* out;
    char* ws;
};

__device__ __forceinline__ int otid() { int t = threadIdx.x; asm volatile("" : "+v"(t)); return t; }
__device__ __forceinline__ float bf2f(bf16_t v) { return __uint_as_float(((unsigned)v) << 16); }
__device__ __forceinline__ unsigned cvt_pk_bf16(float lo, float hi) { unsigned r; asm volatile("v_cvt_pk_bf16_f32 %0, %1, %2" : "=v"(r) : "v"(lo), "v"(hi)); return r; }
constexpr float F8_SW = 256.0f, F8_SX = 8.0f, F8_INV = 1.0f / (F8_SW * F8_SX);
constexpr float I8_SX = 127.0f / 6.0f, I8_SW = 127.0f / 0.18f, I8_INV = 1.0f / (I8_SX * I8_SW);
__device__ __forceinline__ unsigned cvt4_i8(float a, float b, float c, float d) {
    a = __builtin_amdgcn_fmed3f(a, -127.f, 127.f) + 12582912.0f; b = __builtin_amdgcn_fmed3f(b, -127.f, 127.f) + 12582912.0f; c = __builtin_amdgcn_fmed3f(c, -127.f, 127.f) + 12582912.0f; d = __builtin_amdgcn_fmed3f(d, -127.f, 127.f) + 12582912.0f;
    return (__float_as_uint(a) & 0xffu) | ((__float_as_uint(b) & 0xffu) << 8) | ((__float_as_uint(c) & 0xffu) << 16) | (__float_as_uint(d) << 24); }
constexpr float F8_SY = 32.0f;
constexpr float F8_SO = 16.0f, F8_INVO = 1.0f / (F8_SW * F8_SO);
__device__ __forceinline__ unsigned cvt4_fp8(float a, float b, float c, float d) {
    a = __builtin_amdgcn_fmed3f(a, -448.f, 448.f); b = __builtin_amdgcn_fmed3f(b, -448.f, 448.f); c = __builtin_amdgcn_fmed3f(c, -448.f, 448.f); d = __builtin_amdgcn_fmed3f(d, -448.f, 448.f);
    int w = 0; w = __builtin_amdgcn_cvt_pk_fp8_f32(a, b, w, false); w = __builtin_amdgcn_cvt_pk_fp8_f32(c, d, w, true); return (unsigned)w; }
__device__ __forceinline__ bf16_t f2bf(float f) { return (bf16_t)(cvt_pk_bf16(f, 0.f) & 0xffffu); }
__device__ __forceinline__ float lo_bf(unsigned w) { return __uint_as_float(w << 16); }
__device__ __forceinline__ float hi_bf(unsigned w) { return __uint_as_float(w & 0xffff0000u); }
__device__ __forceinline__ float wave_sum(float v) {
#pragma unroll
    for (int o = 32; o > 0; o >>= 1) v += __shfl_xor(v, o);
    return v; }

#define XB_TMO      128
#define XB_XCNT(j)  (256  + 64 * (j))
#define XB_XSUB(j)  (1280 + 64 * (j))
#define XB_XGEN(j)  (2304 + 64 * (j))
#define XB_TOP      3328
#define XB_TOPGEN   3392
#define XCD_BAR_WORDS 3456
#define XB_SPIN_CAP (1u << 18)
__device__ __forceinline__ unsigned xb_ld(unsigned* p)              { return __hip_atomic_load(p, __ATOMIC_RELAXED, __HIP_MEMORY_SCOPE_AGENT); }
__device__ __forceinline__ unsigned xb_add(unsigned* p, unsigned v) { return __hip_atomic_fetch_add(p, v, __ATOMIC_RELAXED, __HIP_MEMORY_SCOPE_AGENT); }
__device__ __forceinline__ unsigned xb_xcc_id() { return (unsigned)__builtin_amdgcn_s_getreg((3 << 11) | 20) & 0xFu; }
#define XB_SPIN(cond, bar) do { unsigned _sp = 0; while (cond) { __builtin_amdgcn_s_sleep(1); \
    if ((++_sp & 255u) == 0u) { if (xb_ld(&(bar)[XB_TMO])) break; if (_sp > XB_SPIN_CAP) { atomicAdd(&(bar)[XB_TMO], 1u); break; } } } } while (0)
struct XcdBarrier { unsigned* bar; unsigned x; volatile LAS unsigned* st; };
__device__ __forceinline__ XcdBarrier xcd_barrier_post(unsigned* bar, volatile LAS unsigned* st) {
    XcdBarrier b; b.bar = bar; b.x = xb_xcc_id(); b.st = st;
    if (threadIdx.x == 0) (void)xb_add(&bar[XB_XCNT(b.x)], 1u);
    return b;
}
__device__ __forceinline__ void xcd_barrier_complete(unsigned* bar, unsigned x, unsigned& nloc, unsigned& nx) {
    const unsigned G = gridDim.x * gridDim.y * gridDim.z;
    unsigned sum, cnt, mine, sp = 0u;
    for (;;) {
        sum = 0u; cnt = 0u; mine = 0u;
#pragma unroll
        for (unsigned j = 0; j < 16; ++j) { const unsigned c = xb_ld(&bar[XB_XCNT(j)]); sum += c; cnt += (c > 0u) ? 1u : 0u; mine = (j == x) ? c : mine; }
        if (sum == G) break;
        __builtin_amdgcn_s_sleep(1);
        if ((++sp & 255u) == 0u) { if (xb_ld(&bar[XB_TMO])) break; if (sp > XB_SPIN_CAP) { atomicAdd(&bar[XB_TMO], 1u); break; } }
    }
    nloc = mine > 0u ? mine : 1u; nx = cnt > 0u ? cnt : 1u;
}
__device__ __forceinline__ void xcd_barrier(const XcdBarrier& b) {
    asm volatile("s_waitcnt vmcnt(0)" ::: "memory");
    __syncthreads();
    if (threadIdx.x == 0) {
        unsigned* bar = b.bar;
        __builtin_amdgcn_s_waitcnt(0);
        unsigned nloc = b.st[0], nx = b.st[1];
        if (nloc == 0u) { xcd_barrier_complete(bar, b.x, nloc, nx); b.st[0] = nloc; b.st[1] = nx; }
        const unsigned old = xb_add(&bar[XB_XSUB(b.x)], 1u);
        const unsigned gen = old / nloc;
        bool released = false;
        if (old + 1u == (gen + 1u) * nloc) {
            __builtin_amdgcn_fence(__ATOMIC_RELEASE, "agent");
            asm volatile("s_waitcnt vmcnt(0)" ::: "memory");
            const unsigned og = xb_add(&bar[XB_TOP], 1u);
            const unsigned tg = og / nx;
            if (og + 1u == (tg + 1u) * nx) {
#pragma unroll
                for (unsigned j = 0; j < 16; ++j) xb_add(&bar[XB_XGEN(j)], 1u);
                released = true;
            }
        }
        __builtin_amdgcn_fence(__ATOMIC_ACQUIRE, "agent");
        if (!released) XB_SPIN(xb_ld(&bar[XB_XGEN(b.x)]) == gen, bar);
        asm volatile("s_waitcnt vmcnt(0)" ::: "memory");
    }
    __syncthreads();
}

namespace pg8 {
constexpr int BM = 256, BK = 64, HALF = 128, HTB = HALF * BK * 2, STAGE_BYTES = 8 * HTB, NXCD = 8, WGM = 8;
__device__ __forceinline__ int lds_byte(int r, int c) { const int st = (r >> 4) * 2 + (c >> 5), rr = r & 15, cc = c & 31, ob = rr * 64 + cc * 2; return st * 1024 + (ob ^ (((ob >> 9) & 1) << 5)); }
__device__ __forceinline__ void stage_rc(int b, int& R, int& C) { const int st = b / 1024, sb = b % 1024, swz = sb ^ (((sb >> 9) & 1) << 5); R = (st >> 1) * 16 + swz / 64; C = (st & 1) * 32 + (swz % 64) / 2; }
__device__ __forceinline__ int perm32(int rho) { const int n = rho >> 4, i = rho & 15; return 8 * (i >> 2) + 4 * n + (i & 3); }
struct Unit { int pm, pn, aux, aux2; };
__device__ __forceinline__ i32x8 cat8(bf16x8 a, bf16x8 b) { const i32x4 x = __builtin_bit_cast(i32x4, a), y = __builtin_bit_cast(i32x4, b); return __builtin_shufflevector(x, y, 0, 1, 2, 3, 4, 5, 6, 7); }

__device__ __forceinline__ void static_unit(int L, int nM, int nN, Unit& u) {
    const int nwg = nM * nN;
    int wgid = L; { const int q = nwg / NXCD, r = nwg % NXCD, xcd = wgid % NXCD, off = wgid / NXCD; wgid = (xcd < r ? xcd * (q + 1) : r * (q + 1) + (xcd - r) * q) + off; }
    const int nig = WGM * nN, gid = wgid / nig, fm = gid * WGM, gsz = (nM - fm) < WGM ? (nM - fm) : WGM;
    u.pm = fm + ((wgid % nig) % gsz); u.pn = (wgid % nig) / gsz; u.aux = 0; u.aux2 = 0;
}

__device__ __forceinline__ void stage2(const char* sbase, unsigned v0, unsigned v1, unsigned lds0) {
    unsigned sv;
    asm volatile("s_mov_b32 %0, m0\n\ts_mov_b32 m0, %4\n\ts_nop 0\n\tglobal_load_lds_dwordx4 %1, %3\n\ts_mov_b32 m0, %5\n\ts_nop 0\n\tglobal_load_lds_dwordx4 %2, %3\n\ts_mov_b32 m0, %0"
                 : "=&s"(sv) : "v"(v0), "v"(v1), "s"(sbase), "s"(lds0), "s"(lds0 + 8192u) : "memory");
}
template <class Epi, class Sched>
__device__ __forceinline__ void gemm_phase(LAS unsigned char* lds, const Sched& S, const Epi& E) {
    const int tid = otid(), wid = __builtin_amdgcn_readfirstlane(tid >> 6), lane = tid & 63, wr = wid >> 2, wc = wid & 3, fr = lane & 15, fq = lane >> 4;
    int nt_ = S.nt; asm volatile("" : "+s"(nt_));
    const int nt = nt_;
    int sR[2], sC[2];
    unsigned vB[2][2];
#pragma unroll
    for (int i = 0; i < 2; ++i) { stage_rc(tid * 16 + i * 8192, sR[i], sC[i]); const int Rb = Epi::PERM ? ((sR[i] & ~31) + perm32(sR[i] & 31)) : sR[i];
#pragma unroll
        for (int h = 0; h < 2; ++h) vB[h][i] = (unsigned)(h * HALF + Rb) * S.ldb + (unsigned)sC[i] * 2u; }
    const size_t kstepA = S.kstepA, kstepB = S.kstepB;
    const unsigned ldsb = (unsigned)__builtin_amdgcn_readfirstlane((int)((unsigned)(unsigned long)lds + (unsigned)wid * 1024u));
    const int aoff = lds_byte(wr * 64 + fr, fq * 8), boff = lds_byte(wc * 32 + fr, fq * 8);
#define PG8_SA(b, h) (((b) * 2 + (h)) * HTB)
#define PG8_SB(b, h) ((4 + (b) * 2 + (h)) * HTB)
#define PG8_STAGE(bufoff, gbase, v0, v1) stage2((const char*)(gbase), (v0), (v1), ldsb + (unsigned)(bufoff))
#define PG8_LDA(dst, b, h) do { if constexpr (Sched::F8) { _Pragma("unroll") for (int m = 0; m < 4; ++m) { dst##8[m].lo = *(const LAS i32x4*)(lds + PG8_SA(b, h) + aoff + m * 2048); dst##8[m].hi = *(const LAS i32x4*)(lds + PG8_SA(b, h) + aoff + m * 2048 + 1024); } } \
        else { _Pragma("unroll") for (int m = 0; m < 4; ++m) _Pragma("unroll") for (int k = 0; k < 2; ++k) dst[m][k] = *(const LAS bf16x8*)(lds + PG8_SA(b, h) + aoff + m * 2048 + k * 1024); } } while (0)
#define PG8_LDB(dst, b, h) do { if constexpr (Sched::F8) { _Pragma("unroll") for (int n = 0; n < 2; ++n) { dst##8[n].lo = *(const LAS i32x4*)(lds + PG8_SB(b, h) + boff + n * 2048); dst##8[n].hi = *(const LAS i32x4*)(lds + PG8_SB(b, h) + boff + n * 2048 + 1024); } } \
        else { _Pragma("unroll") for (int n = 0; n < 2; ++n) _Pragma("unroll") for (int k = 0; k < 2; ++k) dst[n][k] = *(const LAS bf16x8*)(lds + PG8_SB(b, h) + boff + n * 2048 + k * 1024); } } while (0)
#define PG8_MMA(ai, bj, At, Bt) do { __builtin_amdgcn_s_setprio(1); \
        if constexpr (Sched::F8) { _Pragma("unroll") for (int m = 0; m < 4; ++m) _Pragma("unroll") for (int n = 0; n < 2; ++n) \
            acc[ai][bj][m][n] = __builtin_amdgcn_mfma_scale_f32_16x16x128_f8f6f4(Bt##8[n], At##8[m], acc[ai][bj][m][n], 0, 0, 0, 0, 0, 0); } \
        else if constexpr (Sched::I8) { _Pragma("unroll") for (int m = 0; m < 4; ++m) _Pragma("unroll") for (int n = 0; n < 2; ++n) _Pragma("unroll") for (int k = 0; k < 2; ++k) \
            acc[ai][bj][m][n] = __builtin_bit_cast(f32x4, __builtin_amdgcn_mfma_i32_16x16x64_i8(__builtin_bit_cast(i32x4, Bt[n][k]), __builtin_bit_cast(i32x4, At[m][k]), __builtin_bit_cast(i32x4, acc[ai][bj][m][n]), 0, 0, 0)); } \
        else { _Pragma("unroll") for (int m = 0; m < 4; ++m) _Pragma("unroll") for (int n = 0; n < 2; ++n) _Pragma("unroll") for (int k = 0; k < 2; ++k) \
            acc[ai][bj][m][n] = __builtin_amdgcn_mfma_f32_16x16x32_bf16(Bt[n][k], At[m][k], acc[ai][bj][m][n], 0, 0, 0); } \
        __builtin_amdgcn_s_setprio(0); } while (0)
#define PG8_WAIT_V(n) asm volatile("s_waitcnt vmcnt(" #n ")" ::: "memory")
#define PG8_WAIT_L(n) asm volatile("s_waitcnt lgkmcnt(" #n ")" ::: "memory")
#define PG8_BAR __builtin_amdgcn_s_barrier()
#define PG8_SCHED __builtin_amdgcn_sched_barrier(0)
    Unit cur, nxt; int ui = 0; int prev_code = -1;
    if (!S.next(0, cur)) return;
    f32x4 acc[2][2][4][2];
#pragma unroll
    for (int a = 0; a < 2; ++a)
#pragma unroll
        for (int b = 0; b < 2; ++b)
#pragma unroll
            for (int m = 0; m < 4; ++m)
#pragma unroll
                for (int n = 0; n < 2; ++n) acc[a][b][m][n] = (f32x4){0.f, 0.f, 0.f, 0.f};
    bf16x8 At[4][2], B0[2][2], B1[2][2]; i32x8 At8[4], B08[2], B18[2];
    unsigned vA[2][2], vN[2][2];
#pragma unroll
    for (int h = 0; h < 2; ++h)
#pragma unroll
        for (int i = 0; i < 2; ++i) { vA[h][i] = S.aoff(cur, h * HALF + sR[i], sC[i]); vN[h][i] = vA[h][i]; }
    const char* cA = S.abase(cur); const char* cB = S.bbase(cur);
    S.a_ready(cur);
    PG8_STAGE(PG8_SB(0, 0), cB, vB[0][0], vB[0][1]); PG8_STAGE(PG8_SA(0, 0), cA, vA[0][0], vA[0][1]); PG8_STAGE(PG8_SB(0, 1), cB, vB[1][0], vB[1][1]); PG8_STAGE(PG8_SA(0, 1), cA, vA[1][0], vA[1][1]);
    if (wr == 1) PG8_BAR;
    PG8_WAIT_V(4); PG8_BAR;
    PG8_STAGE(PG8_SB(1, 0), cB + kstepB, vB[0][0], vB[0][1]); PG8_STAGE(PG8_SA(1, 0), cA + kstepA, vA[0][0], vA[0][1]); PG8_STAGE(PG8_SB(1, 1), cB + kstepB, vB[1][0], vB[1][1]);
    PG8_WAIT_V(6); PG8_BAR;
    for (;;) {
        const bool has_next = S.next(ui + 1, nxt);
        const char* nA = has_next ? S.abase(nxt) : cA; const char* nB = has_next ? S.bbase(nxt) : cB;
        if (Sched::DYN_A && has_next) {
#pragma unroll
            for (int h = 0; h < 2; ++h)
#pragma unroll
                for (int i = 0; i < 2; ++i) vN[h][i] = S.aoff(nxt, h * HALF + sR[i], sC[i]);
        }
        asm volatile(".p2align 8" ::: );
#pragma unroll 1
        for (int t = 0; t < nt; t += 2) {
            const bool last = (t == nt - 2);
            const char* a1 = cA + (size_t)(t + 1) * kstepA;
            const char* a2 = last ? nA : cA + (size_t)(t + 2) * kstepA; const char* b2 = last ? nB : cB + (size_t)(t + 2) * kstepB;
            const char* a3 = a2 + kstepA; const char* b3 = b2 + kstepB;
            if (last && has_next) S.a_ready(nxt);
            PG8_LDB(B0, 0, 0); PG8_SCHED; PG8_LDA(At, 0, 0); PG8_STAGE(PG8_SA(1, 1), a1, vA[1][0], vA[1][1]);
            if (Sched::DYN_A && last) {
#pragma unroll
                for (int h = 0; h < 2; ++h)
#pragma unroll
                    for (int i = 0; i < 2; ++i) vA[h][i] = vN[h][i]; }
            PG8_WAIT_L(8); PG8_BAR; PG8_WAIT_L(0); PG8_MMA(0, 0, At, B0); PG8_BAR; PG8_SCHED;
            PG8_LDB(B1, 0, 1); PG8_STAGE(PG8_SB(0, 0), b2, vB[0][0], vB[0][1]);
            PG8_BAR; PG8_WAIT_L(0); PG8_MMA(0, 1, At, B1); PG8_BAR;
            PG8_LDA(At, 0, 1); PG8_STAGE(PG8_SA(0, 0), a2, vA[0][0], vA[0][1]);
            PG8_BAR; PG8_WAIT_L(0); PG8_MMA(1, 0, At, B0); PG8_BAR; PG8_SCHED;
            PG8_STAGE(PG8_SB(0, 1), b2, vB[1][0], vB[1][1]);
            PG8_WAIT_V(6); PG8_BAR; PG8_MMA(1, 1, At, B1); PG8_BAR;
            PG8_LDB(B0, 1, 0); PG8_SCHED; PG8_LDA(At, 1, 0); PG8_STAGE(PG8_SA(0, 1), a2, vA[1][0], vA[1][1]);
            PG8_WAIT_L(8); PG8_BAR; PG8_WAIT_L(0); PG8_MMA(0, 0, At, B0); PG8_BAR; PG8_SCHED;
            PG8_LDB(B1, 1, 1); PG8_STAGE(PG8_SB(1, 0), b3, vB[0][0], vB[0][1]);
            PG8_BAR; PG8_WAIT_L(0); PG8_MMA(0, 1, At, B1); PG8_BAR;
            PG8_LDA(At, 1, 1); PG8_STAGE(PG8_SA(1, 0), a3, vA[0][0], vA[0][1]);
            PG8_BAR; PG8_WAIT_L(0); PG8_MMA(1, 0, At, B0); PG8_BAR; PG8_SCHED;
            PG8_STAGE(PG8_SB(1, 1), b3, vB[1][0], vB[1][1]);
            PG8_WAIT_V(6); PG8_BAR; PG8_MMA(1, 1, At, B1); PG8_BAR;
            if (Sched::PUBLISH && prev_code >= 0) { S.done(prev_code); prev_code = -1; }
        }
        if constexpr (Sched::I8) {
#pragma unroll
            for (int a = 0; a < 2; ++a)
#pragma unroll
                for (int b = 0; b < 2; ++b)
#pragma unroll
                    for (int m = 0; m < 4; ++m)
#pragma unroll
                        for (int n = 0; n < 2; ++n) { const i32x4 iv = __builtin_bit_cast(i32x4, acc[a][b][m][n]); acc[a][b][m][n] = (f32x4){(float)iv[0], (float)iv[1], (float)iv[2], (float)iv[3]} * I8_INV; } }
        E(acc, cur, wr, wc, fr, fq); prev_code = Sched::PUBLISH ? (cur.pm | (cur.pn << 16)) : -1;
        if (!has_next) break;
#pragma unroll
        for (int a = 0; a < 2; ++a)
#pragma unroll
            for (int b = 0; b < 2; ++b)
#pragma unroll
                for (int m = 0; m < 4; ++m)
#pragma unroll
                    for (int n = 0; n < 2; ++n) acc[a][b][m][n] = (f32x4){0.f, 0.f, 0.f, 0.f};
        cur = nxt; cA = nA; cB = nB; ++ui;
    }
    PG8_WAIT_V(0);
    if (Sched::PUBLISH && prev_code >= 0) S.done(prev_code);
    if (wr == 0) PG8_BAR;
    PG8_BAR;
#undef PG8_SA
#undef PG8_SB
#undef PG8_STAGE
#undef PG8_LDA
#undef PG8_LDB
#undef PG8_MMA
#undef PG8_WAIT_V
#undef PG8_WAIT_L
#undef PG8_BAR
#undef PG8_SCHED
}
}
using pg8::Unit;

struct SchedPlain {
    static constexpr bool DYN_A = false;
    static constexpr bool F8 = false;
    static constexpr bool I8 = false;
    const char* A; const char* Bt; int K, nM, nN, G, c; int nt; unsigned kstepA, kstepB, ldb;
    __device__ __forceinline__ void init(const void* A_, const void* Bt_, int M, int N, int K_) { A = (const char*)A_; Bt = (const char*)Bt_; K = K_; nM = M / 256; nN = N / 256; G = gridDim.x; c = blockIdx.x; nt = K / 64; kstepA = 128; kstepB = 128; ldb = (unsigned)K * 2u; }
    __device__ __forceinline__ bool next(int i, Unit& u) const { const int L = i * G + c; if (L >= nM * nN) return false; pg8::static_unit(L, nM, nN, u); return true; }
    __device__ __forceinline__ const char* abase(const Unit& u) const { return A + (size_t)u.pm * 256 * K * 2; }
    __device__ __forceinline__ const char* bbase(const Unit& u) const { return Bt + (size_t)u.pn * 256 * K * 2; }
    __device__ __forceinline__ unsigned aoff(const Unit&, int row, int col) const { return (unsigned)(row * K + col) * 2u; }
    static constexpr bool PUBLISH = false;
    __device__ __forceinline__ void a_ready(const Unit&) const {}
    __device__ __forceinline__ void done(int) const {}
};
constexpr int ML_CNT = 131072, ML_PPRE = ML_CNT + 128, ML_PE = ML_PPRE + 256;
__device__ __forceinline__ int moe_tables(const char* ws, int layer, LAS unsigned char* lds) {
    const int tid = otid(); LAS int* cnt = (LAS int*)(lds + ML_CNT); LAS int* ppre = (LAS int*)(lds + ML_PPRE); LAS int* pe = (LAS int*)(lds + ML_PE);
    __syncthreads();
    if (tid < 32) cnt[tid] = ((const int*)(ws + WS_GCNT))[layer * 32 + tid];
    __syncthreads();
    if (tid == 0) { int s = 0; for (int e = 0; e < NEXP; ++e) { ppre[e] = s; s += (cnt[e] + 255) >> 8; } ppre[NEXP] = s; }
    __syncthreads();
    const int nM = ppre[NEXP];
    if (tid < nM) { int e = 0; for (int k = 1; k < NEXP; ++k) e += (ppre[k] <= tid) ? 1 : 0; pe[tid] = e; }
    __syncthreads();
    return nM;
}
struct SchedPlainF8 : SchedPlain {
    static constexpr bool F8 = true;
    static constexpr bool I8 = false;
    static constexpr bool DYN_A = true;
    __device__ __forceinline__ const char* abase(const Unit&) const { return A; }
    __device__ __forceinline__ unsigned aoff(const Unit& u, int row, int col) const { return (unsigned)((u.pm * 256 + row) * K + col) * 2u; }
};
struct SchedNsaProj : SchedPlain {
    static constexpr bool PUBLISH = true;
    unsigned* bcnt;
    __device__ __forceinline__ void done(int code) const { const int pm = code & 0xffff, pn = code >> 16;
        if ((pn == 4 || pn == 5) && (threadIdx.x & 63) == 0) __hip_atomic_fetch_add(bcnt + (pm >> 3) * 16, 1u, __ATOMIC_RELAXED, __HIP_MEMORY_SCOPE_AGENT); }
};
struct SchedPlainI8 : SchedPlain { static constexpr bool I8 = true; };
struct SchedNsaProjI8 : SchedNsaProj { static constexpr bool I8 = true; };
struct SchedMoeGU {
    static constexpr bool DYN_A = true;
    static constexpr bool F8 = true;
    static constexpr bool I8 = false;
    const char* X; const char* W; const int* tokof; LAS unsigned char* lds; int nM, G, c; int nt; unsigned kstepA, kstepB, ldb;
    __device__ __forceinline__ void init(const char* ws, int layer, LAS unsigned char* lds_) { lds = lds_; nM = moe_tables(ws, layer, lds_); X = ws + WS_X1Q; W = ws + WS_GU; tokof = (const int*)(ws + WS_ROWTOK); G = gridDim.x; c = blockIdx.x; nt = 8; kstepA = 128; kstepB = 128; ldb = 1024; }
    __device__ __forceinline__ bool next(int i, Unit& u) const { const int L = i * G + c; if (L >= nM * 4) return false; pg8::static_unit(L, nM, 4, u);
        const int e = ((const LAS int*)(lds + ML_PE))[u.pm]; u.aux = e | ((u.pm - ((const LAS int*)(lds + ML_PPRE))[e]) << 16); u.aux2 = ((const LAS int*)(lds + ML_CNT))[e]; return true; }
    __device__ __forceinline__ const char* abase(const Unit&) const { return X; }
    __device__ __forceinline__ const char* bbase(const Unit& u) const { return W + ((size_t)(u.aux & 255) * 1024 + (size_t)u.pn * 256) * 1024; }
    __device__ __forceinline__ unsigned aoff(const Unit& u, int row, int col) const { const int slot = (u.aux >> 16) * 256 + row; const int sl = slot < u.aux2 ? slot : 0;
        return (unsigned)tokof[(u.aux & 255) * 65536 + sl] * 1024u + (unsigned)col * 2u; }
    static constexpr bool PUBLISH = false;
    __device__ __forceinline__ void a_ready(const Unit&) const {}
    __device__ __forceinline__ void done(int) const {}
};
struct SchedMoeDN {
    static constexpr bool DYN_A = true;
    static constexpr bool F8 = true;
    static constexpr bool I8 = false;
    const char* H; const char* W; LAS unsigned char* lds; int nM, G, c; int nt; unsigned kstepA, kstepB, ldb;
    __device__ __forceinline__ void init(const char* ws, int layer, LAS unsigned char* lds_) { lds = lds_; nM = moe_tables(ws, layer, lds_); H = ws + WS_AOH; W = ws + WS_DN + (layer ? DN1_OFF : 0); G = gridDim.x; c = blockIdx.x; nt = 4; kstepA = 128; kstepB = 128; ldb = 512; }
    __device__ __forceinline__ bool next(int i, Unit& u) const { const int L = i * G + c; if (L >= nM * 4) return false; pg8::static_unit(L, nM, 4, u); u.aux = ((const LAS int*)(lds + ML_PE))[u.pm]; u.aux2 = 0; return true; }
    __device__ __forceinline__ const char* abase(const Unit&) const { return H; }
    __device__ __forceinline__ const char* bbase(const Unit& u) const { return W + ((size_t)u.aux * 1024 + (size_t)u.pn * 256) * 512; }
    __device__ __forceinline__ unsigned aoff(const Unit& u, int row, int col) const { return (unsigned)((u.pm * 256 + row) * 512 + col * 2); }
    static constexpr bool PUBLISH = false;
    __device__ __forceinline__ void a_ready(const Unit&) const {}
    __device__ __forceinline__ void done(int) const {}
};
struct SchedCmp {
    static constexpr bool DYN_A = false;
    static constexpr bool F8 = false;
    static constexpr bool I8 = false;
    static constexpr bool PUBLISH = false;
    const char* Q; const char* W; unsigned* bcnt; unsigned* tmo; int c; int nt; unsigned kstepA, kstepB, ldb;
    __device__ __forceinline__ void init(const char* ws) { Q = ws + WS_BIG; W = ws + WS_W1T; bcnt = (unsigned*)(ws + WS_BCNT); tmo = (unsigned*)(ws + WS_CTL) + XB_TMO; c = (int)blockIdx.x - 128; nt = 16; kstepA = NSA_LD * 2; kstepB = 128; ldb = 4096; }
    __device__ __forceinline__ bool next(int i, Unit& u) const { if (c < 0 || i >= 1 || gridDim.x != 256) return false; const int L = c; u.aux = L >> 6; u.aux2 = 0; u.pm = (L >> 1) & 31; u.pn = L & 1; return true; }
    __device__ __forceinline__ const char* abase(const Unit& u) const { return Q + (size_t)(u.aux ? NSA_VC : NSA_KC) * 2 + (size_t)u.pn * 16 * (NSA_LD * 2); }
    __device__ __forceinline__ const char* bbase(const Unit& u) const { return W + (size_t)u.aux * 256 * 4096 + (size_t)u.pn * 16 * 128; }
    __device__ __forceinline__ unsigned aoff(const Unit& u, int row, int col) const {
        const int m = u.pm * 256 + row, bh = m >> 7, n = m & 127, nn = n > 126 ? 126 : n, b = bh >> 2, hkv = bh & 3;
        return (unsigned)(((b * SEQ + 16 * nn) * NSA_LD) + hkv * 64 + col) * 2u; }
    __device__ __forceinline__ void a_ready(const Unit& u) const {
        if (threadIdx.x < 64) { unsigned polls = 0; unsigned* w = bcnt + (u.pm >> 1) * 16;
            while ((unsigned)__builtin_amdgcn_readfirstlane((int)__hip_atomic_load(w, __ATOMIC_RELAXED, __HIP_MEMORY_SCOPE_AGENT)) < 128u) {
                __builtin_amdgcn_s_sleep(2);
                if ((++polls & 255u) == 0u) { if (__builtin_amdgcn_readfirstlane((int)__hip_atomic_load(tmo, __ATOMIC_RELAXED, __HIP_MEMORY_SCOPE_AGENT)) != 0) break;
                    if (polls > (1u << 18)) { if (threadIdx.x == 0) __hip_atomic_fetch_add(tmo, 1u, __ATOMIC_RELAXED, __HIP_MEMORY_SCOPE_AGENT); break; } } }
            __builtin_amdgcn_fence(__ATOMIC_ACQUIRE, "agent");
            asm volatile("s_waitcnt vmcnt(0)" ::: "memory"); }
        asm volatile("" ::: "memory"); __builtin_amdgcn_s_barrier(); asm volatile("" ::: "memory");
    }
    __device__ __forceinline__ void done(int) const {}
};

struct EpiQKV0 {
    static constexpr bool PERM = true;
    bf16_t* O; float* kpart;
    __device__ __forceinline__ void operator()(const f32x4 (&acc)[2][2][4][2], const Unit& u, int wr, int wc, int fr, int fq) const {
        const int row0 = u.pm * 256 + wr * 64 + fr, col0 = u.pn * 256 + wc * 32 + 8 * fq;
        const float sc = (u.pn < 4) ? C2 : 1.0f;
#pragma unroll
        for (int ai = 0; ai < 2; ++ai)
#pragma unroll
            for (int m = 0; m < 4; ++m) { bf16_t* rowp = O + (size_t)(row0 + ai * 128 + m * 16) * QKV_LD + col0;
#pragma unroll
                for (int bj = 0; bj < 2; ++bj) { const f32x4 v0 = acc[ai][bj][m][0] * sc, v1 = acc[ai][bj][m][1] * sc;
                    u32x4 w; w.x = cvt_pk_bf16(v0[0], v0[1]); w.y = cvt_pk_bf16(v0[2], v0[3]); w.z = cvt_pk_bf16(v1[0], v1[1]); w.w = cvt_pk_bf16(v1[2], v1[3]);
                    *(u32x4*)(rowp + bj * 128) = w; } }
        if (u.pn >= 4 && u.pn < 8) {
#pragma unroll
            for (int bj = 0; bj < 2; ++bj)
#pragma unroll
                for (int n = 0; n < 2; ++n) { f32x4 s = (f32x4){0.f, 0.f, 0.f, 0.f};
#pragma unroll
                    for (int ai = 0; ai < 2; ++ai)
#pragma unroll
                        for (int m = 0; m < 4; ++m) s += acc[ai][bj][m][n];
#pragma unroll
                    for (int j = 0; j < 4; ++j) { float v = s[j]; v += __shfl_xor(v, 1); v += __shfl_xor(v, 2); v += __shfl_xor(v, 4); v += __shfl_xor(v, 8); s[j] = v; }
                    if (fr == 0) *(f32x4*)(kpart + ((size_t)u.pm * 2 + wr) * 1024 + (u.pn - 4) * 256 + bj * 128 + wc * 32 + 8 * fq + 4 * n) = s; }
        }
    }
};
struct EpiNull {
    static constexpr bool PERM = true;
    float* sink;
    __device__ __forceinline__ void operator()(const f32x4 (&acc)[2][2][4][2], const Unit& u, int wr, int wc, int fr, int fq) const {
        float s = 0.f;
#pragma unroll
        for (int ai = 0; ai < 2; ++ai)
#pragma unroll
            for (int bj = 0; bj < 2; ++bj)
#pragma unroll
                for (int m = 0; m < 4; ++m)
#pragma unroll
                    for (int n = 0; n < 2; ++n) s += acc[ai][bj][m][n][0] + acc[ai][bj][m][n][3];
        if (s == 12345.678f) sink[u.pm + wr + wc + fr + fq] = s;
    }
};
struct EpiNSA {
    static constexpr bool PERM = true;
    bf16_t* O;
    __device__ __forceinline__ void operator()(const f32x4 (&acc)[2][2][4][2], const Unit& u, int wr, int wc, int fr, int fq) const {
        const int row0 = u.pm * 256 + wr * 64 + fr, col0 = u.pn * 256 + wc * 32 + 8 * fq;
        const float sc = (u.pn < 4) ? C2 : 1.0f; const bool sg = (u.pn == 10), wt = (u.pn == 4 || u.pn == 5);
        const auto rsrc = __builtin_amdgcn_make_buffer_rsrc((void*)O, 0, (int)((size_t)NTOK * NSA_LD * 2), 0x00020000);
#pragma unroll
        for (int ai = 0; ai < 2; ++ai)
#pragma unroll
            for (int m = 0; m < 4; ++m) { bf16_t* rowp = O + (size_t)(row0 + ai * 128 + m * 16) * NSA_LD + col0;
#pragma unroll
                for (int bj = 0; bj < 2; ++bj) { f32x4 v0 = acc[ai][bj][m][0] * sc, v1 = acc[ai][bj][m][1] * sc;
                    if (sg) {
#pragma unroll
                        for (int j = 0; j < 4; ++j) { v0[j] = __builtin_amdgcn_rcpf(1.0f + __builtin_amdgcn_exp2f(-LOG2E * v0[j])); v1[j] = __builtin_amdgcn_rcpf(1.0f + __builtin_amdgcn_exp2f(-LOG2E * v1[j])); } }
                    u32x4 w; w.x = cvt_pk_bf16(v0[0], v0[1]); w.y = cvt_pk_bf16(v0[2], v0[3]); w.z = cvt_pk_bf16(v1[0], v1[1]); w.w = cvt_pk_bf16(v1[2], v1[3]);
                    if (wt) __builtin_amdgcn_raw_buffer_store_b128(w, rsrc, (int)(((unsigned)(row0 + ai * 128 + m * 16) * (unsigned)NSA_LD + (unsigned)(col0 + bj * 128)) * 2u), 0, 16);
                    else *(u32x4*)(rowp + bj * 128) = w; } }
    }
};
template <bool RES_F32, bool F8O = false> struct EpiRes {
    static constexpr bool PERM = true;
    bf16_t* O; const float* rf; const bf16_t* rb;
    __device__ __forceinline__ void operator()(const f32x4 (&acc)[2][2][4][2], const Unit& u, int wr, int wc, int fr, int fq) const {
        const int row0 = u.pm * 256 + wr * 64 + fr, col0 = u.pn * 256 + wc * 32 + 8 * fq;
#pragma unroll
        for (int ai = 0; ai < 2; ++ai) {
            if (RES_F32) {
#pragma unroll
                for (int mh = 0; mh < 2; ++mh) { f32x4 r[2][2][2];
#pragma unroll
                    for (int m2 = 0; m2 < 2; ++m2)
#pragma unroll
                        for (int bj = 0; bj < 2; ++bj) { const size_t ro = (size_t)(row0 + ai * 128 + (mh * 2 + m2) * 16) * 1024 + col0 + bj * 128; r[m2][bj][0] = *(const f32x4*)(rf + ro); r[m2][bj][1] = *(const f32x4*)(rf + ro + 4); }
#pragma unroll
                    for (int m2 = 0; m2 < 2; ++m2)
#pragma unroll
                        for (int bj = 0; bj < 2; ++bj) { const int m = mh * 2 + m2; const size_t ro = (size_t)(row0 + ai * 128 + m * 16) * 1024 + col0 + bj * 128;
                            const f32x4 v0 = acc[ai][bj][m][0] + r[m2][bj][0] * ALPHA, v1 = acc[ai][bj][m][1] + r[m2][bj][1] * ALPHA;
                            u32x4 w; w.x = cvt_pk_bf16(v0[0], v0[1]); w.y = cvt_pk_bf16(v0[2], v0[3]); w.z = cvt_pk_bf16(v1[0], v1[1]); w.w = cvt_pk_bf16(v1[2], v1[3]);
                            *(u32x4*)(O + ro) = w; } }
            } else {
                u32x4 r[4][2];
#pragma unroll
                for (int m = 0; m < 4; ++m)
#pragma unroll
                    for (int bj = 0; bj < 2; ++bj) r[m][bj] = *(const u32x4*)(rb + (size_t)(row0 + ai * 128 + m * 16) * 1024 + col0 + bj * 128);
#pragma unroll
                for (int m = 0; m < 4; ++m)
#pragma unroll
                    for (int bj = 0; bj < 2; ++bj) { const size_t ro = (size_t)(row0 + ai * 128 + m * 16) * 1024 + col0 + bj * 128; const u32x4 rw = r[m][bj];
                        const f32x4 r0 = (f32x4){lo_bf(rw.x), hi_bf(rw.x), lo_bf(rw.y), hi_bf(rw.y)}, r1 = (f32x4){lo_bf(rw.z), hi_bf(rw.z), lo_bf(rw.w), hi_bf(rw.w)};
                        const f32x4 v0 = (F8O ? acc[ai][bj][m][0] * F8_INVO : acc[ai][bj][m][0]) + r0 * ALPHA, v1 = (F8O ? acc[ai][bj][m][1] * F8_INVO : acc[ai][bj][m][1]) + r1 * ALPHA;
                        u32x4 w; w.x = cvt_pk_bf16(v0[0], v0[1]); w.y = cvt_pk_bf16(v0[2], v0[3]); w.z = cvt_pk_bf16(v1[0], v1[1]); w.w = cvt_pk_bf16(v1[2], v1[3]);
                        *(u32x4*)(O + ro) = w; }
            }
        }
    }
};
struct EpiGU {
    static constexpr bool PERM = true;
    unsigned char* O;
    __device__ __forceinline__ void operator()(const f32x4 (&acc)[2][2][4][2], const Unit& u, int wr, int wc, int fr, int fq) const {
        const int row0 = u.pm * 256 + wr * 64 + fr, col0 = u.pn * 128 + wc * 32 + 8 * fq;
#pragma unroll
        for (int ai = 0; ai < 2; ++ai)
#pragma unroll
            for (int m = 0; m < 4; ++m) { float h[8];
#pragma unroll
                for (int n = 0; n < 2; ++n)
#pragma unroll
                    for (int j = 0; j < 4; ++j) { const float g = acc[ai][0][m][n][j] * F8_INV, up = acc[ai][1][m][n][j] * (F8_INV * F8_SX); h[n * 4 + j] = g * up * __builtin_amdgcn_rcpf(1.0f + __builtin_amdgcn_exp2f(-LOG2E * g)); }
                u32x2 w; w.x = cvt4_fp8(h[0], h[1], h[2], h[3]); w.y = cvt4_fp8(h[4], h[5], h[6], h[7]);
                *(u32x2*)(O + (size_t)(row0 + ai * 128 + m * 16) * 512 + col0) = w; }
    }
};
struct EpiDN {
    static constexpr bool PERM = true;
    unsigned char* O;
    __device__ __forceinline__ void operator()(const f32x4 (&acc)[2][2][4][2], const Unit& u, int wr, int wc, int fr, int fq) const {
        const int row0 = u.pm * 256 + wr * 64 + fr, col0 = u.pn * 256 + wc * 32 + 8 * fq; constexpr float s = F8_INV * F8_SY;
#pragma unroll
        for (int ai = 0; ai < 2; ++ai)
#pragma unroll
            for (int m = 0; m < 4; ++m) { unsigned char* rowp = O + (size_t)(row0 + ai * 128 + m * 16) * 1024 + col0;
#pragma unroll
                for (int bj = 0; bj < 2; ++bj) { const f32x4 v0 = acc[ai][bj][m][0] * s, v1 = acc[ai][bj][m][1] * s;
                    u32x2 w; w.x = cvt4_fp8(v0[0], v0[1], v0[2], v0[3]); w.y = cvt4_fp8(v1[0], v1[1], v1[2], v1[3]);
                    *(u32x2*)(rowp + bj * 128) = w; } }
    }
};
struct EpiCmp {
    static constexpr bool PERM = false;
    float* CP;
    __device__ __forceinline__ void operator()(const f32x4 (&acc)[2][2][4][2], const Unit& u, int wr, int wc, int fr, int fq) const {
        float* base = CP + ((size_t)(u.aux * 2 + u.pn) * 8192 + (size_t)u.pm * 256) * 256;
        const int row0 = wr * 64 + fr, col0 = wc * 32 + 4 * fq;
#pragma unroll
        for (int ai = 0; ai < 2; ++ai)
#pragma unroll
            for (int m = 0; m < 4; ++m) { float* rowp = base + (size_t)(row0 + ai * 128 + m * 16) * 256 + col0;
#pragma unroll
                for (int bj = 0; bj < 2; ++bj)
#pragma unroll
                    for (int n = 0; n < 2; ++n) *(f32x4*)(rowp + bj * 128 + n * 16) = acc[ai][bj][m][n]; }
    }
};

constexpr int AL_K = 0  , AL_V = 24576  , AL_BIAS = 57344  , AL_KM = AL_BIAS + 4 * BT_H * 4, AL_IMP = AL_KM + 2048  , AL_CMP = AL_IMP + 33792  , AL_SEL = AL_CMP + 32768, AL_LIST = AL_SEL + 512, AL_END = AL_LIST + 256;
static_assert(AL_END <= LDS_BYTES, "attention LDS map");
static_assert(AL_END <= LDS_BYTES - 16 && 4 * 64 * 33 * 4 <= 65536, "attention LDS map");
#define MFMA32(a, b, c) __builtin_amdgcn_mfma_f32_32x32x16_bf16(a, b, c, 0, 0, 0)
__device__ __forceinline__ s16x4 vtr(lds_cptr p) { return __builtin_bit_cast(s16x4, __builtin_amdgcn_ds_read_tr16_b64_v4i16((LAS v4i16_t*)p)); }
__device__ __forceinline__ float xhalf_max(float m) { auto rr = __builtin_amdgcn_permlane32_swap(__float_as_uint(m), __float_as_uint(m), false, false); return __builtin_fmaxf(__uint_as_float(rr[0]), __uint_as_float(rr[1])); }
__device__ __forceinline__ float xhalf_sum(float m) { auto rr = __builtin_amdgcn_permlane32_swap(__float_as_uint(m), __float_as_uint(m), false, false); return __uint_as_float(rr[0]) + __uint_as_float(rr[1]); }
__device__ __forceinline__ float max16(const f32x16& p) { float a = __builtin_fmaxf(p[0], p[1]), b = __builtin_fmaxf(p[2], p[3]);
#pragma unroll
    for (int r = 4; r < 16; r += 4) { a = __builtin_fmaxf(a, __builtin_fmaxf(p[r], p[r + 1])); b = __builtin_fmaxf(b, __builtin_fmaxf(p[r + 2], p[r + 3])); }
    return __builtin_fmaxf(a, b); }

#define MX3(a, b, c) __builtin_fmaxf(__builtin_fmaxf((a), (b)), (c))
__device__ __forceinline__ float max32(const f32x16& p0, const f32x16& p1) {
    float a = MX3(p0[0], p0[1], p1[0]), b = MX3(p0[2], p0[3], p1[1]); a = MX3(a, p1[2], p1[3]);
#pragma unroll
    for (int r = 4; r < 16; r += 4) { a = MX3(a, p0[r], p0[r + 1]); b = MX3(b, p0[r + 2], p0[r + 3]); a = MX3(a, p1[r], p1[r + 1]); b = MX3(b, p1[r + 2], p1[r + 3]); }
    return __builtin_fmaxf(a, b); }
constexpr float FLASH_THR = 8.0f;
__device__ __forceinline__ void glds16(const void* g, unsigned lds_addr) {
    unsigned sv; asm volatile("s_mov_b32 %0, m0\n\ts_mov_b32 m0, %2\n\ts_nop 0\n\tglobal_load_lds_dwordx4 %1, off\n\ts_mov_b32 m0, %0" : "=&s"(sv) : "v"(g), "s"(lds_addr) : "memory"); }
__device__ __forceinline__ void dma_k(const bf16_t* src, int ld, LAS unsigned char* lds, int slot, int wid, int lane, int base = AL_K) {
    const int rl = lane >> 3, ch = lane & 7;
    glds16(src + (size_t)(wid * 8 + rl) * ld + ((ch ^ rl) * 8), (unsigned)__builtin_amdgcn_readfirstlane((int)((unsigned)(unsigned long)lds + base + slot * 8192 + wid * 1024))); }
__device__ __forceinline__ void dma_v(const bf16_t* src, int ld, LAS unsigned char* lds, int slot, int wid, int lane, int base = AL_V) {
    glds16(src + (size_t)(16 * (wid & 3) + (lane >> 2)) * ld + (wid >> 2) * 32 + (lane & 3) * 8, (unsigned)__builtin_amdgcn_readfirstlane((int)((unsigned)(unsigned long)lds + base + slot * 8192 + wid * 1024))); }

struct FState { float m, l; f32x16 o0, o1; };
__device__ __forceinline__ void fstate_reset(FState& s) { s.m = -1e30f; s.l = 0.f;
#pragma unroll
    for (int r = 0; r < 16; ++r) { s.o0[r] = 0.f; s.o1[r] = 0.f; } }

__device__ __forceinline__ int kchunk_off(int d0, int kx) { return (((2 * d0 + (kx >> 3)) ^ (kx & 7)) * 16); }
__device__ __forceinline__ void qk_tile(f32x16& c0, f32x16& c1, const bf16x8 (&qr)[4], lds_cptr kp, int kx) {
#pragma unroll
    for (int d0 = 0; d0 < 4; ++d0) { const bf16x8 k0 = *(const LAS bf16x8*)(kp + kchunk_off(d0, kx)), k1 = *(const LAS bf16x8*)(kp + kchunk_off(d0, kx) + 4096);
        c0 = MFMA32(k0, qr[d0], c0); c1 = MFMA32(k1, qr[d0], c1); }
}
__device__ __forceinline__ void pv_tile(f32x16& o0, f32x16& o1, const f32x16& p0, const f32x16& p1, lds_cptr vp) {
#pragma unroll
    for (int k = 0; k < 4; ++k) {
        const f32x16& ps = (k < 2) ? p0 : p1; const int b = 8 * (k & 1);
        const u32x4 pw = (u32x4){cvt_pk_bf16(ps[b], ps[b + 1]), cvt_pk_bf16(ps[b + 2], ps[b + 3]), cvt_pk_bf16(ps[b + 4], ps[b + 5]), cvt_pk_bf16(ps[b + 6], ps[b + 7])};
        const bf16x8 pf = __builtin_bit_cast(bf16x8, pw);
        { const s16x4 lo = vtr(vp + k * 1024), hi = vtr(vp + k * 1024 + 512);
          const bf16x8 vf = (bf16x8){lo[0], lo[1], lo[2], lo[3], hi[0], hi[1], hi[2], hi[3]}; o0 = MFMA32(vf, pf, o0); }
        { const s16x4 lo = vtr(vp + 4096 + k * 1024), hi = vtr(vp + 4096 + k * 1024 + 512);
          const bf16x8 vf = (bf16x8){lo[0], lo[1], lo[2], lo[3], hi[0], hi[1], hi[2], hi[3]}; o1 = MFMA32(vf, pf, o1); }
    }
}
struct TileP { int Dmin; bool rowok, run, win; };
__device__ __forceinline__ void load_kf(bf16x8 (&kf)[8], lds_cptr kp, int kx) {
#pragma unroll
    for (int d0 = 0; d0 < 4; ++d0) { kf[2 * d0] = *(const LAS bf16x8*)(kp + kchunk_off(d0, kx)); kf[2 * d0 + 1] = *(const LAS bf16x8*)(kp + kchunk_off(d0, kx) + 4096); } }
__device__ __forceinline__ void flash_qk(f32x16& c0, f32x16& c1, float& cf, const bf16x8 (&qr)[4], lds_cptr kp, int kx, const LAS float* btab, float cfar, int Dmin, int r32, int hi) {
    bf16x8 kf[8]; load_kf(kf, kp, kx);
    if (Dmin - 63 < 127) {
        const int s0 = (BT_N - 1 - 63) - (Dmin + r32 - 4 * hi), ksh = s0 & 3; cf = 0.f;
        const LAS f32x4* bp = (const LAS f32x4*)(btab + ksh * BT_S + (s0 - ksh));
#pragma unroll
        for (int g = 0; g < 4; ++g) { const f32x4 a = bp[2 * g], b = bp[8 + 2 * g];
#pragma unroll
            for (int i = 0; i < 4; ++i) { c0[4 * g + i] = a[i]; c1[4 * g + i] = b[i]; } }
#pragma unroll
        for (int d0 = 0; d0 < 4; ++d0) { c0 = MFMA32(kf[2 * d0], qr[d0], c0); c1 = MFMA32(kf[2 * d0 + 1], qr[d0], c1); }
    } else {
        cf = cfar;
        const f32x16 z = {0.f, 0.f, 0.f, 0.f, 0.f, 0.f, 0.f, 0.f, 0.f, 0.f, 0.f, 0.f, 0.f, 0.f, 0.f, 0.f};
        c0 = MFMA32(kf[0], qr[0], z); c1 = MFMA32(kf[1], qr[0], z);
#pragma unroll
        for (int d0 = 1; d0 < 4; ++d0) { c0 = MFMA32(kf[2 * d0], qr[d0], c0); c1 = MFMA32(kf[2 * d0 + 1], qr[d0], c1); }
    }
}
__device__ __forceinline__ void flash_sm(FState& st, f32x16& c0, f32x16& c1, float cf, const TileP& tp, int r32, int hi) {
    const int Dmin = tp.Dmin, Dl = Dmin + r32 - 4 * hi;
    if (tp.win && (Dmin + 31 >= 512)) {
#pragma unroll
        for (int r = 0; r < 16; ++r) { const int ko = (r & 3) + 8 * (r >> 2); if (Dl >= 512 + ko) c0[r] = -INFINITY; if (Dl >= 544 + ko) c1[r] = -INFINITY; }
    }
    float mx = xhalf_max(max32(c0, c1)) + cf;
    mx = tp.rowok ? mx : -INFINITY;
    if (__any(mx > st.m + FLASH_THR)) {
        const float mn = __builtin_fmaxf(st.m, mx); const float alpha = __builtin_amdgcn_exp2f(st.m - mn);
        st.m = mn; st.l *= alpha;
#pragma unroll
        for (int r = 0; r < 16; ++r) { st.o0[r] *= alpha; st.o1[r] *= alpha; }
    }
    const float msub = tp.rowok ? (st.m - cf) : INFINITY;
    float rs0 = 0.f, rs1 = 0.f;
#pragma unroll
    for (int r = 0; r < 16; ++r) { c0[r] = __builtin_amdgcn_exp2f(c0[r] - msub); c1[r] = __builtin_amdgcn_exp2f(c1[r] - msub); rs0 += c0[r]; rs1 += c1[r]; }
    st.l += rs0 + rs1;
}
template <int VAR, class Src, bool PRE = false>
__device__ __forceinline__ void attn_stream(Src& S, int NT, FState& st, const bf16x8 (&qr)[4], LAS unsigned char* lds, const LAS float* btab, float cfar, int wid, int lane, int r32, int hi) {
    const lds_cptr kp0 = (lds_cptr)lds + AL_K + r32 * 128; const int kx = (r32 & 7) | (hi << 3);
    const lds_cptr vp0 = (lds_cptr)lds + AL_V + ((lane >> 4) & 1) * 32 + (lane & 3) * 8 + (4 * hi + ((lane & 15) >> 2)) * 64;
    if (!PRE) { S.dma(0, 0, 0); if (NT > 1 && VAR != 5 && VAR != 6) S.dma(1, 1, 1); }
    if (VAR == 5) { asm volatile("s_waitcnt vmcnt(0)" ::: "memory"); __syncthreads(); }
    int sc = 0, sn = 2;
    S.prefetch(-1);
#pragma nounroll
    for (int t = 0; t < NT; ++t) {
        if (VAR != 5) { if (t + 1 < NT) asm volatile("s_waitcnt vmcnt(2)" ::: "memory"); else asm volatile("s_waitcnt vmcnt(0)" ::: "memory");
        __syncthreads(); }
        if (VAR != 5 && VAR != 6) { if (t + 2 < NT) S.dma_pre(t + 2, sn, sn); }
        const TileP tp = S.params(t);
        S.prefetch(t);
        if (tp.run) { f32x16 c0, c1; float cf;
            flash_qk(c0, c1, cf, qr, kp0 + sc * 8192, kx, btab, cfar, tp.Dmin, r32, hi);
            flash_sm(st, c0, c1, cf, tp, r32, hi);
            pv_tile(st.o0, st.o1, c0, c1, vp0 + sc * 8192); }
        S.after(t, st);
        sc = (sc == 2) ? 0 : sc + 1; sn = (sn == 2) ? 0 : sn + 1;
    }
}

__device__ __forceinline__ void conv_tile(const float* src, int N, bf16_t* dst, int ldd, int k0, int n0, int rowadd, int mode, LAS float* t, int lane) {
    f32x4 v[16];
#pragma unroll
    for (int i = 0; i < 16; ++i) { const int r = i * 4 + (lane >> 4), cc = n0 + (lane & 15) * 4;
        v[i] = (cc < N) ? __builtin_nontemporal_load((const f32x4*)(src + (size_t)(k0 + r) * N + cc)) : (f32x4){0.f, 0.f, 0.f, 0.f}; }
#pragma unroll
    for (int i = 0; i < 16; ++i) { const int r = i * 4 + (lane >> 4), cc = (lane & 15) * 4; LAS float* q = t + r * 65 + cc; q[0] = v[i][0]; q[1] = v[i][1]; q[2] = v[i][2]; q[3] = v[i][3]; }
    asm volatile("s_waitcnt lgkmcnt(0)" ::: "memory");
#pragma unroll
    for (int i = 0; i < 8; ++i) { const int nr = i * 8 + (lane >> 3), kc = (lane & 7) * 8; float f[8];
#pragma unroll
        for (int j = 0; j < 8; ++j) f[j] = t[(kc + j) * 65 + nr];
        const int n = n0 + nr; const int drow = ((mode & 1) == 0) ? n : (256 * (n >> 7) + (n & 127) + rowadd);
        if (mode & 2) { u32x2 w8;
            if (mode & 4) { w8.x = cvt4_i8(f[0] * I8_SW, f[1] * I8_SW, f[2] * I8_SW, f[3] * I8_SW); w8.y = cvt4_i8(f[4] * I8_SW, f[5] * I8_SW, f[6] * I8_SW, f[7] * I8_SW); }
            else { w8.x = cvt4_fp8(f[0] * F8_SW, f[1] * F8_SW, f[2] * F8_SW, f[3] * F8_SW); w8.y = cvt4_fp8(f[4] * F8_SW, f[5] * F8_SW, f[6] * F8_SW, f[7] * F8_SW); }
            *(u32x2*)((unsigned char*)dst + (size_t)drow * ldd + k0 + kc) = w8; }
        else { u32x4 w; w.x = cvt_pk_bf16(f[0], f[1]); w.y = cvt_pk_bf16(f[2], f[3]); w.z = cvt_pk_bf16(f[4], f[5]); w.w = cvt_pk_bf16(f[6], f[7]);
            *(u32x4*)(dst + (size_t)drow * ldd + k0 + kc) = w; } }
    asm volatile("s_waitcnt lgkmcnt(0)" ::: "memory");
}
__device__ __forceinline__ int conv_job(const float* src, int K, int N, int Npad, bf16_t* dst, int ldd, int rowadd, int mode, int tile0, LAS float* t, int gw, int ngw, int lane) {
    const int nkt = K / 64, nnt = Npad / 64, ntile = nkt * nnt;
    int first = (gw - tile0 % ngw + ngw) % ngw;
    for (int i = first; i < ntile; i += ngw) conv_tile(src, N, dst, ldd, (i / nnt) * 64, (i % nnt) * 64, rowadd, mode, t, lane);
    return tile0 + ntile;
}
struct MoeTile { const float* src; unsigned char* dst; int N, ldd, k0, n0, rowadd, gated; };
__device__ __forceinline__ MoeTile moe_tile(const Params& p, int layer, int g, int which, size_t dn_off) {
    const int e = which ? (g >> 7) : (g >> 8), job = which ? 2 : ((g >> 7) & 1), tl = g & 127; const size_t wo = ((size_t)layer * NEXP + e) * 1024 * 512; MoeTile m;
    if (job < 2) { m.src = (job ? p.w_up : p.w_gate) + wo; m.N = 512; m.dst = (unsigned char*)(p.ws + WS_GU) + (size_t)e * 1024 * 1024; m.ldd = 1024; m.k0 = (tl >> 3) * 64; m.n0 = (tl & 7) * 64; m.rowadd = job * 128; m.gated = 1; }
    else { m.src = p.w_down + wo; m.N = 1024; m.dst = (unsigned char*)(p.ws + WS_DN) + dn_off + (size_t)e * 1024 * 512; m.ldd = 512; m.k0 = (tl >> 4) * 64; m.n0 = (tl & 15) * 64; m.rowadd = 0; m.gated = 0; }
    return m;
}
__device__ __forceinline__ void moe_tile_load(f32x4 (&v)[16], const MoeTile& m, int lane) {
#pragma unroll
    for (int i = 0; i < 16; ++i) { const int r = i * 4 + (lane >> 4), cc = m.n0 + (lane & 15) * 4; v[i] = __builtin_nontemporal_load((const f32x4*)(m.src + (size_t)(m.k0 + r) * m.N + cc)); }
}
__device__ __forceinline__ void moe_tile_finish(const f32x4 (&v)[16], const MoeTile& m, LAS float* t, int lane) {
#pragma unroll
    for (int i = 0; i < 16; ++i) { const int r = i * 4 + (lane >> 4), cc = (lane & 15) * 4; LAS float* q = t + r * 65 + cc; q[0] = v[i][0]; q[1] = v[i][1]; q[2] = v[i][2]; q[3] = v[i][3]; }
    asm volatile("s_waitcnt lgkmcnt(0)" ::: "memory");
#pragma unroll
    for (int i = 0; i < 8; ++i) { const int nr = i * 8 + (lane >> 3), kc = (lane & 7) * 8; float f[8];
#pragma unroll
        for (int j = 0; j < 8; ++j) f[j] = t[(kc + j) * 65 + nr];
        const int n = m.n0 + nr; const int drow = m.gated ? (256 * (n >> 7) + (n & 127) + m.rowadd) : n;
        u32x2 w8; w8.x = cvt4_fp8(f[0] * F8_SW, f[1] * F8_SW, f[2] * F8_SW, f[3] * F8_SW); w8.y = cvt4_fp8(f[4] * F8_SW, f[5] * F8_SW, f[6] * F8_SW, f[7] * F8_SW);
        *(u32x2*)(m.dst + (size_t)drow * m.ldd + m.k0 + kc) = w8; }
    asm volatile("s_waitcnt lgkmcnt(0)" ::: "memory");
}
__device__ __forceinline__ void conv_moe_stream(const Params& p, int layer, int which, size_t dn_off, LAS unsigned char* lds, int gw, int ngw, int gbeg = 0, int gend = -1) {
    const int tid = otid(), lane = tid & 63, wid = tid >> 6;
    LAS float* t = (LAS float*)(lds + wid * (64 * 65 * 4));
    const int NTILE = gend >= 0 ? gend : (which ? NEXP * 128 : NEXP * 256);
    f32x4 va[16], vb[16];
    int g = gbeg + gw;
    if (g < NTILE) { const MoeTile m = moe_tile(p, layer, g, which, dn_off); moe_tile_load(va, m, lane); }
    while (g < NTILE) {
        { const int gn = g + ngw; if (gn < NTILE) { const MoeTile mn = moe_tile(p, layer, gn, which, dn_off); moe_tile_load(vb, mn, lane); }
          const MoeTile m = moe_tile(p, layer, g, which, dn_off); moe_tile_finish(va, m, t, lane); g = gn; }
        if (g >= NTILE) break;
        { const int gn = g + ngw; if (gn < NTILE) { const MoeTile mn = moe_tile(p, layer, gn, which, dn_off); moe_tile_load(va, mn, lane); }
          const MoeTile m = moe_tile(p, layer, g, which, dn_off); moe_tile_finish(vb, m, t, lane); g = gn; }
    }
}
__device__ __forceinline__ void phase_prologue(const Params& p, LAS unsigned char* lds) {
    const int tid = otid(), lane = tid & 63, wid = tid >> 6, gw = blockIdx.x * 8 + wid, ngw = gridDim.x * 8;
    LAS float* t = (LAS float*)(lds + wid * (64 * 65 * 4));
    char* ws = p.ws;
    { const size_t n8 = (size_t)NTOK * 1024 / 8; bf16_t* xb = (bf16_t*)(ws + WS_XB);
      for (size_t i = (size_t)blockIdx.x * NTHREADS + tid; i < n8; i += (size_t)gridDim.x * NTHREADS) {
          const f32x4 a = __builtin_nontemporal_load((const f32x4*)(p.x + i * 8)), b = __builtin_nontemporal_load((const f32x4*)(p.x + i * 8 + 4));
          u32x4 w; w.x = cvt_pk_bf16(a[0], a[1]); w.y = cvt_pk_bf16(a[2], a[3]); w.z = cvt_pk_bf16(b[0], b[1]); w.w = cvt_pk_bf16(b[2], b[3]);
          *(u32x4*)(xb + i * 8) = w;
          u32x2 w8; w8.x = cvt4_i8(a[0] * I8_SX, a[1] * I8_SX, a[2] * I8_SX, a[3] * I8_SX); w8.y = cvt4_i8(b[0] * I8_SX, b[1] * I8_SX, b[2] * I8_SX, b[3] * I8_SX);
          *(u32x2*)((unsigned char*)(ws + WS_X1Q) + i * 8) = w8; } }
    int tile0 = 0;
    tile0 = conv_job(p.moba_w_in, 1024, 3072, 3072, (bf16_t*)(ws + WS_WQKV0), 1024, 0, 6, tile0, t, gw, ngw, lane);
    tile0 = conv_job(p.moba_w_out, 1024, 1024, 1024, (bf16_t*)(ws + WS_WO0), 1024, 0, 2, tile0, t, gw, ngw, lane);
    tile0 = conv_job(p.nsa_w_in, 1024, 2608, 2816, (bf16_t*)(ws + WS_WIN1), 1024, 0, 6, tile0, t, gw, ngw, lane);
    tile0 = conv_job(p.nsa_w_out, 1024, 1024, 1024, (bf16_t*)(ws + WS_WO1), 1024, 0, 2, tile0, t, gw, ngw, lane);
    tile0 = conv_job(p.ck_w1, 2048, 256, 256, (bf16_t*)(ws + WS_W1T), 2048, 0, 0, tile0, t, gw, ngw, lane);
    tile0 = conv_job(p.cv_w1, 2048, 256, 256, (bf16_t*)(ws + WS_W1T) + 256 * 2048, 2048, 0, 0, tile0, t, gw, ngw, lane);
    conv_moe_stream(p, 0, 0, 0, lds, gw, ngw); conv_moe_stream(p, 0, 1, 0, lds, gw, ngw);
    for (int i = blockIdx.x * NTHREADS + tid; i < 16 * BT_H; i += gridDim.x * NTHREADS) {
        const int h = i / BT_H, k = (i % BT_H) / BT_S, j = i % BT_S; int e = (BT_N - 1) - (j + k); e = e < 0 ? 0 : e;
        int n = e - 63; const bool future = n < 0; n = n < 0 ? 0 : (n > 127 ? 127 : n);
        int bk = n;
        if (n >= 16) { bk = 16 + (int)(logf((float)n / 16.0f) / logf(8.0f) * 16.0f); bk = bk > 31 ? 31 : bk; }
        ((float*)(ws + WS_TAB))[i] = future ? -INFINITY : p.rel_bias[bk * 16 + h] * LOG2E; }
    if (gridDim.x == 256) {
        __syncthreads();
        const int combo = blockIdx.x >> 2, kv = combo >> 5, part = combo & 31, jj = tid & 63, ks = tid >> 6, j = (blockIdx.x & 3) * 64 + jj;
        const float* pos = kv ? p.pos_v : p.pos_k; const float* w1 = kv ? p.cv_w1 : p.ck_w1; float s = 0.f;
#pragma unroll
        for (int k = part * 64 + ks * 8; k < part * 64 + ks * 8 + 8; ++k) s += pos[k] * w1[(size_t)k * 256 + j];
        LAS float* red = (LAS float*)lds; red[ks * 64 + jj] = s;
        __syncthreads();
        if (tid < 64) { float a = 0.f;
#pragma unroll
            for (int q8 = 0; q8 < 8; ++q8) a += red[q8 * 64 + tid];
            ((float*)(ws + WS_B1))[(kv * 32 + part) * 256 + j] = a; }
    } else if (blockIdx.x < 32) { const int kv = blockIdx.x >> 4, part = (blockIdx.x & 15) * 2 + (tid >> 8), j = tid & 255;
        const float* pos = kv ? p.pos_v : p.pos_k; const float* w1 = kv ? p.cv_w1 : p.ck_w1; float s = 0.f;
#pragma unroll 16
        for (int k = part * 64; k < part * 64 + 64; ++k) s += pos[k] * w1[(size_t)k * 256 + j];
        ((float*)(ws + WS_B1))[(kv * 32 + part) * 256 + j] = s; }
}

__device__ __forceinline__ void store_o_rows(LAS unsigned char* stg, unsigned char* grow0, const f32x16& a0, const f32x16& a1, float scale, int lane, int r32, int hi) {
    LAS unsigned char* sp = stg + r32 * 80 + hi * 4; const float s16 = scale * F8_SO;
#pragma unroll
    for (int g4 = 0; g4 < 4; ++g4) {
        *(LAS unsigned*)(sp + g4 * 8) = cvt4_fp8(a0[4 * g4] * s16, a0[4 * g4 + 1] * s16, a0[4 * g4 + 2] * s16, a0[4 * g4 + 3] * s16);
        *(LAS unsigned*)(sp + 32 + g4 * 8) = cvt4_fp8(a1[4 * g4] * s16, a1[4 * g4 + 1] * s16, a1[4 * g4 + 2] * s16, a1[4 * g4 + 3] * s16); }
    asm volatile("s_waitcnt lgkmcnt(0)" ::: "memory");
#pragma unroll
    for (int it = 0; it < 2; ++it) { const int row = it * 16 + (lane >> 2), ch = lane & 3;
        const u32x4 v = *(const LAS u32x4*)(stg + row * 80 + ch * 16);
        *(u32x4*)(grow0 + (size_t)row * 1024 + ch * 16) = v; }
    asm volatile("s_waitcnt lgkmcnt(0)" ::: "memory");
}
template <int VAR> __device__ __forceinline__ void moba_unit(const Params& p, LAS unsigned char* lds, int b, int h, int qb) {
    const int tid = otid(), lane = tid & 63, r32 = lane & 31, hi = lane >> 5; const int wid = __builtin_amdgcn_readfirstlane(tid >> 6);
    const bf16_t* QKV = (const bf16_t*)(p.ws + WS_BIG);
    const size_t rowbase = (size_t)b * SEQ; const int q0 = qb * 256, qw = q0 + wid * 32;
    const bf16_t* Kb = QKV + rowbase * QKV_LD + 1024 + h * 64; const bf16_t* Vb = QKV + rowbase * QKV_LD + 2048 + h * 64;
    bf16x8 qr[4];
    { const bf16_t* qp = QKV + (rowbase + qw + r32) * QKV_LD + h * 64 + hi * 8;
#pragma unroll
      for (int d0 = 0; d0 < 4; ++d0) qr[d0] = *(const bf16x8*)(qp + d0 * 16); }
    float kmv, btv[3];
    { const float* kp = (const float*)(p.ws + WS_KPART); const int j = tid >> 6, d = tid & 63;
      const float* s = kp + ((size_t)(b * 8 + j) * 2) * 1024 + h * 64 + d; kmv = s[0] + s[1024];
#pragma unroll
      for (int i = 0; i < 3; ++i) { const int ix = tid + i * NTHREADS; btv[i] = ((const float*)(p.ws + WS_TAB))[h * BT_H + (ix < BT_H ? ix : 0)]; } }
    __syncthreads();
    dma_k(Kb + (size_t)q0 * QKV_LD, QKV_LD, lds, 0, wid, lane); dma_v(Vb + (size_t)q0 * QKV_LD, QKV_LD, lds, 0, wid, lane);
    dma_k(Kb + (size_t)(q0 + 64) * QKV_LD, QKV_LD, lds, 1, wid, lane); dma_v(Vb + (size_t)(q0 + 64) * QKV_LD, QKV_LD, lds, 1, wid, lane);
    ((LAS float*)(lds + AL_KM))[tid] = kmv;
#pragma unroll
    for (int i = 0; i < 3; ++i) { const int ix = tid + i * NTHREADS; if (ix < BT_H) ((LAS float*)(lds + AL_BIAS))[ix] = btv[i]; }
    const int NT = 4 + 4 * qb;
    __syncthreads();
    unsigned sel = 0;
    { float g[8];
#pragma unroll
      for (int j = 0; j < 8; ++j) { float s = 0.f; const LAS float* km = (const LAS float*)(lds + AL_KM) + j * 64 + hi * 8;
#pragma unroll
          for (int d0 = 0; d0 < 4; ++d0)
#pragma unroll
              for (int i = 0; i < 8; ++i) s += bf2f((bf16_t)qr[d0][i]) * km[d0 * 16 + i];
          g[j] = xhalf_sum(s); }
#pragma unroll
      for (int round = 0; round < 3; ++round) { int best = -1; float bv = 0.f;
#pragma unroll
          for (int j = 0; j < 8; ++j) { const bool ok = (j < qb) && !((sel >> j) & 1u) && (best < 0 || g[j] > bv); if (ok) { best = j; bv = g[j]; } }
          if (best >= 0) sel |= 1u << best; } }
    const LAS float* btab = (const LAS float*)(lds + AL_BIAS); const float cfar = btab[0];
    FState st; fstate_reset(st);
    struct MobaSrc {
        const bf16_t *Kb, *Vb; LAS unsigned char* lds; int qb, qw, wid, lane; unsigned sel;
        __device__ __forceinline__ void tile(int t, int& blk, int& kt) const { blk = t < 4 ? qb : qb - 1 - ((t - 4) >> 2); kt = t < 4 ? t : ((t - 4) & 3); }
        __device__ __forceinline__ void dma(int t, int ks, int vs) const { int blk, kt; tile(t, blk, kt); const size_t key0 = (size_t)blk * 256 + kt * 64;
            dma_k(Kb + key0 * QKV_LD, QKV_LD, lds, ks, wid, lane); dma_v(Vb + key0 * QKV_LD, QKV_LD, lds, vs, wid, lane); }
        __device__ __forceinline__ TileP params(int t) const { int blk, kt; tile(t, blk, kt); TileP tp; tp.Dmin = qw - (blk * 256 + kt * 64); tp.win = false;
            if (blk == qb) { tp.rowok = true; tp.run = (64 * kt <= wid * 32 + 31); } else { tp.rowok = (sel >> blk) & 1u; tp.run = __any(tp.rowok); }
            return tp; }
        __device__ __forceinline__ void dma_pre(int t, int ks, int vs) const { dma(t, ks, vs); }
        __device__ __forceinline__ void prefetch(int) const {}
        __device__ __forceinline__ void after(int, FState&) const {}
    } S{Kb, Vb, lds, qb, qw, wid, lane, sel};
    attn_stream<VAR, MobaSrc, true>(S, NT, st, qr, lds, btab, cfar, wid, lane, r32, hi);
    const float inv = 1.0f / xhalf_sum(st.l);
    store_o_rows(lds + AL_IMP + wid * 8192, (unsigned char*)(p.ws + (VAR ? WS_X1B : WS_AOH)) + (size_t)(rowbase + qw) * 1024 + h * 64, st.o0, st.o1, inv, lane, r32, hi);
}
template <int VAR> __device__ __forceinline__ void phase_moba(const Params& p, LAS unsigned char* lds) {
    for (int pr = blockIdx.x, rnd = 0; pr < 1024; pr += gridDim.x, ++rnd) { const int x = blockIdx.x & 7, s = blockIdx.x >> 3; const int bh = (gridDim.x == 256) ? (x + 8 * (rnd * 8 + (s >> 2))) : (pr >> 2), j = (gridDim.x == 256) ? (s & 3) : (pr & 3);
        moba_unit<VAR>(p, lds, bh >> 4, bh & 15, 7 - j);
        moba_unit<VAR>(p, lds, bh >> 4, bh & 15, j); }
    __syncthreads();
}

__device__ __forceinline__ void nsa_unit(const Params& p, LAS unsigned char* lds, int b, int hkv, int c, bool load_tab, bool load_cmp) {
    const int tid = otid(), lane = tid & 63, r32 = lane & 31, hi = lane >> 5; const int wid = __builtin_amdgcn_readfirstlane(tid >> 6);
    const bf16_t* P = (const bf16_t*)(p.ws + WS_BIG);
    const size_t rowbase = (size_t)b * SEQ; const int g = wid >> 1, qq0 = (wid & 1) * 32, h = hkv * 4 + g, qw = c * 64 + qq0, qpos = qw + r32;
    bf16x8 qr[4];
    const bf16_t* rowp = P + (rowbase + qpos) * NSA_LD;
#pragma unroll
    for (int d0 = 0; d0 < 4; ++d0) qr[d0] = *(const bf16x8*)(rowp + h * 64 + hi * 8 + d0 * 16);
    const float g0 = bf2f(rowp[NSA_G + h * 3]), g1 = bf2f(rowp[NSA_G + h * 3 + 1]), g2 = bf2f(rowp[NSA_G + h * 3 + 2]);
    __syncthreads();
    if (load_tab) { for (int i = tid; i < 4 * BT_H; i += NTHREADS) ((LAS float*)(lds + AL_BIAS))[i] = ((const float*)(p.ws + WS_TAB))[hkv * 4 * BT_H + i]; }
    if (tid < 64) ((LAS unsigned*)(lds + AL_SEL))[tid] = 0u;
    const bf16_t* KS = P + rowbase * NSA_LD + NSA_KS + hkv * 64; const bf16_t* VS = P + rowbase * NSA_LD + NSA_VS + hkv * 64;
    if (load_cmp) { const bf16_t* kc = (const bf16_t*)(p.ws + WS_KCMP) + (size_t)(b * 4 + hkv) * 128 * 64; const bf16_t* vc = (const bf16_t*)(p.ws + WS_VCMP) + (size_t)(b * 4 + hkv) * 128 * 64;
      dma_k(kc, 64, lds, 0, wid, lane, AL_CMP); dma_k(kc + 64 * 64, 64, lds, 1, wid, lane, AL_CMP); dma_v(vc, 64, lds, 2, wid, lane, AL_CMP); dma_v(vc + 64 * 64, 64, lds, 3, wid, lane, AL_CMP); }
    dma_k(KS, NSA_LD, lds, 0, wid, lane); dma_v(VS, NSA_LD, lds, 0, wid, lane);
    asm volatile("s_waitcnt vmcnt(2)" ::: "memory");
    __syncthreads();
    const lds_cptr kp0 = (lds_cptr)lds + AL_CMP + r32 * 128; const int kx = (r32 & 7) | (hi << 3);
    const lds_cptr vp0 = (lds_cptr)lds + AL_CMP + 16384 + ((lane >> 4) & 1) * 32 + (lane & 3) * 8 + (4 * hi + ((lane & 15) >> 2)) * 64;
    f32x16 cb0, cb1;
    {
        f32x16 s[2][2];
        const int nlim = (qpos >= 31 ? ((qpos - 31) >> 4) + 1 : 0) - 4 * hi;
#pragma unroll
        for (int t = 0; t < 2; ++t) {
#pragma unroll
            for (int r = 0; r < 16; ++r) { s[t][0][r] = 0.f; s[t][1][r] = 0.f; }
            qk_tile(s[t][0], s[t][1], qr, kp0 + t * 8192, kx);
#pragma unroll
            for (int n2 = 0; n2 < 2; ++n2)
#pragma unroll
                for (int r = 0; r < 16; ++r) { const int nk = 64 * t + 32 * n2 + (r & 3) + 8 * (r >> 2); if (nk >= nlim) s[t][n2][r] = -INFINITY; }
        }
        const float mx = xhalf_max(__builtin_fmaxf(__builtin_fmaxf(max16(s[0][0]), max16(s[0][1])), __builtin_fmaxf(max16(s[1][0]), max16(s[1][1]))));
        const float mref = (mx == -INFINITY) ? 0.f : mx;
        float rs = 0.f;
#pragma unroll
        for (int t = 0; t < 2; ++t)
#pragma unroll
            for (int n2 = 0; n2 < 2; ++n2)
#pragma unroll
                for (int r = 0; r < 16; ++r) { const float e = __builtin_amdgcn_exp2f(s[t][n2][r] - mref); s[t][n2][r] = e; rs += e; }
        const float lt = xhalf_sum(rs); const float inv = lt > 0.f ? 1.0f / lt : 0.f;
#pragma unroll
        for (int t = 0; t < 2; ++t)
#pragma unroll
            for (int n2 = 0; n2 < 2; ++n2)
#pragma unroll
                for (int r = 0; r < 16; ++r) s[t][n2][r] *= inv;
        float Q[16], T[16];
#pragma unroll
        for (int t = 0; t < 2; ++t)
#pragma unroll
            for (int n2 = 0; n2 < 2; ++n2)
#pragma unroll
                for (int r4 = 0; r4 < 4; ++r4) { const int u = 8 * t + 4 * n2 + r4; Q[u] = (s[t][n2][4 * r4] + s[t][n2][4 * r4 + 1]) + (s[t][n2][4 * r4 + 2] + s[t][n2][4 * r4 + 3]); T[u] = s[t][n2][4 * r4 + 3]; }
        LAS float* imp = (LAS float*)(lds + AL_IMP) + (g * 64 + qq0 + r32) * 33;
        float prev = 0.f;
#pragma unroll
        for (int u = 0; u < 16; ++u) { const float rcv = __shfl_xor(T[u], 32); const float add = hi ? rcv : prev; prev = rcv; imp[2 * u + hi] = Q[u] + add; }
        f32x16 o0, o1;
#pragma unroll
        for (int r = 0; r < 16; ++r) { o0[r] = 0.f; o1[r] = 0.f; }
        pv_tile(o0, o1, s[0][0], s[0][1], vp0); pv_tile(o0, o1, s[1][0], s[1][1], vp0 + 8192);
#pragma unroll
        for (int r = 0; r < 16; ++r) { cb0[r] = g0 * o0[r]; cb1[r] = g0 * o1[r]; }
    }
    __syncthreads();
    {
        const int q = tid >> 3, jg = tid & 7; const LAS float* ib = (const LAS float*)(lds + AL_IMP) + q * 33;
        float val[32];
#pragma unroll
        for (int j = 0; j < 32; ++j) { float v = (ib[j] + ib[64 * 33 + j]) + (ib[2 * 64 * 33 + j] + ib[3 * 64 * 33 + j]);
            const bool forced = (j == 0) || (j == c) || (j == c - 1); v = forced ? INFINITY : v; val[j] = (j > c) ? -INFINITY : v; }
        unsigned bits = 0;
#pragma unroll
        for (int i = 0; i < 4; ++i) { const int j = jg * 4 + i; float vj = 0.f;
#pragma unroll
            for (int jj = 0; jj < 32; ++jj) vj = (jj == j) ? val[jj] : vj;
            int rank = 0;
#pragma unroll
            for (int jj = 0; jj < 32; ++jj) rank += (val[jj] > vj || (val[jj] == vj && jj < j)) ? 1 : 0;
            if (j <= c && rank < 16) bits |= 1u << j; }
        if (bits) atomicOr((unsigned*)(lds + AL_SEL) + q, bits);
    }
    __syncthreads();
    unsigned uni = ((const LAS unsigned*)(lds + AL_SEL))[lane];
#pragma unroll
    for (int o = 32; o > 0; o >>= 1) uni |= (unsigned)__shfl_xor((int)uni, o);
    uni = (unsigned)__builtin_amdgcn_readfirstlane((int)uni);
    const unsigned rowmask = ((const LAS unsigned*)(lds + AL_SEL))[qq0 + r32];
    const LAS float* btab = (const LAS float*)(lds + AL_BIAS) + g * BT_H; const float cfar = btab[0];
    const bf16_t* KW = P + rowbase * NSA_LD + NSA_KW + hkv * 64; const bf16_t* VW = P + rowbase * NSA_LD + NSA_VW + hkv * 64;
    const int nslc = __builtin_popcount(uni); const int wlo = c >= 8 ? 0 : 8 - c; const int NT = nslc + (9 - wlo);
    LAS int* list = (LAS int*)(lds + AL_LIST);
    if (tid < 32) { if ((uni >> tid) & 1u) list[__builtin_popcount(uni & ((1u << tid) - 1u))] = tid; }
    else if (tid < 32 + 9 - wlo) list[nslc + (tid - 32)] = 64 + (c - 8 + wlo + (tid - 32));
    __syncthreads();
    FState st; fstate_reset(st);
    struct NsaSrc {
        const bf16_t *KS, *VS, *KW, *VW; LAS unsigned char* lds; const LAS int* list; int nslc, qw, wid, lane; unsigned rowmask; float g1; f32x16* cb0; f32x16* cb1; int pre_d, pre_p;
        __device__ __forceinline__ void prefetch(int t) { pre_d = list[t + 3]; pre_p = list[t + 1]; }
        __device__ __forceinline__ void dma_pre(int, int ks, int vs) const { const int e = __builtin_amdgcn_readfirstlane(pre_d);
            if (e < 64) { dma_k(KS + (size_t)e * 64 * NSA_LD, NSA_LD, lds, ks, wid, lane); dma_v(VS + (size_t)e * 64 * NSA_LD, NSA_LD, lds, vs, wid, lane); }
            else { dma_k(KW + (size_t)(e - 64) * 64 * NSA_LD, NSA_LD, lds, ks, wid, lane); dma_v(VW + (size_t)(e - 64) * 64 * NSA_LD, NSA_LD, lds, vs, wid, lane); } }
        __device__ __forceinline__ void dma(int t, int ks, int vs) const { const int e = __builtin_amdgcn_readfirstlane(list[t]);
            if (e < 64) { dma_k(KS + (size_t)e * 64 * NSA_LD, NSA_LD, lds, ks, wid, lane); dma_v(VS + (size_t)e * 64 * NSA_LD, NSA_LD, lds, vs, wid, lane); }
            else { dma_k(KW + (size_t)(e - 64) * 64 * NSA_LD, NSA_LD, lds, ks, wid, lane); dma_v(VW + (size_t)(e - 64) * 64 * NSA_LD, NSA_LD, lds, vs, wid, lane); } }
        __device__ __forceinline__ TileP params(int) const { const int e = __builtin_amdgcn_readfirstlane(pre_p); TileP tp;
            if (e < 64) { tp.Dmin = qw - 64 * e; tp.rowok = (rowmask >> e) & 1u; tp.run = __any(tp.rowok); tp.win = false; }
            else { tp.Dmin = qw - 64 * (e - 64); tp.rowok = true; tp.run = true; tp.win = true; }
            return tp; }
        __device__ __forceinline__ void after(int t, FState& st) const {
            if (t == nslc - 1) { const float f = g1 / xhalf_sum(st.l);
#pragma unroll
                for (int r = 0; r < 16; ++r) { (*cb0)[r] += f * st.o0[r]; (*cb1)[r] += f * st.o1[r]; }
                fstate_reset(st); } }
    } S{KS, VS, KW, VW, lds, list, nslc, qw, wid, lane, rowmask, g1, &cb0, &cb1, 0, 0};
    S.dma(1, 1, 1);
    attn_stream<0, NsaSrc, true>(S, NT, st, qr, lds, btab, cfar, wid, lane, r32, hi);
    { const float f = g2 / xhalf_sum(st.l);
#pragma unroll
      for (int r = 0; r < 16; ++r) { cb0[r] += f * st.o0[r]; cb1[r] += f * st.o1[r]; } }
    store_o_rows(lds + AL_IMP + wid * 4096, (unsigned char*)(p.ws + WS_AOH) + (size_t)(rowbase + qw) * 1024 + h * 64, cb0, cb1, 1.0f, lane, r32, hi);
}
__device__ __forceinline__ void phase_nsa(const Params& p, LAS unsigned char* lds) {
    int last_hkv = -1;
    for (int pr = blockIdx.x, rnd = 0; pr < 1024; pr += gridDim.x, ++rnd) { const int x = blockIdx.x & 7, s = blockIdx.x >> 3; const int bh = (gridDim.x == 256) ? (x + 8 * (rnd * 2 + (s >> 4))) : (pr >> 4), j = (gridDim.x == 256) ? ((s + 4 * rnd) & 15) : (pr & 15);
        nsa_unit(p, lds, bh >> 2, bh & 3, 31 - j, (bh & 3) != last_hkv, true);
        nsa_unit(p, lds, bh >> 2, bh & 3, j, false, false); last_hkv = bh & 3; }
    __syncthreads();
}

template <int L> __device__ __forceinline__ void phase_ln1(const Params& p, LAS unsigned char* lds) {
    const int tid = otid(), lane = tid & 63, wid = tid >> 6, r = lane & 15, q = lane >> 4;
    const float* lg = p.ln_g + (L * 2 + 0) * 1024; const float* lb = p.ln_b + (L * 2 + 0) * 1024;
    const bf16_t* Y = (const bf16_t*)(p.ws + WS_BIG); bf16_t* X1 = (bf16_t*)(p.ws + WS_X1B);
    for (int i = tid; i < 32 * 2 * 64; i += NTHREADS) { const int l2 = i & 63, nb = (i >> 6) & 1, s = i >> 7; const int e = 16 * nb + (l2 & 15), k0 = 32 * s + 8 * (l2 >> 4);
        float w[8]; unsigned hw[4], lw[4];
#pragma unroll
        for (int j = 0; j < 8; ++j) w[j] = p.router_w[(size_t)(k0 + j) * 32 + e];
#pragma unroll
        for (int j = 0; j < 4; ++j) { hw[j] = cvt_pk_bf16(w[2 * j], w[2 * j + 1]); lw[j] = cvt_pk_bf16(w[2 * j] - lo_bf(hw[j]), w[2 * j + 1] - hi_bf(hw[j])); }
        *(LAS u32x4*)(lds + ((size_t)((s * 2 + nb) * 2 + 0) * 64 + l2) * 16) = (u32x4){hw[0], hw[1], hw[2], hw[3]};
        *(LAS u32x4*)(lds + ((size_t)((s * 2 + nb) * 2 + 1) * 64 + l2) * 16) = (u32x4){lw[0], lw[1], lw[2], lw[3]}; }
    LAS int* hist = (LAS int*)(lds + 131072 + 8 * 2048);
    if (tid < 32) hist[tid] = 0;
    __syncthreads();
    for (int tb = blockIdx.x; tb < NTOK / 128; tb += gridDim.x) {
        const int tok = tb * 128 + wid * 16 + r;
        const bf16_t* yp = Y + (size_t)tok * 1024 + 8 * q;
        float sum = 0.f, sq = 0.f;
#pragma unroll 16
        for (int s = 0; s < 32; ++s) { const u32x4 y = *(const u32x4*)(yp + 32 * s); const unsigned yw[4] = {y.x, y.y, y.z, y.w};
#pragma unroll
            for (int j = 0; j < 4; ++j) { const float a = lo_bf(yw[j]), b2 = hi_bf(yw[j]); sum += a + b2; sq += a * a + b2 * b2; } }
        sum += __shfl_xor(sum, 16); sum += __shfl_xor(sum, 32); sq += __shfl_xor(sq, 16); sq += __shfl_xor(sq, 32);
        const float mu = sum * (1.0f / 1024.0f);
        const float rstd = rsqrtf(fmaxf(sq * (1.0f / 1024.0f) - mu * mu, 0.f) + 1e-5f);
        f32x4 acc0 = (f32x4){0.f, 0.f, 0.f, 0.f}, acc1 = acc0;
        bf16_t* xp = X1 + (size_t)tok * 1024 + 8 * q; unsigned char* xq = (unsigned char*)(p.ws + WS_X1Q) + (size_t)tok * 1024 + 8 * q;
#pragma unroll 4
        for (int s = 0; s < 32; ++s) {
            const u32x4 y = *(const u32x4*)(yp + 32 * s);
            const f32x4 ga = *(const f32x4*)(lg + 32 * s + 8 * q), gb = *(const f32x4*)(lg + 32 * s + 8 * q + 4), ba = *(const f32x4*)(lb + 32 * s + 8 * q), bb = *(const f32x4*)(lb + 32 * s + 8 * q + 4);
            u32x4 w;
            const float x0 = (lo_bf(y.x) - mu) * rstd * ga[0] + ba[0], x1 = (hi_bf(y.x) - mu) * rstd * ga[1] + ba[1], x2 = (lo_bf(y.y) - mu) * rstd * ga[2] + ba[2], x3 = (hi_bf(y.y) - mu) * rstd * ga[3] + ba[3];
            const float x4 = (lo_bf(y.z) - mu) * rstd * gb[0] + bb[0], x5 = (hi_bf(y.z) - mu) * rstd * gb[1] + bb[1], x6 = (lo_bf(y.w) - mu) * rstd * gb[2] + bb[2], x7 = (hi_bf(y.w) - mu) * rstd * gb[3] + bb[3];
            w.x = cvt_pk_bf16(x0, x1); w.y = cvt_pk_bf16(x2, x3); w.z = cvt_pk_bf16(x4, x5); w.w = cvt_pk_bf16(x6, x7);
            *(u32x4*)(xp + 32 * s) = w;
            { u32x2 w8; w8.x = cvt4_fp8(x0 * F8_SX, x1 * F8_SX, x2 * F8_SX, x3 * F8_SX); w8.y = cvt4_fp8(x4 * F8_SX, x5 * F8_SX, x6 * F8_SX, x7 * F8_SX); *(u32x2*)(xq + 32 * s) = w8; }
            const bf16x8 af = __builtin_bit_cast(bf16x8, w);
            const LAS unsigned char* bq = lds + (size_t)s * 4096 + lane * 16;
            const bf16x8 b0h = *(const LAS bf16x8*)(bq), b0l = *(const LAS bf16x8*)(bq + 1024), b1h = *(const LAS bf16x8*)(bq + 2048), b1l = *(const LAS bf16x8*)(bq + 3072);
            acc0 = __builtin_amdgcn_mfma_f32_16x16x32_bf16(af, b0h, acc0, 0, 0, 0); acc0 = __builtin_amdgcn_mfma_f32_16x16x32_bf16(af, b0l, acc0, 0, 0, 0);
            acc1 = __builtin_amdgcn_mfma_f32_16x16x32_bf16(af, b1h, acc1, 0, 0, 0); acc1 = __builtin_amdgcn_mfma_f32_16x16x32_bf16(af, b1l, acc1, 0, 0, 0);
        }
        LAS float* lg2 = (LAS float*)(lds + 131072 + wid * 2048);
#pragma unroll
        for (int i = 0; i < 4; ++i) { lg2[(4 * q + i) * 32 + r] = acc0[i] + p.router_b[r]; lg2[(4 * q + i) * 32 + 16 + r] = acc1[i] + p.router_b[16 + r]; }
        asm volatile("s_waitcnt lgkmcnt(0)" ::: "memory");
        int e0 = 0, e1 = 0, r0 = 0, r1 = 0; float w0 = 0.f, w1 = 0.f;
        if (lane < 16) {
            float pr[32]; float mx = -INFINITY;
#pragma unroll
            for (int e = 0; e < 32; ++e) { pr[e] = lg2[lane * 32 + e]; mx = fmaxf(mx, pr[e]); }
#pragma unroll
            for (int e = 0; e < 32; ++e) pr[e] = __expf(pr[e] - mx);
            int best = 0; float bs = -1.f;
#pragma unroll
            for (int gi = 0; gi < 8; ++gi) { const float a = pr[4 * gi], b2 = pr[4 * gi + 1], c2 = pr[4 * gi + 2], d2 = pr[4 * gi + 3];
                const float h1 = fmaxf(a, b2), l1 = fminf(a, b2), h2 = fmaxf(c2, d2), l2 = fminf(c2, d2);
                const float m1 = fmaxf(h1, h2), m2 = fmaxf(fminf(h1, h2), fmaxf(l1, l2));
                const float sc = m1 + m2; if (sc > bs) { bs = sc; best = gi; } }
            float v[4];
#pragma unroll
            for (int gi = 0; gi < 8; ++gi) if (gi == best) { v[0] = pr[4 * gi]; v[1] = pr[4 * gi + 1]; v[2] = pr[4 * gi + 2]; v[3] = pr[4 * gi + 3]; }
            int i0 = 0; float v0 = v[0];
#pragma unroll
            for (int i = 1; i < 4; ++i) if (v[i] > v0) { v0 = v[i]; i0 = i; }
            int i1 = -1; float v1 = -1.f;
#pragma unroll
            for (int i = 0; i < 4; ++i) if (i != i0 && v[i] > v1) { v1 = v[i]; i1 = i; }
            e0 = best * 4 + i0; e1 = best * 4 + i1; const float ws = 1.0f / (v0 + v1); w0 = v0 * ws; w1 = v1 * ws;
            r0 = atomicAdd((int*)hist + e0, 1); r1 = atomicAdd((int*)hist + e1, 1);
        }
        __syncthreads();
        if (tid < 32) { const int hv = hist[tid]; hist[32 + tid] = hv ? atomicAdd((int*)(p.ws + WS_GCNT) + L * 32 + tid, hv) : 0; }
        __syncthreads();
        if (lane < 16) { const int t2 = tb * 128 + wid * 16 + lane; const int s0 = hist[32 + e0] + r0, s1 = hist[32 + e1] + r1;
            ((int*)(p.ws + WS_RE))[t2 * 2] = e0; ((int*)(p.ws + WS_RE))[t2 * 2 + 1] = e1;
            ((float*)(p.ws + WS_RWT))[t2 * 2] = w0 * (1.0f / F8_SY); ((float*)(p.ws + WS_RWT))[t2 * 2 + 1] = w1 * (1.0f / F8_SY);
            ((int*)(p.ws + WS_POS))[t2 * 2] = s0; ((int*)(p.ws + WS_POS))[t2 * 2 + 1] = s1;
            ((int*)(p.ws + WS_ROWTOK))[e0 * 65536 + s0] = t2; ((int*)(p.ws + WS_ROWTOK))[e1 * 65536 + s1] = t2; }
        __syncthreads();
        if (tid < 32) hist[tid] = 0;
        __syncthreads();
    }
}

template <int L> __device__ __forceinline__ void phase_ln2(const Params& p, LAS unsigned char* lds) {
    const int tid = otid(), lane = tid & 63, wid = tid >> 6;
    LAS int* pst = (LAS int*)lds;
    __syncthreads();
    if (tid == 0) { const int* cnt = (const int*)(p.ws + WS_GCNT) + L * 32; int s = 0; for (int e = 0; e < NEXP; ++e) { pst[e] = s; s += (cnt[e] + 255) & ~255; } }
    __syncthreads();
    const int* RE = (const int*)(p.ws + WS_RE);
    const float* lg = p.ln_g + (L * 2 + 1) * 1024; const float* lb = p.ln_b + (L * 2 + 1) * 1024;
    const bf16_t* X1 = (const bf16_t*)(p.ws + WS_X1B); const unsigned char* YB = (const unsigned char*)(p.ws + WS_BIG);
    const int* POS = (const int*)(p.ws + WS_POS); const float* RW = (const float*)(p.ws + WS_RWT);
    const int tok0 = blockIdx.x * 8 + wid, tstride = gridDim.x * 8, nk = (NTOK - tok0 + tstride - 1) / tstride;
    int rs0 = 0, rs1 = 0; float rw0 = 0.f, rw1 = 0.f;
    if (lane < nk && lane < 16) { const int t = tok0 + lane * tstride; rs0 = pst[RE[t * 2]] + POS[t * 2]; rs1 = pst[RE[t * 2 + 1]] + POS[t * 2 + 1]; rw0 = RW[t * 2]; rw1 = RW[t * 2 + 1]; }
    u32x4 ra[2][2]; u32x2 rb[2][2], rc[2][2];
#define LN2_LOAD(k, buf) do { const int t_ = tok0 + (k) * tstride; const int s0_ = __shfl(rs0, (k)), s1_ = __shfl(rs1, (k)); _Pragma("unroll") for (int hf = 0; hf < 2; ++hf) { const int c0 = hf * 512 + lane * 8; \
        ra[buf][hf] = __builtin_nontemporal_load((const u32x4*)(X1 + (size_t)t_ * 1024 + c0)); rb[buf][hf] = __builtin_nontemporal_load((const u32x2*)(YB + (size_t)s0_ * 1024 + c0)); rc[buf][hf] = __builtin_nontemporal_load((const u32x2*)(YB + (size_t)s1_ * 1024 + c0)); } } while (0)
    if (nk > 0) LN2_LOAD(0, 0);
#pragma unroll
    for (int k = 0; k < 16; ++k) {
        if (k < nk) {
            const int tok = tok0 + k * tstride; const float w0 = __shfl(rw0, k), w1 = __shfl(rw1, k);
            if (k + 1 < nk) LN2_LOAD(k + 1, (k + 1) & 1);
            float v[16];
#pragma unroll
            for (int hf = 0; hf < 2; ++hf) { const u32x4 a = ra[k & 1][hf]; const u32x2 b = rb[k & 1][hf], c = rc[k & 1][hf];
                const unsigned aw[4] = {a.x, a.y, a.z, a.w}, bw[2] = {b.x, b.y}, cw[2] = {c.x, c.y};
#pragma unroll
                for (int j = 0; j < 4; ++j) { const f32x2 yb = (j & 1) ? __builtin_amdgcn_cvt_pk_f32_fp8((int)bw[j >> 1], true) : __builtin_amdgcn_cvt_pk_f32_fp8((int)bw[j >> 1], false);
                    const f32x2 yc = (j & 1) ? __builtin_amdgcn_cvt_pk_f32_fp8((int)cw[j >> 1], true) : __builtin_amdgcn_cvt_pk_f32_fp8((int)cw[j >> 1], false);
                    v[hf * 8 + 2 * j] = ALPHA * lo_bf(aw[j]) + w0 * yb[0] + w1 * yc[0]; v[hf * 8 + 2 * j + 1] = ALPHA * hi_bf(aw[j]) + w0 * yb[1] + w1 * yc[1]; } }
            float s = 0.f;
#pragma unroll
            for (int i = 0; i < 16; ++i) s += v[i];
            const float mu = wave_sum(s) * (1.0f / 1024.0f);
            float qv = 0.f;
#pragma unroll
            for (int i = 0; i < 16; ++i) { const float d = v[i] - mu; qv += d * d; }
            const float rstd = rsqrtf(wave_sum(qv) * (1.0f / 1024.0f) + 1e-5f);
#pragma unroll
            for (int hf = 0; hf < 2; ++hf) { const int c0 = hf * 512 + lane * 8; float o[8];
                const f32x4 ga = *(const f32x4*)(lg + c0), gb = *(const f32x4*)(lg + c0 + 4), ba = *(const f32x4*)(lb + c0), bb = *(const f32x4*)(lb + c0 + 4);
#pragma unroll
                for (int j = 0; j < 4; ++j) { o[j] = (v[hf * 8 + j] - mu) * rstd * ga[j] + ba[j]; o[4 + j] = (v[hf * 8 + 4 + j] - mu) * rstd * gb[j] + bb[j]; }
                if (L == 1) { __builtin_nontemporal_store((f32x4){o[0], o[1], o[2], o[3]}, (f32x4*)(p.out + (size_t)tok * 1024 + c0)); __builtin_nontemporal_store((f32x4){o[4], o[5], o[6], o[7]}, (f32x4*)(p.out + (size_t)tok * 1024 + c0 + 4)); }
                else { u32x4 w; w.x = cvt_pk_bf16(o[0], o[1]); w.y = cvt_pk_bf16(o[2], o[3]); w.z = cvt_pk_bf16(o[4], o[5]); w.w = cvt_pk_bf16(o[6], o[7]); *(u32x4*)((bf16_t*)(p.ws + WS_XB) + (size_t)tok * 1024 + c0) = w;
                    u32x2 w8; w8.x = cvt4_i8(o[0] * I8_SX, o[1] * I8_SX, o[2] * I8_SX, o[3] * I8_SX); w8.y = cvt4_i8(o[4] * I8_SX, o[5] * I8_SX, o[6] * I8_SX, o[7] * I8_SX);
                    *(u32x2*)((unsigned char*)(p.ws + WS_X1Q) + (size_t)tok * 1024 + c0) = w8; } }
        }
    }
#undef LN2_LOAD
}

__device__ __forceinline__ void phase_cmpfin(const Params& p, LAS unsigned char* lds) {
    const int tid = otid(), lane = tid & 63, wid = tid >> 6;
    LAS float* w2s = (LAS float*)lds;
    LAS float* hs = (LAS float*)(lds + 65536) + wid * 1024;
    LAS float* b1s = (LAS float*)(lds + 65536 + 32768);
    const float* CP = (const float*)(p.ws + WS_X1B); const float* B1 = (const float*)(p.ws + WS_B1);
    for (int kv = 0; kv < 2; ++kv) {
        __syncthreads();
        { const float* w2g = kv ? p.cv_w2 : p.ck_w2; for (int i = tid; i < 256 * 64; i += NTHREADS) w2s[i] = w2g[i]; }
        if (tid < 256) { float b1 = 0.f;
#pragma unroll 8
            for (int pt = 0; pt < 32; ++pt) b1 += B1[(kv * 32 + pt) * 256 + tid];
            b1s[tid] = b1; }
        __syncthreads();
        bf16_t* dst = (bf16_t*)(p.ws + (kv ? WS_VCMP : WS_KCMP));
        for (int rg = blockIdx.x * 8 + wid; rg < 8192 / 4; rg += gridDim.x * 8) {
            const int m0 = rg * 4;
#pragma unroll
            for (int i = 0; i < 4; ++i) { const int j = lane + 64 * i; const float b1 = b1s[j];
                f32x4 hv;
#pragma unroll
                for (int rr = 0; rr < 4; ++rr) { float a = b1;
#pragma unroll
                    for (int ks = 0; ks < 2; ++ks) a += __builtin_nontemporal_load(CP + ((size_t)(kv * 2 + ks) * 8192 + m0 + rr) * 256 + j);
                    const float u = 0.7978845608028654f * (a + 0.044715f * a * a * a); const float th = 1.0f - 2.0f / (1.0f + __expf(2.0f * u));
                    hv[rr] = 0.5f * a * (1.0f + th); }
                *(LAS f32x4*)(hs + j * 4) = hv; }
            asm volatile("s_waitcnt lgkmcnt(0)" ::: "memory");
            f32x4 o = (f32x4){0.f, 0.f, 0.f, 0.f}; const LAS float* w2 = w2s + lane;
#pragma unroll 8
            for (int j = 0; j < 256; ++j) o += *(const LAS f32x4*)(hs + j * 4) * w2[j * 64];
#pragma unroll
            for (int rr = 0; rr < 4; ++rr) dst[(size_t)(m0 + rr) * 64 + lane] = f2bf((((m0 + rr) & 127) == 127) ? 0.f : o[rr]);
            asm volatile("s_waitcnt lgkmcnt(0)" ::: "memory");
        }
    }
}

constexpr int NPHASE = 19;
template <int PH> __device__ __forceinline__ void run_phase(const Params& p, LAS unsigned char* lds) {
    char* ws = p.ws;
    if constexpr (PH == 0) phase_prologue(p, lds);
    else if constexpr (PH == 1) { SchedPlainI8 S; S.init(ws + WS_X1Q, ws + WS_WQKV0, NTOK, 3072, 512); EpiQKV0 E{(bf16_t*)(ws + WS_BIG), (float*)(ws + WS_KPART)}; pg8::gemm_phase(lds, S, E); }
    else if constexpr (PH == 2) phase_moba<0>(p, lds);
    else if constexpr (PH == 3) { SchedPlainF8 S; S.init(ws + WS_AOH, ws + WS_WO0, NTOK, 1024, 512); EpiRes<false, true> E{(bf16_t*)(ws + WS_BIG), nullptr, (const bf16_t*)(ws + WS_XB)}; pg8::gemm_phase(lds, S, E); }
    else if constexpr (PH == 4) phase_ln1<0>(p, lds);
    else if constexpr (PH == 6 || PH == 16) { SchedMoeGU S; S.init(ws, PH == 16, lds); EpiGU E{(unsigned char*)(ws + WS_AOH)}; pg8::gemm_phase(lds, S, E);
        if constexpr (PH == 6) {
            const int rem = (S.nM * 4) % (int)gridDim.x, nidle = (int)gridDim.x - rem; const bool useidle = (rem > 0 && nidle * 2 >= (int)gridDim.x);
            __syncthreads();
            if (!useidle) conv_moe_stream(p, 1, 1, DN1_OFF, lds, (int)blockIdx.x * 8 + (otid() >> 6), (int)gridDim.x * 8);
            else if ((int)blockIdx.x >= rem) conv_moe_stream(p, 1, 1, DN1_OFF, lds, ((int)blockIdx.x - rem) * 8 + (otid() >> 6), nidle * 8); } }
    else if constexpr (PH == 7 || PH == 17) { SchedMoeDN S; S.init(ws, PH == 17, lds); EpiDN E{(unsigned char*)(ws + WS_BIG)}; pg8::gemm_phase(lds, S, E);
        if constexpr (PH == 7) {
            const int rem = (S.nM * 4) % (int)gridDim.x, nidle = (int)gridDim.x - rem; const bool useidle = (rem > 0 && nidle * 2 >= (int)gridDim.x);
            __syncthreads();
            if (!useidle) conv_moe_stream(p, 1, 0, 0, lds, (int)blockIdx.x * 8 + (otid() >> 6), (int)gridDim.x * 8, 0, GU1_EARLY);
            else if ((int)blockIdx.x >= rem) conv_moe_stream(p, 1, 0, 0, lds, ((int)blockIdx.x - rem) * 8 + (otid() >> 6), nidle * 8, 0, GU1_EARLY); } }
    else if constexpr (PH == 8) { phase_ln2<0>(p, lds); __syncthreads(); conv_moe_stream(p, 1, 0, 0, lds, (int)blockIdx.x * 8 + (otid() >> 6), (int)gridDim.x * 8, GU1_EARLY); }
    else if constexpr (PH == 9) {
        { SchedNsaProjI8 S; S.init(ws + WS_X1Q, ws + WS_WIN1, NTOK, 2816, 512); S.bcnt = (unsigned*)(ws + WS_BCNT); EpiNSA E{(bf16_t*)(ws + WS_BIG)}; pg8::gemm_phase(lds, S, E); }
        { SchedCmp S; S.init(ws); EpiCmp E{(float*)(ws + WS_X1B)}; pg8::gemm_phase(lds, S, E); } }
    else if constexpr (PH == 11) phase_cmpfin(p, lds);
    else if constexpr (PH == 12) phase_nsa(p, lds);
    else if constexpr (PH == 13) { SchedPlainF8 S; S.init(ws + WS_AOH, ws + WS_WO1, NTOK, 1024, 512); EpiRes<false, true> E{(bf16_t*)(ws + WS_BIG), nullptr, (const bf16_t*)(ws + WS_XB)}; pg8::gemm_phase(lds, S, E); }
    else if constexpr (PH == 14) phase_ln1<1>(p, lds);
    else if constexpr (PH == 18) phase_ln2<1>(p, lds);
}

extern __shared__ __attribute__((aligned(16))) unsigned char g_smem[];

template <int PH> __global__ void __launch_bounds__(NTHREADS, 2) k_phase(Params p) {
    run_phase<PH>(p, (LAS unsigned char*)g_smem);
}

#if !MK_LAUNCHES
template <int PH> __device__ __forceinline__ void mega_seq(const Params& p, LAS unsigned char* lds, const XcdBarrier& bar) {
    if constexpr (PH == 5 || PH == 15 || PH == 10) { mega_seq<PH + 1>(p, lds, bar); return; }
    run_phase<PH>(p, lds);
#ifdef PROBE_VAR
    if constexpr (PH == 2) { xcd_barrier(bar); phase_moba<PROBE_VAR>(p, lds); }
#endif
#ifdef PROBE_BAR
    if constexpr (PH == 3) { for (int i = 0; i < 16; ++i) xcd_barrier(bar); }
#endif
#ifdef PROBE_GEMM_NULL
    if constexpr (PH == 1) { xcd_barrier(bar); SchedPlain S; S.init(p.ws + WS_XB, p.ws + WS_WQKV0, NTOK, 3072, 1024); EpiNull E{(float*)(p.ws + WS_X1B)}; pg8::gemm_phase(lds, S, E); }
#endif
#ifdef PROBE_MASK
    if constexpr ((PROBE_MASK >> PH) & 1) { xcd_barrier(bar); run_phase<PH>(p, lds); }
#endif
    if constexpr (PH + 1 < NPHASE) { xcd_barrier(bar); mega_seq<PH + 1>(p, lds, bar); }
}
__global__ void __launch_bounds__(NTHREADS, 2) k_mega(Params p) {
    LAS unsigned char* lds = (LAS unsigned char*)g_smem;
    LAS unsigned* stw = (LAS unsigned*)(lds + LDS_BYTES - 16);
    if (threadIdx.x == 0) { stw[0] = 0u; stw[1] = 0u; stw[2] = 0u; stw[3] = 0u; }
    __syncthreads();
    XcdBarrier bar = xcd_barrier_post((unsigned*)(p.ws + WS_CTL), (volatile LAS unsigned*)stw);
    mega_seq<0>(p, lds, bar);
}

#endif
template <int PH> static void launch_phases(const Params& p, int grid, hipStream_t stream) {
    hipFuncSetAttribute((const void*)k_phase<PH>, hipFuncAttributeMaxDynamicSharedMemorySize, LDS_BYTES);
    hipLaunchKernelGGL(k_phase<PH>, dim3(grid), dim3(NTHREADS), LDS_BYTES, stream, p);
    if constexpr (PH + 1 < NPHASE) launch_phases<PH + 1>(p, grid, stream);
}

extern "C" void kernel_launch(void* const* d_in, const int* in_sizes, int n_in, void* d_out, int out_size, void* d_ws, size_t ws_size, hipStream_t stream) {
    if (n_in != 19 || ws_size < WS_END) { fprintf(stderr, "kernel_launch: need 19 inputs and %zu bytes of workspace (got %d, %zu)\n", (size_t)WS_END, n_in, ws_size); return; }
    Params p{};
    p.x = (const float*)d_in[0]; p.rel_bias = (const float*)d_in[1]; p.router_w = (const float*)d_in[2]; p.router_b = (const float*)d_in[3];
    p.ln_g = (const float*)d_in[4]; p.ln_b = (const float*)d_in[5]; p.moba_w_in = (const float*)d_in[6]; p.moba_w_out = (const float*)d_in[7];
    p.nsa_w_in = (const float*)d_in[8]; p.nsa_w_out = (const float*)d_in[9]; p.pos_k = (const float*)d_in[10]; p.pos_v = (const float*)d_in[11];
    p.ck_w1 = (const float*)d_in[12]; p.ck_w2 = (const float*)d_in[13]; p.cv_w1 = (const float*)d_in[14]; p.cv_w2 = (const float*)d_in[15];
    p.w_gate = (const float*)d_in[16]; p.w_up = (const float*)d_in[17]; p.w_down = (const float*)d_in[18];
    p.out = (float*)d_out; p.ws = (char*)d_ws;
    const int grid = NWG_EXPECT;
#if MK_LAUNCHES
    launch_phases<0>(p, grid, stream);
#else
    hipFuncSetAttribute((const void*)k_mega, hipFuncAttributeMaxDynamicSharedMemorySize, LDS_BYTES);
    hipMemsetAsync((char*)d_ws + WS_CTL, 0, 16384, stream);
    hipLaunchKernelGGL(k_mega, dim3(grid), dim3(NTHREADS), LDS_BYTES, stream, p);
#endif
}
```

```cpp
#include <hip/hip_runtime.h>
#include <cstdio>
#include <cstdint>

#ifndef MK_LAUNCHES
#define MK_LAUNCHES 0
#endif

#define LAS __attribute__((address_space(3)))
typedef unsigned short bf16_t;
typedef short bf16x8 __attribute__((ext_vector_type(8)));
typedef short s16x4 __attribute__((ext_vector_type(4)));
typedef short v4i16_t __attribute__((ext_vector_type(4)));
typedef float f32x4 __attribute__((ext_vector_type(4)));
typedef float f32x16 __attribute__((ext_vector_type(16)));
typedef unsigned u32x4 __attribute__((ext_vector_type(4)));
typedef unsigned u32x2 __attribute__((ext_vector_type(2)));
typedef float f32x2 __attribute__((ext_vector_type(2)));
typedef int i32x4 __attribute__((ext_vector_type(4)));
typedef int i32x8 __attribute__((ext_vector_type(8)));
typedef LAS const char* lds_cptr;

constexpr int NTOK = 32768, DM = 1024, SEQ = 2048, NBATCH = 16, NHEAD = 16;
constexpr int QKV_LD = 3072, NSA_LD = 2816;
constexpr int NSA_KC = 1024, NSA_VC = 1280, NSA_KS = 1536, NSA_VS = 1792, NSA_KW = 2048, NSA_VW = 2304, NSA_G = 2560;
constexpr int NEXP = 32, DEXP = 512, MAXPAN = 288, RPAD = MAXPAN * 256;
constexpr int NTHREADS = 512, NWG_EXPECT = 256;
constexpr int LDS_BYTES = 155648;
constexpr float LOG2E = 1.4426950408889634f;
constexpr float C2 = 0.125f * LOG2E;
constexpr float ALPHA = 1.4142135623730951f;
constexpr int BT_N = 288;
constexpr int BT_S = 292, BT_H = 4 * BT_S;

constexpr size_t al256(size_t x) { return (x + 255) & ~(size_t)255; }
constexpr size_t WS_CTL = 0;
constexpr size_t WS_BCNT = 14592;
constexpr size_t WS_GCNT = 14336;
constexpr size_t WS_TAB = 16384;
constexpr size_t WS_B1 = WS_TAB + al256(16 * BT_H * 4);
constexpr size_t WS_NPAN = WS_B1 + 65536;
constexpr size_t WS_PANEL = WS_NPAN + 256;
constexpr size_t WS_HIST = WS_PANEL + 1280;
constexpr size_t WS_KPART = WS_HIST + 32768;
constexpr size_t WS_RE = WS_KPART + 128 * 2 * 1024 * 4;
constexpr size_t WS_RWT = WS_RE + (size_t)NTOK * 8;
constexpr size_t WS_POS = WS_RWT + (size_t)NTOK * 8;
constexpr size_t WS_ROWTOK = WS_POS + (size_t)NTOK * 8;
constexpr size_t WS_KCMP = WS_ROWTOK + (size_t)32 * 65536 * 4;
constexpr size_t WS_VCMP = WS_KCMP + 16 * 4 * 128 * 64 * 2;
constexpr size_t WS_WQKV0 = WS_VCMP + 16 * 4 * 128 * 64 * 2;
constexpr size_t WS_WO0 = WS_WQKV0 + (size_t)3072 * 1024 * 2;
constexpr size_t WS_WIN1 = WS_WO0 + (size_t)1024 * 1024 * 2;
constexpr size_t WS_WO1 = WS_WIN1 + (size_t)2816 * 1024 * 2;
constexpr size_t WS_W1T = WS_WO1 + (size_t)1024 * 1024 * 2;
constexpr size_t WS_GU = WS_W1T + (size_t)2 * 256 * 2048 * 2;
constexpr size_t WS_X1Q = WS_GU + (size_t)32 * 1024 * 1024;
constexpr size_t WS_DN = WS_GU + (size_t)32 * 1024 * 1024 * 2;
constexpr int GU1_P6 = 2816, GU1_EARLY = GU1_P6 + 1536;
constexpr size_t DN1_OFF = (size_t)16 * 1024 * 1024;
constexpr size_t WS_XB = WS_DN + (size_t)32 * 1024 * 512 * 2;
constexpr size_t WS_BIG = WS_XB + (size_t)NTOK * 1024 * 2;
constexpr size_t WS_AOH = WS_BIG + (size_t)NTOK * 3072 * 2;
constexpr size_t WS_GU1 = WS_AOH + (size_t)40 * 1024 * 1024;
constexpr size_t WS_X1B = WS_AOH + (size_t)RPAD * 512 * 2;
constexpr size_t WS_END = WS_X1B + (size_t)NTOK * 1024 * 2;

struct Params {
    const float *x, *rel_bias, *router_w, *router_b, *ln_g, *ln_b, *moba_w_in, *moba_w_out, *nsa_w_in, *nsa_w_out, *pos_k, *pos_v,
                *ck_w1, *ck_w2, *cv_w1, *cv_w2, *w_gate, *w_up, *w_down;
    float* out;
    char* ws;
};

__device__ __forceinline__ int otid() { int t = threadIdx.x; asm volatile("" : "+v"(t)); return t; }
__device__ __forceinline__ float bf2f(bf16_t v) { return __uint_as_float(((unsigned)v) << 16); }
__device__ __forceinline__ unsigned cvt_pk_bf16(float lo, float hi) { unsigned r; asm volatile("v_cvt_pk_bf16_f32 %0, %1, %2" : "=v"(r) : "v"(lo), "v"(hi)); return r; }
constexpr float F8_SW = 256.0f, F8_SX = 8.0f, F8_INV = 1.0f / (F8_SW * F8_SX);
constexpr float I8_SX = 127.0f / 6.0f, I8_SW = 127.0f / 0.18f, I8_INV = 1.0f / (I8_SX * I8_SW);
__device__ __forceinline__ unsigned cvt4_i8(float a, float b, float c, float d) {
    a = __builtin_amdgcn_fmed3f(a, -127.f, 127.f) + 12582912.0f; b = __builtin_amdgcn_fmed3f(b, -127.f, 127.f) + 12582912.0f; c = __builtin_amdgcn_fmed3f(c, -127.f, 127.f) + 12582912.0f; d = __builtin_amdgcn_fmed3f(d, -127.f, 127.f) + 12582912.0f;
    return (__float_as_uint(a) & 0xffu) | ((__float_as_uint(b) & 0xffu) << 8) | ((__float_as_uint(c) & 0xffu) << 16) | (__float_as_uint(d) << 24); }
constexpr float F8_SY = 32.0f;
constexpr float F8_SO = 16.0f, F8_INVO = 1.0f / (F8_SW * F8_SO);
__device__ __forceinline__ unsigned cvt4_fp8(float a, float b, float c, float d) {
    a = __builtin_amdgcn_fmed3f(a, -448.f, 448.f); b = __builtin_amdgcn_fmed3f(b, -448.f, 448.f); c = __builtin_amdgcn_fmed3f(c, -448.f, 448.f); d = __builtin_amdgcn_fmed3f(d, -448.f, 448.f);
    int w = 0; w = __builtin_amdgcn_cvt_pk_fp8_f32(a, b, w, false); w = __builtin_amdgcn_cvt_pk_fp8_f32(c, d, w, true); return (unsigned)w; }
__device__ __forceinline__ bf16_t f2bf(float f) { return (bf16_t)(cvt_pk_bf16(f, 0.f) & 0xffffu); }
__device__ __forceinline__ float lo_bf(unsigned w) { return __uint_as_float(w << 16); }
__device__ __forceinline__ float hi_bf(unsigned w) { return __uint_as_float(w & 0xffff0000u); }
__device__ __forceinline__ float wave_sum(float v) {
#pragma unroll
    for (int o = 32; o > 0; o >>= 1) v += __shfl_xor(v, o);
    return v; }

#define XB_TMO      128
#define XB_XCNT(j)  (256  + 64 * (j))
#define XB_XSUB(j)  (1280 + 64 * (j))
#define XB_XGEN(j)  (2304 + 64 * (j))
#define XB_TOP      3328
#define XB_TOPGEN   3392
#define XCD_BAR_WORDS 3456
#define XB_SPIN_CAP (1u << 18)
__device__ __forceinline__ unsigned xb_ld(unsigned* p)              { return __hip_atomic_load(p, __ATOMIC_RELAXED, __HIP_MEMORY_SCOPE_AGENT); }
__device__ __forceinline__ unsigned xb_add(unsigned* p, unsigned v) { return __hip_atomic_fetch_add(p, v, __ATOMIC_RELAXED, __HIP_MEMORY_SCOPE_AGENT); }
__device__ __forceinline__ unsigned xb_xcc_id() { return (unsigned)__builtin_amdgcn_s_getreg((3 << 11) | 20) & 0xFu; }
#define XB_SPIN(cond, bar) do { unsigned _sp = 0; while (cond) { __builtin_amdgcn_s_sleep(1); \
    if ((++_sp & 255u) == 0u) { if (xb_ld(&(bar)[XB_TMO])) break; if (_sp > XB_SPIN_CAP) { atomicAdd(&(bar)[XB_TMO], 1u); break; } } } } while (0)
struct XcdBarrier { unsigned* bar; unsigned x; volatile LAS unsigned* st; };
__device__ __forceinline__ XcdBarrier xcd_barrier_post(unsigned* bar, volatile LAS unsigned* st) {
    XcdBarrier b; b.bar = bar; b.x = xb_xcc_id(); b.st = st;
    if (threadIdx.x == 0) (void)xb_add(&bar[XB_XCNT(b.x)], 1u);
    return b;
}
__device__ __forceinline__ void xcd_barrier_complete(unsigned* bar, unsigned x, unsigned& nloc, unsigned& nx) {
    const unsigned G = gridDim.x * gridDim.y * gridDim.z;
    unsigned sum, cnt, mine, sp = 0u;
    for (;;) {
        sum = 0u; cnt = 0u; mine = 0u;
#pragma unroll
        for (unsigned j = 0; j < 16; ++j) { const unsigned c = xb_ld(&bar[XB_XCNT(j)]); sum += c; cnt += (c > 0u) ? 1u : 0u; mine = (j == x) ? c : mine; }
        if (sum == G) break;
        __builtin_amdgcn_s_sleep(1);
        if ((++sp & 255u) == 0u) { if (xb_ld(&bar[XB_TMO])) break; if (sp > XB_SPIN_CAP) { atomicAdd(&bar[XB_TMO], 1u); break; } }
    }
    nloc = mine > 0u ? mine : 1u; nx = cnt > 0u ? cnt : 1u;
}
__device__ __forceinline__ void xcd_barrier(const XcdBarrier& b) {
    asm volatile("s_waitcnt vmcnt(0)" ::: "memory");
    __syncthreads();
    if (threadIdx.x == 0) {
        unsigned* bar = b.bar;
        __builtin_amdgcn_s_waitcnt(0);
        unsigned nloc = b.st[0], nx = b.st[1];
        if (nloc == 0u) { xcd_barrier_complete(bar, b.x, nloc, nx); b.st[0] = nloc; b.st[1] = nx; }
        const unsigned old = xb_add(&bar[XB_XSUB(b.x)], 1u);
        const unsigned gen = old / nloc;
        bool released = false;
        if (old + 1u == (gen + 1u) * nloc) {
            __builtin_amdgcn_fence(__ATOMIC_RELEASE, "agent");
            asm volatile("s_waitcnt vmcnt(0)" ::: "memory");
            const unsigned og = xb_add(&bar[XB_TOP], 1u);
            const unsigned tg = og / nx;
            if (og + 1u == (tg + 1u) * nx) {
#pragma unroll
                for (unsigned j = 0; j < 16; ++j) xb_add(&bar[XB_XGEN(j)], 1u);
                released = true;
            }
        }
        __builtin_amdgcn_fence(__ATOMIC_ACQUIRE, "agent");
        if (!released) XB_SPIN(xb_ld(&bar[XB_XGEN(b.x)]) == gen, bar);
        asm volatile("s_waitcnt vmcnt(0)" ::: "memory");
    }
    __syncthreads();
}

namespace pg8 {
constexpr int BM = 256, BK = 64, HALF = 128, HTB = HALF * BK * 2, STAGE_BYTES = 8 * HTB, NXCD = 8, WGM = 8;
__device__ __forceinline__ int lds_byte(int r, int c) { const int st = (r >> 4) * 2 + (c >> 5), rr = r & 15, cc = c & 31, ob = rr * 64 + cc * 2; return st * 1024 + (ob ^ (((ob >> 9) & 1) << 5)); }
__device__ __forceinline__ void stage_rc(int b, int& R, int& C) { const int st = b / 1024, sb = b % 1024, swz = sb ^ (((sb >> 9) & 1) << 5); R = (st >> 1) * 16 + swz / 64; C = (st & 1) * 32 + (swz % 64) / 2; }
__device__ __forceinline__ int perm32(int rho) { const int n = rho >> 4, i = rho & 15; return 8 * (i >> 2) + 4 * n + (i & 3); }
struct Unit { int pm, pn, aux, aux2; };
__device__ __forceinline__ i32x8 cat8(bf16x8 a, bf16x8 b) { const i32x4 x = __builtin_bit_cast(i32x4, a), y = __builtin_bit_cast(i32x4, b); return __builtin_shufflevector(x, y, 0, 1, 2, 3, 4, 5, 6, 7); }

__device__ __forceinline__ void static_unit(int L, int nM, int nN, Unit& u) {
    const int nwg = nM * nN;
    int wgid = L; { const int q = nwg / NXCD, r = nwg % NXCD, xcd = wgid % NXCD, off = wgid / NXCD; wgid = (xcd < r ? xcd * (q + 1) : r * (q + 1) + (xcd - r) * q) + off; }
    const int nig = WGM * nN, gid = wgid / nig, fm = gid * WGM, gsz = (nM - fm) < WGM ? (nM - fm) : WGM;
    u.pm = fm + ((wgid % nig) % gsz); u.pn = (wgid % nig) / gsz; u.aux = 0; u.aux2 = 0;
}

__device__ __forceinline__ void stage2(const char* sbase, unsigned v0, unsigned v1, unsigned lds0) {
    unsigned sv;
    asm volatile("s_mov_b32 %0, m0\n\ts_mov_b32 m0, %4\n\ts_nop 0\n\tglobal_load_lds_dwordx4 %1, %3\n\ts_mov_b32 m0, %5\n\ts_nop 0\n\tglobal_load_lds_dwordx4 %2, %3\n\ts_mov_b32 m0, %0"
                 : "=&s"(sv) : "v"(v0), "v"(v1), "s"(sbase), "s"(lds0), "s"(lds0 + 8192u) : "memory");
}
template <class Epi, class Sched>
__device__ __forceinline__ void gemm_phase(LAS unsigned char* lds, const Sched& S, const Epi& E) {
    const int tid = otid(), wid = __builtin_amdgcn_readfirstlane(tid >> 6), lane = tid & 63, wr = wid >> 2, wc = wid & 3, fr = lane & 15, fq = lane >> 4;
    int nt_ = S.nt; asm volatile("" : "+s"(nt_));
    const int nt = nt_;
    int sR[2], sC[2];
    unsigned vB[2][2];
#pragma unroll
    for (int i = 0; i < 2; ++i) { stage_rc(tid * 16 + i * 8192, sR[i], sC[i]); const int Rb = Epi::PERM ? ((sR[i] & ~31) + perm32(sR[i] & 31)) : sR[i];
#pragma unroll
        for (int h = 0; h < 2; ++h) vB[h][i] = (unsigned)(h * HALF + Rb) * S.ldb + (unsigned)sC[i] * 2u; }
    const size_t kstepA = S.kstepA, kstepB = S.kstepB;
    const unsigned ldsb = (unsigned)__builtin_amdgcn_readfirstlane((int)((unsigned)(unsigned long)lds + (unsigned)wid * 1024u));
    const int aoff = lds_byte(wr * 64 + fr, fq * 8), boff = lds_byte(wc * 32 + fr, fq * 8);
#define PG8_SA(b, h) (((b) * 2 + (h)) * HTB)
#define PG8_SB(b, h) ((4 + (b) * 2 + (h)) * HTB)
#define PG8_STAGE(bufoff, gbase, v0, v1) stage2((const char*)(gbase), (v0), (v1), ldsb + (unsigned)(bufoff))
#define PG8_LDA(dst, b, h) do { if constexpr (Sched::F8) { _Pragma("unroll") for (int m = 0; m < 4; ++m) { dst##8[m].lo = *(const LAS i32x4*)(lds + PG8_SA(b, h) + aoff + m * 2048); dst##8[m].hi = *(const LAS i32x4*)(lds + PG8_SA(b, h) + aoff + m * 2048 + 1024); } } \
        else { _Pragma("unroll") for (int m = 0; m < 4; ++m) _Pragma("unroll") for (int k = 0; k < 2; ++k) dst[m][k] = *(const LAS bf16x8*)(lds + PG8_SA(b, h) + aoff + m * 2048 + k * 1024); } } while (0)
#define PG8_LDB(dst, b, h) do { if constexpr (Sched::F8) { _Pragma("unroll") for (int n = 0; n < 2; ++n) { dst##8[n].lo = *(const LAS i32x4*)(lds + PG8_SB(b, h) + boff + n * 2048); dst##8[n].hi = *(const LAS i32x4*)(lds + PG8_SB(b, h) + boff + n * 2048 + 1024); } } \
        else { _Pragma("unroll") for (int n = 0; n < 2; ++n) _Pragma("unroll") for (int k = 0; k < 2; ++k) dst[n][k] = *(const LAS bf16x8*)(lds + PG8_SB(b, h) + boff + n * 2048 + k * 1024); } } while (0)
#define PG8_MMA(ai, bj, At, Bt) do { __builtin_amdgcn_s_setprio(1); \
        if constexpr (Sched::F8) { _Pragma("unroll") for (int m = 0; m < 4; ++m) _Pragma("unroll") for (int n = 0; n < 2; ++n) \
            acc[ai][bj][m][n] = __builtin_amdgcn_mfma_scale_f32_16x16x128_f8f6f4(Bt##8[n], At##8[m], acc[ai][bj][m][n], 0, 0, 0, 0, 0, 0); } \
        else if constexpr (Sched::I8) { _Pragma("unroll") for (int m = 0; m < 4; ++m) _Pragma("unroll") for (int n = 0; n < 2; ++n) _Pragma("unroll") for (int k = 0; k < 2; ++k) \
            acc[ai][bj][m][n] = __builtin_bit_cast(f32x4, __builtin_amdgcn_mfma_i32_16x16x64_i8(__builtin_bit_cast(i32x4, Bt[n][k]), __builtin_bit_cast(i32x4, At[m][k]), __builtin_bit_cast(i32x4, acc[ai][bj][m][n]), 0, 0, 0)); } \
        else { _Pragma("unroll") for (int m = 0; m < 4; ++m) _Pragma("unroll") for (int n = 0; n < 2; ++n) _Pragma("unroll") for (int k = 0; k < 2; ++k) \
            acc[ai][bj][m][n] = __builtin_amdgcn_mfma_f32_16x16x32_bf16(Bt[n][k], At[m][k], acc[ai][bj][m][n], 0, 0, 0); } \
        __builtin_amdgcn_s_setprio(0); } while (0)
#define PG8_WAIT_V(n) asm volatile("s_waitcnt vmcnt(" #n ")" ::: "memory")
#define PG8_WAIT_L(n) asm volatile("s_waitcnt lgkmcnt(" #n ")" ::: "memory")
#define PG8_BAR __builtin_amdgcn_s_barrier()
#define PG8_SCHED __builtin_amdgcn_sched_barrier(0)
    Unit cur, nxt; int ui = 0; int prev_code = -1;
    if (!S.next(0, cur)) return;
    f32x4 acc[2][2][4][2];
#pragma unroll
    for (int a = 0; a < 2; ++a)
#pragma unroll
        for (int b = 0; b < 2; ++b)
#pragma unroll
            for (int m = 0; m < 4; ++m)
#pragma unroll
                for (int n = 0; n < 2; ++n) acc[a][b][m][n] = (f32x4){0.f, 0.f, 0.f, 0.f};
    bf16x8 At[4][2], B0[2][2], B1[2][2]; i32x8 At8[4], B08[2], B18[2];
    unsigned vA[2][2], vN[2][2];
#pragma unroll
    for (int h = 0; h < 2; ++h)
#pragma unroll
        for (int i = 0; i < 2; ++i) { vA[h][i] = S.aoff(cur, h * HALF + sR[i], sC[i]); vN[h][i] = vA[h][i]; }
    const char* cA = S.abase(cur); const char* cB = S.bbase(cur);
    S.a_ready(cur);
    PG8_STAGE(PG8_SB(0, 0), cB, vB[0][0], vB[0][1]); PG8_STAGE(PG8_SA(0, 0), cA, vA[0][0], vA[0][1]); PG8_STAGE(PG8_SB(0, 1), cB, vB[1][0], vB[1][1]); PG8_STAGE(PG8_SA(0, 1), cA, vA[1][0], vA[1][1]);
    if (wr == 1) PG8_BAR;
    PG8_WAIT_V(4); PG8_BAR;
    PG8_STAGE(PG8_SB(1, 0), cB + kstepB, vB[0][0], vB[0][1]); PG8_STAGE(PG8_SA(1, 0), cA + kstepA, vA[0][0], vA[0][1]); PG8_STAGE(PG8_SB(1, 1), cB + kstepB, vB[1][0], vB[1][1]);
    PG8_WAIT_V(6); PG8_BAR;
    for (;;) {
        const bool has_next = S.next(ui + 1, nxt);
        const char* nA = has_next ? S.abase(nxt) : cA; const char* nB = has_next ? S.bbase(nxt) : cB;
        if (Sched::DYN_A && has_next) {
#pragma unroll
            for (int h = 0; h < 2; ++h)
#pragma unroll
                for (int i = 0; i < 2; ++i) vN[h][i] = S.aoff(nxt, h * HALF + sR[i], sC[i]);
        }
        asm volatile(".p2align 8" ::: );
#pragma unroll 1
        for (int t = 0; t < nt; t += 2) {
            const bool last = (t == nt - 2);
            const char* a1 = cA + (size_t)(t + 1) * kstepA;
            const char* a2 = last ? nA : cA + (size_t)(t + 2) * kstepA; const char* b2 = last ? nB : cB + (size_t)(t + 2) * kstepB;
            const char* a3 = a2 + kstepA; const char* b3 = b2 + kstepB;
            if (last && has_next) S.a_ready(nxt);
            PG8_LDB(B0, 0, 0); PG8_SCHED; PG8_LDA(At, 0, 0); PG8_STAGE(PG8_SA(1, 1), a1, vA[1][0], vA[1][1]);
            if (Sched::DYN_A && last) {
#pragma unroll
                for (int h = 0; h < 2; ++h)
#pragma unroll
                    for (int i = 0; i < 2; ++i) vA[h][i] = vN[h][i]; }
            PG8_WAIT_L(8); PG8_BAR; PG8_WAIT_L(0); PG8_MMA(0, 0, At, B0); PG8_BAR; PG8_SCHED;
            PG8_LDB(B1, 0, 1); PG8_STAGE(PG8_SB(0, 0), b2, vB[0][0], vB[0][1]);
            PG8_BAR; PG8_WAIT_L(0); PG8_MMA(0, 1, At, B1); PG8_BAR;
            PG8_LDA(At, 0, 1); PG8_STAGE(PG8_SA(0, 0), a2, vA[0][0], vA[0][1]);
            PG8_BAR; PG8_WAIT_L(0); PG8_MMA(1, 0, At, B0); PG8_BAR; PG8_SCHED;
            PG8_STAGE(PG8_SB(0, 1), b2, vB[1][0], vB[1][1]);
            PG8_WAIT_V(6); PG8_BAR; PG8_MMA(1, 1, At, B1); PG8_BAR;
            PG8_LDB(B0, 1, 0); PG8_SCHED; PG8_LDA(At, 1, 0); PG8_STAGE(PG8_SA(0, 1), a2, vA[1][0], vA[1][1]);
            PG8_WAIT_L(8); PG8_BAR; PG8_WAIT_L(0); PG8_MMA(0, 0, At, B0); PG8_BAR; PG8_SCHED;
            PG8_LDB(B1, 1, 1); PG8_STAGE(PG8_SB(1, 0), b3, vB[0][0], vB[0][1]);
            PG8_BAR; PG8_WAIT_L(0); PG8_MMA(0, 1, At, B1); PG8_BAR;
            PG8_LDA(At, 1, 1); PG8_STAGE(PG8_SA(1, 0), a3, vA[0][0], vA[0][1]);
            PG8_BAR; PG8_WAIT_L(0); PG8_MMA(1, 0, At, B0); PG8_BAR; PG8_SCHED;
            PG8_STAGE(PG8_SB(1, 1), b3, vB[1][0], vB[1][1]);
            PG8_WAIT_V(6); PG8_BAR; PG8_MMA(1, 1, At, B1); PG8_BAR;
            if (Sched::PUBLISH && prev_code >= 0) { S.done(prev_code); prev_code = -1; }
        }
        if constexpr (Sched::I8) {
#pragma unroll
            for (int a = 0; a < 2; ++a)
#pragma unroll
                for (int b = 0; b < 2; ++b)
#pragma unroll
                    for (int m = 0; m < 4; ++m)
#pragma unroll
                        for (int n = 0; n < 2; ++n) { const i32x4 iv = __builtin_bit_cast(i32x4, acc[a][b][m][n]); acc[a][b][m][n] = (f32x4){(float)iv[0], (float)iv[1], (float)iv[2], (float)iv[3]} * I8_INV; } }
        E(acc, cur, wr, wc, fr, fq); prev_code = Sched::PUBLISH ? (cur.pm | (cur.pn << 16)) : -1;
        if (!has_next) break;
#pragma unroll
        for (int a = 0; a < 2; ++a)
#pragma unroll
            for (int b = 0; b < 2; ++b)
#pragma unroll
                for (int m = 0; m < 4; ++m)
#pragma unroll
                    for (int n = 0; n < 2; ++n) acc[a][b][m][n] = (f32x4){0.f, 0.f, 0.f, 0.f};
        cur = nxt; cA = nA; cB = nB; ++ui;
    }
    PG8_WAIT_V(0);
    if (Sched::PUBLISH && prev_code >= 0) S.done(prev_code);
    if (wr == 0) PG8_BAR;
    PG8_BAR;
#undef PG8_SA
#undef PG8_SB
#undef PG8_STAGE
#undef PG8_LDA
#undef PG8_LDB
#undef PG8_MMA
#undef PG8_WAIT_V
#undef PG8_WAIT_L
#undef PG8_BAR
#undef PG8_SCHED
}
}
using pg8::Unit;

struct SchedPlain {
    static constexpr bool DYN_A = false;
    static constexpr bool F8 = false;
    static constexpr bool I8 = false;
    const char* A; const char* Bt; int K, nM, nN, G, c; int nt; unsigned kstepA, kstepB, ldb;
    __device__ __forceinline__ void init(const void* A_, const void* Bt_, int M, int N, int K_) { A = (const char*)A_; Bt = (const char*)Bt_; K = K_; nM = M / 256; nN = N / 256; G = gridDim.x; c = blockIdx.x; nt = K / 64; kstepA = 128; kstepB = 128; ldb = (unsigned)K * 2u; }
    __device__ __forceinline__ bool next(int i, Unit& u) const { const int L = i * G + c; if (L >= nM * nN) return false; pg8::static_unit(L, nM, nN, u); return true; }
    __device__ __forceinline__ const char* abase(const Unit& u) const { return A + (size_t)u.pm * 256 * K * 2; }
    __device__ __forceinline__ const char* bbase(const Unit& u) const { return Bt + (size_t)u.pn * 256 * K * 2; }
    __device__ __forceinline__ unsigned aoff(const Unit&, int row, int col) const { return (unsigned)(row * K + col) * 2u; }
    static constexpr bool PUBLISH = false;
    __device__ __forceinline__ void a_ready(const Unit&) const {}
    __device__ __forceinline__ void done(int) const {}
};
constexpr int ML_CNT = 131072, ML_PPRE = ML_CNT + 128, ML_PE = ML_PPRE + 256;
__device__ __forceinline__ int moe_tables(const char* ws, int layer, LAS unsigned char* lds) {
    const int tid = otid(); LAS int* cnt = (LAS int*)(lds + ML_CNT); LAS int* ppre = (LAS int*)(lds + ML_PPRE); LAS int* pe = (LAS int*)(lds + ML_PE);
    __syncthreads();
    if (tid < 32) cnt[tid] = ((const int*)(ws + WS_GCNT))[layer * 32 + tid];
    __syncthreads();
    if (tid == 0) { int s = 0; for (int e = 0; e < NEXP; ++e) { ppre[e] = s; s += (cnt[e] + 255) >> 8; } ppre[NEXP] = s; }
    __syncthreads();
    const int nM = ppre[NEXP];
    if (tid < nM) { int e = 0; for (int k = 1; k < NEXP; ++k) e += (ppre[k] <= tid) ? 1 : 0; pe[tid] = e; }
    __syncthreads();
    return nM;
}
struct SchedPlainF8 : SchedPlain {
    static constexpr bool F8 = true;
    static constexpr bool I8 = false;
    static constexpr bool DYN_A = true;
    __device__ __forceinline__ const char* abase(const Unit&) const { return A; }
    __device__ __forceinline__ unsigned aoff(const Unit& u, int row, int col) const { return (unsigned)((u.pm * 256 + row) * K + col) * 2u; }
};
struct SchedNsaProj : SchedPlain {
    static constexpr bool PUBLISH = true;
    unsigned* bcnt;
    __device__ __forceinline__ void done(int code) const { const int pm = code & 0xffff, pn = code >> 16;
        if ((pn == 4 || pn == 5) && (threadIdx.x & 63) == 0) __hip_atomic_fetch_add(bcnt + (pm >> 3) * 16, 1u, __ATOMIC_RELAXED, __HIP_MEMORY_SCOPE_AGENT); }
};
struct SchedPlainI8 : SchedPlain { static constexpr bool I8 = true; };
struct SchedNsaProjI8 : SchedNsaProj { static constexpr bool I8 = true; };
struct SchedMoeGU {
    static constexpr bool DYN_A = true;
    static constexpr bool F8 = true;
    static constexpr bool I8 = false;
    const char* X; const char* W; const int* tokof; LAS unsigned char* lds; int nM, G, c; int nt; unsigned kstepA, kstepB, ldb;
    __device__ __forceinline__ void init(const char* ws, int layer, LAS unsigned char* lds_) { lds = lds_; nM = moe_tables(ws, layer, lds_); X = ws + WS_X1Q; W = ws + (layer ? WS_GU1 : WS_GU); tokof = (const int*)(ws + WS_ROWTOK); G = gridDim.x; c = blockIdx.x; nt = 8; kstepA = 128; kstepB = 128; ldb = 1024; }
    __device__ __forceinline__ bool next(int i, Unit& u) const { const int L = i * G + c; if (L >= nM * 4) return false; pg8::static_unit(L, nM, 4, u);
        const int e = ((const LAS int*)(lds + ML_PE))[u.pm]; u.aux = e | ((u.pm - ((const LAS int*)(lds + ML_PPRE))[e]) << 16); u.aux2 = ((const LAS int*)(lds + ML_CNT))[e]; return true; }
    __device__ __forceinline__ const char* abase(const Unit&) const { return X; }
    __device__ __forceinline__ const char* bbase(const Unit& u) const { return W + ((size_t)(u.aux & 255) * 1024 + (size_t)u.pn * 256) * 1024; }
    __device__ __forceinline__ unsigned aoff(const Unit& u, int row, int col) const { const int slot = (u.aux >> 16) * 256 + row; const int sl = slot < u.aux2 ? slot : 0;
        return (unsigned)tokof[(u.aux & 255) * 65536 + sl] * 1024u + (unsigned)col * 2u; }
    static constexpr bool PUBLISH = false;
    __device__ __forceinline__ void a_ready(const Unit&) const {}
    __device__ __forceinline__ void done(int) const {}
};
struct SchedMoeDN {
    static constexpr bool DYN_A = true;
    static constexpr bool F8 = true;
    static constexpr bool I8 = false;
    const char* H; const char* W; LAS unsigned char* lds; int nM, G, c; int nt; unsigned kstepA, kstepB, ldb;
    __device__ __forceinline__ void init(const char* ws, int layer, LAS unsigned char* lds_) { lds = lds_; nM = moe_tables(ws, layer, lds_); H = ws + WS_AOH; W = ws + WS_DN + (layer ? DN1_OFF : 0); G = gridDim.x; c = blockIdx.x; nt = 4; kstepA = 128; kstepB = 128; ldb = 512; }
    __device__ __forceinline__ bool next(int i, Unit& u) const { const int L = i * G + c; if (L >= nM * 4) return false; pg8::static_unit(L, nM, 4, u); u.aux = ((const LAS int*)(lds + ML_PE))[u.pm]; u.aux2 = 0; return true; }
    __device__ __forceinline__ const char* abase(const Unit&) const { return H; }
    __device__ __forceinline__ const char* bbase(const Unit& u) const { return W + ((size_t)u.aux * 1024 + (size_t)u.pn * 256) * 512; }
    __device__ __forceinline__ unsigned aoff(const Unit& u, int row, int col) const { return (unsigned)((u.pm * 256 + row) * 512 + col * 2); }
    static constexpr bool PUBLISH = false;
    __device__ __forceinline__ void a_ready(const Unit&) const {}
    __device__ __forceinline__ void done(int) const {}
};
struct SchedCmp {
    static constexpr bool DYN_A = false;
    static constexpr bool F8 = false;
    static constexpr bool I8 = false;
    static constexpr bool PUBLISH = false;
    const char* Q; const char* W; unsigned* bcnt; unsigned* tmo; int c; int nt; unsigned kstepA, kstepB, ldb;
    __device__ __forceinline__ void init(const char* ws) { Q = ws + WS_BIG; W = ws + WS_W1T; bcnt = (unsigned*)(ws + WS_BCNT); tmo = (unsigned*)(ws + WS_CTL) + XB_TMO; c = (int)blockIdx.x - 128; nt = 16; kstepA = NSA_LD * 2; kstepB = 128; ldb = 4096; }
    __device__ __forceinline__ bool next(int i, Unit& u) const { if (c < 0 || i >= 1 || gridDim.x != 256) return false; const int L = c; u.aux = L >> 6; u.aux2 = 0; u.pm = (L >> 1) & 31; u.pn = L & 1; return true; }
    __device__ __forceinline__ const char* abase(const Unit& u) const { return Q + (size_t)(u.aux ? NSA_VC : NSA_KC) * 2 + (size_t)u.pn * 16 * (NSA_LD * 2); }
    __device__ __forceinline__ const char* bbase(const Unit& u) const { return W + (size_t)u.aux * 256 * 4096 + (size_t)u.pn * 16 * 128; }
    __device__ __forceinline__ unsigned aoff(const Unit& u, int row, int col) const {
        const int m = u.pm * 256 + row, bh = m >> 7, n = m & 127, nn = n > 126 ? 126 : n, b = bh >> 2, hkv = bh & 3;
        return (unsigned)(((b * SEQ + 16 * nn) * NSA_LD) + hkv * 64 + col) * 2u; }
    __device__ __forceinline__ void a_ready(const Unit& u) const {
        if (threadIdx.x < 64) { unsigned polls = 0; unsigned* w = bcnt + (u.pm >> 1) * 16;
            while ((unsigned)__builtin_amdgcn_readfirstlane((int)__hip_atomic_load(w, __ATOMIC_RELAXED, __HIP_MEMORY_SCOPE_AGENT)) < 128u) {
                __builtin_amdgcn_s_sleep(2);
                if ((++polls & 255u) == 0u) { if (__builtin_amdgcn_readfirstlane((int)__hip_atomic_load(tmo, __ATOMIC_RELAXED, __HIP_MEMORY_SCOPE_AGENT)) != 0) break;
                    if (polls > (1u << 18)) { if (threadIdx.x == 0) __hip_atomic_fetch_add(tmo, 1u, __ATOMIC_RELAXED, __HIP_MEMORY_SCOPE_AGENT); break; } } }
            __builtin_amdgcn_fence(__ATOMIC_ACQUIRE, "agent");
            asm volatile("s_waitcnt vmcnt(0)" ::: "memory"); }
        asm volatile("" ::: "memory"); __builtin_amdgcn_s_barrier(); asm volatile("" ::: "memory");
    }
    __device__ __forceinline__ void done(int) const {}
};

struct EpiQKV0 {
    static constexpr bool PERM = true;
    bf16_t* O; float* kpart;
    __device__ __forceinline__ void operator()(const f32x4 (&acc)[2][2][4][2], const Unit& u, int wr, int wc, int fr, int fq) const {
        const int row0 = u.pm * 256 + wr * 64 + fr, col0 = u.pn * 256 + wc * 32 + 8 * fq;
        const float sc = (u.pn < 4) ? C2 : 1.0f;
#pragma unroll
        for (int ai = 0; ai < 2; ++ai)
#pragma unroll
            for (int m = 0; m < 4; ++m) { bf16_t* rowp = O + (size_t)(row0 + ai * 128 + m * 16) * QKV_LD + col0;
#pragma unroll
                for (int bj = 0; bj < 2; ++bj) { const f32x4 v0 = acc[ai][bj][m][0] * sc, v1 = acc[ai][bj][m][1] * sc;
                    u32x4 w; w.x = cvt_pk_bf16(v0[0], v0[1]); w.y = cvt_pk_bf16(v0[2], v0[3]); w.z = cvt_pk_bf16(v1[0], v1[1]); w.w = cvt_pk_bf16(v1[2], v1[3]);
                    *(u32x4*)(rowp + bj * 128) = w; } }
        if (u.pn >= 4 && u.pn < 8) {
#pragma unroll
            for (int bj = 0; bj < 2; ++bj)
#pragma unroll
                for (int n = 0; n < 2; ++n) { f32x4 s = (f32x4){0.f, 0.f, 0.f, 0.f};
#pragma unroll
                    for (int ai = 0; ai < 2; ++ai)
#pragma unroll
                        for (int m = 0; m < 4; ++m) s += acc[ai][bj][m][n];
#pragma unroll
                    for (int j = 0; j < 4; ++j) { float v = s[j]; v += __shfl_xor(v, 1); v += __shfl_xor(v, 2); v += __shfl_xor(v, 4); v += __shfl_xor(v, 8); s[j] = v; }
                    if (fr == 0) *(f32x4*)(kpart + ((size_t)u.pm * 2 + wr) * 1024 + (u.pn - 4) * 256 + bj * 128 + wc * 32 + 8 * fq + 4 * n) = s; }
        }
    }
};
struct EpiNull {
    static constexpr bool PERM = true;
    float* sink;
    __device__ __forceinline__ void operator()(const f32x4 (&acc)[2][2][4][2], const Unit& u, int wr, int wc, int fr, int fq) const {
        float s = 0.f;
#pragma unroll
        for (int ai = 0; ai < 2; ++ai)
#pragma unroll
            for (int bj = 0; bj < 2; ++bj)
#pragma unroll
                for (int m = 0; m < 4; ++m)
#pragma unroll
                    for (int n = 0; n < 2; ++n) s += acc[ai][bj][m][n][0] + acc[ai][bj][m][n][3];
        if (s == 12345.678f) sink[u.pm + wr + wc + fr + fq] = s;
    }
};
struct EpiNSA {
    static constexpr bool PERM = true;
    bf16_t* O;
    __device__ __forceinline__ void operator()(const f32x4 (&acc)[2][2][4][2], const Unit& u, int wr, int wc, int fr, int fq) const {
        const int row0 = u.pm * 256 + wr * 64 + fr, col0 = u.pn * 256 + wc * 32 + 8 * fq;
        const float sc = (u.pn < 4) ? C2 : 1.0f; const bool sg = (u.pn == 10), wt = (u.pn == 4 || u.pn == 5);
        const auto rsrc = __builtin_amdgcn_make_buffer_rsrc((void*)O, 0, (int)((size_t)NTOK * NSA_LD * 2), 0x00020000);
#pragma unroll
        for (int ai = 0; ai < 2; ++ai)
#pragma unroll
            for (int m = 0; m < 4; ++m) { bf16_t* rowp = O + (size_t)(row0 + ai * 128 + m * 16) * NSA_LD + col0;
#pragma unroll
                for (int bj = 0; bj < 2; ++bj) { f32x4 v0 = acc[ai][bj][m][0] * sc, v1 = acc[ai][bj][m][1] * sc;
                    if (sg) {
#pragma unroll
                        for (int j = 0; j < 4; ++j) { v0[j] = __builtin_amdgcn_rcpf(1.0f + __builtin_amdgcn_exp2f(-LOG2E * v0[j])); v1[j] = __builtin_amdgcn_rcpf(1.0f + __builtin_amdgcn_exp2f(-LOG2E * v1[j])); } }
                    u32x4 w; w.x = cvt_pk_bf16(v0[0], v0[1]); w.y = cvt_pk_bf16(v0[2], v0[3]); w.z = cvt_pk_bf16(v1[0], v1[1]); w.w = cvt_pk_bf16(v1[2], v1[3]);
                    if (wt) __builtin_amdgcn_raw_buffer_store_b128(w, rsrc, (int)(((unsigned)(row0 + ai * 128 + m * 16) * (unsigned)NSA_LD + (unsigned)(col0 + bj * 128)) * 2u), 0, 16);
                    else *(u32x4*)(rowp + bj * 128) = w; } }
    }
};
template <bool RES_F32, bool F8O = false> struct EpiRes {
    static constexpr bool PERM = true;
    bf16_t* O; const float* rf; const bf16_t* rb;
    __device__ __forceinline__ void operator()(const f32x4 (&acc)[2][2][4][2], const Unit& u, int wr, int wc, int fr, int fq) const {
        const int row0 = u.pm * 256 + wr * 64 + fr, col0 = u.pn * 256 + wc * 32 + 8 * fq;
#pragma unroll
        for (int ai = 0; ai < 2; ++ai) {
            if (RES_F32) {
#pragma unroll
                for (int mh = 0; mh < 2; ++mh) { f32x4 r[2][2][2];
#pragma unroll
                    for (int m2 = 0; m2 < 2; ++m2)
#pragma unroll
                        for (int bj = 0; bj < 2; ++bj) { const size_t ro = (size_t)(row0 + ai * 128 + (mh * 2 + m2) * 16) * 1024 + col0 + bj * 128; r[m2][bj][0] = *(const f32x4*)(rf + ro); r[m2][bj][1] = *(const f32x4*)(rf + ro + 4); }
#pragma unroll
                    for (int m2 = 0; m2 < 2; ++m2)
#pragma unroll
                        for (int bj = 0; bj < 2; ++bj) { const int m = mh * 2 + m2; const size_t ro = (size_t)(row0 + ai * 128 + m * 16) * 1024 + col0 + bj * 128;
                            const f32x4 v0 = acc[ai][bj][m][0] + r[m2][bj][0] * ALPHA, v1 = acc[ai][bj][m][1] + r[m2][bj][1] * ALPHA;
                            u32x4 w; w.x = cvt_pk_bf16(v0[0], v0[1]); w.y = cvt_pk_bf16(v0[2], v0[3]); w.z = cvt_pk_bf16(v1[0], v1[1]); w.w = cvt_pk_bf16(v1[2], v1[3]);
                            *(u32x4*)(O + ro) = w; } }
            } else {
                u32x4 r[4][2];
#pragma unroll
                for (int m = 0; m < 4; ++m)
#pragma unroll
                    for (int bj = 0; bj < 2; ++bj) r[m][bj] = *(const u32x4*)(rb + (size_t)(row0 + ai * 128 + m * 16) * 1024 + col0 + bj * 128);
#pragma unroll
                for (int m = 0; m < 4; ++m)
#pragma unroll
                    for (int bj = 0; bj < 2; ++bj) { const size_t ro = (size_t)(row0 + ai * 128 + m * 16) * 1024 + col0 + bj * 128; const u32x4 rw = r[m][bj];
                        const f32x4 r0 = (f32x4){lo_bf(rw.x), hi_bf(rw.x), lo_bf(rw.y), hi_bf(rw.y)}, r1 = (f32x4){lo_bf(rw.z), hi_bf(rw.z), lo_bf(rw.w), hi_bf(rw.w)};
                        const f32x4 v0 = (F8O ? acc[ai][bj][m][0] * F8_INVO : acc[ai][bj][m][0]) + r0 * ALPHA, v1 = (F8O ? acc[ai][bj][m][1] * F8_INVO : acc[ai][bj][m][1]) + r1 * ALPHA;
                        u32x4 w; w.x = cvt_pk_bf16(v0[0], v0[1]); w.y = cvt_pk_bf16(v0[2], v0[3]); w.z = cvt_pk_bf16(v1[0], v1[1]); w.w = cvt_pk_bf16(v1[2], v1[3]);
                        *(u32x4*)(O + ro) = w; }
            }
        }
    }
};
struct EpiGU {
    static constexpr bool PERM = true;
    unsigned char* O;
    __device__ __forceinline__ void operator()(const f32x4 (&acc)[2][2][4][2], const Unit& u, int wr, int wc, int fr, int fq) const {
        const int row0 = u.pm * 256 + wr * 64 + fr, col0 = u.pn * 128 + wc * 32 + 8 * fq;
#pragma unroll
        for (int ai = 0; ai < 2; ++ai)
#pragma unroll
            for (int m = 0; m < 4; ++m) { float h[8];
#pragma unroll
                for (int n = 0; n < 2; ++n)
#pragma unroll
                    for (int j = 0; j < 4; ++j) { const float g = acc[ai][0][m][n][j] * F8_INV, up = acc[ai][1][m][n][j] * (F8_INV * F8_SX); h[n * 4 + j] = g * up * __builtin_amdgcn_rcpf(1.0f + __builtin_amdgcn_exp2f(-LOG2E * g)); }
                u32x2 w; w.x = cvt4_fp8(h[0], h[1], h[2], h[3]); w.y = cvt4_fp8(h[4], h[5], h[6], h[7]);
                *(u32x2*)(O + (size_t)(row0 + ai * 128 + m * 16) * 512 + col0) = w; }
    }
};
struct EpiDN {
    static constexpr bool PERM = true;
    unsigned char* O;
    __device__ __forceinline__ void operator()(const f32x4 (&acc)[2][2][4][2], const Unit& u, int wr, int wc, int fr, int fq) const {
        const int row0 = u.pm * 256 + wr * 64 + fr, col0 = u.pn * 256 + wc * 32 + 8 * fq; constexpr float s = F8_INV * F8_SY;
#pragma unroll
        for (int ai = 0; ai < 2; ++ai)
#pragma unroll
            for (int m = 0; m < 4; ++m) { unsigned char* rowp = O + (size_t)(row0 + ai * 128 + m * 16) * 1024 + col0;
#pragma unroll
                for (int bj = 0; bj < 2; ++bj) { const f32x4 v0 = acc[ai][bj][m][0] * s, v1 = acc[ai][bj][m][1] * s;
                    u32x2 w; w.x = cvt4_fp8(v0[0], v0[1], v0[2], v0[3]); w.y = cvt4_fp8(v1[0], v1[1], v1[2], v1[3]);
                    *(u32x2*)(rowp + bj * 128) = w; } }
    }
};
struct EpiCmp {
    static constexpr bool PERM = false;
    float* CP;
    __device__ __forceinline__ void operator()(const f32x4 (&acc)[2][2][4][2], const Unit& u, int wr, int wc, int fr, int fq) const {
        float* base = CP + ((size_t)(u.aux * 2 + u.pn) * 8192 + (size_t)u.pm * 256) * 256;
        const int row0 = wr * 64 + fr, col0 = wc * 32 + 4 * fq;
#pragma unroll
        for (int ai = 0; ai < 2; ++ai)
#pragma unroll
            for (int m = 0; m < 4; ++m) { float* rowp = base + (size_t)(row0 + ai * 128 + m * 16) * 256 + col0;
#pragma unroll
                for (int bj = 0; bj < 2; ++bj)
#pragma unroll
                    for (int n = 0; n < 2; ++n) *(f32x4*)(rowp + bj * 128 + n * 16) = acc[ai][bj][m][n]; }
    }
};

constexpr int AL_K = 0  , AL_V = 24576  , AL_BIAS = 57344  , AL_KM = AL_BIAS + 4 * BT_H * 4, AL_IMP = AL_KM + 2048  , AL_CMP = AL_IMP + 33792  , AL_SEL = AL_CMP + 32768, AL_LIST = AL_SEL + 512, AL_END = AL_LIST + 256;
static_assert(AL_END <= LDS_BYTES, "attention LDS map");
static_assert(AL_END <= LDS_BYTES - 16 && 4 * 64 * 33 * 4 <= 65536, "attention LDS map");
#define MFMA32(a, b, c) __builtin_amdgcn_mfma_f32_32x32x16_bf16(a, b, c, 0, 0, 0)
__device__ __forceinline__ s16x4 vtr(lds_cptr p) { return __builtin_bit_cast(s16x4, __builtin_amdgcn_ds_read_tr16_b64_v4i16((LAS v4i16_t*)p)); }
__device__ __forceinline__ float xhalf_max(float m) { auto rr = __builtin_amdgcn_permlane32_swap(__float_as_uint(m), __float_as_uint(m), false, false); return __builtin_fmaxf(__uint_as_float(rr[0]), __uint_as_float(rr[1])); }
__device__ __forceinline__ float xhalf_sum(float m) { auto rr = __builtin_amdgcn_permlane32_swap(__float_as_uint(m), __float_as_uint(m), false, false); return __uint_as_float(rr[0]) + __uint_as_float(rr[1]); }
__device__ __forceinline__ float max16(const f32x16& p) { float a = __builtin_fmaxf(p[0], p[1]), b = __builtin_fmaxf(p[2], p[3]);
#pragma unroll
    for (int r = 4; r < 16; r += 4) { a = __builtin_fmaxf(a, __builtin_fmaxf(p[r], p[r + 1])); b = __builtin_fmaxf(b, __builtin_fmaxf(p[r + 2], p[r + 3])); }
    return __builtin_fmaxf(a, b); }

#define MX3(a, b, c) __builtin_fmaxf(__builtin_fmaxf((a), (b)), (c))
__device__ __forceinline__ float max32(const f32x16& p0, const f32x16& p1) {
    float a = MX3(p0[0], p0[1], p1[0]), b = MX3(p0[2], p0[3], p1[1]); a = MX3(a, p1[2], p1[3]);
#pragma unroll
    for (int r = 4; r < 16; r += 4) { a = MX3(a, p0[r], p0[r + 1]); b = MX3(b, p0[r + 2], p0[r + 3]); a = MX3(a, p1[r], p1[r + 1]); b = MX3(b, p1[r + 2], p1[r + 3]); }
    return __builtin_fmaxf(a, b); }
constexpr float FLASH_THR = 8.0f;
__device__ __forceinline__ void glds16(const void* g, unsigned lds_addr) {
    unsigned sv; asm volatile("s_mov_b32 %0, m0\n\ts_mov_b32 m0, %2\n\ts_nop 0\n\tglobal_load_lds_dwordx4 %1, off\n\ts_mov_b32 m0, %0" : "=&s"(sv) : "v"(g), "s"(lds_addr) : "memory"); }
__device__ __forceinline__ void dma_k(const bf16_t* src, int ld, LAS unsigned char* lds, int slot, int wid, int lane, int base = AL_K) {
    const int rl = lane >> 3, ch = lane & 7;
    glds16(src + (size_t)(wid * 8 + rl) * ld + ((ch ^ rl) * 8), (unsigned)__builtin_amdgcn_readfirstlane((int)((unsigned)(unsigned long)lds + base + slot * 8192 + wid * 1024))); }
__device__ __forceinline__ void dma_v(const bf16_t* src, int ld, LAS unsigned char* lds, int slot, int wid, int lane, int base = AL_V) {
    glds16(src + (size_t)(16 * (wid & 3) + (lane >> 2)) * ld + (wid >> 2) * 32 + (lane & 3) * 8, (unsigned)__builtin_amdgcn_readfirstlane((int)((unsigned)(unsigned long)lds + base + slot * 8192 + wid * 1024))); }

struct FState { float m, l; f32x16 o0, o1; };
__device__ __forceinline__ void fstate_reset(FState& s) { s.m = -1e30f; s.l = 0.f;
#pragma unroll
    for (int r = 0; r < 16; ++r) { s.o0[r] = 0.f; s.o1[r] = 0.f; } }

__device__ __forceinline__ int kchunk_off(int d0, int kx) { return (((2 * d0 + (kx >> 3)) ^ (kx & 7)) * 16); }
__device__ __forceinline__ void qk_tile(f32x16& c0, f32x16& c1, const bf16x8 (&qr)[4], lds_cptr kp, int kx) {
#pragma unroll
    for (int d0 = 0; d0 < 4; ++d0) { const bf16x8 k0 = *(const LAS bf16x8*)(kp + kchunk_off(d0, kx)), k1 = *(const LAS bf16x8*)(kp + kchunk_off(d0, kx) + 4096);
        c0 = MFMA32(k0, qr[d0], c0); c1 = MFMA32(k1, qr[d0], c1); }
}
__device__ __forceinline__ void pv_tile(f32x16& o0, f32x16& o1, const f32x16& p0, const f32x16& p1, lds_cptr vp) {
#pragma unroll
    for (int k = 0; k < 4; ++k) {
        const f32x16& ps = (k < 2) ? p0 : p1; const int b = 8 * (k & 1);
        const u32x4 pw = (u32x4){cvt_pk_bf16(ps[b], ps[b + 1]), cvt_pk_bf16(ps[b + 2], ps[b + 3]), cvt_pk_bf16(ps[b + 4], ps[b + 5]), cvt_pk_bf16(ps[b + 6], ps[b + 7])};
        const bf16x8 pf = __builtin_bit_cast(bf16x8, pw);
        { const s16x4 lo = vtr(vp + k * 1024), hi = vtr(vp + k * 1024 + 512);
          const bf16x8 vf = (bf16x8){lo[0], lo[1], lo[2], lo[3], hi[0], hi[1], hi[2], hi[3]}; o0 = MFMA32(vf, pf, o0); }
        { const s16x4 lo = vtr(vp + 4096 + k * 1024), hi = vtr(vp + 4096 + k * 1024 + 512);
          const bf16x8 vf = (bf16x8){lo[0], lo[1], lo[2], lo[3], hi[0], hi[1], hi[2], hi[3]}; o1 = MFMA32(vf, pf, o1); }
    }
}
struct TileP { int Dmin; bool rowok, run, win; };
__device__ __forceinline__ void load_kf(bf16x8 (&kf)[8], lds_cptr kp, int kx) {
#pragma unroll
    for (int d0 = 0; d0 < 4; ++d0) { kf[2 * d0] = *(const LAS bf16x8*)(kp + kchunk_off(d0, kx)); kf[2 * d0 + 1] = *(const LAS bf16x8*)(kp + kchunk_off(d0, kx) + 4096); } }
__device__ __forceinline__ void flash_qk(f32x16& c0, f32x16& c1, float& cf, const bf16x8 (&qr)[4], lds_cptr kp, int kx, const LAS float* btab, float cfar, int Dmin, int r32, int hi) {
    bf16x8 kf[8]; load_kf(kf, kp, kx);
    if (Dmin - 63 < 127) {
        const int s0 = (BT_N - 1 - 63) - (Dmin + r32 - 4 * hi), ksh = s0 & 3; cf = 0.f;
        const LAS f32x4* bp = (const LAS f32x4*)(btab + ksh * BT_S + (s0 - ksh));
#pragma unroll
        for (int g = 0; g < 4; ++g) { const f32x4 a = bp[2 * g], b = bp[8 + 2 * g];
#pragma unroll
            for (int i = 0; i < 4; ++i) { c0[4 * g + i] = a[i]; c1[4 * g + i] = b[i]; } }
#pragma unroll
        for (int d0 = 0; d0 < 4; ++d0) { c0 = MFMA32(kf[2 * d0], qr[d0], c0); c1 = MFMA32(kf[2 * d0 + 1], qr[d0], c1); }
    } else {
        cf = cfar;
        const f32x16 z = {0.f, 0.f, 0.f, 0.f, 0.f, 0.f, 0.f, 0.f, 0.f, 0.f, 0.f, 0.f, 0.f, 0.f, 0.f, 0.f};
        c0 = MFMA32(kf[0], qr[0], z); c1 = MFMA32(kf[1], qr[0], z);
#pragma unroll
        for (int d0 = 1; d0 < 4; ++d0) { c0 = MFMA32(kf[2 * d0], qr[d0], c0); c1 = MFMA32(kf[2 * d0 + 1], qr[d0], c1); }
    }
}
__device__ __forceinline__ void flash_sm(FState& st, f32x16& c0, f32x16& c1, float cf, const TileP& tp, int r32, int hi) {
    const int Dmin = tp.Dmin, Dl = Dmin + r32 - 4 * hi;
    if (tp.win && (Dmin + 31 >= 512)) {
#pragma unroll
        for (int r = 0; r < 16; ++r) { const int ko = (r & 3) + 8 * (r >> 2); if (Dl >= 512 + ko) c0[r] = -INFINITY; if (Dl >= 544 + ko) c1[r] = -INFINITY; }
    }
    float mx = xhalf_max(max32(c0, c1)) + cf;
    mx = tp.rowok ? mx : -INFINITY;
    if (__any(mx > st.m + FLASH_THR)) {
        const float mn = __builtin_fmaxf(st.m, mx); const float alpha = __builtin_amdgcn_exp2f(st.m - mn);
        st.m = mn; st.l *= alpha;
#pragma unroll
        for (int r = 0; r < 16; ++r) { st.o0[r] *= alpha; st.o1[r] *= alpha; }
    }
    const float msub = tp.rowok ? (st.m - cf) : INFINITY;
    float rs0 = 0.f, rs1 = 0.f;
#pragma unroll
    for (int r = 0; r < 16; ++r) { c0[r] = __builtin_amdgcn_exp2f(c0[r] - msub); c1[r] = __builtin_amdgcn_exp2f(c1[r] - msub); rs0 += c0[r]; rs1 += c1[r]; }
    st.l += rs0 + rs1;
}
template <int VAR, class Src, bool PRE = false>
__device__ __forceinline__ void attn_stream(Src& S, int NT, FState& st, const bf16x8 (&qr)[4], LAS unsigned char* lds, const LAS float* btab, float cfar, int wid, int lane, int r32, int hi) {
    const lds_cptr kp0 = (lds_cptr)lds + AL_K + r32 * 128; const int kx = (r32 & 7) | (hi << 3);
    const lds_cptr vp0 = (lds_cptr)lds + AL_V + ((lane >> 4) & 1) * 32 + (lane & 3) * 8 + (4 * hi + ((lane & 15) >> 2)) * 64;
    if (!PRE) { S.dma(0, 0, 0); if (NT > 1 && VAR != 5 && VAR != 6) S.dma(1, 1, 1); }
    if (VAR == 5) { asm volatile("s_waitcnt vmcnt(0)" ::: "memory"); __syncthreads(); }
    int sc = 0, sn = 2;
    S.prefetch(-1);
#pragma nounroll
    for (int t = 0; t < NT; ++t) {
        if (VAR != 5) { if (t + 1 < NT) asm volatile("s_waitcnt vmcnt(2)" ::: "memory"); else asm volatile("s_waitcnt vmcnt(0)" ::: "memory");
        __syncthreads(); }
        if (VAR != 5 && VAR != 6) { if (t + 2 < NT) S.dma_pre(t + 2, sn, sn); }
        const TileP tp = S.params(t);
        S.prefetch(t);
        if (tp.run) { f32x16 c0, c1; float cf;
            flash_qk(c0, c1, cf, qr, kp0 + sc * 8192, kx, btab, cfar, tp.Dmin, r32, hi);
            flash_sm(st, c0, c1, cf, tp, r32, hi);
            pv_tile(st.o0, st.o1, c0, c1, vp0 + sc * 8192); }
        S.after(t, st);
        sc = (sc == 2) ? 0 : sc + 1; sn = (sn == 2) ? 0 : sn + 1;
    }
}

__device__ __forceinline__ void conv_tile(const float* src, int N, bf16_t* dst, int ldd, int k0, int n0, int rowadd, int mode, LAS float* t, int lane) {
    f32x4 v[16];
#pragma unroll
    for (int i = 0; i < 16; ++i) { const int r = i * 4 + (lane >> 4), cc = n0 + (lane & 15) * 4;
        v[i] = (cc < N) ? __builtin_nontemporal_load((const f32x4*)(src + (size_t)(k0 + r) * N + cc)) : (f32x4){0.f, 0.f, 0.f, 0.f}; }
#pragma unroll
    for (int i = 0; i < 16; ++i) { const int r = i * 4 + (lane >> 4), cc = (lane & 15) * 4; LAS float* q = t + r * 65 + cc; q[0] = v[i][0]; q[1] = v[i][1]; q[2] = v[i][2]; q[3] = v[i][3]; }
    asm volatile("s_waitcnt lgkmcnt(0)" ::: "memory");
#pragma unroll
    for (int i = 0; i < 8; ++i) { const int nr = i * 8 + (lane >> 3), kc = (lane & 7) * 8; float f[8];
#pragma unroll
        for (int j = 0; j < 8; ++j) f[j] = t[(kc + j) * 65 + nr];
        const int n = n0 + nr; const int drow = ((mode & 1) == 0) ? n : (256 * (n >> 7) + (n & 127) + rowadd);
        if (mode & 2) { u32x2 w8;
            if (mode & 4) { w8.x = cvt4_i8(f[0] * I8_SW, f[1] * I8_SW, f[2] * I8_SW, f[3] * I8_SW); w8.y = cvt4_i8(f[4] * I8_SW, f[5] * I8_SW, f[6] * I8_SW, f[7] * I8_SW); }
            else { w8.x = cvt4_fp8(f[0] * F8_SW, f[1] * F8_SW, f[2] * F8_SW, f[3] * F8_SW); w8.y = cvt4_fp8(f[4] * F8_SW, f[5] * F8_SW, f[6] * F8_SW, f[7] * F8_SW); }
            *(u32x2*)((unsigned char*)dst + (size_t)drow * ldd + k0 + kc) = w8; }
        else { u32x4 w; w.x = cvt_pk_bf16(f[0], f[1]); w.y = cvt_pk_bf16(f[2], f[3]); w.z = cvt_pk_bf16(f[4], f[5]); w.w = cvt_pk_bf16(f[6], f[7]);
            *(u32x4*)(dst + (size_t)drow * ldd + k0 + kc) = w; } }
    asm volatile("s_waitcnt lgkmcnt(0)" ::: "memory");
}
__device__ __forceinline__ int conv_job(const float* src, int K, int N, int Npad, bf16_t* dst, int ldd, int rowadd, int mode, int tile0, LAS float* t, int gw, int ngw, int lane) {
    const int nkt = K / 64, nnt = Npad / 64, ntile = nkt * nnt;
    int first = (gw - tile0 % ngw + ngw) % ngw;
    for (int i = first; i < ntile; i += ngw) conv_tile(src, N, dst, ldd, (i / nnt) * 64, (i % nnt) * 64, rowadd, mode, t, lane);
    return tile0 + ntile;
}
struct MoeTile { const float* src; unsigned char* dst; int N, ldd, k0, n0, rowadd, gated; };
__device__ __forceinline__ MoeTile moe_tile(const Params& p, int layer, int g, int which, size_t dn_off) {
    const int e = which ? (g >> 7) : (g >> 8), job = which ? 2 : ((g >> 7) & 1), tl = g & 127; const size_t wo = ((size_t)layer * NEXP + e) * 1024 * 512; MoeTile m;
    if (job < 2) { m.src = (job ? p.w_up : p.w_gate) + wo; m.N = 512; m.dst = (unsigned char*)(p.ws + (layer ? WS_GU1 : WS_GU)) + (size_t)e * 1024 * 1024; m.ldd = 1024; m.k0 = (tl >> 3) * 64; m.n0 = (tl & 7) * 64; m.rowadd = job * 128; m.gated = 1; }
    else { m.src = p.w_down + wo; m.N = 1024; m.dst = (unsigned char*)(p.ws + WS_DN) + dn_off + (size_t)e * 1024 * 512; m.ldd = 512; m.k0 = (tl >> 4) * 64; m.n0 = (tl & 15) * 64; m.rowadd = 0; m.gated = 0; }
    return m;
}
__device__ __forceinline__ void moe_tile_load(f32x4 (&v)[16], const MoeTile& m, int lane) {
#pragma unroll
    for (int i = 0; i < 16; ++i) { const int r = i * 4 + (lane >> 4), cc = m.n0 + (lane & 15) * 4; v[i] = __builtin_nontemporal_load((const f32x4*)(m.src + (size_t)(m.k0 + r) * m.N + cc)); }
}
__device__ __forceinline__ void moe_tile_finish(const f32x4 (&v)[16], const MoeTile& m, LAS float* t, int lane) {
#pragma unroll
    for (int i = 0; i < 16; ++i) { const int r = i * 4 + (lane >> 4), cc = (lane & 15) * 4; LAS float* q = t + r * 65 + cc; q[0] = v[i][0]; q[1] = v[i][1]; q[2] = v[i][2]; q[3] = v[i][3]; }
    asm volatile("s_waitcnt lgkmcnt(0)" ::: "memory");
#pragma unroll
    for (int i = 0; i < 8; ++i) { const int nr = i * 8 + (lane >> 3), kc = (lane & 7) * 8; float f[8];
#pragma unroll
        for (int j = 0; j < 8; ++j) f[j] = t[(kc + j) * 65 + nr];
        const int n = m.n0 + nr; const int drow = m.gated ? (256 * (n >> 7) + (n & 127) + m.rowadd) : n;
        u32x2 w8; w8.x = cvt4_fp8(f[0] * F8_SW, f[1] * F8_SW, f[2] * F8_SW, f[3] * F8_SW); w8.y = cvt4_fp8(f[4] * F8_SW, f[5] * F8_SW, f[6] * F8_SW, f[7] * F8_SW);
        *(u32x2*)(m.dst + (size_t)drow * m.ldd + m.k0 + kc) = w8; }
    asm volatile("s_waitcnt lgkmcnt(0)" ::: "memory");
}
__device__ __forceinline__ void conv_moe_stream(const Params& p, int layer, int which, size_t dn_off, LAS unsigned char* lds, int gw, int ngw, int gbeg = 0, int gend = -1) {
    const int tid = otid(), lane = tid & 63, wid = tid >> 6;
    LAS float* t = (LAS float*)(lds + wid * (64 * 65 * 4));
    const int NTILE = gend >= 0 ? gend : (which ? NEXP * 128 : NEXP * 256);
    f32x4 va[16], vb[16];
    int g = gbeg + gw;
    if (g < NTILE) { const MoeTile m = moe_tile(p, layer, g, which, dn_off); moe_tile_load(va, m, lane); }
    while (g < NTILE) {
        { const int gn = g + ngw; if (gn < NTILE) { const MoeTile mn = moe_tile(p, layer, gn, which, dn_off); moe_tile_load(vb, mn, lane); }
          const MoeTile m = moe_tile(p, layer, g, which, dn_off); moe_tile_finish(va, m, t, lane); g = gn; }
        if (g >= NTILE) break;
        { const int gn = g + ngw; if (gn < NTILE) { const MoeTile mn = moe_tile(p, layer, gn, which, dn_off); moe_tile_load(va, mn, lane); }
          const MoeTile m = moe_tile(p, layer, g, which, dn_off); moe_tile_finish(vb, m, t, lane); g = gn; }
    }
}
__device__ __forceinline__ void phase_prologue(const Params& p, LAS unsigned char* lds) {
    const int tid = otid(), lane = tid & 63, wid = tid >> 6, gw = blockIdx.x * 8 + wid, ngw = gridDim.x * 8;
    LAS float* t = (LAS float*)(lds + wid * (64 * 65 * 4));
    char* ws = p.ws;
    { const size_t n8 = (size_t)NTOK * 1024 / 8; bf16_t* xb = (bf16_t*)(ws + WS_XB);
      for (size_t i = (size_t)blockIdx.x * NTHREADS + tid; i < n8; i += (size_t)gridDim.x * NTHREADS) {
          const f32x4 a = __builtin_nontemporal_load((const f32x4*)(p.x + i * 8)), b = __builtin_nontemporal_load((const f32x4*)(p.x + i * 8 + 4));
          u32x4 w; w.x = cvt_pk_bf16(a[0], a[1]); w.y = cvt_pk_bf16(a[2], a[3]); w.z = cvt_pk_bf16(b[0], b[1]); w.w = cvt_pk_bf16(b[2], b[3]);
          *(u32x4*)(xb + i * 8) = w;
          u32x2 w8; w8.x = cvt4_i8(a[0] * I8_SX, a[1] * I8_SX, a[2] * I8_SX, a[3] * I8_SX); w8.y = cvt4_i8(b[0] * I8_SX, b[1] * I8_SX, b[2] * I8_SX, b[3] * I8_SX);
          *(u32x2*)((unsigned char*)(ws + WS_X1Q) + i * 8) = w8; } }
    int tile0 = 0;
    tile0 = conv_job(p.moba_w_in, 1024, 3072, 3072, (bf16_t*)(ws + WS_WQKV0), 1024, 0, 6, tile0, t, gw, ngw, lane);
    tile0 = conv_job(p.moba_w_out, 1024, 1024, 1024, (bf16_t*)(ws + WS_WO0), 1024, 0, 2, tile0, t, gw, ngw, lane);
    tile0 = conv_job(p.nsa_w_in, 1024, 2608, 2816, (bf16_t*)(ws + WS_WIN1), 1024, 0, 6, tile0, t, gw, ngw, lane);
    tile0 = conv_job(p.nsa_w_out, 1024, 1024, 1024, (bf16_t*)(ws + WS_WO1), 1024, 0, 2, tile0, t, gw, ngw, lane);
    tile0 = conv_job(p.ck_w1, 2048, 256, 256, (bf16_t*)(ws + WS_W1T), 2048, 0, 0, tile0, t, gw, ngw, lane);
    tile0 = conv_job(p.cv_w1, 2048, 256, 256, (bf16_t*)(ws + WS_W1T) + 256 * 2048, 2048, 0, 0, tile0, t, gw, ngw, lane);
    conv_moe_stream(p, 0, 0, 0, lds, gw, ngw); conv_moe_stream(p, 0, 1, 0, lds, gw, ngw);
    for (int i = blockIdx.x * NTHREADS + tid; i < 16 * BT_H; i += gridDim.x * NTHREADS) {
        const int h = i / BT_H, k = (i % BT_H) / BT_S, j = i % BT_S; int e = (BT_N - 1) - (j + k); e = e < 0 ? 0 : e;
        int n = e - 63; const bool future = n < 0; n = n < 0 ? 0 : (n > 127 ? 127 : n);
        int bk = n;
        if (n >= 16) { bk = 16 + (int)(logf((float)n / 16.0f) / logf(8.0f) * 16.0f); bk = bk > 31 ? 31 : bk; }
        ((float*)(ws + WS_TAB))[i] = future ? -INFINITY : p.rel_bias[bk * 16 + h] * LOG2E; }
    if (gridDim.x == 256) {
        __syncthreads();
        const int combo = blockIdx.x >> 2, kv = combo >> 5, part = combo & 31, jj = tid & 63, ks = tid >> 6, j = (blockIdx.x & 3) * 64 + jj;
        const float* pos = kv ? p.pos_v : p.pos_k; const float* w1 = kv ? p.cv_w1 : p.ck_w1; float s = 0.f;
#pragma unroll
        for (int k = part * 64 + ks * 8; k < part * 64 + ks * 8 + 8; ++k) s += pos[k] * w1[(size_t)k * 256 + j];
        LAS float* red = (LAS float*)lds; red[ks * 64 + jj] = s;
        __syncthreads();
        if (tid < 64) { float a = 0.f;
#pragma unroll
            for (int q8 = 0; q8 < 8; ++q8) a += red[q8 * 64 + tid];
            ((float*)(ws + WS_B1))[(kv * 32 + part) * 256 + j] = a; }
    } else if (blockIdx.x < 32) { const int kv = blockIdx.x >> 4, part = (blockIdx.x & 15) * 2 + (tid >> 8), j = tid & 255;
        const float* pos = kv ? p.pos_v : p.pos_k; const float* w1 = kv ? p.cv_w1 : p.ck_w1; float s = 0.f;
#pragma unroll 16
        for (int k = part * 64; k < part * 64 + 64; ++k) s += pos[k] * w1[(size_t)k * 256 + j];
        ((float*)(ws + WS_B1))[(kv * 32 + part) * 256 + j] = s; }
}

__device__ __forceinline__ void store_o_rows(LAS unsigned char* stg, unsigned char* grow0, const f32x16& a0, const f32x16& a1, float scale, int lane, int r32, int hi) {
    LAS unsigned char* sp = stg + r32 * 80 + hi * 4; const float s16 = scale * F8_SO;
#pragma unroll
    for (int g4 = 0; g4 < 4; ++g4) {
        *(LAS unsigned*)(sp + g4 * 8) = cvt4_fp8(a0[4 * g4] * s16, a0[4 * g4 + 1] * s16, a0[4 * g4 + 2] * s16, a0[4 * g4 + 3] * s16);
        *(LAS unsigned*)(sp + 32 + g4 * 8) = cvt4_fp8(a1[4 * g4] * s16, a1[4 * g4 + 1] * s16, a1[4 * g4 + 2] * s16, a1[4 * g4 + 3] * s16); }
    asm volatile("s_waitcnt lgkmcnt(0)" ::: "memory");
#pragma unroll
    for (int it = 0; it < 2; ++it) { const int row = it * 16 + (lane >> 2), ch = lane & 3;
        const u32x4 v = *(const LAS u32x4*)(stg + row * 80 + ch * 16);
        *(u32x4*)(grow0 + (size_t)row * 1024 + ch * 16) = v; }
    asm volatile("s_waitcnt lgkmcnt(0)" ::: "memory");
}
template <int VAR> __device__ __forceinline__ void moba_unit(const Params& p, LAS unsigned char* lds, int b, int h, int qb) {
    const int tid = otid(), lane = tid & 63, r32 = lane & 31, hi = lane >> 5; const int wid = __builtin_amdgcn_readfirstlane(tid >> 6);
    const bf16_t* QKV = (const bf16_t*)(p.ws + WS_BIG);
    const size_t rowbase = (size_t)b * SEQ; const int q0 = qb * 256, qw = q0 + wid * 32;
    const bf16_t* Kb = QKV + rowbase * QKV_LD + 1024 + h * 64; const bf16_t* Vb = QKV + rowbase * QKV_LD + 2048 + h * 64;
    bf16x8 qr[4];
    { const bf16_t* qp = QKV + (rowbase + qw + r32) * QKV_LD + h * 64 + hi * 8;
#pragma unroll
      for (int d0 = 0; d0 < 4; ++d0) qr[d0] = *(const bf16x8*)(qp + d0 * 16); }
    float kmv, btv[3];
    { const float* kp = (const float*)(p.ws + WS_KPART); const int j = tid >> 6, d = tid & 63;
      const float* s = kp + ((size_t)(b * 8 + j) * 2) * 1024 + h * 64 + d; kmv = s[0] + s[1024];
#pragma unroll
      for (int i = 0; i < 3; ++i) { const int ix = tid + i * NTHREADS; btv[i] = ((const float*)(p.ws + WS_TAB))[h * BT_H + (ix < BT_H ? ix : 0)]; } }
    __syncthreads();
    dma_k(Kb + (size_t)q0 * QKV_LD, QKV_LD, lds, 0, wid, lane); dma_v(Vb + (size_t)q0 * QKV_LD, QKV_LD, lds, 0, wid, lane);
    dma_k(Kb + (size_t)(q0 + 64) * QKV_LD, QKV_LD, lds, 1, wid, lane); dma_v(Vb + (size_t)(q0 + 64) * QKV_LD, QKV_LD, lds, 1, wid, lane);
    ((LAS float*)(lds + AL_KM))[tid] = kmv;
#pragma unroll
    for (int i = 0; i < 3; ++i) { const int ix = tid + i * NTHREADS; if (ix < BT_H) ((LAS float*)(lds + AL_BIAS))[ix] = btv[i]; }
    const int NT = 4 + 4 * qb;
    __syncthreads();
    unsigned sel = 0;
    { float g[8];
#pragma unroll
      for (int j = 0; j < 8; ++j) { float s = 0.f; const LAS float* km = (const LAS float*)(lds + AL_KM) + j * 64 + hi * 8;
#pragma unroll
          for (int d0 = 0; d0 < 4; ++d0)
#pragma unroll
              for (int i = 0; i < 8; ++i) s += bf2f((bf16_t)qr[d0][i]) * km[d0 * 16 + i];
          g[j] = xhalf_sum(s); }
#pragma unroll
      for (int round = 0; round < 3; ++round) { int best = -1; float bv = 0.f;
#pragma unroll
          for (int j = 0; j < 8; ++j) { const bool ok = (j < qb) && !((sel >> j) & 1u) && (best < 0 || g[j] > bv); if (ok) { best = j; bv = g[j]; } }
          if (best >= 0) sel |= 1u << best; } }
    const LAS float* btab = (const LAS float*)(lds + AL_BIAS); const float cfar = btab[0];
    FState st; fstate_reset(st);
    struct MobaSrc {
        const bf16_t *Kb, *Vb; LAS unsigned char* lds; int qb, qw, wid, lane; unsigned sel;
        __device__ __forceinline__ void tile(int t, int& blk, int& kt) const { blk = t < 4 ? qb : qb - 1 - ((t - 4) >> 2); kt = t < 4 ? t : ((t - 4) & 3); }
        __device__ __forceinline__ void dma(int t, int ks, int vs) const { int blk, kt; tile(t, blk, kt); const size_t key0 = (size_t)blk * 256 + kt * 64;
            dma_k(Kb + key0 * QKV_LD, QKV_LD, lds, ks, wid, lane); dma_v(Vb + key0 * QKV_LD, QKV_LD, lds, vs, wid, lane); }
        __device__ __forceinline__ TileP params(int t) const { int blk, kt; tile(t, blk, kt); TileP tp; tp.Dmin = qw - (blk * 256 + kt * 64); tp.win = false;
            if (blk == qb) { tp.rowok = true; tp.run = (64 * kt <= wid * 32 + 31); } else { tp.rowok = (sel >> blk) & 1u; tp.run = __any(tp.rowok); }
            return tp; }
        __device__ __forceinline__ void dma_pre(int t, int ks, int vs) const { dma(t, ks, vs); }
        __device__ __forceinline__ void prefetch(int) const {}
        __device__ __forceinline__ void after(int, FState&) const {}
    } S{Kb, Vb, lds, qb, qw, wid, lane, sel};
    attn_stream<VAR, MobaSrc, true>(S, NT, st, qr, lds, btab, cfar, wid, lane, r32, hi);
    const float inv = 1.0f / xhalf_sum(st.l);
    store_o_rows(lds + AL_IMP + wid * 8192, (unsigned char*)(p.ws + (VAR ? WS_X1B : WS_AOH)) + (size_t)(rowbase + qw) * 1024 + h * 64, st.o0, st.o1, inv, lane, r32, hi);
}
template <int VAR> __device__ __forceinline__ void phase_moba(const Params& p, LAS unsigned char* lds) {
    for (int pr = blockIdx.x, rnd = 0; pr < 1024; pr += gridDim.x, ++rnd) { const int x = blockIdx.x & 7, s = blockIdx.x >> 3; const int bh = (gridDim.x == 256) ? (x + 8 * (rnd * 8 + (s >> 2))) : (pr >> 2), j = (gridDim.x == 256) ? (s & 3) : (pr & 3);
        moba_unit<VAR>(p, lds, bh >> 4, bh & 15, 7 - j);
        moba_unit<VAR>(p, lds, bh >> 4, bh & 15, j); }
    __syncthreads();
}

__device__ __forceinline__ void nsa_unit(const Params& p, LAS unsigned char* lds, int b, int hkv, int c, bool load_tab, bool load_cmp) {
    const int tid = otid(), lane = tid & 63, r32 = lane & 31, hi = lane >> 5; const int wid = __builtin_amdgcn_readfirstlane(tid >> 6);
    const bf16_t* P = (const bf16_t*)(p.ws + WS_BIG);
    const size_t rowbase = (size_t)b * SEQ; const int g = wid >> 1, qq0 = (wid & 1) * 32, h = hkv * 4 + g, qw = c * 64 + qq0, qpos = qw + r32;
    bf16x8 qr[4];
    const bf16_t* rowp = P + (rowbase + qpos) * NSA_LD;
#pragma unroll
    for (int d0 = 0; d0 < 4; ++d0) qr[d0] = *(const bf16x8*)(rowp + h * 64 + hi * 8 + d0 * 16);
    const float g0 = bf2f(rowp[NSA_G + h * 3]), g1 = bf2f(rowp[NSA_G + h * 3 + 1]), g2 = bf2f(rowp[NSA_G + h * 3 + 2]);
    __syncthreads();
    if (load_tab) { for (int i = tid; i < 4 * BT_H; i += NTHREADS) ((LAS float*)(lds + AL_BIAS))[i] = ((const float*)(p.ws + WS_TAB))[hkv * 4 * BT_H + i]; }
    if (tid < 64) ((LAS unsigned*)(lds + AL_SEL))[tid] = 0u;
    const bf16_t* KS = P + rowbase * NSA_LD + NSA_KS + hkv * 64; const bf16_t* VS = P + rowbase * NSA_LD + NSA_VS + hkv * 64;
    if (load_cmp) { const bf16_t* kc = (const bf16_t*)(p.ws + WS_KCMP) + (size_t)(b * 4 + hkv) * 128 * 64; const bf16_t* vc = (const bf16_t*)(p.ws + WS_VCMP) + (size_t)(b * 4 + hkv) * 128 * 64;
      dma_k(kc, 64, lds, 0, wid, lane, AL_CMP); dma_k(kc + 64 * 64, 64, lds, 1, wid, lane, AL_CMP); dma_v(vc, 64, lds, 2, wid, lane, AL_CMP); dma_v(vc + 64 * 64, 64, lds, 3, wid, lane, AL_CMP); }
    dma_k(KS, NSA_LD, lds, 0, wid, lane); dma_v(VS, NSA_LD, lds, 0, wid, lane);
    asm volatile("s_waitcnt vmcnt(2)" ::: "memory");
    __syncthreads();
    const lds_cptr kp0 = (lds_cptr)lds + AL_CMP + r32 * 128; const int kx = (r32 & 7) | (hi << 3);
    const lds_cptr vp0 = (lds_cptr)lds + AL_CMP + 16384 + ((lane >> 4) & 1) * 32 + (lane & 3) * 8 + (4 * hi + ((lane & 15) >> 2)) * 64;
    f32x16 cb0, cb1;
    {
        f32x16 s[2][2];
        const int nlim = (qpos >= 31 ? ((qpos - 31) >> 4) + 1 : 0) - 4 * hi;
#pragma unroll
        for (int t = 0; t < 2; ++t) {
#pragma unroll
            for (int r = 0; r < 16; ++r) { s[t][0][r] = 0.f; s[t][1][r] = 0.f; }
            qk_tile(s[t][0], s[t][1], qr, kp0 + t * 8192, kx);
#pragma unroll
            for (int n2 = 0; n2 < 2; ++n2)
#pragma unroll
                for (int r = 0; r < 16; ++r) { const int nk = 64 * t + 32 * n2 + (r & 3) + 8 * (r >> 2); if (nk >= nlim) s[t][n2][r] = -INFINITY; }
        }
        const float mx = xhalf_max(__builtin_fmaxf(__builtin_fmaxf(max16(s[0][0]), max16(s[0][1])), __builtin_fmaxf(max16(s[1][0]), max16(s[1][1]))));
        const float mref = (mx == -INFINITY) ? 0.f : mx;
        float rs = 0.f;
#pragma unroll
        for (int t = 0; t < 2; ++t)
#pragma unroll
            for (int n2 = 0; n2 < 2; ++n2)
#pragma unroll
                for (int r = 0; r < 16; ++r) { const float e = __builtin_amdgcn_exp2f(s[t][n2][r] - mref); s[t][n2][r] = e; rs += e; }
        const float lt = xhalf_sum(rs); const float inv = lt > 0.f ? 1.0f / lt : 0.f;
#pragma unroll
        for (int t = 0; t < 2; ++t)
#pragma unroll
            for (int n2 = 0; n2 < 2; ++n2)
#pragma unroll
                for (int r = 0; r < 16; ++r) s[t][n2][r] *= inv;
        float Q[16], T[16];
#pragma unroll
        for (int t = 0; t < 2; ++t)
#pragma unroll
            for (int n2 = 0; n2 < 2; ++n2)
#pragma unroll
                for (int r4 = 0; r4 < 4; ++r4) { const int u = 8 * t + 4 * n2 + r4; Q[u] = (s[t][n2][4 * r4] + s[t][n2][4 * r4 + 1]) + (s[t][n2][4 * r4 + 2] + s[t][n2][4 * r4 + 3]); T[u] = s[t][n2][4 * r4 + 3]; }
        LAS float* imp = (LAS float*)(lds + AL_IMP) + (g * 64 + qq0 + r32) * 33;
        float prev = 0.f;
#pragma unroll
        for (int u = 0; u < 16; ++u) { const float rcv = __shfl_xor(T[u], 32); const float add = hi ? rcv : prev; prev = rcv; imp[2 * u + hi] = Q[u] + add; }
        f32x16 o0, o1;
#pragma unroll
        for (int r = 0; r < 16; ++r) { o0[r] = 0.f; o1[r] = 0.f; }
        pv_tile(o0, o1, s[0][0], s[0][1], vp0); pv_tile(o0, o1, s[1][0], s[1][1], vp0 + 8192);
#pragma unroll
        for (int r = 0; r < 16; ++r) { cb0[r] = g0 * o0[r]; cb1[r] = g0 * o1[r]; }
    }
    __syncthreads();
    {
        const int q = tid >> 3, jg = tid & 7; const LAS float* ib = (const LAS float*)(lds + AL_IMP) + q * 33;
        float val[32];
#pragma unroll
        for (int j = 0; j < 32; ++j) { float v = (ib[j] + ib[64 * 33 + j]) + (ib[2 * 64 * 33 + j] + ib[3 * 64 * 33 + j]);
            const bool forced = (j == 0) || (j == c) || (j == c - 1); v = forced ? INFINITY : v; val[j] = (j > c) ? -INFINITY : v; }
        unsigned bits = 0;
#pragma unroll
        for (int i = 0; i < 4; ++i) { const int j = jg * 4 + i; float vj = 0.f;
#pragma unroll
            for (int jj = 0; jj < 32; ++jj) vj = (jj == j) ? val[jj] : vj;
            int rank = 0;
#pragma unroll
            for (int jj = 0; jj < 32; ++jj) rank += (val[jj] > vj || (val[jj] == vj && jj < j)) ? 1 : 0;
            if (j <= c && rank < 16) bits |= 1u << j; }
        if (bits) atomicOr((unsigned*)(lds + AL_SEL) + q, bits);
    }
    __syncthreads();
    unsigned uni = ((const LAS unsigned*)(lds + AL_SEL))[lane];
#pragma unroll
    for (int o = 32; o > 0; o >>= 1) uni |= (unsigned)__shfl_xor((int)uni, o);
    uni = (unsigned)__builtin_amdgcn_readfirstlane((int)uni);
    const unsigned rowmask = ((const LAS unsigned*)(lds + AL_SEL))[qq0 + r32];
    const LAS float* btab = (const LAS float*)(lds + AL_BIAS) + g * BT_H; const float cfar = btab[0];
    const bf16_t* KW = P + rowbase * NSA_LD + NSA_KW + hkv * 64; const bf16_t* VW = P + rowbase * NSA_LD + NSA_VW + hkv * 64;
    const int nslc = __builtin_popcount(uni); const int wlo = c >= 8 ? 0 : 8 - c; const int NT = nslc + (9 - wlo);
    LAS int* list = (LAS int*)(lds + AL_LIST);
    if (tid < 32) { if ((uni >> tid) & 1u) list[__builtin_popcount(uni & ((1u << tid) - 1u))] = tid; }
    else if (tid < 32 + 9 - wlo) list[nslc + (tid - 32)] = 64 + (c - 8 + wlo + (tid - 32));
    __syncthreads();
    FState st; fstate_reset(st);
    struct NsaSrc {
        const bf16_t *KS, *VS, *KW, *VW; LAS unsigned char* lds; const LAS int* list; int nslc, qw, wid, lane; unsigned rowmask; float g1; f32x16* cb0; f32x16* cb1; int pre_d, pre_p;
        __device__ __forceinline__ void prefetch(int t) { pre_d = list[t + 3]; pre_p = list[t + 1]; }
        __device__ __forceinline__ void dma_pre(int, int ks, int vs) const { const int e = __builtin_amdgcn_readfirstlane(pre_d);
            if (e < 64) { dma_k(KS + (size_t)e * 64 * NSA_LD, NSA_LD, lds, ks, wid, lane); dma_v(VS + (size_t)e * 64 * NSA_LD, NSA_LD, lds, vs, wid, lane); }
            else { dma_k(KW + (size_t)(e - 64) * 64 * NSA_LD, NSA_LD, lds, ks, wid, lane); dma_v(VW + (size_t)(e - 64) * 64 * NSA_LD, NSA_LD, lds, vs, wid, lane); } }
        __device__ __forceinline__ void dma(int t, int ks, int vs) const { const int e = __builtin_amdgcn_readfirstlane(list[t]);
            if (e < 64) { dma_k(KS + (size_t)e * 64 * NSA_LD, NSA_LD, lds, ks, wid, lane); dma_v(VS + (size_t)e * 64 * NSA_LD, NSA_LD, lds, vs, wid, lane); }
            else { dma_k(KW + (size_t)(e - 64) * 64 * NSA_LD, NSA_LD, lds, ks, wid, lane); dma_v(VW + (size_t)(e - 64) * 64 * NSA_LD, NSA_LD, lds, vs, wid, lane); } }
        __device__ __forceinline__ TileP params(int) const { const int e = __builtin_amdgcn_readfirstlane(pre_p); TileP tp;
            if (e < 64) { tp.Dmin = qw - 64 * e; tp.rowok = (rowmask >> e) & 1u; tp.run = __any(tp.rowok); tp.win = false; }
            else { tp.Dmin = qw - 64 * (e - 64); tp.rowok = true; tp.run = true; tp.win = true; }
            return tp; }
        __device__ __forceinline__ void after(int t, FState& st) const {
            if (t == nslc - 1) { const float f = g1 / xhalf_sum(st.l);
#pragma unroll
                for (int r = 0; r < 16; ++r) { (*cb0)[r] += f * st.o0[r]; (*cb1)[r] += f * st.o1[r]; }
                fstate_reset(st); } }
    } S{KS, VS, KW, VW, lds, list, nslc, qw, wid, lane, rowmask, g1, &cb0, &cb1, 0, 0};
    S.dma(1, 1, 1);
    attn_stream<0, NsaSrc, true>(S, NT, st, qr, lds, btab, cfar, wid, lane, r32, hi);
    { const float f = g2 / xhalf_sum(st.l);
#pragma unroll
      for (int r = 0; r < 16; ++r) { cb0[r] += f * st.o0[r]; cb1[r] += f * st.o1[r]; } }
    store_o_rows(lds + AL_IMP + wid * 4096, (unsigned char*)(p.ws + WS_AOH) + (size_t)(rowbase + qw) * 1024 + h * 64, cb0, cb1, 1.0f, lane, r32, hi);
}
__device__ __forceinline__ void phase_nsa(const Params& p, LAS unsigned char* lds) {
    int last_hkv = -1;
    for (int pr = blockIdx.x, rnd = 0; pr < 1024; pr += gridDim.x, ++rnd) { const int x = blockIdx.x & 7, s = blockIdx.x >> 3; const int bh = (gridDim.x == 256) ? (x + 8 * (rnd * 2 + (s >> 4))) : (pr >> 4), j = (gridDim.x == 256) ? ((s + 4 * rnd) & 15) : (pr & 15);
        nsa_unit(p, lds, bh >> 2, bh & 3, 31 - j, (bh & 3) != last_hkv, true);
        nsa_unit(p, lds, bh >> 2, bh & 3, j, false, false); last_hkv = bh & 3; }
    __syncthreads();
}

template <int L> __device__ __forceinline__ void phase_ln1(const Params& p, LAS unsigned char* lds) {
    const int tid = otid(), lane = tid & 63, wid = tid >> 6, r = lane & 15, q = lane >> 4;
    const float* lg = p.ln_g + (L * 2 + 0) * 1024; const float* lb = p.ln_b + (L * 2 + 0) * 1024;
    const bf16_t* Y = (const bf16_t*)(p.ws + WS_BIG); bf16_t* X1 = (bf16_t*)(p.ws + WS_X1B);
    for (int i = tid; i < 32 * 2 * 64; i += NTHREADS) { const int l2 = i & 63, nb = (i >> 6) & 1, s = i >> 7; const int e = 16 * nb + (l2 & 15), k0 = 32 * s + 8 * (l2 >> 4);
        float w[8]; unsigned hw[4], lw[4];
#pragma unroll
        for (int j = 0; j < 8; ++j) w[j] = p.router_w[(size_t)(k0 + j) * 32 + e];
#pragma unroll
        for (int j = 0; j < 4; ++j) { hw[j] = cvt_pk_bf16(w[2 * j], w[2 * j + 1]); lw[j] = cvt_pk_bf16(w[2 * j] - lo_bf(hw[j]), w[2 * j + 1] - hi_bf(hw[j])); }
        *(LAS u32x4*)(lds + ((size_t)((s * 2 + nb) * 2 + 0) * 64 + l2) * 16) = (u32x4){hw[0], hw[1], hw[2], hw[3]};
        *(LAS u32x4*)(lds + ((size_t)((s * 2 + nb) * 2 + 1) * 64 + l2) * 16) = (u32x4){lw[0], lw[1], lw[2], lw[3]}; }
    LAS int* hist = (LAS int*)(lds + 131072 + 8 * 2048);
    if (tid < 32) hist[tid] = 0;
    __syncthreads();
    for (int tb = blockIdx.x; tb < NTOK / 128; tb += gridDim.x) {
        const int tok = tb * 128 + wid * 16 + r;
        const bf16_t* yp = Y + (size_t)tok * 1024 + 8 * q;
        float sum = 0.f, sq = 0.f;
#pragma unroll 16
        for (int s = 0; s < 32; ++s) { const u32x4 y = *(const u32x4*)(yp + 32 * s); const unsigned yw[4] = {y.x, y.y, y.z, y.w};
#pragma unroll
            for (int j = 0; j < 4; ++j) { const float a = lo_bf(yw[j]), b2 = hi_bf(yw[j]); sum += a + b2; sq += a * a + b2 * b2; } }
        sum += __shfl_xor(sum, 16); sum += __shfl_xor(sum, 32); sq += __shfl_xor(sq, 16); sq += __shfl_xor(sq, 32);
        const float mu = sum * (1.0f / 1024.0f);
        const float rstd = rsqrtf(fmaxf(sq * (1.0f / 1024.0f) - mu * mu, 0.f) + 1e-5f);
        f32x4 acc0 = (f32x4){0.f, 0.f, 0.f, 0.f}, acc1 = acc0;
        bf16_t* xp = X1 + (size_t)tok * 1024 + 8 * q; unsigned char* xq = (unsigned char*)(p.ws + WS_X1Q) + (size_t)tok * 1024 + 8 * q;
#pragma unroll 4
        for (int s = 0; s < 32; ++s) {
            const u32x4 y = *(const u32x4*)(yp + 32 * s);
            const f32x4 ga = *(const f32x4*)(lg + 32 * s + 8 * q), gb = *(const f32x4*)(lg + 32 * s + 8 * q + 4), ba = *(const f32x4*)(lb + 32 * s + 8 * q), bb = *(const f32x4*)(lb + 32 * s + 8 * q + 4);
            u32x4 w;
            const float x0 = (lo_bf(y.x) - mu) * rstd * ga[0] + ba[0], x1 = (hi_bf(y.x) - mu) * rstd * ga[1] + ba[1], x2 = (lo_bf(y.y) - mu) * rstd * ga[2] + ba[2], x3 = (hi_bf(y.y) - mu) * rstd * ga[3] + ba[3];
            const float x4 = (lo_bf(y.z) - mu) * rstd * gb[0] + bb[0], x5 = (hi_bf(y.z) - mu) * rstd * gb[1] + bb[1], x6 = (lo_bf(y.w) - mu) * rstd * gb[2] + bb[2], x7 = (hi_bf(y.w) - mu) * rstd * gb[3] + bb[3];
            w.x = cvt_pk_bf16(x0, x1); w.y = cvt_pk_bf16(x2, x3); w.z = cvt_pk_bf16(x4, x5); w.w = cvt_pk_bf16(x6, x7);
            *(u32x4*)(xp + 32 * s) = w;
            { u32x2 w8; w8.x = cvt4_fp8(x0 * F8_SX, x1 * F8_SX, x2 * F8_SX, x3 * F8_SX); w8.y = cvt4_fp8(x4 * F8_SX, x5 * F8_SX, x6 * F8_SX, x7 * F8_SX); *(u32x2*)(xq + 32 * s) = w8; }
            const bf16x8 af = __builtin_bit_cast(bf16x8, w);
            const LAS unsigned char* bq = lds + (size_t)s * 4096 + lane * 16;
            const bf16x8 b0h = *(const LAS bf16x8*)(bq), b0l = *(const LAS bf16x8*)(bq + 1024), b1h = *(const LAS bf16x8*)(bq + 2048), b1l = *(const LAS bf16x8*)(bq + 3072);
            acc0 = __builtin_amdgcn_mfma_f32_16x16x32_bf16(af, b0h, acc0, 0, 0, 0); acc0 = __builtin_amdgcn_mfma_f32_16x16x32_bf16(af, b0l, acc0, 0, 0, 0);
            acc1 = __builtin_amdgcn_mfma_f32_16x16x32_bf16(af, b1h, acc1, 0, 0, 0); acc1 = __builtin_amdgcn_mfma_f32_16x16x32_bf16(af, b1l, acc1, 0, 0, 0);
        }
        LAS float* lg2 = (LAS float*)(lds + 131072 + wid * 2048);
#pragma unroll
        for (int i = 0; i < 4; ++i) { lg2[(4 * q + i) * 32 + r] = acc0[i] + p.router_b[r]; lg2[(4 * q + i) * 32 + 16 + r] = acc1[i] + p.router_b[16 + r]; }
        asm volatile("s_waitcnt lgkmcnt(0)" ::: "memory");
        int e0 = 0, e1 = 0, r0 = 0, r1 = 0; float w0 = 0.f, w1 = 0.f;
        if (lane < 16) {
            float pr[32]; float mx = -INFINITY;
#pragma unroll
            for (int e = 0; e < 32; ++e) { pr[e] = lg2[lane * 32 + e]; mx = fmaxf(mx, pr[e]); }
#pragma unroll
            for (int e = 0; e < 32; ++e) pr[e] = __expf(pr[e] - mx);
            int best = 0; float bs = -1.f;
#pragma unroll
            for (int gi = 0; gi < 8; ++gi) { const float a = pr[4 * gi], b2 = pr[4 * gi + 1], c2 = pr[4 * gi + 2], d2 = pr[4 * gi + 3];
                const float h1 = fmaxf(a, b2), l1 = fminf(a, b2), h2 = fmaxf(c2, d2), l2 = fminf(c2, d2);
                const float m1 = fmaxf(h1, h2), m2 = fmaxf(fminf(h1, h2), fmaxf(l1, l2));
                const float sc = m1 + m2; if (sc > bs) { bs = sc; best = gi; } }
            float v[4];
#pragma unroll
            for (int gi = 0; gi < 8; ++gi) if (gi == best) { v[0] = pr[4 * gi]; v[1] = pr[4 * gi + 1]; v[2] = pr[4 * gi + 2]; v[3] = pr[4 * gi + 3]; }
            int i0 = 0; float v0 = v[0];
#pragma unroll
            for (int i = 1; i < 4; ++i) if (v[i] > v0) { v0 = v[i]; i0 = i; }
            int i1 = -1; float v1 = -1.f;
#pragma unroll
            for (int i = 0; i < 4; ++i) if (i != i0 && v[i] > v1) { v1 = v[i]; i1 = i; }
            e0 = best * 4 + i0; e1 = best * 4 + i1; const float ws = 1.0f / (v0 + v1); w0 = v0 * ws; w1 = v1 * ws;
            r0 = atomicAdd((int*)hist + e0, 1); r1 = atomicAdd((int*)hist + e1, 1);
        }
        __syncthreads();
        if (tid < 32) { const int hv = hist[tid]; hist[32 + tid] = hv ? atomicAdd((int*)(p.ws + WS_GCNT) + L * 32 + tid, hv) : 0; }
        __syncthreads();
        if (lane < 16) { const int t2 = tb * 128 + wid * 16 + lane; const int s0 = hist[32 + e0] + r0, s1 = hist[32 + e1] + r1;
            ((int*)(p.ws + WS_RE))[t2 * 2] = e0; ((int*)(p.ws + WS_RE))[t2 * 2 + 1] = e1;
            ((float*)(p.ws + WS_RWT))[t2 * 2] = w0 * (1.0f / F8_SY); ((float*)(p.ws + WS_RWT))[t2 * 2 + 1] = w1 * (1.0f / F8_SY);
            ((int*)(p.ws + WS_POS))[t2 * 2] = s0; ((int*)(p.ws + WS_POS))[t2 * 2 + 1] = s1;
            ((int*)(p.ws + WS_ROWTOK))[e0 * 65536 + s0] = t2; ((int*)(p.ws + WS_ROWTOK))[e1 * 65536 + s1] = t2; }
        __syncthreads();
        if (tid < 32) hist[tid] = 0;
        __syncthreads();
    }
}

template <int L> __device__ __forceinline__ void phase_ln2(const Params& p, LAS unsigned char* lds) {
    const int tid = otid(), lane = tid & 63, wid = tid >> 6;
    LAS int* pst = (LAS int*)lds;
    __syncthreads();
    if (tid == 0) { const int* cnt = (const int*)(p.ws + WS_GCNT) + L * 32; int s = 0; for (int e = 0; e < NEXP; ++e) { pst[e] = s; s += (cnt[e] + 255) & ~255; } }
    __syncthreads();
    const int* RE = (const int*)(p.ws + WS_RE);
    const float* lg = p.ln_g + (L * 2 + 1) * 1024; const float* lb = p.ln_b + (L * 2 + 1) * 1024;
    const bf16_t* X1 = (const bf16_t*)(p.ws + WS_X1B); const unsigned char* YB = (const unsigned char*)(p.ws + WS_BIG);
    const int* POS = (const int*)(p.ws + WS_POS); const float* RW = (const float*)(p.ws + WS_RWT);
    const int tok0 = blockIdx.x * 8 + wid, tstride = gridDim.x * 8, nk = (NTOK - tok0 + tstride - 1) / tstride;
    int rs0 = 0, rs1 = 0; float rw0 = 0.f, rw1 = 0.f;
    if (lane < nk && lane < 16) { const int t = tok0 + lane * tstride; rs0 = pst[RE[t * 2]] + POS[t * 2]; rs1 = pst[RE[t * 2 + 1]] + POS[t * 2 + 1]; rw0 = RW[t * 2]; rw1 = RW[t * 2 + 1]; }
    u32x4 ra[2][2]; u32x2 rb[2][2], rc[2][2];
#define LN2_LOAD(k, buf) do { const int t_ = tok0 + (k) * tstride; const int s0_ = __shfl(rs0, (k)), s1_ = __shfl(rs1, (k)); _Pragma("unroll") for (int hf = 0; hf < 2; ++hf) { const int c0 = hf * 512 + lane * 8; \
        ra[buf][hf] = __builtin_nontemporal_load((const u32x4*)(X1 + (size_t)t_ * 1024 + c0)); rb[buf][hf] = __builtin_nontemporal_load((const u32x2*)(YB + (size_t)s0_ * 1024 + c0)); rc[buf][hf] = __builtin_nontemporal_load((const u32x2*)(YB + (size_t)s1_ * 1024 + c0)); } } while (0)
    if (nk > 0) LN2_LOAD(0, 0);
#pragma unroll
    for (int k = 0; k < 16; ++k) {
        if (k < nk) {
            const int tok = tok0 + k * tstride; const float w0 = __shfl(rw0, k), w1 = __shfl(rw1, k);
            if (k + 1 < nk) LN2_LOAD(k + 1, (k + 1) & 1);
            float v[16];
#pragma unroll
            for (int hf = 0; hf < 2; ++hf) { const u32x4 a = ra[k & 1][hf]; const u32x2 b = rb[k & 1][hf], c = rc[k & 1][hf];
                const unsigned aw[4] = {a.x, a.y, a.z, a.w}, bw[2] = {b.x, b.y}, cw[2] = {c.x, c.y};
#pragma unroll
                for (int j = 0; j < 4; ++j) { const f32x2 yb = (j & 1) ? __builtin_amdgcn_cvt_pk_f32_fp8((int)bw[j >> 1], true) : __builtin_amdgcn_cvt_pk_f32_fp8((int)bw[j >> 1], false);
                    const f32x2 yc = (j & 1) ? __builtin_amdgcn_cvt_pk_f32_fp8((int)cw[j >> 1], true) : __builtin_amdgcn_cvt_pk_f32_fp8((int)cw[j >> 1], false);
                    v[hf * 8 + 2 * j] = ALPHA * lo_bf(aw[j]) + w0 * yb[0] + w1 * yc[0]; v[hf * 8 + 2 * j + 1] = ALPHA * hi_bf(aw[j]) + w0 * yb[1] + w1 * yc[1]; } }
            float s = 0.f;
#pragma unroll
            for (int i = 0; i < 16; ++i) s += v[i];
            const float mu = wave_sum(s) * (1.0f / 1024.0f);
            float qv = 0.f;
#pragma unroll
            for (int i = 0; i < 16; ++i) { const float d = v[i] - mu; qv += d * d; }
            const float rstd = rsqrtf(wave_sum(qv) * (1.0f / 1024.0f) + 1e-5f);
#pragma unroll
            for (int hf = 0; hf < 2; ++hf) { const int c0 = hf * 512 + lane * 8; float o[8];
                const f32x4 ga = *(const f32x4*)(lg + c0), gb = *(const f32x4*)(lg + c0 + 4), ba = *(const f32x4*)(lb + c0), bb = *(const f32x4*)(lb + c0 + 4);
#pragma unroll
                for (int j = 0; j < 4; ++j) { o[j] = (v[hf * 8 + j] - mu) * rstd * ga[j] + ba[j]; o[4 + j] = (v[hf * 8 + 4 + j] - mu) * rstd * gb[j] + bb[j]; }
                if (L == 1) { __builtin_nontemporal_store((f32x4){o[0], o[1], o[2], o[3]}, (f32x4*)(p.out + (size_t)tok * 1024 + c0)); __builtin_nontemporal_store((f32x4){o[4], o[5], o[6], o[7]}, (f32x4*)(p.out + (size_t)tok * 1024 + c0 + 4)); }
                else { u32x4 w; w.x = cvt_pk_bf16(o[0], o[1]); w.y = cvt_pk_bf16(o[2], o[3]); w.z = cvt_pk_bf16(o[4], o[5]); w.w = cvt_pk_bf16(o[6], o[7]); *(u32x4*)((bf16_t*)(p.ws + WS_XB) + (size_t)tok * 1024 + c0) = w;
                    u32x2 w8; w8.x = cvt4_i8(o[0] * I8_SX, o[1] * I8_SX, o[2] * I8_SX, o[3] * I8_SX); w8.y = cvt4_i8(o[4] * I8_SX, o[5] * I8_SX, o[6] * I8_SX, o[7] * I8_SX);
                    *(u32x2*)((unsigned char*)(p.ws + WS_X1Q) + (size_t)tok * 1024 + c0) = w8; } }
        }
    }
#undef LN2_LOAD
}

__device__ __forceinline__ void phase_cmpfin(const Params& p, LAS unsigned char* lds) {
    const int tid = otid(), lane = tid & 63, wid = tid >> 6;
    LAS float* w2s = (LAS float*)lds;
    LAS float* hs = (LAS float*)(lds + 65536) + wid * 1024;
    LAS float* b1s = (LAS float*)(lds + 65536 + 32768);
    const float* CP = (const float*)(p.ws + WS_X1B); const float* B1 = (const float*)(p.ws + WS_B1);
    for (int kv = 0; kv < 2; ++kv) {
        __syncthreads();
        { const float* w2g = kv ? p.cv_w2 : p.ck_w2; for (int i = tid; i < 256 * 64; i += NTHREADS) w2s[i] = w2g[i]; }
        if (tid < 256) { float b1 = 0.f;
#pragma unroll 8
            for (int pt = 0; pt < 32; ++pt) b1 += B1[(kv * 32 + pt) * 256 + tid];
            b1s[tid] = b1; }
        __syncthreads();
        bf16_t* dst = (bf16_t*)(p.ws + (kv ? WS_VCMP : WS_KCMP));
        for (int rg = blockIdx.x * 8 + wid; rg < 8192 / 4; rg += gridDim.x * 8) {
            const int m0 = rg * 4;
#pragma unroll
            for (int i = 0; i < 4; ++i) { const int j = lane + 64 * i; const float b1 = b1s[j];
                f32x4 hv;
#pragma unroll
                for (int rr = 0; rr < 4; ++rr) { float a = b1;
#pragma unroll
                    for (int ks = 0; ks < 2; ++ks) a += __builtin_nontemporal_load(CP + ((size_t)(kv * 2 + ks) * 8192 + m0 + rr) * 256 + j);
                    const float u = 0.7978845608028654f * (a + 0.044715f * a * a * a); const float th = 1.0f - 2.0f / (1.0f + __expf(2.0f * u));
                    hv[rr] = 0.5f * a * (1.0f + th); }
                *(LAS f32x4*)(hs + j * 4) = hv; }
            asm volatile("s_waitcnt lgkmcnt(0)" ::: "memory");
            f32x4 o = (f32x4){0.f, 0.f, 0.f, 0.f}; const LAS float* w2 = w2s + lane;
#pragma unroll 8
            for (int j = 0; j < 256; ++j) o += *(const LAS f32x4*)(hs + j * 4) * w2[j * 64];
#pragma unroll
            for (int rr = 0; rr < 4; ++rr) dst[(size_t)(m0 + rr) * 64 + lane] = f2bf((((m0 + rr) & 127) == 127) ? 0.f : o[rr]);
            asm volatile("s_waitcnt lgkmcnt(0)" ::: "memory");
        }
    }
}

constexpr int NPHASE = 19;
template <int PH> __device__ __forceinline__ void run_phase(const Params& p, LAS unsigned char* lds) {
    char* ws = p.ws;
    if constexpr (PH == 0) phase_prologue(p, lds);
    else if constexpr (PH == 1) { SchedPlainI8 S; S.init(ws + WS_X1Q, ws + WS_WQKV0, NTOK, 3072, 512); EpiQKV0 E{(bf16_t*)(ws + WS_BIG), (float*)(ws + WS_KPART)}; pg8::gemm_phase(lds, S, E); }
    else if constexpr (PH == 2) phase_moba<0>(p, lds);
    else if constexpr (PH == 3) { SchedPlainF8 S; S.init(ws + WS_AOH, ws + WS_WO0, NTOK, 1024, 512); EpiRes<false, true> E{(bf16_t*)(ws + WS_BIG), nullptr, (const bf16_t*)(ws + WS_XB)}; pg8::gemm_phase(lds, S, E); }
    else if constexpr (PH == 4) phase_ln1<0>(p, lds);
    else if constexpr (PH == 6 || PH == 16) { SchedMoeGU S; S.init(ws, PH == 16, lds); EpiGU E{(unsigned char*)(ws + WS_AOH)}; pg8::gemm_phase(lds, S, E);
        {
            const int rem = (S.nM * 4) % (int)gridDim.x, nidle = (int)gridDim.x - rem; const bool useidle = (rem > 0 && nidle * 2 >= (int)gridDim.x);
            const int cgw = useidle ? ((int)blockIdx.x - rem) * 8 + (otid() >> 6) : (int)blockIdx.x * 8 + (otid() >> 6), cng = (useidle ? nidle : (int)gridDim.x) * 8;
            __syncthreads();
            if (!useidle || (int)blockIdx.x >= rem) {
                if constexpr (PH == 6) conv_moe_stream(p, 1, 0, 0, lds, cgw, cng, 0, GU1_P6);
                else conv_moe_stream(p, 1, 1, DN1_OFF, lds, cgw, cng); } } }
    else if constexpr (PH == 7 || PH == 17) { SchedMoeDN S; S.init(ws, PH == 17, lds); EpiDN E{(unsigned char*)(ws + WS_BIG)}; pg8::gemm_phase(lds, S, E);
        if constexpr (PH == 7) {
            const int rem = (S.nM * 4) % (int)gridDim.x, nidle = (int)gridDim.x - rem; const bool useidle = (rem > 0 && nidle * 2 >= (int)gridDim.x);
            __syncthreads();
            if (!useidle) conv_moe_stream(p, 1, 0, 0, lds, (int)blockIdx.x * 8 + (otid() >> 6), (int)gridDim.x * 8, GU1_P6, GU1_EARLY);
            else if ((int)blockIdx.x >= rem) conv_moe_stream(p, 1, 0, 0, lds, ((int)blockIdx.x - rem) * 8 + (otid() >> 6), nidle * 8, GU1_P6, GU1_EARLY); } }
    else if constexpr (PH == 8) { phase_ln2<0>(p, lds); __syncthreads(); conv_moe_stream(p, 1, 0, 0, lds, (int)blockIdx.x * 8 + (otid() >> 6), (int)gridDim.x * 8, GU1_EARLY); }
    else if constexpr (PH == 9) {
        { SchedNsaProjI8 S; S.init(ws + WS_X1Q, ws + WS_WIN1, NTOK, 2816, 512); S.bcnt = (unsigned*)(ws + WS_BCNT); EpiNSA E{(bf16_t*)(ws + WS_BIG)}; pg8::gemm_phase(lds, S, E); }
        { SchedCmp S; S.init(ws); EpiCmp E{(float*)(ws + WS_X1B)}; pg8::gemm_phase(lds, S, E); } }
    else if constexpr (PH == 11) phase_cmpfin(p, lds);
    else if constexpr (PH == 12) phase_nsa(p, lds);
    else if constexpr (PH == 13) { SchedPlainF8 S; S.init(ws + WS_AOH, ws + WS_WO1, NTOK, 1024, 512); EpiRes<false, true> E{(bf16_t*)(ws + WS_BIG), nullptr, (const bf16_t*)(ws + WS_XB)}; pg8::gemm_phase(lds, S, E); }
    else if constexpr (PH == 14) phase_ln1<1>(p, lds);
    else if constexpr (PH == 18) phase_ln2<1>(p, lds);
}

extern __shared__ __attribute__((aligned(16))) unsigned char g_smem[];

template <int PH> __global__ void __launch_bounds__(NTHREADS, 2) k_phase(Params p) {
    run_phase<PH>(p, (LAS unsigned char*)g_smem);
}

#if !MK_LAUNCHES
template <int PH> __device__ __forceinline__ void mega_seq(const Params& p, LAS unsigned char* lds, const XcdBarrier& bar) {
    if constexpr (PH == 5 || PH == 15 || PH == 10) { mega_seq<PH + 1>(p, lds, bar); return; }
    run_phase<PH>(p, lds);
#ifdef PROBE_VAR
    if constexpr (PH == 2) { xcd_barrier(bar); phase_moba<PROBE_VAR>(p, lds); }
#endif
#ifdef PROBE_BAR
    if constexpr (PH == 3) { for (int i = 0; i < 16; ++i) xcd_barrier(bar); }
#endif
#ifdef PROBE_GEMM_NULL
    if constexpr (PH == 1) { xcd_barrier(bar); SchedPlain S; S.init(p.ws + WS_XB, p.ws + WS_WQKV0, NTOK, 3072, 1024); EpiNull E{(float*)(p.ws + WS_X1B)}; pg8::gemm_phase(lds, S, E); }
#endif
#ifdef PROBE_MASK
    if constexpr ((PROBE_MASK >> PH) & 1) { xcd_barrier(bar); run_phase<PH>(p, lds); }
#endif
    if constexpr (PH + 1 < NPHASE) { xcd_barrier(bar); mega_seq<PH + 1>(p, lds, bar); }
}
__global__ void __launch_bounds__(NTHREADS, 2) k_mega(Params p) {
    LAS unsigned char* lds = (LAS unsigned char*)g_smem;
    LAS unsigned* stw = (LAS unsigned*)(lds + LDS_BYTES - 16);
    if (threadIdx.x == 0) { stw[0] = 0u; stw[1] = 0u; stw[2] = 0u; stw[3] = 0u; }
    __syncthreads();
    XcdBarrier bar = xcd_barrier_post((unsigned*)(p.ws + WS_CTL), (volatile LAS unsigned*)stw);
    mega_seq<0>(p, lds, bar);
}

#endif
template <int PH> static void launch_phases(const Params& p, int grid, hipStream_t stream) {
    hipFuncSetAttribute((const void*)k_phase<PH>, hipFuncAttributeMaxDynamicSharedMemorySize, LDS_BYTES);
    hipLaunchKernelGGL(k_phase<PH>, dim3(grid), dim3(NTHREADS), LDS_BYTES, stream, p);
    if constexpr (PH + 1 < NPHASE) launch_phases<PH + 1>(p, grid, stream);
}

extern "C" void kernel_launch(void* const* d_in, const int* in_sizes, int n_in, void* d_out, int out_size, void* d_ws, size_t ws_size, hipStream_t stream) {
    if (n_in != 19 || ws_size < WS_END) { fprintf(stderr, "kernel_launch: need 19 inputs and %zu bytes of workspace (got %d, %zu)\n", (size_t)WS_END, n_in, ws_size); return; }
    Params p{};
    p.x = (const float*)d_in[0]; p.rel_bias = (const float*)d_in[1]; p.router_w = (const float*)d_in[2]; p.router_b = (const float*)d_in[3];
    p.ln_g = (const float*)d_in[4]; p.ln_b = (const float*)d_in[5]; p.moba_w_in = (const float*)d_in[6]; p.moba_w_out = (const float*)d_in[7];
    p.nsa_w_in = (const float*)d_in[8]; p.nsa_w_out = (const float*)d_in[9]; p.pos_k = (const float*)d_in[10]; p.pos_v = (const float*)d_in[11];
    p.ck_w1 = (const float*)d_in[12]; p.ck_w2 = (const float*)d_in[13]; p.cv_w1 = (const float*)d_in[14]; p.cv_w2 = (const float*)d_in[15];
    p.w_gate = (const float*)d_in[16]; p.w_up = (const float*)d_in[17]; p.w_down = (const float*)d_in[18];
    p.out = (float*)d_out; p.ws = (char*)d_ws;
    const int grid = NWG_EXPECT;
#if MK_LAUNCHES
    launch_phases<0>(p, grid, stream);
#else
    hipFuncSetAttribute((const void*)k_mega, hipFuncAttributeMaxDynamicSharedMemorySize, LDS_BYTES);
    hipMemsetAsync((char*)d_ws + WS_CTL, 0, 16384, stream);
    hipLaunchKernelGGL(k_mega, dim3(grid), dim3(NTHREADS), LDS_BYTES, stream, p);
#endif
}
```

```cpp
#include <hip/hip_runtime.h>
#include <cstdio>
#include <cstdint>

#ifndef MK_LAUNCHES
#define MK_LAUNCHES 0
#endif

#define LAS __attribute__((address_space(3)))
typedef unsigned short bf16_t;
typedef short bf16x8 __attribute__((ext_vector_type(8)));
typedef short s16x4 __attribute__((ext_vector_type(4)));
typedef short v4i16_t __attribute__((ext_vector_type(4)));
typedef float f32x4 __attribute__((ext_vector_type(4)));
typedef float f32x16 __attribute__((ext_vector_type(16)));
typedef unsigned u32x4 __attribute__((ext_vector_type(4)));
typedef unsigned u32x2 __attribute__((ext_vector_type(2)));
typedef float f32x2 __attribute__((ext_vector_type(2)));
typedef int i32x4 __attribute__((ext_vector_type(4)));
typedef int i32x8 __attribute__((ext_vector_type(8)));
typedef LAS const char* lds_cptr;

constexpr int NTOK = 32768, DM = 1024, SEQ = 2048, NBATCH = 16, NHEAD = 16;
constexpr int QKV_LD = 3072, NSA_LD = 2816;
constexpr int NSA_KC = 1024, NSA_VC = 1280, NSA_KS = 1536, NSA_VS = 1792, NSA_KW = 2048, NSA_VW = 2304, NSA_G = 2560;
constexpr int NEXP = 32, DEXP = 512, MAXPAN = 288, RPAD = MAXPAN * 256;
constexpr int NTHREADS = 512, NWG_EXPECT = 256;
constexpr int LDS_BYTES = 155648;
constexpr float LOG2E = 1.4426950408889634f;
constexpr float C2 = 0.125f * LOG2E;
constexpr float ALPHA = 1.4142135623730951f;
constexpr int BT_N = 288;
constexpr int BT_S = 292, BT_H = 4 * BT_S;

constexpr size_t al256(size_t x) { return (x + 255) & ~(size_t)255; }
constexpr size_t WS_CTL = 0;
constexpr size_t WS_BCNT = 14592;
constexpr size_t WS_GCNT = 14336;
constexpr size_t WS_TAB = 16384;
constexpr size_t WS_B1 = WS_TAB + al256(16 * BT_H * 4);
constexpr size_t WS_NPAN = WS_B1 + 65536;
constexpr size_t WS_PANEL = WS_NPAN + 256;
constexpr size_t WS_HIST = WS_PANEL + 1280;
constexpr size_t WS_KPART = WS_HIST + 32768;
constexpr size_t WS_RE = WS_KPART + 128 * 2 * 1024 * 4;
constexpr size_t WS_RWT = WS_RE + (size_t)NTOK * 8;
constexpr size_t WS_POS = WS_RWT + (size_t)NTOK * 8;
constexpr size_t WS_ROWTOK = WS_POS + (size_t)NTOK * 8;
constexpr size_t WS_KCMP = WS_ROWTOK + (size_t)32 * 65536 * 4;
constexpr size_t WS_VCMP = WS_KCMP + 16 * 4 * 128 * 64 * 2;
constexpr size_t WS_WQKV0 = WS_VCMP + 16 * 4 * 128 * 64 * 2;
constexpr size_t WS_WO0 = WS_WQKV0 + (size_t)3072 * 1024 * 2;
constexpr size_t WS_WIN1 = WS_WO0 + (size_t)1024 * 1024 * 2;
constexpr size_t WS_WO1 = WS_WIN1 + (size_t)2816 * 1024 * 2;
constexpr size_t WS_W1T = WS_WO1 + (size_t)1024 * 1024 * 2;
constexpr size_t WS_GU = WS_W1T + (size_t)2 * 256 * 2048 * 2;
constexpr size_t WS_X1Q = WS_GU + (size_t)32 * 1024 * 1024;
constexpr size_t WS_DN = WS_GU + (size_t)32 * 1024 * 1024 * 2;
constexpr int GU1_P6 = 2816, GU1_EARLY = GU1_P6 + 1536;
constexpr size_t DN1_OFF = (size_t)16 * 1024 * 1024;
constexpr size_t WS_XB = WS_DN + (size_t)32 * 1024 * 512 * 2;
constexpr size_t WS_BIG = WS_XB + (size_t)NTOK * 1024 * 2;
constexpr size_t WS_AOH = WS_BIG + (size_t)NTOK * 3072 * 2;
constexpr size_t WS_GU1 = WS_AOH + (size_t)40 * 1024 * 1024;
constexpr size_t WS_X1B = WS_AOH + (size_t)RPAD * 512 * 2;
constexpr size_t WS_END = WS_X1B + (size_t)NTOK * 1024 * 2;

struct Params {
    const float *x, *rel_bias, *router_w, *router_b, *ln_g, *ln_b, *moba_w_in, *moba_w_out, *nsa_w_in, *nsa_w_out, *pos_k, *pos_v,
                *ck_w1, *ck_w2, *cv_w1, *cv_w2, *w_gate, *w_up, *w_down;
    float* out;
    char* ws;
};

__device__ __forceinline__ int otid() { int t = threadIdx.x; asm volatile("" : "+v"(t)); return t; }
__device__ __forceinline__ float bf2f(bf16_t v) { return __uint_as_float(((unsigned)v) << 16); }
__device__ __forceinline__ unsigned cvt_pk_bf16(float lo, float hi) { unsigned r; asm volatile("v_cvt_pk_bf16_f32 %0, %1, %2" : "=v"(r) : "v"(lo), "v"(hi)); return r; }
constexpr float F8_SW = 256.0f, F8_SX = 8.0f, F8_INV = 1.0f / (F8_SW * F8_SX);
constexpr float I8_SX = 127.0f / 6.0f, I8_SW = 127.0f / 0.18f, I8_INV = 1.0f / (I8_SX * I8_SW);
__device__ __forceinline__ unsigned cvt4_i8(float a, float b, float c, float d) {
    a = __builtin_amdgcn_fmed3f(a, -127.f, 127.f) + 12582912.0f; b = __builtin_amdgcn_fmed3f(b, -127.f, 127.f) + 12582912.0f; c = __builtin_amdgcn_fmed3f(c, -127.f, 127.f) + 12582912.0f; d = __builtin_amdgcn_fmed3f(d, -127.f, 127.f) + 12582912.0f;
    return (__float_as_uint(a) & 0xffu) | ((__float_as_uint(b) & 0xffu) << 8) | ((__float_as_uint(c) & 0xffu) << 16) | (__float_as_uint(d) << 24); }
constexpr float QK8_SQ = 16.0f, QK8_SK = 8.0f, QK8_INV = 1.0f / (QK8_SQ * QK8_SK);
constexpr float F8_SY = 32.0f;
constexpr float F8_SO = 16.0f, F8_INVO = 1.0f / (F8_SW * F8_SO);
__device__ __forceinline__ unsigned cvt4_fp8(float a, float b, float c, float d) {
    a = __builtin_amdgcn_fmed3f(a, -448.f, 448.f); b = __builtin_amdgcn_fmed3f(b, -448.f, 448.f); c = __builtin_amdgcn_fmed3f(c, -448.f, 448.f); d = __builtin_amdgcn_fmed3f(d, -448.f, 448.f);
    int w = 0; w = __builtin_amdgcn_cvt_pk_fp8_f32(a, b, w, false); w = __builtin_amdgcn_cvt_pk_fp8_f32(c, d, w, true); return (unsigned)w; }
__device__ __forceinline__ bf16_t f2bf(float f) { return (bf16_t)(cvt_pk_bf16(f, 0.f) & 0xffffu); }
__device__ __forceinline__ float lo_bf(unsigned w) { return __uint_as_float(w << 16); }
__device__ __forceinline__ float hi_bf(unsigned w) { return __uint_as_float(w & 0xffff0000u); }
__device__ __forceinline__ float wave_sum(float v) {
#pragma unroll
    for (int o = 32; o > 0; o >>= 1) v += __shfl_xor(v, o);
    return v; }

#define XB_TMO      128
#define XB_XCNT(j)  (256  + 64 * (j))
#define XB_XSUB(j)  (1280 + 64 * (j))
#define XB_XGEN(j)  (2304 + 64 * (j))
#define XB_TOP      3328
#define XB_TOPGEN   3392
#define XCD_BAR_WORDS 3456
#define XB_SPIN_CAP (1u << 18)
__device__ __forceinline__ unsigned xb_ld(unsigned* p)              { return __hip_atomic_load(p, __ATOMIC_RELAXED, __HIP_MEMORY_SCOPE_AGENT); }
__device__ __forceinline__ unsigned xb_add(unsigned* p, unsigned v) { return __hip_atomic_fetch_add(p, v, __ATOMIC_RELAXED, __HIP_MEMORY_SCOPE_AGENT); }
__device__ __forceinline__ unsigned xb_xcc_id() { return (unsigned)__builtin_amdgcn_s_getreg((3 << 11) | 20) & 0xFu; }
#define XB_SPIN(cond, bar) do { unsigned _sp = 0; while (cond) { __builtin_amdgcn_s_sleep(1); \
    if ((++_sp & 255u) == 0u) { if (xb_ld(&(bar)[XB_TMO])) break; if (_sp > XB_SPIN_CAP) { atomicAdd(&(bar)[XB_TMO], 1u); break; } } } } while (0)
struct XcdBarrier { unsigned* bar; unsigned x; volatile LAS unsigned* st; };
__device__ __forceinline__ XcdBarrier xcd_barrier_post(unsigned* bar, volatile LAS unsigned* st) {
    XcdBarrier b; b.bar = bar; b.x = xb_xcc_id(); b.st = st;
    if (threadIdx.x == 0) (void)xb_add(&bar[XB_XCNT(b.x)], 1u);
    return b;
}
__device__ __forceinline__ void xcd_barrier_complete(unsigned* bar, unsigned x, unsigned& nloc, unsigned& nx) {
    const unsigned G = gridDim.x * gridDim.y * gridDim.z;
    unsigned sum, cnt, mine, sp = 0u;
    for (;;) {
        sum = 0u; cnt = 0u; mine = 0u;
#pragma unroll
        for (unsigned j = 0; j < 16; ++j) { const unsigned c = xb_ld(&bar[XB_XCNT(j)]); sum += c; cnt += (c > 0u) ? 1u : 0u; mine = (j == x) ? c : mine; }
        if (sum == G) break;
        __builtin_amdgcn_s_sleep(1);
        if ((++sp & 255u) == 0u) { if (xb_ld(&bar[XB_TMO])) break; if (sp > XB_SPIN_CAP) { atomicAdd(&bar[XB_TMO], 1u); break; } }
    }
    nloc = mine > 0u ? mine : 1u; nx = cnt > 0u ? cnt : 1u;
}
__device__ __forceinline__ void xcd_barrier(const XcdBarrier& b) {
    asm volatile("s_waitcnt vmcnt(0)" ::: "memory");
    __syncthreads();
    if (threadIdx.x == 0) {
        unsigned* bar = b.bar;
        __builtin_amdgcn_s_waitcnt(0);
        unsigned nloc = b.st[0], nx = b.st[1];
        if (nloc == 0u) { xcd_barrier_complete(bar, b.x, nloc, nx); b.st[0] = nloc; b.st[1] = nx; }
        const unsigned old = xb_add(&bar[XB_XSUB(b.x)], 1u);
        const unsigned gen = old / nloc;
        bool released = false;
        if (old + 1u == (gen + 1u) * nloc) {
            __builtin_amdgcn_fence(__ATOMIC_RELEASE, "agent");
            asm volatile("s_waitcnt vmcnt(0)" ::: "memory");
            const unsigned og = xb_add(&bar[XB_TOP], 1u);
            const unsigned tg = og / nx;
            if (og + 1u == (tg + 1u) * nx) {
#pragma unroll
                for (unsigned j = 0; j < 16; ++j) xb_add(&bar[XB_XGEN(j)], 1u);
                released = true;
            }
        }
        __builtin_amdgcn_fence(__ATOMIC_ACQUIRE, "agent");
        if (!released) XB_SPIN(xb_ld(&bar[XB_XGEN(b.x)]) == gen, bar);
        asm volatile("s_waitcnt vmcnt(0)" ::: "memory");
    }
    __syncthreads();
}

namespace pg8 {
constexpr int BM = 256, BK = 64, HALF = 128, HTB = HALF * BK * 2, STAGE_BYTES = 8 * HTB, NXCD = 8, WGM = 8;
__device__ __forceinline__ int lds_byte(int r, int c) { const int st = (r >> 4) * 2 + (c >> 5), rr = r & 15, cc = c & 31, ob = rr * 64 + cc * 2; return st * 1024 + (ob ^ (((ob >> 9) & 1) << 5)); }
__device__ __forceinline__ void stage_rc(int b, int& R, int& C) { const int st = b / 1024, sb = b % 1024, swz = sb ^ (((sb >> 9) & 1) << 5); R = (st >> 1) * 16 + swz / 64; C = (st & 1) * 32 + (swz % 64) / 2; }
__device__ __forceinline__ int perm32(int rho) { const int n = rho >> 4, i = rho & 15; return 8 * (i >> 2) + 4 * n + (i & 3); }
struct Unit { int pm, pn, aux, aux2; };
__device__ __forceinline__ i32x8 cat8(bf16x8 a, bf16x8 b) { const i32x4 x = __builtin_bit_cast(i32x4, a), y = __builtin_bit_cast(i32x4, b); return __builtin_shufflevector(x, y, 0, 1, 2, 3, 4, 5, 6, 7); }

__device__ __forceinline__ void static_unit(int L, int nM, int nN, Unit& u) {
    const int nwg = nM * nN;
    int wgid = L; { const int q = nwg / NXCD, r = nwg % NXCD, xcd = wgid % NXCD, off = wgid / NXCD; wgid = (xcd < r ? xcd * (q + 1) : r * (q + 1) + (xcd - r) * q) + off; }
    const int nig = WGM * nN, gid = wgid / nig, fm = gid * WGM, gsz = (nM - fm) < WGM ? (nM - fm) : WGM;
    u.pm = fm + ((wgid % nig) % gsz); u.pn = (wgid % nig) / gsz; u.aux = 0; u.aux2 = 0;
}

__device__ __forceinline__ void stage2(const char* sbase, unsigned v0, unsigned v1, unsigned lds0) {
    unsigned sv;
    asm volatile("s_mov_b32 %0, m0\n\ts_mov_b32 m0, %4\n\ts_nop 0\n\tglobal_load_lds_dwordx4 %1, %3\n\ts_mov_b32 m0, %5\n\ts_nop 0\n\tglobal_load_lds_dwordx4 %2, %3\n\ts_mov_b32 m0, %0"
                 : "=&s"(sv) : "v"(v0), "v"(v1), "s"(sbase), "s"(lds0), "s"(lds0 + 8192u) : "memory");
}
template <class Epi, class Sched>
__device__ __forceinline__ void gemm_phase(LAS unsigned char* lds, const Sched& S, const Epi& E) {
    const int tid = otid(), wid = __builtin_amdgcn_readfirstlane(tid >> 6), lane = tid & 63, wr = wid >> 2, wc = wid & 3, fr = lane & 15, fq = lane >> 4;
    int nt_ = S.nt; asm volatile("" : "+s"(nt_));
    const int nt = nt_;
    int sR[2], sC[2];
    unsigned vB[2][2];
#pragma unroll
    for (int i = 0; i < 2; ++i) { stage_rc(tid * 16 + i * 8192, sR[i], sC[i]); const int Rb = Epi::PERM ? ((sR[i] & ~31) + perm32(sR[i] & 31)) : sR[i];
#pragma unroll
        for (int h = 0; h < 2; ++h) vB[h][i] = (unsigned)(h * HALF + Rb) * S.ldb + (unsigned)sC[i] * 2u; }
    const size_t kstepA = S.kstepA, kstepB = S.kstepB;
    const unsigned ldsb = (unsigned)__builtin_amdgcn_readfirstlane((int)((unsigned)(unsigned long)lds + (unsigned)wid * 1024u));
    const int aoff = lds_byte(wr * 64 + fr, fq * 8), boff = lds_byte(wc * 32 + fr, fq * 8);
#define PG8_SA(b, h) (((b) * 2 + (h)) * HTB)
#define PG8_SB(b, h) ((4 + (b) * 2 + (h)) * HTB)
#define PG8_STAGE(bufoff, gbase, v0, v1) stage2((const char*)(gbase), (v0), (v1), ldsb + (unsigned)(bufoff))
#define PG8_LDA(dst, b, h) do { if constexpr (Sched::F8) { _Pragma("unroll") for (int m = 0; m < 4; ++m) { dst##8[m].lo = *(const LAS i32x4*)(lds + PG8_SA(b, h) + aoff + m * 2048); dst##8[m].hi = *(const LAS i32x4*)(lds + PG8_SA(b, h) + aoff + m * 2048 + 1024); } } \
        else { _Pragma("unroll") for (int m = 0; m < 4; ++m) _Pragma("unroll") for (int k = 0; k < 2; ++k) dst[m][k] = *(const LAS bf16x8*)(lds + PG8_SA(b, h) + aoff + m * 2048 + k * 1024); } } while (0)
#define PG8_LDB(dst, b, h) do { if constexpr (Sched::F8) { _Pragma("unroll") for (int n = 0; n < 2; ++n) { dst##8[n].lo = *(const LAS i32x4*)(lds + PG8_SB(b, h) + boff + n * 2048); dst##8[n].hi = *(const LAS i32x4*)(lds + PG8_SB(b, h) + boff + n * 2048 + 1024); } } \
        else { _Pragma("unroll") for (int n = 0; n < 2; ++n) _Pragma("unroll") for (int k = 0; k < 2; ++k) dst[n][k] = *(const LAS bf16x8*)(lds + PG8_SB(b, h) + boff + n * 2048 + k * 1024); } } while (0)
#define PG8_MMA(ai, bj, At, Bt) do { __builtin_amdgcn_s_setprio(1); \
        if constexpr (Sched::F8) { _Pragma("unroll") for (int m = 0; m < 4; ++m) _Pragma("unroll") for (int n = 0; n < 2; ++n) \
            acc[ai][bj][m][n] = __builtin_amdgcn_mfma_scale_f32_16x16x128_f8f6f4(Bt##8[n], At##8[m], acc[ai][bj][m][n], 0, 0, 0, 0, 0, 0); } \
        else if constexpr (Sched::I8) { _Pragma("unroll") for (int m = 0; m < 4; ++m) _Pragma("unroll") for (int n = 0; n < 2; ++n) _Pragma("unroll") for (int k = 0; k < 2; ++k) \
            acc[ai][bj][m][n] = __builtin_bit_cast(f32x4, __builtin_amdgcn_mfma_i32_16x16x64_i8(__builtin_bit_cast(i32x4, Bt[n][k]), __builtin_bit_cast(i32x4, At[m][k]), __builtin_bit_cast(i32x4, acc[ai][bj][m][n]), 0, 0, 0)); } \
        else { _Pragma("unroll") for (int m = 0; m < 4; ++m) _Pragma("unroll") for (int n = 0; n < 2; ++n) _Pragma("unroll") for (int k = 0; k < 2; ++k) \
            acc[ai][bj][m][n] = __builtin_amdgcn_mfma_f32_16x16x32_bf16(Bt[n][k], At[m][k], acc[ai][bj][m][n], 0, 0, 0); } \
        __builtin_amdgcn_s_setprio(0); } while (0)
#define PG8_WAIT_V(n) asm volatile("s_waitcnt vmcnt(" #n ")" ::: "memory")
#define PG8_WAIT_L(n) asm volatile("s_waitcnt lgkmcnt(" #n ")" ::: "memory")
#define PG8_BAR __builtin_amdgcn_s_barrier()
#define PG8_SCHED __builtin_amdgcn_sched_barrier(0)
    Unit cur, nxt; int ui = 0; int prev_code = -1;
    if (!S.next(0, cur)) return;
    f32x4 acc[2][2][4][2];
#pragma unroll
    for (int a = 0; a < 2; ++a)
#pragma unroll
        for (int b = 0; b < 2; ++b)
#pragma unroll
            for (int m = 0; m < 4; ++m)
#pragma unroll
                for (int n = 0; n < 2; ++n) acc[a][b][m][n] = (f32x4){0.f, 0.f, 0.f, 0.f};
    bf16x8 At[4][2], B0[2][2], B1[2][2]; i32x8 At8[4], B08[2], B18[2];
    unsigned vA[2][2], vN[2][2];
#pragma unroll
    for (int h = 0; h < 2; ++h)
#pragma unroll
        for (int i = 0; i < 2; ++i) { vA[h][i] = S.aoff(cur, h * HALF + sR[i], sC[i]); vN[h][i] = vA[h][i]; }
    const char* cA = S.abase(cur); const char* cB = S.bbase(cur);
    S.a_ready(cur);
    PG8_STAGE(PG8_SB(0, 0), cB, vB[0][0], vB[0][1]); PG8_STAGE(PG8_SA(0, 0), cA, vA[0][0], vA[0][1]); PG8_STAGE(PG8_SB(0, 1), cB, vB[1][0], vB[1][1]); PG8_STAGE(PG8_SA(0, 1), cA, vA[1][0], vA[1][1]);
    if (wr == 1) PG8_BAR;
    PG8_WAIT_V(4); PG8_BAR;
    PG8_STAGE(PG8_SB(1, 0), cB + kstepB, vB[0][0], vB[0][1]); PG8_STAGE(PG8_SA(1, 0), cA + kstepA, vA[0][0], vA[0][1]); PG8_STAGE(PG8_SB(1, 1), cB + kstepB, vB[1][0], vB[1][1]);
    PG8_WAIT_V(6); PG8_BAR;
    for (;;) {
        const bool has_next = S.next(ui + 1, nxt);
        const char* nA = has_next ? S.abase(nxt) : cA; const char* nB = has_next ? S.bbase(nxt) : cB;
        if (Sched::DYN_A && has_next) {
#pragma unroll
            for (int h = 0; h < 2; ++h)
#pragma unroll
                for (int i = 0; i < 2; ++i) vN[h][i] = S.aoff(nxt, h * HALF + sR[i], sC[i]);
        }
        asm volatile(".p2align 8" ::: );
#pragma unroll 1
        for (int t = 0; t < nt; t += 2) {
            const bool last = (t == nt - 2);
            const char* a1 = cA + (size_t)(t + 1) * kstepA;
            const char* a2 = last ? nA : cA + (size_t)(t + 2) * kstepA; const char* b2 = last ? nB : cB + (size_t)(t + 2) * kstepB;
            const char* a3 = a2 + kstepA; const char* b3 = b2 + kstepB;
            if (last && has_next) S.a_ready(nxt);
            PG8_LDB(B0, 0, 0); PG8_SCHED; PG8_LDA(At, 0, 0); PG8_STAGE(PG8_SA(1, 1), a1, vA[1][0], vA[1][1]);
            if (Sched::DYN_A && last) {
#pragma unroll
                for (int h = 0; h < 2; ++h)
#pragma unroll
                    for (int i = 0; i < 2; ++i) vA[h][i] = vN[h][i]; }
            PG8_WAIT_L(8); PG8_BAR; PG8_WAIT_L(0); PG8_MMA(0, 0, At, B0); PG8_BAR; PG8_SCHED;
            PG8_LDB(B1, 0, 1); PG8_STAGE(PG8_SB(0, 0), b2, vB[0][0], vB[0][1]);
            PG8_BAR; PG8_WAIT_L(0); PG8_MMA(0, 1, At, B1); PG8_BAR;
            PG8_LDA(At, 0, 1); PG8_STAGE(PG8_SA(0, 0), a2, vA[0][0], vA[0][1]);
            PG8_BAR; PG8_WAIT_L(0); PG8_MMA(1, 0, At, B0); PG8_BAR; PG8_SCHED;
            PG8_STAGE(PG8_SB(0, 1), b2, vB[1][0], vB[1][1]);
            PG8_WAIT_V(6); PG8_BAR; PG8_MMA(1, 1, At, B1); PG8_BAR;
            PG8_LDB(B0, 1, 0); PG8_SCHED; PG8_LDA(At, 1, 0); PG8_STAGE(PG8_SA(0, 1), a2, vA[1][0], vA[1][1]);
            PG8_WAIT_L(8); PG8_BAR; PG8_WAIT_L(0); PG8_MMA(0, 0, At, B0); PG8_BAR; PG8_SCHED;
            PG8_LDB(B1, 1, 1); PG8_STAGE(PG8_SB(1, 0), b3, vB[0][0], vB[0][1]);
            PG8_BAR; PG8_WAIT_L(0); PG8_MMA(0, 1, At, B1); PG8_BAR;
            PG8_LDA(At, 1, 1); PG8_STAGE(PG8_SA(1, 0), a3, vA[0][0], vA[0][1]);
            PG8_BAR; PG8_WAIT_L(0); PG8_MMA(1, 0, At, B0); PG8_BAR; PG8_SCHED;
            PG8_STAGE(PG8_SB(1, 1), b3, vB[1][0], vB[1][1]);
            PG8_WAIT_V(6); PG8_BAR; PG8_MMA(1, 1, At, B1); PG8_BAR;
            if (Sched::PUBLISH && prev_code >= 0) { S.done(prev_code); prev_code = -1; }
        }
        if constexpr (Sched::I8) {
#pragma unroll
            for (int a = 0; a < 2; ++a)
#pragma unroll
                for (int b = 0; b < 2; ++b)
#pragma unroll
                    for (int m = 0; m < 4; ++m)
#pragma unroll
                        for (int n = 0; n < 2; ++n) { const i32x4 iv = __builtin_bit_cast(i32x4, acc[a][b][m][n]); acc[a][b][m][n] = (f32x4){(float)iv[0], (float)iv[1], (float)iv[2], (float)iv[3]} * I8_INV; } }
        E(acc, cur, wr, wc, fr, fq); prev_code = Sched::PUBLISH ? (cur.pm | (cur.pn << 16)) : -1;
        if (!has_next) break;
#pragma unroll
        for (int a = 0; a < 2; ++a)
#pragma unroll
            for (int b = 0; b < 2; ++b)
#pragma unroll
                for (int m = 0; m < 4; ++m)
#pragma unroll
                    for (int n = 0; n < 2; ++n) acc[a][b][m][n] = (f32x4){0.f, 0.f, 0.f, 0.f};
        cur = nxt; cA = nA; cB = nB; ++ui;
    }
    PG8_WAIT_V(0);
    if (Sched::PUBLISH && prev_code >= 0) S.done(prev_code);
    if (wr == 0) PG8_BAR;
    PG8_BAR;
#undef PG8_SA
#undef PG8_SB
#undef PG8_STAGE
#undef PG8_LDA
#undef PG8_LDB
#undef PG8_MMA
#undef PG8_WAIT_V
#undef PG8_WAIT_L
#undef PG8_BAR
#undef PG8_SCHED
}
}
using pg8::Unit;

struct SchedPlain {
    static constexpr bool DYN_A = false;
    static constexpr bool F8 = false;
    static constexpr bool I8 = false;
    const char* A; const char* Bt; int K, nM, nN, G, c; int nt; unsigned kstepA, kstepB, ldb;
    __device__ __forceinline__ void init(const void* A_, const void* Bt_, int M, int N, int K_) { A = (const char*)A_; Bt = (const char*)Bt_; K = K_; nM = M / 256; nN = N / 256; G = gridDim.x; c = blockIdx.x; nt = K / 64; kstepA = 128; kstepB = 128; ldb = (unsigned)K * 2u; }
    __device__ __forceinline__ bool next(int i, Unit& u) const { const int L = i * G + c; if (L >= nM * nN) return false; pg8::static_unit(L, nM, nN, u); return true; }
    __device__ __forceinline__ const char* abase(const Unit& u) const { return A + (size_t)u.pm * 256 * K * 2; }
    __device__ __forceinline__ const char* bbase(const Unit& u) const { return Bt + (size_t)u.pn * 256 * K * 2; }
    __device__ __forceinline__ unsigned aoff(const Unit&, int row, int col) const { return (unsigned)(row * K + col) * 2u; }
    static constexpr bool PUBLISH = false;
    __device__ __forceinline__ void a_ready(const Unit&) const {}
    __device__ __forceinline__ void done(int) const {}
};
constexpr int ML_CNT = 131072, ML_PPRE = ML_CNT + 128, ML_PE = ML_PPRE + 256;
__device__ __forceinline__ int moe_tables(const char* ws, int layer, LAS unsigned char* lds) {
    const int tid = otid(); LAS int* cnt = (LAS int*)(lds + ML_CNT); LAS int* ppre = (LAS int*)(lds + ML_PPRE); LAS int* pe = (LAS int*)(lds + ML_PE);
    __syncthreads();
    if (tid < 32) cnt[tid] = ((const int*)(ws + WS_GCNT))[layer * 32 + tid];
    __syncthreads();
    if (tid == 0) { int s = 0; for (int e = 0; e < NEXP; ++e) { ppre[e] = s; s += (cnt[e] + 255) >> 8; } ppre[NEXP] = s; }
    __syncthreads();
    const int nM = ppre[NEXP];
    if (tid < nM) { int e = 0; for (int k = 1; k < NEXP; ++k) e += (ppre[k] <= tid) ? 1 : 0; pe[tid] = e; }
    __syncthreads();
    return nM;
}
struct SchedPlainF8 : SchedPlain {
    static constexpr bool F8 = true;
    static constexpr bool I8 = false;
    static constexpr bool DYN_A = true;
    __device__ __forceinline__ const char* abase(const Unit&) const { return A; }
    __device__ __forceinline__ unsigned aoff(const Unit& u, int row, int col) const { return (unsigned)((u.pm * 256 + row) * K + col) * 2u; }
};
struct SchedNsaProj : SchedPlain {
    static constexpr bool PUBLISH = true;
    unsigned* bcnt;
    __device__ __forceinline__ void done(int code) const { const int pm = code & 0xffff, pn = code >> 16;
        if ((pn == 4 || pn == 5) && (threadIdx.x & 63) == 0) __hip_atomic_fetch_add(bcnt + (pm >> 3) * 16, 1u, __ATOMIC_RELAXED, __HIP_MEMORY_SCOPE_AGENT); }
};
struct SchedPlainI8 : SchedPlain { static constexpr bool I8 = true; };
struct SchedNsaProjI8 : SchedNsaProj { static constexpr bool I8 = true; };
struct SchedMoeGU {
    static constexpr bool DYN_A = true;
    static constexpr bool F8 = true;
    static constexpr bool I8 = false;
    const char* X; const char* W; const int* tokof; LAS unsigned char* lds; int nM, G, c; int nt; unsigned kstepA, kstepB, ldb;
    __device__ __forceinline__ void init(const char* ws, int layer, LAS unsigned char* lds_) { lds = lds_; nM = moe_tables(ws, layer, lds_); X = ws + WS_X1Q; W = ws + (layer ? WS_GU1 : WS_GU); tokof = (const int*)(ws + WS_ROWTOK); G = gridDim.x; c = blockIdx.x; nt = 8; kstepA = 128; kstepB = 128; ldb = 1024; }
    __device__ __forceinline__ bool next(int i, Unit& u) const { const int L = i * G + c; if (L >= nM * 4) return false; pg8::static_unit(L, nM, 4, u);
        const int e = ((const LAS int*)(lds + ML_PE))[u.pm]; u.aux = e | ((u.pm - ((const LAS int*)(lds + ML_PPRE))[e]) << 16); u.aux2 = ((const LAS int*)(lds + ML_CNT))[e]; return true; }
    __device__ __forceinline__ const char* abase(const Unit&) const { return X; }
    __device__ __forceinline__ const char* bbase(const Unit& u) const { return W + ((size_t)(u.aux & 255) * 1024 + (size_t)u.pn * 256) * 1024; }
    __device__ __forceinline__ unsigned aoff(const Unit& u, int row, int col) const { const int slot = (u.aux >> 16) * 256 + row; const int sl = slot < u.aux2 ? slot : 0;
        return (unsigned)tokof[(u.aux & 255) * 65536 + sl] * 1024u + (unsigned)col * 2u; }
    static constexpr bool PUBLISH = false;
    __device__ __forceinline__ void a_ready(const Unit&) const {}
    __device__ __forceinline__ void done(int) const {}
};
struct SchedMoeDN {
    static constexpr bool DYN_A = true;
    static constexpr bool F8 = true;
    static constexpr bool I8 = false;
    const char* H; const char* W; LAS unsigned char* lds; int nM, G, c; int nt; unsigned kstepA, kstepB, ldb;
    __device__ __forceinline__ void init(const char* ws, int layer, LAS unsigned char* lds_) { lds = lds_; nM = moe_tables(ws, layer, lds_); H = ws + WS_AOH; W = ws + WS_DN + (layer ? DN1_OFF : 0); G = gridDim.x; c = blockIdx.x; nt = 4; kstepA = 128; kstepB = 128; ldb = 512; }
    __device__ __forceinline__ bool next(int i, Unit& u) const { const int L = i * G + c; if (L >= nM * 4) return false; pg8::static_unit(L, nM, 4, u); u.aux = ((const LAS int*)(lds + ML_PE))[u.pm]; u.aux2 = 0; return true; }
    __device__ __forceinline__ const char* abase(const Unit&) const { return H; }
    __device__ __forceinline__ const char* bbase(const Unit& u) const { return W + ((size_t)u.aux * 1024 + (size_t)u.pn * 256) * 512; }
    __device__ __forceinline__ unsigned aoff(const Unit& u, int row, int col) const { return (unsigned)((u.pm * 256 + row) * 512 + col * 2); }
    static constexpr bool PUBLISH = false;
    __device__ __forceinline__ void a_ready(const Unit&) const {}
    __device__ __forceinline__ void done(int) const {}
};
struct SchedCmp {
    static constexpr bool DYN_A = false;
    static constexpr bool F8 = false;
    static constexpr bool I8 = false;
    static constexpr bool PUBLISH = false;
    const char* Q; const char* W; unsigned* bcnt; unsigned* tmo; int c; int nt; unsigned kstepA, kstepB, ldb;
    __device__ __forceinline__ void init(const char* ws) { Q = ws + WS_BIG; W = ws + WS_W1T; bcnt = (unsigned*)(ws + WS_BCNT); tmo = (unsigned*)(ws + WS_CTL) + XB_TMO; c = (int)blockIdx.x - 128; nt = 16; kstepA = NSA_LD * 2; kstepB = 128; ldb = 4096; }
    __device__ __forceinline__ bool next(int i, Unit& u) const { if (c < 0 || i >= 1 || gridDim.x != 256) return false; const int L = c; u.aux = L >> 6; u.aux2 = 0; u.pm = (L >> 1) & 31; u.pn = L & 1; return true; }
    __device__ __forceinline__ const char* abase(const Unit& u) const { return Q + (size_t)(u.aux ? NSA_VC : NSA_KC) * 2 + (size_t)u.pn * 16 * (NSA_LD * 2); }
    __device__ __forceinline__ const char* bbase(const Unit& u) const { return W + (size_t)u.aux * 256 * 4096 + (size_t)u.pn * 16 * 128; }
    __device__ __forceinline__ unsigned aoff(const Unit& u, int row, int col) const {
        const int m = u.pm * 256 + row, bh = m >> 7, n = m & 127, nn = n > 126 ? 126 : n, b = bh >> 2, hkv = bh & 3;
        return (unsigned)(((b * SEQ + 16 * nn) * NSA_LD) + hkv * 64 + col) * 2u; }
    __device__ __forceinline__ void a_ready(const Unit& u) const {
        if (threadIdx.x < 64) { unsigned polls = 0; unsigned* w = bcnt + (u.pm >> 1) * 16;
            while ((unsigned)__builtin_amdgcn_readfirstlane((int)__hip_atomic_load(w, __ATOMIC_RELAXED, __HIP_MEMORY_SCOPE_AGENT)) < 128u) {
                __builtin_amdgcn_s_sleep(2);
                if ((++polls & 255u) == 0u) { if (__builtin_amdgcn_readfirstlane((int)__hip_atomic_load(tmo, __ATOMIC_RELAXED, __HIP_MEMORY_SCOPE_AGENT)) != 0) break;
                    if (polls > (1u << 18)) { if (threadIdx.x == 0) __hip_atomic_fetch_add(tmo, 1u, __ATOMIC_RELAXED, __HIP_MEMORY_SCOPE_AGENT); break; } } }
            __builtin_amdgcn_fence(__ATOMIC_ACQUIRE, "agent");
            asm volatile("s_waitcnt vmcnt(0)" ::: "memory"); }
        asm volatile("" ::: "memory"); __builtin_amdgcn_s_barrier(); asm volatile("" ::: "memory");
    }
    __device__ __forceinline__ void done(int) const {}
};

struct EpiQKV0 {
    static constexpr bool PERM = true;
    bf16_t* O; float* kpart;
    __device__ __forceinline__ void operator()(const f32x4 (&acc)[2][2][4][2], const Unit& u, int wr, int wc, int fr, int fq) const {
        const int row0 = u.pm * 256 + wr * 64 + fr, col0 = u.pn * 256 + wc * 32 + 8 * fq;
        const float sc = (u.pn < 4) ? C2 : 1.0f;
#pragma unroll
        for (int ai = 0; ai < 2; ++ai)
#pragma unroll
            for (int m = 0; m < 4; ++m) { bf16_t* rowp = O + (size_t)(row0 + ai * 128 + m * 16) * QKV_LD + col0;
#pragma unroll
                for (int bj = 0; bj < 2; ++bj) { const f32x4 v0 = acc[ai][bj][m][0] * sc, v1 = acc[ai][bj][m][1] * sc;
                    if (u.pn < 8) {
                        const float s8 = (u.pn < 4) ? QK8_SQ : QK8_SK;
                        u32x2 w8; w8.x = cvt4_fp8(v0[0] * s8, v0[1] * s8, v0[2] * s8, v0[3] * s8); w8.y = cvt4_fp8(v1[0] * s8, v1[1] * s8, v1[2] * s8, v1[3] * s8);
                        *(u32x2*)((unsigned char*)O + (size_t)(row0 + ai * 128 + m * 16) * (QKV_LD * 2) + (u.pn < 4 ? 0 : 2048) + (u.pn & 3) * 256 + wc * 32 + 8 * fq + bj * 128) = w8; }
                    else { u32x4 w; w.x = cvt_pk_bf16(v0[0], v0[1]); w.y = cvt_pk_bf16(v0[2], v0[3]); w.z = cvt_pk_bf16(v1[0], v1[1]); w.w = cvt_pk_bf16(v1[2], v1[3]);
                        *(u32x4*)(rowp + bj * 128) = w; } } }
        if (u.pn >= 4 && u.pn < 8) {
#pragma unroll
            for (int bj = 0; bj < 2; ++bj)
#pragma unroll
                for (int n = 0; n < 2; ++n) { f32x4 s = (f32x4){0.f, 0.f, 0.f, 0.f};
#pragma unroll
                    for (int ai = 0; ai < 2; ++ai)
#pragma unroll
                        for (int m = 0; m < 4; ++m) s += acc[ai][bj][m][n];
#pragma unroll
                    for (int j = 0; j < 4; ++j) { float v = s[j]; v += __shfl_xor(v, 1); v += __shfl_xor(v, 2); v += __shfl_xor(v, 4); v += __shfl_xor(v, 8); s[j] = v; }
                    if (fr == 0) *(f32x4*)(kpart + ((size_t)u.pm * 2 + wr) * 1024 + (u.pn - 4) * 256 + bj * 128 + wc * 32 + 8 * fq + 4 * n) = s; }
        }
    }
};
struct EpiNull {
    static constexpr bool PERM = true;
    float* sink;
    __device__ __forceinline__ void operator()(const f32x4 (&acc)[2][2][4][2], const Unit& u, int wr, int wc, int fr, int fq) const {
        float s = 0.f;
#pragma unroll
        for (int ai = 0; ai < 2; ++ai)
#pragma unroll
            for (int bj = 0; bj < 2; ++bj)
#pragma unroll
                for (int m = 0; m < 4; ++m)
#pragma unroll
                    for (int n = 0; n < 2; ++n) s += acc[ai][bj][m][n][0] + acc[ai][bj][m][n][3];
        if (s == 12345.678f) sink[u.pm + wr + wc + fr + fq] = s;
    }
};
struct EpiNSA {
    static constexpr bool PERM = true;
    bf16_t* O;
    __device__ __forceinline__ void operator()(const f32x4 (&acc)[2][2][4][2], const Unit& u, int wr, int wc, int fr, int fq) const {
        const int row0 = u.pm * 256 + wr * 64 + fr, col0 = u.pn * 256 + wc * 32 + 8 * fq;
        const float sc = (u.pn < 4) ? C2 : 1.0f; const bool sg = (u.pn == 10), wt = (u.pn == 4 || u.pn == 5);
        const auto rsrc = __builtin_amdgcn_make_buffer_rsrc((void*)O, 0, (int)((size_t)NTOK * NSA_LD * 2), 0x00020000);
#pragma unroll
        for (int ai = 0; ai < 2; ++ai)
#pragma unroll
            for (int m = 0; m < 4; ++m) { bf16_t* rowp = O + (size_t)(row0 + ai * 128 + m * 16) * NSA_LD + col0;
#pragma unroll
                for (int bj = 0; bj < 2; ++bj) { f32x4 v0 = acc[ai][bj][m][0] * sc, v1 = acc[ai][bj][m][1] * sc;
                    if (sg) {
#pragma unroll
                        for (int j = 0; j < 4; ++j) { v0[j] = __builtin_amdgcn_rcpf(1.0f + __builtin_amdgcn_exp2f(-LOG2E * v0[j])); v1[j] = __builtin_amdgcn_rcpf(1.0f + __builtin_amdgcn_exp2f(-LOG2E * v1[j])); } }
                    u32x4 w; w.x = cvt_pk_bf16(v0[0], v0[1]); w.y = cvt_pk_bf16(v0[2], v0[3]); w.z = cvt_pk_bf16(v1[0], v1[1]); w.w = cvt_pk_bf16(v1[2], v1[3]);
                    if (wt) __builtin_amdgcn_raw_buffer_store_b128(w, rsrc, (int)(((unsigned)(row0 + ai * 128 + m * 16) * (unsigned)NSA_LD + (unsigned)(col0 + bj * 128)) * 2u), 0, 16);
                    else *(u32x4*)(rowp + bj * 128) = w; } }
    }
};
template <bool RES_F32, bool F8O = false> struct EpiRes {
    static constexpr bool PERM = true;
    bf16_t* O; const float* rf; const bf16_t* rb;
    __device__ __forceinline__ void operator()(const f32x4 (&acc)[2][2][4][2], const Unit& u, int wr, int wc, int fr, int fq) const {
        const int row0 = u.pm * 256 + wr * 64 + fr, col0 = u.pn * 256 + wc * 32 + 8 * fq;
#pragma unroll
        for (int ai = 0; ai < 2; ++ai) {
            if (RES_F32) {
#pragma unroll
                for (int mh = 0; mh < 2; ++mh) { f32x4 r[2][2][2];
#pragma unroll
                    for (int m2 = 0; m2 < 2; ++m2)
#pragma unroll
                        for (int bj = 0; bj < 2; ++bj) { const size_t ro = (size_t)(row0 + ai * 128 + (mh * 2 + m2) * 16) * 1024 + col0 + bj * 128; r[m2][bj][0] = *(const f32x4*)(rf + ro); r[m2][bj][1] = *(const f32x4*)(rf + ro + 4); }
#pragma unroll
                    for (int m2 = 0; m2 < 2; ++m2)
#pragma unroll
                        for (int bj = 0; bj < 2; ++bj) { const int m = mh * 2 + m2; const size_t ro = (size_t)(row0 + ai * 128 + m * 16) * 1024 + col0 + bj * 128;
                            const f32x4 v0 = acc[ai][bj][m][0] + r[m2][bj][0] * ALPHA, v1 = acc[ai][bj][m][1] + r[m2][bj][1] * ALPHA;
                            u32x4 w; w.x = cvt_pk_bf16(v0[0], v0[1]); w.y = cvt_pk_bf16(v0[2], v0[3]); w.z = cvt_pk_bf16(v1[0], v1[1]); w.w = cvt_pk_bf16(v1[2], v1[3]);
                            *(u32x4*)(O + ro) = w; } }
            } else {
                u32x4 r[4][2];
#pragma unroll
                for (int m = 0; m < 4; ++m)
#pragma unroll
                    for (int bj = 0; bj < 2; ++bj) r[m][bj] = *(const u32x4*)(rb + (size_t)(row0 + ai * 128 + m * 16) * 1024 + col0 + bj * 128);
#pragma unroll
                for (int m = 0; m < 4; ++m)
#pragma unroll
                    for (int bj = 0; bj < 2; ++bj) { const size_t ro = (size_t)(row0 + ai * 128 + m * 16) * 1024 + col0 + bj * 128; const u32x4 rw = r[m][bj];
                        const f32x4 r0 = (f32x4){lo_bf(rw.x), hi_bf(rw.x), lo_bf(rw.y), hi_bf(rw.y)}, r1 = (f32x4){lo_bf(rw.z), hi_bf(rw.z), lo_bf(rw.w), hi_bf(rw.w)};
                        const f32x4 v0 = (F8O ? acc[ai][bj][m][0] * F8_INVO : acc[ai][bj][m][0]) + r0 * ALPHA, v1 = (F8O ? acc[ai][bj][m][1] * F8_INVO : acc[ai][bj][m][1]) + r1 * ALPHA;
                        u32x4 w; w.x = cvt_pk_bf16(v0[0], v0[1]); w.y = cvt_pk_bf16(v0[2], v0[3]); w.z = cvt_pk_bf16(v1[0], v1[1]); w.w = cvt_pk_bf16(v1[2], v1[3]);
                        *(u32x4*)(O + ro) = w; }
            }
        }
    }
};
struct EpiGU {
    static constexpr bool PERM = true;
    unsigned char* O;
    __device__ __forceinline__ void operator()(const f32x4 (&acc)[2][2][4][2], const Unit& u, int wr, int wc, int fr, int fq) const {
        const int row0 = u.pm * 256 + wr * 64 + fr, col0 = u.pn * 128 + wc * 32 + 8 * fq;
#pragma unroll
        for (int ai = 0; ai < 2; ++ai)
#pragma unroll
            for (int m = 0; m < 4; ++m) { float h[8];
#pragma unroll
                for (int n = 0; n < 2; ++n)
#pragma unroll
                    for (int j = 0; j < 4; ++j) { const float g = acc[ai][0][m][n][j] * F8_INV, up = acc[ai][1][m][n][j] * (F8_INV * F8_SX); h[n * 4 + j] = g * up * __builtin_amdgcn_rcpf(1.0f + __builtin_amdgcn_exp2f(-LOG2E * g)); }
                u32x2 w; w.x = cvt4_fp8(h[0], h[1], h[2], h[3]); w.y = cvt4_fp8(h[4], h[5], h[6], h[7]);
                *(u32x2*)(O + (size_t)(row0 + ai * 128 + m * 16) * 512 + col0) = w; }
    }
};
struct EpiDN {
    static constexpr bool PERM = true;
    unsigned char* O;
    __device__ __forceinline__ void operator()(const f32x4 (&acc)[2][2][4][2], const Unit& u, int wr, int wc, int fr, int fq) const {
        const int row0 = u.pm * 256 + wr * 64 + fr, col0 = u.pn * 256 + wc * 32 + 8 * fq; constexpr float s = F8_INV * F8_SY;
#pragma unroll
        for (int ai = 0; ai < 2; ++ai)
#pragma unroll
            for (int m = 0; m < 4; ++m) { unsigned char* rowp = O + (size_t)(row0 + ai * 128 + m * 16) * 1024 + col0;
#pragma unroll
                for (int bj = 0; bj < 2; ++bj) { const f32x4 v0 = acc[ai][bj][m][0] * s, v1 = acc[ai][bj][m][1] * s;
                    u32x2 w; w.x = cvt4_fp8(v0[0], v0[1], v0[2], v0[3]); w.y = cvt4_fp8(v1[0], v1[1], v1[2], v1[3]);
                    *(u32x2*)(rowp + bj * 128) = w; } }
    }
};
struct EpiCmp {
    static constexpr bool PERM = false;
    float* CP;
    __device__ __forceinline__ void operator()(const f32x4 (&acc)[2][2][4][2], const Unit& u, int wr, int wc, int fr, int fq) const {
        float* base = CP + ((size_t)(u.aux * 2 + u.pn) * 8192 + (size_t)u.pm * 256) * 256;
        const int row0 = wr * 64 + fr, col0 = wc * 32 + 4 * fq;
#pragma unroll
        for (int ai = 0; ai < 2; ++ai)
#pragma unroll
            for (int m = 0; m < 4; ++m) { float* rowp = base + (size_t)(row0 + ai * 128 + m * 16) * 256 + col0;
#pragma unroll
                for (int bj = 0; bj < 2; ++bj)
#pragma unroll
                    for (int n = 0; n < 2; ++n) *(f32x4*)(rowp + bj * 128 + n * 16) = acc[ai][bj][m][n]; }
    }
};

constexpr int AL_K = 0  , AL_V = 24576  , AL_BIAS = 57344  , AL_KM = AL_BIAS + 4 * BT_H * 4, AL_IMP = AL_KM + 2048  , AL_CMP = AL_IMP + 33792  , AL_SEL = AL_CMP + 32768, AL_LIST = AL_SEL + 512, AL_END = AL_LIST + 256;
static_assert(AL_END <= LDS_BYTES, "attention LDS map");
static_assert(AL_END <= LDS_BYTES - 16 && 4 * 64 * 33 * 4 <= 65536, "attention LDS map");
#define MFMA32(a, b, c) __builtin_amdgcn_mfma_f32_32x32x16_bf16(a, b, c, 0, 0, 0)
__device__ __forceinline__ s16x4 vtr(lds_cptr p) { return __builtin_bit_cast(s16x4, __builtin_amdgcn_ds_read_tr16_b64_v4i16((LAS v4i16_t*)p)); }
__device__ __forceinline__ float xhalf_max(float m) { auto rr = __builtin_amdgcn_permlane32_swap(__float_as_uint(m), __float_as_uint(m), false, false); return __builtin_fmaxf(__uint_as_float(rr[0]), __uint_as_float(rr[1])); }
__device__ __forceinline__ float xhalf_sum(float m) { auto rr = __builtin_amdgcn_permlane32_swap(__float_as_uint(m), __float_as_uint(m), false, false); return __uint_as_float(rr[0]) + __uint_as_float(rr[1]); }
__device__ __forceinline__ float max16(const f32x16& p) { float a = __builtin_fmaxf(p[0], p[1]), b = __builtin_fmaxf(p[2], p[3]);
#pragma unroll
    for (int r = 4; r < 16; r += 4) { a = __builtin_fmaxf(a, __builtin_fmaxf(p[r], p[r + 1])); b = __builtin_fmaxf(b, __builtin_fmaxf(p[r + 2], p[r + 3])); }
    return __builtin_fmaxf(a, b); }

#define MX3(a, b, c) __builtin_fmaxf(__builtin_fmaxf((a), (b)), (c))
__device__ __forceinline__ float max32(const f32x16& p0, const f32x16& p1) {
    float a = MX3(p0[0], p0[1], p1[0]), b = MX3(p0[2], p0[3], p1[1]); a = MX3(a, p1[2], p1[3]);
#pragma unroll
    for (int r = 4; r < 16; r += 4) { a = MX3(a, p0[r], p0[r + 1]); b = MX3(b, p0[r + 2], p0[r + 3]); a = MX3(a, p1[r], p1[r + 1]); b = MX3(b, p1[r + 2], p1[r + 3]); }
    return __builtin_fmaxf(a, b); }
constexpr float FLASH_THR = 8.0f;
__device__ __forceinline__ void glds16(const void* g, unsigned lds_addr) {
    unsigned sv; asm volatile("s_mov_b32 %0, m0\n\ts_mov_b32 m0, %2\n\ts_nop 0\n\tglobal_load_lds_dwordx4 %1, off\n\ts_mov_b32 m0, %0" : "=&s"(sv) : "v"(g), "s"(lds_addr) : "memory"); }
__device__ __forceinline__ void dma_k(const bf16_t* src, int ld, LAS unsigned char* lds, int slot, int wid, int lane, int base = AL_K) {
    const int rl = lane >> 3, ch = lane & 7;
    glds16(src + (size_t)(wid * 8 + rl) * ld + ((ch ^ rl) * 8), (unsigned)__builtin_amdgcn_readfirstlane((int)((unsigned)(unsigned long)lds + base + slot * 8192 + wid * 1024))); }
__device__ __forceinline__ void dma_v(const bf16_t* src, int ld, LAS unsigned char* lds, int slot, int wid, int lane, int base = AL_V) {
    glds16(src + (size_t)(16 * (wid & 3) + (lane >> 2)) * ld + (wid >> 2) * 32 + (lane & 3) * 8, (unsigned)__builtin_amdgcn_readfirstlane((int)((unsigned)(unsigned long)lds + base + slot * 8192 + wid * 1024))); }

__device__ __forceinline__ void dma_k8(const unsigned char* src8, int ld, LAS unsigned char* lds, int slot, int wid, int lane) {
    glds16(src8 + (size_t)(16 * (wid & 3) + (lane >> 2)) * ld + (lane & 3) * 16, (unsigned)__builtin_amdgcn_readfirstlane((int)((unsigned)(unsigned long)lds + AL_K + slot * 8192 + (wid & 3) * 1024))); }
struct FState { float m, l; f32x16 o0, o1; };
__device__ __forceinline__ void fstate_reset(FState& s) { s.m = -1e30f; s.l = 0.f;
#pragma unroll
    for (int r = 0; r < 16; ++r) { s.o0[r] = 0.f; s.o1[r] = 0.f; } }

__device__ __forceinline__ int kchunk_off(int d0, int kx) { return (((2 * d0 + (kx >> 3)) ^ (kx & 7)) * 16); }
__device__ __forceinline__ void qk_tile(f32x16& c0, f32x16& c1, const bf16x8 (&qr)[4], lds_cptr kp, int kx) {
#pragma unroll
    for (int d0 = 0; d0 < 4; ++d0) { const bf16x8 k0 = *(const LAS bf16x8*)(kp + kchunk_off(d0, kx)), k1 = *(const LAS bf16x8*)(kp + kchunk_off(d0, kx) + 4096);
        c0 = MFMA32(k0, qr[d0], c0); c1 = MFMA32(k1, qr[d0], c1); }
}
__device__ __forceinline__ void pv_tile(f32x16& o0, f32x16& o1, const f32x16& p0, const f32x16& p1, lds_cptr vp) {
#pragma unroll
    for (int k = 0; k < 4; ++k) {
        const f32x16& ps = (k < 2) ? p0 : p1; const int b = 8 * (k & 1);
        const u32x4 pw = (u32x4){cvt_pk_bf16(ps[b], ps[b + 1]), cvt_pk_bf16(ps[b + 2], ps[b + 3]), cvt_pk_bf16(ps[b + 4], ps[b + 5]), cvt_pk_bf16(ps[b + 6], ps[b + 7])};
        const bf16x8 pf = __builtin_bit_cast(bf16x8, pw);
        { const s16x4 lo = vtr(vp + k * 1024), hi = vtr(vp + k * 1024 + 512);
          const bf16x8 vf = (bf16x8){lo[0], lo[1], lo[2], lo[3], hi[0], hi[1], hi[2], hi[3]}; o0 = MFMA32(vf, pf, o0); }
        { const s16x4 lo = vtr(vp + 4096 + k * 1024), hi = vtr(vp + 4096 + k * 1024 + 512);
          const bf16x8 vf = (bf16x8){lo[0], lo[1], lo[2], lo[3], hi[0], hi[1], hi[2], hi[3]}; o1 = MFMA32(vf, pf, o1); }
    }
}
struct TileP { int Dmin; bool rowok, run, win; };
__device__ __forceinline__ void load_kf(bf16x8 (&kf)[8], lds_cptr kp, int kx) {
#pragma unroll
    for (int d0 = 0; d0 < 4; ++d0) { kf[2 * d0] = *(const LAS bf16x8*)(kp + kchunk_off(d0, kx)); kf[2 * d0 + 1] = *(const LAS bf16x8*)(kp + kchunk_off(d0, kx) + 4096); } }
__device__ __forceinline__ void flash_qk(f32x16& c0, f32x16& c1, float& cf, const bf16x8 (&qr)[4], lds_cptr kp, int kx, const LAS float* btab, float cfar, int Dmin, int r32, int hi) {
    bf16x8 kf[8]; load_kf(kf, kp, kx);
    if (Dmin - 63 < 127) {
        const int s0 = (BT_N - 1 - 63) - (Dmin + r32 - 4 * hi), ksh = s0 & 3; cf = 0.f;
        const LAS f32x4* bp = (const LAS f32x4*)(btab + ksh * BT_S + (s0 - ksh));
#pragma unroll
        for (int g = 0; g < 4; ++g) { const f32x4 a = bp[2 * g], b = bp[8 + 2 * g];
#pragma unroll
            for (int i = 0; i < 4; ++i) { c0[4 * g + i] = a[i]; c1[4 * g + i] = b[i]; } }
#pragma unroll
        for (int d0 = 0; d0 < 4; ++d0) { c0 = MFMA32(kf[2 * d0], qr[d0], c0); c1 = MFMA32(kf[2 * d0 + 1], qr[d0], c1); }
    } else {
        cf = cfar;
        const f32x16 z = {0.f, 0.f, 0.f, 0.f, 0.f, 0.f, 0.f, 0.f, 0.f, 0.f, 0.f, 0.f, 0.f, 0.f, 0.f, 0.f};
        c0 = MFMA32(kf[0], qr[0], z); c1 = MFMA32(kf[1], qr[0], z);
#pragma unroll
        for (int d0 = 1; d0 < 4; ++d0) { c0 = MFMA32(kf[2 * d0], qr[d0], c0); c1 = MFMA32(kf[2 * d0 + 1], qr[d0], c1); }
    }
}
#define MFMA8(a, b, c) __builtin_amdgcn_mfma_scale_f32_32x32x64_f8f6f4(a, b, c, 0, 0, 0, 0, 0, 0)
__device__ __forceinline__ void flash_qk(f32x16& c0, f32x16& c1, float& cf, const i32x8& q8, lds_cptr kp8, int, const LAS float* btab, float cfar, int Dmin, int r32, int hi) {
    i32x8 k0, k1;
    k0.lo = *(const LAS i32x4*)(kp8); k0.hi = *(const LAS i32x4*)(kp8 + 16); k1.lo = *(const LAS i32x4*)(kp8 + 2048); k1.hi = *(const LAS i32x4*)(kp8 + 2048 + 16);
    if (Dmin - 63 < 127) {
        const int s0 = (BT_N - 1 - 63) - (Dmin + r32 - 4 * hi), ksh = s0 & 3; cf = 0.f;
        const LAS f32x4* bp = (const LAS f32x4*)(btab + ksh * BT_S + (s0 - ksh));
#pragma unroll
        for (int g = 0; g < 4; ++g) { const f32x4 a = bp[2 * g] * (QK8_SQ * QK8_SK), b = bp[8 + 2 * g] * (QK8_SQ * QK8_SK);
#pragma unroll
            for (int i = 0; i < 4; ++i) { c0[4 * g + i] = a[i]; c1[4 * g + i] = b[i]; } }
        c0 = MFMA8(k0, q8, c0); c1 = MFMA8(k1, q8, c1);
    } else {
        cf = cfar;
        const f32x16 z = {0.f, 0.f, 0.f, 0.f, 0.f, 0.f, 0.f, 0.f, 0.f, 0.f, 0.f, 0.f, 0.f, 0.f, 0.f, 0.f};
        c0 = MFMA8(k0, q8, z); c1 = MFMA8(k1, q8, z);
    }
}
template <bool K8 = false>
__device__ __forceinline__ void flash_sm(FState& st, f32x16& c0, f32x16& c1, float cf, const TileP& tp, int r32, int hi) {
    const int Dmin = tp.Dmin, Dl = Dmin + r32 - 4 * hi;
    if (tp.win && (Dmin + 31 >= 512)) {
#pragma unroll
        for (int r = 0; r < 16; ++r) { const int ko = (r & 3) + 8 * (r >> 2); if (Dl >= 512 + ko) c0[r] = -INFINITY; if (Dl >= 544 + ko) c1[r] = -INFINITY; }
    }
    float mx = (K8 ? xhalf_max(max32(c0, c1)) * QK8_INV : xhalf_max(max32(c0, c1))) + cf;
    mx = tp.rowok ? mx : -INFINITY;
    if (__any(mx > st.m + FLASH_THR)) {
        const float mn = __builtin_fmaxf(st.m, mx); const float alpha = __builtin_amdgcn_exp2f(st.m - mn);
        st.m = mn; st.l *= alpha;
#pragma unroll
        for (int r = 0; r < 16; ++r) { st.o0[r] *= alpha; st.o1[r] *= alpha; }
    }
    const float msub = tp.rowok ? (st.m - cf) : INFINITY;
    float rs0 = 0.f, rs1 = 0.f;
#pragma unroll
    for (int r = 0; r < 16; ++r) { c0[r] = __builtin_amdgcn_exp2f(K8 ? __builtin_fmaf(c0[r], QK8_INV, -msub) : c0[r] - msub); c1[r] = __builtin_amdgcn_exp2f(K8 ? __builtin_fmaf(c1[r], QK8_INV, -msub) : c1[r] - msub); rs0 += c0[r]; rs1 += c1[r]; }
    st.l += rs0 + rs1;
}
template <int VAR, class Src, bool PRE = false, bool K8 = false, class QT = bf16x8[4]>
__device__ __forceinline__ void attn_stream(Src& S, int NT, FState& st, const QT& qr, LAS unsigned char* lds, const LAS float* btab, float cfar, int wid, int lane, int r32, int hi) {
    const lds_cptr kp0 = K8 ? (lds_cptr)lds + AL_K + r32 * 64 + hi * 32 : (lds_cptr)lds + AL_K + r32 * 128; const int kx = (r32 & 7) | (hi << 3);
    const lds_cptr vp0 = (lds_cptr)lds + AL_V + ((lane >> 4) & 1) * 32 + (lane & 3) * 8 + (4 * hi + ((lane & 15) >> 2)) * 64;
    if (!PRE) { S.dma(0, 0, 0); if (NT > 1 && VAR != 5 && VAR != 6) S.dma(1, 1, 1); }
    if (VAR == 5) { asm volatile("s_waitcnt vmcnt(0)" ::: "memory"); __syncthreads(); }
    int sc = 0, sn = 2;
    S.prefetch(-1);
#pragma nounroll
    for (int t = 0; t < NT; ++t) {
        if (VAR != 5) { if (t + 1 < NT) asm volatile("s_waitcnt vmcnt(2)" ::: "memory"); else asm volatile("s_waitcnt vmcnt(0)" ::: "memory");
        __syncthreads(); }
        if (VAR != 5 && VAR != 6) { if (t + 2 < NT) S.dma_pre(t + 2, sn, sn); }
        const TileP tp = S.params(t);
        S.prefetch(t);
        if (tp.run) { f32x16 c0, c1; float cf;
            flash_qk(c0, c1, cf, qr, kp0 + sc * 8192, kx, btab, cfar, tp.Dmin, r32, hi);
            flash_sm<K8>(st, c0, c1, cf, tp, r32, hi);
            pv_tile(st.o0, st.o1, c0, c1, vp0 + sc * 8192); }
        S.after(t, st);
        sc = (sc == 2) ? 0 : sc + 1; sn = (sn == 2) ? 0 : sn + 1;
    }
}

__device__ __forceinline__ void conv_tile(const float* src, int N, bf16_t* dst, int ldd, int k0, int n0, int rowadd, int mode, LAS float* t, int lane) {
    f32x4 v[16];
#pragma unroll
    for (int i = 0; i < 16; ++i) { const int r = i * 4 + (lane >> 4), cc = n0 + (lane & 15) * 4;
        v[i] = (cc < N) ? __builtin_nontemporal_load((const f32x4*)(src + (size_t)(k0 + r) * N + cc)) : (f32x4){0.f, 0.f, 0.f, 0.f}; }
#pragma unroll
    for (int i = 0; i < 16; ++i) { const int r = i * 4 + (lane >> 4), cc = (lane & 15) * 4; LAS float* q = t + r * 65 + cc; q[0] = v[i][0]; q[1] = v[i][1]; q[2] = v[i][2]; q[3] = v[i][3]; }
    asm volatile("s_waitcnt lgkmcnt(0)" ::: "memory");
#pragma unroll
    for (int i = 0; i < 8; ++i) { const int nr = i * 8 + (lane >> 3), kc = (lane & 7) * 8; float f[8];
#pragma unroll
        for (int j = 0; j < 8; ++j) f[j] = t[(kc + j) * 65 + nr];
        const int n = n0 + nr; const int drow = ((mode & 1) == 0) ? n : (256 * (n >> 7) + (n & 127) + rowadd);
        if (mode & 2) { u32x2 w8;
            if (mode & 4) { w8.x = cvt4_i8(f[0] * I8_SW, f[1] * I8_SW, f[2] * I8_SW, f[3] * I8_SW); w8.y = cvt4_i8(f[4] * I8_SW, f[5] * I8_SW, f[6] * I8_SW, f[7] * I8_SW); }
            else { w8.x = cvt4_fp8(f[0] * F8_SW, f[1] * F8_SW, f[2] * F8_SW, f[3] * F8_SW); w8.y = cvt4_fp8(f[4] * F8_SW, f[5] * F8_SW, f[6] * F8_SW, f[7] * F8_SW); }
            *(u32x2*)((unsigned char*)dst + (size_t)drow * ldd + k0 + kc) = w8; }
        else { u32x4 w; w.x = cvt_pk_bf16(f[0], f[1]); w.y = cvt_pk_bf16(f[2], f[3]); w.z = cvt_pk_bf16(f[4], f[5]); w.w = cvt_pk_bf16(f[6], f[7]);
            *(u32x4*)(dst + (size_t)drow * ldd + k0 + kc) = w; } }
    asm volatile("s_waitcnt lgkmcnt(0)" ::: "memory");
}
__device__ __forceinline__ int conv_job(const float* src, int K, int N, int Npad, bf16_t* dst, int ldd, int rowadd, int mode, int tile0, LAS float* t, int gw, int ngw, int lane) {
    const int nkt = K / 64, nnt = Npad / 64, ntile = nkt * nnt;
    int first = (gw - tile0 % ngw + ngw) % ngw;
    for (int i = first; i < ntile; i += ngw) conv_tile(src, N, dst, ldd, (i / nnt) * 64, (i % nnt) * 64, rowadd, mode, t, lane);
    return tile0 + ntile;
}
struct MoeTile { const float* src; unsigned char* dst; int N, ldd, k0, n0, rowadd, gated; };
__device__ __forceinline__ MoeTile moe_tile(const Params& p, int layer, int g, int which, size_t dn_off) {
    const int e = which ? (g >> 7) : (g >> 8), job = which ? 2 : ((g >> 7) & 1), tl = g & 127; const size_t wo = ((size_t)layer * NEXP + e) * 1024 * 512; MoeTile m;
    if (job < 2) { m.src = (job ? p.w_up : p.w_gate) + wo; m.N = 512; m.dst = (unsigned char*)(p.ws + (layer ? WS_GU1 : WS_GU)) + (size_t)e * 1024 * 1024; m.ldd = 1024; m.k0 = (tl >> 3) * 64; m.n0 = (tl & 7) * 64; m.rowadd = job * 128; m.gated = 1; }
    else { m.src = p.w_down + wo; m.N = 1024; m.dst = (unsigned char*)(p.ws + WS_DN) + dn_off + (size_t)e * 1024 * 512; m.ldd = 512; m.k0 = (tl >> 4) * 64; m.n0 = (tl & 15) * 64; m.rowadd = 0; m.gated = 0; }
    return m;
}
__device__ __forceinline__ void moe_tile_load(f32x4 (&v)[16], const MoeTile& m, int lane) {
#pragma unroll
    for (int i = 0; i < 16; ++i) { const int r = i * 4 + (lane >> 4), cc = m.n0 + (lane & 15) * 4; v[i] = __builtin_nontemporal_load((const f32x4*)(m.src + (size_t)(m.k0 + r) * m.N + cc)); }
}
__device__ __forceinline__ void moe_tile_finish(const f32x4 (&v)[16], const MoeTile& m, LAS float* t, int lane) {
#pragma unroll
    for (int i = 0; i < 16; ++i) { const int r = i * 4 + (lane >> 4), cc = (lane & 15) * 4; LAS float* q = t + r * 65 + cc; q[0] = v[i][0]; q[1] = v[i][1]; q[2] = v[i][2]; q[3] = v[i][3]; }
    asm volatile("s_waitcnt lgkmcnt(0)" ::: "memory");
#pragma unroll
    for (int i = 0; i < 8; ++i) { const int nr = i * 8 + (lane >> 3), kc = (lane & 7) * 8; float f[8];
#pragma unroll
        for (int j = 0; j < 8; ++j) f[j] = t[(kc + j) * 65 + nr];
        const int n = m.n0 + nr; const int drow = m.gated ? (256 * (n >> 7) + (n & 127) + m.rowadd) : n;
        u32x2 w8; w8.x = cvt4_fp8(f[0] * F8_SW, f[1] * F8_SW, f[2] * F8_SW, f[3] * F8_SW); w8.y = cvt4_fp8(f[4] * F8_SW, f[5] * F8_SW, f[6] * F8_SW, f[7] * F8_SW);
        *(u32x2*)(m.dst + (size_t)drow * m.ldd + m.k0 + kc) = w8; }
    asm volatile("s_waitcnt lgkmcnt(0)" ::: "memory");
}
__device__ __forceinline__ void conv_moe_stream(const Params& p, int layer, int which, size_t dn_off, LAS unsigned char* lds, int gw, int ngw, int gbeg = 0, int gend = -1) {
    const int tid = otid(), lane = tid & 63, wid = tid >> 6;
    LAS float* t = (LAS float*)(lds + wid * (64 * 65 * 4));
    const int NTILE = gend >= 0 ? gend : (which ? NEXP * 128 : NEXP * 256);
    f32x4 va[16], vb[16];
    int g = gbeg + gw;
    if (g < NTILE) { const MoeTile m = moe_tile(p, layer, g, which, dn_off); moe_tile_load(va, m, lane); }
    while (g < NTILE) {
        { const int gn = g + ngw; if (gn < NTILE) { const MoeTile mn = moe_tile(p, layer, gn, which, dn_off); moe_tile_load(vb, mn, lane); }
          const MoeTile m = moe_tile(p, layer, g, which, dn_off); moe_tile_finish(va, m, t, lane); g = gn; }
        if (g >= NTILE) break;
        { const int gn = g + ngw; if (gn < NTILE) { const MoeTile mn = moe_tile(p, layer, gn, which, dn_off); moe_tile_load(va, mn, lane); }
          const MoeTile m = moe_tile(p, layer, g, which, dn_off); moe_tile_finish(vb, m, t, lane); g = gn; }
    }
}
__device__ __forceinline__ void phase_prologue(const Params& p, LAS unsigned char* lds) {
    const int tid = otid(), lane = tid & 63, wid = tid >> 6, gw = blockIdx.x * 8 + wid, ngw = gridDim.x * 8;
    LAS float* t = (LAS float*)(lds + wid * (64 * 65 * 4));
    char* ws = p.ws;
    { const size_t n8 = (size_t)NTOK * 1024 / 8; bf16_t* xb = (bf16_t*)(ws + WS_XB);
      for (size_t i = (size_t)blockIdx.x * NTHREADS + tid; i < n8; i += (size_t)gridDim.x * NTHREADS) {
          const f32x4 a = __builtin_nontemporal_load((const f32x4*)(p.x + i * 8)), b = __builtin_nontemporal_load((const f32x4*)(p.x + i * 8 + 4));
          u32x4 w; w.x = cvt_pk_bf16(a[0], a[1]); w.y = cvt_pk_bf16(a[2], a[3]); w.z = cvt_pk_bf16(b[0], b[1]); w.w = cvt_pk_bf16(b[2], b[3]);
          *(u32x4*)(xb + i * 8) = w;
          u32x2 w8; w8.x = cvt4_i8(a[0] * I8_SX, a[1] * I8_SX, a[2] * I8_SX, a[3] * I8_SX); w8.y = cvt4_i8(b[0] * I8_SX, b[1] * I8_SX, b[2] * I8_SX, b[3] * I8_SX);
          *(u32x2*)((unsigned char*)(ws + WS_X1Q) + i * 8) = w8; } }
    int tile0 = 0;
    tile0 = conv_job(p.moba_w_in, 1024, 3072, 3072, (bf16_t*)(ws + WS_WQKV0), 1024, 0, 6, tile0, t, gw, ngw, lane);
    tile0 = conv_job(p.moba_w_out, 1024, 1024, 1024, (bf16_t*)(ws + WS_WO0), 1024, 0, 2, tile0, t, gw, ngw, lane);
    tile0 = conv_job(p.nsa_w_in, 1024, 2608, 2816, (bf16_t*)(ws + WS_WIN1), 1024, 0, 6, tile0, t, gw, ngw, lane);
    tile0 = conv_job(p.nsa_w_out, 1024, 1024, 1024, (bf16_t*)(ws + WS_WO1), 1024, 0, 2, tile0, t, gw, ngw, lane);
    tile0 = conv_job(p.ck_w1, 2048, 256, 256, (bf16_t*)(ws + WS_W1T), 2048, 0, 0, tile0, t, gw, ngw, lane);
    tile0 = conv_job(p.cv_w1, 2048, 256, 256, (bf16_t*)(ws + WS_W1T) + 256 * 2048, 2048, 0, 0, tile0, t, gw, ngw, lane);
    conv_moe_stream(p, 0, 0, 0, lds, gw, ngw); conv_moe_stream(p, 0, 1, 0, lds, gw, ngw);
    for (int i = blockIdx.x * NTHREADS + tid; i < 16 * BT_H; i += gridDim.x * NTHREADS) {
        const int h = i / BT_H, k = (i % BT_H) / BT_S, j = i % BT_S; int e = (BT_N - 1) - (j + k); e = e < 0 ? 0 : e;
        int n = e - 63; const bool future = n < 0; n = n < 0 ? 0 : (n > 127 ? 127 : n);
        int bk = n;
        if (n >= 16) { bk = 16 + (int)(logf((float)n / 16.0f) / logf(8.0f) * 16.0f); bk = bk > 31 ? 31 : bk; }
        ((float*)(ws + WS_TAB))[i] = future ? -INFINITY : p.rel_bias[bk * 16 + h] * LOG2E; }
    if (gridDim.x == 256) {
        __syncthreads();
        const int combo = blockIdx.x >> 2, kv = combo >> 5, part = combo & 31, jj = tid & 63, ks = tid >> 6, j = (blockIdx.x & 3) * 64 + jj;
        const float* pos = kv ? p.pos_v : p.pos_k; const float* w1 = kv ? p.cv_w1 : p.ck_w1; float s = 0.f;
#pragma unroll
        for (int k = part * 64 + ks * 8; k < part * 64 + ks * 8 + 8; ++k) s += pos[k] * w1[(size_t)k * 256 + j];
        LAS float* red = (LAS float*)lds; red[ks * 64 + jj] = s;
        __syncthreads();
        if (tid < 64) { float a = 0.f;
#pragma unroll
            for (int q8 = 0; q8 < 8; ++q8) a += red[q8 * 64 + tid];
            ((float*)(ws + WS_B1))[(kv * 32 + part) * 256 + j] = a; }
    } else if (blockIdx.x < 32) { const int kv = blockIdx.x >> 4, part = (blockIdx.x & 15) * 2 + (tid >> 8), j = tid & 255;
        const float* pos = kv ? p.pos_v : p.pos_k; const float* w1 = kv ? p.cv_w1 : p.ck_w1; float s = 0.f;
#pragma unroll 16
        for (int k = part * 64; k < part * 64 + 64; ++k) s += pos[k] * w1[(size_t)k * 256 + j];
        ((float*)(ws + WS_B1))[(kv * 32 + part) * 256 + j] = s; }
}

__device__ __forceinline__ void store_o_rows(LAS unsigned char* stg, unsigned char* grow0, const f32x16& a0, const f32x16& a1, float scale, int lane, int r32, int hi) {
    LAS unsigned char* sp = stg + r32 * 80 + hi * 4; const float s16 = scale * F8_SO;
#pragma unroll
    for (int g4 = 0; g4 < 4; ++g4) {
        *(LAS unsigned*)(sp + g4 * 8) = cvt4_fp8(a0[4 * g4] * s16, a0[4 * g4 + 1] * s16, a0[4 * g4 + 2] * s16, a0[4 * g4 + 3] * s16);
        *(LAS unsigned*)(sp + 32 + g4 * 8) = cvt4_fp8(a1[4 * g4] * s16, a1[4 * g4 + 1] * s16, a1[4 * g4 + 2] * s16, a1[4 * g4 + 3] * s16); }
    asm volatile("s_waitcnt lgkmcnt(0)" ::: "memory");
#pragma unroll
    for (int it = 0; it < 2; ++it) { const int row = it * 16 + (lane >> 2), ch = lane & 3;
        const u32x4 v = *(const LAS u32x4*)(stg + row * 80 + ch * 16);
        *(u32x4*)(grow0 + (size_t)row * 1024 + ch * 16) = v; }
    asm volatile("s_waitcnt lgkmcnt(0)" ::: "memory");
}
template <int VAR> __device__ __forceinline__ void moba_unit(const Params& p, LAS unsigned char* lds, int b, int h, int qb) {
    const int tid = otid(), lane = tid & 63, r32 = lane & 31, hi = lane >> 5; const int wid = __builtin_amdgcn_readfirstlane(tid >> 6);
    const bf16_t* QKV = (const bf16_t*)(p.ws + WS_BIG);
    const size_t rowbase = (size_t)b * SEQ; const int q0 = qb * 256, qw = q0 + wid * 32;
    const unsigned char* Kb = (const unsigned char*)QKV + rowbase * (QKV_LD * 2) + 2048 + h * 64;
    const bf16_t* Vb = QKV + rowbase * QKV_LD + 2048 + h * 64;
    i32x8 qr;
    { const unsigned char* qp = (const unsigned char*)QKV + (rowbase + qw + r32) * (QKV_LD * 2) + h * 64 + hi * 32;
      qr.lo = *(const i32x4*)(qp); qr.hi = *(const i32x4*)(qp + 16); }
    float kmv, btv[3];
    { const float* kp = (const float*)(p.ws + WS_KPART); const int j = tid >> 6, d = tid & 63;
      const float* s = kp + ((size_t)(b * 8 + j) * 2) * 1024 + h * 64 + d; kmv = s[0] + s[1024];
#pragma unroll
      for (int i = 0; i < 3; ++i) { const int ix = tid + i * NTHREADS; btv[i] = ((const float*)(p.ws + WS_TAB))[h * BT_H + (ix < BT_H ? ix : 0)]; } }
    __syncthreads();
    dma_k8(Kb + (size_t)q0 * (QKV_LD * 2), QKV_LD * 2, lds, 0, wid, lane); dma_v(Vb + (size_t)q0 * QKV_LD, QKV_LD, lds, 0, wid, lane);
    dma_k8(Kb + (size_t)(q0 + 64) * (QKV_LD * 2), QKV_LD * 2, lds, 1, wid, lane); dma_v(Vb + (size_t)(q0 + 64) * QKV_LD, QKV_LD, lds, 1, wid, lane);
    ((LAS float*)(lds + AL_KM))[tid] = kmv;
#pragma unroll
    for (int i = 0; i < 3; ++i) { const int ix = tid + i * NTHREADS; if (ix < BT_H) ((LAS float*)(lds + AL_BIAS))[ix] = btv[i]; }
    const int NT = 4 + 4 * qb;
    __syncthreads();
    unsigned sel = 0;
    { float g[8];
      float qf[32];
#pragma unroll
      for (int i = 0; i < 8; ++i) { const f32x2 a = __builtin_amdgcn_cvt_pk_f32_fp8(qr[i], false), b2 = __builtin_amdgcn_cvt_pk_f32_fp8(qr[i], true); qf[4 * i] = a[0]; qf[4 * i + 1] = a[1]; qf[4 * i + 2] = b2[0]; qf[4 * i + 3] = b2[1]; }
#pragma unroll
      for (int j = 0; j < 8; ++j) { float s = 0.f; const LAS float* km = (const LAS float*)(lds + AL_KM) + j * 64 + hi * 32;
#pragma unroll
          for (int i = 0; i < 32; ++i) s += qf[i] * km[i];
          g[j] = xhalf_sum(s); }
#pragma unroll
      for (int round = 0; round < 3; ++round) { int best = -1; float bv = 0.f;
#pragma unroll
          for (int j = 0; j < 8; ++j) { const bool ok = (j < qb) && !((sel >> j) & 1u) && (best < 0 || g[j] > bv); if (ok) { best = j; bv = g[j]; } }
          if (best >= 0) sel |= 1u << best; } }
    const LAS float* btab = (const LAS float*)(lds + AL_BIAS); const float cfar = btab[0];
    FState st; fstate_reset(st);
    struct MobaSrc {
        const unsigned char* Kb; const bf16_t* Vb; LAS unsigned char* lds; int qb, qw, wid, lane; unsigned sel;
        __device__ __forceinline__ void tile(int t, int& blk, int& kt) const { blk = t < 4 ? qb : qb - 1 - ((t - 4) >> 2); kt = t < 4 ? t : ((t - 4) & 3); }
        __device__ __forceinline__ void dma(int t, int ks, int vs) const { int blk, kt; tile(t, blk, kt); const size_t key0 = (size_t)blk * 256 + kt * 64;
            dma_k8(Kb + key0 * (QKV_LD * 2), QKV_LD * 2, lds, ks, wid, lane); dma_v(Vb + key0 * QKV_LD, QKV_LD, lds, vs, wid, lane); }
        __device__ __forceinline__ TileP params(int t) const { int blk, kt; tile(t, blk, kt); TileP tp; tp.Dmin = qw - (blk * 256 + kt * 64); tp.win = false;
            if (blk == qb) { tp.rowok = true; tp.run = (64 * kt <= wid * 32 + 31); } else { tp.rowok = (sel >> blk) & 1u; tp.run = __any(tp.rowok); }
            return tp; }
        __device__ __forceinline__ void dma_pre(int t, int ks, int vs) const { dma(t, ks, vs); }
        __device__ __forceinline__ void prefetch(int) const {}
        __device__ __forceinline__ void after(int, FState&) const {}
    } S{Kb, Vb, lds, qb, qw, wid, lane, sel};
    attn_stream<VAR, MobaSrc, true, true, i32x8>(S, NT, st, qr, lds, btab, cfar, wid, lane, r32, hi);
    const float inv = 1.0f / xhalf_sum(st.l);
    store_o_rows(lds + AL_IMP + wid * 8192, (unsigned char*)(p.ws + (VAR ? WS_X1B : WS_AOH)) + (size_t)(rowbase + qw) * 1024 + h * 64, st.o0, st.o1, inv, lane, r32, hi);
}
template <int VAR> __device__ __forceinline__ void phase_moba(const Params& p, LAS unsigned char* lds) {
    for (int pr = blockIdx.x, rnd = 0; pr < 1024; pr += gridDim.x, ++rnd) { const int x = blockIdx.x & 7, s = blockIdx.x >> 3; const int bh = (gridDim.x == 256) ? (x + 8 * (rnd * 8 + (s >> 2))) : (pr >> 2), j = (gridDim.x == 256) ? (s & 3) : (pr & 3);
        moba_unit<VAR>(p, lds, bh >> 4, bh & 15, 7 - j);
        moba_unit<VAR>(p, lds, bh >> 4, bh & 15, j); }
    __syncthreads();
}

__device__ __forceinline__ void nsa_unit(const Params& p, LAS unsigned char* lds, int b, int hkv, int c, bool load_tab, bool load_cmp) {
    const int tid = otid(), lane = tid & 63, r32 = lane & 31, hi = lane >> 5; const int wid = __builtin_amdgcn_readfirstlane(tid >> 6);
    const bf16_t* P = (const bf16_t*)(p.ws + WS_BIG);
    const size_t rowbase = (size_t)b * SEQ; const int g = wid >> 1, qq0 = (wid & 1) * 32, h = hkv * 4 + g, qw = c * 64 + qq0, qpos = qw + r32;
    bf16x8 qr[4];
    const bf16_t* rowp = P + (rowbase + qpos) * NSA_LD;
#pragma unroll
    for (int d0 = 0; d0 < 4; ++d0) qr[d0] = *(const bf16x8*)(rowp + h * 64 + hi * 8 + d0 * 16);
    const float g0 = bf2f(rowp[NSA_G + h * 3]), g1 = bf2f(rowp[NSA_G + h * 3 + 1]), g2 = bf2f(rowp[NSA_G + h * 3 + 2]);
    __syncthreads();
    if (load_tab) { for (int i = tid; i < 4 * BT_H; i += NTHREADS) ((LAS float*)(lds + AL_BIAS))[i] = ((const float*)(p.ws + WS_TAB))[hkv * 4 * BT_H + i]; }
    if (tid < 64) ((LAS unsigned*)(lds + AL_SEL))[tid] = 0u;
    const bf16_t* KS = P + rowbase * NSA_LD + NSA_KS + hkv * 64; const bf16_t* VS = P + rowbase * NSA_LD + NSA_VS + hkv * 64;
    if (load_cmp) { const bf16_t* kc = (const bf16_t*)(p.ws + WS_KCMP) + (size_t)(b * 4 + hkv) * 128 * 64; const bf16_t* vc = (const bf16_t*)(p.ws + WS_VCMP) + (size_t)(b * 4 + hkv) * 128 * 64;
      dma_k(kc, 64, lds, 0, wid, lane, AL_CMP); dma_k(kc + 64 * 64, 64, lds, 1, wid, lane, AL_CMP); dma_v(vc, 64, lds, 2, wid, lane, AL_CMP); dma_v(vc + 64 * 64, 64, lds, 3, wid, lane, AL_CMP); }
    dma_k(KS, NSA_LD, lds, 0, wid, lane); dma_v(VS, NSA_LD, lds, 0, wid, lane);
    asm volatile("s_waitcnt vmcnt(2)" ::: "memory");
    __syncthreads();
    const lds_cptr kp0 = (lds_cptr)lds + AL_CMP + r32 * 128; const int kx = (r32 & 7) | (hi << 3);
    const lds_cptr vp0 = (lds_cptr)lds + AL_CMP + 16384 + ((lane >> 4) & 1) * 32 + (lane & 3) * 8 + (4 * hi + ((lane & 15) >> 2)) * 64;
    f32x16 cb0, cb1;
    {
        f32x16 s[2][2];
        const int nlim = (qpos >= 31 ? ((qpos - 31) >> 4) + 1 : 0) - 4 * hi;
#pragma unroll
        for (int t = 0; t < 2; ++t) {
#pragma unroll
            for (int r = 0; r < 16; ++r) { s[t][0][r] = 0.f; s[t][1][r] = 0.f; }
            qk_tile(s[t][0], s[t][1], qr, kp0 + t * 8192, kx);
#pragma unroll
            for (int n2 = 0; n2 < 2; ++n2)
#pragma unroll
                for (int r = 0; r < 16; ++r) { const int nk = 64 * t + 32 * n2 + (r & 3) + 8 * (r >> 2); if (nk >= nlim) s[t][n2][r] = -INFINITY; }
        }
        const float mx = xhalf_max(__builtin_fmaxf(__builtin_fmaxf(max16(s[0][0]), max16(s[0][1])), __builtin_fmaxf(max16(s[1][0]), max16(s[1][1]))));
        const float mref = (mx == -INFINITY) ? 0.f : mx;
        float rs = 0.f;
#pragma unroll
        for (int t = 0; t < 2; ++t)
#pragma unroll
            for (int n2 = 0; n2 < 2; ++n2)
#pragma unroll
                for (int r = 0; r < 16; ++r) { const float e = __builtin_amdgcn_exp2f(s[t][n2][r] - mref); s[t][n2][r] = e; rs += e; }
        const float lt = xhalf_sum(rs); const float inv = lt > 0.f ? 1.0f / lt : 0.f;
#pragma unroll
        for (int t = 0; t < 2; ++t)
#pragma unroll
            for (int n2 = 0; n2 < 2; ++n2)
#pragma unroll
                for (int r = 0; r < 16; ++r) s[t][n2][r] *= inv;
        float Q[16], T[16];
#pragma unroll
        for (int t = 0; t < 2; ++t)
#pragma unroll
            for (int n2 = 0; n2 < 2; ++n2)
#pragma unroll
                for (int r4 = 0; r4 < 4; ++r4) { const int u = 8 * t + 4 * n2 + r4; Q[u] = (s[t][n2][4 * r4] + s[t][n2][4 * r4 + 1]) + (s[t][n2][4 * r4 + 2] + s[t][n2][4 * r4 + 3]); T[u] = s[t][n2][4 * r4 + 3]; }
        LAS float* imp = (LAS float*)(lds + AL_IMP) + (g * 64 + qq0 + r32) * 33;
        float prev = 0.f;
#pragma unroll
        for (int u = 0; u < 16; ++u) { const float rcv = __shfl_xor(T[u], 32); const float add = hi ? rcv : prev; prev = rcv; imp[2 * u + hi] = Q[u] + add; }
        f32x16 o0, o1;
#pragma unroll
        for (int r = 0; r < 16; ++r) { o0[r] = 0.f; o1[r] = 0.f; }
        pv_tile(o0, o1, s[0][0], s[0][1], vp0); pv_tile(o0, o1, s[1][0], s[1][1], vp0 + 8192);
#pragma unroll
        for (int r = 0; r < 16; ++r) { cb0[r] = g0 * o0[r]; cb1[r] = g0 * o1[r]; }
    }
    __syncthreads();
    {
        const int q = tid >> 3, jg = tid & 7; const LAS float* ib = (const LAS float*)(lds + AL_IMP) + q * 33;
        float val[32];
#pragma unroll
        for (int j = 0; j < 32; ++j) { float v = (ib[j] + ib[64 * 33 + j]) + (ib[2 * 64 * 33 + j] + ib[3 * 64 * 33 + j]);
            const bool forced = (j == 0) || (j == c) || (j == c - 1); v = forced ? INFINITY : v; val[j] = (j > c) ? -INFINITY : v; }
        unsigned bits = 0;
#pragma unroll
        for (int i = 0; i < 4; ++i) { const int j = jg * 4 + i; float vj = 0.f;
#pragma unroll
            for (int jj = 0; jj < 32; ++jj) vj = (jj == j) ? val[jj] : vj;
            int rank = 0;
#pragma unroll
            for (int jj = 0; jj < 32; ++jj) rank += (val[jj] > vj || (val[jj] == vj && jj < j)) ? 1 : 0;
            if (j <= c && rank < 16) bits |= 1u << j; }
        if (bits) atomicOr((unsigned*)(lds + AL_SEL) + q, bits);
    }
    __syncthreads();
    unsigned uni = ((const LAS unsigned*)(lds + AL_SEL))[lane];
#pragma unroll
    for (int o = 32; o > 0; o >>= 1) uni |= (unsigned)__shfl_xor((int)uni, o);
    uni = (unsigned)__builtin_amdgcn_readfirstlane((int)uni);
    const unsigned rowmask = ((const LAS unsigned*)(lds + AL_SEL))[qq0 + r32];
    const LAS float* btab = (const LAS float*)(lds + AL_BIAS) + g * BT_H; const float cfar = btab[0];
    const bf16_t* KW = P + rowbase * NSA_LD + NSA_KW + hkv * 64; const bf16_t* VW = P + rowbase * NSA_LD + NSA_VW + hkv * 64;
    const int nslc = __builtin_popcount(uni); const int wlo = c >= 8 ? 0 : 8 - c; const int NT = nslc + (9 - wlo);
    LAS int* list = (LAS int*)(lds + AL_LIST);
    if (tid < 32) { if ((uni >> tid) & 1u) list[__builtin_popcount(uni & ((1u << tid) - 1u))] = tid; }
    else if (tid < 32 + 9 - wlo) list[nslc + (tid - 32)] = 64 + (c - 8 + wlo + (tid - 32));
    __syncthreads();
    FState st; fstate_reset(st);
    struct NsaSrc {
        const bf16_t *KS, *VS, *KW, *VW; LAS unsigned char* lds; const LAS int* list; int nslc, qw, wid, lane; unsigned rowmask; float g1; f32x16* cb0; f32x16* cb1; int pre_d, pre_p;
        __device__ __forceinline__ void prefetch(int t) { pre_d = list[t + 3]; pre_p = list[t + 1]; }
        __device__ __forceinline__ void dma_pre(int, int ks, int vs) const { const int e = __builtin_amdgcn_readfirstlane(pre_d);
            if (e < 64) { dma_k(KS + (size_t)e * 64 * NSA_LD, NSA_LD, lds, ks, wid, lane); dma_v(VS + (size_t)e * 64 * NSA_LD, NSA_LD, lds, vs, wid, lane); }
            else { dma_k(KW + (size_t)(e - 64) * 64 * NSA_LD, NSA_LD, lds, ks, wid, lane); dma_v(VW + (size_t)(e - 64) * 64 * NSA_LD, NSA_LD, lds, vs, wid, lane); } }
        __device__ __forceinline__ void dma(int t, int ks, int vs) const { const int e = __builtin_amdgcn_readfirstlane(list[t]);
            if (e < 64) { dma_k(KS + (size_t)e * 64 * NSA_LD, NSA_LD, lds, ks, wid, lane); dma_v(VS + (size_t)e * 64 * NSA_LD, NSA_LD, lds, vs, wid, lane); }
            else { dma_k(KW + (size_t)(e - 64) * 64 * NSA_LD, NSA_LD, lds, ks, wid, lane); dma_v(VW + (size_t)(e - 64) * 64 * NSA_LD, NSA_LD, lds, vs, wid, lane); } }
        __device__ __forceinline__ TileP params(int) const { const int e = __builtin_amdgcn_readfirstlane(pre_p); TileP tp;
            if (e < 64) { tp.Dmin = qw - 64 * e; tp.rowok = (rowmask >> e) & 1u; tp.run = __any(tp.rowok); tp.win = false; }
            else { tp.Dmin = qw - 64 * (e - 64); tp.rowok = true; tp.run = true; tp.win = true; }
            return tp; }
        __device__ __forceinline__ void after(int t, FState& st) const {
            if (t == nslc - 1) { const float f = g1 / xhalf_sum(st.l);
#pragma unroll
                for (int r = 0; r < 16; ++r) { (*cb0)[r] += f * st.o0[r]; (*cb1)[r] += f * st.o1[r]; }
                fstate_reset(st); } }
    } S{KS, VS, KW, VW, lds, list, nslc, qw, wid, lane, rowmask, g1, &cb0, &cb1, 0, 0};
    S.dma(1, 1, 1);
    attn_stream<0, NsaSrc, true>(S, NT, st, qr, lds, btab, cfar, wid, lane, r32, hi);
    { const float f = g2 / xhalf_sum(st.l);
#pragma unroll
      for (int r = 0; r < 16; ++r) { cb0[r] += f * st.o0[r]; cb1[r] += f * st.o1[r]; } }
    store_o_rows(lds + AL_IMP + wid * 4096, (unsigned char*)(p.ws + WS_AOH) + (size_t)(rowbase + qw) * 1024 + h * 64, cb0, cb1, 1.0f, lane, r32, hi);
}
__device__ __forceinline__ void phase_nsa(const Params& p, LAS unsigned char* lds) {
    int last_hkv = -1;
    for (int pr = blockIdx.x, rnd = 0; pr < 1024; pr += gridDim.x, ++rnd) { const int x = blockIdx.x & 7, s = blockIdx.x >> 3; const int bh = (gridDim.x == 256) ? (x + 8 * (rnd * 2 + (s >> 4))) : (pr >> 4), j = (gridDim.x == 256) ? ((s + 4 * rnd) & 15) : (pr & 15);
        nsa_unit(p, lds, bh >> 2, bh & 3, 31 - j, (bh & 3) != last_hkv, true);
        nsa_unit(p, lds, bh >> 2, bh & 3, j, false, false); last_hkv = bh & 3; }
    __syncthreads();
}

template <int L> __device__ __forceinline__ void phase_ln1(const Params& p, LAS unsigned char* lds) {
    const int tid = otid(), lane = tid & 63, wid = tid >> 6, r = lane & 15, q = lane >> 4;
    const float* lg = p.ln_g + (L * 2 + 0) * 1024; const float* lb = p.ln_b + (L * 2 + 0) * 1024;
    const bf16_t* Y = (const bf16_t*)(p.ws + WS_BIG); bf16_t* X1 = (bf16_t*)(p.ws + WS_X1B);
    for (int i = tid; i < 32 * 2 * 64; i += NTHREADS) { const int l2 = i & 63, nb = (i >> 6) & 1, s = i >> 7; const int e = 16 * nb + (l2 & 15), k0 = 32 * s + 8 * (l2 >> 4);
        float w[8]; unsigned hw[4], lw[4];
#pragma unroll
        for (int j = 0; j < 8; ++j) w[j] = p.router_w[(size_t)(k0 + j) * 32 + e];
#pragma unroll
        for (int j = 0; j < 4; ++j) { hw[j] = cvt_pk_bf16(w[2 * j], w[2 * j + 1]); lw[j] = cvt_pk_bf16(w[2 * j] - lo_bf(hw[j]), w[2 * j + 1] - hi_bf(hw[j])); }
        *(LAS u32x4*)(lds + ((size_t)((s * 2 + nb) * 2 + 0) * 64 + l2) * 16) = (u32x4){hw[0], hw[1], hw[2], hw[3]};
        *(LAS u32x4*)(lds + ((size_t)((s * 2 + nb) * 2 + 1) * 64 + l2) * 16) = (u32x4){lw[0], lw[1], lw[2], lw[3]}; }
    LAS int* hist = (LAS int*)(lds + 131072 + 8 * 2048);
    if (tid < 32) hist[tid] = 0;
    __syncthreads();
    for (int tb = blockIdx.x; tb < NTOK / 128; tb += gridDim.x) {
        const int tok = tb * 128 + wid * 16 + r;
        const bf16_t* yp = Y + (size_t)tok * 1024 + 8 * q;
        float sum = 0.f, sq = 0.f;
#pragma unroll 16
        for (int s = 0; s < 32; ++s) { const u32x4 y = *(const u32x4*)(yp + 32 * s); const unsigned yw[4] = {y.x, y.y, y.z, y.w};
#pragma unroll
            for (int j = 0; j < 4; ++j) { const float a = lo_bf(yw[j]), b2 = hi_bf(yw[j]); sum += a + b2; sq += a * a + b2 * b2; } }
        sum += __shfl_xor(sum, 16); sum += __shfl_xor(sum, 32); sq += __shfl_xor(sq, 16); sq += __shfl_xor(sq, 32);
        const float mu = sum * (1.0f / 1024.0f);
        const float rstd = rsqrtf(fmaxf(sq * (1.0f / 1024.0f) - mu * mu, 0.f) + 1e-5f);
        f32x4 acc0 = (f32x4){0.f, 0.f, 0.f, 0.f}, acc1 = acc0;
        bf16_t* xp = X1 + (size_t)tok * 1024 + 8 * q; unsigned char* xq = (unsigned char*)(p.ws + WS_X1Q) + (size_t)tok * 1024 + 8 * q;
#pragma unroll 4
        for (int s = 0; s < 32; ++s) {
            const u32x4 y = *(const u32x4*)(yp + 32 * s);
            const f32x4 ga = *(const f32x4*)(lg + 32 * s + 8 * q), gb = *(const f32x4*)(lg + 32 * s + 8 * q + 4), ba = *(const f32x4*)(lb + 32 * s + 8 * q), bb = *(const f32x4*)(lb + 32 * s + 8 * q + 4);
            u32x4 w;
            const float x0 = (lo_bf(y.x) - mu) * rstd * ga[0] + ba[0], x1 = (hi_bf(y.x) - mu) * rstd * ga[1] + ba[1], x2 = (lo_bf(y.y) - mu) * rstd * ga[2] + ba[2], x3 = (hi_bf(y.y) - mu) * rstd * ga[3] + ba[3];
            const float x4 = (lo_bf(y.z) - mu) * rstd * gb[0] + bb[0], x5 = (hi_bf(y.z) - mu) * rstd * gb[1] + bb[1], x6 = (lo_bf(y.w) - mu) * rstd * gb[2] + bb[2], x7 = (hi_bf(y.w) - mu) * rstd * gb[3] + bb[3];
            w.x = cvt_pk_bf16(x0, x1); w.y = cvt_pk_bf16(x2, x3); w.z = cvt_pk_bf16(x4, x5); w.w = cvt_pk_bf16(x6, x7);
            *(u32x4*)(xp + 32 * s) = w;
            { u32x2 w8; w8.x = cvt4_fp8(x0 * F8_SX, x1 * F8_SX, x2 * F8_SX, x3 * F8_SX); w8.y = cvt4_fp8(x4 * F8_SX, x5 * F8_SX, x6 * F8_SX, x7 * F8_SX); *(u32x2*)(xq + 32 * s) = w8; }
            const bf16x8 af = __builtin_bit_cast(bf16x8, w);
            const LAS unsigned char* bq = lds + (size_t)s * 4096 + lane * 16;
            const bf16x8 b0h = *(const LAS bf16x8*)(bq), b0l = *(const LAS bf16x8*)(bq + 1024), b1h = *(const LAS bf16x8*)(bq + 2048), b1l = *(const LAS bf16x8*)(bq + 3072);
            acc0 = __builtin_amdgcn_mfma_f32_16x16x32_bf16(af, b0h, acc0, 0, 0, 0); acc0 = __builtin_amdgcn_mfma_f32_16x16x32_bf16(af, b0l, acc0, 0, 0, 0);
            acc1 = __builtin_amdgcn_mfma_f32_16x16x32_bf16(af, b1h, acc1, 0, 0, 0); acc1 = __builtin_amdgcn_mfma_f32_16x16x32_bf16(af, b1l, acc1, 0, 0, 0);
        }
        LAS float* lg2 = (LAS float*)(lds + 131072 + wid * 2048);
#pragma unroll
        for (int i = 0; i < 4; ++i) { lg2[(4 * q + i) * 32 + r] = acc0[i] + p.router_b[r]; lg2[(4 * q + i) * 32 + 16 + r] = acc1[i] + p.router_b[16 + r]; }
        asm volatile("s_waitcnt lgkmcnt(0)" ::: "memory");
        int e0 = 0, e1 = 0, r0 = 0, r1 = 0; float w0 = 0.f, w1 = 0.f;
        if (lane < 16) {
            float pr[32]; float mx = -INFINITY;
#pragma unroll
            for (int e = 0; e < 32; ++e) { pr[e] = lg2[lane * 32 + e]; mx = fmaxf(mx, pr[e]); }
#pragma unroll
            for (int e = 0; e < 32; ++e) pr[e] = __expf(pr[e] - mx);
            int best = 0; float bs = -1.f;
#pragma unroll
            for (int gi = 0; gi < 8; ++gi) { const float a = pr[4 * gi], b2 = pr[4 * gi + 1], c2 = pr[4 * gi + 2], d2 = pr[4 * gi + 3];
                const float h1 = fmaxf(a, b2), l1 = fminf(a, b2), h2 = fmaxf(c2, d2), l2 = fminf(c2, d2);
                const float m1 = fmaxf(h1, h2), m2 = fmaxf(fminf(h1, h2), fmaxf(l1, l2));
                const float sc = m1 + m2; if (sc > bs) { bs = sc; best = gi; } }
            float v[4];
#pragma unroll
            for (int gi = 0; gi < 8; ++gi) if (gi == best) { v[0] = pr[4 * gi]; v[1] = pr[4 * gi + 1]; v[2] = pr[4 * gi + 2]; v[3] = pr[4 * gi + 3]; }
            int i0 = 0; float v0 = v[0];
#pragma unroll
            for (int i = 1; i < 4; ++i) if (v[i] > v0) { v0 = v[i]; i0 = i; }
            int i1 = -1; float v1 = -1.f;
#pragma unroll
            for (int i = 0; i < 4; ++i) if (i != i0 && v[i] > v1) { v1 = v[i]; i1 = i; }
            e0 = best * 4 + i0; e1 = best * 4 + i1; const float ws = 1.0f / (v0 + v1); w0 = v0 * ws; w1 = v1 * ws;
            r0 = atomicAdd((int*)hist + e0, 1); r1 = atomicAdd((int*)hist + e1, 1);
        }
        __syncthreads();
        if (tid < 32) { const int hv = hist[tid]; hist[32 + tid] = hv ? atomicAdd((int*)(p.ws + WS_GCNT) + L * 32 + tid, hv) : 0; }
        __syncthreads();
        if (lane < 16) { const int t2 = tb * 128 + wid * 16 + lane; const int s0 = hist[32 + e0] + r0, s1 = hist[32 + e1] + r1;
            ((int*)(p.ws + WS_RE))[t2 * 2] = e0; ((int*)(p.ws + WS_RE))[t2 * 2 + 1] = e1;
            ((float*)(p.ws + WS_RWT))[t2 * 2] = w0 * (1.0f / F8_SY); ((float*)(p.ws + WS_RWT))[t2 * 2 + 1] = w1 * (1.0f / F8_SY);
            ((int*)(p.ws + WS_POS))[t2 * 2] = s0; ((int*)(p.ws + WS_POS))[t2 * 2 + 1] = s1;
            ((int*)(p.ws + WS_ROWTOK))[e0 * 65536 + s0] = t2; ((int*)(p.ws + WS_ROWTOK))[e1 * 65536 + s1] = t2; }
        __syncthreads();
        if (tid < 32) hist[tid] = 0;
        __syncthreads();
    }
}

template <int L> __device__ __forceinline__ void phase_ln2(const Params& p, LAS unsigned char* lds) {
    const int tid = otid(), lane = tid & 63, wid = tid >> 6;
    LAS int* pst = (LAS int*)lds;
    __syncthreads();
    if (tid == 0) { const int* cnt = (const int*)(p.ws + WS_GCNT) + L * 32; int s = 0; for (int e = 0; e < NEXP; ++e) { pst[e] = s; s += (cnt[e] + 255) & ~255; } }
    __syncthreads();
    const int* RE = (const int*)(p.ws + WS_RE);
    const float* lg = p.ln_g + (L * 2 + 1) * 1024; const float* lb = p.ln_b + (L * 2 + 1) * 1024;
    const bf16_t* X1 = (const bf16_t*)(p.ws + WS_X1B); const unsigned char* YB = (const unsigned char*)(p.ws + WS_BIG);
    const int* POS = (const int*)(p.ws + WS_POS); const float* RW = (const float*)(p.ws + WS_RWT);
    const int tok0 = blockIdx.x * 8 + wid, tstride = gridDim.x * 8, nk = (NTOK - tok0 + tstride - 1) / tstride;
    int rs0 = 0, rs1 = 0; float rw0 = 0.f, rw1 = 0.f;
    if (lane < nk && lane < 16) { const int t = tok0 + lane * tstride; rs0 = pst[RE[t * 2]] + POS[t * 2]; rs1 = pst[RE[t * 2 + 1]] + POS[t * 2 + 1]; rw0 = RW[t * 2]; rw1 = RW[t * 2 + 1]; }
    u32x4 ra[2][2]; u32x2 rb[2][2], rc[2][2];
#define LN2_LOAD(k, buf) do { const int t_ = tok0 + (k) * tstride; const int s0_ = __shfl(rs0, (k)), s1_ = __shfl(rs1, (k)); _Pragma("unroll") for (int hf = 0; hf < 2; ++hf) { const int c0 = hf * 512 + lane * 8; \
        ra[buf][hf] = __builtin_nontemporal_load((const u32x4*)(X1 + (size_t)t_ * 1024 + c0)); rb[buf][hf] = __builtin_nontemporal_load((const u32x2*)(YB + (size_t)s0_ * 1024 + c0)); rc[buf][hf] = __builtin_nontemporal_load((const u32x2*)(YB + (size_t)s1_ * 1024 + c0)); } } while (0)
    if (nk > 0) LN2_LOAD(0, 0);
#pragma unroll
    for (int k = 0; k < 16; ++k) {
        if (k < nk) {
            const int tok = tok0 + k * tstride; const float w0 = __shfl(rw0, k), w1 = __shfl(rw1, k);
            if (k + 1 < nk) LN2_LOAD(k + 1, (k + 1) & 1);
            float v[16];
#pragma unroll
            for (int hf = 0; hf < 2; ++hf) { const u32x4 a = ra[k & 1][hf]; const u32x2 b = rb[k & 1][hf], c = rc[k & 1][hf];
                const unsigned aw[4] = {a.x, a.y, a.z, a.w}, bw[2] = {b.x, b.y}, cw[2] = {c.x, c.y};
#pragma unroll
                for (int j = 0; j < 4; ++j) { const f32x2 yb = (j & 1) ? __builtin_amdgcn_cvt_pk_f32_fp8((int)bw[j >> 1], true) : __builtin_amdgcn_cvt_pk_f32_fp8((int)bw[j >> 1], false);
                    const f32x2 yc = (j & 1) ? __builtin_amdgcn_cvt_pk_f32_fp8((int)cw[j >> 1], true) : __builtin_amdgcn_cvt_pk_f32_fp8((int)cw[j >> 1], false);
                    v[hf * 8 + 2 * j] = ALPHA * lo_bf(aw[j]) + w0 * yb[0] + w1 * yc[0]; v[hf * 8 + 2 * j + 1] = ALPHA * hi_bf(aw[j]) + w0 * yb[1] + w1 * yc[1]; } }
            float s = 0.f;
#pragma unroll
            for (int i = 0; i < 16; ++i) s += v[i];
            const float mu = wave_sum(s) * (1.0f / 1024.0f);
            float qv = 0.f;
#pragma unroll
            for (int i = 0; i < 16; ++i) { const float d = v[i] - mu; qv += d * d; }
            const float rstd = rsqrtf(wave_sum(qv) * (1.0f / 1024.0f) + 1e-5f);
#pragma unroll
            for (int hf = 0; hf < 2; ++hf) { const int c0 = hf * 512 + lane * 8; float o[8];
                const f32x4 ga = *(const f32x4*)(lg + c0), gb = *(const f32x4*)(lg + c0 + 4), ba = *(const f32x4*)(lb + c0), bb = *(const f32x4*)(lb + c0 + 4);
#pragma unroll
                for (int j = 0; j < 4; ++j) { o[j] = (v[hf * 8 + j] - mu) * rstd * ga[j] + ba[j]; o[4 + j] = (v[hf * 8 + 4 + j] - mu) * rstd * gb[j] + bb[j]; }
                if (L == 1) { __builtin_nontemporal_store((f32x4){o[0], o[1], o[2], o[3]}, (f32x4*)(p.out + (size_t)tok * 1024 + c0)); __builtin_nontemporal_store((f32x4){o[4], o[5], o[6], o[7]}, (f32x4*)(p.out + (size_t)tok * 1024 + c0 + 4)); }
                else { u32x4 w; w.x = cvt_pk_bf16(o[0], o[1]); w.y = cvt_pk_bf16(o[2], o[3]); w.z = cvt_pk_bf16(o[4], o[5]); w.w = cvt_pk_bf16(o[6], o[7]); *(u32x4*)((bf16_t*)(p.ws + WS_XB) + (size_t)tok * 1024 + c0) = w;
                    u32x2 w8; w8.x = cvt4_i8(o[0] * I8_SX, o[1] * I8_SX, o[2] * I8_SX, o[3] * I8_SX); w8.y = cvt4_i8(o[4] * I8_SX, o[5] * I8_SX, o[6] * I8_SX, o[7] * I8_SX);
                    *(u32x2*)((unsigned char*)(p.ws + WS_X1Q) + (size_t)tok * 1024 + c0) = w8; } }
        }
    }
#undef LN2_LOAD
}

__device__ __forceinline__ void phase_cmpfin(const Params& p, LAS unsigned char* lds) {
    const int tid = otid(), lane = tid & 63, wid = tid >> 6;
    LAS float* w2s = (LAS float*)lds;
    LAS float* hs = (LAS float*)(lds + 65536) + wid * 1024;
    LAS float* b1s = (LAS float*)(lds + 65536 + 32768);
    const float* CP = (const float*)(p.ws + WS_X1B); const float* B1 = (const float*)(p.ws + WS_B1);
    for (int kv = 0; kv < 2; ++kv) {
        __syncthreads();
        { const float* w2g = kv ? p.cv_w2 : p.ck_w2; for (int i = tid; i < 256 * 64; i += NTHREADS) w2s[i] = w2g[i]; }
        if (tid < 256) { float b1 = 0.f;
#pragma unroll 8
            for (int pt = 0; pt < 32; ++pt) b1 += B1[(kv * 32 + pt) * 256 + tid];
            b1s[tid] = b1; }
        __syncthreads();
        bf16_t* dst = (bf16_t*)(p.ws + (kv ? WS_VCMP : WS_KCMP));
        for (int rg = blockIdx.x * 8 + wid; rg < 8192 / 4; rg += gridDim.x * 8) {
            const int m0 = rg * 4;
#pragma unroll
            for (int i = 0; i < 4; ++i) { const int j = lane + 64 * i; const float b1 = b1s[j];
                f32x4 hv;
#pragma unroll
                for (int rr = 0; rr < 4; ++rr) { float a = b1;
#pragma unroll
                    for (int ks = 0; ks < 2; ++ks) a += __builtin_nontemporal_load(CP + ((size_t)(kv * 2 + ks) * 8192 + m0 + rr) * 256 + j);
                    const float u = 0.7978845608028654f * (a + 0.044715f * a * a * a); const float th = 1.0f - 2.0f / (1.0f + __expf(2.0f * u));
                    hv[rr] = 0.5f * a * (1.0f + th); }
                *(LAS f32x4*)(hs + j * 4) = hv; }
            asm volatile("s_waitcnt lgkmcnt(0)" ::: "memory");
            f32x4 o = (f32x4){0.f, 0.f, 0.f, 0.f}; const LAS float* w2 = w2s + lane;
#pragma unroll 8
            for (int j = 0; j < 256; ++j) o += *(const LAS f32x4*)(hs + j * 4) * w2[j * 64];
#pragma unroll
            for (int rr = 0; rr < 4; ++rr) dst[(size_t)(m0 + rr) * 64 + lane] = f2bf((((m0 + rr) & 127) == 127) ? 0.f : o[rr]);
            asm volatile("s_waitcnt lgkmcnt(0)" ::: "memory");
        }
    }
}

constexpr int NPHASE = 19;
template <int PH> __device__ __forceinline__ void run_phase(const Params& p, LAS unsigned char* lds) {
    char* ws = p.ws;
    if constexpr (PH == 0) phase_prologue(p, lds);
    else if constexpr (PH == 1) { SchedPlainI8 S; S.init(ws + WS_X1Q, ws + WS_WQKV0, NTOK, 3072, 512); EpiQKV0 E{(bf16_t*)(ws + WS_BIG), (float*)(ws + WS_KPART)}; pg8::gemm_phase(lds, S, E); }
    else if constexpr (PH == 2) phase_moba<0>(p, lds);
    else if constexpr (PH == 3) { SchedPlainF8 S; S.init(ws + WS_AOH, ws + WS_WO0, NTOK, 1024, 512); EpiRes<false, true> E{(bf16_t*)(ws + WS_BIG), nullptr, (const bf16_t*)(ws + WS_XB)}; pg8::gemm_phase(lds, S, E); }
    else if constexpr (PH == 4) phase_ln1<0>(p, lds);
    else if constexpr (PH == 6 || PH == 16) { SchedMoeGU S; S.init(ws, PH == 16, lds); EpiGU E{(unsigned char*)(ws + WS_AOH)}; pg8::gemm_phase(lds, S, E);
        {
            const int rem = (S.nM * 4) % (int)gridDim.x, nidle = (int)gridDim.x - rem; const bool useidle = (rem > 0 && nidle * 2 >= (int)gridDim.x);
            const int cgw = useidle ? ((int)blockIdx.x - rem) * 8 + (otid() >> 6) : (int)blockIdx.x * 8 + (otid() >> 6), cng = (useidle ? nidle : (int)gridDim.x) * 8;
            __syncthreads();
            if (!useidle || (int)blockIdx.x >= rem) {
                if constexpr (PH == 6) conv_moe_stream(p, 1, 0, 0, lds, cgw, cng, 0, GU1_P6);
                else conv_moe_stream(p, 1, 1, DN1_OFF, lds, cgw, cng); } } }
    else if constexpr (PH == 7 || PH == 17) { SchedMoeDN S; S.init(ws, PH == 17, lds); EpiDN E{(unsigned char*)(ws + WS_BIG)}; pg8::gemm_phase(lds, S, E);
        if constexpr (PH == 7) {
            const int rem = (S.nM * 4) % (int)gridDim.x, nidle = (int)gridDim.x - rem; const bool useidle = (rem > 0 && nidle * 2 >= (int)gridDim.x);
            __syncthreads();
            if (!useidle) conv_moe_stream(p, 1, 0, 0, lds, (int)blockIdx.x * 8 + (otid() >> 6), (int)gridDim.x * 8, GU1_P6, GU1_EARLY);
            else if ((int)blockIdx.x >= rem) conv_moe_stream(p, 1, 0, 0, lds, ((int)blockIdx.x - rem) * 8 + (otid() >> 6), nidle * 8, GU1_P6, GU1_EARLY); } }
    else if constexpr (PH == 8) { phase_ln2<0>(p, lds); __syncthreads(); conv_moe_stream(p, 1, 0, 0, lds, (int)blockIdx.x * 8 + (otid() >> 6), (int)gridDim.x * 8, GU1_EARLY); }
    else if constexpr (PH == 9) {
        { SchedNsaProjI8 S; S.init(ws + WS_X1Q, ws + WS_WIN1, NTOK, 2816, 512); S.bcnt = (unsigned*)(ws + WS_BCNT); EpiNSA E{(bf16_t*)(ws + WS_BIG)}; pg8::gemm_phase(lds, S, E); }
        { SchedCmp S; S.init(ws); EpiCmp E{(float*)(ws + WS_X1B)}; pg8::gemm_phase(lds, S, E); } }
    else if constexpr (PH == 11) phase_cmpfin(p, lds);
    else if constexpr (PH == 12) phase_nsa(p, lds);
    else if constexpr (PH == 13) { SchedPlainF8 S; S.init(ws + WS_AOH, ws + WS_WO1, NTOK, 1024, 512); EpiRes<false, true> E{(bf16_t*)(ws + WS_BIG), nullptr, (const bf16_t*)(ws + WS_XB)}; pg8::gemm_phase(lds, S, E); }
    else if constexpr (PH == 14) phase_ln1<1>(p, lds);
    else if constexpr (PH == 18) phase_ln2<1>(p, lds);
}

extern __shared__ __attribute__((aligned(16))) unsigned char g_smem[];

template <int PH> __global__ void __launch_bounds__(NTHREADS, 2) k_phase(Params p) {
    run_phase<PH>(p, (LAS unsigned char*)g_smem);
}

#if !MK_LAUNCHES
template <int PH> __device__ __forceinline__ void mega_seq(const Params& p, LAS unsigned char* lds, const XcdBarrier& bar) {
    if constexpr (PH == 5 || PH == 15 || PH == 10) { mega_seq<PH + 1>(p, lds, bar); return; }
    run_phase<PH>(p, lds);
#ifdef PROBE_VAR
    if constexpr (PH == 2) { xcd_barrier(bar); phase_moba<PROBE_VAR>(p, lds); }
#endif
#ifdef PROBE_BAR
    if constexpr (PH == 3) { for (int i = 0; i < 16; ++i) xcd_barrier(bar); }
#endif
#ifdef PROBE_GEMM_NULL
    if constexpr (PH == 1) { xcd_barrier(bar); SchedPlain S; S.init(p.ws + WS_XB, p.ws + WS_WQKV0, NTOK, 3072, 1024); EpiNull E{(float*)(p.ws + WS_X1B)}; pg8::gemm_phase(lds, S, E); }
#endif
#ifdef PROBE_MASK
    if constexpr ((PROBE_MASK >> PH) & 1) { xcd_barrier(bar); run_phase<PH>(p, lds); }
#endif
    if constexpr (PH + 1 < NPHASE) { xcd_barrier(bar); mega_seq<PH + 1>(p, lds, bar); }
}
__global__ void __launch_bounds__(NTHREADS, 2) k_mega(Params p) {
    LAS unsigned char* lds = (LAS unsigned char*)g_smem;
    LAS unsigned* stw = (LAS unsigned*)(lds + LDS_BYTES - 16);
    if (threadIdx.x == 0) { stw[0] = 0u; stw[1] = 0u; stw[2] = 0u; stw[3] = 0u; }
    __syncthreads();
    XcdBarrier bar = xcd_barrier_post((unsigned*)(p.ws + WS_CTL), (volatile LAS unsigned*)stw);
    mega_seq<0>(p, lds, bar);
}

#endif
template <int PH> static void launch_phases(const Params& p, int grid, hipStream_t stream) {
    hipFuncSetAttribute((const void*)k_phase<PH>, hipFuncAttributeMaxDynamicSharedMemorySize, LDS_BYTES);
    hipLaunchKernelGGL(k_phase<PH>, dim3(grid), dim3(NTHREADS), LDS_BYTES, stream, p);
    if constexpr (PH + 1 < NPHASE) launch_phases<PH + 1>(p, grid, stream);
}

extern "C" void kernel_launch(void* const* d_in, const int* in_sizes, int n_in, void* d_out, int out_size, void* d_ws, size_t ws_size, hipStream_t stream) {
    if (n_in != 19 || ws_size < WS_END) { fprintf(stderr, "kernel_launch: need 19 inputs and %zu bytes of workspace (got %d, %zu)\n", (size_t)WS_END, n_in, ws_size); return; }
    Params p{};
    p.x = (const float*)d_in[0]; p.rel_bias = (const float*)d_in[1]; p.router_w = (const float*)d_in[2]; p.router_b = (const float*)d_in[3];
    p.ln_g = (const float*)d_in[4]; p.ln_b = (const float*)d_in[5]; p.moba_w_in = (const float*)d_in[6]; p.moba_w_out = (const float*)d_in[7];
    p.nsa_w_in = (const float*)d_in[8]; p.nsa_w_out = (const float*)d_in[9]; p.pos_k = (const float*)d_in[10]; p.pos_v = (const float*)d_in[11];
    p.ck_w1 = (const float*)d_in[12]; p.ck_w2 = (const float*)d_in[13]; p.cv_w1 = (const float*)d_in[14]; p.cv_w2 = (const float*)d_in[15];
    p.w_gate = (const float*)d_in[16]; p.w_up = (const float*)d_in[17]; p.w_down = (const float*)d_in[18];
    p.out = (float*)d_out; p.ws = (char*)d_ws;
    const int grid = NWG_EXPECT;
#if MK_LAUNCHES
    launch_phases<0>(p, grid, stream);
#else
    hipFuncSetAttribute((const void*)k_mega, hipFuncAttributeMaxDynamicSharedMemorySize, LDS_BYTES);
    hipMemsetAsync((char*)d_ws + WS_CTL, 0, 16384, stream);
    hipLaunchKernelGGL(k_mega, dim3(grid), dim3(NTHREADS), LDS_BYTES, stream, p);
#endif
}
```

```cpp
#include <hip/hip_runtime.h>
#include <cstdio>
#include <cstdint>

#ifndef MK_LAUNCHES
#define MK_LAUNCHES 0
#endif

#define LAS __attribute__((address_space(3)))
typedef unsigned short bf16_t;
typedef short bf16x8 __attribute__((ext_vector_type(8)));
typedef short s16x4 __attribute__((ext_vector_type(4)));
typedef short v4i16_t __attribute__((ext_vector_type(4)));
typedef float f32x4 __attribute__((ext_vector_type(4)));
typedef float f32x16 __attribute__((ext_vector_type(16)));
typedef unsigned u32x4 __attribute__((ext_vector_type(4)));
typedef unsigned u32x2 __attribute__((ext_vector_type(2)));
typedef float f32x2 __attribute__((ext_vector_type(2)));
typedef int i32x4 __attribute__((ext_vector_type(4)));
typedef int i32x8 __attribute__((ext_vector_type(8)));
typedef LAS const char* lds_cptr;

constexpr int NTOK = 32768, DM = 1024, SEQ = 2048, NBATCH = 16, NHEAD = 16;
constexpr int QKV_LD = 3072, NSA_LD = 2816;
constexpr int NSA_KC = 1024, NSA_VC = 1280, NSA_KS = 1536, NSA_VS = 1792, NSA_KW = 2048, NSA_VW = 2304, NSA_G = 2560;
constexpr int NEXP = 32, DEXP = 512, MAXPAN = 288, RPAD = MAXPAN * 256;
constexpr int NTHREADS = 512, NWG_EXPECT = 256;
constexpr int LDS_BYTES = 155648;
constexpr float LOG2E = 1.4426950408889634f;
constexpr float C2 = 0.125f * LOG2E;
constexpr float ALPHA = 1.4142135623730951f;
constexpr int BT_N = 288;
constexpr int BT_S = 292, BT_H = 4 * BT_S;

constexpr size_t al256(size_t x) { return (x + 255) & ~(size_t)255; }
constexpr size_t WS_CTL = 0;
constexpr size_t WS_BCNT = 14592;
constexpr size_t WS_GCNT = 14336;
constexpr size_t WS_TAB = 16384;
constexpr size_t WS_B1 = WS_TAB + al256(16 * BT_H * 4);
constexpr size_t WS_NPAN = WS_B1 + 65536;
constexpr size_t WS_PANEL = WS_NPAN + 256;
constexpr size_t WS_HIST = WS_PANEL + 1280;
constexpr size_t WS_KPART = WS_HIST + 32768;
constexpr size_t WS_RE = WS_KPART + 128 * 2 * 1024 * 4;
constexpr size_t WS_RWT = WS_RE + (size_t)NTOK * 8;
constexpr size_t WS_POS = WS_RWT + (size_t)NTOK * 8;
constexpr size_t WS_ROWTOK = WS_POS + (size_t)NTOK * 8;
constexpr size_t WS_KCMP = WS_ROWTOK + (size_t)32 * 65536 * 4;
constexpr size_t WS_VCMP = WS_KCMP + 16 * 4 * 128 * 64 * 2;
constexpr size_t WS_WQKV0 = WS_VCMP + 16 * 4 * 128 * 64 * 2;
constexpr size_t WS_WO0 = WS_WQKV0 + (size_t)3072 * 1024 * 2;
constexpr size_t WS_WIN1 = WS_WO0 + (size_t)1024 * 1024 * 2;
constexpr size_t WS_WO1 = WS_WIN1 + (size_t)2816 * 1024 * 2;
constexpr size_t WS_W1T = WS_WO1 + (size_t)1024 * 1024 * 2;
constexpr size_t WS_GU = WS_W1T + (size_t)2 * 256 * 2048 * 2;
constexpr size_t WS_X1Q = WS_GU + (size_t)32 * 1024 * 1024;
constexpr size_t WS_DN = WS_GU + (size_t)32 * 1024 * 1024 * 2;
constexpr int GU1_P6 = 2816, GU1_EARLY = GU1_P6 + 1536;
constexpr size_t DN1_OFF = (size_t)16 * 1024 * 1024;
constexpr size_t WS_XB = WS_DN + (size_t)32 * 1024 * 512 * 2;
constexpr size_t WS_BIG = WS_XB + (size_t)NTOK * 1024 * 2;
constexpr size_t WS_AOH = WS_BIG + (size_t)NTOK * 3072 * 2;
constexpr size_t WS_GU1 = WS_AOH + (size_t)40 * 1024 * 1024;
constexpr size_t WS_X1B = WS_AOH + (size_t)RPAD * 512 * 2;
constexpr size_t WS_END = WS_X1B + (size_t)NTOK * 1024 * 2;

struct Params {
    const float *x, *rel_bias, *router_w, *router_b, *ln_g, *ln_b, *moba_w_in, *moba_w_out, *nsa_w_in, *nsa_w_out, *pos_k, *pos_v,
                *ck_w1, *ck_w2, *cv_w1, *cv_w2, *w_gate, *w_up, *w_down;
    float* out;
    char* ws;
};

__device__ __forceinline__ int otid() { int t = threadIdx.x; asm volatile("" : "+v"(t)); return t; }
__device__ __forceinline__ float bf2f(bf16_t v) { return __uint_as_float(((unsigned)v) << 16); }
__device__ __forceinline__ unsigned cvt_pk_bf16(float lo, float hi) { unsigned r; asm volatile("v_cvt_pk_bf16_f32 %0, %1, %2" : "=v"(r) : "v"(lo), "v"(hi)); return r; }
constexpr float F8_SW = 256.0f, F8_SX = 8.0f, F8_INV = 1.0f / (F8_SW * F8_SX);
constexpr float I8_SX = 127.0f / 6.0f, I8_SW = 127.0f / 0.18f, I8_INV = 1.0f / (I8_SX * I8_SW);
__device__ __forceinline__ unsigned cvt4_i8(float a, float b, float c, float d) {
    a = __builtin_amdgcn_fmed3f(a, -127.f, 127.f) + 12582912.0f; b = __builtin_amdgcn_fmed3f(b, -127.f, 127.f) + 12582912.0f; c = __builtin_amdgcn_fmed3f(c, -127.f, 127.f) + 12582912.0f; d = __builtin_amdgcn_fmed3f(d, -127.f, 127.f) + 12582912.0f;
    return (__float_as_uint(a) & 0xffu) | ((__float_as_uint(b) & 0xffu) << 8) | ((__float_as_uint(c) & 0xffu) << 16) | (__float_as_uint(d) << 24); }
constexpr float QK8_SQ = 16.0f, QK8_SK = 8.0f, QK8_INV = 1.0f / (QK8_SQ * QK8_SK);
constexpr float F8_SY = 32.0f;
constexpr float F8_SO = 16.0f, F8_INVO = 1.0f / (F8_SW * F8_SO);
__device__ __forceinline__ unsigned cvt4_fp8(float a, float b, float c, float d) {
    a = __builtin_amdgcn_fmed3f(a, -448.f, 448.f); b = __builtin_amdgcn_fmed3f(b, -448.f, 448.f); c = __builtin_amdgcn_fmed3f(c, -448.f, 448.f); d = __builtin_amdgcn_fmed3f(d, -448.f, 448.f);
    int w = 0; w = __builtin_amdgcn_cvt_pk_fp8_f32(a, b, w, false); w = __builtin_amdgcn_cvt_pk_fp8_f32(c, d, w, true); return (unsigned)w; }
__device__ __forceinline__ bf16_t f2bf(float f) { return (bf16_t)(cvt_pk_bf16(f, 0.f) & 0xffffu); }
__device__ __forceinline__ float lo_bf(unsigned w) { return __uint_as_float(w << 16); }
__device__ __forceinline__ float hi_bf(unsigned w) { return __uint_as_float(w & 0xffff0000u); }
__device__ __forceinline__ float wave_sum(float v) {
#pragma unroll
    for (int o = 32; o > 0; o >>= 1) v += __shfl_xor(v, o);
    return v; }

#define XB_TMO      128
#define XB_XCNT(j)  (256  + 64 * (j))
#define XB_XSUB(j)  (1280 + 64 * (j))
#define XB_XGEN(j)  (2304 + 64 * (j))
#define XB_TOP      3328
#define XB_TOPGEN   3392
#define XCD_BAR_WORDS 3456
#define XB_SPIN_CAP (1u << 18)
__device__ __forceinline__ unsigned xb_ld(unsigned* p)              { return __hip_atomic_load(p, __ATOMIC_RELAXED, __HIP_MEMORY_SCOPE_AGENT); }
__device__ __forceinline__ unsigned xb_add(unsigned* p, unsigned v) { return __hip_atomic_fetch_add(p, v, __ATOMIC_RELAXED, __HIP_MEMORY_SCOPE_AGENT); }
__device__ __forceinline__ unsigned xb_xcc_id() { return (unsigned)__builtin_amdgcn_s_getreg((3 << 11) | 20) & 0xFu; }
#define XB_SPIN(cond, bar) do { unsigned _sp = 0; while (cond) { __builtin_amdgcn_s_sleep(1); \
    if ((++_sp & 255u) == 0u) { if (xb_ld(&(bar)[XB_TMO])) break; if (_sp > XB_SPIN_CAP) { atomicAdd(&(bar)[XB_TMO], 1u); break; } } } } while (0)
struct XcdBarrier { unsigned* bar; unsigned x; volatile LAS unsigned* st; };
__device__ __forceinline__ XcdBarrier xcd_barrier_post(unsigned* bar, volatile LAS unsigned* st) {
    XcdBarrier b; b.bar = bar; b.x = xb_xcc_id(); b.st = st;
    if (threadIdx.x == 0) (void)xb_add(&bar[XB_XCNT(b.x)], 1u);
    return b;
}
__device__ __forceinline__ void xcd_barrier_complete(unsigned* bar, unsigned x, unsigned& nloc, unsigned& nx) {
    const unsigned G = gridDim.x * gridDim.y * gridDim.z;
    unsigned sum, cnt, mine, sp = 0u;
    for (;;) {
        sum = 0u; cnt = 0u; mine = 0u;
#pragma unroll
        for (unsigned j = 0; j < 16; ++j) { const unsigned c = xb_ld(&bar[XB_XCNT(j)]); sum += c; cnt += (c > 0u) ? 1u : 0u; mine = (j == x) ? c : mine; }
        if (sum == G) break;
        __builtin_amdgcn_s_sleep(1);
        if ((++sp & 255u) == 0u) { if (xb_ld(&bar[XB_TMO])) break; if (sp > XB_SPIN_CAP) { atomicAdd(&bar[XB_TMO], 1u); break; } }
    }
    nloc = mine > 0u ? mine : 1u; nx = cnt > 0u ? cnt : 1u;
}
__device__ __forceinline__ void xcd_barrier(const XcdBarrier& b) {
    asm volatile("s_waitcnt vmcnt(0)" ::: "memory");
    __syncthreads();
    if (threadIdx.x == 0) {
        unsigned* bar = b.bar;
        __builtin_amdgcn_s_waitcnt(0);
        unsigned nloc = b.st[0], nx = b.st[1];
        if (nloc == 0u) { xcd_barrier_complete(bar, b.x, nloc, nx); b.st[0] = nloc; b.st[1] = nx; }
        const unsigned old = xb_add(&bar[XB_XSUB(b.x)], 1u);
        const unsigned gen = old / nloc;
        bool released = false;
        if (old + 1u == (gen + 1u) * nloc) {
            __builtin_amdgcn_fence(__ATOMIC_RELEASE, "agent");
            asm volatile("s_waitcnt vmcnt(0)" ::: "memory");
            const unsigned og = xb_add(&bar[XB_TOP], 1u);
            const unsigned tg = og / nx;
            if (og + 1u == (tg + 1u) * nx) {
#pragma unroll
                for (unsigned j = 0; j < 16; ++j) xb_add(&bar[XB_XGEN(j)], 1u);
                released = true;
            }
        }
        __builtin_amdgcn_fence(__ATOMIC_ACQUIRE, "agent");
        if (!released) XB_SPIN(xb_ld(&bar[XB_XGEN(b.x)]) == gen, bar);
        asm volatile("s_waitcnt vmcnt(0)" ::: "memory");
    }
    __syncthreads();
}

namespace pg8 {
constexpr int BM = 256, BK = 64, HALF = 128, HTB = HALF * BK * 2, STAGE_BYTES = 8 * HTB, NXCD = 8, WGM = 8;
__device__ __forceinline__ int lds_byte(int r, int c) { const int st = (r >> 4) * 2 + (c >> 5), rr = r & 15, cc = c & 31, ob = rr * 64 + cc * 2; return st * 1024 + (ob ^ (((ob >> 9) & 1) << 5)); }
__device__ __forceinline__ void stage_rc(int b, int& R, int& C) { const int st = b / 1024, sb = b % 1024, swz = sb ^ (((sb >> 9) & 1) << 5); R = (st >> 1) * 16 + swz / 64; C = (st & 1) * 32 + (swz % 64) / 2; }
__device__ __forceinline__ int perm32(int rho) { const int n = rho >> 4, i = rho & 15; return 8 * (i >> 2) + 4 * n + (i & 3); }
struct Unit { int pm, pn, aux, aux2; };
__device__ __forceinline__ i32x8 cat8(bf16x8 a, bf16x8 b) { const i32x4 x = __builtin_bit_cast(i32x4, a), y = __builtin_bit_cast(i32x4, b); return __builtin_shufflevector(x, y, 0, 1, 2, 3, 4, 5, 6, 7); }

__device__ __forceinline__ void static_unit(int L, int nM, int nN, Unit& u) {
    const int nwg = nM * nN;
    int wgid = L; { const int q = nwg / NXCD, r = nwg % NXCD, xcd = wgid % NXCD, off = wgid / NXCD; wgid = (xcd < r ? xcd * (q + 1) : r * (q + 1) + (xcd - r) * q) + off; }
    const int nig = WGM * nN, gid = wgid / nig, fm = gid * WGM, gsz = (nM - fm) < WGM ? (nM - fm) : WGM;
    u.pm = fm + ((wgid % nig) % gsz); u.pn = (wgid % nig) / gsz; u.aux = 0; u.aux2 = 0;
}

__device__ __forceinline__ void stage2(const char* sbase, unsigned v0, unsigned v1, unsigned lds0) {
    unsigned sv;
    asm volatile("s_mov_b32 %0, m0\n\ts_mov_b32 m0, %4\n\ts_nop 0\n\tglobal_load_lds_dwordx4 %1, %3\n\ts_mov_b32 m0, %5\n\ts_nop 0\n\tglobal_load_lds_dwordx4 %2, %3\n\ts_mov_b32 m0, %0"
                 : "=&s"(sv) : "v"(v0), "v"(v1), "s"(sbase), "s"(lds0), "s"(lds0 + 8192u) : "memory");
}
template <class Epi, class Sched>
__device__ __forceinline__ void gemm_phase(LAS unsigned char* lds, const Sched& S, const Epi& E) {
    const int tid = otid(), wid = __builtin_amdgcn_readfirstlane(tid >> 6), lane = tid & 63, wr = wid >> 2, wc = wid & 3, fr = lane & 15, fq = lane >> 4;
    int nt_ = S.nt; asm volatile("" : "+s"(nt_));
    const int nt = nt_;
    int sR[2], sC[2];
    unsigned vB[2][2];
#pragma unroll
    for (int i = 0; i < 2; ++i) { stage_rc(tid * 16 + i * 8192, sR[i], sC[i]); const int Rb = Epi::PERM ? ((sR[i] & ~31) + perm32(sR[i] & 31)) : sR[i];
#pragma unroll
        for (int h = 0; h < 2; ++h) vB[h][i] = (unsigned)(h * HALF + Rb) * S.ldb + (unsigned)sC[i] * 2u; }
    const size_t kstepA = S.kstepA, kstepB = S.kstepB;
    const unsigned ldsb = (unsigned)__builtin_amdgcn_readfirstlane((int)((unsigned)(unsigned long)lds + (unsigned)wid * 1024u));
    const int aoff = lds_byte(wr * 64 + fr, fq * 8), boff = lds_byte(wc * 32 + fr, fq * 8);
#define PG8_SA(b, h) (((b) * 2 + (h)) * HTB)
#define PG8_SB(b, h) ((4 + (b) * 2 + (h)) * HTB)
#define PG8_STAGE(bufoff, gbase, v0, v1) stage2((const char*)(gbase), (v0), (v1), ldsb + (unsigned)(bufoff))
#define PG8_LDA(dst, b, h) do { if constexpr (Sched::F8) { _Pragma("unroll") for (int m = 0; m < 4; ++m) { dst##8[m].lo = *(const LAS i32x4*)(lds + PG8_SA(b, h) + aoff + m * 2048); dst##8[m].hi = *(const LAS i32x4*)(lds + PG8_SA(b, h) + aoff + m * 2048 + 1024); } } \
        else { _Pragma("unroll") for (int m = 0; m < 4; ++m) _Pragma("unroll") for (int k = 0; k < 2; ++k) dst[m][k] = *(const LAS bf16x8*)(lds + PG8_SA(b, h) + aoff + m * 2048 + k * 1024); } } while (0)
#define PG8_LDB(dst, b, h) do { if constexpr (Sched::F8) { _Pragma("unroll") for (int n = 0; n < 2; ++n) { dst##8[n].lo = *(const LAS i32x4*)(lds + PG8_SB(b, h) + boff + n * 2048); dst##8[n].hi = *(const LAS i32x4*)(lds + PG8_SB(b, h) + boff + n * 2048 + 1024); } } \
        else { _Pragma("unroll") for (int n = 0; n < 2; ++n) _Pragma("unroll") for (int k = 0; k < 2; ++k) dst[n][k] = *(const LAS bf16x8*)(lds + PG8_SB(b, h) + boff + n * 2048 + k * 1024); } } while (0)
#define PG8_MMA(ai, bj, At, Bt) do { __builtin_amdgcn_s_setprio(1); \
        if constexpr (Sched::F8) { _Pragma("unroll") for (int m = 0; m < 4; ++m) _Pragma("unroll") for (int n = 0; n < 2; ++n) \
            acc[ai][bj][m][n] = __builtin_amdgcn_mfma_scale_f32_16x16x128_f8f6f4(Bt##8[n], At##8[m], acc[ai][bj][m][n], 0, 0, 0, 0, 0, 0); } \
        else if constexpr (Sched::I8) { _Pragma("unroll") for (int m = 0; m < 4; ++m) _Pragma("unroll") for (int n = 0; n < 2; ++n) _Pragma("unroll") for (int k = 0; k < 2; ++k) \
            acc[ai][bj][m][n] = __builtin_bit_cast(f32x4, __builtin_amdgcn_mfma_i32_16x16x64_i8(__builtin_bit_cast(i32x4, Bt[n][k]), __builtin_bit_cast(i32x4, At[m][k]), __builtin_bit_cast(i32x4, acc[ai][bj][m][n]), 0, 0, 0)); } \
        else { _Pragma("unroll") for (int m = 0; m < 4; ++m) _Pragma("unroll") for (int n = 0; n < 2; ++n) _Pragma("unroll") for (int k = 0; k < 2; ++k) \
            acc[ai][bj][m][n] = __builtin_amdgcn_mfma_f32_16x16x32_bf16(Bt[n][k], At[m][k], acc[ai][bj][m][n], 0, 0, 0); } \
        __builtin_amdgcn_s_setprio(0); } while (0)
#define PG8_WAIT_V(n) asm volatile("s_waitcnt vmcnt(" #n ")" ::: "memory")
#define PG8_WAIT_L(n) asm volatile("s_waitcnt lgkmcnt(" #n ")" ::: "memory")
#define PG8_BAR __builtin_amdgcn_s_barrier()
#define PG8_SCHED __builtin_amdgcn_sched_barrier(0)
    Unit cur, nxt; int ui = 0; int prev_code = -1;
    if (!S.next(0, cur)) return;
    f32x4 acc[2][2][4][2];
#pragma unroll
    for (int a = 0; a < 2; ++a)
#pragma unroll
        for (int b = 0; b < 2; ++b)
#pragma unroll
            for (int m = 0; m < 4; ++m)
#pragma unroll
                for (int n = 0; n < 2; ++n) acc[a][b][m][n] = (f32x4){0.f, 0.f, 0.f, 0.f};
    bf16x8 At[4][2], B0[2][2], B1[2][2]; i32x8 At8[4], B08[2], B18[2];
    unsigned vA[2][2], vN[2][2];
#pragma unroll
    for (int h = 0; h < 2; ++h)
#pragma unroll
        for (int i = 0; i < 2; ++i) { vA[h][i] = S.aoff(cur, h * HALF + sR[i], sC[i]); vN[h][i] = vA[h][i]; }
    const char* cA = S.abase(cur); const char* cB = S.bbase(cur);
    S.a_ready(cur);
    PG8_STAGE(PG8_SB(0, 0), cB, vB[0][0], vB[0][1]); PG8_STAGE(PG8_SA(0, 0), cA, vA[0][0], vA[0][1]); PG8_STAGE(PG8_SB(0, 1), cB, vB[1][0], vB[1][1]); PG8_STAGE(PG8_SA(0, 1), cA, vA[1][0], vA[1][1]);
    if (wr == 1) PG8_BAR;
    PG8_WAIT_V(4); PG8_BAR;
    PG8_STAGE(PG8_SB(1, 0), cB + kstepB, vB[0][0], vB[0][1]); PG8_STAGE(PG8_SA(1, 0), cA + kstepA, vA[0][0], vA[0][1]); PG8_STAGE(PG8_SB(1, 1), cB + kstepB, vB[1][0], vB[1][1]);
    PG8_WAIT_V(6); PG8_BAR;
    for (;;) {
        const bool has_next = S.next(ui + 1, nxt);
        const char* nA = has_next ? S.abase(nxt) : cA; const char* nB = has_next ? S.bbase(nxt) : cB;
        if (Sched::DYN_A && has_next) {
#pragma unroll
            for (int h = 0; h < 2; ++h)
#pragma unroll
                for (int i = 0; i < 2; ++i) vN[h][i] = S.aoff(nxt, h * HALF + sR[i], sC[i]);
        }
        asm volatile(".p2align 8" ::: );
#pragma unroll 1
        for (int t = 0; t < nt; t += 2) {
            const bool last = (t == nt - 2);
            const char* a1 = cA + (size_t)(t + 1) * kstepA;
            const char* a2 = last ? nA : cA + (size_t)(t + 2) * kstepA; const char* b2 = last ? nB : cB + (size_t)(t + 2) * kstepB;
            const char* a3 = a2 + kstepA; const char* b3 = b2 + kstepB;
            if (last && has_next) S.a_ready(nxt);
            PG8_LDB(B0, 0, 0); PG8_SCHED; PG8_LDA(At, 0, 0); PG8_STAGE(PG8_SA(1, 1), a1, vA[1][0], vA[1][1]);
            if (Sched::DYN_A && last) {
#pragma unroll
                for (int h = 0; h < 2; ++h)
#pragma unroll
                    for (int i = 0; i < 2; ++i) vA[h][i] = vN[h][i]; }
            PG8_WAIT_L(8); PG8_BAR; PG8_WAIT_L(0); PG8_MMA(0, 0, At, B0); PG8_BAR; PG8_SCHED;
            PG8_LDB(B1, 0, 1); PG8_STAGE(PG8_SB(0, 0), b2, vB[0][0], vB[0][1]);
            PG8_BAR; PG8_WAIT_L(0); PG8_MMA(0, 1, At, B1); PG8_BAR;
            PG8_LDA(At, 0, 1); PG8_STAGE(PG8_SA(0, 0), a2, vA[0][0], vA[0][1]);
            PG8_BAR; PG8_WAIT_L(0); PG8_MMA(1, 0, At, B0); PG8_BAR; PG8_SCHED;
            PG8_STAGE(PG8_SB(0, 1), b2, vB[1][0], vB[1][1]);
            PG8_WAIT_V(6); PG8_BAR; PG8_MMA(1, 1, At, B1); PG8_BAR;
            PG8_LDB(B0, 1, 0); PG8_SCHED; PG8_LDA(At, 1, 0); PG8_STAGE(PG8_SA(0, 1), a2, vA[1][0], vA[1][1]);
            PG8_WAIT_L(8); PG8_BAR; PG8_WAIT_L(0); PG8_MMA(0, 0, At, B0); PG8_BAR; PG8_SCHED;
            PG8_LDB(B1, 1, 1); PG8_STAGE(PG8_SB(1, 0), b3, vB[0][0], vB[0][1]);
            PG8_BAR; PG8_WAIT_L(0); PG8_MMA(0, 1, At, B1); PG8_BAR;
            PG8_LDA(At, 1, 1); PG8_STAGE(PG8_SA(1, 0), a3, vA[0][0], vA[0][1]);
            PG8_BAR; PG8_WAIT_L(0); PG8_MMA(1, 0, At, B0); PG8_BAR; PG8_SCHED;
            PG8_STAGE(PG8_SB(1, 1), b3, vB[1][0], vB[1][1]);
            PG8_WAIT_V(6); PG8_BAR; PG8_MMA(1, 1, At, B1); PG8_BAR;
            if (Sched::PUBLISH && prev_code >= 0) { S.done(prev_code); prev_code = -1; }
        }
        if constexpr (Sched::I8) {
#pragma unroll
            for (int a = 0; a < 2; ++a)
#pragma unroll
                for (int b = 0; b < 2; ++b)
#pragma unroll
                    for (int m = 0; m < 4; ++m)
#pragma unroll
                        for (int n = 0; n < 2; ++n) { const i32x4 iv = __builtin_bit_cast(i32x4, acc[a][b][m][n]); acc[a][b][m][n] = (f32x4){(float)iv[0], (float)iv[1], (float)iv[2], (float)iv[3]} * I8_INV; } }
        E(acc, cur, wr, wc, fr, fq); prev_code = Sched::PUBLISH ? (cur.pm | (cur.pn << 16)) : -1;
        if (!has_next) break;
#pragma unroll
        for (int a = 0; a < 2; ++a)
#pragma unroll
            for (int b = 0; b < 2; ++b)
#pragma unroll
                for (int m = 0; m < 4; ++m)
#pragma unroll
                    for (int n = 0; n < 2; ++n) acc[a][b][m][n] = (f32x4){0.f, 0.f, 0.f, 0.f};
        cur = nxt; cA = nA; cB = nB; ++ui;
    }
    PG8_WAIT_V(0);
    if (Sched::PUBLISH && prev_code >= 0) S.done(prev_code);
    if (wr == 0) PG8_BAR;
    PG8_BAR;
#undef PG8_SA
#undef PG8_SB
#undef PG8_STAGE
#undef PG8_LDA
#undef PG8_LDB
#undef PG8_MMA
#undef PG8_WAIT_V
#undef PG8_WAIT_L
#undef PG8_BAR
#undef PG8_SCHED
}
}
using pg8::Unit;

struct SchedPlain {
    static constexpr bool DYN_A = false;
    static constexpr bool F8 = false;
    static constexpr bool I8 = false;
    const char* A; const char* Bt; int K, nM, nN, G, c; int nt; unsigned kstepA, kstepB, ldb;
    __device__ __forceinline__ void init(const void* A_, const void* Bt_, int M, int N, int K_) { A = (const char*)A_; Bt = (const char*)Bt_; K = K_; nM = M / 256; nN = N / 256; G = gridDim.x; c = blockIdx.x; nt = K / 64; kstepA = 128; kstepB = 128; ldb = (unsigned)K * 2u; }
    __device__ __forceinline__ bool next(int i, Unit& u) const { const int L = i * G + c; if (L >= nM * nN) return false; pg8::static_unit(L, nM, nN, u); return true; }
    __device__ __forceinline__ const char* abase(const Unit& u) const { return A + (size_t)u.pm * 256 * K * 2; }
    __device__ __forceinline__ const char* bbase(const Unit& u) const { return Bt + (size_t)u.pn * 256 * K * 2; }
    __device__ __forceinline__ unsigned aoff(const Unit&, int row, int col) const { return (unsigned)(row * K + col) * 2u; }
    static constexpr bool PUBLISH = false;
    __device__ __forceinline__ void a_ready(const Unit&) const {}
    __device__ __forceinline__ void done(int) const {}
};
constexpr int ML_CNT = 131072, ML_PPRE = ML_CNT + 128, ML_PE = ML_PPRE + 256;
__device__ __forceinline__ int moe_tables(const char* ws, int layer, LAS unsigned char* lds) {
    const int tid = otid(); LAS int* cnt = (LAS int*)(lds + ML_CNT); LAS int* ppre = (LAS int*)(lds + ML_PPRE); LAS int* pe = (LAS int*)(lds + ML_PE);
    __syncthreads();
    if (tid < 32) cnt[tid] = ((const int*)(ws + WS_GCNT))[layer * 32 + tid];
    __syncthreads();
    if (tid == 0) { int s = 0; for (int e = 0; e < NEXP; ++e) { ppre[e] = s; s += (cnt[e] + 255) >> 8; } ppre[NEXP] = s; }
    __syncthreads();
    const int nM = ppre[NEXP];
    if (tid < nM) { int e = 0; for (int k = 1; k < NEXP; ++k) e += (ppre[k] <= tid) ? 1 : 0; pe[tid] = e; }
    __syncthreads();
    return nM;
}
struct SchedPlainF8 : SchedPlain {
    static constexpr bool F8 = true;
    static constexpr bool I8 = false;
    static constexpr bool DYN_A = true;
    __device__ __forceinline__ const char* abase(const Unit&) const { return A; }
    __device__ __forceinline__ unsigned aoff(const Unit& u, int row, int col) const { return (unsigned)((u.pm * 256 + row) * K + col) * 2u; }
};
struct SchedNsaProj : SchedPlain {
    static constexpr bool PUBLISH = true;
    unsigned* bcnt;
    __device__ __forceinline__ void done(int code) const { const int pm = code & 0xffff, pn = code >> 16;
        if ((pn == 4 || pn == 5) && (threadIdx.x & 63) == 0) __hip_atomic_fetch_add(bcnt + (pm >> 3) * 16, 1u, __ATOMIC_RELAXED, __HIP_MEMORY_SCOPE_AGENT); }
};
struct SchedPlainI8 : SchedPlain { static constexpr bool I8 = true; };
struct SchedNsaProjI8 : SchedNsaProj { static constexpr bool I8 = true; };
struct SchedMoeGU {
    static constexpr bool DYN_A = true;
    static constexpr bool F8 = true;
    static constexpr bool I8 = false;
    const char* X; const char* W; const int* tokof; LAS unsigned char* lds; int nM, G, c; int nt; unsigned kstepA, kstepB, ldb;
    __device__ __forceinline__ void init(const char* ws, int layer, LAS unsigned char* lds_) { lds = lds_; nM = moe_tables(ws, layer, lds_); X = ws + WS_X1Q; W = ws + (layer ? WS_GU1 : WS_GU); tokof = (const int*)(ws + WS_ROWTOK); G = gridDim.x; c = blockIdx.x; nt = 8; kstepA = 128; kstepB = 128; ldb = 1024; }
    __device__ __forceinline__ bool next(int i, Unit& u) const { const int L = i * G + c; if (L >= nM * 4) return false; pg8::static_unit(L, nM, 4, u);
        const int e = ((const LAS int*)(lds + ML_PE))[u.pm]; u.aux = e | ((u.pm - ((const LAS int*)(lds + ML_PPRE))[e]) << 16); u.aux2 = ((const LAS int*)(lds + ML_CNT))[e]; return true; }
    __device__ __forceinline__ const char* abase(const Unit&) const { return X; }
    __device__ __forceinline__ const char* bbase(const Unit& u) const { return W + ((size_t)(u.aux & 255) * 1024 + (size_t)u.pn * 256) * 1024; }
    __device__ __forceinline__ unsigned aoff(const Unit& u, int row, int col) const { const int slot = (u.aux >> 16) * 256 + row; const int sl = slot < u.aux2 ? slot : 0;
        return (unsigned)tokof[(u.aux & 255) * 65536 + sl] * 1024u + (unsigned)col * 2u; }
    static constexpr bool PUBLISH = false;
    __device__ __forceinline__ void a_ready(const Unit&) const {}
    __device__ __forceinline__ void done(int) const {}
};
struct SchedMoeDN {
    static constexpr bool DYN_A = true;
    static constexpr bool F8 = true;
    static constexpr bool I8 = false;
    const char* H; const char* W; LAS unsigned char* lds; int nM, G, c; int nt; unsigned kstepA, kstepB, ldb;
    __device__ __forceinline__ void init(const char* ws, int layer, LAS unsigned char* lds_) { lds = lds_; nM = moe_tables(ws, layer, lds_); H = ws + WS_AOH; W = ws + WS_DN + (layer ? DN1_OFF : 0); G = gridDim.x; c = blockIdx.x; nt = 4; kstepA = 128; kstepB = 128; ldb = 512; }
    __device__ __forceinline__ bool next(int i, Unit& u) const { const int L = i * G + c; if (L >= nM * 4) return false; pg8::static_unit(L, nM, 4, u); u.aux = ((const LAS int*)(lds + ML_PE))[u.pm]; u.aux2 = 0; return true; }
    __device__ __forceinline__ const char* abase(const Unit&) const { return H; }
    __device__ __forceinline__ const char* bbase(const Unit& u) const { return W + ((size_t)u.aux * 1024 + (size_t)u.pn * 256) * 512; }
    __device__ __forceinline__ unsigned aoff(const Unit& u, int row, int col) const { return (unsigned)((u.pm * 256 + row) * 512 + col * 2); }
    static constexpr bool PUBLISH = false;
    __device__ __forceinline__ void a_ready(const Unit&) const {}
    __device__ __forceinline__ void done(int) const {}
};
struct SchedCmp {
    static constexpr bool DYN_A = false;
    static constexpr bool F8 = false;
    static constexpr bool I8 = false;
    static constexpr bool PUBLISH = false;
    const char* Q; const char* W; unsigned* bcnt; unsigned* tmo; int c; int nt; unsigned kstepA, kstepB, ldb;
    __device__ __forceinline__ void init(const char* ws) { Q = ws + WS_BIG; W = ws + WS_W1T; bcnt = (unsigned*)(ws + WS_BCNT); tmo = (unsigned*)(ws + WS_CTL) + XB_TMO; c = (int)blockIdx.x - 128; nt = 16; kstepA = NSA_LD * 2; kstepB = 128; ldb = 4096; }
    __device__ __forceinline__ bool next(int i, Unit& u) const { if (c < 0 || i >= 1 || gridDim.x != 256) return false; const int L = c; u.aux = L >> 6; u.aux2 = 0; u.pm = (L >> 1) & 31; u.pn = L & 1; return true; }
    __device__ __forceinline__ const char* abase(const Unit& u) const { return Q + (size_t)(u.aux ? NSA_VC : NSA_KC) * 2 + (size_t)u.pn * 16 * (NSA_LD * 2); }
    __device__ __forceinline__ const char* bbase(const Unit& u) const { return W + (size_t)u.aux * 256 * 4096 + (size_t)u.pn * 16 * 128; }
    __device__ __forceinline__ unsigned aoff(const Unit& u, int row, int col) const {
        const int m = u.pm * 256 + row, bh = m >> 7, n = m & 127, nn = n > 126 ? 126 : n, b = bh >> 2, hkv = bh & 3;
        return (unsigned)(((b * SEQ + 16 * nn) * NSA_LD) + hkv * 64 + col) * 2u; }
    __device__ __forceinline__ void a_ready(const Unit& u) const {
        if (threadIdx.x < 64) { unsigned polls = 0; unsigned* w = bcnt + (u.pm >> 1) * 16;
            while ((unsigned)__builtin_amdgcn_readfirstlane((int)__hip_atomic_load(w, __ATOMIC_RELAXED, __HIP_MEMORY_SCOPE_AGENT)) < 128u) {
                __builtin_amdgcn_s_sleep(2);
                if ((++polls & 255u) == 0u) { if (__builtin_amdgcn_readfirstlane((int)__hip_atomic_load(tmo, __ATOMIC_RELAXED, __HIP_MEMORY_SCOPE_AGENT)) != 0) break;
                    if (polls > (1u << 18)) { if (threadIdx.x == 0) __hip_atomic_fetch_add(tmo, 1u, __ATOMIC_RELAXED, __HIP_MEMORY_SCOPE_AGENT); break; } } }
            __builtin_amdgcn_fence(__ATOMIC_ACQUIRE, "agent");
            asm volatile("s_waitcnt vmcnt(0)" ::: "memory"); }
        asm volatile("" ::: "memory"); __builtin_amdgcn_s_barrier(); asm volatile("" ::: "memory");
    }
    __device__ __forceinline__ void done(int) const {}
};

struct EpiQKV0 {
    static constexpr bool PERM = true;
    bf16_t* O; float* kpart;
    __device__ __forceinline__ void operator()(const f32x4 (&acc)[2][2][4][2], const Unit& u, int wr, int wc, int fr, int fq) const {
        const int row0 = u.pm * 256 + wr * 64 + fr, col0 = u.pn * 256 + wc * 32 + 8 * fq;
        const float sc = (u.pn < 4) ? C2 : 1.0f;
#pragma unroll
        for (int ai = 0; ai < 2; ++ai)
#pragma unroll
            for (int m = 0; m < 4; ++m) { bf16_t* rowp = O + (size_t)(row0 + ai * 128 + m * 16) * QKV_LD + col0;
#pragma unroll
                for (int bj = 0; bj < 2; ++bj) { const f32x4 v0 = acc[ai][bj][m][0] * sc, v1 = acc[ai][bj][m][1] * sc;
                    if (u.pn < 8) {
                        const float s8 = (u.pn < 4) ? QK8_SQ : QK8_SK;
                        u32x2 w8; w8.x = cvt4_fp8(v0[0] * s8, v0[1] * s8, v0[2] * s8, v0[3] * s8); w8.y = cvt4_fp8(v1[0] * s8, v1[1] * s8, v1[2] * s8, v1[3] * s8);
                        *(u32x2*)((unsigned char*)O + (size_t)(row0 + ai * 128 + m * 16) * (QKV_LD * 2) + (u.pn < 4 ? 0 : 2048) + (u.pn & 3) * 256 + wc * 32 + 8 * fq + bj * 128) = w8; }
                    else { u32x4 w; w.x = cvt_pk_bf16(v0[0], v0[1]); w.y = cvt_pk_bf16(v0[2], v0[3]); w.z = cvt_pk_bf16(v1[0], v1[1]); w.w = cvt_pk_bf16(v1[2], v1[3]);
                        *(u32x4*)(rowp + bj * 128) = w; } } }
        if (u.pn >= 4 && u.pn < 8) {
#pragma unroll
            for (int bj = 0; bj < 2; ++bj)
#pragma unroll
                for (int n = 0; n < 2; ++n) { f32x4 s = (f32x4){0.f, 0.f, 0.f, 0.f};
#pragma unroll
                    for (int ai = 0; ai < 2; ++ai)
#pragma unroll
                        for (int m = 0; m < 4; ++m) s += acc[ai][bj][m][n];
#pragma unroll
                    for (int j = 0; j < 4; ++j) { float v = s[j]; v += __shfl_xor(v, 1); v += __shfl_xor(v, 2); v += __shfl_xor(v, 4); v += __shfl_xor(v, 8); s[j] = v; }
                    if (fr == 0) *(f32x4*)(kpart + ((size_t)u.pm * 2 + wr) * 1024 + (u.pn - 4) * 256 + bj * 128 + wc * 32 + 8 * fq + 4 * n) = s; }
        }
    }
};
struct EpiNull {
    static constexpr bool PERM = true;
    float* sink;
    __device__ __forceinline__ void operator()(const f32x4 (&acc)[2][2][4][2], const Unit& u, int wr, int wc, int fr, int fq) const {
        float s = 0.f;
#pragma unroll
        for (int ai = 0; ai < 2; ++ai)
#pragma unroll
            for (int bj = 0; bj < 2; ++bj)
#pragma unroll
                for (int m = 0; m < 4; ++m)
#pragma unroll
                    for (int n = 0; n < 2; ++n) s += acc[ai][bj][m][n][0] + acc[ai][bj][m][n][3];
        if (s == 12345.678f) sink[u.pm + wr + wc + fr + fq] = s;
    }
};
struct EpiNSA {
    static constexpr bool PERM = true;
    bf16_t* O;
    __device__ __forceinline__ void operator()(const f32x4 (&acc)[2][2][4][2], const Unit& u, int wr, int wc, int fr, int fq) const {
        const int row0 = u.pm * 256 + wr * 64 + fr, col0 = u.pn * 256 + wc * 32 + 8 * fq;
        const float sc = (u.pn < 4) ? C2 : 1.0f; const bool sg = (u.pn == 10), wt = (u.pn == 4 || u.pn == 5);
        const auto rsrc = __builtin_amdgcn_make_buffer_rsrc((void*)O, 0, (int)((size_t)NTOK * NSA_LD * 2), 0x00020000);
#pragma unroll
        for (int ai = 0; ai < 2; ++ai)
#pragma unroll
            for (int m = 0; m < 4; ++m) { bf16_t* rowp = O + (size_t)(row0 + ai * 128 + m * 16) * NSA_LD + col0;
#pragma unroll
                for (int bj = 0; bj < 2; ++bj) { f32x4 v0 = acc[ai][bj][m][0] * sc, v1 = acc[ai][bj][m][1] * sc;
                    if (sg) {
#pragma unroll
                        for (int j = 0; j < 4; ++j) { v0[j] = __builtin_amdgcn_rcpf(1.0f + __builtin_amdgcn_exp2f(-LOG2E * v0[j])); v1[j] = __builtin_amdgcn_rcpf(1.0f + __builtin_amdgcn_exp2f(-LOG2E * v1[j])); } }
                    if (u.pn < 4 || u.pn == 6 || u.pn == 8) {
                        const float s8 = (u.pn < 4) ? QK8_SQ : QK8_SK;
                        u32x2 w8; w8.x = cvt4_fp8(v0[0] * s8, v0[1] * s8, v0[2] * s8, v0[3] * s8); w8.y = cvt4_fp8(v1[0] * s8, v1[1] * s8, v1[2] * s8, v1[3] * s8);
                        *(u32x2*)((unsigned char*)O + (size_t)(row0 + ai * 128 + m * 16) * (NSA_LD * 2) + (u.pn < 4 ? u.pn * 256 : u.pn * 512) + wc * 32 + 8 * fq + bj * 128) = w8; continue; }
                    u32x4 w; w.x = cvt_pk_bf16(v0[0], v0[1]); w.y = cvt_pk_bf16(v0[2], v0[3]); w.z = cvt_pk_bf16(v1[0], v1[1]); w.w = cvt_pk_bf16(v1[2], v1[3]);
                    if (wt) __builtin_amdgcn_raw_buffer_store_b128(w, rsrc, (int)(((unsigned)(row0 + ai * 128 + m * 16) * (unsigned)NSA_LD + (unsigned)(col0 + bj * 128)) * 2u), 0, 16);
                    else *(u32x4*)(rowp + bj * 128) = w; } }
    }
};
template <bool RES_F32, bool F8O = false> struct EpiRes {
    static constexpr bool PERM = true;
    bf16_t* O; const float* rf; const bf16_t* rb;
    __device__ __forceinline__ void operator()(const f32x4 (&acc)[2][2][4][2], const Unit& u, int wr, int wc, int fr, int fq) const {
        const int row0 = u.pm * 256 + wr * 64 + fr, col0 = u.pn * 256 + wc * 32 + 8 * fq;
#pragma unroll
        for (int ai = 0; ai < 2; ++ai) {
            if (RES_F32) {
#pragma unroll
                for (int mh = 0; mh < 2; ++mh) { f32x4 r[2][2][2];
#pragma unroll
                    for (int m2 = 0; m2 < 2; ++m2)
#pragma unroll
                        for (int bj = 0; bj < 2; ++bj) { const size_t ro = (size_t)(row0 + ai * 128 + (mh * 2 + m2) * 16) * 1024 + col0 + bj * 128; r[m2][bj][0] = *(const f32x4*)(rf + ro); r[m2][bj][1] = *(const f32x4*)(rf + ro + 4); }
#pragma unroll
                    for (int m2 = 0; m2 < 2; ++m2)
#pragma unroll
                        for (int bj = 0; bj < 2; ++bj) { const int m = mh * 2 + m2; const size_t ro = (size_t)(row0 + ai * 128 + m * 16) * 1024 + col0 + bj * 128;
                            const f32x4 v0 = acc[ai][bj][m][0] + r[m2][bj][0] * ALPHA, v1 = acc[ai][bj][m][1] + r[m2][bj][1] * ALPHA;
                            u32x4 w; w.x = cvt_pk_bf16(v0[0], v0[1]); w.y = cvt_pk_bf16(v0[2], v0[3]); w.z = cvt_pk_bf16(v1[0], v1[1]); w.w = cvt_pk_bf16(v1[2], v1[3]);
                            *(u32x4*)(O + ro) = w; } }
            } else {
                u32x4 r[4][2];
#pragma unroll
                for (int m = 0; m < 4; ++m)
#pragma unroll
                    for (int bj = 0; bj < 2; ++bj) r[m][bj] = *(const u32x4*)(rb + (size_t)(row0 + ai * 128 + m * 16) * 1024 + col0 + bj * 128);
#pragma unroll
                for (int m = 0; m < 4; ++m)
#pragma unroll
                    for (int bj = 0; bj < 2; ++bj) { const size_t ro = (size_t)(row0 + ai * 128 + m * 16) * 1024 + col0 + bj * 128; const u32x4 rw = r[m][bj];
                        const f32x4 r0 = (f32x4){lo_bf(rw.x), hi_bf(rw.x), lo_bf(rw.y), hi_bf(rw.y)}, r1 = (f32x4){lo_bf(rw.z), hi_bf(rw.z), lo_bf(rw.w), hi_bf(rw.w)};
                        const f32x4 v0 = (F8O ? acc[ai][bj][m][0] * F8_INVO : acc[ai][bj][m][0]) + r0 * ALPHA, v1 = (F8O ? acc[ai][bj][m][1] * F8_INVO : acc[ai][bj][m][1]) + r1 * ALPHA;
                        u32x4 w; w.x = cvt_pk_bf16(v0[0], v0[1]); w.y = cvt_pk_bf16(v0[2], v0[3]); w.z = cvt_pk_bf16(v1[0], v1[1]); w.w = cvt_pk_bf16(v1[2], v1[3]);
                        *(u32x4*)(O + ro) = w; }
            }
        }
    }
};
struct EpiGU {
    static constexpr bool PERM = true;
    unsigned char* O;
    __device__ __forceinline__ void operator()(const f32x4 (&acc)[2][2][4][2], const Unit& u, int wr, int wc, int fr, int fq) const {
        const int row0 = u.pm * 256 + wr * 64 + fr, col0 = u.pn * 128 + wc * 32 + 8 * fq;
#pragma unroll
        for (int ai = 0; ai < 2; ++ai)
#pragma unroll
            for (int m = 0; m < 4; ++m) { float h[8];
#pragma unroll
                for (int n = 0; n < 2; ++n)
#pragma unroll
                    for (int j = 0; j < 4; ++j) { const float g = acc[ai][0][m][n][j] * F8_INV, up = acc[ai][1][m][n][j] * (F8_INV * F8_SX); h[n * 4 + j] = g * up * __builtin_amdgcn_rcpf(1.0f + __builtin_amdgcn_exp2f(-LOG2E * g)); }
                u32x2 w; w.x = cvt4_fp8(h[0], h[1], h[2], h[3]); w.y = cvt4_fp8(h[4], h[5], h[6], h[7]);
                *(u32x2*)(O + (size_t)(row0 + ai * 128 + m * 16) * 512 + col0) = w; }
    }
};
struct EpiDN {
    static constexpr bool PERM = true;
    unsigned char* O;
    __device__ __forceinline__ void operator()(const f32x4 (&acc)[2][2][4][2], const Unit& u, int wr, int wc, int fr, int fq) const {
        const int row0 = u.pm * 256 + wr * 64 + fr, col0 = u.pn * 256 + wc * 32 + 8 * fq; constexpr float s = F8_INV * F8_SY;
#pragma unroll
        for (int ai = 0; ai < 2; ++ai)
#pragma unroll
            for (int m = 0; m < 4; ++m) { unsigned char* rowp = O + (size_t)(row0 + ai * 128 + m * 16) * 1024 + col0;
#pragma unroll
                for (int bj = 0; bj < 2; ++bj) { const f32x4 v0 = acc[ai][bj][m][0] * s, v1 = acc[ai][bj][m][1] * s;
                    u32x2 w; w.x = cvt4_fp8(v0[0], v0[1], v0[2], v0[3]); w.y = cvt4_fp8(v1[0], v1[1], v1[2], v1[3]);
                    *(u32x2*)(rowp + bj * 128) = w; } }
    }
};
struct EpiCmp {
    static constexpr bool PERM = false;
    float* CP;
    __device__ __forceinline__ void operator()(const f32x4 (&acc)[2][2][4][2], const Unit& u, int wr, int wc, int fr, int fq) const {
        float* base = CP + ((size_t)(u.aux * 2 + u.pn) * 8192 + (size_t)u.pm * 256) * 256;
        const int row0 = wr * 64 + fr, col0 = wc * 32 + 4 * fq;
#pragma unroll
        for (int ai = 0; ai < 2; ++ai)
#pragma unroll
            for (int m = 0; m < 4; ++m) { float* rowp = base + (size_t)(row0 + ai * 128 + m * 16) * 256 + col0;
#pragma unroll
                for (int bj = 0; bj < 2; ++bj)
#pragma unroll
                    for (int n = 0; n < 2; ++n) *(f32x4*)(rowp + bj * 128 + n * 16) = acc[ai][bj][m][n]; }
    }
};

constexpr int AL_K = 0  , AL_V = 24576  , AL_BIAS = 57344  , AL_KM = AL_BIAS + 4 * BT_H * 4, AL_IMP = AL_KM + 2048  , AL_CMP = AL_IMP + 33792  , AL_SEL = AL_CMP + 32768, AL_LIST = AL_SEL + 512, AL_END = AL_LIST + 256;
static_assert(AL_END <= LDS_BYTES, "attention LDS map");
static_assert(AL_END <= LDS_BYTES - 16 && 4 * 64 * 33 * 4 <= 65536, "attention LDS map");
#define MFMA32(a, b, c) __builtin_amdgcn_mfma_f32_32x32x16_bf16(a, b, c, 0, 0, 0)
__device__ __forceinline__ s16x4 vtr(lds_cptr p) { return __builtin_bit_cast(s16x4, __builtin_amdgcn_ds_read_tr16_b64_v4i16((LAS v4i16_t*)p)); }
__device__ __forceinline__ float xhalf_max(float m) { auto rr = __builtin_amdgcn_permlane32_swap(__float_as_uint(m), __float_as_uint(m), false, false); return __builtin_fmaxf(__uint_as_float(rr[0]), __uint_as_float(rr[1])); }
__device__ __forceinline__ float xhalf_sum(float m) { auto rr = __builtin_amdgcn_permlane32_swap(__float_as_uint(m), __float_as_uint(m), false, false); return __uint_as_float(rr[0]) + __uint_as_float(rr[1]); }
__device__ __forceinline__ float max16(const f32x16& p) { float a = __builtin_fmaxf(p[0], p[1]), b = __builtin_fmaxf(p[2], p[3]);
#pragma unroll
    for (int r = 4; r < 16; r += 4) { a = __builtin_fmaxf(a, __builtin_fmaxf(p[r], p[r + 1])); b = __builtin_fmaxf(b, __builtin_fmaxf(p[r + 2], p[r + 3])); }
    return __builtin_fmaxf(a, b); }

#define MX3(a, b, c) __builtin_fmaxf(__builtin_fmaxf((a), (b)), (c))
__device__ __forceinline__ float max32(const f32x16& p0, const f32x16& p1) {
    float a = MX3(p0[0], p0[1], p1[0]), b = MX3(p0[2], p0[3], p1[1]); a = MX3(a, p1[2], p1[3]);
#pragma unroll
    for (int r = 4; r < 16; r += 4) { a = MX3(a, p0[r], p0[r + 1]); b = MX3(b, p0[r + 2], p0[r + 3]); a = MX3(a, p1[r], p1[r + 1]); b = MX3(b, p1[r + 2], p1[r + 3]); }
    return __builtin_fmaxf(a, b); }
constexpr float FLASH_THR = 8.0f;
__device__ __forceinline__ void glds16(const void* g, unsigned lds_addr) {
    unsigned sv; asm volatile("s_mov_b32 %0, m0\n\ts_mov_b32 m0, %2\n\ts_nop 0\n\tglobal_load_lds_dwordx4 %1, off\n\ts_mov_b32 m0, %0" : "=&s"(sv) : "v"(g), "s"(lds_addr) : "memory"); }
__device__ __forceinline__ void dma_k(const bf16_t* src, int ld, LAS unsigned char* lds, int slot, int wid, int lane, int base = AL_K) {
    const int rl = lane >> 3, ch = lane & 7;
    glds16(src + (size_t)(wid * 8 + rl) * ld + ((ch ^ rl) * 8), (unsigned)__builtin_amdgcn_readfirstlane((int)((unsigned)(unsigned long)lds + base + slot * 8192 + wid * 1024))); }
__device__ __forceinline__ void dma_v(const bf16_t* src, int ld, LAS unsigned char* lds, int slot, int wid, int lane, int base = AL_V) {
    glds16(src + (size_t)(16 * (wid & 3) + (lane >> 2)) * ld + (wid >> 2) * 32 + (lane & 3) * 8, (unsigned)__builtin_amdgcn_readfirstlane((int)((unsigned)(unsigned long)lds + base + slot * 8192 + wid * 1024))); }

__device__ __forceinline__ void dma_k8(const unsigned char* src8, int ld, LAS unsigned char* lds, int slot, int wid, int lane, int base = AL_K) {
    glds16(src8 + (size_t)(16 * (wid & 3) + (lane >> 2)) * ld + (lane & 3) * 16, (unsigned)__builtin_amdgcn_readfirstlane((int)((unsigned)(unsigned long)lds + base + slot * 8192 + (wid & 3) * 1024))); }
struct FState { float m, l; f32x16 o0, o1; };
__device__ __forceinline__ void fstate_reset(FState& s) { s.m = -1e30f; s.l = 0.f;
#pragma unroll
    for (int r = 0; r < 16; ++r) { s.o0[r] = 0.f; s.o1[r] = 0.f; } }

__device__ __forceinline__ int kchunk_off(int d0, int kx) { return (((2 * d0 + (kx >> 3)) ^ (kx & 7)) * 16); }
__device__ __forceinline__ void qk_tile(f32x16& c0, f32x16& c1, const bf16x8 (&qr)[4], lds_cptr kp, int kx) {
#pragma unroll
    for (int d0 = 0; d0 < 4; ++d0) { const bf16x8 k0 = *(const LAS bf16x8*)(kp + kchunk_off(d0, kx)), k1 = *(const LAS bf16x8*)(kp + kchunk_off(d0, kx) + 4096);
        c0 = MFMA32(k0, qr[d0], c0); c1 = MFMA32(k1, qr[d0], c1); }
}
__device__ __forceinline__ void pv_tile(f32x16& o0, f32x16& o1, const f32x16& p0, const f32x16& p1, lds_cptr vp) {
#pragma unroll
    for (int k = 0; k < 4; ++k) {
        const f32x16& ps = (k < 2) ? p0 : p1; const int b = 8 * (k & 1);
        const u32x4 pw = (u32x4){cvt_pk_bf16(ps[b], ps[b + 1]), cvt_pk_bf16(ps[b + 2], ps[b + 3]), cvt_pk_bf16(ps[b + 4], ps[b + 5]), cvt_pk_bf16(ps[b + 6], ps[b + 7])};
        const bf16x8 pf = __builtin_bit_cast(bf16x8, pw);
        { const s16x4 lo = vtr(vp + k * 1024), hi = vtr(vp + k * 1024 + 512);
          const bf16x8 vf = (bf16x8){lo[0], lo[1], lo[2], lo[3], hi[0], hi[1], hi[2], hi[3]}; o0 = MFMA32(vf, pf, o0); }
        { const s16x4 lo = vtr(vp + 4096 + k * 1024), hi = vtr(vp + 4096 + k * 1024 + 512);
          const bf16x8 vf = (bf16x8){lo[0], lo[1], lo[2], lo[3], hi[0], hi[1], hi[2], hi[3]}; o1 = MFMA32(vf, pf, o1); }
    }
}
struct TileP { int Dmin; bool rowok, run, win; };
__device__ __forceinline__ void load_kf(bf16x8 (&kf)[8], lds_cptr kp, int kx) {
#pragma unroll
    for (int d0 = 0; d0 < 4; ++d0) { kf[2 * d0] = *(const LAS bf16x8*)(kp + kchunk_off(d0, kx)); kf[2 * d0 + 1] = *(const LAS bf16x8*)(kp + kchunk_off(d0, kx) + 4096); } }
__device__ __forceinline__ void flash_qk(f32x16& c0, f32x16& c1, float& cf, const bf16x8 (&qr)[4], lds_cptr kp, int kx, const LAS float* btab, float cfar, int Dmin, int r32, int hi) {
    bf16x8 kf[8]; load_kf(kf, kp, kx);
    if (Dmin - 63 < 127) {
        const int s0 = (BT_N - 1 - 63) - (Dmin + r32 - 4 * hi), ksh = s0 & 3; cf = 0.f;
        const LAS f32x4* bp = (const LAS f32x4*)(btab + ksh * BT_S + (s0 - ksh));
#pragma unroll
        for (int g = 0; g < 4; ++g) { const f32x4 a = bp[2 * g], b = bp[8 + 2 * g];
#pragma unroll
            for (int i = 0; i < 4; ++i) { c0[4 * g + i] = a[i]; c1[4 * g + i] = b[i]; } }
#pragma unroll
        for (int d0 = 0; d0 < 4; ++d0) { c0 = MFMA32(kf[2 * d0], qr[d0], c0); c1 = MFMA32(kf[2 * d0 + 1], qr[d0], c1); }
    } else {
        cf = cfar;
        const f32x16 z = {0.f, 0.f, 0.f, 0.f, 0.f, 0.f, 0.f, 0.f, 0.f, 0.f, 0.f, 0.f, 0.f, 0.f, 0.f, 0.f};
        c0 = MFMA32(kf[0], qr[0], z); c1 = MFMA32(kf[1], qr[0], z);
#pragma unroll
        for (int d0 = 1; d0 < 4; ++d0) { c0 = MFMA32(kf[2 * d0], qr[d0], c0); c1 = MFMA32(kf[2 * d0 + 1], qr[d0], c1); }
    }
}
#define MFMA8(a, b, c) __builtin_amdgcn_mfma_scale_f32_32x32x64_f8f6f4(a, b, c, 0, 0, 0, 0, 0, 0)
__device__ __forceinline__ void flash_qk(f32x16& c0, f32x16& c1, float& cf, const i32x8& q8, lds_cptr kp8, int, const LAS float* btab, float cfar, int Dmin, int r32, int hi) {
    i32x8 k0, k1;
    k0.lo = *(const LAS i32x4*)(kp8); k0.hi = *(const LAS i32x4*)(kp8 + 16); k1.lo = *(const LAS i32x4*)(kp8 + 2048); k1.hi = *(const LAS i32x4*)(kp8 + 2048 + 16);
    if (Dmin - 63 < 127) {
        const int s0 = (BT_N - 1 - 63) - (Dmin + r32 - 4 * hi), ksh = s0 & 3; cf = 0.f;
        const LAS f32x4* bp = (const LAS f32x4*)(btab + ksh * BT_S + (s0 - ksh));
#pragma unroll
        for (int g = 0; g < 4; ++g) { const f32x4 a = bp[2 * g] * (QK8_SQ * QK8_SK), b = bp[8 + 2 * g] * (QK8_SQ * QK8_SK);
#pragma unroll
            for (int i = 0; i < 4; ++i) { c0[4 * g + i] = a[i]; c1[4 * g + i] = b[i]; } }
        c0 = MFMA8(k0, q8, c0); c1 = MFMA8(k1, q8, c1);
    } else {
        cf = cfar;
        const f32x16 z = {0.f, 0.f, 0.f, 0.f, 0.f, 0.f, 0.f, 0.f, 0.f, 0.f, 0.f, 0.f, 0.f, 0.f, 0.f, 0.f};
        c0 = MFMA8(k0, q8, z); c1 = MFMA8(k1, q8, z);
    }
}
template <bool K8 = false>
__device__ __forceinline__ void flash_sm(FState& st, f32x16& c0, f32x16& c1, float cf, const TileP& tp, int r32, int hi) {
    const int Dmin = tp.Dmin, Dl = Dmin + r32 - 4 * hi;
    if (tp.win && (Dmin + 31 >= 512)) {
#pragma unroll
        for (int r = 0; r < 16; ++r) { const int ko = (r & 3) + 8 * (r >> 2); if (Dl >= 512 + ko) c0[r] = -INFINITY; if (Dl >= 544 + ko) c1[r] = -INFINITY; }
    }
    float mx = (K8 ? xhalf_max(max32(c0, c1)) * QK8_INV : xhalf_max(max32(c0, c1))) + cf;
    mx = tp.rowok ? mx : -INFINITY;
    if (__any(mx > st.m + FLASH_THR)) {
        const float mn = __builtin_fmaxf(st.m, mx); const float alpha = __builtin_amdgcn_exp2f(st.m - mn);
        st.m = mn; st.l *= alpha;
#pragma unroll
        for (int r = 0; r < 16; ++r) { st.o0[r] *= alpha; st.o1[r] *= alpha; }
    }
    const float msub = tp.rowok ? (st.m - cf) : INFINITY;
    float rs0 = 0.f, rs1 = 0.f;
#pragma unroll
    for (int r = 0; r < 16; ++r) { c0[r] = __builtin_amdgcn_exp2f(K8 ? __builtin_fmaf(c0[r], QK8_INV, -msub) : c0[r] - msub); c1[r] = __builtin_amdgcn_exp2f(K8 ? __builtin_fmaf(c1[r], QK8_INV, -msub) : c1[r] - msub); rs0 += c0[r]; rs1 += c1[r]; }
    st.l += rs0 + rs1;
}
template <int VAR, class Src, bool PRE = false, bool K8 = false, class QT = bf16x8[4]>
__device__ __forceinline__ void attn_stream(Src& S, int NT, FState& st, const QT& qr, LAS unsigned char* lds, const LAS float* btab, float cfar, int wid, int lane, int r32, int hi) {
    const lds_cptr kp0 = K8 ? (lds_cptr)lds + AL_K + r32 * 64 + hi * 32 : (lds_cptr)lds + AL_K + r32 * 128; const int kx = (r32 & 7) | (hi << 3);
    const lds_cptr vp0 = (lds_cptr)lds + AL_V + ((lane >> 4) & 1) * 32 + (lane & 3) * 8 + (4 * hi + ((lane & 15) >> 2)) * 64;
    if (!PRE) { S.dma(0, 0, 0); if (NT > 1 && VAR != 5 && VAR != 6) S.dma(1, 1, 1); }
    if (VAR == 5) { asm volatile("s_waitcnt vmcnt(0)" ::: "memory"); __syncthreads(); }
    int sc = 0, sn = 2;
    S.prefetch(-1);
#pragma nounroll
    for (int t = 0; t < NT; ++t) {
        if (VAR != 5) { if (t + 1 < NT) asm volatile("s_waitcnt vmcnt(2)" ::: "memory"); else asm volatile("s_waitcnt vmcnt(0)" ::: "memory");
        __syncthreads(); }
        if (VAR != 5 && VAR != 6) { if (t + 2 < NT) S.dma_pre(t + 2, sn, sn); }
        const TileP tp = S.params(t);
        S.prefetch(t);
        if (tp.run) { f32x16 c0, c1; float cf;
            flash_qk(c0, c1, cf, qr, kp0 + sc * 8192, kx, btab, cfar, tp.Dmin, r32, hi);
            flash_sm<K8>(st, c0, c1, cf, tp, r32, hi);
            pv_tile(st.o0, st.o1, c0, c1, vp0 + sc * 8192); }
        S.after(t, st);
        sc = (sc == 2) ? 0 : sc + 1; sn = (sn == 2) ? 0 : sn + 1;
    }
}

__device__ __forceinline__ void conv_tile(const float* src, int N, bf16_t* dst, int ldd, int k0, int n0, int rowadd, int mode, LAS float* t, int lane) {
    f32x4 v[16];
#pragma unroll
    for (int i = 0; i < 16; ++i) { const int r = i * 4 + (lane >> 4), cc = n0 + (lane & 15) * 4;
        v[i] = (cc < N) ? __builtin_nontemporal_load((const f32x4*)(src + (size_t)(k0 + r) * N + cc)) : (f32x4){0.f, 0.f, 0.f, 0.f}; }
#pragma unroll
    for (int i = 0; i < 16; ++i) { const int r = i * 4 + (lane >> 4), cc = (lane & 15) * 4; LAS float* q = t + r * 65 + cc; q[0] = v[i][0]; q[1] = v[i][1]; q[2] = v[i][2]; q[3] = v[i][3]; }
    asm volatile("s_waitcnt lgkmcnt(0)" ::: "memory");
#pragma unroll
    for (int i = 0; i < 8; ++i) { const int nr = i * 8 + (lane >> 3), kc = (lane & 7) * 8; float f[8];
#pragma unroll
        for (int j = 0; j < 8; ++j) f[j] = t[(kc + j) * 65 + nr];
        const int n = n0 + nr; const int drow = ((mode & 1) == 0) ? n : (256 * (n >> 7) + (n & 127) + rowadd);
        if (mode & 2) { u32x2 w8;
            if (mode & 4) { w8.x = cvt4_i8(f[0] * I8_SW, f[1] * I8_SW, f[2] * I8_SW, f[3] * I8_SW); w8.y = cvt4_i8(f[4] * I8_SW, f[5] * I8_SW, f[6] * I8_SW, f[7] * I8_SW); }
            else { w8.x = cvt4_fp8(f[0] * F8_SW, f[1] * F8_SW, f[2] * F8_SW, f[3] * F8_SW); w8.y = cvt4_fp8(f[4] * F8_SW, f[5] * F8_SW, f[6] * F8_SW, f[7] * F8_SW); }
            *(u32x2*)((unsigned char*)dst + (size_t)drow * ldd + k0 + kc) = w8; }
        else { u32x4 w; w.x = cvt_pk_bf16(f[0], f[1]); w.y = cvt_pk_bf16(f[2], f[3]); w.z = cvt_pk_bf16(f[4], f[5]); w.w = cvt_pk_bf16(f[6], f[7]);
            *(u32x4*)(dst + (size_t)drow * ldd + k0 + kc) = w; } }
    asm volatile("s_waitcnt lgkmcnt(0)" ::: "memory");
}
__device__ __forceinline__ int conv_job(const float* src, int K, int N, int Npad, bf16_t* dst, int ldd, int rowadd, int mode, int tile0, LAS float* t, int gw, int ngw, int lane) {
    const int nkt = K / 64, nnt = Npad / 64, ntile = nkt * nnt;
    int first = (gw - tile0 % ngw + ngw) % ngw;
    for (int i = first; i < ntile; i += ngw) conv_tile(src, N, dst, ldd, (i / nnt) * 64, (i % nnt) * 64, rowadd, mode, t, lane);
    return tile0 + ntile;
}
struct MoeTile { const float* src; unsigned char* dst; int N, ldd, k0, n0, rowadd, gated; };
__device__ __forceinline__ MoeTile moe_tile(const Params& p, int layer, int g, int which, size_t dn_off) {
    const int e = which ? (g >> 7) : (g >> 8), job = which ? 2 : ((g >> 7) & 1), tl = g & 127; const size_t wo = ((size_t)layer * NEXP + e) * 1024 * 512; MoeTile m;
    if (job < 2) { m.src = (job ? p.w_up : p.w_gate) + wo; m.N = 512; m.dst = (unsigned char*)(p.ws + (layer ? WS_GU1 : WS_GU)) + (size_t)e * 1024 * 1024; m.ldd = 1024; m.k0 = (tl >> 3) * 64; m.n0 = (tl & 7) * 64; m.rowadd = job * 128; m.gated = 1; }
    else { m.src = p.w_down + wo; m.N = 1024; m.dst = (unsigned char*)(p.ws + WS_DN) + dn_off + (size_t)e * 1024 * 512; m.ldd = 512; m.k0 = (tl >> 4) * 64; m.n0 = (tl & 15) * 64; m.rowadd = 0; m.gated = 0; }
    return m;
}
__device__ __forceinline__ void moe_tile_load(f32x4 (&v)[16], const MoeTile& m, int lane) {
#pragma unroll
    for (int i = 0; i < 16; ++i) { const int r = i * 4 + (lane >> 4), cc = m.n0 + (lane & 15) * 4; v[i] = __builtin_nontemporal_load((const f32x4*)(m.src + (size_t)(m.k0 + r) * m.N + cc)); }
}
__device__ __forceinline__ void moe_tile_finish(const f32x4 (&v)[16], const MoeTile& m, LAS float* t, int lane) {
#pragma unroll
    for (int i = 0; i < 16; ++i) { const int r = i * 4 + (lane >> 4), cc = (lane & 15) * 4; LAS float* q = t + r * 65 + cc; q[0] = v[i][0]; q[1] = v[i][1]; q[2] = v[i][2]; q[3] = v[i][3]; }
    asm volatile("s_waitcnt lgkmcnt(0)" ::: "memory");
#pragma unroll
    for (int i = 0; i < 8; ++i) { const int nr = i * 8 + (lane >> 3), kc = (lane & 7) * 8; float f[8];
#pragma unroll
        for (int j = 0; j < 8; ++j) f[j] = t[(kc + j) * 65 + nr];
        const int n = m.n0 + nr; const int drow = m.gated ? (256 * (n >> 7) + (n & 127) + m.rowadd) : n;
        u32x2 w8; w8.x = cvt4_fp8(f[0] * F8_SW, f[1] * F8_SW, f[2] * F8_SW, f[3] * F8_SW); w8.y = cvt4_fp8(f[4] * F8_SW, f[5] * F8_SW, f[6] * F8_SW, f[7] * F8_SW);
        *(u32x2*)(m.dst + (size_t)drow * m.ldd + m.k0 + kc) = w8; }
    asm volatile("s_waitcnt lgkmcnt(0)" ::: "memory");
}
__device__ __forceinline__ void conv_moe_stream(const Params& p, int layer, int which, size_t dn_off, LAS unsigned char* lds, int gw, int ngw, int gbeg = 0, int gend = -1) {
    const int tid = otid(), lane = tid & 63, wid = tid >> 6;
    LAS float* t = (LAS float*)(lds + wid * (64 * 65 * 4));
    const int NTILE = gend >= 0 ? gend : (which ? NEXP * 128 : NEXP * 256);
    f32x4 va[16], vb[16];
    int g = gbeg + gw;
    if (g < NTILE) { const MoeTile m = moe_tile(p, layer, g, which, dn_off); moe_tile_load(va, m, lane); }
    while (g < NTILE) {
        { const int gn = g + ngw; if (gn < NTILE) { const MoeTile mn = moe_tile(p, layer, gn, which, dn_off); moe_tile_load(vb, mn, lane); }
          const MoeTile m = moe_tile(p, layer, g, which, dn_off); moe_tile_finish(va, m, t, lane); g = gn; }
        if (g >= NTILE) break;
        { const int gn = g + ngw; if (gn < NTILE) { const MoeTile mn = moe_tile(p, layer, gn, which, dn_off); moe_tile_load(va, mn, lane); }
          const MoeTile m = moe_tile(p, layer, g, which, dn_off); moe_tile_finish(vb, m, t, lane); g = gn; }
    }
}
__device__ __forceinline__ void phase_prologue(const Params& p, LAS unsigned char* lds) {
    const int tid = otid(), lane = tid & 63, wid = tid >> 6, gw = blockIdx.x * 8 + wid, ngw = gridDim.x * 8;
    LAS float* t = (LAS float*)(lds + wid * (64 * 65 * 4));
    char* ws = p.ws;
    { const size_t n8 = (size_t)NTOK * 1024 / 8; bf16_t* xb = (bf16_t*)(ws + WS_XB);
      for (size_t i = (size_t)blockIdx.x * NTHREADS + tid; i < n8; i += (size_t)gridDim.x * NTHREADS) {
          const f32x4 a = __builtin_nontemporal_load((const f32x4*)(p.x + i * 8)), b = __builtin_nontemporal_load((const f32x4*)(p.x + i * 8 + 4));
          u32x4 w; w.x = cvt_pk_bf16(a[0], a[1]); w.y = cvt_pk_bf16(a[2], a[3]); w.z = cvt_pk_bf16(b[0], b[1]); w.w = cvt_pk_bf16(b[2], b[3]);
          *(u32x4*)(xb + i * 8) = w;
          u32x2 w8; w8.x = cvt4_i8(a[0] * I8_SX, a[1] * I8_SX, a[2] * I8_SX, a[3] * I8_SX); w8.y = cvt4_i8(b[0] * I8_SX, b[1] * I8_SX, b[2] * I8_SX, b[3] * I8_SX);
          *(u32x2*)((unsigned char*)(ws + WS_X1Q) + i * 8) = w8; } }
    int tile0 = 0;
    tile0 = conv_job(p.moba_w_in, 1024, 3072, 3072, (bf16_t*)(ws + WS_WQKV0), 1024, 0, 6, tile0, t, gw, ngw, lane);
    tile0 = conv_job(p.moba_w_out, 1024, 1024, 1024, (bf16_t*)(ws + WS_WO0), 1024, 0, 2, tile0, t, gw, ngw, lane);
    tile0 = conv_job(p.nsa_w_in, 1024, 2608, 2816, (bf16_t*)(ws + WS_WIN1), 1024, 0, 6, tile0, t, gw, ngw, lane);
    tile0 = conv_job(p.nsa_w_out, 1024, 1024, 1024, (bf16_t*)(ws + WS_WO1), 1024, 0, 2, tile0, t, gw, ngw, lane);
    tile0 = conv_job(p.ck_w1, 2048, 256, 256, (bf16_t*)(ws + WS_W1T), 2048, 0, 0, tile0, t, gw, ngw, lane);
    tile0 = conv_job(p.cv_w1, 2048, 256, 256, (bf16_t*)(ws + WS_W1T) + 256 * 2048, 2048, 0, 0, tile0, t, gw, ngw, lane);
    conv_moe_stream(p, 0, 0, 0, lds, gw, ngw); conv_moe_stream(p, 0, 1, 0, lds, gw, ngw);
    for (int i = blockIdx.x * NTHREADS + tid; i < 16 * BT_H; i += gridDim.x * NTHREADS) {
        const int h = i / BT_H, k = (i % BT_H) / BT_S, j = i % BT_S; int e = (BT_N - 1) - (j + k); e = e < 0 ? 0 : e;
        int n = e - 63; const bool future = n < 0; n = n < 0 ? 0 : (n > 127 ? 127 : n);
        int bk = n;
        if (n >= 16) { bk = 16 + (int)(logf((float)n / 16.0f) / logf(8.0f) * 16.0f); bk = bk > 31 ? 31 : bk; }
        ((float*)(ws + WS_TAB))[i] = future ? -INFINITY : p.rel_bias[bk * 16 + h] * LOG2E; }
    if (gridDim.x == 256) {
        __syncthreads();
        const int combo = blockIdx.x >> 2, kv = combo >> 5, part = combo & 31, jj = tid & 63, ks = tid >> 6, j = (blockIdx.x & 3) * 64 + jj;
        const float* pos = kv ? p.pos_v : p.pos_k; const float* w1 = kv ? p.cv_w1 : p.ck_w1; float s = 0.f;
#pragma unroll
        for (int k = part * 64 + ks * 8; k < part * 64 + ks * 8 + 8; ++k) s += pos[k] * w1[(size_t)k * 256 + j];
        LAS float* red = (LAS float*)lds; red[ks * 64 + jj] = s;
        __syncthreads();
        if (tid < 64) { float a = 0.f;
#pragma unroll
            for (int q8 = 0; q8 < 8; ++q8) a += red[q8 * 64 + tid];
            ((float*)(ws + WS_B1))[(kv * 32 + part) * 256 + j] = a; }
    } else if (blockIdx.x < 32) { const int kv = blockIdx.x >> 4, part = (blockIdx.x & 15) * 2 + (tid >> 8), j = tid & 255;
        const float* pos = kv ? p.pos_v : p.pos_k; const float* w1 = kv ? p.cv_w1 : p.ck_w1; float s = 0.f;
#pragma unroll 16
        for (int k = part * 64; k < part * 64 + 64; ++k) s += pos[k] * w1[(size_t)k * 256 + j];
        ((float*)(ws + WS_B1))[(kv * 32 + part) * 256 + j] = s; }
}

__device__ __forceinline__ void store_o_rows(LAS unsigned char* stg, unsigned char* grow0, const f32x16& a0, const f32x16& a1, float scale, int lane, int r32, int hi) {
    LAS unsigned char* sp = stg + r32 * 80 + hi * 4; const float s16 = scale * F8_SO;
#pragma unroll
    for (int g4 = 0; g4 < 4; ++g4) {
        *(LAS unsigned*)(sp + g4 * 8) = cvt4_fp8(a0[4 * g4] * s16, a0[4 * g4 + 1] * s16, a0[4 * g4 + 2] * s16, a0[4 * g4 + 3] * s16);
        *(LAS unsigned*)(sp + 32 + g4 * 8) = cvt4_fp8(a1[4 * g4] * s16, a1[4 * g4 + 1] * s16, a1[4 * g4 + 2] * s16, a1[4 * g4 + 3] * s16); }
    asm volatile("s_waitcnt lgkmcnt(0)" ::: "memory");
#pragma unroll
    for (int it = 0; it < 2; ++it) { const int row = it * 16 + (lane >> 2), ch = lane & 3;
        const u32x4 v = *(const LAS u32x4*)(stg + row * 80 + ch * 16);
        *(u32x4*)(grow0 + (size_t)row * 1024 + ch * 16) = v; }
    asm volatile("s_waitcnt lgkmcnt(0)" ::: "memory");
}
template <int VAR> __device__ __forceinline__ void moba_unit(const Params& p, LAS unsigned char* lds, int b, int h, int qb) {
    const int tid = otid(), lane = tid & 63, r32 = lane & 31, hi = lane >> 5; const int wid = __builtin_amdgcn_readfirstlane(tid >> 6);
    const bf16_t* QKV = (const bf16_t*)(p.ws + WS_BIG);
    const size_t rowbase = (size_t)b * SEQ; const int q0 = qb * 256, qw = q0 + wid * 32;
    const unsigned char* Kb = (const unsigned char*)QKV + rowbase * (QKV_LD * 2) + 2048 + h * 64;
    const bf16_t* Vb = QKV + rowbase * QKV_LD + 2048 + h * 64;
    i32x8 qr;
    { const unsigned char* qp = (const unsigned char*)QKV + (rowbase + qw + r32) * (QKV_LD * 2) + h * 64 + hi * 32;
      qr.lo = *(const i32x4*)(qp); qr.hi = *(const i32x4*)(qp + 16); }
    float kmv, btv[3];
    { const float* kp = (const float*)(p.ws + WS_KPART); const int j = tid >> 6, d = tid & 63;
      const float* s = kp + ((size_t)(b * 8 + j) * 2) * 1024 + h * 64 + d; kmv = s[0] + s[1024];
#pragma unroll
      for (int i = 0; i < 3; ++i) { const int ix = tid + i * NTHREADS; btv[i] = ((const float*)(p.ws + WS_TAB))[h * BT_H + (ix < BT_H ? ix : 0)]; } }
    __syncthreads();
    dma_k8(Kb + (size_t)q0 * (QKV_LD * 2), QKV_LD * 2, lds, 0, wid, lane); dma_v(Vb + (size_t)q0 * QKV_LD, QKV_LD, lds, 0, wid, lane);
    dma_k8(Kb + (size_t)(q0 + 64) * (QKV_LD * 2), QKV_LD * 2, lds, 1, wid, lane); dma_v(Vb + (size_t)(q0 + 64) * QKV_LD, QKV_LD, lds, 1, wid, lane);
    ((LAS float*)(lds + AL_KM))[tid] = kmv;
#pragma unroll
    for (int i = 0; i < 3; ++i) { const int ix = tid + i * NTHREADS; if (ix < BT_H) ((LAS float*)(lds + AL_BIAS))[ix] = btv[i]; }
    const int NT = 4 + 4 * qb;
    __syncthreads();
    unsigned sel = 0;
    { float g[8];
      float qf[32];
#pragma unroll
      for (int i = 0; i < 8; ++i) { const f32x2 a = __builtin_amdgcn_cvt_pk_f32_fp8(qr[i], false), b2 = __builtin_amdgcn_cvt_pk_f32_fp8(qr[i], true); qf[4 * i] = a[0]; qf[4 * i + 1] = a[1]; qf[4 * i + 2] = b2[0]; qf[4 * i + 3] = b2[1]; }
#pragma unroll
      for (int j = 0; j < 8; ++j) { float s = 0.f; const LAS float* km = (const LAS float*)(lds + AL_KM) + j * 64 + hi * 32;
#pragma unroll
          for (int i = 0; i < 32; ++i) s += qf[i] * km[i];
          g[j] = xhalf_sum(s); }
#pragma unroll
      for (int round = 0; round < 3; ++round) { int best = -1; float bv = 0.f;
#pragma unroll
          for (int j = 0; j < 8; ++j) { const bool ok = (j < qb) && !((sel >> j) & 1u) && (best < 0 || g[j] > bv); if (ok) { best = j; bv = g[j]; } }
          if (best >= 0) sel |= 1u << best; } }
    const LAS float* btab = (const LAS float*)(lds + AL_BIAS); const float cfar = btab[0];
    FState st; fstate_reset(st);
    struct MobaSrc {
        const unsigned char* Kb; const bf16_t* Vb; LAS unsigned char* lds; int qb, qw, wid, lane; unsigned sel;
        __device__ __forceinline__ void tile(int t, int& blk, int& kt) const { blk = t < 4 ? qb : qb - 1 - ((t - 4) >> 2); kt = t < 4 ? t : ((t - 4) & 3); }
        __device__ __forceinline__ void dma(int t, int ks, int vs) const { int blk, kt; tile(t, blk, kt); const size_t key0 = (size_t)blk * 256 + kt * 64;
            dma_k8(Kb + key0 * (QKV_LD * 2), QKV_LD * 2, lds, ks, wid, lane); dma_v(Vb + key0 * QKV_LD, QKV_LD, lds, vs, wid, lane); }
        __device__ __forceinline__ TileP params(int t) const { int blk, kt; tile(t, blk, kt); TileP tp; tp.Dmin = qw - (blk * 256 + kt * 64); tp.win = false;
            if (blk == qb) { tp.rowok = true; tp.run = (64 * kt <= wid * 32 + 31); } else { tp.rowok = (sel >> blk) & 1u; tp.run = __any(tp.rowok); }
            return tp; }
        __device__ __forceinline__ void dma_pre(int t, int ks, int vs) const { dma(t, ks, vs); }
        __device__ __forceinline__ void prefetch(int) const {}
        __device__ __forceinline__ void after(int, FState&) const {}
    } S{Kb, Vb, lds, qb, qw, wid, lane, sel};
    attn_stream<VAR, MobaSrc, true, true, i32x8>(S, NT, st, qr, lds, btab, cfar, wid, lane, r32, hi);
    const float inv = 1.0f / xhalf_sum(st.l);
    store_o_rows(lds + AL_IMP + wid * 8192, (unsigned char*)(p.ws + (VAR ? WS_X1B : WS_AOH)) + (size_t)(rowbase + qw) * 1024 + h * 64, st.o0, st.o1, inv, lane, r32, hi);
}
template <int VAR> __device__ __forceinline__ void phase_moba(const Params& p, LAS unsigned char* lds) {
    for (int pr = blockIdx.x, rnd = 0; pr < 1024; pr += gridDim.x, ++rnd) { const int x = blockIdx.x & 7, s = blockIdx.x >> 3; const int bh = (gridDim.x == 256) ? (x + 8 * (rnd * 8 + (s >> 2))) : (pr >> 2), j = (gridDim.x == 256) ? (s & 3) : (pr & 3);
        moba_unit<VAR>(p, lds, bh >> 4, bh & 15, 7 - j);
        moba_unit<VAR>(p, lds, bh >> 4, bh & 15, j); }
    __syncthreads();
}

__device__ __forceinline__ void nsa_unit(const Params& p, LAS unsigned char* lds, int b, int hkv, int c, bool load_tab, bool load_cmp) {
    const int tid = otid(), lane = tid & 63, r32 = lane & 31, hi = lane >> 5; const int wid = __builtin_amdgcn_readfirstlane(tid >> 6);
    const bf16_t* P = (const bf16_t*)(p.ws + WS_BIG);
    const size_t rowbase = (size_t)b * SEQ; const int g = wid >> 1, qq0 = (wid & 1) * 32, h = hkv * 4 + g, qw = c * 64 + qq0, qpos = qw + r32;
    i32x8 qr;
    const bf16_t* rowp = P + (rowbase + qpos) * NSA_LD;
    { const unsigned char* qp = (const unsigned char*)rowp + h * 64 + hi * 32; qr.lo = *(const i32x4*)(qp); qr.hi = *(const i32x4*)(qp + 16); }
    const float g0 = bf2f(rowp[NSA_G + h * 3]), g1 = bf2f(rowp[NSA_G + h * 3 + 1]), g2 = bf2f(rowp[NSA_G + h * 3 + 2]);
    __syncthreads();
    if (load_tab) { for (int i = tid; i < 4 * BT_H; i += NTHREADS) ((LAS float*)(lds + AL_BIAS))[i] = ((const float*)(p.ws + WS_TAB))[hkv * 4 * BT_H + i]; }
    if (tid < 64) ((LAS unsigned*)(lds + AL_SEL))[tid] = 0u;
    const unsigned char* KS = (const unsigned char*)P + rowbase * (NSA_LD * 2) + NSA_KS * 2 + hkv * 64; const bf16_t* VS = P + rowbase * NSA_LD + NSA_VS + hkv * 64;
    if (load_cmp) { const unsigned char* kc = (const unsigned char*)(p.ws + WS_KCMP) + (size_t)(b * 4 + hkv) * 128 * 64; const bf16_t* vc = (const bf16_t*)(p.ws + WS_VCMP) + (size_t)(b * 4 + hkv) * 128 * 64;
      dma_k8(kc, 64, lds, 0, wid, lane, AL_CMP); dma_k8(kc + 64 * 64, 64, lds, 1, wid, lane, AL_CMP); dma_v(vc, 64, lds, 2, wid, lane, AL_CMP); dma_v(vc + 64 * 64, 64, lds, 3, wid, lane, AL_CMP); }
    dma_k8(KS, NSA_LD * 2, lds, 0, wid, lane); dma_v(VS, NSA_LD, lds, 0, wid, lane);
    asm volatile("s_waitcnt vmcnt(2)" ::: "memory");
    __syncthreads();
    const lds_cptr kp0 = (lds_cptr)lds + AL_CMP + r32 * 64 + hi * 32;
    const lds_cptr vp0 = (lds_cptr)lds + AL_CMP + 16384 + ((lane >> 4) & 1) * 32 + (lane & 3) * 8 + (4 * hi + ((lane & 15) >> 2)) * 64;
    f32x16 cb0, cb1;
    {
        f32x16 s[2][2];
        const int nlim = (qpos >= 31 ? ((qpos - 31) >> 4) + 1 : 0) - 4 * hi;
#pragma unroll
        for (int t = 0; t < 2; ++t) {
#pragma unroll
            for (int r = 0; r < 16; ++r) { s[t][0][r] = 0.f; s[t][1][r] = 0.f; }
            { i32x8 k0, k1; const lds_cptr kp8 = kp0 + t * 8192;
              k0.lo = *(const LAS i32x4*)(kp8); k0.hi = *(const LAS i32x4*)(kp8 + 16); k1.lo = *(const LAS i32x4*)(kp8 + 2048); k1.hi = *(const LAS i32x4*)(kp8 + 2048 + 16);
              s[t][0] = MFMA8(k0, qr, s[t][0]); s[t][1] = MFMA8(k1, qr, s[t][1]);
#pragma unroll
              for (int r = 0; r < 16; ++r) { s[t][0][r] *= QK8_INV; s[t][1][r] *= QK8_INV; } }
#pragma unroll
            for (int n2 = 0; n2 < 2; ++n2)
#pragma unroll
                for (int r = 0; r < 16; ++r) { const int nk = 64 * t + 32 * n2 + (r & 3) + 8 * (r >> 2); if (nk >= nlim) s[t][n2][r] = -INFINITY; }
        }
        const float mx = xhalf_max(__builtin_fmaxf(__builtin_fmaxf(max16(s[0][0]), max16(s[0][1])), __builtin_fmaxf(max16(s[1][0]), max16(s[1][1]))));
        const float mref = (mx == -INFINITY) ? 0.f : mx;
        float rs = 0.f;
#pragma unroll
        for (int t = 0; t < 2; ++t)
#pragma unroll
            for (int n2 = 0; n2 < 2; ++n2)
#pragma unroll
                for (int r = 0; r < 16; ++r) { const float e = __builtin_amdgcn_exp2f(s[t][n2][r] - mref); s[t][n2][r] = e; rs += e; }
        const float lt = xhalf_sum(rs); const float inv = lt > 0.f ? 1.0f / lt : 0.f;
#pragma unroll
        for (int t = 0; t < 2; ++t)
#pragma unroll
            for (int n2 = 0; n2 < 2; ++n2)
#pragma unroll
                for (int r = 0; r < 16; ++r) s[t][n2][r] *= inv;
        float Q[16], T[16];
#pragma unroll
        for (int t = 0; t < 2; ++t)
#pragma unroll
            for (int n2 = 0; n2 < 2; ++n2)
#pragma unroll
                for (int r4 = 0; r4 < 4; ++r4) { const int u = 8 * t + 4 * n2 + r4; Q[u] = (s[t][n2][4 * r4] + s[t][n2][4 * r4 + 1]) + (s[t][n2][4 * r4 + 2] + s[t][n2][4 * r4 + 3]); T[u] = s[t][n2][4 * r4 + 3]; }
        LAS float* imp = (LAS float*)(lds + AL_IMP) + (g * 64 + qq0 + r32) * 33;
        float prev = 0.f;
#pragma unroll
        for (int u = 0; u < 16; ++u) { const float rcv = __shfl_xor(T[u], 32); const float add = hi ? rcv : prev; prev = rcv; imp[2 * u + hi] = Q[u] + add; }
        f32x16 o0, o1;
#pragma unroll
        for (int r = 0; r < 16; ++r) { o0[r] = 0.f; o1[r] = 0.f; }
        pv_tile(o0, o1, s[0][0], s[0][1], vp0); pv_tile(o0, o1, s[1][0], s[1][1], vp0 + 8192);
#pragma unroll
        for (int r = 0; r < 16; ++r) { cb0[r] = g0 * o0[r]; cb1[r] = g0 * o1[r]; }
    }
    __syncthreads();
    {
        const int q = tid >> 3, jg = tid & 7; const LAS float* ib = (const LAS float*)(lds + AL_IMP) + q * 33;
        float val[32];
#pragma unroll
        for (int j = 0; j < 32; ++j) { float v = (ib[j] + ib[64 * 33 + j]) + (ib[2 * 64 * 33 + j] + ib[3 * 64 * 33 + j]);
            const bool forced = (j == 0) || (j == c) || (j == c - 1); v = forced ? INFINITY : v; val[j] = (j > c) ? -INFINITY : v; }
        unsigned bits = 0;
#pragma unroll
        for (int i = 0; i < 4; ++i) { const int j = jg * 4 + i; float vj = 0.f;
#pragma unroll
            for (int jj = 0; jj < 32; ++jj) vj = (jj == j) ? val[jj] : vj;
            int rank = 0;
#pragma unroll
            for (int jj = 0; jj < 32; ++jj) rank += (val[jj] > vj || (val[jj] == vj && jj < j)) ? 1 : 0;
            if (j <= c && rank < 16) bits |= 1u << j; }
        if (bits) atomicOr((unsigned*)(lds + AL_SEL) + q, bits);
    }
    __syncthreads();
    unsigned uni = ((const LAS unsigned*)(lds + AL_SEL))[lane];
#pragma unroll
    for (int o = 32; o > 0; o >>= 1) uni |= (unsigned)__shfl_xor((int)uni, o);
    uni = (unsigned)__builtin_amdgcn_readfirstlane((int)uni);
    const unsigned rowmask = ((const LAS unsigned*)(lds + AL_SEL))[qq0 + r32];
    const LAS float* btab = (const LAS float*)(lds + AL_BIAS) + g * BT_H; const float cfar = btab[0];
    const unsigned char* KW = (const unsigned char*)P + rowbase * (NSA_LD * 2) + NSA_KW * 2 + hkv * 64; const bf16_t* VW = P + rowbase * NSA_LD + NSA_VW + hkv * 64;
    const int nslc = __builtin_popcount(uni); const int wlo = c >= 8 ? 0 : 8 - c; const int NT = nslc + (9 - wlo);
    LAS int* list = (LAS int*)(lds + AL_LIST);
    if (tid < 32) { if ((uni >> tid) & 1u) list[__builtin_popcount(uni & ((1u << tid) - 1u))] = tid; }
    else if (tid < 32 + 9 - wlo) list[nslc + (tid - 32)] = 64 + (c - 8 + wlo + (tid - 32));
    __syncthreads();
    FState st; fstate_reset(st);
    struct NsaSrc {
        const unsigned char* KS; const bf16_t* VS; const unsigned char* KW; const bf16_t* VW; LAS unsigned char* lds; const LAS int* list; int nslc, qw, wid, lane; unsigned rowmask; float g1; f32x16* cb0; f32x16* cb1; int pre_d, pre_p;
        __device__ __forceinline__ void prefetch(int t) { pre_d = list[t + 3]; pre_p = list[t + 1]; }
        __device__ __forceinline__ void dma_pre(int, int ks, int vs) const { const int e = __builtin_amdgcn_readfirstlane(pre_d);
            if (e < 64) { dma_k8(KS + (size_t)e * 64 * (NSA_LD * 2), NSA_LD * 2, lds, ks, wid, lane); dma_v(VS + (size_t)e * 64 * NSA_LD, NSA_LD, lds, vs, wid, lane); }
            else { dma_k8(KW + (size_t)(e - 64) * 64 * (NSA_LD * 2), NSA_LD * 2, lds, ks, wid, lane); dma_v(VW + (size_t)(e - 64) * 64 * NSA_LD, NSA_LD, lds, vs, wid, lane); } }
        __device__ __forceinline__ void dma(int t, int ks, int vs) const { const int e = __builtin_amdgcn_readfirstlane(list[t]);
            if (e < 64) { dma_k8(KS + (size_t)e * 64 * (NSA_LD * 2), NSA_LD * 2, lds, ks, wid, lane); dma_v(VS + (size_t)e * 64 * NSA_LD, NSA_LD, lds, vs, wid, lane); }
            else { dma_k8(KW + (size_t)(e - 64) * 64 * (NSA_LD * 2), NSA_LD * 2, lds, ks, wid, lane); dma_v(VW + (size_t)(e - 64) * 64 * NSA_LD, NSA_LD, lds, vs, wid, lane); } }
        __device__ __forceinline__ TileP params(int) const { const int e = __builtin_amdgcn_readfirstlane(pre_p); TileP tp;
            if (e < 64) { tp.Dmin = qw - 64 * e; tp.rowok = (rowmask >> e) & 1u; tp.run = __any(tp.rowok); tp.win = false; }
            else { tp.Dmin = qw - 64 * (e - 64); tp.rowok = true; tp.run = true; tp.win = true; }
            return tp; }
        __device__ __forceinline__ void after(int t, FState& st) const {
            if (t == nslc - 1) { const float f = g1 / xhalf_sum(st.l);
#pragma unroll
                for (int r = 0; r < 16; ++r) { (*cb0)[r] += f * st.o0[r]; (*cb1)[r] += f * st.o1[r]; }
                fstate_reset(st); } }
    } S{KS, VS, KW, VW, lds, list, nslc, qw, wid, lane, rowmask, g1, &cb0, &cb1, 0, 0};
    S.dma(1, 1, 1);
    attn_stream<0, NsaSrc, true, true, i32x8>(S, NT, st, qr, lds, btab, cfar, wid, lane, r32, hi);
    { const float f = g2 / xhalf_sum(st.l);
#pragma unroll
      for (int r = 0; r < 16; ++r) { cb0[r] += f * st.o0[r]; cb1[r] += f * st.o1[r]; } }
    store_o_rows(lds + AL_IMP + wid * 4096, (unsigned char*)(p.ws + WS_AOH) + (size_t)(rowbase + qw) * 1024 + h * 64, cb0, cb1, 1.0f, lane, r32, hi);
}
__device__ __forceinline__ void phase_nsa(const Params& p, LAS unsigned char* lds) {
    int last_hkv = -1;
    for (int pr = blockIdx.x, rnd = 0; pr < 1024; pr += gridDim.x, ++rnd) { const int x = blockIdx.x & 7, s = blockIdx.x >> 3; const int bh = (gridDim.x == 256) ? (x + 8 * (rnd * 2 + (s >> 4))) : (pr >> 4), j = (gridDim.x == 256) ? ((s + 4 * rnd) & 15) : (pr & 15);
        nsa_unit(p, lds, bh >> 2, bh & 3, 31 - j, (bh & 3) != last_hkv, true);
        nsa_unit(p, lds, bh >> 2, bh & 3, j, false, false); last_hkv = bh & 3; }
    __syncthreads();
}

template <int L> __device__ __forceinline__ void phase_ln1(const Params& p, LAS unsigned char* lds) {
    const int tid = otid(), lane = tid & 63, wid = tid >> 6, r = lane & 15, q = lane >> 4;
    const float* lg = p.ln_g + (L * 2 + 0) * 1024; const float* lb = p.ln_b + (L * 2 + 0) * 1024;
    const bf16_t* Y = (const bf16_t*)(p.ws + WS_BIG); bf16_t* X1 = (bf16_t*)(p.ws + WS_X1B);
    for (int i = tid; i < 32 * 2 * 64; i += NTHREADS) { const int l2 = i & 63, nb = (i >> 6) & 1, s = i >> 7; const int e = 16 * nb + (l2 & 15), k0 = 32 * s + 8 * (l2 >> 4);
        float w[8]; unsigned hw[4], lw[4];
#pragma unroll
        for (int j = 0; j < 8; ++j) w[j] = p.router_w[(size_t)(k0 + j) * 32 + e];
#pragma unroll
        for (int j = 0; j < 4; ++j) { hw[j] = cvt_pk_bf16(w[2 * j], w[2 * j + 1]); lw[j] = cvt_pk_bf16(w[2 * j] - lo_bf(hw[j]), w[2 * j + 1] - hi_bf(hw[j])); }
        *(LAS u32x4*)(lds + ((size_t)((s * 2 + nb) * 2 + 0) * 64 + l2) * 16) = (u32x4){hw[0], hw[1], hw[2], hw[3]};
        *(LAS u32x4*)(lds + ((size_t)((s * 2 + nb) * 2 + 1) * 64 + l2) * 16) = (u32x4){lw[0], lw[1], lw[2], lw[3]}; }
    LAS int* hist = (LAS int*)(lds + 131072 + 8 * 2048);
    if (tid < 32) hist[tid] = 0;
    __syncthreads();
    for (int tb = blockIdx.x; tb < NTOK / 128; tb += gridDim.x) {
        const int tok = tb * 128 + wid * 16 + r;
        const bf16_t* yp = Y + (size_t)tok * 1024 + 8 * q;
        float sum = 0.f, sq = 0.f;
#pragma unroll 16
        for (int s = 0; s < 32; ++s) { const u32x4 y = *(const u32x4*)(yp + 32 * s); const unsigned yw[4] = {y.x, y.y, y.z, y.w};
#pragma unroll
            for (int j = 0; j < 4; ++j) { const float a = lo_bf(yw[j]), b2 = hi_bf(yw[j]); sum += a + b2; sq += a * a + b2 * b2; } }
        sum += __shfl_xor(sum, 16); sum += __shfl_xor(sum, 32); sq += __shfl_xor(sq, 16); sq += __shfl_xor(sq, 32);
        const float mu = sum * (1.0f / 1024.0f);
        const float rstd = rsqrtf(fmaxf(sq * (1.0f / 1024.0f) - mu * mu, 0.f) + 1e-5f);
        f32x4 acc0 = (f32x4){0.f, 0.f, 0.f, 0.f}, acc1 = acc0;
        bf16_t* xp = X1 + (size_t)tok * 1024 + 8 * q; unsigned char* xq = (unsigned char*)(p.ws + WS_X1Q) + (size_t)tok * 1024 + 8 * q;
#pragma unroll 4
        for (int s = 0; s < 32; ++s) {
            const u32x4 y = *(const u32x4*)(yp + 32 * s);
            const f32x4 ga = *(const f32x4*)(lg + 32 * s + 8 * q), gb = *(const f32x4*)(lg + 32 * s + 8 * q + 4), ba = *(const f32x4*)(lb + 32 * s + 8 * q), bb = *(const f32x4*)(lb + 32 * s + 8 * q + 4);
            u32x4 w;
            const float x0 = (lo_bf(y.x) - mu) * rstd * ga[0] + ba[0], x1 = (hi_bf(y.x) - mu) * rstd * ga[1] + ba[1], x2 = (lo_bf(y.y) - mu) * rstd * ga[2] + ba[2], x3 = (hi_bf(y.y) - mu) * rstd * ga[3] + ba[3];
            const float x4 = (lo_bf(y.z) - mu) * rstd * gb[0] + bb[0], x5 = (hi_bf(y.z) - mu) * rstd * gb[1] + bb[1], x6 = (lo_bf(y.w) - mu) * rstd * gb[2] + bb[2], x7 = (hi_bf(y.w) - mu) * rstd * gb[3] + bb[3];
            w.x = cvt_pk_bf16(x0, x1); w.y = cvt_pk_bf16(x2, x3); w.z = cvt_pk_bf16(x4, x5); w.w = cvt_pk_bf16(x6, x7);
            *(u32x4*)(xp + 32 * s) = w;
            { u32x2 w8; w8.x = cvt4_fp8(x0 * F8_SX, x1 * F8_SX, x2 * F8_SX, x3 * F8_SX); w8.y = cvt4_fp8(x4 * F8_SX, x5 * F8_SX, x6 * F8_SX, x7 * F8_SX); *(u32x2*)(xq + 32 * s) = w8; }
            const bf16x8 af = __builtin_bit_cast(bf16x8, w);
            const LAS unsigned char* bq = lds + (size_t)s * 4096 + lane * 16;
            const bf16x8 b0h = *(const LAS bf16x8*)(bq), b0l = *(const LAS bf16x8*)(bq + 1024), b1h = *(const LAS bf16x8*)(bq + 2048), b1l = *(const LAS bf16x8*)(bq + 3072);
            acc0 = __builtin_amdgcn_mfma_f32_16x16x32_bf16(af, b0h, acc0, 0, 0, 0); acc0 = __builtin_amdgcn_mfma_f32_16x16x32_bf16(af, b0l, acc0, 0, 0, 0);
            acc1 = __builtin_amdgcn_mfma_f32_16x16x32_bf16(af, b1h, acc1, 0, 0, 0); acc1 = __builtin_amdgcn_mfma_f32_16x16x32_bf16(af, b1l, acc1, 0, 0, 0);
        }
        LAS float* lg2 = (LAS float*)(lds + 131072 + wid * 2048);
#pragma unroll
        for (int i = 0; i < 4; ++i) { lg2[(4 * q + i) * 32 + r] = acc0[i] + p.router_b[r]; lg2[(4 * q + i) * 32 + 16 + r] = acc1[i] + p.router_b[16 + r]; }
        asm volatile("s_waitcnt lgkmcnt(0)" ::: "memory");
        int e0 = 0, e1 = 0, r0 = 0, r1 = 0; float w0 = 0.f, w1 = 0.f;
        if (lane < 16) {
            float pr[32]; float mx = -INFINITY;
#pragma unroll
            for (int e = 0; e < 32; ++e) { pr[e] = lg2[lane * 32 + e]; mx = fmaxf(mx, pr[e]); }
#pragma unroll
            for (int e = 0; e < 32; ++e) pr[e] = __expf(pr[e] - mx);
            int best = 0; float bs = -1.f;
#pragma unroll
            for (int gi = 0; gi < 8; ++gi) { const float a = pr[4 * gi], b2 = pr[4 * gi + 1], c2 = pr[4 * gi + 2], d2 = pr[4 * gi + 3];
                const float h1 = fmaxf(a, b2), l1 = fminf(a, b2), h2 = fmaxf(c2, d2), l2 = fminf(c2, d2);
                const float m1 = fmaxf(h1, h2), m2 = fmaxf(fminf(h1, h2), fmaxf(l1, l2));
                const float sc = m1 + m2; if (sc > bs) { bs = sc; best = gi; } }
            float v[4];
#pragma unroll
            for (int gi = 0; gi < 8; ++gi) if (gi == best) { v[0] = pr[4 * gi]; v[1] = pr[4 * gi + 1]; v[2] = pr[4 * gi + 2]; v[3] = pr[4 * gi + 3]; }
            int i0 = 0; float v0 = v[0];
#pragma unroll
            for (int i = 1; i < 4; ++i) if (v[i] > v0) { v0 = v[i]; i0 = i; }
            int i1 = -1; float v1 = -1.f;
#pragma unroll
            for (int i = 0; i < 4; ++i) if (i != i0 && v[i] > v1) { v1 = v[i]; i1 = i; }
            e0 = best * 4 + i0; e1 = best * 4 + i1; const float ws = 1.0f / (v0 + v1); w0 = v0 * ws; w1 = v1 * ws;
            r0 = atomicAdd((int*)hist + e0, 1); r1 = atomicAdd((int*)hist + e1, 1);
        }
        __syncthreads();
        if (tid < 32) { const int hv = hist[tid]; hist[32 + tid] = hv ? atomicAdd((int*)(p.ws + WS_GCNT) + L * 32 + tid, hv) : 0; }
        __syncthreads();
        if (lane < 16) { const int t2 = tb * 128 + wid * 16 + lane; const int s0 = hist[32 + e0] + r0, s1 = hist[32 + e1] + r1;
            ((int*)(p.ws + WS_RE))[t2 * 2] = e0; ((int*)(p.ws + WS_RE))[t2 * 2 + 1] = e1;
            ((float*)(p.ws + WS_RWT))[t2 * 2] = w0 * (1.0f / F8_SY); ((float*)(p.ws + WS_RWT))[t2 * 2 + 1] = w1 * (1.0f / F8_SY);
            ((int*)(p.ws + WS_POS))[t2 * 2] = s0; ((int*)(p.ws + WS_POS))[t2 * 2 + 1] = s1;
            ((int*)(p.ws + WS_ROWTOK))[e0 * 65536 + s0] = t2; ((int*)(p.ws + WS_ROWTOK))[e1 * 65536 + s1] = t2; }
        __syncthreads();
        if (tid < 32) hist[tid] = 0;
        __syncthreads();
    }
}

template <int L> __device__ __forceinline__ void phase_ln2(const Params& p, LAS unsigned char* lds) {
    const int tid = otid(), lane = tid & 63, wid = tid >> 6;
    LAS int* pst = (LAS int*)lds;
    __syncthreads();
    if (tid == 0) { const int* cnt = (const int*)(p.ws + WS_GCNT) + L * 32; int s = 0; for (int e = 0; e < NEXP; ++e) { pst[e] = s; s += (cnt[e] + 255) & ~255; } }
    __syncthreads();
    const int* RE = (const int*)(p.ws + WS_RE);
    const float* lg = p.ln_g + (L * 2 + 1) * 1024; const float* lb = p.ln_b + (L * 2 + 1) * 1024;
    const bf16_t* X1 = (const bf16_t*)(p.ws + WS_X1B); const unsigned char* YB = (const unsigned char*)(p.ws + WS_BIG);
    const int* POS = (const int*)(p.ws + WS_POS); const float* RW = (const float*)(p.ws + WS_RWT);
    const int tok0 = blockIdx.x * 8 + wid, tstride = gridDim.x * 8, nk = (NTOK - tok0 + tstride - 1) / tstride;
    int rs0 = 0, rs1 = 0; float rw0 = 0.f, rw1 = 0.f;
    if (lane < nk && lane < 16) { const int t = tok0 + lane * tstride; rs0 = pst[RE[t * 2]] + POS[t * 2]; rs1 = pst[RE[t * 2 + 1]] + POS[t * 2 + 1]; rw0 = RW[t * 2]; rw1 = RW[t * 2 + 1]; }
    u32x4 ra[2][2]; u32x2 rb[2][2], rc[2][2];
#define LN2_LOAD(k, buf) do { const int t_ = tok0 + (k) * tstride; const int s0_ = __shfl(rs0, (k)), s1_ = __shfl(rs1, (k)); _Pragma("unroll") for (int hf = 0; hf < 2; ++hf) { const int c0 = hf * 512 + lane * 8; \
        ra[buf][hf] = __builtin_nontemporal_load((const u32x4*)(X1 + (size_t)t_ * 1024 + c0)); rb[buf][hf] = __builtin_nontemporal_load((const u32x2*)(YB + (size_t)s0_ * 1024 + c0)); rc[buf][hf] = __builtin_nontemporal_load((const u32x2*)(YB + (size_t)s1_ * 1024 + c0)); } } while (0)
    if (nk > 0) LN2_LOAD(0, 0);
#pragma unroll
    for (int k = 0; k < 16; ++k) {
        if (k < nk) {
            const int tok = tok0 + k * tstride; const float w0 = __shfl(rw0, k), w1 = __shfl(rw1, k);
            if (k + 1 < nk) LN2_LOAD(k + 1, (k + 1) & 1);
            float v[16];
#pragma unroll
            for (int hf = 0; hf < 2; ++hf) { const u32x4 a = ra[k & 1][hf]; const u32x2 b = rb[k & 1][hf], c = rc[k & 1][hf];
                const unsigned aw[4] = {a.x, a.y, a.z, a.w}, bw[2] = {b.x, b.y}, cw[2] = {c.x, c.y};
#pragma unroll
                for (int j = 0; j < 4; ++j) { const f32x2 yb = (j & 1) ? __builtin_amdgcn_cvt_pk_f32_fp8((int)bw[j >> 1], true) : __builtin_amdgcn_cvt_pk_f32_fp8((int)bw[j >> 1], false);
                    const f32x2 yc = (j & 1) ? __builtin_amdgcn_cvt_pk_f32_fp8((int)cw[j >> 1], true) : __builtin_amdgcn_cvt_pk_f32_fp8((int)cw[j >> 1], false);
                    v[hf * 8 + 2 * j] = ALPHA * lo_bf(aw[j]) + w0 * yb[0] + w1 * yc[0]; v[hf * 8 + 2 * j + 1] = ALPHA * hi_bf(aw[j]) + w0 * yb[1] + w1 * yc[1]; } }
            float s = 0.f;
#pragma unroll
            for (int i = 0; i < 16; ++i) s += v[i];
            const float mu = wave_sum(s) * (1.0f / 1024.0f);
            float qv = 0.f;
#pragma unroll
            for (int i = 0; i < 16; ++i) { const float d = v[i] - mu; qv += d * d; }
            const float rstd = rsqrtf(wave_sum(qv) * (1.0f / 1024.0f) + 1e-5f);
#pragma unroll
            for (int hf = 0; hf < 2; ++hf) { const int c0 = hf * 512 + lane * 8; float o[8];
                const f32x4 ga = *(const f32x4*)(lg + c0), gb = *(const f32x4*)(lg + c0 + 4), ba = *(const f32x4*)(lb + c0), bb = *(const f32x4*)(lb + c0 + 4);
#pragma unroll
                for (int j = 0; j < 4; ++j) { o[j] = (v[hf * 8 + j] - mu) * rstd * ga[j] + ba[j]; o[4 + j] = (v[hf * 8 + 4 + j] - mu) * rstd * gb[j] + bb[j]; }
                if (L == 1) { __builtin_nontemporal_store((f32x4){o[0], o[1], o[2], o[3]}, (f32x4*)(p.out + (size_t)tok * 1024 + c0)); __builtin_nontemporal_store((f32x4){o[4], o[5], o[6], o[7]}, (f32x4*)(p.out + (size_t)tok * 1024 + c0 + 4)); }
                else { u32x4 w; w.x = cvt_pk_bf16(o[0], o[1]); w.y = cvt_pk_bf16(o[2], o[3]); w.z = cvt_pk_bf16(o[4], o[5]); w.w = cvt_pk_bf16(o[6], o[7]); *(u32x4*)((bf16_t*)(p.ws + WS_XB) + (size_t)tok * 1024 + c0) = w;
                    u32x2 w8; w8.x = cvt4_i8(o[0] * I8_SX, o[1] * I8_SX, o[2] * I8_SX, o[3] * I8_SX); w8.y = cvt4_i8(o[4] * I8_SX, o[5] * I8_SX, o[6] * I8_SX, o[7] * I8_SX);
                    *(u32x2*)((unsigned char*)(p.ws + WS_X1Q) + (size_t)tok * 1024 + c0) = w8; } }
        }
    }
#undef LN2_LOAD
}

__device__ __forceinline__ void phase_cmpfin(const Params& p, LAS unsigned char* lds) {
    const int tid = otid(), lane = tid & 63, wid = tid >> 6;
    LAS float* w2s = (LAS float*)lds;
    LAS float* hs = (LAS float*)(lds + 65536) + wid * 1024;
    LAS float* b1s = (LAS float*)(lds + 65536 + 32768);
    const float* CP = (const float*)(p.ws + WS_X1B); const float* B1 = (const float*)(p.ws + WS_B1);
    for (int kv = 0; kv < 2; ++kv) {
        __syncthreads();
        { const float* w2g = kv ? p.cv_w2 : p.ck_w2; for (int i = tid; i < 256 * 64; i += NTHREADS) w2s[i] = w2g[i]; }
        if (tid < 256) { float b1 = 0.f;
#pragma unroll 8
            for (int pt = 0; pt < 32; ++pt) b1 += B1[(kv * 32 + pt) * 256 + tid];
            b1s[tid] = b1; }
        __syncthreads();
        bf16_t* dst = (bf16_t*)(p.ws + (kv ? WS_VCMP : WS_KCMP));
        for (int rg = blockIdx.x * 8 + wid; rg < 8192 / 4; rg += gridDim.x * 8) {
            const int m0 = rg * 4;
#pragma unroll
            for (int i = 0; i < 4; ++i) { const int j = lane + 64 * i; const float b1 = b1s[j];
                f32x4 hv;
#pragma unroll
                for (int rr = 0; rr < 4; ++rr) { float a = b1;
#pragma unroll
                    for (int ks = 0; ks < 2; ++ks) a += __builtin_nontemporal_load(CP + ((size_t)(kv * 2 + ks) * 8192 + m0 + rr) * 256 + j);
                    const float u = 0.7978845608028654f * (a + 0.044715f * a * a * a); const float th = 1.0f - 2.0f / (1.0f + __expf(2.0f * u));
                    hv[rr] = 0.5f * a * (1.0f + th); }
                *(LAS f32x4*)(hs + j * 4) = hv; }
            asm volatile("s_waitcnt lgkmcnt(0)" ::: "memory");
            f32x4 o = (f32x4){0.f, 0.f, 0.f, 0.f}; const LAS float* w2 = w2s + lane;
#pragma unroll 8
            for (int j = 0; j < 256; ++j) o += *(const LAS f32x4*)(hs + j * 4) * w2[j * 64];
#pragma unroll
            for (int rr = 0; rr < 4; ++rr) { const float ov = (((m0 + rr) & 127) == 127) ? 0.f : o[rr];
                if (kv) dst[(size_t)(m0 + rr) * 64 + lane] = f2bf(ov);
                else ((unsigned char*)dst)[(size_t)(m0 + rr) * 64 + lane] = (unsigned char)(cvt4_fp8(ov * QK8_SK, 0.f, 0.f, 0.f) & 0xffu); }
            asm volatile("s_waitcnt lgkmcnt(0)" ::: "memory");
        }
    }
}

constexpr int NPHASE = 19;
template <int PH> __device__ __forceinline__ void run_phase(const Params& p, LAS unsigned char* lds) {
    char* ws = p.ws;
    if constexpr (PH == 0) phase_prologue(p, lds);
    else if constexpr (PH == 1) { SchedPlainI8 S; S.init(ws + WS_X1Q, ws + WS_WQKV0, NTOK, 3072, 512); EpiQKV0 E{(bf16_t*)(ws + WS_BIG), (float*)(ws + WS_KPART)}; pg8::gemm_phase(lds, S, E); }
    else if constexpr (PH == 2) phase_moba<0>(p, lds);
    else if constexpr (PH == 3) { SchedPlainF8 S; S.init(ws + WS_AOH, ws + WS_WO0, NTOK, 1024, 512); EpiRes<false, true> E{(bf16_t*)(ws + WS_BIG), nullptr, (const bf16_t*)(ws + WS_XB)}; pg8::gemm_phase(lds, S, E); }
    else if constexpr (PH == 4) phase_ln1<0>(p, lds);
    else if constexpr (PH == 6 || PH == 16) { SchedMoeGU S; S.init(ws, PH == 16, lds); EpiGU E{(unsigned char*)(ws + WS_AOH)}; pg8::gemm_phase(lds, S, E);
        {
            const int rem = (S.nM * 4) % (int)gridDim.x, nidle = (int)gridDim.x - rem; const bool useidle = (rem > 0 && nidle * 2 >= (int)gridDim.x);
            const int cgw = useidle ? ((int)blockIdx.x - rem) * 8 + (otid() >> 6) : (int)blockIdx.x * 8 + (otid() >> 6), cng = (useidle ? nidle : (int)gridDim.x) * 8;
            __syncthreads();
            if (!useidle || (int)blockIdx.x >= rem) {
                if constexpr (PH == 6) conv_moe_stream(p, 1, 0, 0, lds, cgw, cng, 0, GU1_P6);
                else conv_moe_stream(p, 1, 1, DN1_OFF, lds, cgw, cng); } } }
    else if constexpr (PH == 7 || PH == 17) { SchedMoeDN S; S.init(ws, PH == 17, lds); EpiDN E{(unsigned char*)(ws + WS_BIG)}; pg8::gemm_phase(lds, S, E);
        if constexpr (PH == 7) {
            const int rem = (S.nM * 4) % (int)gridDim.x, nidle = (int)gridDim.x - rem; const bool useidle = (rem > 0 && nidle * 2 >= (int)gridDim.x);
            __syncthreads();
            if (!useidle) conv_moe_stream(p, 1, 0, 0, lds, (int)blockIdx.x * 8 + (otid() >> 6), (int)gridDim.x * 8, GU1_P6, GU1_EARLY);
            else if ((int)blockIdx.x >= rem) conv_moe_stream(p, 1, 0, 0, lds, ((int)blockIdx.x - rem) * 8 + (otid() >> 6), nidle * 8, GU1_P6, GU1_EARLY); } }
    else if constexpr (PH == 8) { phase_ln2<0>(p, lds); __syncthreads(); conv_moe_stream(p, 1, 0, 0, lds, (int)blockIdx.x * 8 + (otid() >> 6), (int)gridDim.x * 8, GU1_EARLY); }
    else if constexpr (PH == 9) {
        { SchedNsaProjI8 S; S.init(ws + WS_X1Q, ws + WS_WIN1, NTOK, 2816, 512); S.bcnt = (unsigned*)(ws + WS_BCNT); EpiNSA E{(bf16_t*)(ws + WS_BIG)}; pg8::gemm_phase(lds, S, E); }
        { SchedCmp S; S.init(ws); EpiCmp E{(float*)(ws + WS_X1B)}; pg8::gemm_phase(lds, S, E); } }
    else if constexpr (PH == 11) phase_cmpfin(p, lds);
    else if constexpr (PH == 12) phase_nsa(p, lds);
    else if constexpr (PH == 13) { SchedPlainF8 S; S.init(ws + WS_AOH, ws + WS_WO1, NTOK, 1024, 512); EpiRes<false, true> E{(bf16_t*)(ws + WS_BIG), nullptr, (const bf16_t*)(ws + WS_XB)}; pg8::gemm_phase(lds, S, E); }
    else if constexpr (PH == 14) phase_ln1<1>(p, lds);
    else if constexpr (PH == 18) phase_ln2<1>(p, lds);
}

extern __shared__ __attribute__((aligned(16))) unsigned char g_smem[];

template <int PH> __global__ void __launch_bounds__(NTHREADS, 2) k_phase(Params p) {
    run_phase<PH>(p, (LAS unsigned char*)g_smem);
}

#if !MK_LAUNCHES
template <int PH> __device__ __forceinline__ void mega_seq(const Params& p, LAS unsigned char* lds, const XcdBarrier& bar) {
    if constexpr (PH == 5 || PH == 15 || PH == 10) { mega_seq<PH + 1>(p, lds, bar); return; }
    run_phase<PH>(p, lds);
#ifdef PROBE_VAR
    if constexpr (PH == 2) { xcd_barrier(bar); phase_moba<PROBE_VAR>(p, lds); }
#endif
#ifdef PROBE_BAR
    if constexpr (PH == 3) { for (int i = 0; i < 16; ++i) xcd_barrier(bar); }
#endif
#ifdef PROBE_GEMM_NULL
    if constexpr (PH == 1) { xcd_barrier(bar); SchedPlain S; S.init(p.ws + WS_XB, p.ws + WS_WQKV0, NTOK, 3072, 1024); EpiNull E{(float*)(p.ws + WS_X1B)}; pg8::gemm_phase(lds, S, E); }
#endif
#ifdef PROBE_MASK
    if constexpr ((PROBE_MASK >> PH) & 1) { xcd_barrier(bar); run_phase<PH>(p, lds); }
#endif
    if constexpr (PH + 1 < NPHASE) { xcd_barrier(bar); mega_seq<PH + 1>(p, lds, bar); }
}
__global__ void __launch_bounds__(NTHREADS, 2) k_mega(Params p) {
    LAS unsigned char* lds = (LAS unsigned char*)g_smem;
    LAS unsigned* stw = (LAS unsigned*)(lds + LDS_BYTES - 16);
    if (threadIdx.x == 0) { stw[0] = 0u; stw[1] = 0u; stw[2] = 0u; stw[3] = 0u; }
    __syncthreads();
    XcdBarrier bar = xcd_barrier_post((unsigned*)(p.ws + WS_CTL), (volatile LAS unsigned*)stw);
    mega_seq<0>(p, lds, bar);
}

#endif
template <int PH> static void launch_phases(const Params& p, int grid, hipStream_t stream) {
    hipFuncSetAttribute((const void*)k_phase<PH>, hipFuncAttributeMaxDynamicSharedMemorySize, LDS_BYTES);
    hipLaunchKernelGGL(k_phase<PH>, dim3(grid), dim3(NTHREADS), LDS_BYTES, stream, p);
    if constexpr (PH + 1 < NPHASE) launch_phases<PH + 1>(p, grid, stream);
}

extern "C" void kernel_launch(void* const* d_in, const int* in_sizes, int n_in, void* d_out, int out_size, void* d_ws, size_t ws_size, hipStream_t stream) {
    if (n_in != 19 || ws_size < WS_END) { fprintf(stderr, "kernel_launch: need 19 inputs and %zu bytes of workspace (got %d, %zu)\n", (size_t)WS_END, n_in, ws_size); return; }
    Params p{};
    p.x = (const float*)d_in[0]; p.rel_bias = (const float*)d_in[1]; p.router_w = (const float*)d_in[2]; p.router_b = (const float*)d_in[3];
    p.ln_g = (const float*)d_in[4]; p.ln_b = (const float*)d_in[5]; p.moba_w_in = (const float*)d_in[6]; p.moba_w_out = (const float*)d_in[7];
    p.nsa_w_in = (const float*)d_in[8]; p.nsa_w_out = (const float*)d_in[9]; p.pos_k = (const float*)d_in[10]; p.pos_v = (const float*)d_in[11];
    p.ck_w1 = (const float*)d_in[12]; p.ck_w2 = (const float*)d_in[13]; p.cv_w1 = (const float*)d_in[14]; p.cv_w2 = (const float*)d_in[15];
    p.w_gate = (const float*)d_in[16]; p.w_up = (const float*)d_in[17]; p.w_down = (const float*)d_in[18];
    p.out = (float*)d_out; p.ws = (char*)d_ws;
    const int grid = NWG_EXPECT;
#if MK_LAUNCHES
    launch_phases<0>(p, grid, stream);
#else
    hipFuncSetAttribute((const void*)k_mega, hipFuncAttributeMaxDynamicSharedMemorySize, LDS_BYTES);
    hipMemsetAsync((char*)d_ws + WS_CTL, 0, 16384, stream);
    hipLaunchKernelGGL(k_mega, dim3(grid), dim3(NTHREADS), LDS_BYTES, stream, p);
#endif
}
```

```cpp
#include <hip/hip_runtime.h>
#include <cstdio>
#include <cstdint>

#ifndef MK_LAUNCHES
#define MK_LAUNCHES 0
#endif

#define LAS __attribute__((address_space(3)))
typedef unsigned short bf16_t;
typedef short bf16x8 __attribute__((ext_vector_type(8)));
typedef short s16x4 __attribute__((ext_vector_type(4)));
typedef short v4i16_t __attribute__((ext_vector_type(4)));
typedef float f32x4 __attribute__((ext_vector_type(4)));
typedef float f32x16 __attribute__((ext_vector_type(16)));
typedef unsigned u32x4 __attribute__((ext_vector_type(4)));
typedef unsigned u32x2 __attribute__((ext_vector_type(2)));
typedef float f32x2 __attribute__((ext_vector_type(2)));
typedef int i32x4 __attribute__((ext_vector_type(4)));
typedef int i32x8 __attribute__((ext_vector_type(8)));
typedef LAS const char* lds_cptr;

constexpr int NTOK = 32768, DM = 1024, SEQ = 2048, NBATCH = 16, NHEAD = 16;
constexpr int QKV_LD = 3072, NSA_LD = 2816;
constexpr int NSA_KC = 1024, NSA_VC = 1280, NSA_KS = 1536, NSA_VS = 1792, NSA_KW = 2048, NSA_VW = 2304, NSA_G = 2560;
constexpr int NEXP = 32, DEXP = 512, MAXPAN = 288, RPAD = MAXPAN * 256;
constexpr int NTHREADS = 512, NWG_EXPECT = 256;
constexpr int LDS_BYTES = 155648;
constexpr float LOG2E = 1.4426950408889634f;
constexpr float C2 = 0.125f * LOG2E;
constexpr float ALPHA = 1.4142135623730951f;
constexpr int BT_N = 288;
constexpr int BT_S = 292, BT_H = 4 * BT_S;

constexpr size_t al256(size_t x) { return (x + 255) & ~(size_t)255; }
constexpr size_t WS_CTL = 0;
constexpr size_t WS_BCNT = 14592;
constexpr size_t WS_GCNT = 14336;
constexpr size_t WS_TAB = 16384;
constexpr size_t WS_B1 = WS_TAB + al256(16 * BT_H * 4);
constexpr size_t WS_NPAN = WS_B1 + 65536;
constexpr size_t WS_PANEL = WS_NPAN + 256;
constexpr size_t WS_HIST = WS_PANEL + 1280;
constexpr size_t WS_KPART = WS_HIST + 32768;
constexpr size_t WS_RE = WS_KPART + 128 * 2 * 1024 * 4;
constexpr size_t WS_RWT = WS_RE + (size_t)NTOK * 8;
constexpr size_t WS_POS = WS_RWT + (size_t)NTOK * 8;
constexpr size_t WS_ROWTOK = WS_POS + (size_t)NTOK * 8;
constexpr size_t WS_KCMP = WS_ROWTOK + (size_t)32 * 65536 * 4;
constexpr size_t WS_VCMP = WS_KCMP + 16 * 4 * 128 * 64 * 2;
constexpr size_t WS_WQKV0 = WS_VCMP + 16 * 4 * 128 * 64 * 2;
constexpr size_t WS_WO0 = WS_WQKV0 + (size_t)3072 * 1024 * 2;
constexpr size_t WS_WIN1 = WS_WO0 + (size_t)1024 * 1024 * 2;
constexpr size_t WS_WO1 = WS_WIN1 + (size_t)2816 * 1024 * 2;
constexpr size_t WS_W1T = WS_WO1 + (size_t)1024 * 1024 * 2;
constexpr size_t WS_GU = WS_W1T + (size_t)2 * 256 * 2048 * 2;
constexpr size_t WS_X1Q = WS_GU + (size_t)32 * 1024 * 1024;
constexpr size_t WS_DN = WS_GU + (size_t)32 * 1024 * 1024 * 2;
constexpr int GU1_P6 = 2816, GU1_EARLY = GU1_P6 + 1536;
constexpr size_t DN1_OFF = (size_t)16 * 1024 * 1024;
constexpr size_t WS_XB = WS_DN + (size_t)32 * 1024 * 512 * 2;
constexpr size_t WS_BIG = WS_XB + (size_t)NTOK * 1024 * 2;
constexpr size_t WS_AOH = WS_BIG + (size_t)NTOK * 3072 * 2;
constexpr size_t WS_GU1 = WS_AOH + (size_t)40 * 1024 * 1024;
constexpr size_t WS_X1B = WS_AOH + (size_t)RPAD * 512 * 2;
constexpr size_t WS_END = WS_X1B + (size_t)NTOK * 1024 * 2;

struct Params {
    const float *x, *rel_bias, *router_w, *router_b, *ln_g, *ln_b, *moba_w_in, *moba_w_out, *nsa_w_in, *nsa_w_out, *pos_k, *pos_v,
                *ck_w1, *ck_w2, *cv_w1, *cv_w2, *w_gate, *w_up, *w_down;
    float* out;
    char* ws;
};

__device__ __forceinline__ int otid() { int t = threadIdx.x; asm volatile("" : "+v"(t)); return t; }
__device__ __forceinline__ float bf2f(bf16_t v) { return __uint_as_float(((unsigned)v) << 16); }
__device__ __forceinline__ unsigned cvt_pk_bf16(float lo, float hi) { unsigned r; asm volatile("v_cvt_pk_bf16_f32 %0, %1, %2" : "=v"(r) : "v"(lo), "v"(hi)); return r; }
constexpr float F8_SW = 256.0f, F8_SX = 8.0f, F8_INV = 1.0f / (F8_SW * F8_SX);
constexpr float I8_SX = 127.0f / 6.0f, I8_SW = 127.0f / 0.18f, I8_INV = 1.0f / (I8_SX * I8_SW);
__device__ __forceinline__ unsigned cvt4_i8(float a, float b, float c, float d) {
    a = __builtin_amdgcn_fmed3f(a, -127.f, 127.f) + 12582912.0f; b = __builtin_amdgcn_fmed3f(b, -127.f, 127.f) + 12582912.0f; c = __builtin_amdgcn_fmed3f(c, -127.f, 127.f) + 12582912.0f; d = __builtin_amdgcn_fmed3f(d, -127.f, 127.f) + 12582912.0f;
    return (__float_as_uint(a) & 0xffu) | ((__float_as_uint(b) & 0xffu) << 8) | ((__float_as_uint(c) & 0xffu) << 16) | (__float_as_uint(d) << 24); }
constexpr float QK8_SQ = 16.0f, QK8_SK = 8.0f, QK8_INV = 1.0f / (QK8_SQ * QK8_SK);
constexpr float F8_SY = 32.0f;
constexpr float F8_SO = 16.0f, F8_INVO = 1.0f / (F8_SW * F8_SO);
__device__ __forceinline__ unsigned cvt4_fp8(float a, float b, float c, float d) {
    a = __builtin_amdgcn_fmed3f(a, -448.f, 448.f); b = __builtin_amdgcn_fmed3f(b, -448.f, 448.f); c = __builtin_amdgcn_fmed3f(c, -448.f, 448.f); d = __builtin_amdgcn_fmed3f(d, -448.f, 448.f);
    int w = 0; w = __builtin_amdgcn_cvt_pk_fp8_f32(a, b, w, false); w = __builtin_amdgcn_cvt_pk_fp8_f32(c, d, w, true); return (unsigned)w; }
__device__ __forceinline__ bf16_t f2bf(float f) { return (bf16_t)(cvt_pk_bf16(f, 0.f) & 0xffffu); }
__device__ __forceinline__ float lo_bf(unsigned w) { return __uint_as_float(w << 16); }
__device__ __forceinline__ float hi_bf(unsigned w) { return __uint_as_float(w & 0xffff0000u); }
__device__ __forceinline__ float wave_sum(float v) {
#pragma unroll
    for (int o = 32; o > 0; o >>= 1) v += __shfl_xor(v, o);
    return v; }

#define XB_TMO      128
#define XB_XCNT(j)  (256  + 64 * (j))
#define XB_XSUB(j)  (1280 + 64 * (j))
#define XB_XGEN(j)  (2304 + 64 * (j))
#define XB_TOP      3328
#define XB_TOPGEN   3392
#define XCD_BAR_WORDS 3456
#define XB_SPIN_CAP (1u << 18)
__device__ __forceinline__ unsigned xb_ld(unsigned* p)              { return __hip_atomic_load(p, __ATOMIC_RELAXED, __HIP_MEMORY_SCOPE_AGENT); }
__device__ __forceinline__ unsigned xb_add(unsigned* p, unsigned v) { return __hip_atomic_fetch_add(p, v, __ATOMIC_RELAXED, __HIP_MEMORY_SCOPE_AGENT); }
__device__ __forceinline__ unsigned xb_xcc_id() { return (unsigned)__builtin_amdgcn_s_getreg((3 << 11) | 20) & 0xFu; }
#define XB_SPIN(cond, bar) do { unsigned _sp = 0; while (cond) { __builtin_amdgcn_s_sleep(1); \
    if ((++_sp & 255u) == 0u) { if (xb_ld(&(bar)[XB_TMO])) break; if (_sp > XB_SPIN_CAP) { atomicAdd(&(bar)[XB_TMO], 1u); break; } } } } while (0)
struct XcdBarrier { unsigned* bar; unsigned x; volatile LAS unsigned* st; };
__device__ __forceinline__ XcdBarrier xcd_barrier_post(unsigned* bar, volatile LAS unsigned* st) {
    XcdBarrier b; b.bar = bar; b.x = xb_xcc_id(); b.st = st;
    if (threadIdx.x == 0) (void)xb_add(&bar[XB_XCNT(b.x)], 1u);
    return b;
}
__device__ __forceinline__ void xcd_barrier_complete(unsigned* bar, unsigned x, unsigned& nloc, unsigned& nx) {
    const unsigned G = gridDim.x * gridDim.y * gridDim.z;
    unsigned sum, cnt, mine, sp = 0u;
    for (;;) {
        sum = 0u; cnt = 0u; mine = 0u;
#pragma unroll
        for (unsigned j = 0; j < 16; ++j) { const unsigned c = xb_ld(&bar[XB_XCNT(j)]); sum += c; cnt += (c > 0u) ? 1u : 0u; mine = (j == x) ? c : mine; }
        if (sum == G) break;
        __builtin_amdgcn_s_sleep(1);
        if ((++sp & 255u) == 0u) { if (xb_ld(&bar[XB_TMO])) break; if (sp > XB_SPIN_CAP) { atomicAdd(&bar[XB_TMO], 1u); break; } }
    }
    nloc = mine > 0u ? mine : 1u; nx = cnt > 0u ? cnt : 1u;
}
__device__ __forceinline__ void xcd_barrier(const XcdBarrier& b) {
    asm volatile("s_waitcnt vmcnt(0)" ::: "memory");
    __syncthreads();
    if (threadIdx.x == 0) {
        unsigned* bar = b.bar;
        __builtin_amdgcn_s_waitcnt(0);
        unsigned nloc = b.st[0], nx = b.st[1];
        if (nloc == 0u) { xcd_barrier_complete(bar, b.x, nloc, nx); b.st[0] = nloc; b.st[1] = nx; }
        const unsigned old = xb_add(&bar[XB_XSUB(b.x)], 1u);
        const unsigned gen = old / nloc;
        bool released = false;
        if (old + 1u == (gen + 1u) * nloc) {
            __builtin_amdgcn_fence(__ATOMIC_RELEASE, "agent");
            asm volatile("s_waitcnt vmcnt(0)" ::: "memory");
            const unsigned og = xb_add(&bar[XB_TOP], 1u);
            const unsigned tg = og / nx;
            if (og + 1u == (tg + 1u) * nx) {
#pragma unroll
                for (unsigned j = 0; j < 16; ++j) xb_add(&bar[XB_XGEN(j)], 1u);
                released = true;
            }
        }
        __builtin_amdgcn_fence(__ATOMIC_ACQUIRE, "agent");
        if (!released) XB_SPIN(xb_ld(&bar[XB_XGEN(b.x)]) == gen, bar);
        asm volatile("s_waitcnt vmcnt(0)" ::: "memory");
    }
    __syncthreads();
}

namespace pg8 {
constexpr int BM = 256, BK = 64, HALF = 128, HTB = HALF * BK * 2, STAGE_BYTES = 8 * HTB, NXCD = 8, WGM = 8;
__device__ __forceinline__ int lds_byte(int r, int c) { const int st = (r >> 4) * 2 + (c >> 5), rr = r & 15, cc = c & 31, ob = rr * 64 + cc * 2; return st * 1024 + (ob ^ (((ob >> 9) & 1) << 5)); }
__device__ __forceinline__ void stage_rc(int b, int& R, int& C) { const int st = b / 1024, sb = b % 1024, swz = sb ^ (((sb >> 9) & 1) << 5); R = (st >> 1) * 16 + swz / 64; C = (st & 1) * 32 + (swz % 64) / 2; }
__device__ __forceinline__ int perm32(int rho) { const int n = rho >> 4, i = rho & 15; return 8 * (i >> 2) + 4 * n + (i & 3); }
struct Unit { int pm, pn, aux, aux2; };
__device__ __forceinline__ i32x8 cat8(bf16x8 a, bf16x8 b) { const i32x4 x = __builtin_bit_cast(i32x4, a), y = __builtin_bit_cast(i32x4, b); return __builtin_shufflevector(x, y, 0, 1, 2, 3, 4, 5, 6, 7); }

__device__ __forceinline__ void static_unit(int L, int nM, int nN, Unit& u) {
    const int nwg = nM * nN;
    int wgid = L; { const int q = nwg / NXCD, r = nwg % NXCD, xcd = wgid % NXCD, off = wgid / NXCD; wgid = (xcd < r ? xcd * (q + 1) : r * (q + 1) + (xcd - r) * q) + off; }
    const int nig = WGM * nN, gid = wgid / nig, fm = gid * WGM, gsz = (nM - fm) < WGM ? (nM - fm) : WGM;
    u.pm = fm + ((wgid % nig) % gsz); u.pn = (wgid % nig) / gsz; u.aux = 0; u.aux2 = 0;
}

__device__ __forceinline__ void stage2(const char* sbase, unsigned v0, unsigned v1, unsigned lds0) {
    unsigned sv;
    asm volatile("s_mov_b32 %0, m0\n\ts_mov_b32 m0, %4\n\ts_nop 0\n\tglobal_load_lds_dwordx4 %1, %3\n\ts_mov_b32 m0, %5\n\ts_nop 0\n\tglobal_load_lds_dwordx4 %2, %3\n\ts_mov_b32 m0, %0"
                 : "=&s"(sv) : "v"(v0), "v"(v1), "s"(sbase), "s"(lds0), "s"(lds0 + 8192u) : "memory");
}
template <class Epi, class Sched>
__device__ __forceinline__ void gemm_phase(LAS unsigned char* lds, const Sched& S, const Epi& E) {
    const int tid = otid(), wid = __builtin_amdgcn_readfirstlane(tid >> 6), lane = tid & 63, wr = wid >> 2, wc = wid & 3, fr = lane & 15, fq = lane >> 4;
    int nt_ = S.nt; asm volatile("" : "+s"(nt_));
    const int nt = nt_;
    int sR[2], sC[2];
    unsigned vB[2][2];
#pragma unroll
    for (int i = 0; i < 2; ++i) { stage_rc(tid * 16 + i * 8192, sR[i], sC[i]); const int Rb = Epi::PERM ? ((sR[i] & ~31) + perm32(sR[i] & 31)) : sR[i];
#pragma unroll
        for (int h = 0; h < 2; ++h) vB[h][i] = (unsigned)(h * HALF + Rb) * S.ldb + (unsigned)sC[i] * 2u; }
    const size_t kstepA = S.kstepA, kstepB = S.kstepB;
    const unsigned ldsb = (unsigned)__builtin_amdgcn_readfirstlane((int)((unsigned)(unsigned long)lds + (unsigned)wid * 1024u));
    const int aoff = lds_byte(wr * 64 + fr, fq * 8), boff = lds_byte(wc * 32 + fr, fq * 8);
#define PG8_SA(b, h) (((b) * 2 + (h)) * HTB)
#define PG8_SB(b, h) ((4 + (b) * 2 + (h)) * HTB)
#define PG8_STAGE(bufoff, gbase, v0, v1) stage2((const char*)(gbase), (v0), (v1), ldsb + (unsigned)(bufoff))
#define PG8_LDA(dst, b, h) do { if constexpr (Sched::F8) { _Pragma("unroll") for (int m = 0; m < 4; ++m) { dst##8[m].lo = *(const LAS i32x4*)(lds + PG8_SA(b, h) + aoff + m * 2048); dst##8[m].hi = *(const LAS i32x4*)(lds + PG8_SA(b, h) + aoff + m * 2048 + 1024); } } \
        else { _Pragma("unroll") for (int m = 0; m < 4; ++m) _Pragma("unroll") for (int k = 0; k < 2; ++k) dst[m][k] = *(const LAS bf16x8*)(lds + PG8_SA(b, h) + aoff + m * 2048 + k * 1024); } } while (0)
#define PG8_LDB(dst, b, h) do { if constexpr (Sched::F8) { _Pragma("unroll") for (int n = 0; n < 2; ++n) { dst##8[n].lo = *(const LAS i32x4*)(lds + PG8_SB(b, h) + boff + n * 2048); dst##8[n].hi = *(const LAS i32x4*)(lds + PG8_SB(b, h) + boff + n * 2048 + 1024); } } \
        else { _Pragma("unroll") for (int n = 0; n < 2; ++n) _Pragma("unroll") for (int k = 0; k < 2; ++k) dst[n][k] = *(const LAS bf16x8*)(lds + PG8_SB(b, h) + boff + n * 2048 + k * 1024); } } while (0)
#define PG8_MMA(ai, bj, At, Bt) do { __builtin_amdgcn_s_setprio(1); \
        if constexpr (Sched::F8) { _Pragma("unroll") for (int m = 0; m < 4; ++m) _Pragma("unroll") for (int n = 0; n < 2; ++n) \
            acc[ai][bj][m][n] = __builtin_amdgcn_mfma_scale_f32_16x16x128_f8f6f4(Bt##8[n], At##8[m], acc[ai][bj][m][n], 0, 0, 0, 0, 0, 0); } \
        else if constexpr (Sched::I8) { _Pragma("unroll") for (int m = 0; m < 4; ++m) _Pragma("unroll") for (int n = 0; n < 2; ++n) _Pragma("unroll") for (int k = 0; k < 2; ++k) \
            acc[ai][bj][m][n] = __builtin_bit_cast(f32x4, __builtin_amdgcn_mfma_i32_16x16x64_i8(__builtin_bit_cast(i32x4, Bt[n][k]), __builtin_bit_cast(i32x4, At[m][k]), __builtin_bit_cast(i32x4, acc[ai][bj][m][n]), 0, 0, 0)); } \
        else { _Pragma("unroll") for (int m = 0; m < 4; ++m) _Pragma("unroll") for (int n = 0; n < 2; ++n) _Pragma("unroll") for (int k = 0; k < 2; ++k) \
            acc[ai][bj][m][n] = __builtin_amdgcn_mfma_f32_16x16x32_bf16(Bt[n][k], At[m][k], acc[ai][bj][m][n], 0, 0, 0); } \
        __builtin_amdgcn_s_setprio(0); } while (0)
#define PG8_WAIT_V(n) asm volatile("s_waitcnt vmcnt(" #n ")" ::: "memory")
#define PG8_WAIT_L(n) asm volatile("s_waitcnt lgkmcnt(" #n ")" ::: "memory")
#define PG8_BAR __builtin_amdgcn_s_barrier()
#define PG8_SCHED __builtin_amdgcn_sched_barrier(0)
    Unit cur, nxt; int ui = 0; int prev_code = -1;
    if (!S.next(0, cur)) return;
    f32x4 acc[2][2][4][2];
#pragma unroll
    for (int a = 0; a < 2; ++a)
#pragma unroll
        for (int b = 0; b < 2; ++b)
#pragma unroll
            for (int m = 0; m < 4; ++m)
#pragma unroll
                for (int n = 0; n < 2; ++n) acc[a][b][m][n] = (f32x4){0.f, 0.f, 0.f, 0.f};
    bf16x8 At[4][2], B0[2][2], B1[2][2]; i32x8 At8[4], B08[2], B18[2];
    unsigned vA[2][2], vN[2][2];
#pragma unroll
    for (int h = 0; h < 2; ++h)
#pragma unroll
        for (int i = 0; i < 2; ++i) { vA[h][i] = S.aoff(cur, h * HALF + sR[i], sC[i]); vN[h][i] = vA[h][i]; }
    const char* cA = S.abase(cur); const char* cB = S.bbase(cur);
    S.a_ready(cur);
    PG8_STAGE(PG8_SB(0, 0), cB, vB[0][0], vB[0][1]); PG8_STAGE(PG8_SA(0, 0), cA, vA[0][0], vA[0][1]); PG8_STAGE(PG8_SB(0, 1), cB, vB[1][0], vB[1][1]); PG8_STAGE(PG8_SA(0, 1), cA, vA[1][0], vA[1][1]);
    if (wr == 1) PG8_BAR;
    PG8_WAIT_V(4); PG8_BAR;
    PG8_STAGE(PG8_SB(1, 0), cB + kstepB, vB[0][0], vB[0][1]); PG8_STAGE(PG8_SA(1, 0), cA + kstepA, vA[0][0], vA[0][1]); PG8_STAGE(PG8_SB(1, 1), cB + kstepB, vB[1][0], vB[1][1]);
    PG8_WAIT_V(6); PG8_BAR;
    for (;;) {
        const bool has_next = S.next(ui + 1, nxt);
        const char* nA = has_next ? S.abase(nxt) : cA; const char* nB = has_next ? S.bbase(nxt) : cB;
        if (Sched::DYN_A && has_next) {
#pragma unroll
            for (int h = 0; h < 2; ++h)
#pragma unroll
                for (int i = 0; i < 2; ++i) vN[h][i] = S.aoff(nxt, h * HALF + sR[i], sC[i]);
        }
        asm volatile(".p2align 8" ::: );
#pragma unroll 1
        for (int t = 0; t < nt; t += 2) {
            const bool last = (t == nt - 2);
            const char* a1 = cA + (size_t)(t + 1) * kstepA;
            const char* a2 = last ? nA : cA + (size_t)(t + 2) * kstepA; const char* b2 = last ? nB : cB + (size_t)(t + 2) * kstepB;
            const char* a3 = a2 + kstepA; const char* b3 = b2 + kstepB;
            if (last && has_next) S.a_ready(nxt);
            PG8_LDB(B0, 0, 0); PG8_SCHED; PG8_LDA(At, 0, 0); PG8_STAGE(PG8_SA(1, 1), a1, vA[1][0], vA[1][1]);
            if (Sched::DYN_A && last) {
#pragma unroll
                for (int h = 0; h < 2; ++h)
#pragma unroll
                    for (int i = 0; i < 2; ++i) vA[h][i] = vN[h][i]; }
            PG8_WAIT_L(8); PG8_BAR; PG8_WAIT_L(0); PG8_MMA(0, 0, At, B0); PG8_BAR; PG8_SCHED;
            PG8_LDB(B1, 0, 1); PG8_STAGE(PG8_SB(0, 0), b2, vB[0][0], vB[0][1]);
            PG8_BAR; PG8_WAIT_L(0); PG8_MMA(0, 1, At, B1); PG8_BAR;
            PG8_LDA(At, 0, 1); PG8_STAGE(PG8_SA(0, 0), a2, vA[0][0], vA[0][1]);
            PG8_BAR; PG8_WAIT_L(0); PG8_MMA(1, 0, At, B0); PG8_BAR; PG8_SCHED;
            PG8_STAGE(PG8_SB(0, 1), b2, vB[1][0], vB[1][1]);
            PG8_WAIT_V(6); PG8_BAR; PG8_MMA(1, 1, At, B1); PG8_BAR;
            PG8_LDB(B0, 1, 0); PG8_SCHED; PG8_LDA(At, 1, 0); PG8_STAGE(PG8_SA(0, 1), a2, vA[1][0], vA[1][1]);
            PG8_WAIT_L(8); PG8_BAR; PG8_WAIT_L(0); PG8_MMA(0, 0, At, B0); PG8_BAR; PG8_SCHED;
            PG8_LDB(B1, 1, 1); PG8_STAGE(PG8_SB(1, 0), b3, vB[0][0], vB[0][1]);
            PG8_BAR; PG8_WAIT_L(0); PG8_MMA(0, 1, At, B1); PG8_BAR;
            PG8_LDA(At, 1, 1); PG8_STAGE(PG8_SA(1, 0), a3, vA[0][0], vA[0][1]);
            PG8_BAR; PG8_WAIT_L(0); PG8_MMA(1, 0, At, B0); PG8_BAR; PG8_SCHED;
            PG8_STAGE(PG8_SB(1, 1), b3, vB[1][0], vB[1][1]);
            PG8_WAIT_V(6); PG8_BAR; PG8_MMA(1, 1, At, B1); PG8_BAR;
            if (Sched::PUBLISH && prev_code >= 0) { S.done(prev_code); prev_code = -1; }
        }
        if constexpr (Sched::I8) {
#pragma unroll
            for (int a = 0; a < 2; ++a)
#pragma unroll
                for (int b = 0; b < 2; ++b)
#pragma unroll
                    for (int m = 0; m < 4; ++m)
#pragma unroll
                        for (int n = 0; n < 2; ++n) { const i32x4 iv = __builtin_bit_cast(i32x4, acc[a][b][m][n]); acc[a][b][m][n] = (f32x4){(float)iv[0], (float)iv[1], (float)iv[2], (float)iv[3]} * I8_INV; } }
        E(acc, cur, wr, wc, fr, fq); prev_code = Sched::PUBLISH ? (cur.pm | (cur.pn << 16)) : -1;
        if (!has_next) break;
#pragma unroll
        for (int a = 0; a < 2; ++a)
#pragma unroll
            for (int b = 0; b < 2; ++b)
#pragma unroll
                for (int m = 0; m < 4; ++m)
#pragma unroll
                    for (int n = 0; n < 2; ++n) acc[a][b][m][n] = (f32x4){0.f, 0.f, 0.f, 0.f};
        cur = nxt; cA = nA; cB = nB; ++ui;
    }
    PG8_WAIT_V(0);
    if (Sched::PUBLISH && prev_code >= 0) S.done(prev_code);
    if (wr == 0) PG8_BAR;
    PG8_BAR;
#undef PG8_SA
#undef PG8_SB
#undef PG8_STAGE
#undef PG8_LDA
#undef PG8_LDB
#undef PG8_MMA
#undef PG8_WAIT_V
#undef PG8_WAIT_L
#undef PG8_BAR
#undef PG8_SCHED
}
}
using pg8::Unit;

struct SchedPlain {
    static constexpr bool DYN_A = false;
    static constexpr bool F8 = false;
    static constexpr bool I8 = false;
    const char* A; const char* Bt; int K, nM, nN, G, c; int nt; unsigned kstepA, kstepB, ldb;
    __device__ __forceinline__ void init(const void* A_, const void* Bt_, int M, int N, int K_) { A = (const char*)A_; Bt = (const char*)Bt_; K = K_; nM = M / 256; nN = N / 256; G = gridDim.x; c = blockIdx.x; nt = K / 64; kstepA = 128; kstepB = 128; ldb = (unsigned)K * 2u; }
    __device__ __forceinline__ bool next(int i, Unit& u) const { const int L = i * G + c; if (L >= nM * nN) return false; pg8::static_unit(L, nM, nN, u); return true; }
    __device__ __forceinline__ const char* abase(const Unit& u) const { return A + (size_t)u.pm * 256 * K * 2; }
    __device__ __forceinline__ const char* bbase(const Unit& u) const { return Bt + (size_t)u.pn * 256 * K * 2; }
    __device__ __forceinline__ unsigned aoff(const Unit&, int row, int col) const { return (unsigned)(row * K + col) * 2u; }
    static constexpr bool PUBLISH = false;
    __device__ __forceinline__ void a_ready(const Unit&) const {}
    __device__ __forceinline__ void done(int) const {}
};
constexpr int ML_CNT = 131072, ML_PPRE = ML_CNT + 128, ML_PE = ML_PPRE + 256;
__device__ __forceinline__ int moe_tables(const char* ws, int layer, LAS unsigned char* lds) {
    const int tid = otid(); LAS int* cnt = (LAS int*)(lds + ML_CNT); LAS int* ppre = (LAS int*)(lds + ML_PPRE); LAS int* pe = (LAS int*)(lds + ML_PE);
    __syncthreads();
    if (tid < 32) cnt[tid] = ((const int*)(ws + WS_GCNT))[layer * 32 + tid];
    __syncthreads();
    if (tid == 0) { int s = 0; for (int e = 0; e < NEXP; ++e) { ppre[e] = s; s += (cnt[e] + 255) >> 8; } ppre[NEXP] = s; }
    __syncthreads();
    const int nM = ppre[NEXP];
    if (tid < nM) { int e = 0; for (int k = 1; k < NEXP; ++k) e += (ppre[k] <= tid) ? 1 : 0; pe[tid] = e; }
    __syncthreads();
    return nM;
}
struct SchedPlainF8 : SchedPlain {
    static constexpr bool F8 = true;
    static constexpr bool I8 = false;
    static constexpr bool DYN_A = true;
    __device__ __forceinline__ const char* abase(const Unit&) const { return A; }
    __device__ __forceinline__ unsigned aoff(const Unit& u, int row, int col) const { return (unsigned)((u.pm * 256 + row) * K + col) * 2u; }
};
struct SchedNsaProj : SchedPlain {
    static constexpr bool PUBLISH = true;
    unsigned* bcnt;
    __device__ __forceinline__ void done(int code) const { const int pm = code & 0xffff, pn = code >> 16;
        if ((pn == 4 || pn == 5) && (threadIdx.x & 63) == 0) __hip_atomic_fetch_add(bcnt + (pm >> 3) * 16, 1u, __ATOMIC_RELAXED, __HIP_MEMORY_SCOPE_AGENT); }
};
struct SchedPlainI8 : SchedPlain { static constexpr bool I8 = true; };
struct SchedNsaProjI8 : SchedNsaProj { static constexpr bool I8 = true; };
struct SchedMoeGU {
    static constexpr bool DYN_A = true;
    static constexpr bool F8 = true;
    static constexpr bool I8 = false;
    const char* X; const char* W; const int* tokof; LAS unsigned char* lds; int nM, G, c; int nt; unsigned kstepA, kstepB, ldb;
    __device__ __forceinline__ void init(const char* ws, int layer, LAS unsigned char* lds_) { lds = lds_; nM = moe_tables(ws, layer, lds_); X = ws + WS_X1Q; W = ws + (layer ? WS_GU1 : WS_GU); tokof = (const int*)(ws + WS_ROWTOK); G = gridDim.x; c = blockIdx.x; nt = 8; kstepA = 128; kstepB = 128; ldb = 1024; }
    __device__ __forceinline__ bool next(int i, Unit& u) const { const int L = i * G + c; if (L >= nM * 4) return false; pg8::static_unit(L, nM, 4, u);
        const int e = ((const LAS int*)(lds + ML_PE))[u.pm]; u.aux = e | ((u.pm - ((const LAS int*)(lds + ML_PPRE))[e]) << 16); u.aux2 = ((const LAS int*)(lds + ML_CNT))[e]; return true; }
    __device__ __forceinline__ const char* abase(const Unit&) const { return X; }
    __device__ __forceinline__ const char* bbase(const Unit& u) const { return W + ((size_t)(u.aux & 255) * 1024 + (size_t)u.pn * 256) * 1024; }
    __device__ __forceinline__ unsigned aoff(const Unit& u, int row, int col) const { const int slot = (u.aux >> 16) * 256 + row; const int sl = slot < u.aux2 ? slot : 0;
        return (unsigned)tokof[(u.aux & 255) * 65536 + sl] * 1024u + (unsigned)col * 2u; }
    static constexpr bool PUBLISH = false;
    __device__ __forceinline__ void a_ready(const Unit&) const {}
    __device__ __forceinline__ void done(int) const {}
};
struct SchedMoeDN {
    static constexpr bool DYN_A = true;
    static constexpr bool F8 = true;
    static constexpr bool I8 = false;
    const char* H; const char* W; LAS unsigned char* lds; int nM, G, c; int nt; unsigned kstepA, kstepB, ldb;
    __device__ __forceinline__ void init(const char* ws, int layer, LAS unsigned char* lds_) { lds = lds_; nM = moe_tables(ws, layer, lds_); H = ws + WS_AOH; W = ws + WS_DN + (layer ? DN1_OFF : 0); G = gridDim.x; c = blockIdx.x; nt = 4; kstepA = 128; kstepB = 128; ldb = 512; }
    __device__ __forceinline__ bool next(int i, Unit& u) const { const int L = i * G + c; if (L >= nM * 4) return false; pg8::static_unit(L, nM, 4, u); u.aux = ((const LAS int*)(lds + ML_PE))[u.pm]; u.aux2 = 0; return true; }
    __device__ __forceinline__ const char* abase(const Unit&) const { return H; }
    __device__ __forceinline__ const char* bbase(const Unit& u) const { return W + ((size_t)u.aux * 1024 + (size_t)u.pn * 256) * 512; }
    __device__ __forceinline__ unsigned aoff(const Unit& u, int row, int col) const { return (unsigned)((u.pm * 256 + row) * 512 + col * 2); }
    static constexpr bool PUBLISH = false;
    __device__ __forceinline__ void a_ready(const Unit&) const {}
    __device__ __forceinline__ void done(int) const {}
};
struct SchedCmp {
    static constexpr bool DYN_A = false;
    static constexpr bool F8 = false;
    static constexpr bool I8 = false;
    static constexpr bool PUBLISH = false;
    const char* Q; const char* W; unsigned* bcnt; unsigned* tmo; int c; int nt; unsigned kstepA, kstepB, ldb;
    __device__ __forceinline__ void init(const char* ws) { Q = ws + WS_BIG; W = ws + WS_W1T; bcnt = (unsigned*)(ws + WS_BCNT); tmo = (unsigned*)(ws + WS_CTL) + XB_TMO; c = (int)blockIdx.x - 128; nt = 16; kstepA = NSA_LD * 2; kstepB = 128; ldb = 4096; }
    __device__ __forceinline__ bool next(int i, Unit& u) const { if (c < 0 || i >= 1 || gridDim.x != 256) return false; const int L = c; u.aux = L >> 6; u.aux2 = 0; u.pm = (L >> 1) & 31; u.pn = L & 1; return true; }
    __device__ __forceinline__ const char* abase(const Unit& u) const { return Q + (size_t)(u.aux ? NSA_VC : NSA_KC) * 2 + (size_t)u.pn * 16 * (NSA_LD * 2); }
    __device__ __forceinline__ const char* bbase(const Unit& u) const { return W + (size_t)u.aux * 256 * 4096 + (size_t)u.pn * 16 * 128; }
    __device__ __forceinline__ unsigned aoff(const Unit& u, int row, int col) const {
        const int m = u.pm * 256 + row, bh = m >> 7, n = m & 127, nn = n > 126 ? 126 : n, b = bh >> 2, hkv = bh & 3;
        return (unsigned)(((b * SEQ + 16 * nn) * NSA_LD) + hkv * 64 + col) * 2u; }
    __device__ __forceinline__ void a_ready(const Unit& u) const {
        if (threadIdx.x < 64) { unsigned polls = 0; unsigned* w = bcnt + (u.pm >> 1) * 16;
            while ((unsigned)__builtin_amdgcn_readfirstlane((int)__hip_atomic_load(w, __ATOMIC_RELAXED, __HIP_MEMORY_SCOPE_AGENT)) < 128u) {
                __builtin_amdgcn_s_sleep(2);
                if ((++polls & 255u) == 0u) { if (__builtin_amdgcn_readfirstlane((int)__hip_atomic_load(tmo, __ATOMIC_RELAXED, __HIP_MEMORY_SCOPE_AGENT)) != 0) break;
                    if (polls > (1u << 18)) { if (threadIdx.x == 0) __hip_atomic_fetch_add(tmo, 1u, __ATOMIC_RELAXED, __HIP_MEMORY_SCOPE_AGENT); break; } } }
            __builtin_amdgcn_fence(__ATOMIC_ACQUIRE, "agent");
            asm volatile("s_waitcnt vmcnt(0)" ::: "memory"); }
        asm volatile("" ::: "memory"); __builtin_amdgcn_s_barrier(); asm volatile("" ::: "memory");
    }
    __device__ __forceinline__ void done(int) const {}
};

struct EpiQKV0 {
    static constexpr bool PERM = true;
    bf16_t* O; float* kpart;
    __device__ __forceinline__ void operator()(const f32x4 (&acc)[2][2][4][2], const Unit& u, int wr, int wc, int fr, int fq) const {
        const int row0 = u.pm * 256 + wr * 64 + fr, col0 = u.pn * 256 + wc * 32 + 8 * fq;
        const float sc = (u.pn < 4) ? C2 : 1.0f;
#pragma unroll
        for (int ai = 0; ai < 2; ++ai)
#pragma unroll
            for (int m = 0; m < 4; ++m) { bf16_t* rowp = O + (size_t)(row0 + ai * 128 + m * 16) * QKV_LD + col0;
#pragma unroll
                for (int bj = 0; bj < 2; ++bj) { const f32x4 v0 = acc[ai][bj][m][0] * sc, v1 = acc[ai][bj][m][1] * sc;
                    if (u.pn < 8) {
                        const float s8 = (u.pn < 4) ? QK8_SQ : QK8_SK;
                        u32x2 w8; w8.x = cvt4_fp8(v0[0] * s8, v0[1] * s8, v0[2] * s8, v0[3] * s8); w8.y = cvt4_fp8(v1[0] * s8, v1[1] * s8, v1[2] * s8, v1[3] * s8);
                        *(u32x2*)((unsigned char*)O + (size_t)(row0 + ai * 128 + m * 16) * (QKV_LD * 2) + (u.pn < 4 ? 0 : 2048) + (u.pn & 3) * 256 + wc * 32 + 8 * fq + bj * 128) = w8; }
                    else { u32x4 w; w.x = cvt_pk_bf16(v0[0], v0[1]); w.y = cvt_pk_bf16(v0[2], v0[3]); w.z = cvt_pk_bf16(v1[0], v1[1]); w.w = cvt_pk_bf16(v1[2], v1[3]);
                        *(u32x4*)(rowp + bj * 128) = w; } } }
        if (u.pn >= 4 && u.pn < 8) {
#pragma unroll
            for (int bj = 0; bj < 2; ++bj)
#pragma unroll
                for (int n = 0; n < 2; ++n) { f32x4 s = (f32x4){0.f, 0.f, 0.f, 0.f};
#pragma unroll
                    for (int ai = 0; ai < 2; ++ai)
#pragma unroll
                        for (int m = 0; m < 4; ++m) s += acc[ai][bj][m][n];
#pragma unroll
                    for (int j = 0; j < 4; ++j) { float v = s[j]; v += __shfl_xor(v, 1); v += __shfl_xor(v, 2); v += __shfl_xor(v, 4); v += __shfl_xor(v, 8); s[j] = v; }
                    if (fr == 0) *(f32x4*)(kpart + ((size_t)u.pm * 2 + wr) * 1024 + (u.pn - 4) * 256 + bj * 128 + wc * 32 + 8 * fq + 4 * n) = s; }
        }
    }
};
struct EpiNull {
    static constexpr bool PERM = true;
    float* sink;
    __device__ __forceinline__ void operator()(const f32x4 (&acc)[2][2][4][2], const Unit& u, int wr, int wc, int fr, int fq) const {
        float s = 0.f;
#pragma unroll
        for (int ai = 0; ai < 2; ++ai)
#pragma unroll
            for (int bj = 0; bj < 2; ++bj)
#pragma unroll
                for (int m = 0; m < 4; ++m)
#pragma unroll
                    for (int n = 0; n < 2; ++n) s += acc[ai][bj][m][n][0] + acc[ai][bj][m][n][3];
        if (s == 12345.678f) sink[u.pm + wr + wc + fr + fq] = s;
    }
};
struct EpiNSA {
    static constexpr bool PERM = true;
    bf16_t* O;
    __device__ __forceinline__ void operator()(const f32x4 (&acc)[2][2][4][2], const Unit& u, int wr, int wc, int fr, int fq) const {
        const int row0 = u.pm * 256 + wr * 64 + fr, col0 = u.pn * 256 + wc * 32 + 8 * fq;
        const float sc = (u.pn < 4) ? C2 : 1.0f; const bool sg = (u.pn == 10), wt = (u.pn == 4 || u.pn == 5);
        const auto rsrc = __builtin_amdgcn_make_buffer_rsrc((void*)O, 0, (int)((size_t)NTOK * NSA_LD * 2), 0x00020000);
#pragma unroll
        for (int ai = 0; ai < 2; ++ai)
#pragma unroll
            for (int m = 0; m < 4; ++m) { bf16_t* rowp = O + (size_t)(row0 + ai * 128 + m * 16) * NSA_LD + col0;
#pragma unroll
                for (int bj = 0; bj < 2; ++bj) { f32x4 v0 = acc[ai][bj][m][0] * sc, v1 = acc[ai][bj][m][1] * sc;
                    if (sg) {
#pragma unroll
                        for (int j = 0; j < 4; ++j) { v0[j] = __builtin_amdgcn_rcpf(1.0f + __builtin_amdgcn_exp2f(-LOG2E * v0[j])); v1[j] = __builtin_amdgcn_rcpf(1.0f + __builtin_amdgcn_exp2f(-LOG2E * v1[j])); } }
                    if (u.pn < 4 || u.pn == 6 || u.pn == 8) {
                        const float s8 = (u.pn < 4) ? QK8_SQ : QK8_SK;
                        u32x2 w8; w8.x = cvt4_fp8(v0[0] * s8, v0[1] * s8, v0[2] * s8, v0[3] * s8); w8.y = cvt4_fp8(v1[0] * s8, v1[1] * s8, v1[2] * s8, v1[3] * s8);
                        *(u32x2*)((unsigned char*)O + (size_t)(row0 + ai * 128 + m * 16) * (NSA_LD * 2) + (u.pn < 4 ? u.pn * 256 : u.pn * 512) + wc * 32 + 8 * fq + bj * 128) = w8; continue; }
                    u32x4 w; w.x = cvt_pk_bf16(v0[0], v0[1]); w.y = cvt_pk_bf16(v0[2], v0[3]); w.z = cvt_pk_bf16(v1[0], v1[1]); w.w = cvt_pk_bf16(v1[2], v1[3]);
                    if (wt) __builtin_amdgcn_raw_buffer_store_b128(w, rsrc, (int)(((unsigned)(row0 + ai * 128 + m * 16) * (unsigned)NSA_LD + (unsigned)(col0 + bj * 128)) * 2u), 0, 16);
                    else *(u32x4*)(rowp + bj * 128) = w; } }
    }
};
template <bool RES_F32, bool F8O = false> struct EpiRes {
    static constexpr bool PERM = true;
    bf16_t* O; const float* rf; const bf16_t* rb;
    __device__ __forceinline__ void operator()(const f32x4 (&acc)[2][2][4][2], const Unit& u, int wr, int wc, int fr, int fq) const {
        const int row0 = u.pm * 256 + wr * 64 + fr, col0 = u.pn * 256 + wc * 32 + 8 * fq;
#pragma unroll
        for (int ai = 0; ai < 2; ++ai) {
            if (RES_F32) {
#pragma unroll
                for (int mh = 0; mh < 2; ++mh) { f32x4 r[2][2][2];
#pragma unroll
                    for (int m2 = 0; m2 < 2; ++m2)
#pragma unroll
                        for (int bj = 0; bj < 2; ++bj) { const size_t ro = (size_t)(row0 + ai * 128 + (mh * 2 + m2) * 16) * 1024 + col0 + bj * 128; r[m2][bj][0] = *(const f32x4*)(rf + ro); r[m2][bj][1] = *(const f32x4*)(rf + ro + 4); }
#pragma unroll
                    for (int m2 = 0; m2 < 2; ++m2)
#pragma unroll
                        for (int bj = 0; bj < 2; ++bj) { const int m = mh * 2 + m2; const size_t ro = (size_t)(row0 + ai * 128 + m * 16) * 1024 + col0 + bj * 128;
                            const f32x4 v0 = acc[ai][bj][m][0] + r[m2][bj][0] * ALPHA, v1 = acc[ai][bj][m][1] + r[m2][bj][1] * ALPHA;
                            u32x4 w; w.x = cvt_pk_bf16(v0[0], v0[1]); w.y = cvt_pk_bf16(v0[2], v0[3]); w.z = cvt_pk_bf16(v1[0], v1[1]); w.w = cvt_pk_bf16(v1[2], v1[3]);
                            *(u32x4*)(O + ro) = w; } }
            } else {
                u32x4 r[4][2];
#pragma unroll
                for (int m = 0; m < 4; ++m)
#pragma unroll
                    for (int bj = 0; bj < 2; ++bj) r[m][bj] = *(const u32x4*)(rb + (size_t)(row0 + ai * 128 + m * 16) * 1024 + col0 + bj * 128);
#pragma unroll
                for (int m = 0; m < 4; ++m)
#pragma unroll
                    for (int bj = 0; bj < 2; ++bj) { const size_t ro = (size_t)(row0 + ai * 128 + m * 16) * 1024 + col0 + bj * 128; const u32x4 rw = r[m][bj];
                        const f32x4 r0 = (f32x4){lo_bf(rw.x), hi_bf(rw.x), lo_bf(rw.y), hi_bf(rw.y)}, r1 = (f32x4){lo_bf(rw.z), hi_bf(rw.z), lo_bf(rw.w), hi_bf(rw.w)};
                        const f32x4 v0 = (F8O ? acc[ai][bj][m][0] * F8_INVO : acc[ai][bj][m][0]) + r0 * ALPHA, v1 = (F8O ? acc[ai][bj][m][1] * F8_INVO : acc[ai][bj][m][1]) + r1 * ALPHA;
                        u32x4 w; w.x = cvt_pk_bf16(v0[0], v0[1]); w.y = cvt_pk_bf16(v0[2], v0[3]); w.z = cvt_pk_bf16(v1[0], v1[1]); w.w = cvt_pk_bf16(v1[2], v1[3]);
                        *(u32x4*)(O + ro) = w; }
            }
        }
    }
};
struct EpiGU {
    static constexpr bool PERM = true;
    unsigned char* O;
    __device__ __forceinline__ void operator()(const f32x4 (&acc)[2][2][4][2], const Unit& u, int wr, int wc, int fr, int fq) const {
        const int row0 = u.pm * 256 + wr * 64 + fr, col0 = u.pn * 128 + wc * 32 + 8 * fq;
#pragma unroll
        for (int ai = 0; ai < 2; ++ai)
#pragma unroll
            for (int m = 0; m < 4; ++m) { float h[8];
#pragma unroll
                for (int n = 0; n < 2; ++n)
#pragma unroll
                    for (int j = 0; j < 4; ++j) { const float g = acc[ai][0][m][n][j] * F8_INV, up = acc[ai][1][m][n][j] * (F8_INV * F8_SX); h[n * 4 + j] = g * up * __builtin_amdgcn_rcpf(1.0f + __builtin_amdgcn_exp2f(-LOG2E * g)); }
                u32x2 w; w.x = cvt4_fp8(h[0], h[1], h[2], h[3]); w.y = cvt4_fp8(h[4], h[5], h[6], h[7]);
                *(u32x2*)(O + (size_t)(row0 + ai * 128 + m * 16) * 512 + col0) = w; }
    }
};
struct EpiDN {
    static constexpr bool PERM = true;
    unsigned char* O;
    __device__ __forceinline__ void operator()(const f32x4 (&acc)[2][2][4][2], const Unit& u, int wr, int wc, int fr, int fq) const {
        const int row0 = u.pm * 256 + wr * 64 + fr, col0 = u.pn * 256 + wc * 32 + 8 * fq; constexpr float s = F8_INV * F8_SY;
#pragma unroll
        for (int ai = 0; ai < 2; ++ai)
#pragma unroll
            for (int m = 0; m < 4; ++m) { unsigned char* rowp = O + (size_t)(row0 + ai * 128 + m * 16) * 1024 + col0;
#pragma unroll
                for (int bj = 0; bj < 2; ++bj) { const f32x4 v0 = acc[ai][bj][m][0] * s, v1 = acc[ai][bj][m][1] * s;
                    u32x2 w; w.x = cvt4_fp8(v0[0], v0[1], v0[2], v0[3]); w.y = cvt4_fp8(v1[0], v1[1], v1[2], v1[3]);
                    *(u32x2*)(rowp + bj * 128) = w; } }
    }
};
struct EpiCmp {
    static constexpr bool PERM = false;
    float* CP;
    __device__ __forceinline__ void operator()(const f32x4 (&acc)[2][2][4][2], const Unit& u, int wr, int wc, int fr, int fq) const {
        float* base = CP + ((size_t)(u.aux * 2 + u.pn) * 8192 + (size_t)u.pm * 256) * 256;
        const int row0 = wr * 64 + fr, col0 = wc * 32 + 4 * fq;
#pragma unroll
        for (int ai = 0; ai < 2; ++ai)
#pragma unroll
            for (int m = 0; m < 4; ++m) { float* rowp = base + (size_t)(row0 + ai * 128 + m * 16) * 256 + col0;
#pragma unroll
                for (int bj = 0; bj < 2; ++bj)
#pragma unroll
                    for (int n = 0; n < 2; ++n) *(f32x4*)(rowp + bj * 128 + n * 16) = acc[ai][bj][m][n]; }
    }
};

constexpr int AL_K = 0  , AL_V = 24576  , AL_BIAS = 57344  , AL_KM = AL_BIAS + 4 * BT_H * 4, AL_IMP = AL_KM + 2048  , AL_CMP = AL_IMP + 33792  , AL_SEL = AL_CMP + 32768, AL_LIST = AL_SEL + 512, AL_END = AL_LIST + 256;
static_assert(AL_END <= LDS_BYTES, "attention LDS map");
static_assert(AL_END <= LDS_BYTES - 16 && 4 * 64 * 33 * 4 <= 65536, "attention LDS map");
#define MFMA32(a, b, c) __builtin_amdgcn_mfma_f32_32x32x16_bf16(a, b, c, 0, 0, 0)
__device__ __forceinline__ s16x4 vtr(lds_cptr p) { return __builtin_bit_cast(s16x4, __builtin_amdgcn_ds_read_tr16_b64_v4i16((LAS v4i16_t*)p)); }
__device__ __forceinline__ float xhalf_max(float m) { auto rr = __builtin_amdgcn_permlane32_swap(__float_as_uint(m), __float_as_uint(m), false, false); return __builtin_fmaxf(__uint_as_float(rr[0]), __uint_as_float(rr[1])); }
__device__ __forceinline__ float xhalf_sum(float m) { auto rr = __builtin_amdgcn_permlane32_swap(__float_as_uint(m), __float_as_uint(m), false, false); return __uint_as_float(rr[0]) + __uint_as_float(rr[1]); }
__device__ __forceinline__ float max16(const f32x16& p) { float a = __builtin_fmaxf(p[0], p[1]), b = __builtin_fmaxf(p[2], p[3]);
#pragma unroll
    for (int r = 4; r < 16; r += 4) { a = __builtin_fmaxf(a, __builtin_fmaxf(p[r], p[r + 1])); b = __builtin_fmaxf(b, __builtin_fmaxf(p[r + 2], p[r + 3])); }
    return __builtin_fmaxf(a, b); }

#define MX3(a, b, c) __builtin_fmaxf(__builtin_fmaxf((a), (b)), (c))
__device__ __forceinline__ float max32(const f32x16& p0, const f32x16& p1) {
    float a = MX3(p0[0], p0[1], p1[0]), b = MX3(p0[2], p0[3], p1[1]); a = MX3(a, p1[2], p1[3]);
#pragma unroll
    for (int r = 4; r < 16; r += 4) { a = MX3(a, p0[r], p0[r + 1]); b = MX3(b, p0[r + 2], p0[r + 3]); a = MX3(a, p1[r], p1[r + 1]); b = MX3(b, p1[r + 2], p1[r + 3]); }
    return __builtin_fmaxf(a, b); }
constexpr float FLASH_THR = 8.0f;
__device__ __forceinline__ void glds16(const void* g, unsigned lds_addr) {
    unsigned sv; asm volatile("s_mov_b32 %0, m0\n\ts_mov_b32 m0, %2\n\ts_nop 0\n\tglobal_load_lds_dwordx4 %1, off\n\ts_mov_b32 m0, %0" : "=&s"(sv) : "v"(g), "s"(lds_addr) : "memory"); }
__device__ __forceinline__ void dma_k(const bf16_t* src, int ld, LAS unsigned char* lds, int slot, int wid, int lane, int base = AL_K) {
    const int rl = lane >> 3, ch = lane & 7;
    glds16(src + (size_t)(wid * 8 + rl) * ld + ((ch ^ rl) * 8), (unsigned)__builtin_amdgcn_readfirstlane((int)((unsigned)(unsigned long)lds + base + slot * 8192 + wid * 1024))); }
__device__ __forceinline__ void dma_v(const bf16_t* src, int ld, LAS unsigned char* lds, int slot, int wid, int lane, int base = AL_V) {
    glds16(src + (size_t)(16 * (wid & 3) + (lane >> 2)) * ld + (wid >> 2) * 32 + (lane & 3) * 8, (unsigned)__builtin_amdgcn_readfirstlane((int)((unsigned)(unsigned long)lds + base + slot * 8192 + wid * 1024))); }

__device__ __forceinline__ void dma_k8(const unsigned char* src8, int ld, LAS unsigned char* lds, int slot, int wid, int lane, int base = AL_K) {
    const int row = 16 * (wid & 3) + (lane >> 2);
    glds16(src8 + (size_t)row * ld + (((lane & 3) ^ ((row >> 2) & 3)) * 16), (unsigned)__builtin_amdgcn_readfirstlane((int)((unsigned)(unsigned long)lds + base + slot * 8192 + (wid & 3) * 1024))); }
struct FState { float m, l; f32x16 o0, o1; };
__device__ __forceinline__ void fstate_reset(FState& s) { s.m = -1e30f; s.l = 0.f;
#pragma unroll
    for (int r = 0; r < 16; ++r) { s.o0[r] = 0.f; s.o1[r] = 0.f; } }

__device__ __forceinline__ int kchunk_off(int d0, int kx) { return (((2 * d0 + (kx >> 3)) ^ (kx & 7)) * 16); }
__device__ __forceinline__ void qk_tile(f32x16& c0, f32x16& c1, const bf16x8 (&qr)[4], lds_cptr kp, int kx) {
#pragma unroll
    for (int d0 = 0; d0 < 4; ++d0) { const bf16x8 k0 = *(const LAS bf16x8*)(kp + kchunk_off(d0, kx)), k1 = *(const LAS bf16x8*)(kp + kchunk_off(d0, kx) + 4096);
        c0 = MFMA32(k0, qr[d0], c0); c1 = MFMA32(k1, qr[d0], c1); }
}
__device__ __forceinline__ void pv_tile(f32x16& o0, f32x16& o1, const f32x16& p0, const f32x16& p1, lds_cptr vp) {
#pragma unroll
    for (int k = 0; k < 4; ++k) {
        const f32x16& ps = (k < 2) ? p0 : p1; const int b = 8 * (k & 1);
        const u32x4 pw = (u32x4){cvt_pk_bf16(ps[b], ps[b + 1]), cvt_pk_bf16(ps[b + 2], ps[b + 3]), cvt_pk_bf16(ps[b + 4], ps[b + 5]), cvt_pk_bf16(ps[b + 6], ps[b + 7])};
        const bf16x8 pf = __builtin_bit_cast(bf16x8, pw);
        { const s16x4 lo = vtr(vp + k * 1024), hi = vtr(vp + k * 1024 + 512);
          const bf16x8 vf = (bf16x8){lo[0], lo[1], lo[2], lo[3], hi[0], hi[1], hi[2], hi[3]}; o0 = MFMA32(vf, pf, o0); }
        { const s16x4 lo = vtr(vp + 4096 + k * 1024), hi = vtr(vp + 4096 + k * 1024 + 512);
          const bf16x8 vf = (bf16x8){lo[0], lo[1], lo[2], lo[3], hi[0], hi[1], hi[2], hi[3]}; o1 = MFMA32(vf, pf, o1); }
    }
}
struct TileP { int Dmin; bool rowok, run, win; };
__device__ __forceinline__ void load_kf(bf16x8 (&kf)[8], lds_cptr kp, int kx) {
#pragma unroll
    for (int d0 = 0; d0 < 4; ++d0) { kf[2 * d0] = *(const LAS bf16x8*)(kp + kchunk_off(d0, kx)); kf[2 * d0 + 1] = *(const LAS bf16x8*)(kp + kchunk_off(d0, kx) + 4096); } }
__device__ __forceinline__ void flash_qk(f32x16& c0, f32x16& c1, float& cf, const bf16x8 (&qr)[4], lds_cptr kp, int kx, const LAS float* btab, float cfar, int Dmin, int r32, int hi) {
    bf16x8 kf[8]; load_kf(kf, kp, kx);
    if (Dmin - 63 < 127) {
        const int s0 = (BT_N - 1 - 63) - (Dmin + r32 - 4 * hi), ksh = s0 & 3; cf = 0.f;
        const LAS f32x4* bp = (const LAS f32x4*)(btab + ksh * BT_S + (s0 - ksh));
#pragma unroll
        for (int g = 0; g < 4; ++g) { const f32x4 a = bp[2 * g], b = bp[8 + 2 * g];
#pragma unroll
            for (int i = 0; i < 4; ++i) { c0[4 * g + i] = a[i]; c1[4 * g + i] = b[i]; } }
#pragma unroll
        for (int d0 = 0; d0 < 4; ++d0) { c0 = MFMA32(kf[2 * d0], qr[d0], c0); c1 = MFMA32(kf[2 * d0 + 1], qr[d0], c1); }
    } else {
        cf = cfar;
        const f32x16 z = {0.f, 0.f, 0.f, 0.f, 0.f, 0.f, 0.f, 0.f, 0.f, 0.f, 0.f, 0.f, 0.f, 0.f, 0.f, 0.f};
        c0 = MFMA32(kf[0], qr[0], z); c1 = MFMA32(kf[1], qr[0], z);
#pragma unroll
        for (int d0 = 1; d0 < 4; ++d0) { c0 = MFMA32(kf[2 * d0], qr[d0], c0); c1 = MFMA32(kf[2 * d0 + 1], qr[d0], c1); }
    }
}
#define MFMA8(a, b, c) __builtin_amdgcn_mfma_scale_f32_32x32x64_f8f6f4(a, b, c, 0, 0, 0, 0, 0, 0)
__device__ __forceinline__ void flash_qk(f32x16& c0, f32x16& c1, float& cf, const i32x8& q8, lds_cptr kp8, int kx, const LAS float* btab, float cfar, int Dmin, int r32, int hi) {
    i32x8 k0, k1; const int o0 = ((2 * hi) ^ kx) * 16, o1 = ((2 * hi + 1) ^ kx) * 16;
    k0.lo = *(const LAS i32x4*)(kp8 + o0); k0.hi = *(const LAS i32x4*)(kp8 + o1); k1.lo = *(const LAS i32x4*)(kp8 + 2048 + o0); k1.hi = *(const LAS i32x4*)(kp8 + 2048 + o1);
    if (Dmin - 63 < 127) {
        const int s0 = (BT_N - 1 - 63) - (Dmin + r32 - 4 * hi), ksh = s0 & 3; cf = 0.f;
        const LAS f32x4* bp = (const LAS f32x4*)(btab + ksh * BT_S + (s0 - ksh));
#pragma unroll
        for (int g = 0; g < 4; ++g) { const f32x4 a = bp[2 * g] * (QK8_SQ * QK8_SK), b = bp[8 + 2 * g] * (QK8_SQ * QK8_SK);
#pragma unroll
            for (int i = 0; i < 4; ++i) { c0[4 * g + i] = a[i]; c1[4 * g + i] = b[i]; } }
        c0 = MFMA8(k0, q8, c0); c1 = MFMA8(k1, q8, c1);
    } else {
        cf = cfar;
        const f32x16 z = {0.f, 0.f, 0.f, 0.f, 0.f, 0.f, 0.f, 0.f, 0.f, 0.f, 0.f, 0.f, 0.f, 0.f, 0.f, 0.f};
        c0 = MFMA8(k0, q8, z); c1 = MFMA8(k1, q8, z);
    }
}
template <bool K8 = false>
__device__ __forceinline__ void flash_sm(FState& st, f32x16& c0, f32x16& c1, float cf, const TileP& tp, int r32, int hi) {
    const int Dmin = tp.Dmin, Dl = Dmin + r32 - 4 * hi;
    if (tp.win && (Dmin + 31 >= 512)) {
#pragma unroll
        for (int r = 0; r < 16; ++r) { const int ko = (r & 3) + 8 * (r >> 2); if (Dl >= 512 + ko) c0[r] = -INFINITY; if (Dl >= 544 + ko) c1[r] = -INFINITY; }
    }
    float mx = (K8 ? xhalf_max(max32(c0, c1)) * QK8_INV : xhalf_max(max32(c0, c1))) + cf;
    mx = tp.rowok ? mx : -INFINITY;
    if (__any(mx > st.m + FLASH_THR)) {
        const float mn = __builtin_fmaxf(st.m, mx); const float alpha = __builtin_amdgcn_exp2f(st.m - mn);
        st.m = mn; st.l *= alpha;
#pragma unroll
        for (int r = 0; r < 16; ++r) { st.o0[r] *= alpha; st.o1[r] *= alpha; }
    }
    const float msub = tp.rowok ? (st.m - cf) : INFINITY;
    float rs0 = 0.f, rs1 = 0.f;
#pragma unroll
    for (int r = 0; r < 16; ++r) { c0[r] = __builtin_amdgcn_exp2f(K8 ? __builtin_fmaf(c0[r], QK8_INV, -msub) : c0[r] - msub); c1[r] = __builtin_amdgcn_exp2f(K8 ? __builtin_fmaf(c1[r], QK8_INV, -msub) : c1[r] - msub); rs0 += c0[r]; rs1 += c1[r]; }
    st.l += rs0 + rs1;
}
template <int VAR, class Src, bool PRE = false, bool K8 = false, class QT = bf16x8[4]>
__device__ __forceinline__ void attn_stream(Src& S, int NT, FState& st, const QT& qr, LAS unsigned char* lds, const LAS float* btab, float cfar, int wid, int lane, int r32, int hi) {
    const lds_cptr kp0 = K8 ? (lds_cptr)lds + AL_K + r32 * 64 : (lds_cptr)lds + AL_K + r32 * 128; const int kx = K8 ? ((r32 >> 2) & 3) : ((r32 & 7) | (hi << 3));
    const lds_cptr vp0 = (lds_cptr)lds + AL_V + ((lane >> 4) & 1) * 32 + (lane & 3) * 8 + (4 * hi + ((lane & 15) >> 2)) * 64;
    if (!PRE) { S.dma(0, 0, 0); if (NT > 1 && VAR != 5 && VAR != 6) S.dma(1, 1, 1); }
    if (VAR == 5) { asm volatile("s_waitcnt vmcnt(0)" ::: "memory"); __syncthreads(); }
    int sc = 0, sn = 2;
    S.prefetch(-1);
#pragma nounroll
    for (int t = 0; t < NT; ++t) {
        if (VAR != 5) { if (t + 1 < NT) asm volatile("s_waitcnt vmcnt(2)" ::: "memory"); else asm volatile("s_waitcnt vmcnt(0)" ::: "memory");
        __syncthreads(); }
        if (VAR != 5 && VAR != 6) { if (t + 2 < NT) S.dma_pre(t + 2, sn, sn); }
        const TileP tp = S.params(t);
        S.prefetch(t);
        if (tp.run) { f32x16 c0, c1; float cf;
            flash_qk(c0, c1, cf, qr, kp0 + sc * 8192, kx, btab, cfar, tp.Dmin, r32, hi);
            flash_sm<K8>(st, c0, c1, cf, tp, r32, hi);
            pv_tile(st.o0, st.o1, c0, c1, vp0 + sc * 8192); }
        S.after(t, st);
        sc = (sc == 2) ? 0 : sc + 1; sn = (sn == 2) ? 0 : sn + 1;
    }
}

__device__ __forceinline__ void conv_tile(const float* src, int N, bf16_t* dst, int ldd, int k0, int n0, int rowadd, int mode, LAS float* t, int lane) {
    f32x4 v[16];
#pragma unroll
    for (int i = 0; i < 16; ++i) { const int r = i * 4 + (lane >> 4), cc = n0 + (lane & 15) * 4;
        v[i] = (cc < N) ? __builtin_nontemporal_load((const f32x4*)(src + (size_t)(k0 + r) * N + cc)) : (f32x4){0.f, 0.f, 0.f, 0.f}; }
#pragma unroll
    for (int i = 0; i < 16; ++i) { const int r = i * 4 + (lane >> 4), cc = (lane & 15) * 4; LAS float* q = t + r * 65 + cc; q[0] = v[i][0]; q[1] = v[i][1]; q[2] = v[i][2]; q[3] = v[i][3]; }
    asm volatile("s_waitcnt lgkmcnt(0)" ::: "memory");
#pragma unroll
    for (int i = 0; i < 8; ++i) { const int nr = i * 8 + (lane >> 3), kc = (lane & 7) * 8; float f[8];
#pragma unroll
        for (int j = 0; j < 8; ++j) f[j] = t[(kc + j) * 65 + nr];
        const int n = n0 + nr; const int drow = ((mode & 1) == 0) ? n : (256 * (n >> 7) + (n & 127) + rowadd);
        if (mode & 2) { u32x2 w8;
            if (mode & 4) { w8.x = cvt4_i8(f[0] * I8_SW, f[1] * I8_SW, f[2] * I8_SW, f[3] * I8_SW); w8.y = cvt4_i8(f[4] * I8_SW, f[5] * I8_SW, f[6] * I8_SW, f[7] * I8_SW); }
            else { w8.x = cvt4_fp8(f[0] * F8_SW, f[1] * F8_SW, f[2] * F8_SW, f[3] * F8_SW); w8.y = cvt4_fp8(f[4] * F8_SW, f[5] * F8_SW, f[6] * F8_SW, f[7] * F8_SW); }
            *(u32x2*)((unsigned char*)dst + (size_t)drow * ldd + k0 + kc) = w8; }
        else { u32x4 w; w.x = cvt_pk_bf16(f[0], f[1]); w.y = cvt_pk_bf16(f[2], f[3]); w.z = cvt_pk_bf16(f[4], f[5]); w.w = cvt_pk_bf16(f[6], f[7]);
            *(u32x4*)(dst + (size_t)drow * ldd + k0 + kc) = w; } }
    asm volatile("s_waitcnt lgkmcnt(0)" ::: "memory");
}
__device__ __forceinline__ int conv_job(const float* src, int K, int N, int Npad, bf16_t* dst, int ldd, int rowadd, int mode, int tile0, LAS float* t, int gw, int ngw, int lane) {
    const int nkt = K / 64, nnt = Npad / 64, ntile = nkt * nnt;
    int first = (gw - tile0 % ngw + ngw) % ngw;
    for (int i = first; i < ntile; i += ngw) conv_tile(src, N, dst, ldd, (i / nnt) * 64, (i % nnt) * 64, rowadd, mode, t, lane);
    return tile0 + ntile;
}
struct MoeTile { const float* src; unsigned char* dst; int N, ldd, k0, n0, rowadd, gated; };
__device__ __forceinline__ MoeTile moe_tile(const Params& p, int layer, int g, int which, size_t dn_off) {
    const int e = which ? (g >> 7) : (g >> 8), job = which ? 2 : ((g >> 7) & 1), tl = g & 127; const size_t wo = ((size_t)layer * NEXP + e) * 1024 * 512; MoeTile m;
    if (job < 2) { m.src = (job ? p.w_up : p.w_gate) + wo; m.N = 512; m.dst = (unsigned char*)(p.ws + (layer ? WS_GU1 : WS_GU)) + (size_t)e * 1024 * 1024; m.ldd = 1024; m.k0 = (tl >> 3) * 64; m.n0 = (tl & 7) * 64; m.rowadd = job * 128; m.gated = 1; }
    else { m.src = p.w_down + wo; m.N = 1024; m.dst = (unsigned char*)(p.ws + WS_DN) + dn_off + (size_t)e * 1024 * 512; m.ldd = 512; m.k0 = (tl >> 4) * 64; m.n0 = (tl & 15) * 64; m.rowadd = 0; m.gated = 0; }
    return m;
}
__device__ __forceinline__ void moe_tile_load(f32x4 (&v)[16], const MoeTile& m, int lane) {
#pragma unroll
    for (int i = 0; i < 16; ++i) { const int r = i * 4 + (lane >> 4), cc = m.n0 + (lane & 15) * 4; v[i] = __builtin_nontemporal_load((const f32x4*)(m.src + (size_t)(m.k0 + r) * m.N + cc)); }
}
__device__ __forceinline__ void moe_tile_finish(const f32x4 (&v)[16], const MoeTile& m, LAS float* t, int lane) {
#pragma unroll
    for (int i = 0; i < 16; ++i) { const int r = i * 4 + (lane >> 4), cc = (lane & 15) * 4; LAS float* q = t + r * 65 + cc; q[0] = v[i][0]; q[1] = v[i][1]; q[2] = v[i][2]; q[3] = v[i][3]; }
    asm volatile("s_waitcnt lgkmcnt(0)" ::: "memory");
#pragma unroll
    for (int i = 0; i < 8; ++i) { const int nr = i * 8 + (lane >> 3), kc = (lane & 7) * 8; float f[8];
#pragma unroll
        for (int j = 0; j < 8; ++j) f[j] = t[(kc + j) * 65 + nr];
        const int n = m.n0 + nr; const int drow = m.gated ? (256 * (n >> 7) + (n & 127) + m.rowadd) : n;
        u32x2 w8; w8.x = cvt4_fp8(f[0] * F8_SW, f[1] * F8_SW, f[2] * F8_SW, f[3] * F8_SW); w8.y = cvt4_fp8(f[4] * F8_SW, f[5] * F8_SW, f[6] * F8_SW, f[7] * F8_SW);
        *(u32x2*)(m.dst + (size_t)drow * m.ldd + m.k0 + kc) = w8; }
    asm volatile("s_waitcnt lgkmcnt(0)" ::: "memory");
}
__device__ __forceinline__ void conv_moe_stream(const Params& p, int layer, int which, size_t dn_off, LAS unsigned char* lds, int gw, int ngw, int gbeg = 0, int gend = -1) {
    const int tid = otid(), lane = tid & 63, wid = tid >> 6;
    LAS float* t = (LAS float*)(lds + wid * (64 * 65 * 4));
    const int NTILE = gend >= 0 ? gend : (which ? NEXP * 128 : NEXP * 256);
    f32x4 va[16], vb[16];
    int g = gbeg + gw;
    if (g < NTILE) { const MoeTile m = moe_tile(p, layer, g, which, dn_off); moe_tile_load(va, m, lane); }
    while (g < NTILE) {
        { const int gn = g + ngw; if (gn < NTILE) { const MoeTile mn = moe_tile(p, layer, gn, which, dn_off); moe_tile_load(vb, mn, lane); }
          const MoeTile m = moe_tile(p, layer, g, which, dn_off); moe_tile_finish(va, m, t, lane); g = gn; }
        if (g >= NTILE) break;
        { const int gn = g + ngw; if (gn < NTILE) { const MoeTile mn = moe_tile(p, layer, gn, which, dn_off); moe_tile_load(va, mn, lane); }
          const MoeTile m = moe_tile(p, layer, g, which, dn_off); moe_tile_finish(vb, m, t, lane); g = gn; }
    }
}
__device__ __forceinline__ void phase_prologue(const Params& p, LAS unsigned char* lds) {
    const int tid = otid(), lane = tid & 63, wid = tid >> 6, gw = blockIdx.x * 8 + wid, ngw = gridDim.x * 8;
    LAS float* t = (LAS float*)(lds + wid * (64 * 65 * 4));
    char* ws = p.ws;
    { const size_t n8 = (size_t)NTOK * 1024 / 8; bf16_t* xb = (bf16_t*)(ws + WS_XB);
      for (size_t i = (size_t)blockIdx.x * NTHREADS + tid; i < n8; i += (size_t)gridDim.x * NTHREADS) {
          const f32x4 a = __builtin_nontemporal_load((const f32x4*)(p.x + i * 8)), b = __builtin_nontemporal_load((const f32x4*)(p.x + i * 8 + 4));
          u32x4 w; w.x = cvt_pk_bf16(a[0], a[1]); w.y = cvt_pk_bf16(a[2], a[3]); w.z = cvt_pk_bf16(b[0], b[1]); w.w = cvt_pk_bf16(b[2], b[3]);
          *(u32x4*)(xb + i * 8) = w;
          u32x2 w8; w8.x = cvt4_i8(a[0] * I8_SX, a[1] * I8_SX, a[2] * I8_SX, a[3] * I8_SX); w8.y = cvt4_i8(b[0] * I8_SX, b[1] * I8_SX, b[2] * I8_SX, b[3] * I8_SX);
          *(u32x2*)((unsigned char*)(ws + WS_X1Q) + i * 8) = w8; } }
    int tile0 = 0;
    tile0 = conv_job(p.moba_w_in, 1024, 3072, 3072, (bf16_t*)(ws + WS_WQKV0), 1024, 0, 6, tile0, t, gw, ngw, lane);
    tile0 = conv_job(p.moba_w_out, 1024, 1024, 1024, (bf16_t*)(ws + WS_WO0), 1024, 0, 2, tile0, t, gw, ngw, lane);
    tile0 = conv_job(p.nsa_w_in, 1024, 2608, 2816, (bf16_t*)(ws + WS_WIN1), 1024, 0, 6, tile0, t, gw, ngw, lane);
    tile0 = conv_job(p.nsa_w_out, 1024, 1024, 1024, (bf16_t*)(ws + WS_WO1), 1024, 0, 2, tile0, t, gw, ngw, lane);
    tile0 = conv_job(p.ck_w1, 2048, 256, 256, (bf16_t*)(ws + WS_W1T), 2048, 0, 0, tile0, t, gw, ngw, lane);
    tile0 = conv_job(p.cv_w1, 2048, 256, 256, (bf16_t*)(ws + WS_W1T) + 256 * 2048, 2048, 0, 0, tile0, t, gw, ngw, lane);
    conv_moe_stream(p, 0, 0, 0, lds, gw, ngw); conv_moe_stream(p, 0, 1, 0, lds, gw, ngw);
    for (int i = blockIdx.x * NTHREADS + tid; i < 16 * BT_H; i += gridDim.x * NTHREADS) {
        const int h = i / BT_H, k = (i % BT_H) / BT_S, j = i % BT_S; int e = (BT_N - 1) - (j + k); e = e < 0 ? 0 : e;
        int n = e - 63; const bool future = n < 0; n = n < 0 ? 0 : (n > 127 ? 127 : n);
        int bk = n;
        if (n >= 16) { bk = 16 + (int)(logf((float)n / 16.0f) / logf(8.0f) * 16.0f); bk = bk > 31 ? 31 : bk; }
        ((float*)(ws + WS_TAB))[i] = future ? -INFINITY : p.rel_bias[bk * 16 + h] * LOG2E; }
    if (gridDim.x == 256) {
        __syncthreads();
        const int combo = blockIdx.x >> 2, kv = combo >> 5, part = combo & 31, jj = tid & 63, ks = tid >> 6, j = (blockIdx.x & 3) * 64 + jj;
        const float* pos = kv ? p.pos_v : p.pos_k; const float* w1 = kv ? p.cv_w1 : p.ck_w1; float s = 0.f;
#pragma unroll
        for (int k = part * 64 + ks * 8; k < part * 64 + ks * 8 + 8; ++k) s += pos[k] * w1[(size_t)k * 256 + j];
        LAS float* red = (LAS float*)lds; red[ks * 64 + jj] = s;
        __syncthreads();
        if (tid < 64) { float a = 0.f;
#pragma unroll
            for (int q8 = 0; q8 < 8; ++q8) a += red[q8 * 64 + tid];
            ((float*)(ws + WS_B1))[(kv * 32 + part) * 256 + j] = a; }
    } else if (blockIdx.x < 32) { const int kv = blockIdx.x >> 4, part = (blockIdx.x & 15) * 2 + (tid >> 8), j = tid & 255;
        const float* pos = kv ? p.pos_v : p.pos_k; const float* w1 = kv ? p.cv_w1 : p.ck_w1; float s = 0.f;
#pragma unroll 16
        for (int k = part * 64; k < part * 64 + 64; ++k) s += pos[k] * w1[(size_t)k * 256 + j];
        ((float*)(ws + WS_B1))[(kv * 32 + part) * 256 + j] = s; }
}

__device__ __forceinline__ void store_o_rows(LAS unsigned char* stg, unsigned char* grow0, const f32x16& a0, const f32x16& a1, float scale, int lane, int r32, int hi) {
    LAS unsigned char* sp = stg + r32 * 80 + hi * 4; const float s16 = scale * F8_SO;
#pragma unroll
    for (int g4 = 0; g4 < 4; ++g4) {
        *(LAS unsigned*)(sp + g4 * 8) = cvt4_fp8(a0[4 * g4] * s16, a0[4 * g4 + 1] * s16, a0[4 * g4 + 2] * s16, a0[4 * g4 + 3] * s16);
        *(LAS unsigned*)(sp + 32 + g4 * 8) = cvt4_fp8(a1[4 * g4] * s16, a1[4 * g4 + 1] * s16, a1[4 * g4 + 2] * s16, a1[4 * g4 + 3] * s16); }
    asm volatile("s_waitcnt lgkmcnt(0)" ::: "memory");
#pragma unroll
    for (int it = 0; it < 2; ++it) { const int row = it * 16 + (lane >> 2), ch = lane & 3;
        const u32x4 v = *(const LAS u32x4*)(stg + row * 80 + ch * 16);
        *(u32x4*)(grow0 + (size_t)row * 1024 + ch * 16) = v; }
    asm volatile("s_waitcnt lgkmcnt(0)" ::: "memory");
}
template <int VAR> __device__ __forceinline__ void moba_unit(const Params& p, LAS unsigned char* lds, int b, int h, int qb) {
    const int tid = otid(), lane = tid & 63, r32 = lane & 31, hi = lane >> 5; const int wid = __builtin_amdgcn_readfirstlane(tid >> 6);
    const bf16_t* QKV = (const bf16_t*)(p.ws + WS_BIG);
    const size_t rowbase = (size_t)b * SEQ; const int q0 = qb * 256, qw = q0 + wid * 32;
    const unsigned char* Kb = (const unsigned char*)QKV + rowbase * (QKV_LD * 2) + 2048 + h * 64;
    const bf16_t* Vb = QKV + rowbase * QKV_LD + 2048 + h * 64;
    i32x8 qr;
    { const unsigned char* qp = (const unsigned char*)QKV + (rowbase + qw + r32) * (QKV_LD * 2) + h * 64 + hi * 32;
      qr.lo = *(const i32x4*)(qp); qr.hi = *(const i32x4*)(qp + 16); }
    float kmv, btv[3];
    { const float* kp = (const float*)(p.ws + WS_KPART); const int j = tid >> 6, d = tid & 63;
      const float* s = kp + ((size_t)(b * 8 + j) * 2) * 1024 + h * 64 + d; kmv = s[0] + s[1024];
#pragma unroll
      for (int i = 0; i < 3; ++i) { const int ix = tid + i * NTHREADS; btv[i] = ((const float*)(p.ws + WS_TAB))[h * BT_H + (ix < BT_H ? ix : 0)]; } }
    __syncthreads();
    dma_k8(Kb + (size_t)q0 * (QKV_LD * 2), QKV_LD * 2, lds, 0, wid, lane); dma_v(Vb + (size_t)q0 * QKV_LD, QKV_LD, lds, 0, wid, lane);
    dma_k8(Kb + (size_t)(q0 + 64) * (QKV_LD * 2), QKV_LD * 2, lds, 1, wid, lane); dma_v(Vb + (size_t)(q0 + 64) * QKV_LD, QKV_LD, lds, 1, wid, lane);
    ((LAS float*)(lds + AL_KM))[tid] = kmv;
#pragma unroll
    for (int i = 0; i < 3; ++i) { const int ix = tid + i * NTHREADS; if (ix < BT_H) ((LAS float*)(lds + AL_BIAS))[ix] = btv[i]; }
    const int NT = 4 + 4 * qb;
    __syncthreads();
    unsigned sel = 0;
    { float g[8];
      float qf[32];
#pragma unroll
      for (int i = 0; i < 8; ++i) { const f32x2 a = __builtin_amdgcn_cvt_pk_f32_fp8(qr[i], false), b2 = __builtin_amdgcn_cvt_pk_f32_fp8(qr[i], true); qf[4 * i] = a[0]; qf[4 * i + 1] = a[1]; qf[4 * i + 2] = b2[0]; qf[4 * i + 3] = b2[1]; }
#pragma unroll
      for (int j = 0; j < 8; ++j) { float s = 0.f; const LAS float* km = (const LAS float*)(lds + AL_KM) + j * 64 + hi * 32;
#pragma unroll
          for (int i = 0; i < 32; ++i) s += qf[i] * km[i];
          g[j] = xhalf_sum(s); }
#pragma unroll
      for (int round = 0; round < 3; ++round) { int best = -1; float bv = 0.f;
#pragma unroll
          for (int j = 0; j < 8; ++j) { const bool ok = (j < qb) && !((sel >> j) & 1u) && (best < 0 || g[j] > bv); if (ok) { best = j; bv = g[j]; } }
          if (best >= 0) sel |= 1u << best; } }
    const LAS float* btab = (const LAS float*)(lds + AL_BIAS); const float cfar = btab[0];
    FState st; fstate_reset(st);
    struct MobaSrc {
        const unsigned char* Kb; const bf16_t* Vb; LAS unsigned char* lds; int qb, qw, wid, lane; unsigned sel;
        __device__ __forceinline__ void tile(int t, int& blk, int& kt) const { blk = t < 4 ? qb : qb - 1 - ((t - 4) >> 2); kt = t < 4 ? t : ((t - 4) & 3); }
        __device__ __forceinline__ void dma(int t, int ks, int vs) const { int blk, kt; tile(t, blk, kt); const size_t key0 = (size_t)blk * 256 + kt * 64;
            dma_k8(Kb + key0 * (QKV_LD * 2), QKV_LD * 2, lds, ks, wid, lane); dma_v(Vb + key0 * QKV_LD, QKV_LD, lds, vs, wid, lane); }
        __device__ __forceinline__ TileP params(int t) const { int blk, kt; tile(t, blk, kt); TileP tp; tp.Dmin = qw - (blk * 256 + kt * 64); tp.win = false;
            if (blk == qb) { tp.rowok = true; tp.run = (64 * kt <= wid * 32 + 31); } else { tp.rowok = (sel >> blk) & 1u; tp.run = __any(tp.rowok); }
            return tp; }
        __device__ __forceinline__ void dma_pre(int t, int ks, int vs) const { dma(t, ks, vs); }
        __device__ __forceinline__ void prefetch(int) const {}
        __device__ __forceinline__ void after(int, FState&) const {}
    } S{Kb, Vb, lds, qb, qw, wid, lane, sel};
    attn_stream<VAR, MobaSrc, true, true, i32x8>(S, NT, st, qr, lds, btab, cfar, wid, lane, r32, hi);
    const float inv = 1.0f / xhalf_sum(st.l);
    store_o_rows(lds + AL_IMP + wid * 8192, (unsigned char*)(p.ws + (VAR ? WS_X1B : WS_AOH)) + (size_t)(rowbase + qw) * 1024 + h * 64, st.o0, st.o1, inv, lane, r32, hi);
}
template <int VAR> __device__ __forceinline__ void phase_moba(const Params& p, LAS unsigned char* lds) {
    for (int pr = blockIdx.x, rnd = 0; pr < 1024; pr += gridDim.x, ++rnd) { const int x = blockIdx.x & 7, s = blockIdx.x >> 3; const int bh = (gridDim.x == 256) ? (x + 8 * (rnd * 8 + (s >> 2))) : (pr >> 2), j = (gridDim.x == 256) ? (s & 3) : (pr & 3);
        moba_unit<VAR>(p, lds, bh >> 4, bh & 15, 7 - j);
        moba_unit<VAR>(p, lds, bh >> 4, bh & 15, j); }
    __syncthreads();
}

__device__ __forceinline__ void nsa_unit(const Params& p, LAS unsigned char* lds, int b, int hkv, int c, bool load_tab, bool load_cmp) {
    const int tid = otid(), lane = tid & 63, r32 = lane & 31, hi = lane >> 5; const int wid = __builtin_amdgcn_readfirstlane(tid >> 6);
    const bf16_t* P = (const bf16_t*)(p.ws + WS_BIG);
    const size_t rowbase = (size_t)b * SEQ; const int g = wid >> 1, qq0 = (wid & 1) * 32, h = hkv * 4 + g, qw = c * 64 + qq0, qpos = qw + r32;
    i32x8 qr;
    const bf16_t* rowp = P + (rowbase + qpos) * NSA_LD;
    { const unsigned char* qp = (const unsigned char*)rowp + h * 64 + hi * 32; qr.lo = *(const i32x4*)(qp); qr.hi = *(const i32x4*)(qp + 16); }
    const float g0 = bf2f(rowp[NSA_G + h * 3]), g1 = bf2f(rowp[NSA_G + h * 3 + 1]), g2 = bf2f(rowp[NSA_G + h * 3 + 2]);
    __syncthreads();
    if (load_tab) { for (int i = tid; i < 4 * BT_H; i += NTHREADS) ((LAS float*)(lds + AL_BIAS))[i] = ((const float*)(p.ws + WS_TAB))[hkv * 4 * BT_H + i]; }
    if (tid < 64) ((LAS unsigned*)(lds + AL_SEL))[tid] = 0u;
    const unsigned char* KS = (const unsigned char*)P + rowbase * (NSA_LD * 2) + NSA_KS * 2 + hkv * 64; const bf16_t* VS = P + rowbase * NSA_LD + NSA_VS + hkv * 64;
    if (load_cmp) { const unsigned char* kc = (const unsigned char*)(p.ws + WS_KCMP) + (size_t)(b * 4 + hkv) * 128 * 64; const bf16_t* vc = (const bf16_t*)(p.ws + WS_VCMP) + (size_t)(b * 4 + hkv) * 128 * 64;
      dma_k8(kc, 64, lds, 0, wid, lane, AL_CMP); dma_k8(kc + 64 * 64, 64, lds, 1, wid, lane, AL_CMP); dma_v(vc, 64, lds, 2, wid, lane, AL_CMP); dma_v(vc + 64 * 64, 64, lds, 3, wid, lane, AL_CMP); }
    dma_k8(KS, NSA_LD * 2, lds, 0, wid, lane); dma_v(VS, NSA_LD, lds, 0, wid, lane);
    asm volatile("s_waitcnt vmcnt(2)" ::: "memory");
    __syncthreads();
    const lds_cptr kp0 = (lds_cptr)lds + AL_CMP + r32 * 64; const int ko0 = ((2 * hi) ^ ((r32 >> 2) & 3)) * 16, ko1 = ((2 * hi + 1) ^ ((r32 >> 2) & 3)) * 16;
    const lds_cptr vp0 = (lds_cptr)lds + AL_CMP + 16384 + ((lane >> 4) & 1) * 32 + (lane & 3) * 8 + (4 * hi + ((lane & 15) >> 2)) * 64;
    f32x16 cb0, cb1;
    {
        f32x16 s[2][2];
        const int nlim = (qpos >= 31 ? ((qpos - 31) >> 4) + 1 : 0) - 4 * hi;
#pragma unroll
        for (int t = 0; t < 2; ++t) {
#pragma unroll
            for (int r = 0; r < 16; ++r) { s[t][0][r] = 0.f; s[t][1][r] = 0.f; }
            { i32x8 k0, k1; const lds_cptr kp8 = kp0 + t * 8192;
              k0.lo = *(const LAS i32x4*)(kp8 + ko0); k0.hi = *(const LAS i32x4*)(kp8 + ko1); k1.lo = *(const LAS i32x4*)(kp8 + 2048 + ko0); k1.hi = *(const LAS i32x4*)(kp8 + 2048 + ko1);
              s[t][0] = MFMA8(k0, qr, s[t][0]); s[t][1] = MFMA8(k1, qr, s[t][1]);
#pragma unroll
              for (int r = 0; r < 16; ++r) { s[t][0][r] *= QK8_INV; s[t][1][r] *= QK8_INV; } }
#pragma unroll
            for (int n2 = 0; n2 < 2; ++n2)
#pragma unroll
                for (int r = 0; r < 16; ++r) { const int nk = 64 * t + 32 * n2 + (r & 3) + 8 * (r >> 2); if (nk >= nlim) s[t][n2][r] = -INFINITY; }
        }
        const float mx = xhalf_max(__builtin_fmaxf(__builtin_fmaxf(max16(s[0][0]), max16(s[0][1])), __builtin_fmaxf(max16(s[1][0]), max16(s[1][1]))));
        const float mref = (mx == -INFINITY) ? 0.f : mx;
        float rs = 0.f;
#pragma unroll
        for (int t = 0; t < 2; ++t)
#pragma unroll
            for (int n2 = 0; n2 < 2; ++n2)
#pragma unroll
                for (int r = 0; r < 16; ++r) { const float e = __builtin_amdgcn_exp2f(s[t][n2][r] - mref); s[t][n2][r] = e; rs += e; }
        const float lt = xhalf_sum(rs); const float inv = lt > 0.f ? 1.0f / lt : 0.f;
#pragma unroll
        for (int t = 0; t < 2; ++t)
#pragma unroll
            for (int n2 = 0; n2 < 2; ++n2)
#pragma unroll
                for (int r = 0; r < 16; ++r) s[t][n2][r] *= inv;
        float Q[16], T[16];
#pragma unroll
        for (int t = 0; t < 2; ++t)
#pragma unroll
            for (int n2 = 0; n2 < 2; ++n2)
#pragma unroll
                for (int r4 = 0; r4 < 4; ++r4) { const int u = 8 * t + 4 * n2 + r4; Q[u] = (s[t][n2][4 * r4] + s[t][n2][4 * r4 + 1]) + (s[t][n2][4 * r4 + 2] + s[t][n2][4 * r4 + 3]); T[u] = s[t][n2][4 * r4 + 3]; }
        LAS float* imp = (LAS float*)(lds + AL_IMP) + (g * 64 + qq0 + r32) * 33;
        float prev = 0.f;
#pragma unroll
        for (int u = 0; u < 16; ++u) { const float rcv = __shfl_xor(T[u], 32); const float add = hi ? rcv : prev; prev = rcv; imp[2 * u + hi] = Q[u] + add; }
        f32x16 o0, o1;
#pragma unroll
        for (int r = 0; r < 16; ++r) { o0[r] = 0.f; o1[r] = 0.f; }
        pv_tile(o0, o1, s[0][0], s[0][1], vp0); pv_tile(o0, o1, s[1][0], s[1][1], vp0 + 8192);
#pragma unroll
        for (int r = 0; r < 16; ++r) { cb0[r] = g0 * o0[r]; cb1[r] = g0 * o1[r]; }
    }
    __syncthreads();
    {
        const int q = tid >> 3, jg = tid & 7; const LAS float* ib = (const LAS float*)(lds + AL_IMP) + q * 33;
        float val[32];
#pragma unroll
        for (int j = 0; j < 32; ++j) { float v = (ib[j] + ib[64 * 33 + j]) + (ib[2 * 64 * 33 + j] + ib[3 * 64 * 33 + j]);
            const bool forced = (j == 0) || (j == c) || (j == c - 1); v = forced ? INFINITY : v; val[j] = (j > c) ? -INFINITY : v; }
        unsigned bits = 0;
#pragma unroll
        for (int i = 0; i < 4; ++i) { const int j = jg * 4 + i; float vj = 0.f;
#pragma unroll
            for (int jj = 0; jj < 32; ++jj) vj = (jj == j) ? val[jj] : vj;
            int rank = 0;
#pragma unroll
            for (int jj = 0; jj < 32; ++jj) rank += (val[jj] > vj || (val[jj] == vj && jj < j)) ? 1 : 0;
            if (j <= c && rank < 16) bits |= 1u << j; }
        if (bits) atomicOr((unsigned*)(lds + AL_SEL) + q, bits);
    }
    __syncthreads();
    unsigned uni = ((const LAS unsigned*)(lds + AL_SEL))[lane];
#pragma unroll
    for (int o = 32; o > 0; o >>= 1) uni |= (unsigned)__shfl_xor((int)uni, o);
    uni = (unsigned)__builtin_amdgcn_readfirstlane((int)uni);
    const unsigned rowmask = ((const LAS unsigned*)(lds + AL_SEL))[qq0 + r32];
    const LAS float* btab = (const LAS float*)(lds + AL_BIAS) + g * BT_H; const float cfar = btab[0];
    const unsigned char* KW = (const unsigned char*)P + rowbase * (NSA_LD * 2) + NSA_KW * 2 + hkv * 64; const bf16_t* VW = P + rowbase * NSA_LD + NSA_VW + hkv * 64;
    const int nslc = __builtin_popcount(uni); const int wlo = c >= 8 ? 0 : 8 - c; const int NT = nslc + (9 - wlo);
    LAS int* list = (LAS int*)(lds + AL_LIST);
    if (tid < 32) { if ((uni >> tid) & 1u) list[__builtin_popcount(uni & ((1u << tid) - 1u))] = tid; }
    else if (tid < 32 + 9 - wlo) list[nslc + (tid - 32)] = 64 + (c - 8 + wlo + (tid - 32));
    __syncthreads();
    FState st; fstate_reset(st);
    struct NsaSrc {
        const unsigned char* KS; const bf16_t* VS; const unsigned char* KW; const bf16_t* VW; LAS unsigned char* lds; const LAS int* list; int nslc, qw, wid, lane; unsigned rowmask; float g1; f32x16* cb0; f32x16* cb1; int pre_d, pre_p;
        __device__ __forceinline__ void prefetch(int t) { pre_d = list[t + 3]; pre_p = list[t + 1]; }
        __device__ __forceinline__ void dma_pre(int, int ks, int vs) const { const int e = __builtin_amdgcn_readfirstlane(pre_d);
            if (e < 64) { dma_k8(KS + (size_t)e * 64 * (NSA_LD * 2), NSA_LD * 2, lds, ks, wid, lane); dma_v(VS + (size_t)e * 64 * NSA_LD, NSA_LD, lds, vs, wid, lane); }
            else { dma_k8(KW + (size_t)(e - 64) * 64 * (NSA_LD * 2), NSA_LD * 2, lds, ks, wid, lane); dma_v(VW + (size_t)(e - 64) * 64 * NSA_LD, NSA_LD, lds, vs, wid, lane); } }
        __device__ __forceinline__ void dma(int t, int ks, int vs) const { const int e = __builtin_amdgcn_readfirstlane(list[t]);
            if (e < 64) { dma_k8(KS + (size_t)e * 64 * (NSA_LD * 2), NSA_LD * 2, lds, ks, wid, lane); dma_v(VS + (size_t)e * 64 * NSA_LD, NSA_LD, lds, vs, wid, lane); }
            else { dma_k8(KW + (size_t)(e - 64) * 64 * (NSA_LD * 2), NSA_LD * 2, lds, ks, wid, lane); dma_v(VW + (size_t)(e - 64) * 64 * NSA_LD, NSA_LD, lds, vs, wid, lane); } }
        __device__ __forceinline__ TileP params(int) const { const int e = __builtin_amdgcn_readfirstlane(pre_p); TileP tp;
            if (e < 64) { tp.Dmin = qw - 64 * e; tp.rowok = (rowmask >> e) & 1u; tp.run = __any(tp.rowok); tp.win = false; }
            else { tp.Dmin = qw - 64 * (e - 64); tp.rowok = true; tp.run = true; tp.win = true; }
            return tp; }
        __device__ __forceinline__ void after(int t, FState& st) const {
            if (t == nslc - 1) { const float f = g1 / xhalf_sum(st.l);
#pragma unroll
                for (int r = 0; r < 16; ++r) { (*cb0)[r] += f * st.o0[r]; (*cb1)[r] += f * st.o1[r]; }
                fstate_reset(st); } }
    } S{KS, VS, KW, VW, lds, list, nslc, qw, wid, lane, rowmask, g1, &cb0, &cb1, 0, 0};
    S.dma(1, 1, 1);
    attn_stream<0, NsaSrc, true, true, i32x8>(S, NT, st, qr, lds, btab, cfar, wid, lane, r32, hi);
    { const float f = g2 / xhalf_sum(st.l);
#pragma unroll
      for (int r = 0; r < 16; ++r) { cb0[r] += f * st.o0[r]; cb1[r] += f * st.o1[r]; } }
    store_o_rows(lds + AL_IMP + wid * 4096, (unsigned char*)(p.ws + WS_AOH) + (size_t)(rowbase + qw) * 1024 + h * 64, cb0, cb1, 1.0f, lane, r32, hi);
}
__device__ __forceinline__ void phase_nsa(const Params& p, LAS unsigned char* lds) {
    int last_hkv = -1;
    for (int pr = blockIdx.x, rnd = 0; pr < 1024; pr += gridDim.x, ++rnd) { const int x = blockIdx.x & 7, s = blockIdx.x >> 3; const int bh = (gridDim.x == 256) ? (x + 8 * (rnd * 2 + (s >> 4))) : (pr >> 4), j = (gridDim.x == 256) ? ((s + 4 * rnd) & 15) : (pr & 15);
        nsa_unit(p, lds, bh >> 2, bh & 3, 31 - j, (bh & 3) != last_hkv, true);
        nsa_unit(p, lds, bh >> 2, bh & 3, j, false, false); last_hkv = bh & 3; }
    __syncthreads();
}

template <int L> __device__ __forceinline__ void phase_ln1(const Params& p, LAS unsigned char* lds) {
    const int tid = otid(), lane = tid & 63, wid = tid >> 6, r = lane & 15, q = lane >> 4;
    const float* lg = p.ln_g + (L * 2 + 0) * 1024; const float* lb = p.ln_b + (L * 2 + 0) * 1024;
    const bf16_t* Y = (const bf16_t*)(p.ws + WS_BIG); bf16_t* X1 = (bf16_t*)(p.ws + WS_X1B);
    for (int i = tid; i < 32 * 2 * 64; i += NTHREADS) { const int l2 = i & 63, nb = (i >> 6) & 1, s = i >> 7; const int e = 16 * nb + (l2 & 15), k0 = 32 * s + 8 * (l2 >> 4);
        float w[8]; unsigned hw[4], lw[4];
#pragma unroll
        for (int j = 0; j < 8; ++j) w[j] = p.router_w[(size_t)(k0 + j) * 32 + e];
#pragma unroll
        for (int j = 0; j < 4; ++j) { hw[j] = cvt_pk_bf16(w[2 * j], w[2 * j + 1]); lw[j] = cvt_pk_bf16(w[2 * j] - lo_bf(hw[j]), w[2 * j + 1] - hi_bf(hw[j])); }
        *(LAS u32x4*)(lds + ((size_t)((s * 2 + nb) * 2 + 0) * 64 + l2) * 16) = (u32x4){hw[0], hw[1], hw[2], hw[3]};
        *(LAS u32x4*)(lds + ((size_t)((s * 2 + nb) * 2 + 1) * 64 + l2) * 16) = (u32x4){lw[0], lw[1], lw[2], lw[3]}; }
    LAS int* hist = (LAS int*)(lds + 131072 + 8 * 2048);
    if (tid < 32) hist[tid] = 0;
    __syncthreads();
    for (int tb = blockIdx.x; tb < NTOK / 128; tb += gridDim.x) {
        const int tok = tb * 128 + wid * 16 + r;
        const bf16_t* yp = Y + (size_t)tok * 1024 + 8 * q;
        float sum = 0.f, sq = 0.f;
#pragma unroll 16
        for (int s = 0; s < 32; ++s) { const u32x4 y = *(const u32x4*)(yp + 32 * s); const unsigned yw[4] = {y.x, y.y, y.z, y.w};
#pragma unroll
            for (int j = 0; j < 4; ++j) { const float a = lo_bf(yw[j]), b2 = hi_bf(yw[j]); sum += a + b2; sq += a * a + b2 * b2; } }
        sum += __shfl_xor(sum, 16); sum += __shfl_xor(sum, 32); sq += __shfl_xor(sq, 16); sq += __shfl_xor(sq, 32);
        const float mu = sum * (1.0f / 1024.0f);
        const float rstd = rsqrtf(fmaxf(sq * (1.0f / 1024.0f) - mu * mu, 0.f) + 1e-5f);
        f32x4 acc0 = (f32x4){0.f, 0.f, 0.f, 0.f}, acc1 = acc0;
        bf16_t* xp = X1 + (size_t)tok * 1024 + 8 * q; unsigned char* xq = (unsigned char*)(p.ws + WS_X1Q) + (size_t)tok * 1024 + 8 * q;
#pragma unroll 4
        for (int s = 0; s < 32; ++s) {
            const u32x4 y = *(const u32x4*)(yp + 32 * s);
            const f32x4 ga = *(const f32x4*)(lg + 32 * s + 8 * q), gb = *(const f32x4*)(lg + 32 * s + 8 * q + 4), ba = *(const f32x4*)(lb + 32 * s + 8 * q), bb = *(const f32x4*)(lb + 32 * s + 8 * q + 4);
            u32x4 w;
            const float x0 = (lo_bf(y.x) - mu) * rstd * ga[0] + ba[0], x1 = (hi_bf(y.x) - mu) * rstd * ga[1] + ba[1], x2 = (lo_bf(y.y) - mu) * rstd * ga[2] + ba[2], x3 = (hi_bf(y.y) - mu) * rstd * ga[3] + ba[3];
            const float x4 = (lo_bf(y.z) - mu) * rstd * gb[0] + bb[0], x5 = (hi_bf(y.z) - mu) * rstd * gb[1] + bb[1], x6 = (lo_bf(y.w) - mu) * rstd * gb[2] + bb[2], x7 = (hi_bf(y.w) - mu) * rstd * gb[3] + bb[3];
            w.x = cvt_pk_bf16(x0, x1); w.y = cvt_pk_bf16(x2, x3); w.z = cvt_pk_bf16(x4, x5); w.w = cvt_pk_bf16(x6, x7);
            *(u32x4*)(xp + 32 * s) = w;
            { u32x2 w8; w8.x = cvt4_fp8(x0 * F8_SX, x1 * F8_SX, x2 * F8_SX, x3 * F8_SX); w8.y = cvt4_fp8(x4 * F8_SX, x5 * F8_SX, x6 * F8_SX, x7 * F8_SX); *(u32x2*)(xq + 32 * s) = w8; }
            const bf16x8 af = __builtin_bit_cast(bf16x8, w);
            const LAS unsigned char* bq = lds + (size_t)s * 4096 + lane * 16;
            const bf16x8 b0h = *(const LAS bf16x8*)(bq), b0l = *(const LAS bf16x8*)(bq + 1024), b1h = *(const LAS bf16x8*)(bq + 2048), b1l = *(const LAS bf16x8*)(bq + 3072);
            acc0 = __builtin_amdgcn_mfma_f32_16x16x32_bf16(af, b0h, acc0, 0, 0, 0); acc0 = __builtin_amdgcn_mfma_f32_16x16x32_bf16(af, b0l, acc0, 0, 0, 0);
            acc1 = __builtin_amdgcn_mfma_f32_16x16x32_bf16(af, b1h, acc1, 0, 0, 0); acc1 = __builtin_amdgcn_mfma_f32_16x16x32_bf16(af, b1l, acc1, 0, 0, 0);
        }
        LAS float* lg2 = (LAS float*)(lds + 131072 + wid * 2048);
#pragma unroll
        for (int i = 0; i < 4; ++i) { lg2[(4 * q + i) * 32 + r] = acc0[i] + p.router_b[r]; lg2[(4 * q + i) * 32 + 16 + r] = acc1[i] + p.router_b[16 + r]; }
        asm volatile("s_waitcnt lgkmcnt(0)" ::: "memory");
        int e0 = 0, e1 = 0, r0 = 0, r1 = 0; float w0 = 0.f, w1 = 0.f;
        if (lane < 16) {
            float pr[32]; float mx = -INFINITY;
#pragma unroll
            for (int e = 0; e < 32; ++e) { pr[e] = lg2[lane * 32 + e]; mx = fmaxf(mx, pr[e]); }
#pragma unroll
            for (int e = 0; e < 32; ++e) pr[e] = __expf(pr[e] - mx);
            int best = 0; float bs = -1.f;
#pragma unroll
            for (int gi = 0; gi < 8; ++gi) { const float a = pr[4 * gi], b2 = pr[4 * gi + 1], c2 = pr[4 * gi + 2], d2 = pr[4 * gi + 3];
                const float h1 = fmaxf(a, b2), l1 = fminf(a, b2), h2 = fmaxf(c2, d2), l2 = fminf(c2, d2);
                const float m1 = fmaxf(h1, h2), m2 = fmaxf(fminf(h1, h2), fmaxf(l1, l2));
                const float sc = m1 + m2; if (sc > bs) { bs = sc; best = gi; } }
            float v[4];
#pragma unroll
            for (int gi = 0; gi < 8; ++gi) if (gi == best) { v[0] = pr[4 * gi]; v[1] = pr[4 * gi + 1]; v[2] = pr[4 * gi + 2]; v[3] = pr[4 * gi + 3]; }
            int i0 = 0; float v0 = v[0];
#pragma unroll
            for (int i = 1; i < 4; ++i) if (v[i] > v0) { v0 = v[i]; i0 = i; }
            int i1 = -1; float v1 = -1.f;
#pragma unroll
            for (int i = 0; i < 4; ++i) if (i != i0 && v[i] > v1) { v1 = v[i]; i1 = i; }
            e0 = best * 4 + i0; e1 = best * 4 + i1; const float ws = 1.0f / (v0 + v1); w0 = v0 * ws; w1 = v1 * ws;
            r0 = atomicAdd((int*)hist + e0, 1); r1 = atomicAdd((int*)hist + e1, 1);
        }
        __syncthreads();
        if (tid < 32) { const int hv = hist[tid]; hist[32 + tid] = hv ? atomicAdd((int*)(p.ws + WS_GCNT) + L * 32 + tid, hv) : 0; }
        __syncthreads();
        if (lane < 16) { const int t2 = tb * 128 + wid * 16 + lane; const int s0 = hist[32 + e0] + r0, s1 = hist[32 + e1] + r1;
            ((int*)(p.ws + WS_RE))[t2 * 2] = e0; ((int*)(p.ws + WS_RE))[t2 * 2 + 1] = e1;
            ((float*)(p.ws + WS_RWT))[t2 * 2] = w0 * (1.0f / F8_SY); ((float*)(p.ws + WS_RWT))[t2 * 2 + 1] = w1 * (1.0f / F8_SY);
            ((int*)(p.ws + WS_POS))[t2 * 2] = s0; ((int*)(p.ws + WS_POS))[t2 * 2 + 1] = s1;
            ((int*)(p.ws + WS_ROWTOK))[e0 * 65536 + s0] = t2; ((int*)(p.ws + WS_ROWTOK))[e1 * 65536 + s1] = t2; }
        __syncthreads();
        if (tid < 32) hist[tid] = 0;
        __syncthreads();
    }
}

template <int L> __device__ __forceinline__ void phase_ln2(const Params& p, LAS unsigned char* lds) {
    const int tid = otid(), lane = tid & 63, wid = tid >> 6;
    LAS int* pst = (LAS int*)lds;
    __syncthreads();
    if (tid == 0) { const int* cnt = (const int*)(p.ws + WS_GCNT) + L * 32; int s = 0; for (int e = 0; e < NEXP; ++e) { pst[e] = s; s += (cnt[e] + 255) & ~255; } }
    __syncthreads();
    const int* RE = (const int*)(p.ws + WS_RE);
    const float* lg = p.ln_g + (L * 2 + 1) * 1024; const float* lb = p.ln_b + (L * 2 + 1) * 1024;
    const bf16_t* X1 = (const bf16_t*)(p.ws + WS_X1B); const unsigned char* YB = (const unsigned char*)(p.ws + WS_BIG);
    const int* POS = (const int*)(p.ws + WS_POS); const float* RW = (const float*)(p.ws + WS_RWT);
    const int tok0 = blockIdx.x * 8 + wid, tstride = gridDim.x * 8, nk = (NTOK - tok0 + tstride - 1) / tstride;
    int rs0 = 0, rs1 = 0; float rw0 = 0.f, rw1 = 0.f;
    if (lane < nk && lane < 16) { const int t = tok0 + lane * tstride; rs0 = pst[RE[t * 2]] + POS[t * 2]; rs1 = pst[RE[t * 2 + 1]] + POS[t * 2 + 1]; rw0 = RW[t * 2]; rw1 = RW[t * 2 + 1]; }
    u32x4 ra[2][2]; u32x2 rb[2][2], rc[2][2];
#define LN2_LOAD(k, buf) do { const int t_ = tok0 + (k) * tstride; const int s0_ = __shfl(rs0, (k)), s1_ = __shfl(rs1, (k)); _Pragma("unroll") for (int hf = 0; hf < 2; ++hf) { const int c0 = hf * 512 + lane * 8; \
        ra[buf][hf] = __builtin_nontemporal_load((const u32x4*)(X1 + (size_t)t_ * 1024 + c0)); rb[buf][hf] = __builtin_nontemporal_load((const u32x2*)(YB + (size_t)s0_ * 1024 + c0)); rc[buf][hf] = __builtin_nontemporal_load((const u32x2*)(YB + (size_t)s1_ * 1024 + c0)); } } while (0)
    if (nk > 0) LN2_LOAD(0, 0);
#pragma unroll
    for (int k = 0; k < 16; ++k) {
        if (k < nk) {
            const int tok = tok0 + k * tstride; const float w0 = __shfl(rw0, k), w1 = __shfl(rw1, k);
            if (k + 1 < nk) LN2_LOAD(k + 1, (k + 1) & 1);
            float v[16];
#pragma unroll
            for (int hf = 0; hf < 2; ++hf) { const u32x4 a = ra[k & 1][hf]; const u32x2 b = rb[k & 1][hf], c = rc[k & 1][hf];
                const unsigned aw[4] = {a.x, a.y, a.z, a.w}, bw[2] = {b.x, b.y}, cw[2] = {c.x, c.y};
#pragma unroll
                for (int j = 0; j < 4; ++j) { const f32x2 yb = (j & 1) ? __builtin_amdgcn_cvt_pk_f32_fp8((int)bw[j >> 1], true) : __builtin_amdgcn_cvt_pk_f32_fp8((int)bw[j >> 1], false);
                    const f32x2 yc = (j & 1) ? __builtin_amdgcn_cvt_pk_f32_fp8((int)cw[j >> 1], true) : __builtin_amdgcn_cvt_pk_f32_fp8((int)cw[j >> 1], false);
                    v[hf * 8 + 2 * j] = ALPHA * lo_bf(aw[j]) + w0 * yb[0] + w1 * yc[0]; v[hf * 8 + 2 * j + 1] = ALPHA * hi_bf(aw[j]) + w0 * yb[1] + w1 * yc[1]; } }
            float s = 0.f;
#pragma unroll
            for (int i = 0; i < 16; ++i) s += v[i];
            const float mu = wave_sum(s) * (1.0f / 1024.0f);
            float qv = 0.f;
#pragma unroll
            for (int i = 0; i < 16; ++i) { const float d = v[i] - mu; qv += d * d; }
            const float rstd = rsqrtf(wave_sum(qv) * (1.0f / 1024.0f) + 1e-5f);
#pragma unroll
            for (int hf = 0; hf < 2; ++hf) { const int c0 = hf * 512 + lane * 8; float o[8];
                const f32x4 ga = *(const f32x4*)(lg + c0), gb = *(const f32x4*)(lg + c0 + 4), ba = *(const f32x4*)(lb + c0), bb = *(const f32x4*)(lb + c0 + 4);
#pragma unroll
                for (int j = 0; j < 4; ++j) { o[j] = (v[hf * 8 + j] - mu) * rstd * ga[j] + ba[j]; o[4 + j] = (v[hf * 8 + 4 + j] - mu) * rstd * gb[j] + bb[j]; }
                if (L == 1) { __builtin_nontemporal_store((f32x4){o[0], o[1], o[2], o[3]}, (f32x4*)(p.out + (size_t)tok * 1024 + c0)); __builtin_nontemporal_store((f32x4){o[4], o[5], o[6], o[7]}, (f32x4*)(p.out + (size_t)tok * 1024 + c0 + 4)); }
                else { u32x4 w; w.x = cvt_pk_bf16(o[0], o[1]); w.y = cvt_pk_bf16(o[2], o[3]); w.z = cvt_pk_bf16(o[4], o[5]); w.w = cvt_pk_bf16(o[6], o[7]); *(u32x4*)((bf16_t*)(p.ws + WS_XB) + (size_t)tok * 1024 + c0) = w;
                    u32x2 w8; w8.x = cvt4_i8(o[0] * I8_SX, o[1] * I8_SX, o[2] * I8_SX, o[3] * I8_SX); w8.y = cvt4_i8(o[4] * I8_SX, o[5] * I8_SX, o[6] * I8_SX, o[7] * I8_SX);
                    *(u32x2*)((unsigned char*)(p.ws + WS_X1Q) + (size_t)tok * 1024 + c0) = w8; } }
        }
    }
#undef LN2_LOAD
}

__device__ __forceinline__ void phase_cmpfin(const Params& p, LAS unsigned char* lds) {
    const int tid = otid(), lane = tid & 63, wid = tid >> 6;
    LAS float* w2s = (LAS float*)lds;
    LAS float* hs = (LAS float*)(lds + 65536) + wid * 1024;
    LAS float* b1s = (LAS float*)(lds + 65536 + 32768);
    const float* CP = (const float*)(p.ws + WS_X1B); const float* B1 = (const float*)(p.ws + WS_B1);
    for (int kv = 0; kv < 2; ++kv) {
        __syncthreads();
        { const float* w2g = kv ? p.cv_w2 : p.ck_w2; for (int i = tid; i < 256 * 64; i += NTHREADS) w2s[i] = w2g[i]; }
        if (tid < 256) { float b1 = 0.f;
#pragma unroll 8
            for (int pt = 0; pt < 32; ++pt) b1 += B1[(kv * 32 + pt) * 256 + tid];
            b1s[tid] = b1; }
        __syncthreads();
        bf16_t* dst = (bf16_t*)(p.ws + (kv ? WS_VCMP : WS_KCMP));
        for (int rg = blockIdx.x * 8 + wid; rg < 8192 / 4; rg += gridDim.x * 8) {
            const int m0 = rg * 4;
#pragma unroll
            for (int i = 0; i < 4; ++i) { const int j = lane + 64 * i; const float b1 = b1s[j];
                f32x4 hv;
#pragma unroll
                for (int rr = 0; rr < 4; ++rr) { float a = b1;
#pragma unroll
                    for (int ks = 0; ks < 2; ++ks) a += __builtin_nontemporal_load(CP + ((size_t)(kv * 2 + ks) * 8192 + m0 + rr) * 256 + j);
                    const float u = 0.7978845608028654f * (a + 0.044715f * a * a * a); const float th = 1.0f - 2.0f / (1.0f + __expf(2.0f * u));
                    hv[rr] = 0.5f * a * (1.0f + th); }
                *(LAS f32x4*)(hs + j * 4) = hv; }
            asm volatile("s_waitcnt lgkmcnt(0)" ::: "memory");
            f32x4 o = (f32x4){0.f, 0.f, 0.f, 0.f}; const LAS float* w2 = w2s + lane;
#pragma unroll 8
            for (int j = 0; j < 256; ++j) o += *(const LAS f32x4*)(hs + j * 4) * w2[j * 64];
#pragma unroll
            for (int rr = 0; rr < 4; ++rr) { const float ov = (((m0 + rr) & 127) == 127) ? 0.f : o[rr];
                if (kv) dst[(size_t)(m0 + rr) * 64 + lane] = f2bf(ov);
                else ((unsigned char*)dst)[(size_t)(m0 + rr) * 64 + lane] = (unsigned char)(cvt4_fp8(ov * QK8_SK, 0.f, 0.f, 0.f) & 0xffu); }
            asm volatile("s_waitcnt lgkmcnt(0)" ::: "memory");
        }
    }
}

constexpr int NPHASE = 19;
template <int PH> __device__ __forceinline__ void run_phase(const Params& p, LAS unsigned char* lds) {
    char* ws = p.ws;
    if constexpr (PH == 0) phase_prologue(p, lds);
    else if constexpr (PH == 1) { SchedPlainI8 S; S.init(ws + WS_X1Q, ws + WS_WQKV0, NTOK, 3072, 512); EpiQKV0 E{(bf16_t*)(ws + WS_BIG), (float*)(ws + WS_KPART)}; pg8::gemm_phase(lds, S, E); }
    else if constexpr (PH == 2) phase_moba<0>(p, lds);
    else if constexpr (PH == 3) { SchedPlainF8 S; S.init(ws + WS_AOH, ws + WS_WO0, NTOK, 1024, 512); EpiRes<false, true> E{(bf16_t*)(ws + WS_BIG), nullptr, (const bf16_t*)(ws + WS_XB)}; pg8::gemm_phase(lds, S, E); }
    else if constexpr (PH == 4) phase_ln1<0>(p, lds);
    else if constexpr (PH == 6 || PH == 16) { SchedMoeGU S; S.init(ws, PH == 16, lds); EpiGU E{(unsigned char*)(ws + WS_AOH)}; pg8::gemm_phase(lds, S, E);
        {
            const int rem = (S.nM * 4) % (int)gridDim.x, nidle = (int)gridDim.x - rem; const bool useidle = (rem > 0 && nidle * 2 >= (int)gridDim.x);
            const int cgw = useidle ? ((int)blockIdx.x - rem) * 8 + (otid() >> 6) : (int)blockIdx.x * 8 + (otid() >> 6), cng = (useidle ? nidle : (int)gridDim.x) * 8;
            __syncthreads();
            if (!useidle || (int)blockIdx.x >= rem) {
                if constexpr (PH == 6) conv_moe_stream(p, 1, 0, 0, lds, cgw, cng, 0, GU1_P6);
                else conv_moe_stream(p, 1, 1, DN1_OFF, lds, cgw, cng); } } }
    else if constexpr (PH == 7 || PH == 17) { SchedMoeDN S; S.init(ws, PH == 17, lds); EpiDN E{(unsigned char*)(ws + WS_BIG)}; pg8::gemm_phase(lds, S, E);
        if constexpr (PH == 7) {
            const int rem = (S.nM * 4) % (int)gridDim.x, nidle = (int)gridDim.x - rem; const bool useidle = (rem > 0 && nidle * 2 >= (int)gridDim.x);
            __syncthreads();
            if (!useidle) conv_moe_stream(p, 1, 0, 0, lds, (int)blockIdx.x * 8 + (otid() >> 6), (int)gridDim.x * 8, GU1_P6, GU1_EARLY);
            else if ((int)blockIdx.x >= rem) conv_moe_stream(p, 1, 0, 0, lds, ((int)blockIdx.x - rem) * 8 + (otid() >> 6), nidle * 8, GU1_P6, GU1_EARLY); } }
    else if constexpr (PH == 8) { phase_ln2<0>(p, lds); __syncthreads(); conv_moe_stream(p, 1, 0, 0, lds, (int)blockIdx.x * 8 + (otid() >> 6), (int)gridDim.x * 8, GU1_EARLY); }
    else if constexpr (PH == 9) {
        { SchedNsaProjI8 S; S.init(ws + WS_X1Q, ws + WS_WIN1, NTOK, 2816, 512); S.bcnt = (unsigned*)(ws + WS_BCNT); EpiNSA E{(bf16_t*)(ws + WS_BIG)}; pg8::gemm_phase(lds, S, E); }
        { SchedCmp S; S.init(ws); EpiCmp E{(float*)(ws + WS_X1B)}; pg8::gemm_phase(lds, S, E); } }
    else if constexpr (PH == 11) phase_cmpfin(p, lds);
    else if constexpr (PH == 12) phase_nsa(p, lds);
    else if constexpr (PH == 13) { SchedPlainF8 S; S.init(ws + WS_AOH, ws + WS_WO1, NTOK, 1024, 512); EpiRes<false, true> E{(bf16_t*)(ws + WS_BIG), nullptr, (const bf16_t*)(ws + WS_XB)}; pg8::gemm_phase(lds, S, E); }
    else if constexpr (PH == 14) phase_ln1<1>(p, lds);
    else if constexpr (PH == 18) phase_ln2<1>(p, lds);
}

extern __shared__ __attribute__((aligned(16))) unsigned char g_smem[];

template <int PH> __global__ void __launch_bounds__(NTHREADS, 2) k_phase(Params p) {
    run_phase<PH>(p, (LAS unsigned char*)g_smem);
}

#if !MK_LAUNCHES
template <int PH> __device__ __forceinline__ void mega_seq(const Params& p, LAS unsigned char* lds, const XcdBarrier& bar) {
    if constexpr (PH == 5 || PH == 15 || PH == 10) { mega_seq<PH + 1>(p, lds, bar); return; }
    run_phase<PH>(p, lds);
#ifdef PROBE_VAR
    if constexpr (PH == 2) { xcd_barrier(bar); phase_moba<PROBE_VAR>(p, lds); }
#endif
#ifdef PROBE_BAR
    if constexpr (PH == 3) { for (int i = 0; i < 16; ++i) xcd_barrier(bar); }
#endif
#ifdef PROBE_GEMM_NULL
    if constexpr (PH == 1) { xcd_barrier(bar); SchedPlain S; S.init(p.ws + WS_XB, p.ws + WS_WQKV0, NTOK, 3072, 1024); EpiNull E{(float*)(p.ws + WS_X1B)}; pg8::gemm_phase(lds, S, E); }
#endif
#ifdef PROBE_MASK
    if constexpr ((PROBE_MASK >> PH) & 1) { xcd_barrier(bar); run_phase<PH>(p, lds); }
#endif
    if constexpr (PH + 1 < NPHASE) { xcd_barrier(bar); mega_seq<PH + 1>(p, lds, bar); }
}
__global__ void __launch_bounds__(NTHREADS, 2) k_mega(Params p) {
    LAS unsigned char* lds = (LAS unsigned char*)g_smem;
    LAS unsigned* stw = (LAS unsigned*)(lds + LDS_BYTES - 16);
    if (threadIdx.x == 0) { stw[0] = 0u; stw[1] = 0u; stw[2] = 0u; stw[3] = 0u; }
    __syncthreads();
    XcdBarrier bar = xcd_barrier_post((unsigned*)(p.ws + WS_CTL), (volatile LAS unsigned*)stw);
    mega_seq<0>(p, lds, bar);
}

#endif
template <int PH> static void launch_phases(const Params& p, int grid, hipStream_t stream) {
    hipFuncSetAttribute((const void*)k_phase<PH>, hipFuncAttributeMaxDynamicSharedMemorySize, LDS_BYTES);
    hipLaunchKernelGGL(k_phase<PH>, dim3(grid), dim3(NTHREADS), LDS_BYTES, stream, p);
    if constexpr (PH + 1 < NPHASE) launch_phases<PH + 1>(p, grid, stream);
}

extern "C" void kernel_launch(void* const* d_in, const int* in_sizes, int n_in, void* d_out, int out_size, void* d_ws, size_t ws_size, hipStream_t stream) {
    if (n_in != 19 || ws_size < WS_END) { fprintf(stderr, "kernel_launch: need 19 inputs and %zu bytes of workspace (got %d, %zu)\n", (size_t)WS_END, n_in, ws_size); return; }
    Params p{};
    p.x = (const float*)d_in[0]; p.rel_bias = (const float*)d_in[1]; p.router_w = (const float*)d_in[2]; p.router_b = (const float*)d_in[3];
    p.ln_g = (const float*)d_in[4]; p.ln_b = (const float*)d_in[5]; p.moba_w_in = (const float*)d_in[6]; p.moba_w_out = (const float*)d_in[7];
    p.nsa_w_in = (const float*)d_in[8]; p.nsa_w_out = (const float*)d_in[9]; p.pos_k = (const float*)d_in[10]; p.pos_v = (const float*)d_in[11];
    p.ck_w1 = (const float*)d_in[12]; p.ck_w2 = (const float*)d_in[13]; p.cv_w1 = (const float*)d_in[14]; p.cv_w2 = (const float*)d_in[15];
    p.w_gate = (const float*)d_in[16]; p.w_up = (const float*)d_in[17]; p.w_down = (const float*)d_in[18];
    p.out = (float*)d_out; p.ws = (char*)d_ws;
    const int grid = NWG_EXPECT;
#if MK_LAUNCHES
    launch_phases<0>(p, grid, stream);
#else
    hipFuncSetAttribute((const void*)k_mega, hipFuncAttributeMaxDynamicSharedMemorySize, LDS_BYTES);
    hipMemsetAsync((char*)d_ws + WS_CTL, 0, 16384, stream);
    hipLaunchKernelGGL(k_mega, dim3(grid), dim3(NTHREADS), LDS_BYTES, stream, p);
#endif
}
```
